# Optimizing an MI355X kernel written in HIP

```python
import math
import jax
import jax.numpy as jnp
from jax import lax
import numpy as np

D_MODEL = 1024
BATCH = 2
SEQ = 16384
DEPTH = 2

GRID_W = 64
CTX_LEN = 256
GLA_HEADS = 4
GLA_DK = 32
GLA_DV = 64
GLA_GATE_RANK = 16
GLA_TAU = 16.0
GLA_CHUNK = 64
HY_CH = 256
HY_ORDER = 2
HY_EMB = 33
HY_FILTER_HIDDEN = 64
HY_DECAY_TARGET = 1e-2
HY_FAST_DECAY = 0.3
HY_SLOW_DECAY = 1.5
SHORT_CONV = 3
MLA_HEADS = 8
MLA_Q_RANK = 256
MLA_KV_RANK = 128
MLA_NOPE = 64
MLA_ROPE = 32
MLA_V = 64
MLA_SCALE = (MLA_NOPE + MLA_ROPE) ** -0.5
ROPE_BASE = 10000.0
Q_BLOCK = 128
D_FF = 2816
N_EXPERTS = 8
TOP_K = 2
EXPERT_FF = 3584
D_MIX = GLA_HEADS * GLA_DV + HY_CH + MLA_HEADS * MLA_V
IN_SPLITS = (GLA_HEADS * GLA_DK, GLA_HEADS * GLA_DK, GLA_HEADS * GLA_DV, GLA_HEADS * GLA_DV,
             2 * GLA_GATE_RANK, 3 * HY_CH, MLA_Q_RANK, MLA_KV_RANK, MLA_ROPE)
IN_COLS = sum(IN_SPLITS)
F32 = jnp.float32

kernel_name = "hybrid_gla_hyena_mla_dit_block"


def _rms(x, g, eps=1e-6):
    xf = x.astype(F32)
    y = xf * lax.rsqrt(jnp.mean(xf * xf, axis=-1, keepdims=True) + eps)
    return (y * g.astype(F32)).astype(x.dtype)


def _layernorm(x, g, b, eps=1e-5):
    xf = x.astype(F32)
    mu = jnp.mean(xf, axis=-1, keepdims=True)
    var = jnp.mean(jnp.square(xf - mu), axis=-1, keepdims=True)
    return ((xf - mu) * lax.rsqrt(var + eps) * g.astype(F32) + b.astype(F32)).astype(x.dtype)


def _modulate(x, shift, scale):
    return x * (1 + scale) + shift


def _split_cols(p):
    cuts = [int(v) for v in np.cumsum(IN_SPLITS)[:-1]]
    return jnp.split(p, cuts, axis=-1)


def _heads(t, d):
    B, L, _ = t.shape
    return t.reshape(B, L, -1, d).transpose(0, 2, 1, 3).astype(F32)


def _flip(t):
    return t[:, :, ::-1]


def _gla_q(qa):
    return _heads(qa, GLA_DK) * GLA_DK ** -0.5


def _gla_kv(ka, va, alr, w_gate, b_gate):
    k = _heads(ka, GLA_DK)
    v = _heads(va, GLA_DV)
    log_a = []
    for d in range(2):
        z = alr[..., d * GLA_GATE_RANK:(d + 1) * GLA_GATE_RANK] @ w_gate[d] + b_gate[d]
        log_a.append(_heads(jax.nn.log_sigmoid(z.astype(F32)) / GLA_TAU, GLA_DK))
    return k, v, log_a[0], log_a[1]


def _gla_state(k, v, log_a):
    b = jnp.cumsum(log_a, axis=2)
    return jnp.einsum('bhtk,bhtv->bhkv', k * jnp.exp(b[:, :, -1:] - b), v)


def _gla_chunked(q, k, v, log_a, s0):
    B, H, L, DK = q.shape
    DV = v.shape[-1]
    n = L // GLA_CHUNK
    to_chunks = lambda t: jnp.moveaxis(t.reshape(B, H, n, GLA_CHUNK, t.shape[-1]), 2, 0)
    mask = jnp.tril(jnp.ones((GLA_CHUNK, GLA_CHUNK), dtype=bool))[:, :, None]

    def step(S, inp):
        qi, ki, vi, ai = inp
        b = jnp.cumsum(ai, axis=2)
        o_inter = jnp.einsum('bhtk,bhkv->bhtv', qi * jnp.exp(b), S)
        diff = b[:, :, :, None, :] - b[:, :, None, :, :]
        decay = jnp.where(mask, jnp.exp(jnp.minimum(diff, 0.0)), 0.0)
        att = jnp.einsum('bhtk,bhsk,bhtsk->bhts', qi, ki, decay)
        o = o_inter + jnp.einsum('bhts,bhsv->bhtv', att, vi)
        b_last = b[:, :, -1:, :]
        S_new = jnp.exp(b_last[:, :, 0, :])[..., None] * S + jnp.einsum(
            'bhsk,bhsv->bhkv', ki * jnp.exp(b_last - b), vi)
        return S_new, o

    _, o = lax.scan(step, s0, (to_chunks(q), to_chunks(k), to_chunks(v), to_chunks(log_a)))
    return jnp.moveaxis(o, 0, 2).reshape(B, H, L, DV)


def _gla_bidir(q, k, v, la_f, la_b, s_f, s_b):
    o_f = _gla_chunked(q, k, v, la_f, s_f)
    o_b = _flip(_gla_chunked(_flip(q), _flip(k), _flip(v), _flip(la_b), s_b))
    return o_f + o_b


def _gla_out(o, g, norm_g):
    B, H, L, DV = o.shape
    o = o.transpose(0, 2, 1, 3).astype(g.dtype)
    o = _rms(o, norm_g) * jax.nn.silu(g.reshape(B, L, H, DV))
    return o.reshape(B, L, H * DV)


def _short_conv(u, w, b):
    L = u.shape[1]
    pad = SHORT_CONV // 2
    up = jnp.pad(u, ((0, 0), (pad, pad), (0, 0)))
    y = b
    for j in range(SHORT_CONV):
        y = y + up[:, j:j + L] * w[j]
    return y


def _hyena_filters(L, fw1, fb1, ff1, fw2, fb2, ff2, fw3, fb3):
    pos = jnp.arange(L, dtype=F32)
    t = pos / (L - 1)
    bands = (HY_EMB - 1) // 2
    freqs = jnp.linspace(1e-4, bands - 1, bands, dtype=F32)
    ang = (2.0 * math.pi * pos / L)[:, None] * freqs
    z = jnp.concatenate([t[:, None], jnp.cos(ang), -jnp.sin(ang)], axis=-1)
    hid = jnp.sin(ff1.astype(F32) * (z @ fw1.astype(F32) + fb1.astype(F32)))
    hid = jnp.sin(ff2.astype(F32) * (hid @ fw2.astype(F32) + fb2.astype(F32)))
    h = (hid @ fw3.astype(F32) + fb3.astype(F32)).reshape(L, HY_ORDER, 2, HY_CH)
    deltas = jnp.abs(jnp.linspace(math.log(HY_DECAY_TARGET) / HY_SLOW_DECAY,
                                  math.log(HY_DECAY_TARGET) / HY_FAST_DECAY, HY_CH, dtype=F32))
    h = h * jnp.exp(-t[:, None, None, None] * deltas)
    return h * lax.rsqrt(jnp.sum(h * h, axis=(0, 2), keepdims=True) + 1e-6)


def _bidir_fftconv(u, h_fwd, h_bwd, d_skip):
    L = u.shape[1]
    h_circ = jnp.concatenate([h_fwd, jnp.zeros_like(h_fwd[:1]), h_bwd[:0:-1]], axis=0)
    hf = jnp.fft.rfft(h_circ, n=2 * L, axis=0)
    uf = jnp.fft.rfft(u.astype(F32), n=2 * L, axis=1)
    y = jnp.fft.irfft(uf * hf[None], n=2 * L, axis=1)[:, :L]
    return (y + u.astype(F32) * d_skip.astype(F32)).astype(u.dtype)


def _hyena(u, conv_w, conv_b, filt, skip):
    L = u.shape[1]
    u = _short_conv(u, conv_w, conv_b)
    v, x1, x2 = jnp.split(u, 3, axis=-1)
    h = _hyena_filters(L, *filt)
    z = x1 * _bidir_fftconv(v, h[:, 0, 0], h[:, 0, 1], skip[0])
    return x2 * _bidir_fftconv(z, h[:, 1, 0], h[:, 1, 1], skip[1])


def _rope_2d(x, row, col):
    half = x.shape[-1] // 2
    inv = ROPE_BASE ** (-jnp.arange(0, half, 2, dtype=F32) / half)

    def rot(xa, pos):
        ang = pos.astype(F32)[:, None, None] * inv
        cos = jnp.cos(ang).astype(x.dtype)
        sin = jnp.sin(ang).astype(x.dtype)
        x1, x2 = jnp.split(xa, 2, axis=-1)
        return jnp.concatenate([x1 * cos - x2 * sin, x1 * sin + x2 * cos], axis=-1)

    return jnp.concatenate([rot(x[..., :half], row), rot(x[..., half:], col)], axis=-1)


def _mla_q(cq, qn_g, w_uq, row, col):
    B, L, _ = cq.shape
    q = (_rms(cq, qn_g) @ w_uq).reshape(B, L, MLA_HEADS, MLA_NOPE + MLA_ROPE)
    if row is None:
        return q
    return jnp.concatenate([q[..., :MLA_NOPE], _rope_2d(q[..., MLA_NOPE:], row, col)], axis=-1)


def _mla_kv(ckv, kr, kvn_g, w_ukv, row, col):
    B, L, _ = ckv.shape
    kv = (_rms(ckv, kvn_g) @ w_ukv).reshape(B, L, MLA_HEADS, MLA_NOPE + MLA_V)
    k_nope, v = kv[..., :MLA_NOPE], kv[..., MLA_NOPE:]
    kr = kr[:, :, None, :]
    if row is not None:
        kr = _rope_2d(kr, row, col)
    k = jnp.concatenate([k_nope, jnp.broadcast_to(kr, (B, L, MLA_HEADS, MLA_ROPE))], axis=-1)
    return k, v


def _attend(q, k, v):
    s = jnp.einsum('bqhd,bkhd->bhqk', q, k).astype(F32) * MLA_SCALE
    p = jax.nn.softmax(s, axis=-1).astype(v.dtype)
    return jnp.einsum('bhqk,bkhd->bqhd', p, v)


def _attend_blocked(q, k, v):
    B, L, H, D = q.shape
    nb = L // Q_BLOCK
    qb = jnp.moveaxis(q.reshape(B, nb, Q_BLOCK, H, D), 1, 0)
    ob = lax.map(lambda t: _attend(t, k, v), qb)
    return jnp.moveaxis(ob, 0, 1).reshape(B, L, H, -1)


def _token_mixers(ph, pc, row, col, need_ctx, gla_p, hy_p, mla_p):
    B, L, _ = ph.shape
    qa, ka, va, ga, alr, hyu, cq, ckv, kr = _split_cols(ph)
    qa_c, ka_c, va_c, ga_c, alr_c, hyu_c, cq_c, ckv_c, kr_c = _split_cols(pc)
    w_gate, b_gate, gla_g = gla_p
    conv_w, conv_b, filt, skip, hy_g = hy_p
    qn_g, w_uq, kvn_g, w_ukv, mla_g = mla_p

    k_c, v_c, la_cf, la_cb = _gla_kv(ka_c, va_c, alr_c, w_gate, b_gate)
    s_f = _gla_state(k_c, v_c, la_cf)
    s_b = _gla_state(_flip(k_c), _flip(v_c), _flip(la_cb))
    km_c, vm_c = _mla_kv(ckv_c, kr_c, kvn_g, w_ukv, None, None)

    k, v, la_f, la_b = _gla_kv(ka, va, alr, w_gate, b_gate)
    y_a = _gla_out(_gla_bidir(_gla_q(qa), k, v, la_f, la_b, s_f, s_b), ga, gla_g)
    y_b = _rms(_hyena(hyu, conv_w, conv_b, filt, skip), hy_g)
    km, vm = _mla_kv(ckv, kr, kvn_g, w_ukv, row, col)
    om = _attend_blocked(_mla_q(cq, qn_g, w_uq, row, col),
                         jnp.concatenate([km_c, km], axis=1), jnp.concatenate([vm_c, vm], axis=1))
    y_c = _rms(om.reshape(B, L, -1), mla_g)
    y = jnp.concatenate([y_a, y_b, y_c], axis=-1)
    if not need_ctx:
        return y, None

    Lc = pc.shape[1]
    z0 = jnp.zeros_like(s_f)
    yc_a = _gla_out(_gla_bidir(_gla_q(qa_c), k_c, v_c, la_cf, la_cb, z0, z0), ga_c, gla_g)
    yc_b = _rms(_hyena(hyu_c, conv_w, conv_b, filt, skip), hy_g)
    omc = _attend(_mla_q(cq_c, qn_g, w_uq, None, None), km_c, vm_c)
    yc_c = _rms(omc.reshape(B, Lc, -1), mla_g)
    return y, jnp.concatenate([yc_a, yc_b, yc_c], axis=-1)


def _swiglu(h, w1, w3, w2):
    return (jax.nn.silu(h @ w1) * (h @ w3)) @ w2


def _moe(h, w_router, w1, w3, w2):
    logits = (h @ w_router).astype(F32)
    top_v, top_i = lax.top_k(logits, TOP_K)
    top_w = jax.nn.softmax(top_v, axis=-1)
    gates = jnp.sum(jax.nn.one_hot(top_i, N_EXPERTS, dtype=F32) * top_w[..., None], axis=-2).astype(h.dtype)
    out = jnp.zeros_like(h)
    for e in range(N_EXPERTS):
        out = out + gates[..., e:e + 1] * _swiglu(h, w1[e], w3[e], w2[e])
    return out


def setup_inputs(seed: int = 0) -> dict:
    key = jax.random.key(seed)
    ks = iter(jax.random.split(key, 48))
    nrm = lambda shape, scale=1.0: scale * jax.random.normal(next(ks), shape, F32)
    gain = lambda shape: 1.0 + 0.1 * jax.random.normal(next(ks), shape, F32)
    D = D_MODEL
    Hf = HY_FILTER_HIDDEN
    beta = (8.0 * DEPTH) ** -0.25
    n_dense = (DEPTH + 1) // 2
    n_moe = DEPTH // 2
    return {
        "x": nrm((BATCH, SEQ, D)),
        "c": nrm((BATCH, D)),
        "ctx": nrm((BATCH, CTX_LEN, D)),
        "c_ctx": nrm((D,)),
        "w_mod": nrm((DEPTH, D, 6 * D), 0.5 * D ** -0.5),
        "b_mod": nrm((DEPTH, 6 * D), 0.01),
        "w_in": nrm((DEPTH, D, IN_COLS), D ** -0.5),
        "gla_w_gate": nrm((DEPTH, 2, GLA_GATE_RANK, GLA_HEADS * GLA_DK), GLA_GATE_RANK ** -0.5),
        "gla_b_gate": nrm((DEPTH, 2, GLA_HEADS * GLA_DK), 0.1),
        "gla_norm_g": gain((DEPTH, GLA_DV)),
        "hy_conv_w": nrm((DEPTH, SHORT_CONV, 3 * HY_CH), SHORT_CONV ** -0.5),
        "hy_conv_b": nrm((DEPTH, 3 * HY_CH), 0.01),
        "hy_f_w1": nrm((DEPTH, HY_EMB, Hf), HY_EMB ** -0.5),
        "hy_f_b1": nrm((DEPTH, Hf), 0.1),
        "hy_f_freq1": gain((DEPTH, Hf)),
        "hy_f_w2": nrm((DEPTH, Hf, Hf), Hf ** -0.5),
        "hy_f_b2": nrm((DEPTH, Hf), 0.1),
        "hy_f_freq2": gain((DEPTH, Hf)),
        "hy_f_w3": nrm((DEPTH, Hf, HY_ORDER * 2 * HY_CH), Hf ** -0.5),
        "hy_f_b3": nrm((DEPTH, HY_ORDER * 2 * HY_CH), 0.1),
        "hy_skip": nrm((DEPTH, HY_ORDER, HY_CH)),
        "hy_norm_g": gain((DEPTH, HY_CH)),
        "mla_q_norm_g": gain((DEPTH, MLA_Q_RANK)),
        "mla_w_uq": nrm((DEPTH, MLA_Q_RANK, MLA_HEADS * (MLA_NOPE + MLA_ROPE)), MLA_Q_RANK ** -0.5),
        "mla_kv_norm_g": gain((DEPTH, MLA_KV_RANK)),
        "mla_w_ukv": nrm((DEPTH, MLA_KV_RANK, MLA_HEADS * (MLA_NOPE + MLA_V)), MLA_KV_RANK ** -0.5),
        "mla_norm_g": gain((DEPTH, MLA_HEADS * MLA_V)),
        "w_out": nrm((DEPTH, D_MIX, D), beta * D_MIX ** -0.5),
        "ln_g": gain((DEPTH, 2, D)),
        "ln_b": nrm((DEPTH, 2, D), 0.01),
        "ffn_w1": nrm((n_dense, D, D_FF), D ** -0.5),
        "ffn_w3": nrm((n_dense, D, D_FF), D ** -0.5),
        "ffn_w2": nrm((n_dense, D_FF, D), beta * D_FF ** -0.5),
        "moe_router": nrm((n_moe, D, N_EXPERTS), D ** -0.5),
        "moe_w1": nrm((n_moe, N_EXPERTS, D, EXPERT_FF), D ** -0.5),
        "moe_w3": nrm((n_moe, N_EXPERTS, D, EXPERT_FF), D ** -0.5),
        "moe_w2": nrm((n_moe, N_EXPERTS, EXPERT_FF, D), beta * EXPERT_FF ** -0.5),
    }


def reference(x, c, ctx, c_ctx, w_mod, b_mod, w_in, gla_w_gate, gla_b_gate, gla_norm_g,
              hy_conv_w, hy_conv_b, hy_f_w1, hy_f_b1, hy_f_freq1, hy_f_w2, hy_f_b2, hy_f_freq2,
              hy_f_w3, hy_f_b3, hy_skip, hy_norm_g, mla_q_norm_g, mla_w_uq, mla_kv_norm_g, mla_w_ukv,
              mla_norm_g, w_out, ln_g, ln_b, ffn_w1, ffn_w3, ffn_w2, moe_router, moe_w1, moe_w3, moe_w2):
    B, L, _ = x.shape
    ROWS = L // GRID_W
    row = jnp.broadcast_to(jnp.arange(ROWS, dtype=jnp.int32)[:, None], (ROWS, GRID_W)).reshape(-1)
    col = jnp.broadcast_to(jnp.arange(GRID_W, dtype=jnp.int32)[None, :], (ROWS, GRID_W)).reshape(-1)
    alpha = (2.0 * DEPTH) ** 0.25
    s_lat = jax.nn.silu(c)
    s_ctx = jax.nn.silu(c_ctx)
    xc = ctx
    for l in range(DEPTH):
        need_ctx = l < DEPTH - 1
        m = jnp.split((s_lat @ w_mod[l] + b_mod[l])[:, None, :], 6, axis=-1)
        mc = jnp.split(s_ctx @ w_mod[l] + b_mod[l], 6, axis=-1)
        gla_p = (gla_w_gate[l], gla_b_gate[l], gla_norm_g[l])
        filt = (hy_f_w1[l], hy_f_b1[l], hy_f_freq1[l], hy_f_w2[l], hy_f_b2[l], hy_f_freq2[l],
                hy_f_w3[l], hy_f_b3[l])
        hy_p = (hy_conv_w[l], hy_conv_b[l], filt, hy_skip[l], hy_norm_g[l])
        mla_p = (mla_q_norm_g[l], mla_w_uq[l], mla_kv_norm_g[l], mla_w_ukv[l], mla_norm_g[l])

        ph = _modulate(x, m[0], m[1]) @ w_in[l]
        pc = _modulate(xc, mc[0], mc[1]) @ w_in[l]
        y, yc = _token_mixers(ph, pc, row, col, need_ctx, gla_p, hy_p, mla_p)
        x = _layernorm(alpha * x + m[2] * (y @ w_out[l]), ln_g[l, 0], ln_b[l, 0])
        if need_ctx:
            xc = _layernorm(alpha * xc + mc[2] * (yc @ w_out[l]), ln_g[l, 0], ln_b[l, 0])

        def ffn(h, i=l // 2, dense=(l % 2 == 0)):
            if dense:
                return _swiglu(h, ffn_w1[i], ffn_w3[i], ffn_w2[i])
            return _moe(h, moe_router[i], moe_w1[i], moe_w3[i], moe_w2[i])

        x = _layernorm(alpha * x + m[5] * ffn(_modulate(x, m[3], m[4])), ln_g[l, 1], ln_b[l, 1])
        if need_ctx:
            xc = _layernorm(alpha * xc + mc[5] * ffn(_modulate(xc, mc[3], mc[4])), ln_g[l, 1], ln_b[l, 1])
    return x
```

```cpp
#include <hip/hip_runtime.h>
#include <cstdio>
#include <cstdint>
namespace pg8 {
#define PG8_LAS __attribute__((address_space(3)))
#define PG8_GAS __attribute__((address_space(1)))
typedef unsigned short bf16_t;
typedef short bf16x8 __attribute__((ext_vector_type(8)));
typedef float f32x4 __attribute__((ext_vector_type(4)));
typedef unsigned u32x4 __attribute__((ext_vector_type(4)));
typedef int i32x8_t __attribute__((ext_vector_type(8)));
typedef short bf16x16 __attribute__((ext_vector_type(16)));
constexpr int BM = 256, BK = 64, HALF = 128, HTB = HALF * BK * 2  , STAGE_BYTES = 8 * HTB, NXCD = 8, WGM = 8;

__host__ __device__ __forceinline__ int lds_byte(int r, int c) { const int st = (r >> 4) * 2 + (c >> 5), rr = r & 15, cc = c & 31, ob = rr * 64 + cc * 2; return st * 1024 + (ob ^ (((ob >> 9) & 1) << 5)); }
__host__ __device__ __forceinline__ void stage_rc(int b, int& R, int& C) { const int st = b / 1024, sb = b % 1024, swz = sb ^ (((sb >> 9) & 1) << 5); R = (st >> 1) * 16 + swz / 64; C = (st & 1) * 32 + (swz % 64) / 2; }
__host__ __device__ __forceinline__ int perm32(int rho) { const int n = rho >> 4, i = rho & 15; return 8 * (i >> 2) + 4 * n + (i & 3); }

struct Unit { int pm, pn, be; };
struct Gemm { const PG8_GAS bf16_t* A; const PG8_GAS bf16_t* Bt; int M, N, K; int lda; size_t bstride; };

struct StaticOrder {
    int nM, nN, nwg, G, c;
    __host__ __device__ void init(int M, int N, int G_, int c_) { nM = M / BM; nN = N / BM; nwg = nM * nN; G = G_; c = c_; }
    __host__ __device__ bool next(int i, Unit& u) const {
        const long L = (long)i * G + c; if (L >= nwg) return false;
        int wgid = (int)L; { const int q = nwg / NXCD, r = nwg % NXCD, xcd = wgid % NXCD, off = wgid / NXCD; wgid = (xcd < r ? xcd * (q + 1) : r * (q + 1) + (xcd - r) * q) + off; }
        const int nig = WGM * nN, gid = wgid / nig, fm = gid * WGM, gsz = (nM - fm) < WGM ? (nM - fm) : WGM;
        u.pm = fm + ((wgid % nig) % gsz); u.pn = (wgid % nig) / gsz; u.be = 0; return true;
    }
    __device__ __forceinline__ void a_ready(const Unit&) const {}
    __device__ __forceinline__ void done(const Unit&) const {}
};


__device__ __forceinline__ unsigned cvt_pk_bf16(float lo, float hi) { unsigned r; asm volatile("v_cvt_pk_bf16_f32 %0, %1, %2" : "=v"(r) : "v"(lo), "v"(hi)); return r; }
typedef float f32x2 __attribute__((ext_vector_type(2)));
typedef unsigned u32x2 __attribute__((ext_vector_type(2)));

template <class Epi, class Sched, bool ALIGN_EPI = false, bool SP2 = false, bool F8 = false>
__device__ __forceinline__ void gemm_phase(PG8_LAS unsigned char* lds, const Gemm g, const Sched& S, const Epi& E) {
    { unsigned lb_ = (unsigned)(size_t)lds; asm volatile("" : "+s"(lb_)); lds = (PG8_LAS unsigned char*)(size_t)lb_; }
    int tid_ = threadIdx.x; asm volatile("" : "+v"(tid_));
    const int tid = tid_, wid = __builtin_amdgcn_readfirstlane(tid >> 6), lane = tid & 63, wr = wid >> 2, wc = wid & 3, fr = lane & 15, fq = lane >> 4;
    int K_ = g.K; asm volatile("" : "+s"(K_)); const int K = K_, nt = K / BK;
    unsigned voffA[2], voffB[2];
#pragma unroll
    for (int i = 0; i < 2; ++i) { int R, C; stage_rc(tid * 16 + i * 8192, R, C); const int Rb = Epi::PERM ? ((R & ~31) + perm32(R & 31)) : R;
        voffA[i] = (unsigned)(R * g.lda + C) * 2u; voffB[i] = (unsigned)(Rb * K + C) * 2u; }
    const size_t kstep = (size_t)(BK * 2);
    const size_t hstepB = (size_t)HALF * K * 2, hstepA = (size_t)HALF * g.lda * 2;
    const size_t tstepA = 2 * hstepA, tstepB = 2 * hstepB;
    const unsigned ldsw = (unsigned)wid * 1024u;
    const int aoff = lds_byte(wr * 64 + fr, fq * 8), boff = lds_byte(wc * 32 + fr, fq * 8);
#define PG8_SA(b, h) (((b) * 2 + (h)) * HTB)
#define PG8_SB(b, h) ((4 + (b) * 2 + (h)) * HTB)
#define PG8_STAGE(bufoff, gbase, voff) do { _Pragma("unroll") for (int _i = 0; _i < 2; ++_i) \
        __builtin_amdgcn_global_load_lds((const PG8_GAS unsigned*)((const PG8_GAS char*)(gbase) + (voff)[_i]), (PG8_LAS unsigned*)(lds + (bufoff) + ldsw + _i * 8192), 16, 0, 0); } while (0)
#define PG8_LDA(dst, b, h) do { _Pragma("unroll") for (int m = 0; m < 4; ++m) dst[m] = __builtin_shufflevector(*(const PG8_LAS bf16x8*)(lds + PG8_SA(b, h) + aoff + m * 2048), *(const PG8_LAS bf16x8*)(lds + PG8_SA(b, h) + aoff + m * 2048 + 1024), 0, 1, 2, 3, 4, 5, 6, 7, 8, 9, 10, 11, 12, 13, 14, 15); } while (0)
#define PG8_LDB(dst, b, h) do { _Pragma("unroll") for (int n = 0; n < 2; ++n) dst[n] = __builtin_shufflevector(*(const PG8_LAS bf16x8*)(lds + PG8_SB(b, h) + boff + n * 2048), *(const PG8_LAS bf16x8*)(lds + PG8_SB(b, h) + boff + n * 2048 + 1024), 0, 1, 2, 3, 4, 5, 6, 7, 8, 9, 10, 11, 12, 13, 14, 15); } while (0)
#define PG8_HALF(x, k) ((k) == 0 ? __builtin_shufflevector(x, x, 0, 1, 2, 3, 4, 5, 6, 7) : __builtin_shufflevector(x, x, 8, 9, 10, 11, 12, 13, 14, 15))
#define PG8_MMA(ai, bj, At, Bt) do { __builtin_amdgcn_s_setprio(1); if constexpr (F8) { _Pragma("unroll") for (int m = 0; m < 4; ++m) _Pragma("unroll") for (int n = 0; n < 2; ++n) \
        asm volatile("v_mfma_f32_16x16x128_f8f6f4 %0, %1, %2, %0" : "+v"(acc[ai][bj][m][n]) : "v"(__builtin_bit_cast(i32x8_t, Bt[n])), "v"(__builtin_bit_cast(i32x8_t, At[m]))); } \
    else { _Pragma("unroll") for (int m = 0; m < 4; ++m) _Pragma("unroll") for (int n = 0; n < 2; ++n) _Pragma("unroll") for (int k = 0; k < 2; ++k) \
        acc[ai][bj][m][n] = __builtin_amdgcn_mfma_f32_16x16x32_bf16(PG8_HALF(Bt[n], k), PG8_HALF(At[m], k), acc[ai][bj][m][n], 0, 0, 0); } __builtin_amdgcn_s_setprio(0); } while (0)
#define PG8_F8_DRAIN() do { if constexpr (F8) asm volatile("s_nop 15\n\ts_nop 15" ::: "memory"); } while (0)
#define PG8_WAIT_V(n) asm volatile("s_waitcnt vmcnt(" #n ")" ::: "memory")
#define PG8_WAIT_L(n) asm volatile("s_waitcnt lgkmcnt(" #n ")" ::: "memory")
#define PG8_BAR __builtin_amdgcn_s_barrier()
#define PG8_SCHED __builtin_amdgcn_sched_barrier(0)
    Unit cur, nxt; int ui = 0;
    if (!S.next(0, cur)) return;
    f32x4 acc[2][2][4][2];
#pragma unroll
    for (int a = 0; a < 2; ++a)
#pragma unroll
        for (int b = 0; b < 2; ++b)
#pragma unroll
            for (int m = 0; m < 4; ++m)
#pragma unroll
                for (int n = 0; n < 2; ++n) acc[a][b][m][n] = (f32x4){0.f, 0.f, 0.f, 0.f};
    bf16x16 At[4], B0[2], B1[2];
    const PG8_GAS char* cA = (const PG8_GAS char*)g.A + (size_t)cur.pm * tstepA; const PG8_GAS char* cB = (const PG8_GAS char*)g.Bt + (size_t)cur.be * g.bstride + (size_t)cur.pn * tstepB;
    S.a_ready(cur);
    if constexpr (SP2) {
        PG8_STAGE(PG8_SB(0, 0), cB, voffB); PG8_STAGE(PG8_SB(0, 1), cB + hstepB, voffB); PG8_STAGE(PG8_SA(0, 0), cA, voffA); PG8_STAGE(PG8_SA(0, 1), cA + hstepA, voffA);
        if (wr == 1) PG8_BAR;
        PG8_WAIT_V(2); PG8_BAR;
        PG8_STAGE(PG8_SB(1, 0), cB + kstep, voffB); PG8_STAGE(PG8_SA(1, 0), cA + kstep, voffA); PG8_STAGE(PG8_SB(1, 1), cB + hstepB + kstep, voffB);
        PG8_WAIT_V(6); PG8_BAR;
    } else {
        PG8_STAGE(PG8_SB(0, 0), cB, voffB); PG8_STAGE(PG8_SA(0, 0), cA, voffA); PG8_STAGE(PG8_SB(0, 1), cB + hstepB, voffB); PG8_STAGE(PG8_SA(0, 1), cA + hstepA, voffA);
        if (wr == 1) PG8_BAR;
        PG8_WAIT_V(4); PG8_BAR;
        PG8_STAGE(PG8_SB(1, 0), cB + kstep, voffB); PG8_STAGE(PG8_SA(1, 0), cA + kstep, voffA); PG8_STAGE(PG8_SB(1, 1), cB + hstepB + kstep, voffB);
        PG8_WAIT_V(6); PG8_BAR;
    }
    for (;;) {
        const bool has_next = S.next(ui + 1, nxt);
        const PG8_GAS char* nA = has_next ? (const PG8_GAS char*)g.A + (size_t)nxt.pm * tstepA : cA; const PG8_GAS char* nB = has_next ? (const PG8_GAS char*)g.Bt + (size_t)nxt.be * g.bstride + (size_t)nxt.pn * tstepB : cB;
        for (int t = 0; t < nt; t += 2) {
            const bool last = (t == nt - 2);
            const PG8_GAS char* a1 = cA + (size_t)(t + 1) * kstep;
            const PG8_GAS char* a2 = last ? nA : cA + (size_t)(t + 2) * kstep; const PG8_GAS char* b2 = last ? nB : cB + (size_t)(t + 2) * kstep;
            const PG8_GAS char* a3 = a2 + kstep; const PG8_GAS char* b3 = b2 + kstep;
            if (last && has_next) S.a_ready(nxt);
            if constexpr (SP2) {
            PG8_LDB(B0, 0, 0); PG8_LDB(B1, 0, 1); PG8_SCHED; PG8_LDA(At, 0, 0); PG8_STAGE(PG8_SA(1, 1), a1 + hstepA, voffA);
            PG8_WAIT_V(8); PG8_WAIT_L(0); PG8_BAR; PG8_MMA(0, 0, At, B0); PG8_MMA(0, 1, At, B1); PG8_BAR; PG8_SCHED;
            PG8_LDA(At, 0, 1); PG8_STAGE(PG8_SB(0, 0), b2, voffB); PG8_STAGE(PG8_SB(0, 1), b2 + hstepB, voffB); PG8_STAGE(PG8_SA(0, 0), a2, voffA);
            PG8_WAIT_V(8); PG8_WAIT_L(0); PG8_BAR; PG8_MMA(1, 0, At, B0); PG8_MMA(1, 1, At, B1); PG8_BAR; PG8_SCHED;
            PG8_LDB(B0, 1, 0); PG8_LDB(B1, 1, 1); PG8_SCHED; PG8_LDA(At, 1, 0); PG8_STAGE(PG8_SA(0, 1), a2 + hstepA, voffA);
            PG8_WAIT_V(8); PG8_WAIT_L(0); PG8_BAR; PG8_MMA(0, 0, At, B0); PG8_MMA(0, 1, At, B1); PG8_BAR; PG8_SCHED;
            PG8_LDA(At, 1, 1); PG8_STAGE(PG8_SB(1, 0), b3, voffB); PG8_STAGE(PG8_SB(1, 1), b3 + hstepB, voffB); PG8_STAGE(PG8_SA(1, 0), a3, voffA);
            PG8_WAIT_V(8); PG8_WAIT_L(0); PG8_BAR; PG8_MMA(1, 0, At, B0); PG8_MMA(1, 1, At, B1); PG8_BAR; PG8_SCHED;
            } else {
            PG8_LDB(B0, 0, 0); PG8_SCHED; PG8_LDA(At, 0, 0); PG8_STAGE(PG8_SA(1, 1), a1 + hstepA, voffA);
            PG8_WAIT_L(8); PG8_BAR; PG8_WAIT_L(0); PG8_MMA(0, 0, At, B0); PG8_BAR; PG8_SCHED;
            PG8_LDB(B1, 0, 1); PG8_STAGE(PG8_SB(0, 0), b2, voffB);
            PG8_BAR; PG8_WAIT_L(0); PG8_MMA(0, 1, At, B1); PG8_BAR;
            PG8_LDA(At, 0, 1); PG8_STAGE(PG8_SA(0, 0), a2, voffA);
            PG8_BAR; PG8_WAIT_L(0); PG8_MMA(1, 0, At, B0); PG8_BAR; PG8_SCHED;
            PG8_STAGE(PG8_SB(0, 1), b2 + hstepB, voffB);
            PG8_WAIT_V(6); PG8_BAR; PG8_MMA(1, 1, At, B1); PG8_BAR;
            PG8_LDB(B0, 1, 0); PG8_SCHED; PG8_LDA(At, 1, 0); PG8_STAGE(PG8_SA(0, 1), a2 + hstepA, voffA);
            PG8_WAIT_L(8); PG8_BAR; PG8_WAIT_L(0); PG8_MMA(0, 0, At, B0); PG8_BAR; PG8_SCHED;
            PG8_LDB(B1, 1, 1); PG8_STAGE(PG8_SB(1, 0), b3, voffB);
            PG8_BAR; PG8_WAIT_L(0); PG8_MMA(0, 1, At, B1); PG8_BAR;
            PG8_LDA(At, 1, 1); PG8_STAGE(PG8_SA(1, 0), a3, voffA);
            PG8_BAR; PG8_WAIT_L(0); PG8_MMA(1, 0, At, B0); PG8_BAR; PG8_SCHED;
            PG8_STAGE(PG8_SB(1, 1), b3 + hstepB, voffB);
            PG8_WAIT_V(6); PG8_BAR; PG8_MMA(1, 1, At, B1); PG8_BAR;
            }
        }
        if constexpr (ALIGN_EPI) { if (wr == 0) PG8_BAR; }
        PG8_F8_DRAIN();
        if constexpr (!Epi::AFTER_DRAIN) { E(acc, cur, wr, wc, fr, fq); S.done(cur); }
        if (!has_next) break;
#pragma unroll
        for (int a = 0; a < 2; ++a)
#pragma unroll
            for (int b = 0; b < 2; ++b)
#pragma unroll
                for (int m = 0; m < 4; ++m)
#pragma unroll
                    for (int n = 0; n < 2; ++n) acc[a][b][m][n] = (f32x4){0.f, 0.f, 0.f, 0.f};
        cur = nxt; cA = nA; cB = nB; ++ui;
        if constexpr (ALIGN_EPI) { if (wr == 1) PG8_BAR; }
    }
    PG8_WAIT_V(0);
    if constexpr (!ALIGN_EPI) { if (wr == 0) PG8_BAR; }
    PG8_BAR;
    if constexpr (Epi::AFTER_DRAIN) { E.fused(acc, cur, wr, wc, fr, fq, lds, wid, lane); S.done(cur); }
#undef PG8_SA
#undef PG8_SB
#undef PG8_STAGE
#undef PG8_LDA
#undef PG8_LDB
#undef PG8_MMA
#undef PG8_HALF
#undef PG8_F8_DRAIN
#undef PG8_WAIT_V
#undef PG8_WAIT_L
#undef PG8_BAR
#undef PG8_SCHED
}
}


#ifndef MK_PER_PHASE
#define MK_PER_PHASE 0
#endif

constexpr int NWAVES = 8, NTHR = 512;
constexpr int D = 1024, NBATCH = 2, SEQ = 16384, TL = NBATCH * SEQ, CTXL = 256, TC = NBATCH * CTXL, MR = TL + TC;
constexpr int NPH = 2048, DFF = 2816, NEXP = 8, EFF = 3584, DEPTH = 2;
constexpr float ALPHA = 1.41421356237309515f;
constexpr float LN_EPS = 1e-5f, RMS_EPS = 1e-6f;
constexpr int PH_QA = 0, PH_KA = 128, PH_VA = 256, PH_GA = 512, PH_HY = 768, PH_CQ = 1536, PH_CKV = 1792, PH_KR = 1920, PH_ALR = 1952;

constexpr size_t MiB = 1u << 20;
constexpr size_t WS_CTL = 0, CTL_ZERO_BYTES = 1 * MiB;
constexpr int CW_TMO = 0, CW_BAR = 4096;
constexpr size_t CTL_MODV = 64 * 1024;
constexpr size_t WS_SMALL = 1 * MiB;
constexpr size_t WS_PTRTAB = WS_SMALL + 16 * 1024;
constexpr size_t WS_WIN = 2 * MiB, WS_WOUT = 10 * MiB, WS_W13 = 14 * MiB, WS_W2 = 25 * MiB, WS_WUQ = 31 * MiB, WS_WUKV = 32 * MiB;
constexpr size_t AB = 34 * MiB;
constexpr size_t WS_XN = AB, WS_Y = AB + 65 * MiB, WS_PH = AB + 130 * MiB, WS_Q = AB + 260 * MiB, WS_K = AB + 309 * MiB, WS_V = AB + 358 * MiB;
constexpr size_t WS_VT = AB + 391 * MiB, WS_X1T = AB + 423 * MiB, WS_X2T = AB + 439 * MiB, WS_HF = AB + 455 * MiB, WS_XC = AB + 519 * MiB, WS_END = AB + 521 * MiB;
constexpr size_t WS_G = WS_PH;
static_assert(WS_W13 + (size_t)2 * DFF * D * 2 <= WS_W2 && WS_W2 + (size_t)D * DFF * 2 <= WS_WUQ, "weights map");
static_assert(WS_G + (size_t)MR * DFF * 2 <= WS_K, "G overlay");
static_assert(WS_END <= 573 * MiB, "d_ws budget");

constexpr int LDS_BYTES = 147456, LDS_MISC = 131072 + 320;

#define GAS __attribute__((address_space(1)))
#define LAS __attribute__((address_space(3)))
typedef unsigned short bf16;
typedef unsigned v4u __attribute__((ext_vector_type(4)));
typedef unsigned v2u __attribute__((ext_vector_type(2)));
typedef float f32x4 __attribute__((ext_vector_type(4)));
typedef GAS unsigned gu32;
#define RLX_AGENT __ATOMIC_RELAXED, __HIP_MEMORY_SCOPE_AGENT
#define LDS_WAIT() asm volatile("s_waitcnt lgkmcnt(0)" ::: "memory")
#define VM_WAIT() asm volatile("s_waitcnt vmcnt(0)" ::: "memory")
__device__ __forceinline__ unsigned pk2(float lo, float hi) { return pg8::cvt_pk_bf16(lo, hi); }
__device__ __forceinline__ float bf2f(unsigned short h) { return __uint_as_float((unsigned)h << 16); }
__device__ __forceinline__ float siluf(float x) { return x / (1.f + __expf(-x)); }
#define XB_TMO      128
#define XB_XCNT(j)  (256  + 64 * (j))
#define XB_XSUB(j)  (1280 + 64 * (j))
#define XB_XGEN(j)  (2304 + 64 * (j))
#define XB_TOP      3328
#define XB_TOPGEN   3392
#define XCD_BAR_WORDS 3456
#define XB_SPIN_CAP (1u << 18)

__device__ __forceinline__ unsigned xb_ld(unsigned* p)              { return __hip_atomic_load(p, __ATOMIC_RELAXED, __HIP_MEMORY_SCOPE_AGENT); }
__device__ __forceinline__ unsigned xb_add(unsigned* p, unsigned v) { return __hip_atomic_fetch_add(p, v, __ATOMIC_RELAXED, __HIP_MEMORY_SCOPE_AGENT); }
__device__ __forceinline__ unsigned xb_xcc_id() { return (unsigned)__builtin_amdgcn_s_getreg((3 << 11) | 20) & 0xFu; }
#define XB_SPIN(cond, bar) do { unsigned _sp = 0; while (cond) { __builtin_amdgcn_s_sleep(1); \
    if ((++_sp & 255u) == 0u) { if (xb_ld(&(bar)[XB_TMO])) break; if (_sp > XB_SPIN_CAP) { atomicAdd(&(bar)[XB_TMO], 1u); break; } } } } while (0)

struct XcdBarrier {
    unsigned* bar; unsigned x;
    volatile LAS unsigned* st;
};

__device__ __forceinline__ XcdBarrier xcd_barrier_post(unsigned* bar, volatile LAS unsigned* st) {
    XcdBarrier b; b.bar = bar; b.x = xb_xcc_id(); b.st = st;
    if (threadIdx.x == 0) (void)xb_add(&bar[XB_XCNT(b.x)], 1u);
    return b;
}
__device__ __forceinline__ void xcd_barrier_complete(unsigned* bar, unsigned x, unsigned& nloc, unsigned& nx) {
    const unsigned G = gridDim.x * gridDim.y * gridDim.z;
    unsigned sum, cnt, mine, sp = 0u;
    for (;;) {
        sum = 0u; cnt = 0u; mine = 0u;
#pragma unroll
        for (unsigned j = 0; j < 16; ++j) { const unsigned c = xb_ld(&bar[XB_XCNT(j)]); sum += c; cnt += (c > 0u) ? 1u : 0u; mine = (j == x) ? c : mine; }
        if (sum == G) break;
        __builtin_amdgcn_s_sleep(1);
        if ((++sp & 255u) == 0u) { if (xb_ld(&bar[XB_TMO])) break; if (sp > XB_SPIN_CAP) { atomicAdd(&bar[XB_TMO], 1u); break; } }
    }
    nloc = mine > 0u ? mine : 1u; nx = cnt > 0u ? cnt : 1u;
}

__device__ __forceinline__ void xcd_barrier(const XcdBarrier& b) {
    asm volatile("s_waitcnt vmcnt(0)" ::: "memory");
    __syncthreads();
    if (threadIdx.x == 0) {
        unsigned* bar = b.bar;
        __builtin_amdgcn_s_waitcnt(0);
        unsigned nloc = b.st[0], nx = b.st[1];
        if (nloc == 0u) { xcd_barrier_complete(bar, b.x, nloc, nx); b.st[0] = nloc; b.st[1] = nx; }
        const unsigned old = xb_add(&bar[XB_XSUB(b.x)], 1u);
        const unsigned gen = old / nloc;
        if (old + 1u == (gen + 1u) * nloc) {
            __builtin_amdgcn_fence(__ATOMIC_RELEASE, "agent");
            asm volatile("s_waitcnt vmcnt(0)" ::: "memory");
            const unsigned og = xb_add(&bar[XB_TOP], 1u);
            const unsigned tg = og / nx;
            if (og + 1u == (tg + 1u) * nx) xb_add(&bar[XB_TOPGEN], 1u);
            else XB_SPIN(xb_ld(&bar[XB_TOPGEN]) == tg, bar);
            __builtin_amdgcn_fence(__ATOMIC_ACQUIRE, "agent");
            xb_add(&bar[XB_XGEN(b.x)], 1u);
            asm volatile("s_waitcnt vmcnt(0)" ::: "memory");
        } else {
            XB_SPIN(xb_ld(&bar[XB_XGEN(b.x)]) == gen, bar);
            __builtin_amdgcn_fence(__ATOMIC_ACQUIRE, "agent");
            asm volatile("s_waitcnt vmcnt(0)" ::: "memory");
        }
    }
    __syncthreads();
}

struct Args { const GAS float* in[37]; GAS float* out; GAS unsigned char* ws; int ph_lo, ph_hi; };
enum In { I_X = 0, I_C, I_CTX, I_CCTX, I_WMOD, I_BMOD, I_WIN, I_GWG, I_GBG, I_GNG, I_HCW, I_HCB, I_HW1, I_HB1, I_HF1, I_HW2, I_HB2, I_HF2, I_HW3, I_HB3, I_HSKIP, I_HNG,
          I_QNG, I_WUQ, I_KVNG, I_WUKV, I_MNG, I_WOUT, I_LNG, I_LNB, I_FW1, I_FW3, I_FW2, I_ROUTER, I_MW1, I_MW3, I_MW2 };

struct Frame {
    LAS unsigned char* lds; GAS unsigned char* ws; gu32* ctl; const GAS float* const GAS* in; GAS float* out;
    int tid, lane, wave, G, gw, ngw;
};
__device__ __forceinline__ Frame launder(const Frame& F0) { Frame F = F0; int t = F0.tid; size_t z = 0; asm volatile("" : "+v"(t), "+s"(z)); F.tid = t; F.lane = t & 63; F.ws = F0.ws + z; F.ctl = (gu32*)(F.ws + WS_CTL); F.out = F0.out + z; return F; }
__device__ __forceinline__ float wave_sum(float v) {
#pragma unroll
    for (int o = 1; o < 64; o <<= 1) v += __shfl_xor(v, o);
    return v;
}
__device__ __forceinline__ const GAS float* modv(const Frame& F, int l, int v, int i) { return (const GAS float*)(F.ws + CTL_MODV) + ((size_t)(l * 3 + v) * 6 + i) * D; }
__device__ __forceinline__ int row_v(int row) { return row < TL ? (row >> 14) : 2; }

__device__ __forceinline__ void p0_modv(const Frame& F0) { const Frame F = launder(F0);
    const GAS float* c = F.in[I_C]; const GAS float* cc = F.in[I_CCTX]; const GAS float* wm = F.in[I_WMOD]; const GAS float* bm = F.in[I_BMOD];
    GAS float* mv = (GAS float*)(F.ws + CTL_MODV);
    constexpr int NBLK = 6 * D / 64, NKC = D / 64, NITEM = DEPTH * NBLK * NKC;
    for (int it = F.gw; it < NITEM; it += F.ngw) {
        const int l = it / (NBLK * NKC), r = it % (NBLK * NKC), nb = r / NKC, kc = r % NKC;
        const int k = kc * 64 + F.lane, n = nb * 64 + F.lane;
        const float s0 = siluf(c[k]), s1 = siluf(c[D + k]), s2 = siluf(cc[k]);
        float a0 = 0.f, a1 = 0.f, a2 = 0.f;
        const GAS float* w = wm + ((size_t)l * D + kc * 64) * (6 * D) + n;
#pragma unroll 8
        for (int kk = 0; kk < 64; ++kk) { const float wv = w[(size_t)kk * (6 * D)]; a0 += __shfl(s0, kk) * wv; a1 += __shfl(s1, kk) * wv; a2 += __shfl(s2, kk) * wv; }
        if (kc == 0) { const float b = bm[l * 6 * D + n]; a0 += b; a1 += b; a2 += b; }
        GAS float* o = mv + (size_t)(l * 3) * 6 * D + n;
        (void)__hip_atomic_fetch_add(o, a0, RLX_AGENT); (void)__hip_atomic_fetch_add(o + 6 * D, a1, RLX_AGENT); (void)__hip_atomic_fetch_add(o + 12 * D, a2, RLX_AGENT);
    }
}
template <class RowMap>
__device__ __forceinline__ void transpose_item(const GAS float* W, int N, GAS bf16* WT, int ldk, LAS float* scr, int item, int lane, const RowMap& rm, const GAS float* ks) {
    const int nblk = N / 32, kb = item / nblk, nb = item % nblk, k0 = 64 * kb, n0 = 32 * nb;
#pragma unroll 8
    for (int i = 0; i < 32; ++i) { const int kk = 2 * i + (lane >> 5); float v = W[(size_t)(k0 + kk) * N + n0 + (lane & 31)]; if (ks) v *= ks[k0 + kk]; scr[kk * 33 + (lane & 31)] = v; }
    LDS_WAIT(); asm volatile("" ::: "memory");
    const int c = lane & 7;
#pragma unroll
    for (int j = 0; j < 4; ++j) { const int n = (lane >> 3) + 8 * j; const LAS float* s = scr + (8 * c) * 33 + n;
        v4u o; o.x = pk2(s[0 * 33], s[1 * 33]); o.y = pk2(s[2 * 33], s[3 * 33]); o.z = pk2(s[4 * 33], s[5 * 33]); o.w = pk2(s[6 * 33], s[7 * 33]);
        *(GAS v4u*)(WT + (size_t)rm(n0 + n) * ldk + k0 + 8 * c) = o; }
    LDS_WAIT(); asm volatile("" ::: "memory");
}
__device__ __forceinline__ float clamp448(float x) { return fminf(fmaxf(x, -448.f), 448.f); }
__device__ __forceinline__ unsigned pk4_fp8(float a, float b, float c, float d) { unsigned w = 0; w = __builtin_amdgcn_cvt_pk_fp8_f32(clamp448(a), clamp448(b), w, false); w = __builtin_amdgcn_cvt_pk_fp8_f32(clamp448(c), clamp448(d), w, true); return w; }
template <class RowMap>
__device__ __forceinline__ void transpose_item_f8(const GAS float* W, int N, GAS unsigned char* WT, int ldk, LAS float* scr, int item, int lane, const RowMap& rm, float scale) {
    const int nblk = N / 32, kb = item / nblk, nb = item % nblk, k0 = 64 * kb, n0 = 32 * nb;
#pragma unroll 8
    for (int i = 0; i < 32; ++i) { const int kk = 2 * i + (lane >> 5); scr[kk * 33 + (lane & 31)] = W[(size_t)(k0 + kk) * N + n0 + (lane & 31)] * scale; }
    LDS_WAIT(); asm volatile("" ::: "memory");
    const int c = lane & 7;
#pragma unroll
    for (int j = 0; j < 4; ++j) { const int n = (lane >> 3) + 8 * j; const LAS float* s = scr + (8 * c) * 33 + n;
        v2u o; o.x = pk4_fp8(s[0 * 33], s[1 * 33], s[2 * 33], s[3 * 33]); o.y = pk4_fp8(s[4 * 33], s[5 * 33], s[6 * 33], s[7 * 33]);
        *(GAS v2u*)(WT + (size_t)rm(n0 + n) * ldk + k0 + 8 * c) = o; }
    LDS_WAIT(); asm volatile("" ::: "memory");
}
struct RmIdent { int off; __device__ int operator()(int n) const { return n + off; } };
struct RmWin { __device__ int operator()(int c) const {
    if (c < 768) return c; if (c < 800) return PH_ALR + (c - 768); if (c < 1568) return PH_HY + (c - 800); if (c < 1824) return PH_CQ + (c - 1568); if (c < 1952) return PH_CKV + (c - 1824); return PH_KR + (c - 1952); } };
struct RmGlu { int half; __device__ int operator()(int j) const { return (j >> 2) * 8 + half * 4 + (j & 3); } };

__device__ __forceinline__ void p0_weights(const Frame& F0) { const Frame F = launder(F0);
    LAS float* scr = (LAS float*)(F.lds + F.wave * 16384);
    GAS bf16* WIN = (GAS bf16*)(F.ws + WS_WIN); GAS bf16* WOUT = (GAS bf16*)(F.ws + WS_WOUT); GAS bf16* W13 = (GAS bf16*)(F.ws + WS_W13); GAS bf16* W2 = (GAS bf16*)(F.ws + WS_W2);
    GAS bf16* WUQ = (GAS bf16*)(F.ws + WS_WUQ); GAS bf16* WUKV = (GAS bf16*)(F.ws + WS_WUKV);
    constexpr int I_IN = (D / 64) * (1984 / 32), I_OUT = (D / 64) * (D / 32), I_F1 = (D / 64) * (DFF / 32), I_F2 = (DFF / 64) * (D / 32), I_UQ = (256 / 64) * (768 / 32), I_UKV = (128 / 64) * (1024 / 32);
    constexpr int NITEM = DEPTH * I_IN + DEPTH * I_OUT + 2 * I_F1 + I_F2 + DEPTH * I_UQ + DEPTH * I_UKV;
    for (int it = F.gw; it < NITEM; it += F.ngw) {
        int r = it;
        if (r < DEPTH * I_IN) { const int l = r / I_IN; transpose_item(F.in[I_WIN] + (size_t)l * D * 1984, 1984, WIN + (size_t)l * NPH * D, D, scr, r % I_IN, F.lane, RmWin{}, nullptr); continue; } r -= DEPTH * I_IN;
        if (r < DEPTH * I_OUT) { const int l = r / I_OUT; transpose_item(F.in[I_WOUT] + (size_t)l * D * D, D, WOUT + (size_t)l * D * D, D, scr, r % I_OUT, F.lane, RmIdent{0}, nullptr); continue; } r -= DEPTH * I_OUT;
        if (r < I_F1) { transpose_item(F.in[I_FW1], DFF, W13, D, scr, r, F.lane, RmGlu{0}, nullptr); continue; } r -= I_F1;
        if (r < I_F1) { transpose_item(F.in[I_FW3], DFF, W13, D, scr, r, F.lane, RmGlu{1}, nullptr); continue; } r -= I_F1;
        if (r < I_F2) { transpose_item(F.in[I_FW2], D, W2, DFF, scr, r, F.lane, RmIdent{0}, nullptr); continue; } r -= I_F2;
        if (r < DEPTH * I_UQ) { const int l = r / I_UQ; transpose_item(F.in[I_WUQ] + (size_t)l * 256 * 768, 768, WUQ + (size_t)l * 768 * 256, 256, scr, r % I_UQ, F.lane, RmIdent{0}, F.in[I_QNG] + l * 256); continue; } r -= DEPTH * I_UQ;
        { const int l = r / I_UKV; transpose_item(F.in[I_WUKV] + (size_t)l * 128 * 1024, 1024, WUKV + (size_t)l * 1024 * 256, 256, scr, r % I_UKV, F.lane, RmIdent{0}, F.in[I_KVNG] + l * 128); }
    }
    const int gt = blockIdx.x * NTHR + F.tid, ngt = F.G * NTHR;
    for (int i = gt; i < DEPTH * 64 * D / 8; i += ngt) { const int l = i / (64 * D / 8), r = i % (64 * D / 8); *(GAS v4u*)(WIN + ((size_t)l * NPH + 1984) * D + (size_t)r * 8) = (v4u){0u, 0u, 0u, 0u}; }
    for (int i = gt; i < DEPTH * 1024 * 128 / 8; i += ngt) { const int row = i / 16, c = i % 16; *(GAS v4u*)(WUKV + (size_t)row * 256 + 128 + c * 8) = (v4u){0u, 0u, 0u, 0u}; }
}

__device__ __forceinline__ void mod_store_bf16(const f32x4 (&v)[4], const GAS float* sh, const GAS float* sc, GAS bf16* orow, int lane) {
    GAS unsigned long long* o8 = (GAS unsigned long long*)orow + lane;
#pragma unroll
    for (int j = 0; j < 4; ++j) { const f32x4 a = ((const GAS f32x4*)sc)[lane + 64 * j], b = ((const GAS f32x4*)sh)[lane + 64 * j];
        const f32x4 y = v[j] * (a + 1.f) + b;
        o8[64 * j] = (unsigned long long)pk2(y.x, y.y) | ((unsigned long long)pk2(y.z, y.w) << 32); }
}
__device__ __forceinline__ void p_xn0(const Frame& F0) { const Frame F = launder(F0);
    GAS bf16* XN = (GAS bf16*)(F.ws + WS_XN);
    f32x4 nx[4];
#define XN0_LOAD(mm) do { const GAS float* src_ = (mm) < TL ? F.in[I_X] + (size_t)(mm) * D : F.in[I_CTX] + (size_t)((mm) - TL) * D; _Pragma("unroll") for (int j = 0; j < 4; ++j) nx[j] = ((const GAS f32x4*)src_)[F.lane + 64 * j]; } while (0)
    int m = F.gw; if (m < MR) XN0_LOAD(m);
    for (; m < MR; m += F.ngw) {
        f32x4 v[4];
#pragma unroll
        for (int j = 0; j < 4; ++j) v[j] = nx[j];
        if (m + F.ngw < MR) XN0_LOAD(m + F.ngw);
        const int vv = row_v(m);
        mod_store_bf16(v, modv(F, 0, vv, 0), modv(F, 0, vv, 1), XN + (size_t)m * D, F.lane);
    }
#undef XN0_LOAD
}
__device__ __forceinline__ GAS float* xres(const Frame& F, int row) { return row < TL ? F.out + (size_t)row * D : (GAS float*)(F.ws + WS_XC) + (size_t)(row - TL) * D; }
__device__ __forceinline__ void p_ln(const Frame& F0, int nrows, const GAS float* g, const GAS float* b, bool want_xn, int ml, int si) { const Frame F = launder(F0);
    GAS bf16* XN = (GAS bf16*)(F.ws + WS_XN);
    f32x4 nx[4];
    int m = F.gw; if (m < nrows) { const GAS float* r_ = xres(F, m);
#pragma unroll
        for (int j = 0; j < 4; ++j) nx[j] = ((const GAS f32x4*)r_)[F.lane + 64 * j]; }
    for (; m < nrows; m += F.ngw) {
        GAS float* row = xres(F, m);
        f32x4 v[4]; float s = 0.f;
#pragma unroll
        for (int j = 0; j < 4; ++j) { v[j] = nx[j]; s += (v[j].x + v[j].y) + (v[j].z + v[j].w); }
        if (m + F.ngw < nrows) { const GAS float* r_ = xres(F, m + F.ngw);
#pragma unroll
            for (int j = 0; j < 4; ++j) nx[j] = ((const GAS f32x4*)r_)[F.lane + 64 * j]; }
        const float mean = wave_sum(s) * (1.f / D); float s2 = 0.f;
#pragma unroll
        for (int j = 0; j < 4; ++j) { v[j] = v[j] - mean; s2 += (v[j].x * v[j].x + v[j].y * v[j].y) + (v[j].z * v[j].z + v[j].w * v[j].w); }
        const float rstd = 1.f / sqrtf(wave_sum(s2) * (1.f / D) + LN_EPS);
#pragma unroll
        for (int j = 0; j < 4; ++j) { const f32x4 gg = ((const GAS f32x4*)g)[F.lane + 64 * j], bb = ((const GAS f32x4*)b)[F.lane + 64 * j]; v[j] = v[j] * rstd * gg + bb; ((GAS f32x4*)row)[F.lane + 64 * j] = v[j]; }
        if (want_xn) { const int vv = row_v(m); mod_store_bf16(v, modv(F, ml, vv, si), modv(F, ml, vv, si + 1), XN + (size_t)m * D, F.lane); }
    }
}

using pg8::f32x4; using pg8::Unit;
struct EpiStoreBf16 {
    static constexpr bool PERM = true, AFTER_DRAIN = false;
    GAS bf16* O; int ldc; float sc;
    __device__ __forceinline__ void operator()(const pg8::f32x4 (&acc)[2][2][4][2], const Unit& u, int wr, int wc, int fr, int fq) const {
        const int row0 = u.pm * 256 + wr * 64 + fr, col0 = u.pn * 256 + wc * 32 + 8 * fq;
#pragma unroll
        for (int ai = 0; ai < 2; ++ai)
#pragma unroll
            for (int m = 0; m < 4; ++m) { GAS bf16* rowp = O + (size_t)(row0 + ai * 128 + m * 16) * ldc + col0;
#pragma unroll
                for (int bj = 0; bj < 2; ++bj) { const pg8::f32x4 v0 = acc[ai][bj][m][0] * sc, v1 = acc[ai][bj][m][1] * sc;
                    v4u w; w.x = pk2(v0[0], v0[1]); w.y = pk2(v0[2], v0[3]); w.z = pk2(v1[0], v1[1]); w.w = pk2(v1[2], v1[3]);
                    *(GAS v4u*)(rowp + bj * 128) = w; } }
    }
};
struct EpiSwiglu {
    static constexpr bool PERM = true, AFTER_DRAIN = false;
    GAS bf16* G; int ldg; float sc;
    __device__ __forceinline__ void operator()(const pg8::f32x4 (&acc)[2][2][4][2], const Unit& u, int wr, int wc, int fr, int fq) const {
        const int row0 = u.pm * 256 + wr * 64 + fr, col0 = (u.pn * 256 + wc * 32 + 8 * fq) >> 1;
#pragma unroll
        for (int ai = 0; ai < 2; ++ai)
#pragma unroll
            for (int m = 0; m < 4; ++m) { GAS bf16* rowp = G + (size_t)(row0 + ai * 128 + m * 16) * ldg + col0;
#pragma unroll
                for (int bj = 0; bj < 2; ++bj) { const pg8::f32x4 a = acc[ai][bj][m][0] * sc, b = acc[ai][bj][m][1] * sc;
                    v2u w; w.x = pk2(siluf(a[0]) * b[0], siluf(a[1]) * b[1]); w.y = pk2(siluf(a[2]) * b[2], siluf(a[3]) * b[3]);
                    *(GAS v2u*)(rowp + bj * 64) = w; } }
    }
};
struct EpiSwiglu8 {
    static constexpr bool PERM = true, AFTER_DRAIN = false;
    GAS unsigned char* G; int ldg; float sc, osc;
    __device__ __forceinline__ void operator()(const pg8::f32x4 (&acc)[2][2][4][2], const Unit& u, int wr, int wc, int fr, int fq) const {
        const int row0 = u.pm * 256 + wr * 64 + fr, col0 = (u.pn * 256 + wc * 32 + 8 * fq) >> 1;
#pragma unroll
        for (int ai = 0; ai < 2; ++ai)
#pragma unroll
            for (int m = 0; m < 4; ++m) { GAS unsigned char* rowp = G + (size_t)(row0 + ai * 128 + m * 16) * ldg + col0;
#pragma unroll
                for (int bj = 0; bj < 2; ++bj) { const pg8::f32x4 a = acc[ai][bj][m][0] * sc, b = acc[ai][bj][m][1] * sc;
                    *(GAS unsigned*)(rowp + bj * 64) = pk4_fp8(siluf(a[0]) * b[0] * osc, siluf(a[1]) * b[1] * osc, siluf(a[2]) * b[2] * osc, siluf(a[3]) * b[3] * osc); } }
    }
};
struct EpiRes {
    static constexpr bool PERM = false, AFTER_DRAIN = false;
    const GAS float* xin_lat; const GAS float* xin_ctx; GAS float* out_lat; GAS float* out_ctx; const GAS float* gate0;
    __device__ __forceinline__ void operator()(const pg8::f32x4 (&acc)[2][2][4][2], const Unit& u, int wr, int wc, int fr, int fq) const {
        const bool lat = u.pm < TL / 256; const int v = lat ? (u.pm >> 6) : 2;
        const GAS float* xin = lat ? xin_lat : xin_ctx - (size_t)TL * D; GAS float* out = lat ? out_lat : out_ctx - (size_t)TL * D;
        const GAS float* gate = gate0 + (size_t)v * 6 * D;
        const int row0 = u.pm * 256 + wr * 64 + fr, col0 = u.pn * 256 + wc * 32 + 4 * fq;
        pg8::f32x4 gv[2][2];
#pragma unroll
        for (int bj = 0; bj < 2; ++bj)
#pragma unroll
            for (int n = 0; n < 2; ++n) gv[bj][n] = *(const GAS pg8::f32x4*)(gate + col0 + bj * 128 + n * 16);
#pragma unroll
        for (int ai = 0; ai < 2; ++ai)
#pragma unroll
            for (int m = 0; m < 4; ++m) { const size_t off = (size_t)(row0 + ai * 128 + m * 16) * D + col0;
#pragma unroll
                for (int bj = 0; bj < 2; ++bj)
#pragma unroll
                    for (int n = 0; n < 2; ++n) { const pg8::f32x4 xv = *(const GAS pg8::f32x4*)(xin + off + bj * 128 + n * 16);
                        *(GAS pg8::f32x4*)(out + off + bj * 128 + n * 16) = xv * ALPHA + gv[bj][n] * acc[ai][bj][m][n]; } }
    }
};


constexpr int CW_MOECNT = 2048;
constexpr size_t WS_TI = WS_SMALL + 64 * 1024;
constexpr int MOE_CHUNK_TILES = 64, MOE_NCHUNK = 5, MOE_MAXROWS = MOE_NCHUNK * MOE_CHUNK_TILES * 256;
constexpr size_t WS_HS = AB + 65 * MiB, WS_WM13 = AB + 197 * MiB, WS_WM2 = AB + 309 * MiB, WS_GC = AB + 365 * MiB;
constexpr size_t WS_H8 = WS_XN, WS_HS8 = WS_HS + 66 * MiB;
constexpr float MOE_WSCALE = 64.f, MOE_GSCALE = 16.f, MOE_W2SCALE = 256.f;
static_assert(WS_HS + (size_t)(2 * TL + NEXP * 256) * D * 2 <= WS_WM13 && WS_WM13 + (size_t)NEXP * 2 * EFF * D * 2 <= WS_WM2 && WS_WM2 + (size_t)NEXP * D * EFF * 2 <= WS_GC && WS_GC + (size_t)MOE_CHUNK_TILES * 256 * EFF * 2 <= WS_XC, "MoE map");

__device__ __forceinline__ void p_ln_route(const Frame& F0, const GAS float* g, const GAS float* b, int l) { const Frame F = launder(F0);
    GAS bf16* XN = (GAS bf16*)(F.ws + WS_XN);
    GAS int* TI_E = (GAS int*)(F.ws + WS_TI); GAS int* TI_P0 = TI_E + TL; GAS int* TI_P1 = TI_P0 + TL; GAS float* TI_W0 = (GAS float*)(TI_P1 + TL); GAS float* TI_W1 = TI_W0 + TL;
    const GAS float* wr = F.in[I_ROUTER];
    f32x4 nx[4];
    int m = F.gw; if (m < TL) {
#pragma unroll
        for (int j = 0; j < 4; ++j) nx[j] = ((const GAS f32x4*)(F.out + (size_t)m * D))[F.lane + 64 * j]; }
    for (; m < TL; m += F.ngw) {
        GAS float* row = F.out + (size_t)m * D;
        f32x4 v[4]; float s = 0.f;
#pragma unroll
        for (int j = 0; j < 4; ++j) { v[j] = nx[j]; s += (v[j].x + v[j].y) + (v[j].z + v[j].w); }
        if (m + F.ngw < TL) {
#pragma unroll
            for (int j = 0; j < 4; ++j) nx[j] = ((const GAS f32x4*)(F.out + (size_t)(m + F.ngw) * D))[F.lane + 64 * j]; }
        const float mean = wave_sum(s) * (1.f / D); float s2 = 0.f;
#pragma unroll
        for (int j = 0; j < 4; ++j) { v[j] = v[j] - mean; s2 += (v[j].x * v[j].x + v[j].y * v[j].y) + (v[j].z * v[j].z + v[j].w * v[j].w); }
        const float rstd = 1.f / sqrtf(wave_sum(s2) * (1.f / D) + LN_EPS);
        const int vv = row_v(m); const GAS float* sh = modv(F, l, vv, 3); const GAS float* sc = modv(F, l, vv, 4);
        GAS unsigned* h8 = (GAS unsigned*)(F.ws + WS_H8 + (size_t)m * D) + F.lane;
        float lg[NEXP];
#pragma unroll
        for (int e = 0; e < NEXP; ++e) lg[e] = 0.f;
#pragma unroll
        for (int j = 0; j < 4; ++j) { const f32x4 gg = ((const GAS f32x4*)g)[F.lane + 64 * j], bb = ((const GAS f32x4*)b)[F.lane + 64 * j]; v[j] = v[j] * rstd * gg + bb; ((GAS f32x4*)row)[F.lane + 64 * j] = v[j];
            const f32x4 a = ((const GAS f32x4*)sc)[F.lane + 64 * j], c = ((const GAS f32x4*)sh)[F.lane + 64 * j];
            const f32x4 y = v[j] * (a + 1.f) + c;
            h8[64 * j] = pk4_fp8(y.x, y.y, y.z, y.w);
            const GAS f32x4* w4 = (const GAS f32x4*)(wr + (size_t)(4 * F.lane + 256 * j) * NEXP);
#pragma unroll
            for (int i = 0; i < 4; ++i) { const f32x4 wa = w4[2 * i], wb = w4[2 * i + 1]; const float yi = y[i];
                lg[0] += yi * wa.x; lg[1] += yi * wa.y; lg[2] += yi * wa.z; lg[3] += yi * wa.w; lg[4] += yi * wb.x; lg[5] += yi * wb.y; lg[6] += yi * wb.z; lg[7] += yi * wb.w; } }
#pragma unroll
        for (int e = 0; e < NEXP; ++e) lg[e] = wave_sum(lg[e]);
        int i0 = 0; float v0 = lg[0];
#pragma unroll
        for (int e = 1; e < NEXP; ++e) if (lg[e] > v0) { v0 = lg[e]; i0 = e; }
        int i1 = -1; float v1 = -3.0e38f;
#pragma unroll
        for (int e = 0; e < NEXP; ++e) if (e != i0 && lg[e] > v1) { v1 = lg[e]; i1 = e; }
        if (F.lane == 0) {
            const float w0 = 1.f / (1.f + __expf(v1 - v0));
            const int p0 = (int)__hip_atomic_fetch_add((GAS unsigned*)F.ctl + CW_MOECNT + 64 * i0, 1u, RLX_AGENT);
            const int p1 = (int)__hip_atomic_fetch_add((GAS unsigned*)F.ctl + CW_MOECNT + 64 * i1, 1u, RLX_AGENT);
            TI_E[m] = i0 | (i1 << 8); TI_P0[m] = p0; TI_P1[m] = p1; TI_W0[m] = w0; TI_W1[m] = 1.f - w0;
        }
    }
}
struct MoeBase { int bt[NEXP + 1]; };
__device__ __forceinline__ MoeBase moe_base(const Frame& F) {
    MoeBase B; int acc = 0;
#pragma unroll
    for (int e = 0; e < NEXP; ++e) { B.bt[e] = acc; const unsigned c = __hip_atomic_load((GAS unsigned*)F.ctl + CW_MOECNT + 64 * e, RLX_AGENT); acc += (int)((c + 255u) >> 8); }
    B.bt[NEXP] = acc; return B;
}
__device__ __forceinline__ void p_moe_weights(const Frame& F0) { const Frame F = launder(F0);
    LAS float* scr = (LAS float*)(F.lds + F.wave * 16384);
    GAS unsigned char* WM13 = F.ws + WS_WM13; GAS unsigned char* WM2 = F.ws + WS_WM2;
    constexpr int I1 = (D / 64) * (EFF / 32), I2 = (EFF / 64) * (D / 32), NITEM = NEXP * (2 * I1 + I2);
    for (int it = F.gw; it < NITEM; it += F.ngw) {
        const int e = it / (2 * I1 + I2); int r = it % (2 * I1 + I2);
        if (r < I1) { transpose_item_f8(F.in[I_MW1] + (size_t)e * D * EFF, EFF, WM13 + (size_t)e * 2 * EFF * D, D, scr, r, F.lane, RmGlu{0}, MOE_WSCALE); continue; } r -= I1;
        if (r < I1) { transpose_item_f8(F.in[I_MW3] + (size_t)e * D * EFF, EFF, WM13 + (size_t)e * 2 * EFF * D, D, scr, r, F.lane, RmGlu{1}, MOE_WSCALE); continue; } r -= I1;
        transpose_item_f8(F.in[I_MW2] + (size_t)e * EFF * D, D, WM2 + (size_t)e * D * EFF, EFF, scr, r, F.lane, RmIdent{0}, MOE_W2SCALE);
    }
}
__device__ __forceinline__ void p_moe_scatter(const Frame& F0) { const Frame F = launder(F0);
    const MoeBase B = moe_base(F);
    const GAS unsigned char* H8 = F.ws + WS_H8; GAS unsigned char* HS8 = F.ws + WS_HS8;
    GAS int* TI_E = (GAS int*)(F.ws + WS_TI); GAS int* TI_P0 = TI_E + TL; GAS int* TI_P1 = TI_P0 + TL;
    for (int m = F.gw; m < TL; m += F.ngw) {
        const int ee = TI_E[m], e0 = ee & 255, e1 = ee >> 8;
        int b0 = 0, b1 = 0;
#pragma unroll
        for (int e = 0; e < NEXP; ++e) { if (e == e0) b0 = B.bt[e]; if (e == e1) b1 = B.bt[e]; }
        const int s0 = b0 * 256 + TI_P0[m], s1 = b1 * 256 + TI_P1[m];
        const v4u a = *((const GAS v4u*)(H8 + (size_t)m * D) + F.lane);
        *((GAS v4u*)(HS8 + (size_t)s0 * D) + F.lane) = a; *((GAS v4u*)(HS8 + (size_t)s1 * D) + F.lane) = a;
        if (F.lane == 0) { TI_P0[m] = s0; TI_P1[m] = s1; }
    }
}
constexpr int LDS_MOEBT = LDS_MISC + 64;
__device__ __forceinline__ void moe_base_to_lds(const Frame& F) {
    if (F.tid == 0) { volatile LAS int* bt = (volatile LAS int*)(F.lds + LDS_MOEBT); int acc = 0;
        for (int e = 0; e < NEXP; ++e) { bt[e] = acc; const unsigned c = __hip_atomic_load((GAS unsigned*)F.ctl + CW_MOECNT + 64 * e, RLX_AGENT); acc += (int)((c + 255u) >> 8); }
        bt[NEXP] = acc; }
    __syncthreads();
}
struct MoeOrder {
    int nM, nN, nwg, G, c, tile0; const LAS int* bt;
    __device__ void init(const LAS int* bt_, int chunk, int nN_, int G_, int c_) {
        bt = bt_; tile0 = chunk * MOE_CHUNK_TILES; int v = bt[NEXP] - tile0; nM = v < 0 ? 0 : (v > MOE_CHUNK_TILES ? MOE_CHUNK_TILES : v); nN = nN_; nwg = nM * nN; G = G_; c = c_; }
    __device__ bool next(int i, pg8::Unit& u) const {
        const long L = (long)i * G + c; if (L >= nwg) return false;
        int wgid = (int)L; { const int q = nwg / pg8::NXCD, r = nwg % pg8::NXCD, xcd = wgid % pg8::NXCD, off = wgid / pg8::NXCD; wgid = (xcd < r ? xcd * (q + 1) : r * (q + 1) + (xcd - r) * q) + off; }
        const int nig = pg8::WGM * nN, gid = wgid / nig, fm = gid * pg8::WGM, gsz = (nM - fm) < pg8::WGM ? (nM - fm) : pg8::WGM;
        u.pm = fm + ((wgid % nig) % gsz); u.pn = (wgid % nig) / gsz;
        const int gt = tile0 + u.pm; int e = 0;
#pragma unroll
        for (int k = 1; k < NEXP; ++k) e += (gt >= bt[k]) ? 1 : 0;
        u.be = __builtin_amdgcn_readfirstlane(e); return true;
    }
    __device__ __forceinline__ void a_ready(const pg8::Unit&) const {}
    __device__ __forceinline__ void done(const pg8::Unit&) const {}
};
__device__ __forceinline__ void p_ln_combine(const Frame& F0, const GAS float* g, const GAS float* b, int l) { const Frame F = launder(F0);
    const GAS bf16* YS = (const GAS bf16*)(F.ws + WS_HS);
    GAS int* TI_E = (GAS int*)(F.ws + WS_TI); GAS int* TI_P0 = TI_E + TL; GAS int* TI_P1 = TI_P0 + TL; GAS float* TI_W0 = (GAS float*)(TI_P1 + TL); GAS float* TI_W1 = TI_W0 + TL;
    for (int m = F.gw; m < TL; m += F.ngw) {
        GAS float* row = F.out + (size_t)m * D;
        const int s0 = TI_P0[m], s1 = TI_P1[m]; const float w0 = TI_W0[m], w1 = TI_W1[m];
        const GAS float* gate = modv(F, l, row_v(m), 5);
        const GAS unsigned long long* y0 = (const GAS unsigned long long*)(YS + (size_t)s0 * D) + F.lane; const GAS unsigned long long* y1 = (const GAS unsigned long long*)(YS + (size_t)s1 * D) + F.lane;
        f32x4 v[4]; float s = 0.f;
#pragma unroll
        for (int j = 0; j < 4; ++j) { const f32x4 x = ((const GAS f32x4*)row)[F.lane + 64 * j], gt = ((const GAS f32x4*)gate)[F.lane + 64 * j];
            const unsigned long long a = y0[64 * j], c = y1[64 * j];
            f32x4 f;
            f.x = w0 * bf2f((unsigned short)a) + w1 * bf2f((unsigned short)c); f.y = w0 * bf2f((unsigned short)(a >> 16)) + w1 * bf2f((unsigned short)(c >> 16));
            f.z = w0 * bf2f((unsigned short)(a >> 32)) + w1 * bf2f((unsigned short)(c >> 32)); f.w = w0 * bf2f((unsigned short)(a >> 48)) + w1 * bf2f((unsigned short)(c >> 48));
            v[j] = x * ALPHA + gt * f; s += (v[j].x + v[j].y) + (v[j].z + v[j].w); }
        const float mean = wave_sum(s) * (1.f / D); float s2 = 0.f;
#pragma unroll
        for (int j = 0; j < 4; ++j) { v[j] = v[j] - mean; s2 += (v[j].x * v[j].x + v[j].y * v[j].y) + (v[j].z * v[j].z + v[j].w * v[j].w); }
        const float rstd = 1.f / sqrtf(wave_sum(s2) * (1.f / D) + LN_EPS);
#pragma unroll
        for (int j = 0; j < 4; ++j) { const f32x4 gg = ((const GAS f32x4*)g)[F.lane + 64 * j], bb = ((const GAS f32x4*)b)[F.lane + 64 * j]; ((GAS f32x4*)row)[F.lane + 64 * j] = v[j] * rstd * gg + bb; }
    }
}

namespace att {
using bf16x8 = __attribute__((ext_vector_type(8))) short;
using s16x4  = __attribute__((ext_vector_type(4))) short;
using f32x16 = __attribute__((ext_vector_type(16))) float;
using u32x4  = __attribute__((ext_vector_type(4))) unsigned;
constexpr int DQ = 96, DV = 64, NW = 8, QBLK = 32, KVBLK = 64, NKEY = 16640;
constexpr float THR2 = 8.0f;
constexpr int SHM_K = KVBLK * 144, SHM_V = DV * 80;
typedef int i32x8 __attribute__((ext_vector_type(8)));
constexpr int NSLOT = 3;
constexpr int LDS_V = 0, LDS_K = NSLOT * SHM_V, LDS_WS = LDS_K + NSLOT * SHM_K, LDS_Q = LDS_WS + NW * 64 * 4, ATT_LDS = LDS_Q + NW * 4096;
#define KSWZ(row, colB) ((row) * 256 + ((colB) ^ (((row) & 7) << 4)))
#define SBAR() __builtin_amdgcn_sched_barrier(0)
__device__ __forceinline__ int crow(int r, int hi) { return (r & 3) + 8 * (r >> 2) + 4 * hi; }
__device__ __forceinline__ unsigned cvtpk(float lo, float hi) { unsigned r; asm volatile("v_cvt_pk_bf16_f32 %0, %1, %2" : "=v"(r) : "v"(lo), "v"(hi)); return r; }
template <bool FIRST>
__device__ __forceinline__ bool partialSM(f32x16& p0, f32x16& p1, f32x16& negm, float& alpha) {
  float a = fmaxf(fmaxf(p0[0], p0[1]), p1[0]), b = fmaxf(fmaxf(p0[2], p0[3]), p1[1]); a = fmaxf(fmaxf(a, p1[2]), p1[3]);
#pragma unroll
  for (int r = 4; r < 16; r += 4) { a = fmaxf(fmaxf(a, p0[r]), p0[r + 1]); b = fmaxf(fmaxf(b, p0[r + 2]), p0[r + 3]); a = fmaxf(fmaxf(a, p1[r]), p1[r + 1]); b = fmaxf(fmaxf(b, p1[r + 2]), p1[r + 3]); }
  float pmax = fmaxf(a, b);
  { auto rr = __builtin_amdgcn_permlane32_swap(__float_as_uint(pmax), __float_as_uint(pmax), false, false);
    pmax = fmaxf(__uint_as_float(rr[0]), __uint_as_float(rr[1])); }
  bool resc = false;
  if (FIRST || __builtin_expect(__any(pmax > THR2), 0)) {
    const float dl = FIRST ? pmax : fmaxf(pmax, 0.f);
#pragma unroll
    for (int r = 0; r < 16; ++r) { p0[r] -= dl; p1[r] -= dl; negm[r] -= dl; }
    alpha = __builtin_amdgcn_exp2f(-dl); resc = !FIRST;
  }
  return resc;
}
__device__ __forceinline__ void finishSM(f32x16& p0, f32x16& p1, i32x8& pb) {
#pragma unroll
  for (int r = 0; r < 16; ++r) p0[r] = __builtin_amdgcn_exp2f(p0[r]);
#pragma unroll
  for (int r = 0; r < 16; ++r) p1[r] = __builtin_amdgcn_exp2f(p1[r]);
#pragma unroll
  for (int w = 0; w < 4; ++w) {
    int x = __builtin_amdgcn_cvt_pk_fp8_f32(p0[4 * w], p0[4 * w + 1], __float_as_int(p0[4 * w]), false); x = __builtin_amdgcn_cvt_pk_fp8_f32(p0[4 * w + 2], p0[4 * w + 3], x, true); pb[w] = x;
    int y = __builtin_amdgcn_cvt_pk_fp8_f32(p1[4 * w], p1[4 * w + 1], __float_as_int(p1[4 * w]), false); y = __builtin_amdgcn_cvt_pk_fp8_f32(p1[4 * w + 2], p1[4 * w + 3], y, true); pb[4 + w] = y; }
}
__device__ __forceinline__ i32x8 ld32(const LAS char* p) { const u32x4 a = *reinterpret_cast<const LAS u32x4*>(p), b = *reinterpret_cast<const LAS u32x4*>(p + 16);
  return (i32x8){(int)a[0], (int)a[1], (int)a[2], (int)a[3], (int)b[0], (int)b[1], (int)b[2], (int)b[3]}; }
struct KFrag { i32x8 k00, k01, k10, k11; };
__device__ __forceinline__ void qkt_load(KFrag& k, const LAS char* Ks, int r32, int hi) {
  const LAS char* kp = Ks + r32 * 144 + hi * 32;
  k.k00 = ld32(kp); k.k01 = ld32(kp + 64); k.k10 = ld32(kp + 32 * 144); k.k11 = ld32(kp + 32 * 144 + 64);
}
__device__ __forceinline__ void qkt_mma(f32x16& p0, f32x16& p1, const KFrag& k, const i32x8& q0, const i32x8& q1, const f32x16& negm) {
  asm volatile("s_nop 1\n\tv_mfma_f32_32x32x64_f8f6f4 %0, %1, %2, %3" : "=&v"(p0) : "v"(k.k00), "v"(q0), "v"(negm));
  asm volatile("v_mfma_f32_32x32x64_f8f6f4 %0, %1, %2, %3" : "=&v"(p1) : "v"(k.k10), "v"(q0), "v"(negm));
  asm volatile("v_mfma_f32_32x32x64_f8f6f4 %0, %1, %2, %0" : "+v"(p0) : "v"(k.k01), "v"(q1));
  asm volatile("v_mfma_f32_32x32x64_f8f6f4 %0, %1, %2, %0" : "+v"(p1) : "v"(k.k11), "v"(q1));
}
__device__ __forceinline__ void qkt(f32x16& p0, f32x16& p1, const LAS char* Ks, const i32x8& q0, const i32x8& q1, const f32x16& negm, int r32, int hi) {
  KFrag k; qkt_load(k, Ks, r32, hi); qkt_mma(p0, p1, k, q0, q1, negm);
}
#define QK_DRAIN(P0, P1) asm volatile("s_nop 15\n\ts_nop 7" : "+v"(P0), "+v"(P1))
__device__ __forceinline__ void pv_d0(f32x16* o, const LAS char* Vs, const i32x8& pb, int r32, int hi) {
  const LAS char* vp = Vs + r32 * 80 + hi * 32;
  const u32x4 a0 = *reinterpret_cast<const LAS u32x4*>(vp), a1 = *reinterpret_cast<const LAS u32x4*>(vp + 16);
  const u32x4 b0 = *reinterpret_cast<const LAS u32x4*>(vp + 32 * 80), b1 = *reinterpret_cast<const LAS u32x4*>(vp + 32 * 80 + 16);
  const i32x8 va = {(int)a0[0], (int)a0[1], (int)a0[2], (int)a0[3], (int)a1[0], (int)a1[1], (int)a1[2], (int)a1[3]};
  const i32x8 vb = {(int)b0[0], (int)b0[1], (int)b0[2], (int)b0[3], (int)b1[0], (int)b1[1], (int)b1[2], (int)b1[3]};
  const i32x8 ones = {0x38383838, 0x38383838, 0x38383838, 0x38383838, 0x38383838, 0x38383838, 0x38383838, 0x38383838};
  asm volatile("s_nop 1\n\tv_mfma_f32_32x32x64_f8f6f4 %0, %1, %2, %0" : "+v"(o[0]) : "v"(va), "v"(pb));
  asm volatile("v_mfma_f32_32x32x64_f8f6f4 %0, %1, %2, %0" : "+v"(o[1]) : "v"(vb), "v"(pb));
  asm volatile("v_mfma_f32_32x32x64_f8f6f4 %0, %1, %2, %0" : "+v"(o[2]) : "v"(ones), "v"(pb));
}
#define PV_DRAIN() asm volatile("s_nop 15\n\ts_nop 7" : "+v"(o[0]), "+v"(o[1]), "+v"(o[2]))
__device__ __forceinline__ void attn_unit(const GAS unsigned char* __restrict__ Qb, const GAS unsigned char* __restrict__ Kh, const GAS unsigned char* __restrict__ Vh,
                                          GAS unsigned short* __restrict__ Ob, int ldo, int seq, LAS char* lds, int tid) {
  const int wid = tid >> 6, lane = tid & 63, r32 = lane & 31, hi = lane >> 5;
  LAS char* V_lds = lds + LDS_V; LAS char* K_lds = lds + LDS_K;
  f32x16 o[3] = {}; f32x16 negm = {};
  const GAS unsigned char* Qw = Qb + (long)(wid * QBLK + r32) * 128 + hi * 32;
  i32x8 q0, q1;
  { const u32x4 a = *reinterpret_cast<const GAS u32x4*>(Qw), b = *reinterpret_cast<const GAS u32x4*>(Qw + 16), c = *reinterpret_cast<const GAS u32x4*>(Qw + 64), d = *reinterpret_cast<const GAS u32x4*>(Qw + 80);
    q0 = (i32x8){(int)a[0], (int)a[1], (int)a[2], (int)a[3], (int)b[0], (int)b[1], (int)b[2], (int)b[3]}; q1 = (i32x8){(int)c[0], (int)c[1], (int)c[2], (int)c[3], (int)d[0], (int)d[1], (int)d[2], (int)d[3]}; }
  const int vst = (tid >> 2) * 80 + (tid & 3) * 16;
  const int kst0 = (tid >> 3) * 144 + (tid & 7) * 16;
  const bool hasv = wid < 4;
  struct { bf16x8 ks0, x1; } sr_[1];
#define SLOAD(i, k0) do { sr_[i].ks0 = *reinterpret_cast<const GAS bf16x8*>(Kh + (long)(k0) * 128 + tid * 16); \
    if (hasv) sr_[i].x1 = *reinterpret_cast<const GAS bf16x8*>(Vh + (long)((k0) / KVBLK) * 4096 + tid * 16); } while (0)
#define SWRITE(b, i) do { *(LAS bf16x8*)(K_lds + (b) * SHM_K + kst0) = sr_[i].ks0; \
    if (hasv) *(LAS bf16x8*)(V_lds + (b) * SHM_V + vst) = sr_[i].x1; } while (0)
#define RESC(flag, a) do { if (flag) { PV_DRAIN(); _Pragma("unroll") for (int d = 0; d < 3; ++d) _Pragma("unroll") for (int r = 0; r < 16; ++r) o[d][r] *= (a); } } while (0)
#define ATT_ILV() do { _Pragma("unroll") for (int i_ = 0; i_ < 12; ++i_) { __builtin_amdgcn_sched_group_barrier(0x008, 1, 0); __builtin_amdgcn_sched_group_barrier(0x400, 5, 0); __builtin_amdgcn_sched_group_barrier(0x002, 3, 0); __builtin_amdgcn_sched_group_barrier(0x100, 2, 0); } } while (0)
  f32x16 pA0, pA1, pB0, pB1; float alA = 1.f, alB = 1.f; bool rsA, rsB; i32x8 pb; KFrag kf; const int NT = seq / KVBLK;
#define KS(t) (K_lds + ((t) % NSLOT) * SHM_K)
#define VS(t) (V_lds + ((t) % NSLOT) * SHM_V)
  SLOAD(0, 0); SWRITE(0, 0); SLOAD(0, KVBLK); SWRITE(1, 0); SLOAD(0, 2 * KVBLK);
  __syncthreads();
  qkt(pA0, pA1, KS(0), q0, q1, negm, r32, hi); QK_DRAIN(pA0, pA1); (void)partialSM<true>(pA0, pA1, negm, alA);
  for (int j = 1; j + 1 < NT; j += 2) {
    __syncthreads(); SWRITE((j + 1) % NSLOT, 0); SLOAD(0, (j + 2) * KVBLK);
    SBAR(); qkt_load(kf, KS(j), r32, hi); SBAR();
    finishSM(pA0, pA1, pb); SBAR();
    qkt_mma(pB0, pB1, kf, q0, q1, negm); SBAR();
    pv_d0(o, VS(j - 1), pb, r32, hi); QK_DRAIN(pB0, pB1); rsB = partialSM<false>(pB0, pB1, negm, alB);
    RESC(rsB, alB);
    __syncthreads(); SWRITE((j + 2) % NSLOT, 0); if (j + 3 < NT) SLOAD(0, (j + 3) * KVBLK);
    SBAR(); qkt_load(kf, KS(j + 1), r32, hi); SBAR();
    finishSM(pB0, pB1, pb); SBAR();
    qkt_mma(pA0, pA1, kf, q0, q1, negm); SBAR();
    pv_d0(o, VS(j), pb, r32, hi); QK_DRAIN(pA0, pA1); rsA = partialSM<false>(pA0, pA1, negm, alA);
    RESC(rsA, alA);
  }
  __syncthreads();
  SBAR(); qkt(pB0, pB1, KS(NT - 1), q0, q1, negm, r32, hi);
  finishSM(pA0, pA1, pb); SBAR();
  pv_d0(o, VS(NT - 2), pb, r32, hi); QK_DRAIN(pB0, pB1); rsB = partialSM<false>(pB0, pB1, negm, alB);
  RESC(rsB, alB);
  finishSM(pB0, pB1, pb); SBAR();
  pv_d0(o, VS(NT - 1), pb, r32, hi);
#undef KS
#undef VS
  PV_DRAIN();
  const float rl = __builtin_amdgcn_rcpf(o[2][0]);
  GAS unsigned short* Ow = Ob + (long)(wid * QBLK + r32) * ldo + 4 * hi;
#pragma unroll
  for (int d0 = 0; d0 < 2; ++d0)
#pragma unroll
    for (int g = 0; g < 4; ++g) { unsigned long long w = (unsigned long long)cvtpk(o[d0][4 * g] * rl, o[d0][4 * g + 1] * rl) | ((unsigned long long)cvtpk(o[d0][4 * g + 2] * rl, o[d0][4 * g + 3] * rl) << 32);
      *(GAS unsigned long long*)(Ow + d0 * 32 + g * 8) = w; }
  __syncthreads();
#undef SLOAD
#undef ATT_ILV
#undef SWRITE
#undef RESC
}
#undef KSWZ
}

constexpr size_t WS_ROPE = WS_SMALL;
constexpr size_t WS_RSQ = WS_SMALL + 704 * 1024, WS_RSKV = WS_RSQ + (size_t)MR * 4;
static_assert(WS_RSKV + (size_t)MR * 4 <= WS_WIN, "small map");
constexpr size_t WS_QC = WS_Q + (size_t)NBATCH * 8 * SEQ * 128;
constexpr float MLA_QS = 4.f, MLA_KS = 0.25f;
static_assert(WS_QC + (size_t)NBATCH * 8 * CTXL * 128 <= WS_K && WS_K + (size_t)NBATCH * 8 * 16640 * 128 <= WS_V, "q8/k8 map");
constexpr float MLA_C2 = 0.10206207261596575f * 1.4426950408889634f;

__device__ __forceinline__ void p0_rope_table(const Frame& F0) { const Frame F = launder(F0);
    GAS float* T = (GAS float*)(F.ws + WS_ROPE);
    for (int i = blockIdx.x * NTHR + F.tid; i < 256 * 8; i += F.G * NTHR) {
        const int pos = i >> 3, e = i & 7;
        double inv = 1.0; for (int k = 0; k < (e >> 1); ++k) inv *= 0.1; if (e & 1) inv *= 0.31622776601683794;
        double rev = (double)pos * inv * 0.15915494309189535; rev -= (double)(long long)rev;
        T[2 * i] = __builtin_amdgcn_cosf((float)rev); T[2 * i + 1] = __builtin_amdgcn_sinf((float)rev);
    }
}
__device__ __forceinline__ void p_prep_mla_rows(const Frame& F0) { const Frame F = launder(F0);
    const GAS bf16* PH = (const GAS bf16*)(F.ws + WS_PH);
    GAS float* RSQ = (GAS float*)(F.ws + WS_RSQ); GAS float* RSKV = (GAS float*)(F.ws + WS_RSKV); const GAS float* T = (const GAS float*)(F.ws + WS_ROPE);
    for (int m = F.gw; m < MR; m += F.ngw) {
        const GAS bf16* row = PH + (size_t)m * NPH;
        const unsigned long long q4 = *((const GAS unsigned long long*)(row + PH_CQ) + F.lane);
        float a0 = bf2f((unsigned short)q4), a1 = bf2f((unsigned short)(q4 >> 16)), a2 = bf2f((unsigned short)(q4 >> 32)), a3 = bf2f((unsigned short)(q4 >> 48));
        const float sq = wave_sum(a0 * a0 + a1 * a1 + a2 * a2 + a3 * a3);
        float skv = 0.f, x = 0.f;
        if (F.lane < 32) { const unsigned long long k4 = *((const GAS unsigned long long*)(row + PH_CKV) + F.lane);
            a0 = bf2f((unsigned short)k4); a1 = bf2f((unsigned short)(k4 >> 16)); a2 = bf2f((unsigned short)(k4 >> 32)); a3 = bf2f((unsigned short)(k4 >> 48));
            skv = a0 * a0 + a1 * a1 + a2 * a2 + a3 * a3; x = bf2f(row[PH_KR + F.lane]); }
        skv = wave_sum(skv);
        if (F.lane == 0) { RSQ[m] = 1.f / sqrtf(sq * (1.f / 256.f) + RMS_EPS); RSKV[m] = 1.f / sqrtf(skv * (1.f / 128.f) + RMS_EPS); }
        const float xp = __shfl_xor(x, 8);
        int b, pos; float y = x;
        if (m < TL) { b = m >> 14; const int t = m & (SEQ - 1); pos = CTXL + t;
            const int i = F.lane & 31, half = i >> 4, w = i & 15, p = half ? (t & 63) : (t >> 6); const float c = T[(p * 8 + (w & 7)) * 2], s = T[(p * 8 + (w & 7)) * 2 + 1];
            y = (w < 8) ? (x * c - xp * s) : (xp * s + x * c); }
        else { b = (m - TL) >> 8; pos = (m - TL) & 255; }
        { const unsigned char yb = (unsigned char)(pk4_fp8(F.lane < 32 ? y * MLA_KS : 0.f, 0.f, 0.f, 0.f) & 0xffu);
          GAS unsigned char* K8 = F.ws + WS_K; GAS unsigned char* Q8 = m < TL ? F.ws + WS_Q : F.ws + WS_QC; const int qrows = m < TL ? SEQ : CTXL, qt = m < TL ? (m & (SEQ - 1)) : pos;
#pragma unroll
          for (int h = 0; h < 8; ++h) { K8[((size_t)(b * 8 + h) * att::NKEY + pos) * 128 + 64 + F.lane] = yb;
              if (F.lane >= 32) Q8[((size_t)(b * 8 + h) * qrows + qt) * 128 + 64 + F.lane] = 0; } }
    }
}
struct EpiMlaQ {
    static constexpr bool PERM = true, AFTER_DRAIN = false;
    GAS unsigned char* Q; GAS unsigned char* QC; const GAS float* rsq; const GAS float* rope;
    __device__ __forceinline__ void operator()(const pg8::f32x4 (&acc)[2][2][4][2], const Unit& u, int wr, int wc, int fr, int fq) const {
        const bool lat = u.pm < TL / 256;
        const int b = lat ? (u.pm >> 6) : (u.pm - TL / 256), t0 = lat ? (u.pm & 63) * 256 : 0, rows = lat ? SEQ : CTXL;
        GAS unsigned char* base = lat ? Q : QC;
        const unsigned lane_off = (unsigned)((wr * 64 + fr) * 128 + 8 * fq);
        const GAS float* rsp = rsq + u.pm * 256 + wr * 64 + fr;
#pragma unroll
        for (int ai = 0; ai < 2; ++ai)
#pragma unroll
            for (int m = 0; m < 4; ++m) { const float rs = rsp[ai * 128 + m * 16] * (MLA_C2 * MLA_QS);
                const int trow = t0 + ai * 128 + m * 16;
#pragma unroll
                for (int bj = 0; bj < 2; ++bj) { const int g32 = 8 * u.pn + 4 * bj + wc, head = g32 / 3, part = g32 - 3 * head;
                    float x[8];
#pragma unroll
                    for (int i = 0; i < 4; ++i) { x[i] = acc[ai][bj][m][0][i] * rs; x[4 + i] = acc[ai][bj][m][1][i] * rs; }
                    if (part == 2 && lat) {
                        const int p = (fq < 2) ? ((trow >> 6) + wr) : (m * 16 + fr); const GAS f32x4* cs = (const GAS f32x4*)(rope + p * 16);
#pragma unroll
                        for (int i2 = 0; i2 < 4; ++i2) { const f32x4 c4 = cs[i2];
                            const float xa = __shfl_xor(x[2 * i2], 16), xb = __shfl_xor(x[2 * i2 + 1], 16);
                            x[2 * i2] = (fq & 1) ? (xa * c4.y + x[2 * i2] * c4.x) : (x[2 * i2] * c4.x - xa * c4.y);
                            x[2 * i2 + 1] = (fq & 1) ? (xb * c4.w + x[2 * i2 + 1] * c4.z) : (x[2 * i2 + 1] * c4.z - xb * c4.w); }
                    }
                    v2u w; w.x = pk4_fp8(x[0], x[1], x[2], x[3]); w.y = pk4_fp8(x[4], x[5], x[6], x[7]);
                    const size_t soff = (((size_t)(b * 8 + head) * rows + trow) * 128 + part * 32);
                    *(GAS v2u*)(base + soff + lane_off) = w; }
                asm volatile("" ::: "memory"); }
    }
};
struct EpiMlaKV {
    static constexpr bool PERM = true, AFTER_DRAIN = false;
    GAS unsigned char* K; GAS bf16* V; const GAS float* rskv;
    __device__ __forceinline__ void operator()(const pg8::f32x4 (&acc)[2][2][4][2], const Unit& u, int wr, int wc, int fr, int fq) const {
        const bool lat = u.pm < TL / 256;
        const int b = lat ? (u.pm >> 6) : (u.pm - TL / 256), pos0 = lat ? CTXL + (u.pm & 63) * 256 : 0;
        const bool isk = wc < 2;
        const unsigned lane_off = isk ? (unsigned)((wr * 64 + fr) * 128 + 32 * (wc & 1) + 8 * fq) : (unsigned)(((wr * 64 + fr) * 64 + 32 * (wc & 1) + 8 * fq) * 2);
        const GAS float* rsp = rskv + u.pm * 256 + wr * 64 + fr;
#pragma unroll
        for (int ai = 0; ai < 2; ++ai)
#pragma unroll
            for (int m = 0; m < 4; ++m) { const float rs = rsp[ai * 128 + m * 16];
#pragma unroll
                for (int bj = 0; bj < 2; ++bj) { const int head = 2 * u.pn + bj;
                    const size_t rk = (size_t)(b * 8 + head) * att::NKEY + pos0 + ai * 128 + m * 16;
                    if (isk) { const pg8::f32x4 v0 = acc[ai][bj][m][0] * (rs * MLA_KS), v1 = acc[ai][bj][m][1] * (rs * MLA_KS);
                        v2u w; w.x = pk4_fp8(v0[0], v0[1], v0[2], v0[3]); w.y = pk4_fp8(v1[0], v1[1], v1[2], v1[3]);
                        *(GAS v2u*)(K + rk * 128 + lane_off) = w; }
                    else { const pg8::f32x4 v0 = acc[ai][bj][m][0] * rs, v1 = acc[ai][bj][m][1] * rs;
                        v4u w; w.x = pk2(v0[0], v0[1]); w.y = pk2(v0[2], v0[3]); w.z = pk2(v1[0], v1[1]); w.w = pk2(v1[2], v1[3]);
                        *(GAS v4u*)((GAS char*)V + rk * 128 + lane_off) = w; } }
                asm volatile("" ::: "memory"); }
    }
};
constexpr size_t WS_V8T = WS_QC + (size_t)NBATCH * 8 * CTXL * 128;
static_assert(WS_V8T + (size_t)NBATCH * 8 * (att::NKEY / 64) * 4096 <= WS_K, "v8t map");
__device__ __forceinline__ void p_attn_vt_pack(const Frame& F0) { const Frame F = launder(F0);
    LAS unsigned short* VL = (LAS unsigned short*)F.lds; const int tid = F.tid;
    const GAS bf16* V = (const GAS bf16*)(F.ws + WS_V); GAS unsigned char* V8T = F.ws + WS_V8T;
    const int ntile = att::NKEY / 64;
    for (int u = blockIdx.x; u < NBATCH * 8 * ntile; u += F.G) {
        const int bh = u / ntile, t = u % ntile;
        { const int key = tid >> 3, c8 = (tid & 7) * 8; const v4u w = *(const GAS v4u*)(V + ((size_t)bh * att::NKEY + t * 64 + key) * 64 + c8);
          LAS unsigned short* d = VL + key * 66 + c8; d[0] = (unsigned short)w.x; d[1] = (unsigned short)(w.x >> 16); d[2] = (unsigned short)w.y; d[3] = (unsigned short)(w.y >> 16);
          d[4] = (unsigned short)w.z; d[5] = (unsigned short)(w.z >> 16); d[6] = (unsigned short)w.w; d[7] = (unsigned short)(w.w >> 16); }
        __syncthreads();
        { const int v = tid >> 3, s8 = (tid & 7) * 8; float x[8];
#pragma unroll
          for (int e = 0; e < 8; ++e) { const int slot = s8 + e, hi = slot >> 5, j = slot & 31, jj = j & 15, key = (j >> 4) * 32 + (jj & 3) + 8 * (jj >> 2) + 4 * hi; x[e] = bf2f(VL[key * 66 + v]); }
          v2u o; o.x = pk4_fp8(x[0], x[1], x[2], x[3]); o.y = pk4_fp8(x[4], x[5], x[6], x[7]);
          *(GAS v2u*)(V8T + (size_t)u * 4096 + v * 64 + s8) = o; }
        __syncthreads();
    }
}
__device__ __forceinline__ void p_attention(const Frame& F0, bool with_ctx) { const Frame F = launder(F0);
    const GAS unsigned char* Q = F.ws + WS_Q; const GAS unsigned char* QC = F.ws + WS_QC; const GAS unsigned char* K = F.ws + WS_K; const GAS unsigned char* V8T = F.ws + WS_V8T;
    GAS bf16* Y = (GAS bf16*)(F.ws + WS_Y);
    LAS char* lds = (LAS char*)F.lds;
    const int nlat = NBATCH * 8 * (SEQ / 256);
    for (int i = 0;; ++i) {
        const int L = i * F.G + (int)blockIdx.x; if (L >= nlat) break;
        int bh, qb;
        if (F.G == 256) { const int xcd = blockIdx.x & 7, slot = blockIdx.x >> 3; bh = xcd + 8 * (i >> 1); qb = (i & 1) * 32 + slot; }
        else { bh = L / (SEQ / 256); qb = L % (SEQ / 256); }
        const int b = bh >> 3, h = bh & 7;
        att::attn_unit(Q + ((size_t)bh * SEQ + qb * 256) * 128, K + (size_t)bh * att::NKEY * 128, V8T + (size_t)bh * (att::NKEY / 64) * 4096,
                       Y + ((size_t)b * SEQ + qb * 256) * D + 512 + h * 64, D, att::NKEY, lds, F.tid);
    }
    if (with_ctx && (int)blockIdx.x < NBATCH * 8) { const int bh = blockIdx.x, b = bh >> 3, h = bh & 7;
        att::attn_unit(QC + (size_t)bh * CTXL * 128, K + (size_t)bh * att::NKEY * 128, V8T + (size_t)bh * (att::NKEY / 64) * 4096,
                       Y + ((size_t)TL + b * CTXL) * D + 512 + h * 64, D, CTXL, lds, F.tid);
    }
}
__device__ __forceinline__ void p_ynorm_c(const Frame& F0, int nrows, const GAS float* mg) { const Frame F = launder(F0);
    GAS bf16* Y = (GAS bf16*)(F.ws + WS_Y);
    for (int m = F.gw; m < nrows; m += F.ngw) {
        GAS v4u* p = (GAS v4u*)(Y + (size_t)m * D + 512) + F.lane; const v4u w = *p;
        float x[8]; x[0] = bf2f((unsigned short)w.x); x[1] = bf2f((unsigned short)(w.x >> 16)); x[2] = bf2f((unsigned short)w.y); x[3] = bf2f((unsigned short)(w.y >> 16));
        x[4] = bf2f((unsigned short)w.z); x[5] = bf2f((unsigned short)(w.z >> 16)); x[6] = bf2f((unsigned short)w.w); x[7] = bf2f((unsigned short)(w.w >> 16));
        float s = 0.f;
#pragma unroll
        for (int i = 0; i < 8; ++i) s += x[i] * x[i];
        const float rs = 1.f / sqrtf(wave_sum(s) * (1.f / 512.f) + RMS_EPS);
        const f32x4 g0 = ((const GAS f32x4*)mg)[2 * F.lane], g1 = ((const GAS f32x4*)mg)[2 * F.lane + 1];
        v4u o; o.x = pk2(x[0] * rs * g0.x, x[1] * rs * g0.y); o.y = pk2(x[2] * rs * g0.z, x[3] * rs * g0.w); o.z = pk2(x[4] * rs * g1.x, x[5] * rs * g1.y); o.w = pk2(x[6] * rs * g1.z, x[7] * rs * g1.w);
        *p = o;
    }
}

constexpr int GLA_NCH = 4 + SEQ / 64;
constexpr size_t WS_SLOC = WS_XN, WS_GDEC = AB + 521 * MiB;
static_assert(WS_SLOC + (size_t)NBATCH * 4 * 2 * GLA_NCH * 2048 * 4 <= WS_XN + 33 * MiB && (size_t)NBATCH * 4 * 2 * GLA_NCH * 32 * 4 <= 5 * MiB && GLA_NCH % 20 == 0, "gla map");
constexpr int GB_LA = 0, GB_K = GB_LA + 16384, GB_Q = GB_K + 8192, GB_ALR = GB_Q + 8192, GB_WG = GB_ALR + 8192, GB_BG = GB_WG + 4096, GB_O = GB_BG + 256,
              GB_QF = GB_O + 64 * 65 * 4, GB_QB = GB_QF + 5120, GB_KF = GB_QB + 5120, GB_KB = GB_KF + 5120, GB_KTF = GB_KB + 5120, GB_KTB = GB_KTF + 4608, GB_VT = GB_KTB + 4608,
              GB_ATT = GB_VT + 9216, GB_STF = GB_ATT + 9216, GB_STB = GB_STF + 5120, GB_END = GB_STB + 5120;
static_assert(GB_END <= 131072 && GB_QF % 16 == 0, "gla lds");
typedef short gbf16x8 __attribute__((ext_vector_type(8)));
typedef float gf32x16 __attribute__((ext_vector_type(16)));
__device__ __forceinline__ float logsigmoidf(float z) { return fminf(z, 0.f) - __logf(1.f + __expf(-fabsf(z))); }
__device__ __forceinline__ unsigned short bf1(float x) { return (unsigned short)(pk2(x, x) & 0xffffu); }
__device__ __forceinline__ void ld8bf(const GAS bf16* p, LAS float* d) { const v4u w = *(const GAS v4u*)p;
    d[0] = bf2f((unsigned short)w.x); d[1] = bf2f((unsigned short)(w.x >> 16)); d[2] = bf2f((unsigned short)w.y); d[3] = bf2f((unsigned short)(w.y >> 16));
    d[4] = bf2f((unsigned short)w.z); d[5] = bf2f((unsigned short)(w.z >> 16)); d[6] = bf2f((unsigned short)w.w); d[7] = bf2f((unsigned short)(w.w >> 16)); }
__device__ __forceinline__ int gcrow(int r, int hi) { return (r & 3) + 8 * (r >> 2) + 4 * hi; }
template <int KD>
__device__ __forceinline__ void gmm(gf32x16& acc, const LAS unsigned char* A, int sa, int m0, const LAS unsigned char* BT, int sb, int n0, int r32, int hi) {
#pragma unroll
    for (int kt = 0; kt < KD / 16; ++kt) { const gbf16x8 a = *(const LAS gbf16x8*)(A + (m0 + r32) * sa + (kt * 16 + hi * 8) * 2), b = *(const LAS gbf16x8*)(BT + (n0 + r32) * sb + (kt * 16 + hi * 8) * 2);
        acc = __builtin_amdgcn_mfma_f32_32x32x16_bf16(a, b, acc, 0, 0, 0); }
}
__device__ __forceinline__ void gla_head(const Frame& F, int l, int b, int h, int jj, bool want_q) {
    LAS unsigned char* LB = F.lds; LAS float* LA = (LAS float*)(LB + GB_LA); LAS float* KK = (LAS float*)(LB + GB_K); LAS float* QQ = (LAS float*)(LB + GB_Q); LAS float* ALR = (LAS float*)(LB + GB_ALR);
    LAS float* WG = (LAS float*)(LB + GB_WG); LAS float* BG = (LAS float*)(LB + GB_BG); LAS unsigned short* VT = (LAS unsigned short*)(LB + GB_VT);
    const int tid = F.tid;
    const int row0 = jj < 4 ? TL + b * CTXL + jj * 64 : b * SEQ + (jj - 4) * 64;
    const GAS bf16* PH = (const GAS bf16*)(F.ws + WS_PH) + (size_t)row0 * NPH;
    { const int t = (tid & 255) >> 2, c = (tid & 3) * 8;
      if (tid < 256) { ld8bf(PH + (size_t)t * NPH + PH_KA + h * 32 + c, KK + t * 32 + c); ld8bf(PH + (size_t)t * NPH + PH_ALR + c, ALR + t * 32 + c); }
      else if (want_q) ld8bf(PH + (size_t)t * NPH + PH_QA + h * 32 + c, QQ + t * 32 + c); }
    { const int t = tid >> 3, c = (tid & 7) * 8; const v4u w = *(const GAS v4u*)(PH + (size_t)t * NPH + PH_VA + h * 64 + c);
      VT[(c + 0) * 72 + t] = (unsigned short)w.x; VT[(c + 1) * 72 + t] = (unsigned short)(w.x >> 16); VT[(c + 2) * 72 + t] = (unsigned short)w.y; VT[(c + 3) * 72 + t] = (unsigned short)(w.y >> 16);
      VT[(c + 4) * 72 + t] = (unsigned short)w.z; VT[(c + 5) * 72 + t] = (unsigned short)(w.z >> 16); VT[(c + 6) * 72 + t] = (unsigned short)w.w; VT[(c + 7) * 72 + t] = (unsigned short)(w.w >> 16); }
    { const GAS float* wg = F.in[I_GWG] + (size_t)l * 2 * 16 * 128;
      for (int i = tid; i < 1024; i += NTHR) { const int d = i >> 9, r = (i >> 5) & 15, k = i & 31; WG[i] = wg[(d * 16 + r) * 128 + h * 32 + k]; }
      if (tid < 64) BG[tid] = F.in[I_GBG][l * 256 + (tid >> 5) * 128 + h * 32 + (tid & 31)]; }
    __syncthreads();
    { const int k = tid & 31, t0 = tid >> 5;
#pragma unroll
      for (int d = 0; d < 2; ++d)
#pragma unroll
        for (int tt = 0; tt < 4; ++tt) { const int t = t0 + 16 * tt; float z = BG[d * 32 + k];
#pragma unroll
            for (int r = 0; r < 16; ++r) z += ALR[t * 32 + d * 16 + r] * WG[(d * 16 + r) * 32 + k];
            LA[(d * 64 + t) * 32 + k] = logsigmoidf(z) * (1.f / 16.f); } }
    __syncthreads();
    { const int w = tid >> 6, lane = tid & 63;
#pragma unroll
      for (int c = 0; c < 8; ++c) { const int col = w * 8 + c, d = col >> 5, k = col & 31; float v = LA[(d * 64 + lane) * 32 + k];
#pragma unroll
          for (int o = 1; o < 64; o <<= 1) { const float u = d == 0 ? __shfl_up(v, o) : __shfl_down(v, o); if (d == 0 ? lane >= o : lane + o < 64) v += u; }
          LA[(d * 64 + lane) * 32 + k] = v; } }
    __syncthreads();
}
__device__ __forceinline__ void p_gla_local(const Frame& F0, int l) { const Frame F = launder(F0);
    LAS unsigned char* LB = F.lds; LAS float* LA = (LAS float*)(LB + GB_LA); LAS float* KK = (LAS float*)(LB + GB_K); const int tid = F.tid;
    LAS unsigned short* KTF = (LAS unsigned short*)(LB + GB_KTF); LAS unsigned short* KTB = (LAS unsigned short*)(LB + GB_KTB);
    GAS float* SLOC = (GAS float*)(F.ws + WS_SLOC); GAS float* GDEC = (GAS float*)(F.ws + WS_GDEC);
    const int wv = tid >> 6, lane = tid & 63, r32 = lane & 31, hi = lane >> 5;
    for (int u = blockIdx.x; u < NBATCH * 4 * GLA_NCH; u += F.G) {
        const int b = u / (4 * GLA_NCH), h = (u / GLA_NCH) & 3, jj = u % GLA_NCH;
        gla_head(F, l, b, h, jj, false);
        for (int i = tid; i < 2048; i += NTHR) { const int t = i >> 5, k = i & 31; const float kv = KK[i];
            KTF[k * 72 + t] = bf1(kv * __expf(LA[63 * 32 + k] - LA[t * 32 + k]));
            KTB[k * 72 + t] = bf1(kv * __expf(LA[64 * 32 + k] - LA[(64 + t) * 32 + k])); }
        __syncthreads();
        if (wv < 4) { const int dir = wv >> 1, nt = wv & 1; gf32x16 acc = {};
            gmm<64>(acc, LB + (dir ? GB_KTB : GB_KTF), 144, 0, LB + GB_VT, 144, nt * 32, r32, hi);
            GAS float* dst = SLOC + ((size_t)((b * 4 + h) * 2 + dir) * GLA_NCH + jj) * 2048 + nt * 32 + r32;
#pragma unroll
            for (int r = 0; r < 16; ++r) dst[gcrow(r, hi) * 64] = acc[r]; }
        if (tid < 64) { const int d = tid >> 5, kk = tid & 31; GDEC[((size_t)((b * 4 + h) * 2 + d) * GLA_NCH + jj) * 32 + kk] = __expf(d ? LA[64 * 32 + kk] : LA[63 * 32 + kk]); }
        __syncthreads();
    }
}
__device__ __forceinline__ void p_gla_scan(const Frame& F0) { const Frame F = launder(F0);
    GAS float* SLOC = (GAS float*)(F.ws + WS_SLOC); const GAS float* GDEC = (const GAS float*)(F.ws + WS_GDEC);
    if (F.tid < 128) for (int it = blockIdx.x; it < 256; it += F.G) {
        const int chain = it >> 4, e = (it & 15) * 128 + F.tid, k = e >> 6, dir = chain & 1;
        GAS float* sl = SLOC + (size_t)chain * GLA_NCH * 2048 + e; const GAS float* dc = GDEC + (size_t)chain * GLA_NCH * 32 + k;
        float S = 0.f;
        for (int j0 = 0; j0 < GLA_NCH; j0 += 20) { float lv[20], dv[20];
#pragma unroll
            for (int q = 0; q < 20; ++q) { const int j = j0 + q, jx = dir == 0 ? j : (j < 4 ? 3 - j : GLA_NCH + 3 - j); lv[q] = sl[(size_t)jx * 2048]; dv[q] = dc[jx * 32]; }
#pragma unroll
            for (int q = 0; q < 20; ++q) { const int j = j0 + q, jx = dir == 0 ? j : (j < 4 ? 3 - j : GLA_NCH + 3 - j); sl[(size_t)jx * 2048] = S; S = dv[q] * S + lv[q]; } }
    }
}
__device__ __forceinline__ void p_gla_out(const Frame& F0, int l, bool with_ctx) { const Frame F = launder(F0);
    LAS unsigned char* LB = F.lds; LAS float* LA = (LAS float*)(LB + GB_LA); LAS float* KK = (LAS float*)(LB + GB_K); LAS float* QQ = (LAS float*)(LB + GB_Q); LAS float* OO = (LAS float*)(LB + GB_O);
    LAS unsigned short* QF = (LAS unsigned short*)(LB + GB_QF); LAS unsigned short* QB = (LAS unsigned short*)(LB + GB_QB); LAS unsigned short* KF = (LAS unsigned short*)(LB + GB_KF); LAS unsigned short* KB = (LAS unsigned short*)(LB + GB_KB);
    LAS unsigned short* ATT = (LAS unsigned short*)(LB + GB_ATT); LAS unsigned short* STF = (LAS unsigned short*)(LB + GB_STF); LAS unsigned short* STB = (LAS unsigned short*)(LB + GB_STB);
    const int tid = F.tid, wv = tid >> 6, lane = tid & 63, r32 = lane & 31, hi = lane >> 5;
    const GAS float* SLOC = (const GAS float*)(F.ws + WS_SLOC); GAS bf16* Y = (GAS bf16*)(F.ws + WS_Y); const GAS bf16* PHB = (const GAS bf16*)(F.ws + WS_PH);
    const GAS float* gng = F.in[I_GNG] + l * 64;
    for (int u = blockIdx.x; u < NBATCH * 4 * GLA_NCH; u += F.G) {
        const int b = u / (4 * GLA_NCH), h = (u / GLA_NCH) & 3, jj = u % GLA_NCH;
        if (jj < 4 && !with_ctx) continue;
        gla_head(F, l, b, h, jj, true);
        for (int i = tid; i < 2048; i += NTHR) { const int t = i >> 5, k = i & 31; const float qv = QQ[i] * 0.17677669529663687f, kv = KK[i];
            const float bf_ = LA[t * 32 + k], bb_ = LA[(64 + t) * 32 + k];
            QF[t * 40 + k] = bf1(qv * __expf(bf_)); KF[t * 40 + k] = bf1(kv * __expf(-bf_)); QB[t * 40 + k] = bf1(qv * __expf(bb_)); KB[t * 40 + k] = bf1(kv * __expf(-bb_)); }
        { const GAS float* s0 = SLOC + ((size_t)((b * 4 + h) * 2 + 0) * GLA_NCH + jj) * 2048; const GAS float* s1 = SLOC + ((size_t)((b * 4 + h) * 2 + 1) * GLA_NCH + jj) * 2048;
          const int k = tid >> 4, v4 = (tid & 15) * 4; const f32x4 a = *(const GAS f32x4*)(s0 + k * 64 + v4), c = *(const GAS f32x4*)(s1 + k * 64 + v4);
          STF[(v4 + 0) * 40 + k] = bf1(a.x); STF[(v4 + 1) * 40 + k] = bf1(a.y); STF[(v4 + 2) * 40 + k] = bf1(a.z); STF[(v4 + 3) * 40 + k] = bf1(a.w);
          STB[(v4 + 0) * 40 + k] = bf1(c.x); STB[(v4 + 1) * 40 + k] = bf1(c.y); STB[(v4 + 2) * 40 + k] = bf1(c.z); STB[(v4 + 3) * 40 + k] = bf1(c.w); }
        __syncthreads();
        gf32x16 acc = {};
        const int mt = wv & 1, nt = (wv >> 1) & 1;
        if (wv < 4) {
            gf32x16 af = {}, ab = {};
            gmm<32>(af, LB + GB_QF, 80, mt * 32, LB + GB_KF, 80, nt * 32, r32, hi); gmm<32>(ab, LB + GB_QB, 80, mt * 32, LB + GB_KB, 80, nt * 32, r32, hi);
            const int s = nt * 32 + r32;
#pragma unroll
            for (int r = 0; r < 16; ++r) { const int t = mt * 32 + gcrow(r, hi); const float a = (s <= t ? af[r] : 0.f) + (s >= t ? ab[r] : 0.f); ATT[t * 72 + s] = bf1(a); }
        } else {
            gmm<32>(acc, LB + GB_QF, 80, mt * 32, LB + GB_STF, 80, nt * 32, r32, hi); gmm<32>(acc, LB + GB_QB, 80, mt * 32, LB + GB_STB, 80, nt * 32, r32, hi);
        }
        __syncthreads();
        if (wv >= 4) { gmm<64>(acc, LB + GB_ATT, 144, mt * 32, LB + GB_VT, 144, nt * 32, r32, hi);
#pragma unroll
            for (int r = 0; r < 16; ++r) OO[(mt * 32 + gcrow(r, hi)) * 65 + nt * 32 + r32] = acc[r]; }
        __syncthreads();
        { const int t = tid >> 3, vg = tid & 7; float o8[8], ss = 0.f;
#pragma unroll
          for (int i = 0; i < 8; ++i) { o8[i] = OO[t * 65 + vg * 8 + i]; ss += o8[i] * o8[i]; }
          ss += __shfl_xor(ss, 1); ss += __shfl_xor(ss, 2); ss += __shfl_xor(ss, 4);
          const float rs = 1.f / sqrtf(ss * (1.f / 64.f) + RMS_EPS);
          const int row = (jj < 4 ? TL + b * CTXL + jj * 64 : b * SEQ + (jj - 4) * 64) + t;
          const v4u gw = *(const GAS v4u*)(PHB + (size_t)row * NPH + PH_GA + h * 64 + vg * 8);
          float ga[8]; ga[0] = bf2f((unsigned short)gw.x); ga[1] = bf2f((unsigned short)(gw.x >> 16)); ga[2] = bf2f((unsigned short)gw.y); ga[3] = bf2f((unsigned short)(gw.y >> 16));
          ga[4] = bf2f((unsigned short)gw.z); ga[5] = bf2f((unsigned short)(gw.z >> 16)); ga[6] = bf2f((unsigned short)gw.w); ga[7] = bf2f((unsigned short)(gw.w >> 16));
          float y[8];
#pragma unroll
          for (int i = 0; i < 8; ++i) y[i] = o8[i] * rs * gng[vg * 8 + i] * siluf(ga[i]);
          v4u o; o.x = pk2(y[0], y[1]); o.y = pk2(y[2], y[3]); o.z = pk2(y[4], y[5]); o.w = pk2(y[6], y[7]);
          *(GAS v4u*)(Y + (size_t)row * D + h * 64 + vg * 8) = o; }
        __syncthreads();
    }
}

constexpr int FN = 32768, FN1 = 128, FN2 = 256;
constexpr size_t WS_FA = WS_XN + 33 * MiB;
constexpr size_t WS_HT = WS_PH;
constexpr size_t WS_FA0 = WS_K, WS_FA1 = WS_VT;
constexpr size_t WS_HID = AB + 521 * MiB, WS_HTC = AB + 526 * MiB, WS_CU = AB + 527 * MiB, WS_OTC = AB + 529 * MiB, WS_END2 = AB + 530 * MiB;
static_assert(WS_FA0 + 64 * MiB <= WS_VT && WS_FA1 + 64 * MiB <= WS_HF && WS_END2 <= 573 * MiB, "hyena map");
constexpr size_t CTL_NRM = 256 * 1024;
typedef float f32x2 __attribute__((ext_vector_type(2)));
__device__ __forceinline__ f32x2 cmul(f32x2 a, f32x2 b) { return (f32x2){a.x * b.x - a.y * b.y, a.x * b.y + a.y * b.x}; }
__device__ __forceinline__ unsigned pkc(f32x2 v) { return pk2(v.x, v.y); }
__device__ __forceinline__ f32x2 upc(unsigned w) { return (f32x2){__uint_as_float(w << 16), __uint_as_float(w & 0xffff0000u)}; }
__device__ __forceinline__ f32x2 twid(float rev) { return (f32x2){__builtin_amdgcn_cosf(rev), __builtin_amdgcn_sinf(rev)}; }
__device__ __forceinline__ GAS float* nrm_acc(const Frame& F, int l, int kind) { return (GAS float*)(F.ws + CTL_NRM) + (l * 2 + kind) * 512; }

__device__ __forceinline__ void p_filt_hidden(const Frame& F0, int l) { const Frame F = launder(F0);
    LAS float* L = (LAS float*)F.lds; LAS float* W1 = L, * W2 = L + 33 * 64, * H1 = W2 + 64 * 64, * PB = H1 + 128 * 65;
    GAS float* HID = (GAS float*)(F.ws + WS_HID); const int tid = F.tid;
    for (int i = tid; i < 33 * 64; i += NTHR) W1[i] = F.in[I_HW1][l * 33 * 64 + i];
    for (int i = tid; i < 64 * 64; i += NTHR) W2[i] = F.in[I_HW2][l * 64 * 64 + i];
    if (tid < 64) { PB[tid] = F.in[I_HB1][l * 64 + tid]; PB[64 + tid] = F.in[I_HF1][l * 64 + tid]; PB[128 + tid] = F.in[I_HB2][l * 64 + tid]; PB[192 + tid] = F.in[I_HF2][l * 64 + tid]; }
    __syncthreads();
    const int p = tid & 127, jq = tid >> 7;
    for (int blk = blockIdx.x; blk < (SEQ + CTXL) / 128; blk += F.G) {
        const int prow = blk * 128 + p; const bool lat = prow < SEQ; const int pos = lat ? prow : prow - SEQ; const float Lf = lat ? (float)SEQ : (float)CTXL;
        float z[33]; z[0] = (float)pos / (Lf - 1.f);
#pragma unroll
        for (int i = 0; i < 16; ++i) { const float fr = 1e-4f + (float)i * ((15.f - 1e-4f) / 15.f); float rev = (float)pos * fr / Lf; rev -= floorf(rev);
            z[1 + i] = __builtin_amdgcn_cosf(rev); z[17 + i] = -__builtin_amdgcn_sinf(rev); }
        for (int j = jq * 16; j < jq * 16 + 16; ++j) { float a = PB[j];
#pragma unroll
            for (int i = 0; i < 33; ++i) a += z[i] * W1[i * 64 + j];
            H1[p * 65 + j] = __sinf(PB[64 + j] * a); }
        __syncthreads();
        for (int j = jq * 16; j < jq * 16 + 16; ++j) { float a = PB[128 + j];
            for (int i = 0; i < 64; ++i) a += H1[p * 65 + i] * W2[i * 64 + j];
            HID[(size_t)prow * 64 + j] = __sinf(PB[192 + j] * a); }
        __syncthreads();
    }
}
__device__ __forceinline__ void p_filt_raw(const Frame& F0, int l) { const Frame F = launder(F0);
    LAS float* L = (LAS float*)F.lds; LAS float* HS = L, * W3 = L + 64 * 65; const int tid = F.tid;
    const GAS float* HID = (const GAS float*)(F.ws + WS_HID); GAS float* HT = (GAS float*)(F.ws + WS_HT); GAS float* HTC = (GAS float*)(F.ws + WS_HTC);
    const GAS float* w3 = F.in[I_HW3] + (size_t)l * 64 * 1024; const GAS float* b3 = F.in[I_HB3] + l * 1024;
    const int pg = tid & 15, cg = tid >> 4;
    for (int u = blockIdx.x; u < ((SEQ + CTXL) / 64) * 4; u += F.G) {
        const int pb = u >> 2, cb = u & 3, prow0 = pb * 64; const bool lat = prow0 < SEQ; const int pos0 = lat ? prow0 : prow0 - SEQ; const float Lf = lat ? (float)SEQ : (float)CTXL;
        for (int i = tid; i < 64 * 64; i += NTHR) HS[(i >> 6) * 65 + (i & 63)] = HID[(size_t)prow0 * 64 + i];
        for (int i = tid; i < 64 * 256; i += NTHR) W3[i] = w3[(size_t)(i >> 8) * 1024 + cb * 256 + (i & 255)];
        __syncthreads();
        float acc[4][8];
#pragma unroll
        for (int a = 0; a < 4; ++a)
#pragma unroll
            for (int c = 0; c < 8; ++c) acc[a][c] = 0.f;
        for (int i = 0; i < 64; ++i) { const f32x4 w0 = *(const LAS f32x4*)(W3 + i * 256 + cg * 8), w1 = *(const LAS f32x4*)(W3 + i * 256 + cg * 8 + 4);
#pragma unroll
            for (int a = 0; a < 4; ++a) { const float hv = HS[(pg * 4 + a) * 65 + i];
                acc[a][0] += hv * w0.x; acc[a][1] += hv * w0.y; acc[a][2] += hv * w0.z; acc[a][3] += hv * w0.w; acc[a][4] += hv * w1.x; acc[a][5] += hv * w1.y; acc[a][6] += hv * w1.z; acc[a][7] += hv * w1.w; } }
        float ss[8];
#pragma unroll
        for (int c = 0; c < 8; ++c) { const int col = cb * 256 + cg * 8 + c, ch = col & 255; const float delta = 3.0701134573253944f + (float)ch * (12.280453829301578f / 255.f), bias = b3[col];
            float o[4]; ss[c] = 0.f;
#pragma unroll
            for (int a = 0; a < 4; ++a) { const float t = (float)(pos0 + pg * 4 + a) / (Lf - 1.f); o[a] = (acc[a][c] + bias) * __expf(-t * delta); ss[c] += o[a] * o[a]; }
            GAS float* dst = lat ? HT + (size_t)col * SEQ + pos0 + pg * 4 : HTC + (size_t)col * CTXL + pos0 + pg * 4;
            *(GAS f32x4*)dst = (f32x4){o[0], o[1], o[2], o[3]}; }
#pragma unroll
        for (int c = 0; c < 8; ++c) { float s = ss[c]; s += __shfl_xor(s, 1); s += __shfl_xor(s, 2); s += __shfl_xor(s, 4); s += __shfl_xor(s, 8); ss[c] = s; }
        if (pg == 0) { GAS float* na = nrm_acc(F, l, lat ? 0 : 1);
#pragma unroll
            for (int c = 0; c < 8; ++c) { const int col = cb * 256 + cg * 8 + c; (void)__hip_atomic_fetch_add(na + (col >> 9) * 256 + (col & 255), ss[c], RLX_AGENT); } }
        __syncthreads();
    }
}
constexpr int FFT_TW_OFF = 40960;
__device__ __forceinline__ void fft_tw_init(LAS unsigned char* lds, int tid) { if (tid < 128) ((LAS f32x2*)(lds + FFT_TW_OFF))[tid] = twid(-(float)tid * (1.f / 256.f)); __syncthreads(); }
__device__ __forceinline__ f32x2 cconj(f32x2 a) { return (f32x2){a.x, -a.y}; }
__device__ __forceinline__ f32x2 mul_mi(f32x2 a) { return (f32x2){a.y, -a.x}; }
__device__ __forceinline__ f32x2 mul_pi(f32x2 a) { return (f32x2){-a.y, a.x}; }
template <int ST>
__device__ __forceinline__ void dif4(LAS f32x2* X, const LAS f32x2* TW, int base, int g, int s) {
    const int h = 1 << s, p = g & ((h >> 1) - 1), i = (((g >> (s - 1)) << (s + 1)) | p);
    LAS f32x2* P0 = X + base + i * ST; LAS f32x2* P1 = P0 + (h >> 1) * ST; LAS f32x2* P2 = P0 + h * ST; LAS f32x2* P3 = P1 + h * ST;
    const f32x2 x0 = *P0, x1 = *P1, x2 = *P2, x3 = *P3, wa = TW[p << (7 - s)], wc = TW[p << (8 - s)];
    const f32x2 y0 = x0 + x2, y2 = cmul(x0 - x2, wa), y1 = x1 + x3, y3 = mul_mi(cmul(x1 - x3, wa));
    *P0 = y0 + y1; *P1 = cmul(y0 - y1, wc); *P2 = y2 + y3; *P3 = cmul(y2 - y3, wc);
}
template <int ST>
__device__ __forceinline__ void dit4(LAS f32x2* X, const LAS f32x2* TW, int base, int g, int s) {
    const int h = 1 << s, p = g & (h - 1), i = (((g >> s) << (s + 2)) | p);
    LAS f32x2* P0 = X + base + i * ST; LAS f32x2* P1 = P0 + h * ST; LAS f32x2* P2 = P1 + h * ST; LAS f32x2* P3 = P2 + h * ST;
    const f32x2 w1 = cconj(TW[p << (7 - s)]), w2 = cconj(TW[p << (6 - s)]);
    const f32x2 x0 = *P0, x1 = cmul(*P1, w1), x2 = *P2, x3 = cmul(*P3, w1);
    const f32x2 y0 = x0 + x1, y1 = x0 - x1, y2 = cmul(x2 + x3, w2), y3 = mul_pi(cmul(x2 - x3, w2));
    *P0 = y0 + y2; *P2 = y0 - y2; *P1 = y1 + y3; *P3 = y1 - y3;
}
__device__ __forceinline__ void fft128_cols_fwd(LAS f32x2* X, int tid) {
    const int j = tid & 31, q0 = tid >> 5; const LAS f32x2* TW = (const LAS f32x2*)((const LAS unsigned char*)X + FFT_TW_OFF);
#pragma unroll 1
    for (int s = 6; s >= 2; s -= 2) { dif4<32>(X, TW, j, q0, s); dif4<32>(X, TW, j, q0 + 16, s); __syncthreads(); }
#pragma unroll
    for (int i = 0; i < 4; ++i) { const int q = q0 + 16 * i; const f32x2 a = X[(2 * q) * 32 + j], b = X[(2 * q + 1) * 32 + j]; X[(2 * q) * 32 + j] = a + b; X[(2 * q + 1) * 32 + j] = a - b; }
    __syncthreads();
}
__device__ __forceinline__ void fft128_cols_inv(LAS f32x2* X, int tid) {
    const int j = tid & 31, q0 = tid >> 5; const LAS f32x2* TW = (const LAS f32x2*)((const LAS unsigned char*)X + FFT_TW_OFF);
#pragma unroll
    for (int i = 0; i < 4; ++i) { const int q = q0 + 16 * i; const f32x2 a = X[(2 * q) * 32 + j], b = X[(2 * q + 1) * 32 + j]; X[(2 * q) * 32 + j] = a + b; X[(2 * q + 1) * 32 + j] = a - b; }
    __syncthreads();
#pragma unroll 1
    for (int s = 1; s <= 5; s += 2) { dit4<32>(X, TW, j, q0, s); dit4<32>(X, TW, j, q0 + 16, s); __syncthreads(); }
}
__device__ __forceinline__ void fft256_rows_fwd(LAS f32x2* X, int tid) {
    const int g = tid & 63, r0 = tid >> 6; const LAS f32x2* TW = (const LAS f32x2*)((const LAS unsigned char*)X + FFT_TW_OFF);
#pragma unroll 1
    for (int s = 7; s >= 1; s -= 2) { dif4<1>(X, TW, r0 * 256, g, s); dif4<1>(X, TW, (r0 + 8) * 256, g, s); __syncthreads(); }
}
__device__ __forceinline__ void fft256_rows_inv(LAS f32x2* X, int tid) {
    const int g = tid & 63, r0 = tid >> 6; const LAS f32x2* TW = (const LAS f32x2*)((const LAS unsigned char*)X + FFT_TW_OFF);
#pragma unroll 1
    for (int s = 0; s <= 6; s += 2) { dit4<1>(X, TW, r0 * 256, g, s); dit4<1>(X, TW, (r0 + 8) * 256, g, s); __syncthreads(); }
}
__device__ __forceinline__ int bitrev7(int r) { return (int)(__brev((unsigned)r) >> 25); }
template <int KIND>
__device__ __forceinline__ void p_fft_pass1(const Frame& F0, int order, size_t ws_a) { const Frame F = launder(F0);
    fft_tw_init(F.lds, F.tid);
    LAS f32x2* X = (LAS f32x2*)F.lds; const int tid = F.tid, j = tid & 31, q0 = tid >> 5;
    const GAS float* VT = (const GAS float*)(F.ws + WS_VT); const GAS float* HT = (const GAS float*)(F.ws + WS_HT); GAS unsigned* A = (GAS unsigned*)(F.ws + ws_a);
    f32x2 pre[8];
#define P1_LOAD(uu) do { const int sg_ = (uu) >> 3, nb_ = (uu) & 7; _Pragma("unroll") for (int i = 0; i < 8; ++i) { const int n1 = q0 + 16 * i, n = 256 * n1 + 32 * nb_ + j; f32x2 v = {0.f, 0.f}; \
        if (KIND == 0) { if (n1 < 64) { v.x = VT[(size_t)(sg_ * 2 + 0) * SEQ + n]; v.y = VT[(size_t)(sg_ * 2 + 1) * SEQ + n]; } } \
        else { const GAS float* hf = HT + (size_t)(order * 512 + sg_) * SEQ; const GAS float* hb = HT + (size_t)(order * 512 + 256 + sg_) * SEQ; \
               if (n < SEQ) v.x = hf[n]; else if (n > SEQ) v.x = hb[2 * SEQ - n]; } \
        pre[i] = v; } } while (0)
    int u = blockIdx.x; if (u < 256 * 8) P1_LOAD(u);
    for (; u < 256 * 8; u += F.G) {
        const int sg = u >> 3, nb = u & 7;
#pragma unroll
        for (int i = 0; i < 8; ++i) X[(q0 + 16 * i) * 32 + j] = pre[i];
        __syncthreads();
        if (u + F.G < 256 * 8) P1_LOAD(u + F.G);
        fft128_cols_fwd(X, tid);
#pragma unroll
        for (int i = 0; i < 8; ++i) { const int r = q0 + 16 * i, k1 = bitrev7(r), n2 = 32 * nb + j;
            A[((size_t)sg * FN1 + r) * FN2 + n2] = pkc(cmul(X[r * 32 + j], twid(-(float)(n2 * k1) * (1.f / (float)FN)))); }
        __syncthreads();
    }
#undef P1_LOAD
}
template <int KIND>
__device__ __forceinline__ void p_fft_pass2(const Frame& F0, int l, int order, size_t ws_a) { const Frame F = launder(F0);
    fft_tw_init(F.lds, F.tid);
    LAS f32x2* X = (LAS f32x2*)F.lds; const int tid = F.tid;
    GAS unsigned* A = (GAS unsigned*)(F.ws + ws_a); GAS unsigned* HF = (GAS unsigned*)(F.ws + WS_HF);
    unsigned pa[8], ph[8];
#define P2_LOAD(uu) do { const int sg_ = (uu) >> 3, g_ = (uu) & 7; const GAS unsigned* Ab_ = A + ((size_t)sg_ * FN1 + g_ * 16) * FN2; const GAS unsigned* Hb_ = HF + ((size_t)(order * 256 + sg_) * FN1 + g_ * 16) * FN2; \
        _Pragma("unroll") for (int i = 0; i < 8; ++i) { pa[i] = Ab_[tid + NTHR * i]; if (KIND == 0) ph[i] = Hb_[tid + NTHR * i]; } } while (0)
    int u = blockIdx.x; if (u < 256 * 8) P2_LOAD(u);
    for (; u < 256 * 8; u += F.G) {
        const int sg = u >> 3, g = u & 7;
        GAS unsigned* Ab = A + ((size_t)sg * FN1 + g * 16) * FN2; GAS unsigned* Hb = HF + ((size_t)(order * 256 + sg) * FN1 + g * 16) * FN2;
        unsigned hcur[8];
#pragma unroll
        for (int i = 0; i < 8; ++i) { X[tid + NTHR * i] = upc(pa[i]); if (KIND == 0) hcur[i] = ph[i]; }
        __syncthreads();
        if (u + F.G < 256 * 8) P2_LOAD(u + F.G);
        fft256_rows_fwd(X, tid);
        if (KIND == 1) { const float nr = 1.f / sqrtf(nrm_acc(F, l, 0)[order * 256 + sg] + 1e-6f);
#pragma unroll
            for (int i = 0; i < 8; ++i) { const int e = tid + NTHR * i; const f32x2 v = X[e] * nr; const _Float16 hr = (_Float16)v.x, hi = (_Float16)v.y;
                Hb[e] = (unsigned)__builtin_bit_cast(unsigned short, hr) | ((unsigned)__builtin_bit_cast(unsigned short, hi) << 16); }
            __syncthreads();
        } else {
#pragma unroll
            for (int i = 0; i < 8; ++i) { const int e = tid + NTHR * i; const unsigned hw = hcur[i];
                const f32x2 h = {(float)__builtin_bit_cast(_Float16, (unsigned short)(hw & 0xffffu)), (float)__builtin_bit_cast(_Float16, (unsigned short)(hw >> 16))};
                X[e] = cmul(X[e], h); }
            __syncthreads();
            fft256_rows_inv(X, tid);
#pragma unroll
            for (int i = 0; i < 8; ++i) { const int e = tid + NTHR * i, r = g * 16 + (e >> 8), n2 = e & 255, k1 = bitrev7(r);
                Ab[e] = pkc(cmul(X[e], twid((float)(n2 * k1) * (1.f / (float)FN))) * (1.f / (float)FN)); }
            __syncthreads();
        }
    }
#undef P2_LOAD
}
__device__ __forceinline__ void p_fft_pass3(const Frame& F0, int l, int order) { const Frame F = launder(F0);
    fft_tw_init(F.lds, F.tid);
    LAS f32x2* X = (LAS f32x2*)F.lds; const int tid = F.tid, j = tid & 31, q0 = tid >> 5;
    GAS float* VT = (GAS float*)(F.ws + WS_VT); const GAS bf16* GT = (const GAS bf16*)(F.ws + (order == 0 ? WS_X1T : WS_X2T)); const GAS unsigned* A = (const GAS unsigned*)(F.ws + WS_FA);
    const GAS float* skip = F.in[I_HSKIP] + (size_t)(l * 2 + order) * 256;
    unsigned pa[8]; float pv[4][2]; unsigned short pg[4][2];
#define P3_LOAD(uu) do { const int sg_ = (uu) >> 3, nb_ = (uu) & 7; _Pragma("unroll") for (int i = 0; i < 8; ++i) pa[i] = A[((size_t)sg_ * FN1 + q0 + 16 * i) * FN2 + 32 * nb_ + j]; \
        _Pragma("unroll") for (int i = 0; i < 4; ++i) { const int n = 256 * (q0 + 16 * i) + 32 * nb_ + j; const size_t i0 = (size_t)(sg_ * 2 + 0) * SEQ + n, i1 = (size_t)(sg_ * 2 + 1) * SEQ + n; \
            pv[i][0] = VT[i0]; pv[i][1] = VT[i1]; pg[i][0] = GT[i0]; pg[i][1] = GT[i1]; } } while (0)
    int u = blockIdx.x; if (u < 256 * 8) P3_LOAD(u);
    for (; u < 256 * 8; u += F.G) {
        const int sg = u >> 3, nb = u & 7;
        float cv[4][2], cg[4][2];
#pragma unroll
        for (int i = 0; i < 8; ++i) X[(q0 + 16 * i) * 32 + j] = upc(pa[i]);
#pragma unroll
        for (int i = 0; i < 4; ++i) { cv[i][0] = pv[i][0]; cv[i][1] = pv[i][1]; cg[i][0] = bf2f(pg[i][0]); cg[i][1] = bf2f(pg[i][1]); }
        __syncthreads();
        if (u + F.G < 256 * 8) P3_LOAD(u + F.G);
        fft128_cols_inv(X, tid);
        const float sk = skip[sg];
#pragma unroll
        for (int i = 0; i < 4; ++i) { const int n1 = q0 + 16 * i, n = 256 * n1 + 32 * nb + j; const f32x2 y = X[n1 * 32 + j];
            const size_t i0 = (size_t)(sg * 2 + 0) * SEQ + n, i1 = (size_t)(sg * 2 + 1) * SEQ + n;
            VT[i0] = cg[i][0] * (y.x + sk * cv[i][0]); VT[i1] = cg[i][1] * (y.y + sk * cv[i][1]); }
        __syncthreads();
    }
#undef P3_LOAD
}
__device__ __forceinline__ void p_fft_pass31(const Frame& F0, int l) { const Frame F = launder(F0);
    fft_tw_init(F.lds, F.tid);
    LAS f32x2* X = (LAS f32x2*)F.lds; const int tid = F.tid, j = tid & 31, q0 = tid >> 5;
    GAS float* VT = (GAS float*)(F.ws + WS_VT); const GAS bf16* GT = (const GAS bf16*)(F.ws + WS_X1T); GAS unsigned* A = (GAS unsigned*)(F.ws + WS_FA);
    const GAS float* skip = F.in[I_HSKIP] + (size_t)(l * 2 + 0) * 256;
    unsigned pa[8]; float pv[4][2]; unsigned short pg[4][2];
#define P3_LOAD(uu) do { const int sg_ = (uu) >> 3, nb_ = (uu) & 7; _Pragma("unroll") for (int i = 0; i < 8; ++i) pa[i] = A[((size_t)sg_ * FN1 + q0 + 16 * i) * FN2 + 32 * nb_ + j]; \
        _Pragma("unroll") for (int i = 0; i < 4; ++i) { const int n = 256 * (q0 + 16 * i) + 32 * nb_ + j; const size_t i0 = (size_t)(sg_ * 2 + 0) * SEQ + n, i1 = (size_t)(sg_ * 2 + 1) * SEQ + n; \
            pv[i][0] = VT[i0]; pv[i][1] = VT[i1]; pg[i][0] = GT[i0]; pg[i][1] = GT[i1]; } } while (0)
    int u = blockIdx.x; if (u < 256 * 8) P3_LOAD(u);
    for (; u < 256 * 8; u += F.G) {
        const int sg = u >> 3, nb = u & 7;
        float cv[4][2], cg[4][2];
#pragma unroll
        for (int i = 0; i < 8; ++i) X[(q0 + 16 * i) * 32 + j] = upc(pa[i]);
#pragma unroll
        for (int i = 0; i < 4; ++i) { cv[i][0] = pv[i][0]; cv[i][1] = pv[i][1]; cg[i][0] = bf2f(pg[i][0]); cg[i][1] = bf2f(pg[i][1]); }
        __syncthreads();
        if (u + F.G < 256 * 8) P3_LOAD(u + F.G);
        fft128_cols_inv(X, tid);
        const float sk = skip[sg];
#pragma unroll
        for (int i = 0; i < 4; ++i) { const int n1 = q0 + 16 * i, n = 256 * n1 + 32 * nb + j; const f32x2 y = X[n1 * 32 + j];
            const size_t i0 = (size_t)(sg * 2 + 0) * SEQ + n, i1 = (size_t)(sg * 2 + 1) * SEQ + n;
            const f32x2 z = {cg[i][0] * (y.x + sk * cv[i][0]), cg[i][1] * (y.y + sk * cv[i][1])};
            VT[i0] = z.x; VT[i1] = z.y; X[n1 * 32 + j] = z; X[(n1 + 64) * 32 + j] = (f32x2){0.f, 0.f}; }
        __syncthreads();
        fft128_cols_fwd(X, tid);
#pragma unroll
        for (int i = 0; i < 8; ++i) { const int r = q0 + 16 * i, k1 = bitrev7(r), n2 = 32 * nb + j;
            A[((size_t)sg * FN1 + r) * FN2 + n2] = pkc(cmul(X[r * 32 + j], twid(-(float)(n2 * k1) * (1.f / (float)FN)))); }
        __syncthreads();
    }
#undef P3_LOAD
}
__device__ __forceinline__ void p_hy_shortconv(const Frame& F0, int l) { const Frame F = launder(F0);
    LAS bf16* IN = (LAS bf16*)F.lds; LAS float* OT = (LAS float*)(F.lds + 66 * 256 * 2 + 64); const int tid = F.tid;
    const GAS bf16* PH = (const GAS bf16*)(F.ws + WS_PH); GAS float* VT = (GAS float*)(F.ws + WS_VT); GAS bf16* X1T = (GAS bf16*)(F.ws + WS_X1T); GAS bf16* X2T = (GAS bf16*)(F.ws + WS_X2T); GAS float* CU = (GAS float*)(F.ws + WS_CU);
    const GAS float* cw = F.in[I_HCW] + (size_t)l * 3 * 768; const GAS float* cb = F.in[I_HCB] + (size_t)l * 768;
    const int nlat = NBATCH * (SEQ / 64) * 3, nctx = NBATCH * (CTXL / 64) * 3;
    for (int u = blockIdx.x; u < nlat + nctx; u += F.G) {
        const bool lat = u < nlat; const int uu = lat ? u : u - nlat; const int grp = uu % 3, tile = (uu / 3) % (lat ? SEQ / 64 : CTXL / 64), b = (uu / 3) / (lat ? SEQ / 64 : CTXL / 64);
        const int Ls = lat ? SEQ : CTXL, t0 = tile * 64; const size_t rowb = lat ? (size_t)b * SEQ : (size_t)TL + b * CTXL;
        for (int i = tid; i < 66 * 32; i += NTHR) { const int rr = i >> 5, c8 = (i & 31) * 8, t = t0 + rr - 1; v4u w = {0u, 0u, 0u, 0u};
            if (t >= 0 && t < Ls) w = *(const GAS v4u*)(PH + (rowb + t) * NPH + PH_HY + grp * 256 + c8);
            *(LAS v4u*)(IN + rr * 256 + c8) = w; }
        __syncthreads();
        { const int c = tid & 255, th = tid >> 8, ch = grp * 256 + c; const float w0 = cw[ch], w1 = cw[768 + ch], w2 = cw[1536 + ch], bb = cb[ch];
          float a = bf2f(IN[(th * 32) * 256 + c]), m = bf2f(IN[(th * 32 + 1) * 256 + c]);
          for (int i = 0; i < 32; ++i) { const float n = bf2f(IN[(th * 32 + i + 2) * 256 + c]); const float y = bb + a * w0 + m * w1 + n * w2; a = m; m = n;
              if (lat) OT[c * 65 + th * 32 + i] = y; else CU[((size_t)b * CTXL + t0 + th * 32 + i) * 768 + ch] = y; } }
        __syncthreads();
        if (lat) { const int t4 = (tid & 15) * 4;
#pragma unroll
            for (int i = 0; i < 8; ++i) { const int c = (tid >> 4) + 32 * i; const LAS float* s = OT + c * 65 + t4; const size_t o = (size_t)(c * 2 + b) * SEQ + t0 + t4;
                if (grp == 0) *(GAS f32x4*)(VT + o) = (f32x4){s[0], s[1], s[2], s[3]};
                else { v2u w; w.x = pk2(s[0], s[1]); w.y = pk2(s[2], s[3]); *(GAS v2u*)((grp == 1 ? X1T : X2T) + o) = w; } } }
        __syncthreads();
    }
}
__device__ __forceinline__ void p_hy_ctx(const Frame& F0, int l) { const Frame F = launder(F0);
    LAS float* L = (LAS float*)F.lds; const int tid = F.tid, t = tid & 255, cs = tid >> 8;
    LAS float* SV = L + cs * 1280, * HFW = SV + 256, * HBW = SV + 512, * HF2 = SV + 768, * HB2 = SV + 1024;
    const GAS float* CU = (const GAS float*)(F.ws + WS_CU); const GAS float* HTC = (const GAS float*)(F.ws + WS_HTC); GAS float* OTC = (GAS float*)(F.ws + WS_OTC);
    for (int u = blockIdx.x; u < NBATCH * 128; u += F.G) {
        const int b = u >> 7, c = (u & 127) * 2 + cs;
        const float n0 = 1.f / sqrtf(nrm_acc(F, l, 1)[c] + 1e-6f), n1 = 1.f / sqrtf(nrm_acc(F, l, 1)[256 + c] + 1e-6f);
        const GAS float* cu = CU + ((size_t)b * CTXL + t) * 768;
        const float v = cu[c], x1 = cu[256 + c], x2 = cu[512 + c];
        SV[t] = v; HFW[t] = HTC[(size_t)(0 + c) * CTXL + t] * n0; HBW[t] = HTC[(size_t)(256 + c) * CTXL + t] * n0; HF2[t] = HTC[(size_t)(512 + c) * CTXL + t] * n1; HB2[t] = HTC[(size_t)(768 + c) * CTXL + t] * n1;
        __syncthreads();
        float y = F.in[I_HSKIP][(l * 2 + 0) * 256 + c] * v;
        for (int s = 0; s <= t; ++s) y += HFW[t - s] * SV[s];
        for (int s = t + 1; s < CTXL; ++s) y += HBW[s - t] * SV[s];
        const float z = x1 * y;
        __syncthreads();
        SV[t] = z;
        __syncthreads();
        float y2 = F.in[I_HSKIP][(l * 2 + 1) * 256 + c] * z;
        for (int s = 0; s <= t; ++s) y2 += HF2[t - s] * SV[s];
        for (int s = t + 1; s < CTXL; ++s) y2 += HB2[s - t] * SV[s];
        OTC[((size_t)b * CTXL + t) * 256 + c] = x2 * y2;
        __syncthreads();
    }
}
__device__ __forceinline__ void p_ynorm_b(const Frame& F0, int l, bool with_ctx) { const Frame F = launder(F0);
    LAS float* T = (LAS float*)F.lds; LAS float* RS = T + 256 * 65; LAS float* PS = RS + 64; const int tid = F.tid;
    const GAS float* VT = (const GAS float*)(F.ws + WS_VT); const GAS float* OTC = (const GAS float*)(F.ws + WS_OTC); GAS bf16* Y = (GAS bf16*)(F.ws + WS_Y); const GAS float* hg = F.in[I_HNG] + l * 256;
    const int nlat = NBATCH * (SEQ / 64), nctx = with_ctx ? NBATCH * (CTXL / 64) : 0;
    for (int u = blockIdx.x; u < nlat + nctx; u += F.G) {
        const bool lat = u < nlat; const int uu = lat ? u : u - nlat, b = lat ? uu / (SEQ / 64) : uu / (CTXL / 64), t0 = (lat ? uu % (SEQ / 64) : uu % (CTXL / 64)) * 64;
        const size_t rowb = lat ? (size_t)b * SEQ + t0 : (size_t)TL + b * CTXL + t0;
        if (lat) { const int t4 = (tid & 15) * 4;
#pragma unroll
            for (int i = 0; i < 8; ++i) { const int c = (tid >> 4) + 32 * i; const f32x4 v = *(const GAS f32x4*)(VT + (size_t)(c * 2 + b) * SEQ + t0 + t4); LAS float* d = T + c * 65 + t4; d[0] = v.x; d[1] = v.y; d[2] = v.z; d[3] = v.w; } }
        else { for (int i = tid; i < 64 * 256; i += NTHR) { const int t = i >> 8, c = i & 255; T[c * 65 + t] = OTC[((size_t)b * CTXL + t0 + t) * 256 + c]; } }
        __syncthreads();
        { const int t = tid & 63, part = tid >> 6; float s = 0.f;
          for (int c = part * 32; c < part * 32 + 32; ++c) { const float v = T[c * 65 + t]; s += v * v; }
          PS[part * 64 + t] = s; }
        __syncthreads();
        if (tid < 64) { float s = 0.f;
#pragma unroll
            for (int p = 0; p < 8; ++p) s += PS[p * 64 + tid];
            RS[tid] = 1.f / sqrtf(s * (1.f / 256.f) + RMS_EPS); }
        __syncthreads();
        { const int t = tid >> 3, c0 = (tid & 7) * 8; const float rs = RS[t];
#pragma unroll
          for (int i = 0; i < 4; ++i) { const int c = c0 + 64 * i; float y[8];
#pragma unroll
              for (int e = 0; e < 8; ++e) y[e] = T[(c + e) * 65 + t] * rs * hg[c + e];
              v4u o; o.x = pk2(y[0], y[1]); o.y = pk2(y[2], y[3]); o.z = pk2(y[4], y[5]); o.w = pk2(y[6], y[7]);
              *(GAS v4u*)(Y + (rowb + t) * D + 256 + c) = o; } }
        __syncthreads();
    }
}

enum LP { LP_IN = 0, LP_PREP, LP_GLA2, LP_GLA3, LP_HY0, LP_HY1, LP_HY2, LP_HY3, LP_HY4, LP_HY5, LP_HY6, LP_HY7, LP_ATT, LP_YN, LP_OUT, LP_LN1, LP_F1, LP_F2, LP_M0  , LP_LN2 = LP_M0 + 9, PPL };
constexpr int NPRO = 4;
constexpr int NPHASE = NPRO + DEPTH * PPL;
template <int l>
__device__ __forceinline__ void layer_phases(const Frame& F, const XcdBarrier& bar, const int lo, const int hi) {
#define IN(k) (lo <= (k) && (k) < hi)
#define SEAM(k) do { if ((k) + 1 < hi) xcd_barrier(bar); } while (0)
    LAS unsigned char* ring = F.lds;
    constexpr int pb = NPRO + l * PPL;
#define lng (F.in[I_LNG] + (size_t)l * 2 * D)
#define lnb (F.in[I_LNB] + (size_t)l * 2 * D)
        if (IN(pb + LP_IN)) { const Frame P = launder(F);
            pg8::Gemm g{(const GAS bf16*)(P.ws + WS_XN), (const GAS bf16*)(P.ws + WS_WIN) + (size_t)l * NPH * D, MR, NPH, D, D, 0};
            pg8::StaticOrder S; S.init(MR, NPH, F.G, (int)blockIdx.x);
            EpiStoreBf16 E{(GAS bf16*)(P.ws + WS_PH), NPH, 1.f};
            pg8::gemm_phase<EpiStoreBf16, pg8::StaticOrder, true, true>(ring, g, S, E);
            SEAM(pb + LP_IN);
        }
        if (IN(pb + LP_PREP)) { const Frame P = launder(F); p_prep_mla_rows(F); p_gla_local(F, l);
            p_hy_shortconv(F, l); SEAM(pb + LP_PREP); }
        if (IN(pb + LP_GLA2)) { const Frame P = launder(F);
            { pg8::Gemm g{(const GAS bf16*)(P.ws + WS_PH) + PH_CQ, (const GAS bf16*)(P.ws + WS_WUQ) + (size_t)l * 768 * 256, MR, 768, 256, NPH, 0};
              pg8::StaticOrder S; S.init(MR, 768, F.G, (int)blockIdx.x);
              EpiMlaQ E{P.ws + WS_Q, P.ws + WS_QC, (const GAS float*)(P.ws + WS_RSQ), (const GAS float*)(P.ws + WS_ROPE)};
              pg8::gemm_phase<EpiMlaQ, pg8::StaticOrder, true, true>(ring, g, S, E); }
            { pg8::Gemm g{(const GAS bf16*)(P.ws + WS_PH) + PH_CKV, (const GAS bf16*)(P.ws + WS_WUKV) + (size_t)l * 1024 * 256, MR, 1024, 256, NPH, 0};
              pg8::StaticOrder S; S.init(MR, 1024, F.G, (int)blockIdx.x);
              EpiMlaKV E{P.ws + WS_K, (GAS bf16*)(P.ws + WS_V), (const GAS float*)(P.ws + WS_RSKV)};
              pg8::gemm_phase<EpiMlaKV, pg8::StaticOrder, true, true>(ring, g, S, E); }
            p_gla_scan(F); p_fft_pass1<0>(F, 0, WS_FA);
            SEAM(pb + LP_GLA2);
        }
        if (IN(pb + LP_GLA3)) { const Frame P = launder(F); p_gla_out(F, l, l == 0); p_attn_vt_pack(F); p_fft_pass2<0>(F, l, 0, WS_FA); if constexpr (l == 0) p_hy_ctx(F, l);
            SEAM(pb + LP_GLA3); }
        if (IN(pb + LP_HY0)) { p_fft_pass31(F, l); SEAM(pb + LP_HY0); }
        if (IN(pb + LP_HY1)) { p_fft_pass2<0>(F, l, 1, WS_FA); SEAM(pb + LP_HY1); }
        if (IN(pb + LP_HY2)) { p_fft_pass3(F, l, 1); SEAM(pb + LP_HY2); }
        if (IN(pb + LP_ATT)) { const Frame P = launder(F); p_attention(F, l == 0);
            SEAM(pb + LP_ATT); }
        if (IN(pb + LP_YN)) { const Frame P = launder(F); p_ynorm_c(F, l == 0 ? MR : TL, F.in[I_MNG] + (size_t)l * 512); p_ynorm_b(F, l, l == 0); if constexpr (l == 0) p_filt_hidden(F, 1); SEAM(pb + LP_YN); }
        if (IN(pb + LP_OUT)) { const Frame P = launder(F);
            const int M = (l == 0) ? MR : TL;
            pg8::Gemm g{(const GAS bf16*)(P.ws + WS_Y), (const GAS bf16*)(P.ws + WS_WOUT) + (size_t)l * D * D, M, D, D, D, 0};
            pg8::StaticOrder S; S.init(M, D, F.G, (int)blockIdx.x);
            EpiRes E{l == 0 ? F.in[I_X] : F.out, l == 0 ? F.in[I_CTX] : (const GAS float*)(P.ws + WS_XC), F.out, (GAS float*)(P.ws + WS_XC), modv(F, l, 0, 2)};
            pg8::gemm_phase<EpiRes, pg8::StaticOrder, true, true>(ring, g, S, E);
            if constexpr (l == 0) p_filt_raw(F, 1);
            SEAM(pb + LP_OUT);
        }
        if (IN(pb + LP_LN1)) { const Frame P = launder(F);
            if constexpr (l == 0) { p_ln(F, MR, lng, lnb, true, l, 3); p_fft_pass1<1>(F, 0, WS_FA0); p_fft_pass1<1>(F, 1, WS_FA1); }
            else { p_ln_route(F, lng, lnb, l); p_moe_weights(F); }
            SEAM(pb + LP_LN1);
        }
        if constexpr (l == 0) {
            if (IN(pb + LP_F1)) { const Frame P = launder(F);
                pg8::Gemm g{(const GAS bf16*)(P.ws + WS_XN), (const GAS bf16*)(P.ws + WS_W13), MR, 2 * DFF, D, D, 0};
                pg8::StaticOrder S; S.init(MR, 2 * DFF, F.G, (int)blockIdx.x);
                EpiSwiglu E{(GAS bf16*)(P.ws + WS_G), DFF, 1.f};
                pg8::gemm_phase<EpiSwiglu, pg8::StaticOrder, true, true>(ring, g, S, E);
                p_fft_pass2<1>(F, 1, 0, WS_FA0); p_fft_pass2<1>(F, 1, 1, WS_FA1);
                SEAM(pb + LP_F1);
            }
            if (IN(pb + LP_F2)) { const Frame P = launder(F);
                pg8::Gemm g{(const GAS bf16*)(P.ws + WS_G), (const GAS bf16*)(P.ws + WS_W2), MR, D, DFF, DFF, 0};
                pg8::StaticOrder S; S.init(MR, D, F.G, (int)blockIdx.x);
                EpiRes E{F.out, (const GAS float*)(P.ws + WS_XC), F.out, (GAS float*)(P.ws + WS_XC), modv(F, l, 0, 5)};
                pg8::gemm_phase<EpiRes, pg8::StaticOrder, true, true>(ring, g, S, E);
                SEAM(pb + LP_F2);
            }
            if (IN(pb + LP_LN2)) { const Frame P = launder(F); p_ln(F, MR, lng + D, lnb + D, true, l + 1, 0); SEAM(pb + LP_LN2); }
        } else {
            if (IN(pb + LP_F1)) { const Frame P = launder(F); p_moe_scatter(F); SEAM(pb + LP_F1); }
            for (int ch = 0; ch < MOE_NCHUNK; ++ch) {
                if (IN(pb + LP_F2 + 2 * ch)) { const Frame P = launder(F);
                    moe_base_to_lds(P);
                    pg8::Gemm g{(const GAS bf16*)(P.ws + WS_HS8 + (size_t)ch * MOE_CHUNK_TILES * 256 * D), (const GAS bf16*)(P.ws + WS_WM13), MOE_CHUNK_TILES * 256, 2 * EFF, D / 2, D / 2, (size_t)2 * EFF * D};
                    MoeOrder S; S.init((const LAS int*)(F.lds + LDS_MOEBT), ch, 2 * EFF / 256, F.G, (int)blockIdx.x);
                    EpiSwiglu8 E{P.ws + WS_GC, EFF, 1.f / MOE_WSCALE, MOE_GSCALE};
                    pg8::gemm_phase<EpiSwiglu8, MoeOrder, true, true, true>(ring, g, S, E);
                    SEAM(pb + LP_F2 + 2 * ch);
                }
                if (IN(pb + LP_F2 + 2 * ch + 1)) { const Frame P = launder(F);
                    moe_base_to_lds(P);
                    pg8::Gemm g{(const GAS bf16*)(P.ws + WS_GC), (const GAS bf16*)(P.ws + WS_WM2), MOE_CHUNK_TILES * 256, D, EFF / 2, EFF / 2, (size_t)D * EFF};
                    MoeOrder S; S.init((const LAS int*)(F.lds + LDS_MOEBT), ch, D / 256, F.G, (int)blockIdx.x);
                    EpiStoreBf16 E{(GAS bf16*)(P.ws + WS_HS) + (size_t)ch * MOE_CHUNK_TILES * 256 * D, D, 1.f / (MOE_GSCALE * MOE_W2SCALE)};
                    pg8::gemm_phase<EpiStoreBf16, MoeOrder, true, true, true>(ring, g, S, E);
                    SEAM(pb + LP_F2 + 2 * ch + 1);
                }
            }
            if (IN(pb + LP_LN2)) { const Frame P = launder(F); p_ln_combine(F, lng + D, lnb + D, l); SEAM(pb + LP_LN2); }
        }

#undef lng
#undef lnb
#undef IN
#undef SEAM
}
__global__ void __launch_bounds__(NTHR, 2) mega(Args args) {
    extern __shared__ __attribute__((aligned(16))) unsigned char lds_raw[];
    Frame F;
    F.lds = (LAS unsigned char*)lds_raw; F.ws = args.ws; F.ctl = (gu32*)(args.ws + WS_CTL); F.in = (const GAS float* const GAS*)(args.ws + WS_PTRTAB); F.out = args.out;
    F.tid = threadIdx.x; F.lane = F.tid & 63; F.wave = __builtin_amdgcn_readfirstlane(F.tid >> 6); F.G = gridDim.x;
    F.gw = blockIdx.x * NWAVES + F.wave; F.ngw = F.G * NWAVES;
    volatile LAS unsigned* MISC = (volatile LAS unsigned*)(F.lds + LDS_MISC);
    if (F.tid < 32) MISC[F.tid] = 0u;
    __syncthreads();
    XcdBarrier bar; bar.bar = (unsigned*)(F.ctl + CW_BAR); bar.x = 0; bar.st = nullptr;
#if !MK_PER_PHASE
    bar = xcd_barrier_post((unsigned*)(F.ctl + CW_BAR), MISC + 8);
#endif
    const int lo = args.ph_lo, hi = args.ph_hi;
#define IN(k) (lo <= (k) && (k) < hi)
#define SEAM(k) do { if ((k) + 1 < hi) xcd_barrier(bar); } while (0)
    LAS unsigned char* ring = F.lds;
#define LTID() ({ int t_ = F.tid; asm volatile("" : "+v"(t_)); t_; })

    if (IN(0)) { Frame FK = F; FK.in = (const GAS float* const GAS*)(const GAS void*)args.in;
        if (blockIdx.x == 0 && F.tid < 37) ((const GAS float* GAS*)(args.ws + WS_PTRTAB))[F.tid] = args.in[F.tid];
        p0_modv(FK); p0_weights(FK); p0_rope_table(FK); __syncthreads();     p_filt_hidden(FK, 0);
        SEAM(0); }
    if (IN(1)) { p_xn0(F); p_filt_raw(F, 0);
        SEAM(1); }
    if (IN(2)) { p_fft_pass1<1>(F, 0, WS_FA0); p_fft_pass1<1>(F, 1, WS_FA1); SEAM(2); }
    if (IN(3)) { p_fft_pass2<1>(F, 0, 0, WS_FA0); p_fft_pass2<1>(F, 0, 1, WS_FA1); SEAM(3); }

    layer_phases<0>(F, bar, lo, hi);
    layer_phases<1>(F, bar, lo, hi);
#undef IN
#undef SEAM
}

extern "C" void kernel_launch(void* const* d_in, const int* in_sizes, int n_in, void* d_out, int out_size, void* d_ws, size_t ws_size, hipStream_t stream) {
    static int grid = 0;
    if (grid == 0) {
        if (n_in != 37 || in_sizes[0] != TL * D || out_size != TL * D || ws_size < WS_END2) { fprintf(stderr, "kernel_launch: shape/workspace mismatch (n_in %d in0 %d out %d ws %zu need %zu)\n", n_in, n_in > 0 ? in_sizes[0] : -1, out_size, ws_size, (size_t)WS_END2); grid = -1; return; }
        int dev = 0, cus = 0, per_cu = 0;
        if (hipGetDevice(&dev) != hipSuccess || hipDeviceGetAttribute(&cus, hipDeviceAttributeMultiprocessorCount, dev) != hipSuccess) { grid = -1; return; }
        if (hipFuncSetAttribute((const void*)mega, hipFuncAttributeMaxDynamicSharedMemorySize, LDS_BYTES) != hipSuccess) { fprintf(stderr, "kernel_launch: hipFuncSetAttribute failed\n"); grid = -1; return; }
        if (hipOccupancyMaxActiveBlocksPerMultiprocessor(&per_cu, (const void*)mega, NTHR, LDS_BYTES) != hipSuccess || per_cu < 1) { fprintf(stderr, "kernel_launch: occupancy query says %d\n", per_cu); }
        (void)hipGetLastError();
        grid = cus;
    }
    if (grid < 0) return;
    if (hipMemsetAsync((char*)d_ws + WS_CTL, 0, CTL_ZERO_BYTES, stream) != hipSuccess) return;
    Args a{};
    for (int i = 0; i < 37; ++i) a.in[i] = (const GAS float*)d_in[i];
    a.out = (GAS float*)d_out; a.ws = (GAS unsigned char*)d_ws;
#if MK_PER_PHASE
    for (int p = 0; p < NPHASE; ++p) { a.ph_lo = p; a.ph_hi = p + 1; hipLaunchKernelGGL(mega, dim3(grid), dim3(NTHR), LDS_BYTES, stream, a); }
#else
    a.ph_lo = 0; a.ph_hi = NPHASE;
    hipLaunchKernelGGL(mega, dim3(grid), dim3(NTHR), LDS_BYTES, stream, a);
#endif
    const hipError_t le = hipPeekAtLastError();
    if (le != hipSuccess) fprintf(stderr, "kernel_launch: launch failed: %s\n", hipGetErrorName(le));
}
```

```cpp
#include <hip/hip_runtime.h>
#include <cstdio>
#include <cstdint>
namespace pg8 {
#define PG8_LAS __attribute__((address_space(3)))
#define PG8_GAS __attribute__((address_space(1)))
typedef unsigned short bf16_t;
typedef short bf16x8 __attribute__((ext_vector_type(8)));
typedef float f32x4 __attribute__((ext_vector_type(4)));
typedef unsigned u32x4 __attribute__((ext_vector_type(4)));
typedef int i32x8_t __attribute__((ext_vector_type(8)));
typedef short bf16x16 __attribute__((ext_vector_type(16)));
constexpr int BM = 256, BK = 64, HALF = 128, HTB = HALF * BK * 2  , STAGE_BYTES = 8 * HTB, NXCD = 8, WGM = 8;

__host__ __device__ __forceinline__ int lds_byte(int r, int c) { const int st = (r >> 4) * 2 + (c >> 5), rr = r & 15, cc = c & 31, ob = rr * 64 + cc * 2; return st * 1024 + (ob ^ (((ob >> 9) & 1) << 5)); }
__host__ __device__ __forceinline__ void stage_rc(int b, int& R, int& C) { const int st = b / 1024, sb = b % 1024, swz = sb ^ (((sb >> 9) & 1) << 5); R = (st >> 1) * 16 + swz / 64; C = (st & 1) * 32 + (swz % 64) / 2; }
__host__ __device__ __forceinline__ int perm32(int rho) { const int n = rho >> 4, i = rho & 15; return 8 * (i >> 2) + 4 * n + (i & 3); }

struct Unit { int pm, pn, be; };
struct Gemm { const PG8_GAS bf16_t* A; const PG8_GAS bf16_t* Bt; int M, N, K; int lda; size_t bstride; };

struct StaticOrder {
    int nM, nN, nwg, G, c;
    __host__ __device__ void init(int M, int N, int G_, int c_) { nM = M / BM; nN = N / BM; nwg = nM * nN; G = G_; c = c_; }
    __host__ __device__ bool next(int i, Unit& u) const {
        const long L = (long)i * G + c; if (L >= nwg) return false;
        int wgid = (int)L; { const int q = nwg / NXCD, r = nwg % NXCD, xcd = wgid % NXCD, off = wgid / NXCD; wgid = (xcd < r ? xcd * (q + 1) : r * (q + 1) + (xcd - r) * q) + off; }
        const int nig = WGM * nN, gid = wgid / nig, fm = gid * WGM, gsz = (nM - fm) < WGM ? (nM - fm) : WGM;
        u.pm = fm + ((wgid % nig) % gsz); u.pn = (wgid % nig) / gsz; u.be = 0; return true;
    }
    __device__ __forceinline__ void a_ready(const Unit&) const {}
    __device__ __forceinline__ void done(const Unit&) const {}
};


__device__ __forceinline__ unsigned cvt_pk_bf16(float lo, float hi) { unsigned r; asm volatile("v_cvt_pk_bf16_f32 %0, %1, %2" : "=v"(r) : "v"(lo), "v"(hi)); return r; }
typedef float f32x2 __attribute__((ext_vector_type(2)));
typedef unsigned u32x2 __attribute__((ext_vector_type(2)));

template <class Epi, class Sched, bool ALIGN_EPI = false, bool SP2 = false, bool F8 = false>
__device__ __forceinline__ void gemm_phase(PG8_LAS unsigned char* lds, const Gemm g, const Sched& S, const Epi& E) {
    { unsigned lb_ = (unsigned)(size_t)lds; asm volatile("" : "+s"(lb_)); lds = (PG8_LAS unsigned char*)(size_t)lb_; }
    int tid_ = threadIdx.x; asm volatile("" : "+v"(tid_));
    const int tid = tid_, wid = __builtin_amdgcn_readfirstlane(tid >> 6), lane = tid & 63, wr = wid >> 2, wc = wid & 3, fr = lane & 15, fq = lane >> 4;
    int K_ = g.K; asm volatile("" : "+s"(K_)); const int K = K_, nt = K / BK;
    unsigned voffA[2], voffB[2];
#pragma unroll
    for (int i = 0; i < 2; ++i) { int R, C; stage_rc(tid * 16 + i * 8192, R, C); const int Rb = Epi::PERM ? ((R & ~31) + perm32(R & 31)) : R;
        voffA[i] = (unsigned)(R * g.lda + C) * 2u; voffB[i] = (unsigned)(Rb * K + C) * 2u; }
    const size_t kstep = (size_t)(BK * 2);
    const size_t hstepB = (size_t)HALF * K * 2, hstepA = (size_t)HALF * g.lda * 2;
    const size_t tstepA = 2 * hstepA, tstepB = 2 * hstepB;
    const unsigned ldsw = (unsigned)wid * 1024u;
    const int aoff = lds_byte(wr * 64 + fr, fq * 8), boff = lds_byte(wc * 32 + fr, fq * 8);
#define PG8_SA(b, h) (((b) * 2 + (h)) * HTB)
#define PG8_SB(b, h) ((4 + (b) * 2 + (h)) * HTB)
#define PG8_STAGE(bufoff, gbase, voff) do { _Pragma("unroll") for (int _i = 0; _i < 2; ++_i) \
        __builtin_amdgcn_global_load_lds((const PG8_GAS unsigned*)((const PG8_GAS char*)(gbase) + (voff)[_i]), (PG8_LAS unsigned*)(lds + (bufoff) + ldsw + _i * 8192), 16, 0, 0); } while (0)
#define PG8_LDA(dst, b, h) do { _Pragma("unroll") for (int m = 0; m < 4; ++m) dst[m] = __builtin_shufflevector(*(const PG8_LAS bf16x8*)(lds + PG8_SA(b, h) + aoff + m * 2048), *(const PG8_LAS bf16x8*)(lds + PG8_SA(b, h) + aoff + m * 2048 + 1024), 0, 1, 2, 3, 4, 5, 6, 7, 8, 9, 10, 11, 12, 13, 14, 15); } while (0)
#define PG8_LDB(dst, b, h) do { _Pragma("unroll") for (int n = 0; n < 2; ++n) dst[n] = __builtin_shufflevector(*(const PG8_LAS bf16x8*)(lds + PG8_SB(b, h) + boff + n * 2048), *(const PG8_LAS bf16x8*)(lds + PG8_SB(b, h) + boff + n * 2048 + 1024), 0, 1, 2, 3, 4, 5, 6, 7, 8, 9, 10, 11, 12, 13, 14, 15); } while (0)
#define PG8_HALF(x, k) ((k) == 0 ? __builtin_shufflevector(x, x, 0, 1, 2, 3, 4, 5, 6, 7) : __builtin_shufflevector(x, x, 8, 9, 10, 11, 12, 13, 14, 15))
#define PG8_MMA(ai, bj, At, Bt) do { __builtin_amdgcn_s_setprio(1); if constexpr (F8) { _Pragma("unroll") for (int m = 0; m < 4; ++m) _Pragma("unroll") for (int n = 0; n < 2; ++n) \
        asm volatile("v_mfma_f32_16x16x128_f8f6f4 %0, %1, %2, %0" : "+v"(acc[ai][bj][m][n]) : "v"(__builtin_bit_cast(i32x8_t, Bt[n])), "v"(__builtin_bit_cast(i32x8_t, At[m]))); } \
    else { _Pragma("unroll") for (int m = 0; m < 4; ++m) _Pragma("unroll") for (int n = 0; n < 2; ++n) _Pragma("unroll") for (int k = 0; k < 2; ++k) \
        acc[ai][bj][m][n] = __builtin_amdgcn_mfma_f32_16x16x32_bf16(PG8_HALF(Bt[n], k), PG8_HALF(At[m], k), acc[ai][bj][m][n], 0, 0, 0); } __builtin_amdgcn_s_setprio(0); } while (0)
#define PG8_F8_DRAIN() do { if constexpr (F8) asm volatile("s_nop 15\n\ts_nop 15" ::: "memory"); } while (0)
#define PG8_WAIT_V(n) asm volatile("s_waitcnt vmcnt(" #n ")" ::: "memory")
#define PG8_WAIT_L(n) asm volatile("s_waitcnt lgkmcnt(" #n ")" ::: "memory")
#define PG8_BAR __builtin_amdgcn_s_barrier()
#define PG8_SCHED __builtin_amdgcn_sched_barrier(0)
    Unit cur, nxt; int ui = 0;
    if (!S.next(0, cur)) return;
    f32x4 acc[2][2][4][2];
#pragma unroll
    for (int a = 0; a < 2; ++a)
#pragma unroll
        for (int b = 0; b < 2; ++b)
#pragma unroll
            for (int m = 0; m < 4; ++m)
#pragma unroll
                for (int n = 0; n < 2; ++n) acc[a][b][m][n] = (f32x4){0.f, 0.f, 0.f, 0.f};
    bf16x16 At[4], B0[2], B1[2];
    const PG8_GAS char* cA = (const PG8_GAS char*)g.A + (size_t)cur.pm * tstepA; const PG8_GAS char* cB = (const PG8_GAS char*)g.Bt + (size_t)cur.be * g.bstride + (size_t)cur.pn * tstepB;
    S.a_ready(cur);
    if constexpr (SP2) {
        PG8_STAGE(PG8_SB(0, 0), cB, voffB); PG8_STAGE(PG8_SB(0, 1), cB + hstepB, voffB); PG8_STAGE(PG8_SA(0, 0), cA, voffA); PG8_STAGE(PG8_SA(0, 1), cA + hstepA, voffA);
        if (wr == 1) PG8_BAR;
        PG8_WAIT_V(2); PG8_BAR;
        PG8_STAGE(PG8_SB(1, 0), cB + kstep, voffB); PG8_STAGE(PG8_SA(1, 0), cA + kstep, voffA); PG8_STAGE(PG8_SB(1, 1), cB + hstepB + kstep, voffB);
        PG8_WAIT_V(6); PG8_BAR;
    } else {
        PG8_STAGE(PG8_SB(0, 0), cB, voffB); PG8_STAGE(PG8_SA(0, 0), cA, voffA); PG8_STAGE(PG8_SB(0, 1), cB + hstepB, voffB); PG8_STAGE(PG8_SA(0, 1), cA + hstepA, voffA);
        if (wr == 1) PG8_BAR;
        PG8_WAIT_V(4); PG8_BAR;
        PG8_STAGE(PG8_SB(1, 0), cB + kstep, voffB); PG8_STAGE(PG8_SA(1, 0), cA + kstep, voffA); PG8_STAGE(PG8_SB(1, 1), cB + hstepB + kstep, voffB);
        PG8_WAIT_V(6); PG8_BAR;
    }
    for (;;) {
        const bool has_next = S.next(ui + 1, nxt);
        const PG8_GAS char* nA = has_next ? (const PG8_GAS char*)g.A + (size_t)nxt.pm * tstepA : cA; const PG8_GAS char* nB = has_next ? (const PG8_GAS char*)g.Bt + (size_t)nxt.be * g.bstride + (size_t)nxt.pn * tstepB : cB;
        for (int t = 0; t < nt; t += 2) {
            const bool last = (t == nt - 2);
            const PG8_GAS char* a1 = cA + (size_t)(t + 1) * kstep;
            const PG8_GAS char* a2 = last ? nA : cA + (size_t)(t + 2) * kstep; const PG8_GAS char* b2 = last ? nB : cB + (size_t)(t + 2) * kstep;
            const PG8_GAS char* a3 = a2 + kstep; const PG8_GAS char* b3 = b2 + kstep;
            if (last && has_next) S.a_ready(nxt);
            if constexpr (SP2) {
            PG8_LDB(B0, 0, 0); PG8_LDB(B1, 0, 1); PG8_SCHED; PG8_LDA(At, 0, 0); PG8_STAGE(PG8_SA(1, 1), a1 + hstepA, voffA);
            PG8_WAIT_V(8); PG8_WAIT_L(0); PG8_BAR; PG8_MMA(0, 0, At, B0); PG8_MMA(0, 1, At, B1); PG8_BAR; PG8_SCHED;
            PG8_LDA(At, 0, 1); PG8_STAGE(PG8_SB(0, 0), b2, voffB); PG8_STAGE(PG8_SB(0, 1), b2 + hstepB, voffB); PG8_STAGE(PG8_SA(0, 0), a2, voffA);
            PG8_WAIT_V(8); PG8_WAIT_L(0); PG8_BAR; PG8_MMA(1, 0, At, B0); PG8_MMA(1, 1, At, B1); PG8_BAR; PG8_SCHED;
            PG8_LDB(B0, 1, 0); PG8_LDB(B1, 1, 1); PG8_SCHED; PG8_LDA(At, 1, 0); PG8_STAGE(PG8_SA(0, 1), a2 + hstepA, voffA);
            PG8_WAIT_V(8); PG8_WAIT_L(0); PG8_BAR; PG8_MMA(0, 0, At, B0); PG8_MMA(0, 1, At, B1); PG8_BAR; PG8_SCHED;
            PG8_LDA(At, 1, 1); PG8_STAGE(PG8_SB(1, 0), b3, voffB); PG8_STAGE(PG8_SB(1, 1), b3 + hstepB, voffB); PG8_STAGE(PG8_SA(1, 0), a3, voffA);
            PG8_WAIT_V(8); PG8_WAIT_L(0); PG8_BAR; PG8_MMA(1, 0, At, B0); PG8_MMA(1, 1, At, B1); PG8_BAR; PG8_SCHED;
            } else {
            PG8_LDB(B0, 0, 0); PG8_SCHED; PG8_LDA(At, 0, 0); PG8_STAGE(PG8_SA(1, 1), a1 + hstepA, voffA);
            PG8_WAIT_L(8); PG8_BAR; PG8_WAIT_L(0); PG8_MMA(0, 0, At, B0); PG8_BAR; PG8_SCHED;
            PG8_LDB(B1, 0, 1); PG8_STAGE(PG8_SB(0, 0), b2, voffB);
            PG8_BAR; PG8_WAIT_L(0); PG8_MMA(0, 1, At, B1); PG8_BAR;
            PG8_LDA(At, 0, 1); PG8_STAGE(PG8_SA(0, 0), a2, voffA);
            PG8_BAR; PG8_WAIT_L(0); PG8_MMA(1, 0, At, B0); PG8_BAR; PG8_SCHED;
            PG8_STAGE(PG8_SB(0, 1), b2 + hstepB, voffB);
            PG8_WAIT_V(6); PG8_BAR; PG8_MMA(1, 1, At, B1); PG8_BAR;
            PG8_LDB(B0, 1, 0); PG8_SCHED; PG8_LDA(At, 1, 0); PG8_STAGE(PG8_SA(0, 1), a2 + hstepA, voffA);
            PG8_WAIT_L(8); PG8_BAR; PG8_WAIT_L(0); PG8_MMA(0, 0, At, B0); PG8_BAR; PG8_SCHED;
            PG8_LDB(B1, 1, 1); PG8_STAGE(PG8_SB(1, 0), b3, voffB);
            PG8_BAR; PG8_WAIT_L(0); PG8_MMA(0, 1, At, B1); PG8_BAR;
            PG8_LDA(At, 1, 1); PG8_STAGE(PG8_SA(1, 0), a3, voffA);
            PG8_BAR; PG8_WAIT_L(0); PG8_MMA(1, 0, At, B0); PG8_BAR; PG8_SCHED;
            PG8_STAGE(PG8_SB(1, 1), b3 + hstepB, voffB);
            PG8_WAIT_V(6); PG8_BAR; PG8_MMA(1, 1, At, B1); PG8_BAR;
            }
        }
        if constexpr (ALIGN_EPI) { if (wr == 0) PG8_BAR; }
        PG8_F8_DRAIN();
        if constexpr (!Epi::AFTER_DRAIN) { E(acc, cur, wr, wc, fr, fq); S.done(cur); }
        if (!has_next) break;
#pragma unroll
        for (int a = 0; a < 2; ++a)
#pragma unroll
            for (int b = 0; b < 2; ++b)
#pragma unroll
                for (int m = 0; m < 4; ++m)
#pragma unroll
                    for (int n = 0; n < 2; ++n) acc[a][b][m][n] = (f32x4){0.f, 0.f, 0.f, 0.f};
        cur = nxt; cA = nA; cB = nB; ++ui;
        if constexpr (ALIGN_EPI) { if (wr == 1) PG8_BAR; }
    }
    PG8_WAIT_V(0);
    if constexpr (!ALIGN_EPI) { if (wr == 0) PG8_BAR; }
    PG8_BAR;
    if constexpr (Epi::AFTER_DRAIN) { E.fused(acc, cur, wr, wc, fr, fq, lds, wid, lane); S.done(cur); }
#undef PG8_SA
#undef PG8_SB
#undef PG8_STAGE
#undef PG8_LDA
#undef PG8_LDB
#undef PG8_MMA
#undef PG8_HALF
#undef PG8_F8_DRAIN
#undef PG8_WAIT_V
#undef PG8_WAIT_L
#undef PG8_BAR
#undef PG8_SCHED
}
}


#ifndef MK_PER_PHASE
#define MK_PER_PHASE 0
#endif

constexpr int NWAVES = 8, NTHR = 512;
constexpr int D = 1024, NBATCH = 2, SEQ = 16384, TL = NBATCH * SEQ, CTXL = 256, TC = NBATCH * CTXL, MR = TL + TC;
constexpr int NPH = 2048, DFF = 2816, NEXP = 8, EFF = 3584, DEPTH = 2;
constexpr float ALPHA = 1.41421356237309515f;
constexpr float LN_EPS = 1e-5f, RMS_EPS = 1e-6f;
constexpr int PH_QA = 0, PH_KA = 128, PH_VA = 256, PH_GA = 512, PH_HY = 768, PH_CQ = 1536, PH_CKV = 1792, PH_KR = 1920, PH_ALR = 1952;

constexpr size_t MiB = 1u << 20;
constexpr size_t WS_CTL = 0, CTL_ZERO_BYTES = 1 * MiB;
constexpr int CW_TMO = 0, CW_BAR = 4096;
constexpr size_t CTL_MODV = 64 * 1024;
constexpr size_t WS_SMALL = 1 * MiB;
constexpr size_t WS_PTRTAB = WS_SMALL + 16 * 1024;
constexpr size_t WS_WIN = 2 * MiB, WS_WOUT = 10 * MiB, WS_W13 = 14 * MiB, WS_W2 = 25 * MiB, WS_WUQ = 31 * MiB, WS_WUKV = 32 * MiB;
constexpr size_t AB = 34 * MiB;
constexpr size_t WS_XN = AB, WS_Y = AB + 65 * MiB, WS_PH = AB + 130 * MiB, WS_Q = AB + 260 * MiB, WS_K = AB + 309 * MiB, WS_V = AB + 358 * MiB;
constexpr size_t WS_VT = AB + 391 * MiB, WS_X1T = AB + 423 * MiB, WS_X2T = AB + 439 * MiB, WS_HF = AB + 455 * MiB, WS_XC = AB + 519 * MiB, WS_END = AB + 521 * MiB;
constexpr size_t WS_G = WS_PH;
static_assert(WS_W13 + (size_t)2 * DFF * D * 2 <= WS_W2 && WS_W2 + (size_t)D * DFF * 2 <= WS_WUQ, "weights map");
static_assert(WS_G + (size_t)MR * DFF * 2 <= WS_K, "G overlay");
static_assert(WS_END <= 573 * MiB, "d_ws budget");

constexpr int LDS_BYTES = 147456, LDS_MISC = 131072 + 320;

#define GAS __attribute__((address_space(1)))
#define LAS __attribute__((address_space(3)))
typedef unsigned short bf16;
typedef unsigned v4u __attribute__((ext_vector_type(4)));
typedef unsigned v2u __attribute__((ext_vector_type(2)));
typedef float f32x4 __attribute__((ext_vector_type(4)));
typedef GAS unsigned gu32;
#define RLX_AGENT __ATOMIC_RELAXED, __HIP_MEMORY_SCOPE_AGENT
#define LDS_WAIT() asm volatile("s_waitcnt lgkmcnt(0)" ::: "memory")
#define VM_WAIT() asm volatile("s_waitcnt vmcnt(0)" ::: "memory")
__device__ __forceinline__ unsigned pk2(float lo, float hi) { return pg8::cvt_pk_bf16(lo, hi); }
__device__ __forceinline__ float bf2f(unsigned short h) { return __uint_as_float((unsigned)h << 16); }
__device__ __forceinline__ float siluf(float x) { return x / (1.f + __expf(-x)); }
#define XB_TMO      128
#define XB_XCNT(j)  (256  + 64 * (j))
#define XB_XSUB(j)  (1280 + 64 * (j))
#define XB_XGEN(j)  (2304 + 64 * (j))
#define XB_TOP      3328
#define XB_TOPGEN   3392
#define XCD_BAR_WORDS 3456
#define XB_SPIN_CAP (1u << 18)

__device__ __forceinline__ unsigned xb_ld(unsigned* p)              { return __hip_atomic_load(p, __ATOMIC_RELAXED, __HIP_MEMORY_SCOPE_AGENT); }
__device__ __forceinline__ unsigned xb_add(unsigned* p, unsigned v) { return __hip_atomic_fetch_add(p, v, __ATOMIC_RELAXED, __HIP_MEMORY_SCOPE_AGENT); }
__device__ __forceinline__ unsigned xb_xcc_id() { return (unsigned)__builtin_amdgcn_s_getreg((3 << 11) | 20) & 0xFu; }
#define XB_SPIN(cond, bar) do { unsigned _sp = 0; while (cond) { __builtin_amdgcn_s_sleep(1); \
    if ((++_sp & 255u) == 0u) { if (xb_ld(&(bar)[XB_TMO])) break; if (_sp > XB_SPIN_CAP) { atomicAdd(&(bar)[XB_TMO], 1u); break; } } } } while (0)

struct XcdBarrier {
    unsigned* bar; unsigned x;
    volatile LAS unsigned* st;
};

__device__ __forceinline__ XcdBarrier xcd_barrier_post(unsigned* bar, volatile LAS unsigned* st) {
    XcdBarrier b; b.bar = bar; b.x = xb_xcc_id(); b.st = st;
    if (threadIdx.x == 0) (void)xb_add(&bar[XB_XCNT(b.x)], 1u);
    return b;
}
__device__ __forceinline__ void xcd_barrier_complete(unsigned* bar, unsigned x, unsigned& nloc, unsigned& nx) {
    const unsigned G = gridDim.x * gridDim.y * gridDim.z;
    unsigned sum, cnt, mine, sp = 0u;
    for (;;) {
        sum = 0u; cnt = 0u; mine = 0u;
#pragma unroll
        for (unsigned j = 0; j < 16; ++j) { const unsigned c = xb_ld(&bar[XB_XCNT(j)]); sum += c; cnt += (c > 0u) ? 1u : 0u; mine = (j == x) ? c : mine; }
        if (sum == G) break;
        __builtin_amdgcn_s_sleep(1);
        if ((++sp & 255u) == 0u) { if (xb_ld(&bar[XB_TMO])) break; if (sp > XB_SPIN_CAP) { atomicAdd(&bar[XB_TMO], 1u); break; } }
    }
    nloc = mine > 0u ? mine : 1u; nx = cnt > 0u ? cnt : 1u;
}

__device__ __forceinline__ void xcd_barrier(const XcdBarrier& b) {
    asm volatile("s_waitcnt vmcnt(0)" ::: "memory");
    __syncthreads();
    if (threadIdx.x == 0) {
        unsigned* bar = b.bar;
        __builtin_amdgcn_s_waitcnt(0);
        unsigned nloc = b.st[0], nx = b.st[1];
        if (nloc == 0u) { xcd_barrier_complete(bar, b.x, nloc, nx); b.st[0] = nloc; b.st[1] = nx; }
        const unsigned old = xb_add(&bar[XB_XSUB(b.x)], 1u);
        const unsigned gen = old / nloc;
        if (old + 1u == (gen + 1u) * nloc) {
            __builtin_amdgcn_fence(__ATOMIC_RELEASE, "agent");
            asm volatile("s_waitcnt vmcnt(0)" ::: "memory");
            const unsigned og = xb_add(&bar[XB_TOP], 1u);
            const unsigned tg = og / nx;
            if (og + 1u == (tg + 1u) * nx) xb_add(&bar[XB_TOPGEN], 1u);
            else XB_SPIN(xb_ld(&bar[XB_TOPGEN]) == tg, bar);
            __builtin_amdgcn_fence(__ATOMIC_ACQUIRE, "agent");
            xb_add(&bar[XB_XGEN(b.x)], 1u);
            asm volatile("s_waitcnt vmcnt(0)" ::: "memory");
        } else {
            XB_SPIN(xb_ld(&bar[XB_XGEN(b.x)]) == gen, bar);
            __builtin_amdgcn_fence(__ATOMIC_ACQUIRE, "agent");
            asm volatile("s_waitcnt vmcnt(0)" ::: "memory");
        }
    }
    __syncthreads();
}

struct Args { const GAS float* in[37]; GAS float* out; GAS unsigned char* ws; int ph_lo, ph_hi; };
enum In { I_X = 0, I_C, I_CTX, I_CCTX, I_WMOD, I_BMOD, I_WIN, I_GWG, I_GBG, I_GNG, I_HCW, I_HCB, I_HW1, I_HB1, I_HF1, I_HW2, I_HB2, I_HF2, I_HW3, I_HB3, I_HSKIP, I_HNG,
          I_QNG, I_WUQ, I_KVNG, I_WUKV, I_MNG, I_WOUT, I_LNG, I_LNB, I_FW1, I_FW3, I_FW2, I_ROUTER, I_MW1, I_MW3, I_MW2 };

struct Frame {
    LAS unsigned char* lds; GAS unsigned char* ws; gu32* ctl; const GAS float* const GAS* in; GAS float* out;
    int tid, lane, wave, G, gw, ngw;
};
__device__ __forceinline__ Frame launder(const Frame& F0) { Frame F = F0; int t = F0.tid; size_t z = 0; asm volatile("" : "+v"(t), "+s"(z)); F.tid = t; F.lane = t & 63; F.ws = F0.ws + z; F.ctl = (gu32*)(F.ws + WS_CTL); F.out = F0.out + z; return F; }
__device__ __forceinline__ float wave_sum(float v) {
#pragma unroll
    for (int o = 1; o < 64; o <<= 1) v += __shfl_xor(v, o);
    return v;
}
__device__ __forceinline__ const GAS float* modv(const Frame& F, int l, int v, int i) { return (const GAS float*)(F.ws + CTL_MODV) + ((size_t)(l * 3 + v) * 6 + i) * D; }
__device__ __forceinline__ int row_v(int row) { return row < TL ? (row >> 14) : 2; }

__device__ __forceinline__ void p0_modv(const Frame& F0) { const Frame F = launder(F0);
    const GAS float* c = F.in[I_C]; const GAS float* cc = F.in[I_CCTX]; const GAS float* wm = F.in[I_WMOD]; const GAS float* bm = F.in[I_BMOD];
    GAS float* mv = (GAS float*)(F.ws + CTL_MODV); LAS float* part = (LAS float*)F.lds;
    constexpr int NBLK = 6 * D / 64, NITEM = DEPTH * NBLK;
    for (int it = blockIdx.x; it < NITEM; it += F.G) {
        const int l = it / NBLK, nb = it % NBLK, n = nb * 64 + F.lane, k0 = F.wave * 128;
        const float s0a = siluf(c[k0 + F.lane]), s1a = siluf(c[D + k0 + F.lane]), s2a = siluf(cc[k0 + F.lane]);
        const float s0b = siluf(c[k0 + 64 + F.lane]), s1b = siluf(c[D + k0 + 64 + F.lane]), s2b = siluf(cc[k0 + 64 + F.lane]);
        float a0 = 0.f, a1 = 0.f, a2 = 0.f;
        const GAS float* w = wm + ((size_t)l * D + k0) * (6 * D) + n;
#pragma unroll 16
        for (int kk = 0; kk < 64; ++kk) { const float wv = w[(size_t)kk * (6 * D)]; a0 += __shfl(s0a, kk) * wv; a1 += __shfl(s1a, kk) * wv; a2 += __shfl(s2a, kk) * wv; }
#pragma unroll 16
        for (int kk = 0; kk < 64; ++kk) { const float wv = w[(size_t)(64 + kk) * (6 * D)]; a0 += __shfl(s0b, kk) * wv; a1 += __shfl(s1b, kk) * wv; a2 += __shfl(s2b, kk) * wv; }
        part[(F.wave * 3 + 0) * 64 + F.lane] = a0; part[(F.wave * 3 + 1) * 64 + F.lane] = a1; part[(F.wave * 3 + 2) * 64 + F.lane] = a2;
        __syncthreads();
        if (F.tid < 192) { const int v = F.tid >> 6, ln = F.tid & 63; float acc = bm[l * 6 * D + nb * 64 + ln];
#pragma unroll
            for (int wv = 0; wv < 8; ++wv) acc += part[(wv * 3 + v) * 64 + ln];
            mv[(size_t)(l * 3 + v) * 6 * D + nb * 64 + ln] = acc; }
        __syncthreads();
    }
}
template <class RowMap>
__device__ __forceinline__ void transpose_item(const GAS float* W, int N, GAS bf16* WT, int ldk, LAS float* scr, int item, int lane, const RowMap& rm, const GAS float* ks) {
    const int nblk = N / 32, kb = item / nblk, nb = item % nblk, k0 = 64 * kb, n0 = 32 * nb;
#pragma unroll 8
    for (int i = 0; i < 32; ++i) { const int kk = 2 * i + (lane >> 5); float v = W[(size_t)(k0 + kk) * N + n0 + (lane & 31)]; if (ks) v *= ks[k0 + kk]; scr[kk * 33 + (lane & 31)] = v; }
    LDS_WAIT(); asm volatile("" ::: "memory");
    const int c = lane & 7;
#pragma unroll
    for (int j = 0; j < 4; ++j) { const int n = (lane >> 3) + 8 * j; const LAS float* s = scr + (8 * c) * 33 + n;
        v4u o; o.x = pk2(s[0 * 33], s[1 * 33]); o.y = pk2(s[2 * 33], s[3 * 33]); o.z = pk2(s[4 * 33], s[5 * 33]); o.w = pk2(s[6 * 33], s[7 * 33]);
        *(GAS v4u*)(WT + (size_t)rm(n0 + n) * ldk + k0 + 8 * c) = o; }
    LDS_WAIT(); asm volatile("" ::: "memory");
}
__device__ __forceinline__ float clamp448(float x) { return fminf(fmaxf(x, -448.f), 448.f); }
__device__ __forceinline__ unsigned pk4_fp8(float a, float b, float c, float d) { unsigned w = 0; w = __builtin_amdgcn_cvt_pk_fp8_f32(clamp448(a), clamp448(b), w, false); w = __builtin_amdgcn_cvt_pk_fp8_f32(clamp448(c), clamp448(d), w, true); return w; }
template <class RowMap>
__device__ __forceinline__ void transpose_item_f8(const GAS float* W, int N, GAS unsigned char* WT, int ldk, LAS float* scr, int item, int lane, const RowMap& rm, float scale) {
    const int nblk = N / 32, kb = item / nblk, nb = item % nblk, k0 = 64 * kb, n0 = 32 * nb;
#pragma unroll 8
    for (int i = 0; i < 32; ++i) { const int kk = 2 * i + (lane >> 5); scr[kk * 33 + (lane & 31)] = W[(size_t)(k0 + kk) * N + n0 + (lane & 31)] * scale; }
    LDS_WAIT(); asm volatile("" ::: "memory");
    const int c = lane & 7;
#pragma unroll
    for (int j = 0; j < 4; ++j) { const int n = (lane >> 3) + 8 * j; const LAS float* s = scr + (8 * c) * 33 + n;
        v2u o; o.x = pk4_fp8(s[0 * 33], s[1 * 33], s[2 * 33], s[3 * 33]); o.y = pk4_fp8(s[4 * 33], s[5 * 33], s[6 * 33], s[7 * 33]);
        *(GAS v2u*)(WT + (size_t)rm(n0 + n) * ldk + k0 + 8 * c) = o; }
    LDS_WAIT(); asm volatile("" ::: "memory");
}
struct RmIdent { int off; __device__ int operator()(int n) const { return n + off; } };
struct RmWin { __device__ int operator()(int c) const {
    if (c < 768) return c; if (c < 800) return PH_ALR + (c - 768); if (c < 1568) return PH_HY + (c - 800); if (c < 1824) return PH_CQ + (c - 1568); if (c < 1952) return PH_CKV + (c - 1824); return PH_KR + (c - 1952); } };
struct RmGlu { int half; __device__ int operator()(int j) const { return (j >> 2) * 8 + half * 4 + (j & 3); } };

__device__ __forceinline__ void p0_weights(const Frame& F0) { const Frame F = launder(F0);
    LAS float* scr = (LAS float*)(F.lds + F.wave * 16384);
    GAS bf16* WIN = (GAS bf16*)(F.ws + WS_WIN); GAS bf16* WOUT = (GAS bf16*)(F.ws + WS_WOUT); GAS bf16* W13 = (GAS bf16*)(F.ws + WS_W13); GAS bf16* W2 = (GAS bf16*)(F.ws + WS_W2);
    GAS bf16* WUQ = (GAS bf16*)(F.ws + WS_WUQ); GAS bf16* WUKV = (GAS bf16*)(F.ws + WS_WUKV);
    constexpr int I_IN = (D / 64) * (1984 / 32), I_OUT = (D / 64) * (D / 32), I_F1 = (D / 64) * (DFF / 32), I_F2 = (DFF / 64) * (D / 32), I_UQ = (256 / 64) * (768 / 32), I_UKV = (128 / 64) * (1024 / 32);
    constexpr int NITEM = DEPTH * I_IN + DEPTH * I_OUT + 2 * I_F1 + I_F2 + DEPTH * I_UQ + DEPTH * I_UKV;
    for (int it = F.gw; it < NITEM; it += F.ngw) {
        int r = it;
        if (r < DEPTH * I_IN) { const int l = r / I_IN; transpose_item(F.in[I_WIN] + (size_t)l * D * 1984, 1984, WIN + (size_t)l * NPH * D, D, scr, r % I_IN, F.lane, RmWin{}, nullptr); continue; } r -= DEPTH * I_IN;
        if (r < DEPTH * I_OUT) { const int l = r / I_OUT; transpose_item(F.in[I_WOUT] + (size_t)l * D * D, D, WOUT + (size_t)l * D * D, D, scr, r % I_OUT, F.lane, RmIdent{0}, nullptr); continue; } r -= DEPTH * I_OUT;
        if (r < I_F1) { transpose_item(F.in[I_FW1], DFF, W13, D, scr, r, F.lane, RmGlu{0}, nullptr); continue; } r -= I_F1;
        if (r < I_F1) { transpose_item(F.in[I_FW3], DFF, W13, D, scr, r, F.lane, RmGlu{1}, nullptr); continue; } r -= I_F1;
        if (r < I_F2) { transpose_item(F.in[I_FW2], D, W2, DFF, scr, r, F.lane, RmIdent{0}, nullptr); continue; } r -= I_F2;
        if (r < DEPTH * I_UQ) { const int l = r / I_UQ; transpose_item(F.in[I_WUQ] + (size_t)l * 256 * 768, 768, WUQ + (size_t)l * 768 * 256, 256, scr, r % I_UQ, F.lane, RmIdent{0}, F.in[I_QNG] + l * 256); continue; } r -= DEPTH * I_UQ;
        { const int l = r / I_UKV; transpose_item(F.in[I_WUKV] + (size_t)l * 128 * 1024, 1024, WUKV + (size_t)l * 1024 * 256, 256, scr, r % I_UKV, F.lane, RmIdent{0}, F.in[I_KVNG] + l * 128); }
    }
    const int gt = blockIdx.x * NTHR + F.tid, ngt = F.G * NTHR;
    for (int i = gt; i < DEPTH * 64 * D / 8; i += ngt) { const int l = i / (64 * D / 8), r = i % (64 * D / 8); *(GAS v4u*)(WIN + ((size_t)l * NPH + 1984) * D + (size_t)r * 8) = (v4u){0u, 0u, 0u, 0u}; }
    for (int i = gt; i < DEPTH * 1024 * 128 / 8; i += ngt) { const int row = i / 16, c = i % 16; *(GAS v4u*)(WUKV + (size_t)row * 256 + 128 + c * 8) = (v4u){0u, 0u, 0u, 0u}; }
}

__device__ __forceinline__ void mod_store_bf16(const f32x4 (&v)[4], const GAS float* sh, const GAS float* sc, GAS bf16* orow, int lane) {
    GAS unsigned long long* o8 = (GAS unsigned long long*)orow + lane;
#pragma unroll
    for (int j = 0; j < 4; ++j) { const f32x4 a = ((const GAS f32x4*)sc)[lane + 64 * j], b = ((const GAS f32x4*)sh)[lane + 64 * j];
        const f32x4 y = v[j] * (a + 1.f) + b;
        o8[64 * j] = (unsigned long long)pk2(y.x, y.y) | ((unsigned long long)pk2(y.z, y.w) << 32); }
}
__device__ __forceinline__ void p_xn0(const Frame& F0) { const Frame F = launder(F0);
    GAS bf16* XN = (GAS bf16*)(F.ws + WS_XN);
    f32x4 nx[4];
#define XN0_LOAD(mm) do { const GAS float* src_ = (mm) < TL ? F.in[I_X] + (size_t)(mm) * D : F.in[I_CTX] + (size_t)((mm) - TL) * D; _Pragma("unroll") for (int j = 0; j < 4; ++j) nx[j] = ((const GAS f32x4*)src_)[F.lane + 64 * j]; } while (0)
    int m = F.gw; if (m < MR) XN0_LOAD(m);
    for (; m < MR; m += F.ngw) {
        f32x4 v[4];
#pragma unroll
        for (int j = 0; j < 4; ++j) v[j] = nx[j];
        if (m + F.ngw < MR) XN0_LOAD(m + F.ngw);
        const int vv = row_v(m);
        mod_store_bf16(v, modv(F, 0, vv, 0), modv(F, 0, vv, 1), XN + (size_t)m * D, F.lane);
    }
#undef XN0_LOAD
}
__device__ __forceinline__ GAS float* xres(const Frame& F, int row) { return row < TL ? F.out + (size_t)row * D : (GAS float*)(F.ws + WS_XC) + (size_t)(row - TL) * D; }
__device__ __forceinline__ void p_ln(const Frame& F0, int nrows, const GAS float* g, const GAS float* b, bool want_xn, int ml, int si) { const Frame F = launder(F0);
    GAS bf16* XN = (GAS bf16*)(F.ws + WS_XN);
    f32x4 nx[4];
    int m = F.gw; if (m < nrows) { const GAS float* r_ = xres(F, m);
#pragma unroll
        for (int j = 0; j < 4; ++j) nx[j] = ((const GAS f32x4*)r_)[F.lane + 64 * j]; }
    for (; m < nrows; m += F.ngw) {
        GAS float* row = xres(F, m);
        f32x4 v[4]; float s = 0.f;
#pragma unroll
        for (int j = 0; j < 4; ++j) { v[j] = nx[j]; s += (v[j].x + v[j].y) + (v[j].z + v[j].w); }
        if (m + F.ngw < nrows) { const GAS float* r_ = xres(F, m + F.ngw);
#pragma unroll
            for (int j = 0; j < 4; ++j) nx[j] = ((const GAS f32x4*)r_)[F.lane + 64 * j]; }
        const float mean = wave_sum(s) * (1.f / D); float s2 = 0.f;
#pragma unroll
        for (int j = 0; j < 4; ++j) { v[j] = v[j] - mean; s2 += (v[j].x * v[j].x + v[j].y * v[j].y) + (v[j].z * v[j].z + v[j].w * v[j].w); }
        const float rstd = 1.f / sqrtf(wave_sum(s2) * (1.f / D) + LN_EPS);
#pragma unroll
        for (int j = 0; j < 4; ++j) { const f32x4 gg = ((const GAS f32x4*)g)[F.lane + 64 * j], bb = ((const GAS f32x4*)b)[F.lane + 64 * j]; v[j] = v[j] * rstd * gg + bb; ((GAS f32x4*)row)[F.lane + 64 * j] = v[j]; }
        if (want_xn) { const int vv = row_v(m); mod_store_bf16(v, modv(F, ml, vv, si), modv(F, ml, vv, si + 1), XN + (size_t)m * D, F.lane); }
    }
}

using pg8::f32x4; using pg8::Unit;
struct EpiStoreBf16 {
    static constexpr bool PERM = true, AFTER_DRAIN = false;
    GAS bf16* O; int ldc; float sc;
    __device__ __forceinline__ void operator()(const pg8::f32x4 (&acc)[2][2][4][2], const Unit& u, int wr, int wc, int fr, int fq) const {
        const int row0 = u.pm * 256 + wr * 64 + fr, col0 = u.pn * 256 + wc * 32 + 8 * fq;
#pragma unroll
        for (int ai = 0; ai < 2; ++ai)
#pragma unroll
            for (int m = 0; m < 4; ++m) { GAS bf16* rowp = O + (size_t)(row0 + ai * 128 + m * 16) * ldc + col0;
#pragma unroll
                for (int bj = 0; bj < 2; ++bj) { const pg8::f32x4 v0 = acc[ai][bj][m][0] * sc, v1 = acc[ai][bj][m][1] * sc;
                    v4u w; w.x = pk2(v0[0], v0[1]); w.y = pk2(v0[2], v0[3]); w.z = pk2(v1[0], v1[1]); w.w = pk2(v1[2], v1[3]);
                    *(GAS v4u*)(rowp + bj * 128) = w; } }
    }
};
struct EpiSwiglu {
    static constexpr bool PERM = true, AFTER_DRAIN = false;
    GAS bf16* G; int ldg; float sc;
    __device__ __forceinline__ void operator()(const pg8::f32x4 (&acc)[2][2][4][2], const Unit& u, int wr, int wc, int fr, int fq) const {
        const int row0 = u.pm * 256 + wr * 64 + fr, col0 = (u.pn * 256 + wc * 32 + 8 * fq) >> 1;
#pragma unroll
        for (int ai = 0; ai < 2; ++ai)
#pragma unroll
            for (int m = 0; m < 4; ++m) { GAS bf16* rowp = G + (size_t)(row0 + ai * 128 + m * 16) * ldg + col0;
#pragma unroll
                for (int bj = 0; bj < 2; ++bj) { const pg8::f32x4 a = acc[ai][bj][m][0] * sc, b = acc[ai][bj][m][1] * sc;
                    v2u w; w.x = pk2(siluf(a[0]) * b[0], siluf(a[1]) * b[1]); w.y = pk2(siluf(a[2]) * b[2], siluf(a[3]) * b[3]);
                    *(GAS v2u*)(rowp + bj * 64) = w; } }
    }
};
struct EpiSwiglu8 {
    static constexpr bool PERM = true, AFTER_DRAIN = false;
    GAS unsigned char* G; int ldg; float sc, osc;
    __device__ __forceinline__ void operator()(const pg8::f32x4 (&acc)[2][2][4][2], const Unit& u, int wr, int wc, int fr, int fq) const {
        const int row0 = u.pm * 256 + wr * 64 + fr, col0 = (u.pn * 256 + wc * 32 + 8 * fq) >> 1;
#pragma unroll
        for (int ai = 0; ai < 2; ++ai)
#pragma unroll
            for (int m = 0; m < 4; ++m) { GAS unsigned char* rowp = G + (size_t)(row0 + ai * 128 + m * 16) * ldg + col0;
#pragma unroll
                for (int bj = 0; bj < 2; ++bj) { const pg8::f32x4 a = acc[ai][bj][m][0] * sc, b = acc[ai][bj][m][1] * sc;
                    *(GAS unsigned*)(rowp + bj * 64) = pk4_fp8(siluf(a[0]) * b[0] * osc, siluf(a[1]) * b[1] * osc, siluf(a[2]) * b[2] * osc, siluf(a[3]) * b[3] * osc); } }
    }
};
struct EpiRes {
    static constexpr bool PERM = false, AFTER_DRAIN = false;
    const GAS float* xin_lat; const GAS float* xin_ctx; GAS float* out_lat; GAS float* out_ctx; const GAS float* gate0;
    __device__ __forceinline__ void operator()(const pg8::f32x4 (&acc)[2][2][4][2], const Unit& u, int wr, int wc, int fr, int fq) const {
        const bool lat = u.pm < TL / 256; const int v = lat ? (u.pm >> 6) : 2;
        const GAS float* xin = lat ? xin_lat : xin_ctx - (size_t)TL * D; GAS float* out = lat ? out_lat : out_ctx - (size_t)TL * D;
        const GAS float* gate = gate0 + (size_t)v * 6 * D;
        const int row0 = u.pm * 256 + wr * 64 + fr, col0 = u.pn * 256 + wc * 32 + 4 * fq;
        pg8::f32x4 gv[2][2];
#pragma unroll
        for (int bj = 0; bj < 2; ++bj)
#pragma unroll
            for (int n = 0; n < 2; ++n) gv[bj][n] = *(const GAS pg8::f32x4*)(gate + col0 + bj * 128 + n * 16);
#pragma unroll
        for (int ai = 0; ai < 2; ++ai)
#pragma unroll
            for (int m = 0; m < 4; ++m) { const size_t off = (size_t)(row0 + ai * 128 + m * 16) * D + col0;
#pragma unroll
                for (int bj = 0; bj < 2; ++bj)
#pragma unroll
                    for (int n = 0; n < 2; ++n) { const pg8::f32x4 xv = *(const GAS pg8::f32x4*)(xin + off + bj * 128 + n * 16);
                        *(GAS pg8::f32x4*)(out + off + bj * 128 + n * 16) = xv * ALPHA + gv[bj][n] * acc[ai][bj][m][n]; } }
    }
};


constexpr int CW_MOECNT = 2048;
constexpr size_t WS_TI = WS_SMALL + 64 * 1024;
constexpr int MOE_CHUNK_TILES = 64, MOE_NCHUNK = 5, MOE_MAXROWS = MOE_NCHUNK * MOE_CHUNK_TILES * 256;
constexpr size_t WS_HS = AB + 65 * MiB, WS_WM13 = AB + 197 * MiB, WS_WM2 = AB + 309 * MiB, WS_GC = AB + 365 * MiB;
constexpr size_t WS_H8 = WS_XN, WS_HS8 = WS_HS + 66 * MiB;
constexpr float MOE_WSCALE = 64.f, MOE_GSCALE = 16.f, MOE_W2SCALE = 256.f;
static_assert(WS_HS + (size_t)(2 * TL + NEXP * 256) * D * 2 <= WS_WM13 && WS_WM13 + (size_t)NEXP * 2 * EFF * D * 2 <= WS_WM2 && WS_WM2 + (size_t)NEXP * D * EFF * 2 <= WS_GC && WS_GC + (size_t)MOE_CHUNK_TILES * 256 * EFF * 2 <= WS_XC, "MoE map");

__device__ __forceinline__ void p_ln_route(const Frame& F0, const GAS float* g, const GAS float* b, int l) { const Frame F = launder(F0);
    GAS bf16* XN = (GAS bf16*)(F.ws + WS_XN);
    GAS int* TI_E = (GAS int*)(F.ws + WS_TI); GAS int* TI_P0 = TI_E + TL; GAS int* TI_P1 = TI_P0 + TL; GAS float* TI_W0 = (GAS float*)(TI_P1 + TL); GAS float* TI_W1 = TI_W0 + TL;
    const GAS float* wr = F.in[I_ROUTER];
    f32x4 nx[4];
    int m = F.gw; if (m < TL) {
#pragma unroll
        for (int j = 0; j < 4; ++j) nx[j] = ((const GAS f32x4*)(F.out + (size_t)m * D))[F.lane + 64 * j]; }
    for (; m < TL; m += F.ngw) {
        GAS float* row = F.out + (size_t)m * D;
        f32x4 v[4]; float s = 0.f;
#pragma unroll
        for (int j = 0; j < 4; ++j) { v[j] = nx[j]; s += (v[j].x + v[j].y) + (v[j].z + v[j].w); }
        if (m + F.ngw < TL) {
#pragma unroll
            for (int j = 0; j < 4; ++j) nx[j] = ((const GAS f32x4*)(F.out + (size_t)(m + F.ngw) * D))[F.lane + 64 * j]; }
        const float mean = wave_sum(s) * (1.f / D); float s2 = 0.f;
#pragma unroll
        for (int j = 0; j < 4; ++j) { v[j] = v[j] - mean; s2 += (v[j].x * v[j].x + v[j].y * v[j].y) + (v[j].z * v[j].z + v[j].w * v[j].w); }
        const float rstd = 1.f / sqrtf(wave_sum(s2) * (1.f / D) + LN_EPS);
        const int vv = row_v(m); const GAS float* sh = modv(F, l, vv, 3); const GAS float* sc = modv(F, l, vv, 4);
        GAS unsigned* h8 = (GAS unsigned*)(F.ws + WS_H8 + (size_t)m * D) + F.lane;
        float lg[NEXP];
#pragma unroll
        for (int e = 0; e < NEXP; ++e) lg[e] = 0.f;
#pragma unroll
        for (int j = 0; j < 4; ++j) { const f32x4 gg = ((const GAS f32x4*)g)[F.lane + 64 * j], bb = ((const GAS f32x4*)b)[F.lane + 64 * j]; v[j] = v[j] * rstd * gg + bb; ((GAS f32x4*)row)[F.lane + 64 * j] = v[j];
            const f32x4 a = ((const GAS f32x4*)sc)[F.lane + 64 * j], c = ((const GAS f32x4*)sh)[F.lane + 64 * j];
            const f32x4 y = v[j] * (a + 1.f) + c;
            h8[64 * j] = pk4_fp8(y.x, y.y, y.z, y.w);
            const GAS f32x4* w4 = (const GAS f32x4*)(wr + (size_t)(4 * F.lane + 256 * j) * NEXP);
#pragma unroll
            for (int i = 0; i < 4; ++i) { const f32x4 wa = w4[2 * i], wb = w4[2 * i + 1]; const float yi = y[i];
                lg[0] += yi * wa.x; lg[1] += yi * wa.y; lg[2] += yi * wa.z; lg[3] += yi * wa.w; lg[4] += yi * wb.x; lg[5] += yi * wb.y; lg[6] += yi * wb.z; lg[7] += yi * wb.w; } }
#pragma unroll
        for (int e = 0; e < NEXP; ++e) lg[e] = wave_sum(lg[e]);
        int i0 = 0; float v0 = lg[0];
#pragma unroll
        for (int e = 1; e < NEXP; ++e) if (lg[e] > v0) { v0 = lg[e]; i0 = e; }
        int i1 = -1; float v1 = -3.0e38f;
#pragma unroll
        for (int e = 0; e < NEXP; ++e) if (e != i0 && lg[e] > v1) { v1 = lg[e]; i1 = e; }
        if (F.lane == 0) {
            const float w0 = 1.f / (1.f + __expf(v1 - v0));
            const int p0 = (int)__hip_atomic_fetch_add((GAS unsigned*)F.ctl + CW_MOECNT + 64 * i0, 1u, RLX_AGENT);
            const int p1 = (int)__hip_atomic_fetch_add((GAS unsigned*)F.ctl + CW_MOECNT + 64 * i1, 1u, RLX_AGENT);
            TI_E[m] = i0 | (i1 << 8); TI_P0[m] = p0; TI_P1[m] = p1; TI_W0[m] = w0; TI_W1[m] = 1.f - w0;
        }
    }
}
struct MoeBase { int bt[NEXP + 1]; };
__device__ __forceinline__ MoeBase moe_base(const Frame& F) {
    MoeBase B; int acc = 0;
#pragma unroll
    for (int e = 0; e < NEXP; ++e) { B.bt[e] = acc; const unsigned c = __hip_atomic_load((GAS unsigned*)F.ctl + CW_MOECNT + 64 * e, RLX_AGENT); acc += (int)((c + 255u) >> 8); }
    B.bt[NEXP] = acc; return B;
}
__device__ __forceinline__ void p_moe_weights(const Frame& F0) { const Frame F = launder(F0);
    LAS float* scr = (LAS float*)(F.lds + F.wave * 16384);
    GAS unsigned char* WM13 = F.ws + WS_WM13; GAS unsigned char* WM2 = F.ws + WS_WM2;
    constexpr int I1 = (D / 64) * (EFF / 32), I2 = (EFF / 64) * (D / 32), NITEM = NEXP * (2 * I1 + I2);
    for (int it = F.gw; it < NITEM; it += F.ngw) {
        const int e = it / (2 * I1 + I2); int r = it % (2 * I1 + I2);
        if (r < I1) { transpose_item_f8(F.in[I_MW1] + (size_t)e * D * EFF, EFF, WM13 + (size_t)e * 2 * EFF * D, D, scr, r, F.lane, RmGlu{0}, MOE_WSCALE); continue; } r -= I1;
        if (r < I1) { transpose_item_f8(F.in[I_MW3] + (size_t)e * D * EFF, EFF, WM13 + (size_t)e * 2 * EFF * D, D, scr, r, F.lane, RmGlu{1}, MOE_WSCALE); continue; } r -= I1;
        transpose_item_f8(F.in[I_MW2] + (size_t)e * EFF * D, D, WM2 + (size_t)e * D * EFF, EFF, scr, r, F.lane, RmIdent{0}, MOE_W2SCALE);
    }
}
__device__ __forceinline__ void p_moe_scatter(const Frame& F0) { const Frame F = launder(F0);
    const MoeBase B = moe_base(F);
    const GAS unsigned char* H8 = F.ws + WS_H8; GAS unsigned char* HS8 = F.ws + WS_HS8;
    GAS int* TI_E = (GAS int*)(F.ws + WS_TI); GAS int* TI_P0 = TI_E + TL; GAS int* TI_P1 = TI_P0 + TL;
    for (int m = F.gw; m < TL; m += F.ngw) {
        const int ee = TI_E[m], e0 = ee & 255, e1 = ee >> 8;
        int b0 = 0, b1 = 0;
#pragma unroll
        for (int e = 0; e < NEXP; ++e) { if (e == e0) b0 = B.bt[e]; if (e == e1) b1 = B.bt[e]; }
        const int s0 = b0 * 256 + TI_P0[m], s1 = b1 * 256 + TI_P1[m];
        const v4u a = *((const GAS v4u*)(H8 + (size_t)m * D) + F.lane);
        *((GAS v4u*)(HS8 + (size_t)s0 * D) + F.lane) = a; *((GAS v4u*)(HS8 + (size_t)s1 * D) + F.lane) = a;
        if (F.lane == 0) { TI_P0[m] = s0; TI_P1[m] = s1; }
    }
}
constexpr int LDS_MOEBT = LDS_MISC + 64;
__device__ __forceinline__ void moe_base_to_lds(const Frame& F) {
    if (F.tid == 0) { volatile LAS int* bt = (volatile LAS int*)(F.lds + LDS_MOEBT); int acc = 0;
        for (int e = 0; e < NEXP; ++e) { bt[e] = acc; const unsigned c = __hip_atomic_load((GAS unsigned*)F.ctl + CW_MOECNT + 64 * e, RLX_AGENT); acc += (int)((c + 255u) >> 8); }
        bt[NEXP] = acc; }
    __syncthreads();
}
struct MoeOrder {
    int nM, nN, nwg, G, c, tile0; const LAS int* bt;
    __device__ void init(const LAS int* bt_, int chunk, int nN_, int G_, int c_) {
        bt = bt_; tile0 = chunk * MOE_CHUNK_TILES; int v = bt[NEXP] - tile0; nM = v < 0 ? 0 : (v > MOE_CHUNK_TILES ? MOE_CHUNK_TILES : v); nN = nN_; nwg = nM * nN; G = G_; c = c_; }
    __device__ bool next(int i, pg8::Unit& u) const {
        const long L = (long)i * G + c; if (L >= nwg) return false;
        int wgid = (int)L; { const int q = nwg / pg8::NXCD, r = nwg % pg8::NXCD, xcd = wgid % pg8::NXCD, off = wgid / pg8::NXCD; wgid = (xcd < r ? xcd * (q + 1) : r * (q + 1) + (xcd - r) * q) + off; }
        const int nig = pg8::WGM * nN, gid = wgid / nig, fm = gid * pg8::WGM, gsz = (nM - fm) < pg8::WGM ? (nM - fm) : pg8::WGM;
        u.pm = fm + ((wgid % nig) % gsz); u.pn = (wgid % nig) / gsz;
        const int gt = tile0 + u.pm; int e = 0;
#pragma unroll
        for (int k = 1; k < NEXP; ++k) e += (gt >= bt[k]) ? 1 : 0;
        u.be = __builtin_amdgcn_readfirstlane(e); return true;
    }
    __device__ __forceinline__ void a_ready(const pg8::Unit&) const {}
    __device__ __forceinline__ void done(const pg8::Unit&) const {}
};
__device__ __forceinline__ void p_ln_combine(const Frame& F0, const GAS float* g, const GAS float* b, int l) { const Frame F = launder(F0);
    const GAS bf16* YS = (const GAS bf16*)(F.ws + WS_HS);
    GAS int* TI_E = (GAS int*)(F.ws + WS_TI); GAS int* TI_P0 = TI_E + TL; GAS int* TI_P1 = TI_P0 + TL; GAS float* TI_W0 = (GAS float*)(TI_P1 + TL); GAS float* TI_W1 = TI_W0 + TL;
    for (int m = F.gw; m < TL; m += F.ngw) {
        GAS float* row = F.out + (size_t)m * D;
        const int s0 = TI_P0[m], s1 = TI_P1[m]; const float w0 = TI_W0[m], w1 = TI_W1[m];
        const GAS float* gate = modv(F, l, row_v(m), 5);
        const GAS unsigned long long* y0 = (const GAS unsigned long long*)(YS + (size_t)s0 * D) + F.lane; const GAS unsigned long long* y1 = (const GAS unsigned long long*)(YS + (size_t)s1 * D) + F.lane;
        f32x4 v[4]; float s = 0.f;
#pragma unroll
        for (int j = 0; j < 4; ++j) { const f32x4 x = ((const GAS f32x4*)row)[F.lane + 64 * j], gt = ((const GAS f32x4*)gate)[F.lane + 64 * j];
            const unsigned long long a = y0[64 * j], c = y1[64 * j];
            f32x4 f;
            f.x = w0 * bf2f((unsigned short)a) + w1 * bf2f((unsigned short)c); f.y = w0 * bf2f((unsigned short)(a >> 16)) + w1 * bf2f((unsigned short)(c >> 16));
            f.z = w0 * bf2f((unsigned short)(a >> 32)) + w1 * bf2f((unsigned short)(c >> 32)); f.w = w0 * bf2f((unsigned short)(a >> 48)) + w1 * bf2f((unsigned short)(c >> 48));
            v[j] = x * ALPHA + gt * f; s += (v[j].x + v[j].y) + (v[j].z + v[j].w); }
        const float mean = wave_sum(s) * (1.f / D); float s2 = 0.f;
#pragma unroll
        for (int j = 0; j < 4; ++j) { v[j] = v[j] - mean; s2 += (v[j].x * v[j].x + v[j].y * v[j].y) + (v[j].z * v[j].z + v[j].w * v[j].w); }
        const float rstd = 1.f / sqrtf(wave_sum(s2) * (1.f / D) + LN_EPS);
#pragma unroll
        for (int j = 0; j < 4; ++j) { const f32x4 gg = ((const GAS f32x4*)g)[F.lane + 64 * j], bb = ((const GAS f32x4*)b)[F.lane + 64 * j]; ((GAS f32x4*)row)[F.lane + 64 * j] = v[j] * rstd * gg + bb; }
    }
}

namespace att {
using bf16x8 = __attribute__((ext_vector_type(8))) short;
using s16x4  = __attribute__((ext_vector_type(4))) short;
using f32x16 = __attribute__((ext_vector_type(16))) float;
using u32x4  = __attribute__((ext_vector_type(4))) unsigned;
constexpr int DQ = 96, DV = 64, NW = 8, QBLK = 32, KVBLK = 64, NKEY = 16640;
constexpr float THR2 = 8.0f;
constexpr int SHM_K = KVBLK * 144, SHM_V = DV * 80;
typedef int i32x8 __attribute__((ext_vector_type(8)));
constexpr int NSLOT = 3;
constexpr int LDS_V = 0, LDS_K = NSLOT * SHM_V, LDS_WS = LDS_K + NSLOT * SHM_K, LDS_Q = LDS_WS + NW * 64 * 4, ATT_LDS = LDS_Q + NW * 4096;
#define KSWZ(row, colB) ((row) * 256 + ((colB) ^ (((row) & 7) << 4)))
#define SBAR() __builtin_amdgcn_sched_barrier(0)
__device__ __forceinline__ int crow(int r, int hi) { return (r & 3) + 8 * (r >> 2) + 4 * hi; }
__device__ __forceinline__ unsigned cvtpk(float lo, float hi) { unsigned r; asm volatile("v_cvt_pk_bf16_f32 %0, %1, %2" : "=v"(r) : "v"(lo), "v"(hi)); return r; }
template <bool FIRST>
__device__ __forceinline__ bool partialSM(f32x16& p0, f32x16& p1, f32x16& negm, float& alpha) {
  float a = fmaxf(fmaxf(p0[0], p0[1]), p1[0]), b = fmaxf(fmaxf(p0[2], p0[3]), p1[1]); a = fmaxf(fmaxf(a, p1[2]), p1[3]);
#pragma unroll
  for (int r = 4; r < 16; r += 4) { a = fmaxf(fmaxf(a, p0[r]), p0[r + 1]); b = fmaxf(fmaxf(b, p0[r + 2]), p0[r + 3]); a = fmaxf(fmaxf(a, p1[r]), p1[r + 1]); b = fmaxf(fmaxf(b, p1[r + 2]), p1[r + 3]); }
  float pmax = fmaxf(a, b);
  { auto rr = __builtin_amdgcn_permlane32_swap(__float_as_uint(pmax), __float_as_uint(pmax), false, false);
    pmax = fmaxf(__uint_as_float(rr[0]), __uint_as_float(rr[1])); }
  bool resc = false;
  if (FIRST || __builtin_expect(__any(pmax > THR2), 0)) {
    const float dl = FIRST ? pmax : fmaxf(pmax, 0.f);
#pragma unroll
    for (int r = 0; r < 16; ++r) { p0[r] -= dl; p1[r] -= dl; negm[r] -= dl; }
    alpha = __builtin_amdgcn_exp2f(-dl); resc = !FIRST;
  }
  return resc;
}
__device__ __forceinline__ void finishSM(f32x16& p0, f32x16& p1, i32x8& pb) {
#pragma unroll
  for (int r = 0; r < 16; ++r) p0[r] = __builtin_amdgcn_exp2f(p0[r]);
#pragma unroll
  for (int r = 0; r < 16; ++r) p1[r] = __builtin_amdgcn_exp2f(p1[r]);
#pragma unroll
  for (int w = 0; w < 4; ++w) {
    int x = __builtin_amdgcn_cvt_pk_fp8_f32(p0[4 * w], p0[4 * w + 1], __float_as_int(p0[4 * w]), false); x = __builtin_amdgcn_cvt_pk_fp8_f32(p0[4 * w + 2], p0[4 * w + 3], x, true); pb[w] = x;
    int y = __builtin_amdgcn_cvt_pk_fp8_f32(p1[4 * w], p1[4 * w + 1], __float_as_int(p1[4 * w]), false); y = __builtin_amdgcn_cvt_pk_fp8_f32(p1[4 * w + 2], p1[4 * w + 3], y, true); pb[4 + w] = y; }
}
__device__ __forceinline__ i32x8 ld32(const LAS char* p) { const u32x4 a = *reinterpret_cast<const LAS u32x4*>(p), b = *reinterpret_cast<const LAS u32x4*>(p + 16);
  return (i32x8){(int)a[0], (int)a[1], (int)a[2], (int)a[3], (int)b[0], (int)b[1], (int)b[2], (int)b[3]}; }
struct KFrag { i32x8 k00, k01, k10, k11; };
__device__ __forceinline__ void qkt_load(KFrag& k, const LAS char* Ks, int r32, int hi) {
  const LAS char* kp = Ks + r32 * 144 + hi * 32;
  k.k00 = ld32(kp); k.k01 = ld32(kp + 64); k.k10 = ld32(kp + 32 * 144); k.k11 = ld32(kp + 32 * 144 + 64);
}
__device__ __forceinline__ void qkt_mma(f32x16& p0, f32x16& p1, const KFrag& k, const i32x8& q0, const i32x8& q1, const f32x16& negm) {
  asm volatile("s_nop 1\n\tv_mfma_f32_32x32x64_f8f6f4 %0, %1, %2, %3" : "=&v"(p0) : "v"(k.k00), "v"(q0), "v"(negm));
  asm volatile("v_mfma_f32_32x32x64_f8f6f4 %0, %1, %2, %3" : "=&v"(p1) : "v"(k.k10), "v"(q0), "v"(negm));
  asm volatile("v_mfma_f32_32x32x64_f8f6f4 %0, %1, %2, %0" : "+v"(p0) : "v"(k.k01), "v"(q1));
  asm volatile("v_mfma_f32_32x32x64_f8f6f4 %0, %1, %2, %0" : "+v"(p1) : "v"(k.k11), "v"(q1));
}
__device__ __forceinline__ void qkt(f32x16& p0, f32x16& p1, const LAS char* Ks, const i32x8& q0, const i32x8& q1, const f32x16& negm, int r32, int hi) {
  KFrag k; qkt_load(k, Ks, r32, hi); qkt_mma(p0, p1, k, q0, q1, negm);
}
#define QK_DRAIN(P0, P1) asm volatile("s_nop 15\n\ts_nop 7" : "+v"(P0), "+v"(P1))
__device__ __forceinline__ void pv_d0(f32x16* o, const LAS char* Vs, const i32x8& pb, int r32, int hi) {
  const LAS char* vp = Vs + r32 * 80 + hi * 32;
  const u32x4 a0 = *reinterpret_cast<const LAS u32x4*>(vp), a1 = *reinterpret_cast<const LAS u32x4*>(vp + 16);
  const u32x4 b0 = *reinterpret_cast<const LAS u32x4*>(vp + 32 * 80), b1 = *reinterpret_cast<const LAS u32x4*>(vp + 32 * 80 + 16);
  const i32x8 va = {(int)a0[0], (int)a0[1], (int)a0[2], (int)a0[3], (int)a1[0], (int)a1[1], (int)a1[2], (int)a1[3]};
  const i32x8 vb = {(int)b0[0], (int)b0[1], (int)b0[2], (int)b0[3], (int)b1[0], (int)b1[1], (int)b1[2], (int)b1[3]};
  const i32x8 ones = {0x38383838, 0x38383838, 0x38383838, 0x38383838, 0x38383838, 0x38383838, 0x38383838, 0x38383838};
  asm volatile("s_nop 1\n\tv_mfma_f32_32x32x64_f8f6f4 %0, %1, %2, %0" : "+v"(o[0]) : "v"(va), "v"(pb));
  asm volatile("v_mfma_f32_32x32x64_f8f6f4 %0, %1, %2, %0" : "+v"(o[1]) : "v"(vb), "v"(pb));
  asm volatile("v_mfma_f32_32x32x64_f8f6f4 %0, %1, %2, %0" : "+v"(o[2]) : "v"(ones), "v"(pb));
}
#define PV_DRAIN() asm volatile("s_nop 15\n\ts_nop 7" : "+v"(o[0]), "+v"(o[1]), "+v"(o[2]))
__device__ __forceinline__ void attn_unit(const GAS unsigned char* __restrict__ Qb, const GAS unsigned char* __restrict__ Kh, const GAS unsigned char* __restrict__ Vh,
                                          GAS unsigned short* __restrict__ Ob, int ldo, int seq, LAS char* lds, int tid) {
  const int wid = tid >> 6, lane = tid & 63, r32 = lane & 31, hi = lane >> 5;
  LAS char* V_lds = lds + LDS_V; LAS char* K_lds = lds + LDS_K;
  f32x16 o[3] = {}; f32x16 negm = {};
  const GAS unsigned char* Qw = Qb + (long)(wid * QBLK + r32) * 128 + hi * 32;
  i32x8 q0, q1;
  { const u32x4 a = *reinterpret_cast<const GAS u32x4*>(Qw), b = *reinterpret_cast<const GAS u32x4*>(Qw + 16), c = *reinterpret_cast<const GAS u32x4*>(Qw + 64), d = *reinterpret_cast<const GAS u32x4*>(Qw + 80);
    q0 = (i32x8){(int)a[0], (int)a[1], (int)a[2], (int)a[3], (int)b[0], (int)b[1], (int)b[2], (int)b[3]}; q1 = (i32x8){(int)c[0], (int)c[1], (int)c[2], (int)c[3], (int)d[0], (int)d[1], (int)d[2], (int)d[3]}; }
  const int vst = (tid >> 2) * 80 + (tid & 3) * 16;
  const int kst0 = (tid >> 3) * 144 + (tid & 7) * 16;
  const bool hasv = wid < 4;
  struct { bf16x8 ks0, x1; } sr_[1];
#define SLOAD(i, k0) do { sr_[i].ks0 = *reinterpret_cast<const GAS bf16x8*>(Kh + (long)(k0) * 128 + tid * 16); \
    if (hasv) sr_[i].x1 = *reinterpret_cast<const GAS bf16x8*>(Vh + (long)((k0) / KVBLK) * 4096 + tid * 16); } while (0)
#define SWRITE(b, i) do { *(LAS bf16x8*)(K_lds + (b) * SHM_K + kst0) = sr_[i].ks0; \
    if (hasv) *(LAS bf16x8*)(V_lds + (b) * SHM_V + vst) = sr_[i].x1; } while (0)
#define RESC(flag, a) do { if (flag) { PV_DRAIN(); _Pragma("unroll") for (int d = 0; d < 3; ++d) _Pragma("unroll") for (int r = 0; r < 16; ++r) o[d][r] *= (a); } } while (0)
#define ATT_ILV() do { _Pragma("unroll") for (int i_ = 0; i_ < 12; ++i_) { __builtin_amdgcn_sched_group_barrier(0x008, 1, 0); __builtin_amdgcn_sched_group_barrier(0x400, 5, 0); __builtin_amdgcn_sched_group_barrier(0x002, 3, 0); __builtin_amdgcn_sched_group_barrier(0x100, 2, 0); } } while (0)
  f32x16 pA0, pA1, pB0, pB1; float alA = 1.f, alB = 1.f; bool rsA, rsB; i32x8 pb; KFrag kf; const int NT = seq / KVBLK;
#define KS(t) (K_lds + ((t) % NSLOT) * SHM_K)
#define VS(t) (V_lds + ((t) % NSLOT) * SHM_V)
  SLOAD(0, 0); SWRITE(0, 0); SLOAD(0, KVBLK); SWRITE(1, 0); SLOAD(0, 2 * KVBLK);
  __syncthreads();
  qkt(pA0, pA1, KS(0), q0, q1, negm, r32, hi); QK_DRAIN(pA0, pA1); (void)partialSM<true>(pA0, pA1, negm, alA);
  for (int j = 1; j + 1 < NT; j += 2) {
    __syncthreads(); SWRITE((j + 1) % NSLOT, 0); SLOAD(0, (j + 2) * KVBLK);
    SBAR(); qkt_load(kf, KS(j), r32, hi); SBAR();
    finishSM(pA0, pA1, pb); SBAR();
    qkt_mma(pB0, pB1, kf, q0, q1, negm); SBAR();
    pv_d0(o, VS(j - 1), pb, r32, hi); QK_DRAIN(pB0, pB1); rsB = partialSM<false>(pB0, pB1, negm, alB);
    RESC(rsB, alB);
    __syncthreads(); SWRITE((j + 2) % NSLOT, 0); if (j + 3 < NT) SLOAD(0, (j + 3) * KVBLK);
    SBAR(); qkt_load(kf, KS(j + 1), r32, hi); SBAR();
    finishSM(pB0, pB1, pb); SBAR();
    qkt_mma(pA0, pA1, kf, q0, q1, negm); SBAR();
    pv_d0(o, VS(j), pb, r32, hi); QK_DRAIN(pA0, pA1); rsA = partialSM<false>(pA0, pA1, negm, alA);
    RESC(rsA, alA);
  }
  __syncthreads();
  SBAR(); qkt(pB0, pB1, KS(NT - 1), q0, q1, negm, r32, hi);
  finishSM(pA0, pA1, pb); SBAR();
  pv_d0(o, VS(NT - 2), pb, r32, hi); QK_DRAIN(pB0, pB1); rsB = partialSM<false>(pB0, pB1, negm, alB);
  RESC(rsB, alB);
  finishSM(pB0, pB1, pb); SBAR();
  pv_d0(o, VS(NT - 1), pb, r32, hi);
#undef KS
#undef VS
  PV_DRAIN();
  const float rl = __builtin_amdgcn_rcpf(o[2][0]);
  GAS unsigned short* Ow = Ob + (long)(wid * QBLK + r32) * ldo + 4 * hi;
#pragma unroll
  for (int d0 = 0; d0 < 2; ++d0)
#pragma unroll
    for (int g = 0; g < 4; ++g) { unsigned long long w = (unsigned long long)cvtpk(o[d0][4 * g] * rl, o[d0][4 * g + 1] * rl) | ((unsigned long long)cvtpk(o[d0][4 * g + 2] * rl, o[d0][4 * g + 3] * rl) << 32);
      *(GAS unsigned long long*)(Ow + d0 * 32 + g * 8) = w; }
  __syncthreads();
#undef SLOAD
#undef ATT_ILV
#undef SWRITE
#undef RESC
}
#undef KSWZ
}

constexpr size_t WS_ROPE = WS_SMALL;
constexpr size_t WS_RSQ = WS_SMALL + 704 * 1024, WS_RSKV = WS_RSQ + (size_t)MR * 4;
static_assert(WS_RSKV + (size_t)MR * 4 <= WS_WIN, "small map");
constexpr size_t WS_QC = WS_Q + (size_t)NBATCH * 8 * SEQ * 128;
constexpr float MLA_QS = 4.f, MLA_KS = 0.25f;
static_assert(WS_QC + (size_t)NBATCH * 8 * CTXL * 128 <= WS_K && WS_K + (size_t)NBATCH * 8 * 16640 * 128 <= WS_V, "q8/k8 map");
constexpr float MLA_C2 = 0.10206207261596575f * 1.4426950408889634f;

__device__ __forceinline__ void p0_rope_table(const Frame& F0) { const Frame F = launder(F0);
    GAS float* T = (GAS float*)(F.ws + WS_ROPE);
    for (int i = blockIdx.x * NTHR + F.tid; i < 256 * 8; i += F.G * NTHR) {
        const int pos = i >> 3, e = i & 7;
        double inv = 1.0; for (int k = 0; k < (e >> 1); ++k) inv *= 0.1; if (e & 1) inv *= 0.31622776601683794;
        double rev = (double)pos * inv * 0.15915494309189535; rev -= (double)(long long)rev;
        T[2 * i] = __builtin_amdgcn_cosf((float)rev); T[2 * i + 1] = __builtin_amdgcn_sinf((float)rev);
    }
}
__device__ __forceinline__ void p_prep_mla_rows(const Frame& F0) { const Frame F = launder(F0);
    const GAS bf16* PH = (const GAS bf16*)(F.ws + WS_PH);
    GAS float* RSQ = (GAS float*)(F.ws + WS_RSQ); GAS float* RSKV = (GAS float*)(F.ws + WS_RSKV); const GAS float* T = (const GAS float*)(F.ws + WS_ROPE);
    for (int m = F.gw; m < MR; m += F.ngw) {
        const GAS bf16* row = PH + (size_t)m * NPH;
        const unsigned long long q4 = *((const GAS unsigned long long*)(row + PH_CQ) + F.lane);
        float a0 = bf2f((unsigned short)q4), a1 = bf2f((unsigned short)(q4 >> 16)), a2 = bf2f((unsigned short)(q4 >> 32)), a3 = bf2f((unsigned short)(q4 >> 48));
        const float sq = wave_sum(a0 * a0 + a1 * a1 + a2 * a2 + a3 * a3);
        float skv = 0.f, x = 0.f;
        if (F.lane < 32) { const unsigned long long k4 = *((const GAS unsigned long long*)(row + PH_CKV) + F.lane);
            a0 = bf2f((unsigned short)k4); a1 = bf2f((unsigned short)(k4 >> 16)); a2 = bf2f((unsigned short)(k4 >> 32)); a3 = bf2f((unsigned short)(k4 >> 48));
            skv = a0 * a0 + a1 * a1 + a2 * a2 + a3 * a3; x = bf2f(row[PH_KR + F.lane]); }
        skv = wave_sum(skv);
        if (F.lane == 0) { RSQ[m] = 1.f / sqrtf(sq * (1.f / 256.f) + RMS_EPS); RSKV[m] = 1.f / sqrtf(skv * (1.f / 128.f) + RMS_EPS); }
        const float xp = __shfl_xor(x, 8);
        int b, pos; float y = x;
        if (m < TL) { b = m >> 14; const int t = m & (SEQ - 1); pos = CTXL + t;
            const int i = F.lane & 31, half = i >> 4, w = i & 15, p = half ? (t & 63) : (t >> 6); const float c = T[(p * 8 + (w & 7)) * 2], s = T[(p * 8 + (w & 7)) * 2 + 1];
            y = (w < 8) ? (x * c - xp * s) : (xp * s + x * c); }
        else { b = (m - TL) >> 8; pos = (m - TL) & 255; }
        { const unsigned char yb = (unsigned char)(pk4_fp8(F.lane < 32 ? y * MLA_KS : 0.f, 0.f, 0.f, 0.f) & 0xffu);
          GAS unsigned char* K8 = F.ws + WS_K; GAS unsigned char* Q8 = m < TL ? F.ws + WS_Q : F.ws + WS_QC; const int qrows = m < TL ? SEQ : CTXL, qt = m < TL ? (m & (SEQ - 1)) : pos;
#pragma unroll
          for (int h = 0; h < 8; ++h) { K8[((size_t)(b * 8 + h) * att::NKEY + pos) * 128 + 64 + F.lane] = yb;
              if (F.lane >= 32) Q8[((size_t)(b * 8 + h) * qrows + qt) * 128 + 64 + F.lane] = 0; } }
    }
}
struct EpiMlaQ {
    static constexpr bool PERM = true, AFTER_DRAIN = false;
    GAS unsigned char* Q; GAS unsigned char* QC; const GAS float* rsq; const GAS float* rope;
    __device__ __forceinline__ void operator()(const pg8::f32x4 (&acc)[2][2][4][2], const Unit& u, int wr, int wc, int fr, int fq) const {
        const bool lat = u.pm < TL / 256;
        const int b = lat ? (u.pm >> 6) : (u.pm - TL / 256), t0 = lat ? (u.pm & 63) * 256 : 0, rows = lat ? SEQ : CTXL;
        GAS unsigned char* base = lat ? Q : QC;
        const unsigned lane_off = (unsigned)((wr * 64 + fr) * 128 + 8 * fq);
        const GAS float* rsp = rsq + u.pm * 256 + wr * 64 + fr;
#pragma unroll
        for (int ai = 0; ai < 2; ++ai)
#pragma unroll
            for (int m = 0; m < 4; ++m) { const float rs = rsp[ai * 128 + m * 16] * (MLA_C2 * MLA_QS);
                const int trow = t0 + ai * 128 + m * 16;
#pragma unroll
                for (int bj = 0; bj < 2; ++bj) { const int g32 = 8 * u.pn + 4 * bj + wc, head = g32 / 3, part = g32 - 3 * head;
                    float x[8];
#pragma unroll
                    for (int i = 0; i < 4; ++i) { x[i] = acc[ai][bj][m][0][i] * rs; x[4 + i] = acc[ai][bj][m][1][i] * rs; }
                    if (part == 2 && lat) {
                        const int p = (fq < 2) ? ((trow >> 6) + wr) : (m * 16 + fr); const GAS f32x4* cs = (const GAS f32x4*)(rope + p * 16);
#pragma unroll
                        for (int i2 = 0; i2 < 4; ++i2) { const f32x4 c4 = cs[i2];
                            const float xa = __shfl_xor(x[2 * i2], 16), xb = __shfl_xor(x[2 * i2 + 1], 16);
                            x[2 * i2] = (fq & 1) ? (xa * c4.y + x[2 * i2] * c4.x) : (x[2 * i2] * c4.x - xa * c4.y);
                            x[2 * i2 + 1] = (fq & 1) ? (xb * c4.w + x[2 * i2 + 1] * c4.z) : (x[2 * i2 + 1] * c4.z - xb * c4.w); }
                    }
                    v2u w; w.x = pk4_fp8(x[0], x[1], x[2], x[3]); w.y = pk4_fp8(x[4], x[5], x[6], x[7]);
                    const size_t soff = (((size_t)(b * 8 + head) * rows + trow) * 128 + part * 32);
                    *(GAS v2u*)(base + soff + lane_off) = w; }
                asm volatile("" ::: "memory"); }
    }
};
struct EpiMlaKV {
    static constexpr bool PERM = true, AFTER_DRAIN = false;
    GAS unsigned char* K; GAS bf16* V; const GAS float* rskv;
    __device__ __forceinline__ void operator()(const pg8::f32x4 (&acc)[2][2][4][2], const Unit& u, int wr, int wc, int fr, int fq) const {
        const bool lat = u.pm < TL / 256;
        const int b = lat ? (u.pm >> 6) : (u.pm - TL / 256), pos0 = lat ? CTXL + (u.pm & 63) * 256 : 0;
        const bool isk = wc < 2;
        const unsigned lane_off = isk ? (unsigned)((wr * 64 + fr) * 128 + 32 * (wc & 1) + 8 * fq) : (unsigned)(((wr * 64 + fr) * 64 + 32 * (wc & 1) + 8 * fq) * 2);
        const GAS float* rsp = rskv + u.pm * 256 + wr * 64 + fr;
#pragma unroll
        for (int ai = 0; ai < 2; ++ai)
#pragma unroll
            for (int m = 0; m < 4; ++m) { const float rs = rsp[ai * 128 + m * 16];
#pragma unroll
                for (int bj = 0; bj < 2; ++bj) { const int head = 2 * u.pn + bj;
                    const size_t rk = (size_t)(b * 8 + head) * att::NKEY + pos0 + ai * 128 + m * 16;
                    if (isk) { const pg8::f32x4 v0 = acc[ai][bj][m][0] * (rs * MLA_KS), v1 = acc[ai][bj][m][1] * (rs * MLA_KS);
                        v2u w; w.x = pk4_fp8(v0[0], v0[1], v0[2], v0[3]); w.y = pk4_fp8(v1[0], v1[1], v1[2], v1[3]);
                        *(GAS v2u*)(K + rk * 128 + lane_off) = w; }
                    else { const pg8::f32x4 v0 = acc[ai][bj][m][0] * rs, v1 = acc[ai][bj][m][1] * rs;
                        v4u w; w.x = pk2(v0[0], v0[1]); w.y = pk2(v0[2], v0[3]); w.z = pk2(v1[0], v1[1]); w.w = pk2(v1[2], v1[3]);
                        *(GAS v4u*)((GAS char*)V + rk * 128 + lane_off) = w; } }
                asm volatile("" ::: "memory"); }
    }
};
constexpr size_t WS_V8T = WS_QC + (size_t)NBATCH * 8 * CTXL * 128;
static_assert(WS_V8T + (size_t)NBATCH * 8 * (att::NKEY / 64) * 4096 <= WS_K, "v8t map");
__device__ __forceinline__ void p_attn_vt_pack(const Frame& F0) { const Frame F = launder(F0);
    LAS unsigned short* VL = (LAS unsigned short*)F.lds; const int tid = F.tid;
    const GAS bf16* V = (const GAS bf16*)(F.ws + WS_V); GAS unsigned char* V8T = F.ws + WS_V8T;
    const int ntile = att::NKEY / 64;
    for (int u = blockIdx.x; u < NBATCH * 8 * ntile; u += F.G) {
        const int bh = u / ntile, t = u % ntile;
        { const int key = tid >> 3, c8 = (tid & 7) * 8; const v4u w = *(const GAS v4u*)(V + ((size_t)bh * att::NKEY + t * 64 + key) * 64 + c8);
          LAS unsigned short* d = VL + key * 66 + c8; d[0] = (unsigned short)w.x; d[1] = (unsigned short)(w.x >> 16); d[2] = (unsigned short)w.y; d[3] = (unsigned short)(w.y >> 16);
          d[4] = (unsigned short)w.z; d[5] = (unsigned short)(w.z >> 16); d[6] = (unsigned short)w.w; d[7] = (unsigned short)(w.w >> 16); }
        __syncthreads();
        { const int v = tid >> 3, s8 = (tid & 7) * 8; float x[8];
#pragma unroll
          for (int e = 0; e < 8; ++e) { const int slot = s8 + e, hi = slot >> 5, j = slot & 31, jj = j & 15, key = (j >> 4) * 32 + (jj & 3) + 8 * (jj >> 2) + 4 * hi; x[e] = bf2f(VL[key * 66 + v]); }
          v2u o; o.x = pk4_fp8(x[0], x[1], x[2], x[3]); o.y = pk4_fp8(x[4], x[5], x[6], x[7]);
          *(GAS v2u*)(V8T + (size_t)u * 4096 + v * 64 + s8) = o; }
        __syncthreads();
    }
}
__device__ __forceinline__ void p_attention(const Frame& F0, bool with_ctx) { const Frame F = launder(F0);
    const GAS unsigned char* Q = F.ws + WS_Q; const GAS unsigned char* QC = F.ws + WS_QC; const GAS unsigned char* K = F.ws + WS_K; const GAS unsigned char* V8T = F.ws + WS_V8T;
    GAS bf16* Y = (GAS bf16*)(F.ws + WS_Y);
    LAS char* lds = (LAS char*)F.lds;
    const int nlat = NBATCH * 8 * (SEQ / 256);
    for (int i = 0;; ++i) {
        const int L = i * F.G + (int)blockIdx.x; if (L >= nlat) break;
        int bh, qb;
        if (F.G == 256) { const int xcd = blockIdx.x & 7, slot = blockIdx.x >> 3; bh = xcd + 8 * (i >> 1); qb = (i & 1) * 32 + slot; }
        else { bh = L / (SEQ / 256); qb = L % (SEQ / 256); }
        const int b = bh >> 3, h = bh & 7;
        att::attn_unit(Q + ((size_t)bh * SEQ + qb * 256) * 128, K + (size_t)bh * att::NKEY * 128, V8T + (size_t)bh * (att::NKEY / 64) * 4096,
                       Y + ((size_t)b * SEQ + qb * 256) * D + 512 + h * 64, D, att::NKEY, lds, F.tid);
    }
    if (with_ctx && (int)blockIdx.x < NBATCH * 8) { const int bh = blockIdx.x, b = bh >> 3, h = bh & 7;
        att::attn_unit(QC + (size_t)bh * CTXL * 128, K + (size_t)bh * att::NKEY * 128, V8T + (size_t)bh * (att::NKEY / 64) * 4096,
                       Y + ((size_t)TL + b * CTXL) * D + 512 + h * 64, D, CTXL, lds, F.tid);
    }
}
__device__ __forceinline__ void p_ynorm_c(const Frame& F0, int nrows, const GAS float* mg) { const Frame F = launder(F0);
    GAS bf16* Y = (GAS bf16*)(F.ws + WS_Y);
    for (int m = F.gw; m < nrows; m += F.ngw) {
        GAS v4u* p = (GAS v4u*)(Y + (size_t)m * D + 512) + F.lane; const v4u w = *p;
        float x[8]; x[0] = bf2f((unsigned short)w.x); x[1] = bf2f((unsigned short)(w.x >> 16)); x[2] = bf2f((unsigned short)w.y); x[3] = bf2f((unsigned short)(w.y >> 16));
        x[4] = bf2f((unsigned short)w.z); x[5] = bf2f((unsigned short)(w.z >> 16)); x[6] = bf2f((unsigned short)w.w); x[7] = bf2f((unsigned short)(w.w >> 16));
        float s = 0.f;
#pragma unroll
        for (int i = 0; i < 8; ++i) s += x[i] * x[i];
        const float rs = 1.f / sqrtf(wave_sum(s) * (1.f / 512.f) + RMS_EPS);
        const f32x4 g0 = ((const GAS f32x4*)mg)[2 * F.lane], g1 = ((const GAS f32x4*)mg)[2 * F.lane + 1];
        v4u o; o.x = pk2(x[0] * rs * g0.x, x[1] * rs * g0.y); o.y = pk2(x[2] * rs * g0.z, x[3] * rs * g0.w); o.z = pk2(x[4] * rs * g1.x, x[5] * rs * g1.y); o.w = pk2(x[6] * rs * g1.z, x[7] * rs * g1.w);
        *p = o;
    }
}

constexpr int GLA_NCH = 4 + SEQ / 64;
constexpr size_t WS_SLOC = WS_XN, WS_GDEC = AB + 521 * MiB;
static_assert(WS_SLOC + (size_t)NBATCH * 4 * 2 * GLA_NCH * 2048 * 4 <= WS_XN + 33 * MiB && (size_t)NBATCH * 4 * 2 * GLA_NCH * 32 * 4 <= 5 * MiB && GLA_NCH % 20 == 0, "gla map");
constexpr int GB_LA = 0, GB_K = GB_LA + 16384, GB_Q = GB_K + 8192, GB_ALR = GB_Q + 8192, GB_WG = GB_ALR + 8192, GB_BG = GB_WG + 4096, GB_O = GB_BG + 256,
              GB_QF = GB_O + 64 * 65 * 4, GB_QB = GB_QF + 5120, GB_KF = GB_QB + 5120, GB_KB = GB_KF + 5120, GB_KTF = GB_KB + 5120, GB_KTB = GB_KTF + 4608, GB_VT = GB_KTB + 4608,
              GB_ATT = GB_VT + 9216, GB_STF = GB_ATT + 9216, GB_STB = GB_STF + 5120, GB_END = GB_STB + 5120;
static_assert(GB_END <= 131072 && GB_QF % 16 == 0, "gla lds");
typedef short gbf16x8 __attribute__((ext_vector_type(8)));
typedef float gf32x16 __attribute__((ext_vector_type(16)));
__device__ __forceinline__ float logsigmoidf(float z) { return fminf(z, 0.f) - __logf(1.f + __expf(-fabsf(z))); }
__device__ __forceinline__ unsigned short bf1(float x) { return (unsigned short)(pk2(x, x) & 0xffffu); }
__device__ __forceinline__ void ld8bf(const GAS bf16* p, LAS float* d) { const v4u w = *(const GAS v4u*)p;
    d[0] = bf2f((unsigned short)w.x); d[1] = bf2f((unsigned short)(w.x >> 16)); d[2] = bf2f((unsigned short)w.y); d[3] = bf2f((unsigned short)(w.y >> 16));
    d[4] = bf2f((unsigned short)w.z); d[5] = bf2f((unsigned short)(w.z >> 16)); d[6] = bf2f((unsigned short)w.w); d[7] = bf2f((unsigned short)(w.w >> 16)); }
__device__ __forceinline__ int gcrow(int r, int hi) { return (r & 3) + 8 * (r >> 2) + 4 * hi; }
template <int KD>
__device__ __forceinline__ void gmm(gf32x16& acc, const LAS unsigned char* A, int sa, int m0, const LAS unsigned char* BT, int sb, int n0, int r32, int hi) {
#pragma unroll
    for (int kt = 0; kt < KD / 16; ++kt) { const gbf16x8 a = *(const LAS gbf16x8*)(A + (m0 + r32) * sa + (kt * 16 + hi * 8) * 2), b = *(const LAS gbf16x8*)(BT + (n0 + r32) * sb + (kt * 16 + hi * 8) * 2);
        acc = __builtin_amdgcn_mfma_f32_32x32x16_bf16(a, b, acc, 0, 0, 0); }
}
__device__ __forceinline__ void gla_head(const Frame& F, int l, int b, int h, int jj, bool want_q) {
    LAS unsigned char* LB = F.lds; LAS float* LA = (LAS float*)(LB + GB_LA); LAS float* KK = (LAS float*)(LB + GB_K); LAS float* QQ = (LAS float*)(LB + GB_Q); LAS float* ALR = (LAS float*)(LB + GB_ALR);
    LAS float* WG = (LAS float*)(LB + GB_WG); LAS float* BG = (LAS float*)(LB + GB_BG); LAS unsigned short* VT = (LAS unsigned short*)(LB + GB_VT);
    const int tid = F.tid;
    const int row0 = jj < 4 ? TL + b * CTXL + jj * 64 : b * SEQ + (jj - 4) * 64;
    const GAS bf16* PH = (const GAS bf16*)(F.ws + WS_PH) + (size_t)row0 * NPH;
    { const int t = (tid & 255) >> 2, c = (tid & 3) * 8;
      if (tid < 256) { ld8bf(PH + (size_t)t * NPH + PH_KA + h * 32 + c, KK + t * 32 + c); ld8bf(PH + (size_t)t * NPH + PH_ALR + c, ALR + t * 32 + c); }
      else if (want_q) ld8bf(PH + (size_t)t * NPH + PH_QA + h * 32 + c, QQ + t * 32 + c); }
    { const int t = tid >> 3, c = (tid & 7) * 8; const v4u w = *(const GAS v4u*)(PH + (size_t)t * NPH + PH_VA + h * 64 + c);
      VT[(c + 0) * 72 + t] = (unsigned short)w.x; VT[(c + 1) * 72 + t] = (unsigned short)(w.x >> 16); VT[(c + 2) * 72 + t] = (unsigned short)w.y; VT[(c + 3) * 72 + t] = (unsigned short)(w.y >> 16);
      VT[(c + 4) * 72 + t] = (unsigned short)w.z; VT[(c + 5) * 72 + t] = (unsigned short)(w.z >> 16); VT[(c + 6) * 72 + t] = (unsigned short)w.w; VT[(c + 7) * 72 + t] = (unsigned short)(w.w >> 16); }
    { const GAS float* wg = F.in[I_GWG] + (size_t)l * 2 * 16 * 128;
      for (int i = tid; i < 1024; i += NTHR) { const int d = i >> 9, r = (i >> 5) & 15, k = i & 31; WG[i] = wg[(d * 16 + r) * 128 + h * 32 + k]; }
      if (tid < 64) BG[tid] = F.in[I_GBG][l * 256 + (tid >> 5) * 128 + h * 32 + (tid & 31)]; }
    __syncthreads();
    { const int k = tid & 31, t0 = tid >> 5;
#pragma unroll
      for (int d = 0; d < 2; ++d)
#pragma unroll
        for (int tt = 0; tt < 4; ++tt) { const int t = t0 + 16 * tt; float z = BG[d * 32 + k];
#pragma unroll
            for (int r = 0; r < 16; ++r) z += ALR[t * 32 + d * 16 + r] * WG[(d * 16 + r) * 32 + k];
            LA[(d * 64 + t) * 32 + k] = logsigmoidf(z) * (1.f / 16.f); } }
    __syncthreads();
    { const int w = tid >> 6, lane = tid & 63;
#pragma unroll
      for (int c = 0; c < 8; ++c) { const int col = w * 8 + c, d = col >> 5, k = col & 31; float v = LA[(d * 64 + lane) * 32 + k];
#pragma unroll
          for (int o = 1; o < 64; o <<= 1) { const float u = d == 0 ? __shfl_up(v, o) : __shfl_down(v, o); if (d == 0 ? lane >= o : lane + o < 64) v += u; }
          LA[(d * 64 + lane) * 32 + k] = v; } }
    __syncthreads();
}
__device__ __forceinline__ void p_gla_local(const Frame& F0, int l) { const Frame F = launder(F0);
    LAS unsigned char* LB = F.lds; LAS float* LA = (LAS float*)(LB + GB_LA); LAS float* KK = (LAS float*)(LB + GB_K); const int tid = F.tid;
    LAS unsigned short* KTF = (LAS unsigned short*)(LB + GB_KTF); LAS unsigned short* KTB = (LAS unsigned short*)(LB + GB_KTB);
    GAS float* SLOC = (GAS float*)(F.ws + WS_SLOC); GAS float* GDEC = (GAS float*)(F.ws + WS_GDEC);
    const int wv = tid >> 6, lane = tid & 63, r32 = lane & 31, hi = lane >> 5;
    for (int u = blockIdx.x; u < NBATCH * 4 * GLA_NCH; u += F.G) {
        const int b = u / (4 * GLA_NCH), h = (u / GLA_NCH) & 3, jj = u % GLA_NCH;
        gla_head(F, l, b, h, jj, false);
        for (int i = tid; i < 2048; i += NTHR) { const int t = i >> 5, k = i & 31; const float kv = KK[i];
            KTF[k * 72 + t] = bf1(kv * __expf(LA[63 * 32 + k] - LA[t * 32 + k]));
            KTB[k * 72 + t] = bf1(kv * __expf(LA[64 * 32 + k] - LA[(64 + t) * 32 + k])); }
        __syncthreads();
        if (wv < 4) { const int dir = wv >> 1, nt = wv & 1; gf32x16 acc = {};
            gmm<64>(acc, LB + (dir ? GB_KTB : GB_KTF), 144, 0, LB + GB_VT, 144, nt * 32, r32, hi);
            GAS float* dst = SLOC + ((size_t)((b * 4 + h) * 2 + dir) * GLA_NCH + jj) * 2048 + nt * 32 + r32;
#pragma unroll
            for (int r = 0; r < 16; ++r) dst[gcrow(r, hi) * 64] = acc[r]; }
        if (tid < 64) { const int d = tid >> 5, kk = tid & 31; GDEC[((size_t)((b * 4 + h) * 2 + d) * GLA_NCH + jj) * 32 + kk] = __expf(d ? LA[64 * 32 + kk] : LA[63 * 32 + kk]); }
        __syncthreads();
    }
}
__device__ __forceinline__ void p_gla_scan(const Frame& F0) { const Frame F = launder(F0);
    GAS float* SLOC = (GAS float*)(F.ws + WS_SLOC); const GAS float* GDEC = (const GAS float*)(F.ws + WS_GDEC);
    if (F.tid < 128) for (int it = blockIdx.x; it < 256; it += F.G) {
        const int chain = it >> 4, e = (it & 15) * 128 + F.tid, k = e >> 6, dir = chain & 1;
        GAS float* sl = SLOC + (size_t)chain * GLA_NCH * 2048 + e; const GAS float* dc = GDEC + (size_t)chain * GLA_NCH * 32 + k;
        float S = 0.f;
        for (int j0 = 0; j0 < GLA_NCH; j0 += 20) { float lv[20], dv[20];
#pragma unroll
            for (int q = 0; q < 20; ++q) { const int j = j0 + q, jx = dir == 0 ? j : (j < 4 ? 3 - j : GLA_NCH + 3 - j); lv[q] = sl[(size_t)jx * 2048]; dv[q] = dc[jx * 32]; }
#pragma unroll
            for (int q = 0; q < 20; ++q) { const int j = j0 + q, jx = dir == 0 ? j : (j < 4 ? 3 - j : GLA_NCH + 3 - j); sl[(size_t)jx * 2048] = S; S = dv[q] * S + lv[q]; } }
    }
}
__device__ __forceinline__ void p_gla_out(const Frame& F0, int l, bool with_ctx) { const Frame F = launder(F0);
    LAS unsigned char* LB = F.lds; LAS float* LA = (LAS float*)(LB + GB_LA); LAS float* KK = (LAS float*)(LB + GB_K); LAS float* QQ = (LAS float*)(LB + GB_Q); LAS float* OO = (LAS float*)(LB + GB_O);
    LAS unsigned short* QF = (LAS unsigned short*)(LB + GB_QF); LAS unsigned short* QB = (LAS unsigned short*)(LB + GB_QB); LAS unsigned short* KF = (LAS unsigned short*)(LB + GB_KF); LAS unsigned short* KB = (LAS unsigned short*)(LB + GB_KB);
    LAS unsigned short* ATT = (LAS unsigned short*)(LB + GB_ATT); LAS unsigned short* STF = (LAS unsigned short*)(LB + GB_STF); LAS unsigned short* STB = (LAS unsigned short*)(LB + GB_STB);
    const int tid = F.tid, wv = tid >> 6, lane = tid & 63, r32 = lane & 31, hi = lane >> 5;
    const GAS float* SLOC = (const GAS float*)(F.ws + WS_SLOC); GAS bf16* Y = (GAS bf16*)(F.ws + WS_Y); const GAS bf16* PHB = (const GAS bf16*)(F.ws + WS_PH);
    const GAS float* gng = F.in[I_GNG] + l * 64;
    for (int u = blockIdx.x; u < NBATCH * 4 * GLA_NCH; u += F.G) {
        const int b = u / (4 * GLA_NCH), h = (u / GLA_NCH) & 3, jj = u % GLA_NCH;
        if (jj < 4 && !with_ctx) continue;
        gla_head(F, l, b, h, jj, true);
        for (int i = tid; i < 2048; i += NTHR) { const int t = i >> 5, k = i & 31; const float qv = QQ[i] * 0.17677669529663687f, kv = KK[i];
            const float bf_ = LA[t * 32 + k], bb_ = LA[(64 + t) * 32 + k];
            QF[t * 40 + k] = bf1(qv * __expf(bf_)); KF[t * 40 + k] = bf1(kv * __expf(-bf_)); QB[t * 40 + k] = bf1(qv * __expf(bb_)); KB[t * 40 + k] = bf1(kv * __expf(-bb_)); }
        { const GAS float* s0 = SLOC + ((size_t)((b * 4 + h) * 2 + 0) * GLA_NCH + jj) * 2048; const GAS float* s1 = SLOC + ((size_t)((b * 4 + h) * 2 + 1) * GLA_NCH + jj) * 2048;
          const int k = tid >> 4, v4 = (tid & 15) * 4; const f32x4 a = *(const GAS f32x4*)(s0 + k * 64 + v4), c = *(const GAS f32x4*)(s1 + k * 64 + v4);
          STF[(v4 + 0) * 40 + k] = bf1(a.x); STF[(v4 + 1) * 40 + k] = bf1(a.y); STF[(v4 + 2) * 40 + k] = bf1(a.z); STF[(v4 + 3) * 40 + k] = bf1(a.w);
          STB[(v4 + 0) * 40 + k] = bf1(c.x); STB[(v4 + 1) * 40 + k] = bf1(c.y); STB[(v4 + 2) * 40 + k] = bf1(c.z); STB[(v4 + 3) * 40 + k] = bf1(c.w); }
        __syncthreads();
        gf32x16 acc = {};
        const int mt = wv & 1, nt = (wv >> 1) & 1;
        if (wv < 4) {
            gf32x16 af = {}, ab = {};
            gmm<32>(af, LB + GB_QF, 80, mt * 32, LB + GB_KF, 80, nt * 32, r32, hi); gmm<32>(ab, LB + GB_QB, 80, mt * 32, LB + GB_KB, 80, nt * 32, r32, hi);
            const int s = nt * 32 + r32;
#pragma unroll
            for (int r = 0; r < 16; ++r) { const int t = mt * 32 + gcrow(r, hi); const float a = (s <= t ? af[r] : 0.f) + (s >= t ? ab[r] : 0.f); ATT[t * 72 + s] = bf1(a); }
        } else {
            gmm<32>(acc, LB + GB_QF, 80, mt * 32, LB + GB_STF, 80, nt * 32, r32, hi); gmm<32>(acc, LB + GB_QB, 80, mt * 32, LB + GB_STB, 80, nt * 32, r32, hi);
        }
        __syncthreads();
        if (wv >= 4) { gmm<64>(acc, LB + GB_ATT, 144, mt * 32, LB + GB_VT, 144, nt * 32, r32, hi);
#pragma unroll
            for (int r = 0; r < 16; ++r) OO[(mt * 32 + gcrow(r, hi)) * 65 + nt * 32 + r32] = acc[r]; }
        __syncthreads();
        { const int t = tid >> 3, vg = tid & 7; float o8[8], ss = 0.f;
#pragma unroll
          for (int i = 0; i < 8; ++i) { o8[i] = OO[t * 65 + vg * 8 + i]; ss += o8[i] * o8[i]; }
          ss += __shfl_xor(ss, 1); ss += __shfl_xor(ss, 2); ss += __shfl_xor(ss, 4);
          const float rs = 1.f / sqrtf(ss * (1.f / 64.f) + RMS_EPS);
          const int row = (jj < 4 ? TL + b * CTXL + jj * 64 : b * SEQ + (jj - 4) * 64) + t;
          const v4u gw = *(const GAS v4u*)(PHB + (size_t)row * NPH + PH_GA + h * 64 + vg * 8);
          float ga[8]; ga[0] = bf2f((unsigned short)gw.x); ga[1] = bf2f((unsigned short)(gw.x >> 16)); ga[2] = bf2f((unsigned short)gw.y); ga[3] = bf2f((unsigned short)(gw.y >> 16));
          ga[4] = bf2f((unsigned short)gw.z); ga[5] = bf2f((unsigned short)(gw.z >> 16)); ga[6] = bf2f((unsigned short)gw.w); ga[7] = bf2f((unsigned short)(gw.w >> 16));
          float y[8];
#pragma unroll
          for (int i = 0; i < 8; ++i) y[i] = o8[i] * rs * gng[vg * 8 + i] * siluf(ga[i]);
          v4u o; o.x = pk2(y[0], y[1]); o.y = pk2(y[2], y[3]); o.z = pk2(y[4], y[5]); o.w = pk2(y[6], y[7]);
          *(GAS v4u*)(Y + (size_t)row * D + h * 64 + vg * 8) = o; }
        __syncthreads();
    }
}

constexpr int FN = 32768, FN1 = 128, FN2 = 256;
constexpr size_t WS_FA = WS_XN + 33 * MiB;
constexpr size_t WS_HT = WS_PH;
constexpr size_t WS_FA0 = WS_K, WS_FA1 = WS_VT;
constexpr size_t WS_HID = AB + 521 * MiB, WS_HTC = AB + 526 * MiB, WS_CU = AB + 527 * MiB, WS_OTC = AB + 529 * MiB, WS_NPART = AB + 530 * MiB, WS_END2 = AB + 532 * MiB;
static_assert(WS_FA0 + 64 * MiB <= WS_VT && WS_FA1 + 64 * MiB <= WS_HF && WS_END2 <= 573 * MiB, "hyena map");
constexpr size_t CTL_NRM = 256 * 1024;
constexpr int FFT_TW_OFF = 40960;
typedef float f32x2 __attribute__((ext_vector_type(2)));
__device__ __forceinline__ f32x2 cmul(f32x2 a, f32x2 b) { return (f32x2){a.x * b.x - a.y * b.y, a.x * b.y + a.y * b.x}; }
__device__ __forceinline__ unsigned pkc(f32x2 v) { return pk2(v.x, v.y); }
__device__ __forceinline__ f32x2 upc(unsigned w) { return (f32x2){__uint_as_float(w << 16), __uint_as_float(w & 0xffff0000u)}; }
__device__ __forceinline__ f32x2 twid(float rev) { return (f32x2){__builtin_amdgcn_cosf(rev), __builtin_amdgcn_sinf(rev)}; }
__device__ __forceinline__ float nrm_lat(const Frame& F, int order, int c) {
    LAS float* red = (LAS float*)(F.lds + FFT_TW_OFF + 1024); const GAS float* NP = (const GAS float*)(F.ws + WS_NPART);
    const float v = wave_sum(NP[(size_t)(F.tid & 255) * 1024 + order * 512 + (F.tid >> 8) * 256 + c]);
    __syncthreads(); if (F.lane == 0) red[F.wave] = v; __syncthreads();
    float s = 0.f;
#pragma unroll
    for (int w = 0; w < 8; ++w) s += red[w];
    return 1.f / sqrtf(s + 1e-6f);
}
__device__ __forceinline__ float nrm_ctx(const Frame& F, int order, int c) { const GAS float* NP = (const GAS float*)(F.ws + WS_NPART); float s = 0.f;
#pragma unroll
    for (int pb = 256; pb < 260; ++pb) s += NP[(size_t)pb * 1024 + order * 512 + c] + NP[(size_t)pb * 1024 + order * 512 + 256 + c];
    return 1.f / sqrtf(s + 1e-6f); }

__device__ __forceinline__ void p_filt_hidden(const Frame& F0, int l) { const Frame F = launder(F0);
    LAS float* L = (LAS float*)F.lds; LAS float* W1 = L, * W2 = L + 33 * 64, * H1 = W2 + 64 * 64, * PB = H1 + 128 * 65;
    GAS float* HID = (GAS float*)(F.ws + WS_HID); const int tid = F.tid;
    for (int i = tid; i < 33 * 64; i += NTHR) W1[i] = F.in[I_HW1][l * 33 * 64 + i];
    for (int i = tid; i < 64 * 64; i += NTHR) W2[i] = F.in[I_HW2][l * 64 * 64 + i];
    if (tid < 64) { PB[tid] = F.in[I_HB1][l * 64 + tid]; PB[64 + tid] = F.in[I_HF1][l * 64 + tid]; PB[128 + tid] = F.in[I_HB2][l * 64 + tid]; PB[192 + tid] = F.in[I_HF2][l * 64 + tid]; }
    __syncthreads();
    const int p = tid & 127, jq = tid >> 7;
    for (int blk = blockIdx.x; blk < (SEQ + CTXL) / 128; blk += F.G) {
        const int prow = blk * 128 + p; const bool lat = prow < SEQ; const int pos = lat ? prow : prow - SEQ; const float Lf = lat ? (float)SEQ : (float)CTXL;
        float z[33]; z[0] = (float)pos / (Lf - 1.f);
#pragma unroll
        for (int i = 0; i < 16; ++i) { const float fr = 1e-4f + (float)i * ((15.f - 1e-4f) / 15.f); float rev = (float)pos * fr / Lf; rev -= floorf(rev);
            z[1 + i] = __builtin_amdgcn_cosf(rev); z[17 + i] = -__builtin_amdgcn_sinf(rev); }
        for (int j = jq * 16; j < jq * 16 + 16; ++j) { float a = PB[j];
#pragma unroll
            for (int i = 0; i < 33; ++i) a += z[i] * W1[i * 64 + j];
            H1[p * 65 + j] = __sinf(PB[64 + j] * a); }
        __syncthreads();
        for (int j = jq * 16; j < jq * 16 + 16; ++j) { float a = PB[128 + j];
            for (int i = 0; i < 64; ++i) a += H1[p * 65 + i] * W2[i * 64 + j];
            HID[(size_t)prow * 64 + j] = __sinf(PB[192 + j] * a); }
        __syncthreads();
    }
}
__device__ __forceinline__ void p_filt_raw(const Frame& F0, int l) { const Frame F = launder(F0);
    LAS float* L = (LAS float*)F.lds; LAS float* HS = L, * W3 = L + 64 * 65; const int tid = F.tid;
    const GAS float* HID = (const GAS float*)(F.ws + WS_HID); GAS float* HT = (GAS float*)(F.ws + WS_HT); GAS float* HTC = (GAS float*)(F.ws + WS_HTC);
    const GAS float* w3 = F.in[I_HW3] + (size_t)l * 64 * 1024; const GAS float* b3 = F.in[I_HB3] + l * 1024;
    const int pg = tid & 15, cg = tid >> 4;
    for (int u = blockIdx.x; u < ((SEQ + CTXL) / 64) * 4; u += F.G) {
        const int pb = u >> 2, cb = u & 3, prow0 = pb * 64; const bool lat = prow0 < SEQ; const int pos0 = lat ? prow0 : prow0 - SEQ; const float Lf = lat ? (float)SEQ : (float)CTXL;
        for (int i = tid; i < 64 * 64; i += NTHR) HS[(i >> 6) * 65 + (i & 63)] = HID[(size_t)prow0 * 64 + i];
        for (int i = tid; i < 64 * 256; i += NTHR) W3[i] = w3[(size_t)(i >> 8) * 1024 + cb * 256 + (i & 255)];
        __syncthreads();
        float acc[4][8];
#pragma unroll
        for (int a = 0; a < 4; ++a)
#pragma unroll
            for (int c = 0; c < 8; ++c) acc[a][c] = 0.f;
        for (int i = 0; i < 64; ++i) { const f32x4 w0 = *(const LAS f32x4*)(W3 + i * 256 + cg * 8), w1 = *(const LAS f32x4*)(W3 + i * 256 + cg * 8 + 4);
#pragma unroll
            for (int a = 0; a < 4; ++a) { const float hv = HS[(pg * 4 + a) * 65 + i];
                acc[a][0] += hv * w0.x; acc[a][1] += hv * w0.y; acc[a][2] += hv * w0.z; acc[a][3] += hv * w0.w; acc[a][4] += hv * w1.x; acc[a][5] += hv * w1.y; acc[a][6] += hv * w1.z; acc[a][7] += hv * w1.w; } }
        float ss[8];
#pragma unroll
        for (int c = 0; c < 8; ++c) { const int col = cb * 256 + cg * 8 + c, ch = col & 255; const float delta = 3.0701134573253944f + (float)ch * (12.280453829301578f / 255.f), bias = b3[col];
            float o[4]; ss[c] = 0.f;
#pragma unroll
            for (int a = 0; a < 4; ++a) { const float t = (float)(pos0 + pg * 4 + a) / (Lf - 1.f); o[a] = (acc[a][c] + bias) * __expf(-t * delta); ss[c] += o[a] * o[a]; }
            GAS float* dst = lat ? HT + (size_t)col * SEQ + pos0 + pg * 4 : HTC + (size_t)col * CTXL + pos0 + pg * 4;
            *(GAS f32x4*)dst = (f32x4){o[0], o[1], o[2], o[3]}; }
#pragma unroll
        for (int c = 0; c < 8; ++c) { float s = ss[c]; s += __shfl_xor(s, 1); s += __shfl_xor(s, 2); s += __shfl_xor(s, 4); s += __shfl_xor(s, 8); ss[c] = s; }
        if (pg == 0) { GAS float* np = (GAS float*)(F.ws + WS_NPART) + (size_t)pb * 1024 + cb * 256 + cg * 8;
            *(GAS f32x4*)np = (f32x4){ss[0], ss[1], ss[2], ss[3]}; *(GAS f32x4*)(np + 4) = (f32x4){ss[4], ss[5], ss[6], ss[7]}; }
        __syncthreads();
    }
}
__device__ __forceinline__ void fft_tw_init(LAS unsigned char* lds, int tid) { if (tid < 128) ((LAS f32x2*)(lds + FFT_TW_OFF))[tid] = twid(-(float)tid * (1.f / 256.f)); __syncthreads(); }
__device__ __forceinline__ f32x2 cconj(f32x2 a) { return (f32x2){a.x, -a.y}; }
__device__ __forceinline__ f32x2 mul_mi(f32x2 a) { return (f32x2){a.y, -a.x}; }
__device__ __forceinline__ f32x2 mul_pi(f32x2 a) { return (f32x2){-a.y, a.x}; }
template <int ST>
__device__ __forceinline__ void dif4(LAS f32x2* X, const LAS f32x2* TW, int base, int g, int s) {
    const int h = 1 << s, p = g & ((h >> 1) - 1), i = (((g >> (s - 1)) << (s + 1)) | p);
    LAS f32x2* P0 = X + base + i * ST; LAS f32x2* P1 = P0 + (h >> 1) * ST; LAS f32x2* P2 = P0 + h * ST; LAS f32x2* P3 = P1 + h * ST;
    const f32x2 x0 = *P0, x1 = *P1, x2 = *P2, x3 = *P3, wa = TW[p << (7 - s)], wc = TW[p << (8 - s)];
    const f32x2 y0 = x0 + x2, y2 = cmul(x0 - x2, wa), y1 = x1 + x3, y3 = mul_mi(cmul(x1 - x3, wa));
    *P0 = y0 + y1; *P1 = cmul(y0 - y1, wc); *P2 = y2 + y3; *P3 = cmul(y2 - y3, wc);
}
template <int ST>
__device__ __forceinline__ void dit4(LAS f32x2* X, const LAS f32x2* TW, int base, int g, int s) {
    const int h = 1 << s, p = g & (h - 1), i = (((g >> s) << (s + 2)) | p);
    LAS f32x2* P0 = X + base + i * ST; LAS f32x2* P1 = P0 + h * ST; LAS f32x2* P2 = P1 + h * ST; LAS f32x2* P3 = P2 + h * ST;
    const f32x2 w1 = cconj(TW[p << (7 - s)]), w2 = cconj(TW[p << (6 - s)]);
    const f32x2 x0 = *P0, x1 = cmul(*P1, w1), x2 = *P2, x3 = cmul(*P3, w1);
    const f32x2 y0 = x0 + x1, y1 = x0 - x1, y2 = cmul(x2 + x3, w2), y3 = mul_pi(cmul(x2 - x3, w2));
    *P0 = y0 + y2; *P2 = y0 - y2; *P1 = y1 + y3; *P3 = y1 - y3;
}
__device__ __forceinline__ void fft128_cols_fwd(LAS f32x2* X, int tid) {
    const int j = tid & 31, q0 = tid >> 5; const LAS f32x2* TW = (const LAS f32x2*)((const LAS unsigned char*)X + FFT_TW_OFF);
#pragma unroll 1
    for (int s = 6; s >= 2; s -= 2) { dif4<32>(X, TW, j, q0, s); dif4<32>(X, TW, j, q0 + 16, s); __syncthreads(); }
#pragma unroll
    for (int i = 0; i < 4; ++i) { const int q = q0 + 16 * i; const f32x2 a = X[(2 * q) * 32 + j], b = X[(2 * q + 1) * 32 + j]; X[(2 * q) * 32 + j] = a + b; X[(2 * q + 1) * 32 + j] = a - b; }
    __syncthreads();
}
__device__ __forceinline__ void fft128_cols_inv(LAS f32x2* X, int tid) {
    const int j = tid & 31, q0 = tid >> 5; const LAS f32x2* TW = (const LAS f32x2*)((const LAS unsigned char*)X + FFT_TW_OFF);
#pragma unroll
    for (int i = 0; i < 4; ++i) { const int q = q0 + 16 * i; const f32x2 a = X[(2 * q) * 32 + j], b = X[(2 * q + 1) * 32 + j]; X[(2 * q) * 32 + j] = a + b; X[(2 * q + 1) * 32 + j] = a - b; }
    __syncthreads();
#pragma unroll 1
    for (int s = 1; s <= 5; s += 2) { dit4<32>(X, TW, j, q0, s); dit4<32>(X, TW, j, q0 + 16, s); __syncthreads(); }
}
__device__ __forceinline__ void fft256_rows_fwd(LAS f32x2* X, int tid) {
    const int g = tid & 63, r0 = tid >> 6; const LAS f32x2* TW = (const LAS f32x2*)((const LAS unsigned char*)X + FFT_TW_OFF);
#pragma unroll 1
    for (int s = 7; s >= 1; s -= 2) { dif4<1>(X, TW, r0 * 256, g, s); dif4<1>(X, TW, (r0 + 8) * 256, g, s); __syncthreads(); }
}
__device__ __forceinline__ void fft256_rows_inv(LAS f32x2* X, int tid) {
    const int g = tid & 63, r0 = tid >> 6; const LAS f32x2* TW = (const LAS f32x2*)((const LAS unsigned char*)X + FFT_TW_OFF);
#pragma unroll 1
    for (int s = 0; s <= 6; s += 2) { dit4<1>(X, TW, r0 * 256, g, s); dit4<1>(X, TW, (r0 + 8) * 256, g, s); __syncthreads(); }
}
__device__ __forceinline__ int bitrev7(int r) { return (int)(__brev((unsigned)r) >> 25); }
template <int KIND>
__device__ __forceinline__ void p_fft_pass1(const Frame& F0, int order, size_t ws_a) { const Frame F = launder(F0);
    fft_tw_init(F.lds, F.tid);
    LAS f32x2* X = (LAS f32x2*)F.lds; const int tid = F.tid, j = tid & 31, q0 = tid >> 5;
    const GAS float* VT = (const GAS float*)(F.ws + WS_VT); const GAS float* HT = (const GAS float*)(F.ws + WS_HT); GAS unsigned* A = (GAS unsigned*)(F.ws + ws_a);
    f32x2 pre[8];
#define P1_LOAD(uu) do { const int sg_ = (uu) >> 3, nb_ = (uu) & 7; _Pragma("unroll") for (int i = 0; i < 8; ++i) { const int n1 = q0 + 16 * i, n = 256 * n1 + 32 * nb_ + j; f32x2 v = {0.f, 0.f}; \
        if (KIND == 0) { if (n1 < 64) { v.x = VT[(size_t)(sg_ * 2 + 0) * SEQ + n]; v.y = VT[(size_t)(sg_ * 2 + 1) * SEQ + n]; } } \
        else { const GAS float* hf = HT + (size_t)(order * 512 + sg_) * SEQ; const GAS float* hb = HT + (size_t)(order * 512 + 256 + sg_) * SEQ; \
               if (n < SEQ) v.x = hf[n]; else if (n > SEQ) v.x = hb[2 * SEQ - n]; } \
        pre[i] = v; } } while (0)
    int u = blockIdx.x; if (u < 256 * 8) P1_LOAD(u);
    for (; u < 256 * 8; u += F.G) {
        const int sg = u >> 3, nb = u & 7;
#pragma unroll
        for (int i = 0; i < 8; ++i) X[(q0 + 16 * i) * 32 + j] = pre[i];
        __syncthreads();
        if (u + F.G < 256 * 8) P1_LOAD(u + F.G);
        fft128_cols_fwd(X, tid);
#pragma unroll
        for (int i = 0; i < 8; ++i) { const int r = q0 + 16 * i, k1 = bitrev7(r), n2 = 32 * nb + j;
            A[((size_t)sg * FN1 + r) * FN2 + n2] = pkc(cmul(X[r * 32 + j], twid(-(float)(n2 * k1) * (1.f / (float)FN)))); }
        __syncthreads();
    }
#undef P1_LOAD
}
template <int KIND>
__device__ __forceinline__ void p_fft_pass2(const Frame& F0, int l, int order, size_t ws_a) { const Frame F = launder(F0);
    fft_tw_init(F.lds, F.tid);
    LAS f32x2* X = (LAS f32x2*)F.lds; const int tid = F.tid;
    GAS unsigned* A = (GAS unsigned*)(F.ws + ws_a); GAS unsigned* HF = (GAS unsigned*)(F.ws + WS_HF);
    unsigned pa[8], ph[8];
#define P2_LOAD(uu) do { const int sg_ = (uu) >> 3, g_ = (uu) & 7; const GAS unsigned* Ab_ = A + ((size_t)sg_ * FN1 + g_ * 16) * FN2; const GAS unsigned* Hb_ = HF + ((size_t)(order * 256 + sg_) * FN1 + g_ * 16) * FN2; \
        _Pragma("unroll") for (int i = 0; i < 8; ++i) { pa[i] = Ab_[tid + NTHR * i]; if (KIND == 0) ph[i] = Hb_[tid + NTHR * i]; } } while (0)
    int u = blockIdx.x; if (u < 256 * 8) P2_LOAD(u);
    for (; u < 256 * 8; u += F.G) {
        const int sg = u >> 3, g = u & 7;
        GAS unsigned* Ab = A + ((size_t)sg * FN1 + g * 16) * FN2; GAS unsigned* Hb = HF + ((size_t)(order * 256 + sg) * FN1 + g * 16) * FN2;
        unsigned hcur[8];
#pragma unroll
        for (int i = 0; i < 8; ++i) { X[tid + NTHR * i] = upc(pa[i]); if (KIND == 0) hcur[i] = ph[i]; }
        __syncthreads();
        if (u + F.G < 256 * 8) P2_LOAD(u + F.G);
        fft256_rows_fwd(X, tid);
        if (KIND == 1) { const float nr = nrm_lat(F, order, sg);
#pragma unroll
            for (int i = 0; i < 8; ++i) { const int e = tid + NTHR * i; const f32x2 v = X[e] * nr; const _Float16 hr = (_Float16)v.x, hi = (_Float16)v.y;
                Hb[e] = (unsigned)__builtin_bit_cast(unsigned short, hr) | ((unsigned)__builtin_bit_cast(unsigned short, hi) << 16); }
            __syncthreads();
        } else {
#pragma unroll
            for (int i = 0; i < 8; ++i) { const int e = tid + NTHR * i; const unsigned hw = hcur[i];
                const f32x2 h = {(float)__builtin_bit_cast(_Float16, (unsigned short)(hw & 0xffffu)), (float)__builtin_bit_cast(_Float16, (unsigned short)(hw >> 16))};
                X[e] = cmul(X[e], h); }
            __syncthreads();
            fft256_rows_inv(X, tid);
#pragma unroll
            for (int i = 0; i < 8; ++i) { const int e = tid + NTHR * i, r = g * 16 + (e >> 8), n2 = e & 255, k1 = bitrev7(r);
                Ab[e] = pkc(cmul(X[e], twid((float)(n2 * k1) * (1.f / (float)FN))) * (1.f / (float)FN)); }
            __syncthreads();
        }
    }
#undef P2_LOAD
}
__device__ __forceinline__ void p_fft_pass3(const Frame& F0, int l, int order) { const Frame F = launder(F0);
    fft_tw_init(F.lds, F.tid);
    LAS f32x2* X = (LAS f32x2*)F.lds; const int tid = F.tid, j = tid & 31, q0 = tid >> 5;
    GAS float* VT = (GAS float*)(F.ws + WS_VT); const GAS bf16* GT = (const GAS bf16*)(F.ws + (order == 0 ? WS_X1T : WS_X2T)); const GAS unsigned* A = (const GAS unsigned*)(F.ws + WS_FA);
    const GAS float* skip = F.in[I_HSKIP] + (size_t)(l * 2 + order) * 256;
    unsigned pa[8]; float pv[4][2]; unsigned short pg[4][2];
#define P3_LOAD(uu) do { const int sg_ = (uu) >> 3, nb_ = (uu) & 7; _Pragma("unroll") for (int i = 0; i < 8; ++i) pa[i] = A[((size_t)sg_ * FN1 + q0 + 16 * i) * FN2 + 32 * nb_ + j]; \
        _Pragma("unroll") for (int i = 0; i < 4; ++i) { const int n = 256 * (q0 + 16 * i) + 32 * nb_ + j; const size_t i0 = (size_t)(sg_ * 2 + 0) * SEQ + n, i1 = (size_t)(sg_ * 2 + 1) * SEQ + n; \
            pv[i][0] = VT[i0]; pv[i][1] = VT[i1]; pg[i][0] = GT[i0]; pg[i][1] = GT[i1]; } } while (0)
    int u = blockIdx.x; if (u < 256 * 8) P3_LOAD(u);
    for (; u < 256 * 8; u += F.G) {
        const int sg = u >> 3, nb = u & 7;
        float cv[4][2], cg[4][2];
#pragma unroll
        for (int i = 0; i < 8; ++i) X[(q0 + 16 * i) * 32 + j] = upc(pa[i]);
#pragma unroll
        for (int i = 0; i < 4; ++i) { cv[i][0] = pv[i][0]; cv[i][1] = pv[i][1]; cg[i][0] = bf2f(pg[i][0]); cg[i][1] = bf2f(pg[i][1]); }
        __syncthreads();
        if (u + F.G < 256 * 8) P3_LOAD(u + F.G);
        fft128_cols_inv(X, tid);
        const float sk = skip[sg];
#pragma unroll
        for (int i = 0; i < 4; ++i) { const int n1 = q0 + 16 * i, n = 256 * n1 + 32 * nb + j; const f32x2 y = X[n1 * 32 + j];
            const size_t i0 = (size_t)(sg * 2 + 0) * SEQ + n, i1 = (size_t)(sg * 2 + 1) * SEQ + n;
            VT[i0] = cg[i][0] * (y.x + sk * cv[i][0]); VT[i1] = cg[i][1] * (y.y + sk * cv[i][1]); }
        __syncthreads();
    }
#undef P3_LOAD
}
__device__ __forceinline__ void p_fft_pass31(const Frame& F0, int l) { const Frame F = launder(F0);
    fft_tw_init(F.lds, F.tid);
    LAS f32x2* X = (LAS f32x2*)F.lds; const int tid = F.tid, j = tid & 31, q0 = tid >> 5;
    GAS float* VT = (GAS float*)(F.ws + WS_VT); const GAS bf16* GT = (const GAS bf16*)(F.ws + WS_X1T); GAS unsigned* A = (GAS unsigned*)(F.ws + WS_FA);
    const GAS float* skip = F.in[I_HSKIP] + (size_t)(l * 2 + 0) * 256;
    unsigned pa[8]; float pv[4][2]; unsigned short pg[4][2];
#define P3_LOAD(uu) do { const int sg_ = (uu) >> 3, nb_ = (uu) & 7; _Pragma("unroll") for (int i = 0; i < 8; ++i) pa[i] = A[((size_t)sg_ * FN1 + q0 + 16 * i) * FN2 + 32 * nb_ + j]; \
        _Pragma("unroll") for (int i = 0; i < 4; ++i) { const int n = 256 * (q0 + 16 * i) + 32 * nb_ + j; const size_t i0 = (size_t)(sg_ * 2 + 0) * SEQ + n, i1 = (size_t)(sg_ * 2 + 1) * SEQ + n; \
            pv[i][0] = VT[i0]; pv[i][1] = VT[i1]; pg[i][0] = GT[i0]; pg[i][1] = GT[i1]; } } while (0)
    int u = blockIdx.x; if (u < 256 * 8) P3_LOAD(u);
    for (; u < 256 * 8; u += F.G) {
        const int sg = u >> 3, nb = u & 7;
        float cv[4][2], cg[4][2];
#pragma unroll
        for (int i = 0; i < 8; ++i) X[(q0 + 16 * i) * 32 + j] = upc(pa[i]);
#pragma unroll
        for (int i = 0; i < 4; ++i) { cv[i][0] = pv[i][0]; cv[i][1] = pv[i][1]; cg[i][0] = bf2f(pg[i][0]); cg[i][1] = bf2f(pg[i][1]); }
        __syncthreads();
        if (u + F.G < 256 * 8) P3_LOAD(u + F.G);
        fft128_cols_inv(X, tid);
        const float sk = skip[sg];
#pragma unroll
        for (int i = 0; i < 4; ++i) { const int n1 = q0 + 16 * i, n = 256 * n1 + 32 * nb + j; const f32x2 y = X[n1 * 32 + j];
            const size_t i0 = (size_t)(sg * 2 + 0) * SEQ + n, i1 = (size_t)(sg * 2 + 1) * SEQ + n;
            const f32x2 z = {cg[i][0] * (y.x + sk * cv[i][0]), cg[i][1] * (y.y + sk * cv[i][1])};
            VT[i0] = z.x; VT[i1] = z.y; X[n1 * 32 + j] = z; X[(n1 + 64) * 32 + j] = (f32x2){0.f, 0.f}; }
        __syncthreads();
        fft128_cols_fwd(X, tid);
#pragma unroll
        for (int i = 0; i < 8; ++i) { const int r = q0 + 16 * i, k1 = bitrev7(r), n2 = 32 * nb + j;
            A[((size_t)sg * FN1 + r) * FN2 + n2] = pkc(cmul(X[r * 32 + j], twid(-(float)(n2 * k1) * (1.f / (float)FN)))); }
        __syncthreads();
    }
#undef P3_LOAD
}
__device__ __forceinline__ void p_hy_shortconv(const Frame& F0, int l) { const Frame F = launder(F0);
    LAS bf16* IN = (LAS bf16*)F.lds; LAS float* OT = (LAS float*)(F.lds + 66 * 256 * 2 + 64); const int tid = F.tid;
    const GAS bf16* PH = (const GAS bf16*)(F.ws + WS_PH); GAS float* VT = (GAS float*)(F.ws + WS_VT); GAS bf16* X1T = (GAS bf16*)(F.ws + WS_X1T); GAS bf16* X2T = (GAS bf16*)(F.ws + WS_X2T); GAS float* CU = (GAS float*)(F.ws + WS_CU);
    const GAS float* cw = F.in[I_HCW] + (size_t)l * 3 * 768; const GAS float* cb = F.in[I_HCB] + (size_t)l * 768;
    const int nlat = NBATCH * (SEQ / 64) * 3, nctx = NBATCH * (CTXL / 64) * 3;
    for (int u = blockIdx.x; u < nlat + nctx; u += F.G) {
        const bool lat = u < nlat; const int uu = lat ? u : u - nlat; const int grp = uu % 3, tile = (uu / 3) % (lat ? SEQ / 64 : CTXL / 64), b = (uu / 3) / (lat ? SEQ / 64 : CTXL / 64);
        const int Ls = lat ? SEQ : CTXL, t0 = tile * 64; const size_t rowb = lat ? (size_t)b * SEQ : (size_t)TL + b * CTXL;
        for (int i = tid; i < 66 * 32; i += NTHR) { const int rr = i >> 5, c8 = (i & 31) * 8, t = t0 + rr - 1; v4u w = {0u, 0u, 0u, 0u};
            if (t >= 0 && t < Ls) w = *(const GAS v4u*)(PH + (rowb + t) * NPH + PH_HY + grp * 256 + c8);
            *(LAS v4u*)(IN + rr * 256 + c8) = w; }
        __syncthreads();
        { const int c = tid & 255, th = tid >> 8, ch = grp * 256 + c; const float w0 = cw[ch], w1 = cw[768 + ch], w2 = cw[1536 + ch], bb = cb[ch];
          float a = bf2f(IN[(th * 32) * 256 + c]), m = bf2f(IN[(th * 32 + 1) * 256 + c]);
          for (int i = 0; i < 32; ++i) { const float n = bf2f(IN[(th * 32 + i + 2) * 256 + c]); const float y = bb + a * w0 + m * w1 + n * w2; a = m; m = n;
              if (lat) OT[c * 65 + th * 32 + i] = y; else CU[((size_t)b * CTXL + t0 + th * 32 + i) * 768 + ch] = y; } }
        __syncthreads();
        if (lat) { const int t4 = (tid & 15) * 4;
#pragma unroll
            for (int i = 0; i < 8; ++i) { const int c = (tid >> 4) + 32 * i; const LAS float* s = OT + c * 65 + t4; const size_t o = (size_t)(c * 2 + b) * SEQ + t0 + t4;
                if (grp == 0) *(GAS f32x4*)(VT + o) = (f32x4){s[0], s[1], s[2], s[3]};
                else { v2u w; w.x = pk2(s[0], s[1]); w.y = pk2(s[2], s[3]); *(GAS v2u*)((grp == 1 ? X1T : X2T) + o) = w; } } }
        __syncthreads();
    }
}
__device__ __forceinline__ void p_hy_ctx(const Frame& F0, int l) { const Frame F = launder(F0);
    LAS float* L = (LAS float*)F.lds; const int tid = F.tid, t = tid & 255, cs = tid >> 8;
    LAS float* SV = L + cs * 1280, * HFW = SV + 256, * HBW = SV + 512, * HF2 = SV + 768, * HB2 = SV + 1024;
    const GAS float* CU = (const GAS float*)(F.ws + WS_CU); const GAS float* HTC = (const GAS float*)(F.ws + WS_HTC); GAS float* OTC = (GAS float*)(F.ws + WS_OTC);
    for (int u = blockIdx.x; u < NBATCH * 128; u += F.G) {
        const int b = u >> 7, c = (u & 127) * 2 + cs;
        const float n0 = nrm_ctx(F, 0, c), n1 = nrm_ctx(F, 1, c);
        const GAS float* cu = CU + ((size_t)b * CTXL + t) * 768;
        const float v = cu[c], x1 = cu[256 + c], x2 = cu[512 + c];
        SV[t] = v; HFW[t] = HTC[(size_t)(0 + c) * CTXL + t] * n0; HBW[t] = HTC[(size_t)(256 + c) * CTXL + t] * n0; HF2[t] = HTC[(size_t)(512 + c) * CTXL + t] * n1; HB2[t] = HTC[(size_t)(768 + c) * CTXL + t] * n1;
        __syncthreads();
        float y = F.in[I_HSKIP][(l * 2 + 0) * 256 + c] * v;
        for (int s = 0; s <= t; ++s) y += HFW[t - s] * SV[s];
        for (int s = t + 1; s < CTXL; ++s) y += HBW[s - t] * SV[s];
        const float z = x1 * y;
        __syncthreads();
        SV[t] = z;
        __syncthreads();
        float y2 = F.in[I_HSKIP][(l * 2 + 1) * 256 + c] * z;
        for (int s = 0; s <= t; ++s) y2 += HF2[t - s] * SV[s];
        for (int s = t + 1; s < CTXL; ++s) y2 += HB2[s - t] * SV[s];
        OTC[((size_t)b * CTXL + t) * 256 + c] = x2 * y2;
        __syncthreads();
    }
}
__device__ __forceinline__ void p_ynorm_b(const Frame& F0, int l, bool with_ctx) { const Frame F = launder(F0);
    LAS float* T = (LAS float*)F.lds; LAS float* RS = T + 256 * 65; LAS float* PS = RS + 64; const int tid = F.tid;
    const GAS float* VT = (const GAS float*)(F.ws + WS_VT); const GAS float* OTC = (const GAS float*)(F.ws + WS_OTC); GAS bf16* Y = (GAS bf16*)(F.ws + WS_Y); const GAS float* hg = F.in[I_HNG] + l * 256;
    const int nlat = NBATCH * (SEQ / 64), nctx = with_ctx ? NBATCH * (CTXL / 64) : 0;
    for (int u = blockIdx.x; u < nlat + nctx; u += F.G) {
        const bool lat = u < nlat; const int uu = lat ? u : u - nlat, b = lat ? uu / (SEQ / 64) : uu / (CTXL / 64), t0 = (lat ? uu % (SEQ / 64) : uu % (CTXL / 64)) * 64;
        const size_t rowb = lat ? (size_t)b * SEQ + t0 : (size_t)TL + b * CTXL + t0;
        if (lat) { const int t4 = (tid & 15) * 4;
#pragma unroll
            for (int i = 0; i < 8; ++i) { const int c = (tid >> 4) + 32 * i; const f32x4 v = *(const GAS f32x4*)(VT + (size_t)(c * 2 + b) * SEQ + t0 + t4); LAS float* d = T + c * 65 + t4; d[0] = v.x; d[1] = v.y; d[2] = v.z; d[3] = v.w; } }
        else { for (int i = tid; i < 64 * 256; i += NTHR) { const int t = i >> 8, c = i & 255; T[c * 65 + t] = OTC[((size_t)b * CTXL + t0 + t) * 256 + c]; } }
        __syncthreads();
        { const int t = tid & 63, part = tid >> 6; float s = 0.f;
          for (int c = part * 32; c < part * 32 + 32; ++c) { const float v = T[c * 65 + t]; s += v * v; }
          PS[part * 64 + t] = s; }
        __syncthreads();
        if (tid < 64) { float s = 0.f;
#pragma unroll
            for (int p = 0; p < 8; ++p) s += PS[p * 64 + tid];
            RS[tid] = 1.f / sqrtf(s * (1.f / 256.f) + RMS_EPS); }
        __syncthreads();
        { const int t = tid >> 3, c0 = (tid & 7) * 8; const float rs = RS[t];
#pragma unroll
          for (int i = 0; i < 4; ++i) { const int c = c0 + 64 * i; float y[8];
#pragma unroll
              for (int e = 0; e < 8; ++e) y[e] = T[(c + e) * 65 + t] * rs * hg[c + e];
              v4u o; o.x = pk2(y[0], y[1]); o.y = pk2(y[2], y[3]); o.z = pk2(y[4], y[5]); o.w = pk2(y[6], y[7]);
              *(GAS v4u*)(Y + (rowb + t) * D + 256 + c) = o; } }
        __syncthreads();
    }
}

enum LP { LP_IN = 0, LP_PREP, LP_GLA2, LP_GLA3, LP_HY0, LP_HY1, LP_HY2, LP_HY3, LP_HY4, LP_HY5, LP_HY6, LP_HY7, LP_ATT, LP_YN, LP_OUT, LP_LN1, LP_F1, LP_F2, LP_M0  , LP_LN2 = LP_M0 + 9, PPL };
constexpr int NPRO = 4;
constexpr int NPHASE = NPRO + DEPTH * PPL;
template <int l>
__device__ __forceinline__ void layer_phases(const Frame& F, const XcdBarrier& bar, const int lo, const int hi) {
#define IN(k) (lo <= (k) && (k) < hi)
#define SEAM(k) do { if ((k) + 1 < hi) xcd_barrier(bar); } while (0)
    LAS unsigned char* ring = F.lds;
    constexpr int pb = NPRO + l * PPL;
#define lng (F.in[I_LNG] + (size_t)l * 2 * D)
#define lnb (F.in[I_LNB] + (size_t)l * 2 * D)
        if (IN(pb + LP_IN)) { const Frame P = launder(F);
            pg8::Gemm g{(const GAS bf16*)(P.ws + WS_XN), (const GAS bf16*)(P.ws + WS_WIN) + (size_t)l * NPH * D, MR, NPH, D, D, 0};
            pg8::StaticOrder S; S.init(MR, NPH, F.G, (int)blockIdx.x);
            EpiStoreBf16 E{(GAS bf16*)(P.ws + WS_PH), NPH, 1.f};
            pg8::gemm_phase<EpiStoreBf16, pg8::StaticOrder, true, true>(ring, g, S, E);
            SEAM(pb + LP_IN);
        }
        if (IN(pb + LP_PREP)) { const Frame P = launder(F); p_prep_mla_rows(F); p_gla_local(F, l);
            p_hy_shortconv(F, l); SEAM(pb + LP_PREP); }
        if (IN(pb + LP_GLA2)) { const Frame P = launder(F);
            { pg8::Gemm g{(const GAS bf16*)(P.ws + WS_PH) + PH_CQ, (const GAS bf16*)(P.ws + WS_WUQ) + (size_t)l * 768 * 256, MR, 768, 256, NPH, 0};
              pg8::StaticOrder S; S.init(MR, 768, F.G, (int)blockIdx.x);
              EpiMlaQ E{P.ws + WS_Q, P.ws + WS_QC, (const GAS float*)(P.ws + WS_RSQ), (const GAS float*)(P.ws + WS_ROPE)};
              pg8::gemm_phase<EpiMlaQ, pg8::StaticOrder, true, true>(ring, g, S, E); }
            { pg8::Gemm g{(const GAS bf16*)(P.ws + WS_PH) + PH_CKV, (const GAS bf16*)(P.ws + WS_WUKV) + (size_t)l * 1024 * 256, MR, 1024, 256, NPH, 0};
              pg8::StaticOrder S; S.init(MR, 1024, F.G, (int)blockIdx.x);
              EpiMlaKV E{P.ws + WS_K, (GAS bf16*)(P.ws + WS_V), (const GAS float*)(P.ws + WS_RSKV)};
              pg8::gemm_phase<EpiMlaKV, pg8::StaticOrder, true, true>(ring, g, S, E); }
            p_gla_scan(F); p_fft_pass1<0>(F, 0, WS_FA);
            SEAM(pb + LP_GLA2);
        }
        if (IN(pb + LP_GLA3)) { const Frame P = launder(F); p_gla_out(F, l, l == 0); p_attn_vt_pack(F); p_fft_pass2<0>(F, l, 0, WS_FA); if constexpr (l == 0) p_hy_ctx(F, l);
            SEAM(pb + LP_GLA3); }
        if (IN(pb + LP_HY0)) { p_fft_pass31(F, l); SEAM(pb + LP_HY0); }
        if (IN(pb + LP_HY1)) { p_fft_pass2<0>(F, l, 1, WS_FA); SEAM(pb + LP_HY1); }
        if (IN(pb + LP_HY2)) { p_fft_pass3(F, l, 1); SEAM(pb + LP_HY2); }
        if (IN(pb + LP_ATT)) { const Frame P = launder(F); p_attention(F, l == 0);
            SEAM(pb + LP_ATT); }
        if (IN(pb + LP_YN)) { const Frame P = launder(F); p_ynorm_c(F, l == 0 ? MR : TL, F.in[I_MNG] + (size_t)l * 512); p_ynorm_b(F, l, l == 0); if constexpr (l == 0) p_filt_hidden(F, 1); SEAM(pb + LP_YN); }
        if (IN(pb + LP_OUT)) { const Frame P = launder(F);
            const int M = (l == 0) ? MR : TL;
            pg8::Gemm g{(const GAS bf16*)(P.ws + WS_Y), (const GAS bf16*)(P.ws + WS_WOUT) + (size_t)l * D * D, M, D, D, D, 0};
            pg8::StaticOrder S; S.init(M, D, F.G, (int)blockIdx.x);
            EpiRes E{l == 0 ? F.in[I_X] : F.out, l == 0 ? F.in[I_CTX] : (const GAS float*)(P.ws + WS_XC), F.out, (GAS float*)(P.ws + WS_XC), modv(F, l, 0, 2)};
            pg8::gemm_phase<EpiRes, pg8::StaticOrder, true, true>(ring, g, S, E);
            if constexpr (l == 0) p_filt_raw(F, 1);
            SEAM(pb + LP_OUT);
        }
        if (IN(pb + LP_LN1)) { const Frame P = launder(F);
            if constexpr (l == 0) { p_ln(F, MR, lng, lnb, true, l, 3); p_fft_pass1<1>(F, 0, WS_FA0); p_fft_pass1<1>(F, 1, WS_FA1); }
            else { p_ln_route(F, lng, lnb, l); p_moe_weights(F); }
            SEAM(pb + LP_LN1);
        }
        if constexpr (l == 0) {
            if (IN(pb + LP_F1)) { const Frame P = launder(F);
                pg8::Gemm g{(const GAS bf16*)(P.ws + WS_XN), (const GAS bf16*)(P.ws + WS_W13), MR, 2 * DFF, D, D, 0};
                pg8::StaticOrder S; S.init(MR, 2 * DFF, F.G, (int)blockIdx.x);
                EpiSwiglu E{(GAS bf16*)(P.ws + WS_G), DFF, 1.f};
                pg8::gemm_phase<EpiSwiglu, pg8::StaticOrder, true, true>(ring, g, S, E);
                p_fft_pass2<1>(F, 1, 0, WS_FA0); p_fft_pass2<1>(F, 1, 1, WS_FA1);
                SEAM(pb + LP_F1);
            }
            if (IN(pb + LP_F2)) { const Frame P = launder(F);
                pg8::Gemm g{(const GAS bf16*)(P.ws + WS_G), (const GAS bf16*)(P.ws + WS_W2), MR, D, DFF, DFF, 0};
                pg8::StaticOrder S; S.init(MR, D, F.G, (int)blockIdx.x);
                EpiRes E{F.out, (const GAS float*)(P.ws + WS_XC), F.out, (GAS float*)(P.ws + WS_XC), modv(F, l, 0, 5)};
                pg8::gemm_phase<EpiRes, pg8::StaticOrder, true, true>(ring, g, S, E);
                SEAM(pb + LP_F2);
            }
            if (IN(pb + LP_LN2)) { const Frame P = launder(F); p_ln(F, MR, lng + D, lnb + D, true, l + 1, 0); SEAM(pb + LP_LN2); }
        } else {
            if (IN(pb + LP_F1)) { const Frame P = launder(F); p_moe_scatter(F); SEAM(pb + LP_F1); }
            for (int ch = 0; ch < MOE_NCHUNK; ++ch) {
                if (IN(pb + LP_F2 + 2 * ch)) { const Frame P = launder(F);
                    moe_base_to_lds(P);
                    pg8::Gemm g{(const GAS bf16*)(P.ws + WS_HS8 + (size_t)ch * MOE_CHUNK_TILES * 256 * D), (const GAS bf16*)(P.ws + WS_WM13), MOE_CHUNK_TILES * 256, 2 * EFF, D / 2, D / 2, (size_t)2 * EFF * D};
                    MoeOrder S; S.init((const LAS int*)(F.lds + LDS_MOEBT), ch, 2 * EFF / 256, F.G, (int)blockIdx.x);
                    EpiSwiglu8 E{P.ws + WS_GC, EFF, 1.f / MOE_WSCALE, MOE_GSCALE};
                    pg8::gemm_phase<EpiSwiglu8, MoeOrder, true, true, true>(ring, g, S, E);
                    SEAM(pb + LP_F2 + 2 * ch);
                }
                if (IN(pb + LP_F2 + 2 * ch + 1)) { const Frame P = launder(F);
                    moe_base_to_lds(P);
                    pg8::Gemm g{(const GAS bf16*)(P.ws + WS_GC), (const GAS bf16*)(P.ws + WS_WM2), MOE_CHUNK_TILES * 256, D, EFF / 2, EFF / 2, (size_t)D * EFF};
                    MoeOrder S; S.init((const LAS int*)(F.lds + LDS_MOEBT), ch, D / 256, F.G, (int)blockIdx.x);
                    EpiStoreBf16 E{(GAS bf16*)(P.ws + WS_HS) + (size_t)ch * MOE_CHUNK_TILES * 256 * D, D, 1.f / (MOE_GSCALE * MOE_W2SCALE)};
                    pg8::gemm_phase<EpiStoreBf16, MoeOrder, true, true, true>(ring, g, S, E);
                    SEAM(pb + LP_F2 + 2 * ch + 1);
                }
            }
            if (IN(pb + LP_LN2)) { const Frame P = launder(F); p_ln_combine(F, lng + D, lnb + D, l); SEAM(pb + LP_LN2); }
        }

#undef lng
#undef lnb
#undef IN
#undef SEAM
}
__global__ void __launch_bounds__(NTHR, 2) mega(Args args) {
    extern __shared__ __attribute__((aligned(16))) unsigned char lds_raw[];
    Frame F;
    F.lds = (LAS unsigned char*)lds_raw; F.ws = args.ws; F.ctl = (gu32*)(args.ws + WS_CTL); F.in = (const GAS float* const GAS*)(args.ws + WS_PTRTAB); F.out = args.out;
    F.tid = threadIdx.x; F.lane = F.tid & 63; F.wave = __builtin_amdgcn_readfirstlane(F.tid >> 6); F.G = gridDim.x;
    F.gw = blockIdx.x * NWAVES + F.wave; F.ngw = F.G * NWAVES;
    volatile LAS unsigned* MISC = (volatile LAS unsigned*)(F.lds + LDS_MISC);
    if (F.tid < 32) MISC[F.tid] = 0u;
    __syncthreads();
    XcdBarrier bar; bar.bar = (unsigned*)(F.ctl + CW_BAR); bar.x = 0; bar.st = nullptr;
#if !MK_PER_PHASE
    bar = xcd_barrier_post((unsigned*)(F.ctl + CW_BAR), MISC + 8);
#endif
    const int lo = args.ph_lo, hi = args.ph_hi;
#define IN(k) (lo <= (k) && (k) < hi)
#define SEAM(k) do { if ((k) + 1 < hi) xcd_barrier(bar); } while (0)
    LAS unsigned char* ring = F.lds;
#define LTID() ({ int t_ = F.tid; asm volatile("" : "+v"(t_)); t_; })

    if (IN(0)) { Frame FK = F; FK.in = (const GAS float* const GAS*)(const GAS void*)args.in;
        if (blockIdx.x == 0 && F.tid < 37) ((const GAS float* GAS*)(args.ws + WS_PTRTAB))[F.tid] = args.in[F.tid];
        p0_modv(FK); p0_weights(FK); p0_rope_table(FK); __syncthreads();     p_filt_hidden(FK, 0);
        SEAM(0); }
    if (IN(1)) { p_xn0(F); p_filt_raw(F, 0);
        SEAM(1); }
    if (IN(2)) { p_fft_pass1<1>(F, 0, WS_FA0); p_fft_pass1<1>(F, 1, WS_FA1); SEAM(2); }
    if (IN(3)) { p_fft_pass2<1>(F, 0, 0, WS_FA0); p_fft_pass2<1>(F, 0, 1, WS_FA1); SEAM(3); }

    layer_phases<0>(F, bar, lo, hi);
    layer_phases<1>(F, bar, lo, hi);
#undef IN
#undef SEAM
}

extern "C" void kernel_launch(void* const* d_in, const int* in_sizes, int n_in, void* d_out, int out_size, void* d_ws, size_t ws_size, hipStream_t stream) {
    static int grid = 0;
    if (grid == 0) {
        if (n_in != 37 || in_sizes[0] != TL * D || out_size != TL * D || ws_size < WS_END2) { fprintf(stderr, "kernel_launch: shape/workspace mismatch (n_in %d in0 %d out %d ws %zu need %zu)\n", n_in, n_in > 0 ? in_sizes[0] : -1, out_size, ws_size, (size_t)WS_END2); grid = -1; return; }
        int dev = 0, cus = 0, per_cu = 0;
        if (hipGetDevice(&dev) != hipSuccess || hipDeviceGetAttribute(&cus, hipDeviceAttributeMultiprocessorCount, dev) != hipSuccess) { grid = -1; return; }
        if (hipFuncSetAttribute((const void*)mega, hipFuncAttributeMaxDynamicSharedMemorySize, LDS_BYTES) != hipSuccess) { fprintf(stderr, "kernel_launch: hipFuncSetAttribute failed\n"); grid = -1; return; }
        if (hipOccupancyMaxActiveBlocksPerMultiprocessor(&per_cu, (const void*)mega, NTHR, LDS_BYTES) != hipSuccess || per_cu < 1) { fprintf(stderr, "kernel_launch: occupancy query says %d\n", per_cu); }
        (void)hipGetLastError();
        grid = cus;
    }
    if (grid < 0) return;
    if (hipMemsetAsync((char*)d_ws + WS_CTL, 0, CTL_ZERO_BYTES, stream) != hipSuccess) return;
    Args a{};
    for (int i = 0; i < 37; ++i) a.in[i] = (const GAS float*)d_in[i];
    a.out = (GAS float*)d_out; a.ws = (GAS unsigned char*)d_ws;
#if MK_PER_PHASE
    for (int p = 0; p < NPHASE; ++p) { a.ph_lo = p; a.ph_hi = p + 1; hipLaunchKernelGGL(mega, dim3(grid), dim3(NTHR), LDS_BYTES, stream, a); }
#else
    a.ph_lo = 0; a.ph_hi = NPHASE;
    hipLaunchKernelGGL(mega, dim3(grid), dim3(NTHR), LDS_BYTES, stream, a);
#endif
    const hipError_t le = hipPeekAtLastError();
    if (le != hipSuccess) fprintf(stderr, "kernel_launch: launch failed: %s\n", hipGetErrorName(le));
}
```

```cpp
#include <hip/hip_runtime.h>
#include <cstdio>
#include <cstdint>
namespace pg8 {
#define PG8_LAS __attribute__((address_space(3)))
#define PG8_GAS __attribute__((address_space(1)))
typedef unsigned short bf16_t;
typedef short bf16x8 __attribute__((ext_vector_type(8)));
typedef float f32x4 __attribute__((ext_vector_type(4)));
typedef unsigned u32x4 __attribute__((ext_vector_type(4)));
typedef int i32x8_t __attribute__((ext_vector_type(8)));
typedef short bf16x16 __attribute__((ext_vector_type(16)));
constexpr int BM = 256, BK = 64, HALF = 128, HTB = HALF * BK * 2  , STAGE_BYTES = 8 * HTB, NXCD = 8, WGM = 8;

__host__ __device__ __forceinline__ int lds_byte(int r, int c) { const int st = (r >> 4) * 2 + (c >> 5), rr = r & 15, cc = c & 31, ob = rr * 64 + cc * 2; return st * 1024 + (ob ^ (((ob >> 9) & 1) << 5)); }
__host__ __device__ __forceinline__ void stage_rc(int b, int& R, int& C) { const int st = b / 1024, sb = b % 1024, swz = sb ^ (((sb >> 9) & 1) << 5); R = (st >> 1) * 16 + swz / 64; C = (st & 1) * 32 + (swz % 64) / 2; }
__host__ __device__ __forceinline__ int perm32(int rho) { const int n = rho >> 4, i = rho & 15; return 8 * (i >> 2) + 4 * n + (i & 3); }

struct Unit { int pm, pn, be; };
struct Gemm { const PG8_GAS bf16_t* A; const PG8_GAS bf16_t* Bt; int M, N, K; int lda; size_t bstride; };

struct StaticOrder {
    int nM, nN, nwg, G, c;
    __host__ __device__ void init(int M, int N, int G_, int c_) { nM = M / BM; nN = N / BM; nwg = nM * nN; G = G_; c = c_; }
    __host__ __device__ bool next(int i, Unit& u) const {
        const long L = (long)i * G + c; if (L >= nwg) return false;
        int wgid = (int)L; { const int q = nwg / NXCD, r = nwg % NXCD, xcd = wgid % NXCD, off = wgid / NXCD; wgid = (xcd < r ? xcd * (q + 1) : r * (q + 1) + (xcd - r) * q) + off; }
        const int nig = WGM * nN, gid = wgid / nig, fm = gid * WGM, gsz = (nM - fm) < WGM ? (nM - fm) : WGM;
        u.pm = fm + ((wgid % nig) % gsz); u.pn = (wgid % nig) / gsz; u.be = 0; return true;
    }
    __device__ __forceinline__ void a_ready(const Unit&) const {}
    __device__ __forceinline__ void done(const Unit&) const {}
};


__device__ __forceinline__ unsigned cvt_pk_bf16(float lo, float hi) { unsigned r; asm volatile("v_cvt_pk_bf16_f32 %0, %1, %2" : "=v"(r) : "v"(lo), "v"(hi)); return r; }
typedef float f32x2 __attribute__((ext_vector_type(2)));
typedef unsigned u32x2 __attribute__((ext_vector_type(2)));

template <class Epi, class Sched, bool ALIGN_EPI = false, bool SP2 = false, bool F8 = false>
__device__ __forceinline__ void gemm_phase(PG8_LAS unsigned char* lds, const Gemm g, const Sched& S, const Epi& E) {
    { unsigned lb_ = (unsigned)(size_t)lds; asm volatile("" : "+s"(lb_)); lds = (PG8_LAS unsigned char*)(size_t)lb_; }
    int tid_ = threadIdx.x; asm volatile("" : "+v"(tid_));
    const int tid = tid_, wid = __builtin_amdgcn_readfirstlane(tid >> 6), lane = tid & 63, wr = wid >> 2, wc = wid & 3, fr = lane & 15, fq = lane >> 4;
    int K_ = g.K; asm volatile("" : "+s"(K_)); const int K = K_, nt = K / BK;
    unsigned voffA[2], voffB[2];
#pragma unroll
    for (int i = 0; i < 2; ++i) { int R, C; stage_rc(tid * 16 + i * 8192, R, C); const int Rb = Epi::PERM ? ((R & ~31) + perm32(R & 31)) : R;
        voffA[i] = (unsigned)(R * g.lda + C) * 2u; voffB[i] = (unsigned)(Rb * K + C) * 2u; }
    const size_t kstep = (size_t)(BK * 2);
    const size_t hstepB = (size_t)HALF * K * 2, hstepA = (size_t)HALF * g.lda * 2;
    const size_t tstepA = 2 * hstepA, tstepB = 2 * hstepB;
    const unsigned ldsw = (unsigned)wid * 1024u;
    const int aoff = lds_byte(wr * 64 + fr, fq * 8), boff = lds_byte(wc * 32 + fr, fq * 8);
#define PG8_SA(b, h) (((b) * 2 + (h)) * HTB)
#define PG8_SB(b, h) ((4 + (b) * 2 + (h)) * HTB)
#define PG8_STAGE(bufoff, gbase, voff) do { _Pragma("unroll") for (int _i = 0; _i < 2; ++_i) \
        __builtin_amdgcn_global_load_lds((const PG8_GAS unsigned*)((const PG8_GAS char*)(gbase) + (voff)[_i]), (PG8_LAS unsigned*)(lds + (bufoff) + ldsw + _i * 8192), 16, 0, 0); } while (0)
#define PG8_LDA(dst, b, h) do { _Pragma("unroll") for (int m = 0; m < 4; ++m) dst[m] = __builtin_shufflevector(*(const PG8_LAS bf16x8*)(lds + PG8_SA(b, h) + aoff + m * 2048), *(const PG8_LAS bf16x8*)(lds + PG8_SA(b, h) + aoff + m * 2048 + 1024), 0, 1, 2, 3, 4, 5, 6, 7, 8, 9, 10, 11, 12, 13, 14, 15); } while (0)
#define PG8_LDB(dst, b, h) do { _Pragma("unroll") for (int n = 0; n < 2; ++n) dst[n] = __builtin_shufflevector(*(const PG8_LAS bf16x8*)(lds + PG8_SB(b, h) + boff + n * 2048), *(const PG8_LAS bf16x8*)(lds + PG8_SB(b, h) + boff + n * 2048 + 1024), 0, 1, 2, 3, 4, 5, 6, 7, 8, 9, 10, 11, 12, 13, 14, 15); } while (0)
#define PG8_HALF(x, k) ((k) == 0 ? __builtin_shufflevector(x, x, 0, 1, 2, 3, 4, 5, 6, 7) : __builtin_shufflevector(x, x, 8, 9, 10, 11, 12, 13, 14, 15))
#define PG8_MMA(ai, bj, At, Bt) do { __builtin_amdgcn_s_setprio(1); if constexpr (F8) { _Pragma("unroll") for (int m = 0; m < 4; ++m) _Pragma("unroll") for (int n = 0; n < 2; ++n) \
        asm volatile("v_mfma_f32_16x16x128_f8f6f4 %0, %1, %2, %0" : "+v"(acc[ai][bj][m][n]) : "v"(__builtin_bit_cast(i32x8_t, Bt[n])), "v"(__builtin_bit_cast(i32x8_t, At[m]))); } \
    else { _Pragma("unroll") for (int m = 0; m < 4; ++m) _Pragma("unroll") for (int n = 0; n < 2; ++n) _Pragma("unroll") for (int k = 0; k < 2; ++k) \
        acc[ai][bj][m][n] = __builtin_amdgcn_mfma_f32_16x16x32_bf16(PG8_HALF(Bt[n], k), PG8_HALF(At[m], k), acc[ai][bj][m][n], 0, 0, 0); } __builtin_amdgcn_s_setprio(0); } while (0)
#define PG8_F8_DRAIN() do { if constexpr (F8) asm volatile("s_nop 15\n\ts_nop 15" ::: "memory"); } while (0)
#define PG8_WAIT_V(n) asm volatile("s_waitcnt vmcnt(" #n ")" ::: "memory")
#define PG8_WAIT_L(n) asm volatile("s_waitcnt lgkmcnt(" #n ")" ::: "memory")
#define PG8_BAR __builtin_amdgcn_s_barrier()
#define PG8_SCHED __builtin_amdgcn_sched_barrier(0)
    Unit cur, nxt; int ui = 0;
    if (!S.next(0, cur)) return;
    f32x4 acc[2][2][4][2];
#pragma unroll
    for (int a = 0; a < 2; ++a)
#pragma unroll
        for (int b = 0; b < 2; ++b)
#pragma unroll
            for (int m = 0; m < 4; ++m)
#pragma unroll
                for (int n = 0; n < 2; ++n) acc[a][b][m][n] = (f32x4){0.f, 0.f, 0.f, 0.f};
    bf16x16 At[4], B0[2], B1[2];
    const PG8_GAS char* cA = (const PG8_GAS char*)g.A + (size_t)cur.pm * tstepA; const PG8_GAS char* cB = (const PG8_GAS char*)g.Bt + (size_t)cur.be * g.bstride + (size_t)cur.pn * tstepB;
    S.a_ready(cur);
    if constexpr (SP2) {
        PG8_STAGE(PG8_SB(0, 0), cB, voffB); PG8_STAGE(PG8_SB(0, 1), cB + hstepB, voffB); PG8_STAGE(PG8_SA(0, 0), cA, voffA); PG8_STAGE(PG8_SA(0, 1), cA + hstepA, voffA);
        if (wr == 1) PG8_BAR;
        PG8_WAIT_V(2); PG8_BAR;
        PG8_STAGE(PG8_SB(1, 0), cB + kstep, voffB); PG8_STAGE(PG8_SA(1, 0), cA + kstep, voffA); PG8_STAGE(PG8_SB(1, 1), cB + hstepB + kstep, voffB);
        PG8_WAIT_V(6); PG8_BAR;
    } else {
        PG8_STAGE(PG8_SB(0, 0), cB, voffB); PG8_STAGE(PG8_SA(0, 0), cA, voffA); PG8_STAGE(PG8_SB(0, 1), cB + hstepB, voffB); PG8_STAGE(PG8_SA(0, 1), cA + hstepA, voffA);
        if (wr == 1) PG8_BAR;
        PG8_WAIT_V(4); PG8_BAR;
        PG8_STAGE(PG8_SB(1, 0), cB + kstep, voffB); PG8_STAGE(PG8_SA(1, 0), cA + kstep, voffA); PG8_STAGE(PG8_SB(1, 1), cB + hstepB + kstep, voffB);
        PG8_WAIT_V(6); PG8_BAR;
    }
    for (;;) {
        const bool has_next = S.next(ui + 1, nxt);
        const PG8_GAS char* nA = has_next ? (const PG8_GAS char*)g.A + (size_t)nxt.pm * tstepA : cA; const PG8_GAS char* nB = has_next ? (const PG8_GAS char*)g.Bt + (size_t)nxt.be * g.bstride + (size_t)nxt.pn * tstepB : cB;
        for (int t = 0; t < nt; t += 2) {
            const bool last = (t == nt - 2);
            const PG8_GAS char* a1 = cA + (size_t)(t + 1) * kstep;
            const PG8_GAS char* a2 = last ? nA : cA + (size_t)(t + 2) * kstep; const PG8_GAS char* b2 = last ? nB : cB + (size_t)(t + 2) * kstep;
            const PG8_GAS char* a3 = a2 + kstep; const PG8_GAS char* b3 = b2 + kstep;
            if (last && has_next) S.a_ready(nxt);
            if constexpr (SP2) {
            PG8_LDB(B0, 0, 0); PG8_LDB(B1, 0, 1); PG8_SCHED; PG8_LDA(At, 0, 0); PG8_STAGE(PG8_SA(1, 1), a1 + hstepA, voffA);
            PG8_WAIT_V(8); PG8_WAIT_L(0); PG8_BAR; PG8_MMA(0, 0, At, B0); PG8_MMA(0, 1, At, B1); PG8_BAR; PG8_SCHED;
            PG8_LDA(At, 0, 1); PG8_STAGE(PG8_SB(0, 0), b2, voffB); PG8_STAGE(PG8_SB(0, 1), b2 + hstepB, voffB); PG8_STAGE(PG8_SA(0, 0), a2, voffA);
            PG8_WAIT_V(8); PG8_WAIT_L(0); PG8_BAR; PG8_MMA(1, 0, At, B0); PG8_MMA(1, 1, At, B1); PG8_BAR; PG8_SCHED;
            PG8_LDB(B0, 1, 0); PG8_LDB(B1, 1, 1); PG8_SCHED; PG8_LDA(At, 1, 0); PG8_STAGE(PG8_SA(0, 1), a2 + hstepA, voffA);
            PG8_WAIT_V(8); PG8_WAIT_L(0); PG8_BAR; PG8_MMA(0, 0, At, B0); PG8_MMA(0, 1, At, B1); PG8_BAR; PG8_SCHED;
            PG8_LDA(At, 1, 1); PG8_STAGE(PG8_SB(1, 0), b3, voffB); PG8_STAGE(PG8_SB(1, 1), b3 + hstepB, voffB); PG8_STAGE(PG8_SA(1, 0), a3, voffA);
            PG8_WAIT_V(8); PG8_WAIT_L(0); PG8_BAR; PG8_MMA(1, 0, At, B0); PG8_MMA(1, 1, At, B1); PG8_BAR; PG8_SCHED;
            } else {
            PG8_LDB(B0, 0, 0); PG8_SCHED; PG8_LDA(At, 0, 0); PG8_STAGE(PG8_SA(1, 1), a1 + hstepA, voffA);
            PG8_WAIT_L(8); PG8_BAR; PG8_WAIT_L(0); PG8_MMA(0, 0, At, B0); PG8_BAR; PG8_SCHED;
            PG8_LDB(B1, 0, 1); PG8_STAGE(PG8_SB(0, 0), b2, voffB);
            PG8_BAR; PG8_WAIT_L(0); PG8_MMA(0, 1, At, B1); PG8_BAR;
            PG8_LDA(At, 0, 1); PG8_STAGE(PG8_SA(0, 0), a2, voffA);
            PG8_BAR; PG8_WAIT_L(0); PG8_MMA(1, 0, At, B0); PG8_BAR; PG8_SCHED;
            PG8_STAGE(PG8_SB(0, 1), b2 + hstepB, voffB);
            PG8_WAIT_V(6); PG8_BAR; PG8_MMA(1, 1, At, B1); PG8_BAR;
            PG8_LDB(B0, 1, 0); PG8_SCHED; PG8_LDA(At, 1, 0); PG8_STAGE(PG8_SA(0, 1), a2 + hstepA, voffA);
            PG8_WAIT_L(8); PG8_BAR; PG8_WAIT_L(0); PG8_MMA(0, 0, At, B0); PG8_BAR; PG8_SCHED;
            PG8_LDB(B1, 1, 1); PG8_STAGE(PG8_SB(1, 0), b3, voffB);
            PG8_BAR; PG8_WAIT_L(0); PG8_MMA(0, 1, At, B1); PG8_BAR;
            PG8_LDA(At, 1, 1); PG8_STAGE(PG8_SA(1, 0), a3, voffA);
            PG8_BAR; PG8_WAIT_L(0); PG8_MMA(1, 0, At, B0); PG8_BAR; PG8_SCHED;
            PG8_STAGE(PG8_SB(1, 1), b3 + hstepB, voffB);
            PG8_WAIT_V(6); PG8_BAR; PG8_MMA(1, 1, At, B1); PG8_BAR;
            }
        }
        if constexpr (ALIGN_EPI) { if (wr == 0) PG8_BAR; }
        PG8_F8_DRAIN();
        if constexpr (!Epi::AFTER_DRAIN) { E(acc, cur, wr, wc, fr, fq); S.done(cur); }
        if (!has_next) break;
#pragma unroll
        for (int a = 0; a < 2; ++a)
#pragma unroll
            for (int b = 0; b < 2; ++b)
#pragma unroll
                for (int m = 0; m < 4; ++m)
#pragma unroll
                    for (int n = 0; n < 2; ++n) acc[a][b][m][n] = (f32x4){0.f, 0.f, 0.f, 0.f};
        cur = nxt; cA = nA; cB = nB; ++ui;
        if constexpr (ALIGN_EPI) { if (wr == 1) PG8_BAR; }
    }
    PG8_WAIT_V(0);
    if constexpr (!ALIGN_EPI) { if (wr == 0) PG8_BAR; }
    PG8_BAR;
    if constexpr (Epi::AFTER_DRAIN) { E.fused(acc, cur, wr, wc, fr, fq, lds, wid, lane); S.done(cur); }
#undef PG8_SA
#undef PG8_SB
#undef PG8_STAGE
#undef PG8_LDA
#undef PG8_LDB
#undef PG8_MMA
#undef PG8_HALF
#undef PG8_F8_DRAIN
#undef PG8_WAIT_V
#undef PG8_WAIT_L
#undef PG8_BAR
#undef PG8_SCHED
}
}


#ifndef MK_PER_PHASE
#define MK_PER_PHASE 0
#endif

constexpr int NWAVES = 8, NTHR = 512;
constexpr int D = 1024, NBATCH = 2, SEQ = 16384, TL = NBATCH * SEQ, CTXL = 256, TC = NBATCH * CTXL, MR = TL + TC;
constexpr int NPH = 2048, DFF = 2816, NEXP = 8, EFF = 3584, DEPTH = 2;
constexpr float ALPHA = 1.41421356237309515f;
constexpr float LN_EPS = 1e-5f, RMS_EPS = 1e-6f;
constexpr int PH_QA = 0, PH_KA = 128, PH_VA = 256, PH_GA = 512, PH_HY = 768, PH_CQ = 1536, PH_CKV = 1792, PH_KR = 1920, PH_ALR = 1952;

constexpr size_t MiB = 1u << 20;
constexpr size_t WS_CTL = 0, CTL_ZERO_BYTES = 1 * MiB;
constexpr int CW_TMO = 0, CW_BAR = 4096;
constexpr size_t CTL_MODV = 64 * 1024;
constexpr size_t WS_SMALL = 1 * MiB;
constexpr size_t WS_PTRTAB = WS_SMALL + 16 * 1024;
constexpr size_t WS_WIN = 2 * MiB, WS_WOUT = 10 * MiB, WS_W13 = 14 * MiB, WS_W2 = 25 * MiB, WS_WUQ = 31 * MiB, WS_WUKV = 32 * MiB;
constexpr size_t AB = 34 * MiB;
constexpr size_t WS_XN = AB, WS_Y = AB + 65 * MiB, WS_PH = AB + 130 * MiB, WS_Q = AB + 260 * MiB, WS_K = AB + 309 * MiB, WS_V = AB + 358 * MiB;
constexpr size_t WS_VT = AB + 391 * MiB, WS_X1T = AB + 423 * MiB, WS_X2T = AB + 439 * MiB, WS_HF = AB + 455 * MiB, WS_XC = AB + 519 * MiB, WS_END = AB + 521 * MiB;
constexpr size_t WS_G = WS_PH;
static_assert(WS_W13 + (size_t)2 * DFF * D * 2 <= WS_W2 && WS_W2 + (size_t)D * DFF * 2 <= WS_WUQ, "weights map");
static_assert(WS_G + (size_t)MR * DFF * 2 <= WS_K, "G overlay");
static_assert(WS_END <= 573 * MiB, "d_ws budget");

constexpr int LDS_BYTES = 147456, LDS_MISC = 131072 + 320;

#define GAS __attribute__((address_space(1)))
#define LAS __attribute__((address_space(3)))
typedef unsigned short bf16;
typedef unsigned v4u __attribute__((ext_vector_type(4)));
typedef unsigned v2u __attribute__((ext_vector_type(2)));
typedef float f32x4 __attribute__((ext_vector_type(4)));
typedef GAS unsigned gu32;
#define RLX_AGENT __ATOMIC_RELAXED, __HIP_MEMORY_SCOPE_AGENT
#define LDS_WAIT() asm volatile("s_waitcnt lgkmcnt(0)" ::: "memory")
#define VM_WAIT() asm volatile("s_waitcnt vmcnt(0)" ::: "memory")
__device__ __forceinline__ unsigned pk2(float lo, float hi) { return pg8::cvt_pk_bf16(lo, hi); }
__device__ __forceinline__ float bf2f(unsigned short h) { return __uint_as_float((unsigned)h << 16); }
__device__ __forceinline__ float siluf(float x) { return x / (1.f + __expf(-x)); }
#define XB_TMO      128
#define XB_XCNT(j)  (256  + 64 * (j))
#define XB_XSUB(j)  (1280 + 64 * (j))
#define XB_XGEN(j)  (2304 + 64 * (j))
#define XB_TOP      3328
#define XB_TOPGEN   3392
#define XCD_BAR_WORDS 3456
#define XB_SPIN_CAP (1u << 18)

__device__ __forceinline__ unsigned xb_ld(unsigned* p)              { return __hip_atomic_load(p, __ATOMIC_RELAXED, __HIP_MEMORY_SCOPE_AGENT); }
__device__ __forceinline__ unsigned xb_add(unsigned* p, unsigned v) { return __hip_atomic_fetch_add(p, v, __ATOMIC_RELAXED, __HIP_MEMORY_SCOPE_AGENT); }
__device__ __forceinline__ unsigned xb_xcc_id() { return (unsigned)__builtin_amdgcn_s_getreg((3 << 11) | 20) & 0xFu; }
#define XB_SPIN(cond, bar) do { unsigned _sp = 0; while (cond) { __builtin_amdgcn_s_sleep(1); \
    if ((++_sp & 255u) == 0u) { if (xb_ld(&(bar)[XB_TMO])) break; if (_sp > XB_SPIN_CAP) { atomicAdd(&(bar)[XB_TMO], 1u); break; } } } } while (0)

struct XcdBarrier {
    unsigned* bar; unsigned x;
    volatile LAS unsigned* st;
};

__device__ __forceinline__ XcdBarrier xcd_barrier_post(unsigned* bar, volatile LAS unsigned* st) {
    XcdBarrier b; b.bar = bar; b.x = xb_xcc_id(); b.st = st;
    if (threadIdx.x == 0) (void)xb_add(&bar[XB_XCNT(b.x)], 1u);
    return b;
}
__device__ __forceinline__ void xcd_barrier_complete(unsigned* bar, unsigned x, unsigned& nloc, unsigned& nx) {
    const unsigned G = gridDim.x * gridDim.y * gridDim.z;
    unsigned sum, cnt, mine, sp = 0u;
    for (;;) {
        sum = 0u; cnt = 0u; mine = 0u;
#pragma unroll
        for (unsigned j = 0; j < 16; ++j) { const unsigned c = xb_ld(&bar[XB_XCNT(j)]); sum += c; cnt += (c > 0u) ? 1u : 0u; mine = (j == x) ? c : mine; }
        if (sum == G) break;
        __builtin_amdgcn_s_sleep(1);
        if ((++sp & 255u) == 0u) { if (xb_ld(&bar[XB_TMO])) break; if (sp > XB_SPIN_CAP) { atomicAdd(&bar[XB_TMO], 1u); break; } }
    }
    nloc = mine > 0u ? mine : 1u; nx = cnt > 0u ? cnt : 1u;
}

__device__ __forceinline__ void xcd_barrier(const XcdBarrier& b) {
    asm volatile("s_waitcnt vmcnt(0)" ::: "memory");
    __syncthreads();
    if (threadIdx.x == 0) {
        unsigned* bar = b.bar;
        __builtin_amdgcn_s_waitcnt(0);
        unsigned nloc = b.st[0], nx = b.st[1];
        if (nloc == 0u) { xcd_barrier_complete(bar, b.x, nloc, nx); b.st[0] = nloc; b.st[1] = nx; }
        const unsigned old = xb_add(&bar[XB_XSUB(b.x)], 1u);
        const unsigned gen = old / nloc;
        if (old + 1u == (gen + 1u) * nloc) {
            __builtin_amdgcn_fence(__ATOMIC_RELEASE, "agent");
            asm volatile("s_waitcnt vmcnt(0)" ::: "memory");
            const unsigned og = xb_add(&bar[XB_TOP], 1u);
            const unsigned tg = og / nx;
            if (og + 1u == (tg + 1u) * nx) xb_add(&bar[XB_TOPGEN], 1u);
            else XB_SPIN(xb_ld(&bar[XB_TOPGEN]) == tg, bar);
            __builtin_amdgcn_fence(__ATOMIC_ACQUIRE, "agent");
            xb_add(&bar[XB_XGEN(b.x)], 1u);
            asm volatile("s_waitcnt vmcnt(0)" ::: "memory");
        } else {
            XB_SPIN(xb_ld(&bar[XB_XGEN(b.x)]) == gen, bar);
            __builtin_amdgcn_fence(__ATOMIC_ACQUIRE, "agent");
            asm volatile("s_waitcnt vmcnt(0)" ::: "memory");
        }
    }
    __syncthreads();
}

struct Args { const GAS float* in[37]; GAS float* out; GAS unsigned char* ws; int ph_lo, ph_hi; };
enum In { I_X = 0, I_C, I_CTX, I_CCTX, I_WMOD, I_BMOD, I_WIN, I_GWG, I_GBG, I_GNG, I_HCW, I_HCB, I_HW1, I_HB1, I_HF1, I_HW2, I_HB2, I_HF2, I_HW3, I_HB3, I_HSKIP, I_HNG,
          I_QNG, I_WUQ, I_KVNG, I_WUKV, I_MNG, I_WOUT, I_LNG, I_LNB, I_FW1, I_FW3, I_FW2, I_ROUTER, I_MW1, I_MW3, I_MW2 };

struct Frame {
    LAS unsigned char* lds; GAS unsigned char* ws; gu32* ctl; const GAS float* const GAS* in; GAS float* out;
    int tid, lane, wave, G, gw, ngw;
};
__device__ __forceinline__ Frame launder(const Frame& F0) { Frame F = F0; int t = F0.tid; size_t z = 0; asm volatile("" : "+v"(t), "+s"(z)); F.tid = t; F.lane = t & 63; F.ws = F0.ws + z; F.ctl = (gu32*)(F.ws + WS_CTL); F.out = F0.out + z; return F; }
__device__ __forceinline__ float wave_sum(float v) {
#pragma unroll
    for (int o = 1; o < 64; o <<= 1) v += __shfl_xor(v, o);
    return v;
}
__device__ __forceinline__ const GAS float* modv(const Frame& F, int l, int v, int i) { return (const GAS float*)(F.ws + CTL_MODV) + ((size_t)(l * 3 + v) * 6 + i) * D; }
__device__ __forceinline__ int row_v(int row) { return row < TL ? (row >> 14) : 2; }

__device__ __forceinline__ void p0_modv(const Frame& F0) { const Frame F = launder(F0);
    const GAS float* c = F.in[I_C]; const GAS float* cc = F.in[I_CCTX]; const GAS float* wm = F.in[I_WMOD]; const GAS float* bm = F.in[I_BMOD];
    GAS float* mv = (GAS float*)(F.ws + CTL_MODV); LAS float* part = (LAS float*)F.lds;
    constexpr int NBLK = 6 * D / 64, NITEM = DEPTH * NBLK;
    for (int it = blockIdx.x; it < NITEM; it += F.G) {
        const int l = it / NBLK, nb = it % NBLK, n = nb * 64 + F.lane, k0 = F.wave * 128;
        const float s0a = siluf(c[k0 + F.lane]), s1a = siluf(c[D + k0 + F.lane]), s2a = siluf(cc[k0 + F.lane]);
        const float s0b = siluf(c[k0 + 64 + F.lane]), s1b = siluf(c[D + k0 + 64 + F.lane]), s2b = siluf(cc[k0 + 64 + F.lane]);
        float a0 = 0.f, a1 = 0.f, a2 = 0.f;
        const GAS float* w = wm + ((size_t)l * D + k0) * (6 * D) + n;
#pragma unroll 16
        for (int kk = 0; kk < 64; ++kk) { const float wv = w[(size_t)kk * (6 * D)]; a0 += __shfl(s0a, kk) * wv; a1 += __shfl(s1a, kk) * wv; a2 += __shfl(s2a, kk) * wv; }
#pragma unroll 16
        for (int kk = 0; kk < 64; ++kk) { const float wv = w[(size_t)(64 + kk) * (6 * D)]; a0 += __shfl(s0b, kk) * wv; a1 += __shfl(s1b, kk) * wv; a2 += __shfl(s2b, kk) * wv; }
        part[(F.wave * 3 + 0) * 64 + F.lane] = a0; part[(F.wave * 3 + 1) * 64 + F.lane] = a1; part[(F.wave * 3 + 2) * 64 + F.lane] = a2;
        __syncthreads();
        if (F.tid < 192) { const int v = F.tid >> 6, ln = F.tid & 63; float acc = bm[l * 6 * D + nb * 64 + ln];
#pragma unroll
            for (int wv = 0; wv < 8; ++wv) acc += part[(wv * 3 + v) * 64 + ln];
            mv[(size_t)(l * 3 + v) * 6 * D + nb * 64 + ln] = acc; }
        __syncthreads();
    }
}
template <class RowMap>
__device__ __forceinline__ void transpose_item(const GAS float* W, int N, GAS bf16* WT, int ldk, LAS float* scr, int item, int lane, const RowMap& rm, const GAS float* ks) {
    const int nblk = N / 32, kb = item / nblk, nb = item % nblk, k0 = 64 * kb, n0 = 32 * nb;
#pragma unroll 8
    for (int i = 0; i < 32; ++i) { const int kk = 2 * i + (lane >> 5); float v = W[(size_t)(k0 + kk) * N + n0 + (lane & 31)]; if (ks) v *= ks[k0 + kk]; scr[kk * 33 + (lane & 31)] = v; }
    LDS_WAIT(); asm volatile("" ::: "memory");
    const int c = lane & 7;
#pragma unroll
    for (int j = 0; j < 4; ++j) { const int n = (lane >> 3) + 8 * j; const LAS float* s = scr + (8 * c) * 33 + n;
        v4u o; o.x = pk2(s[0 * 33], s[1 * 33]); o.y = pk2(s[2 * 33], s[3 * 33]); o.z = pk2(s[4 * 33], s[5 * 33]); o.w = pk2(s[6 * 33], s[7 * 33]);
        *(GAS v4u*)(WT + (size_t)rm(n0 + n) * ldk + k0 + 8 * c) = o; }
    LDS_WAIT(); asm volatile("" ::: "memory");
}
__device__ __forceinline__ float clamp448(float x) { return fminf(fmaxf(x, -448.f), 448.f); }
__device__ __forceinline__ unsigned pk4_fp8(float a, float b, float c, float d) { unsigned w = 0; w = __builtin_amdgcn_cvt_pk_fp8_f32(clamp448(a), clamp448(b), w, false); w = __builtin_amdgcn_cvt_pk_fp8_f32(clamp448(c), clamp448(d), w, true); return w; }
template <class RowMap>
__device__ __forceinline__ void transpose_item_f8(const GAS float* W, int N, GAS unsigned char* WT, int ldk, LAS float* scr, int item, int lane, const RowMap& rm, float scale) {
    const int nblk = N / 32, kb = item / nblk, nb = item % nblk, k0 = 64 * kb, n0 = 32 * nb;
#pragma unroll 8
    for (int i = 0; i < 32; ++i) { const int kk = 2 * i + (lane >> 5); scr[kk * 33 + (lane & 31)] = W[(size_t)(k0 + kk) * N + n0 + (lane & 31)] * scale; }
    LDS_WAIT(); asm volatile("" ::: "memory");
    const int c = lane & 7;
#pragma unroll
    for (int j = 0; j < 4; ++j) { const int n = (lane >> 3) + 8 * j; const LAS float* s = scr + (8 * c) * 33 + n;
        v2u o; o.x = pk4_fp8(s[0 * 33], s[1 * 33], s[2 * 33], s[3 * 33]); o.y = pk4_fp8(s[4 * 33], s[5 * 33], s[6 * 33], s[7 * 33]);
        *(GAS v2u*)(WT + (size_t)rm(n0 + n) * ldk + k0 + 8 * c) = o; }
    LDS_WAIT(); asm volatile("" ::: "memory");
}
struct RmIdent { int off; __device__ int operator()(int n) const { return n + off; } };
struct RmWin { __device__ int operator()(int c) const {
    if (c < 768) return c; if (c < 800) return PH_ALR + (c - 768); if (c < 1568) return PH_HY + (c - 800); if (c < 1824) return PH_CQ + (c - 1568); if (c < 1952) return PH_CKV + (c - 1824); return PH_KR + (c - 1952); } };
struct RmGlu { int half; __device__ int operator()(int j) const { return (j >> 2) * 8 + half * 4 + (j & 3); } };

__device__ __forceinline__ void p0_weights(const Frame& F0) { const Frame F = launder(F0);
    LAS float* scr = (LAS float*)(F.lds + F.wave * 16384);
    GAS bf16* WIN = (GAS bf16*)(F.ws + WS_WIN); GAS bf16* WOUT = (GAS bf16*)(F.ws + WS_WOUT); GAS bf16* W13 = (GAS bf16*)(F.ws + WS_W13); GAS bf16* W2 = (GAS bf16*)(F.ws + WS_W2);
    GAS bf16* WUQ = (GAS bf16*)(F.ws + WS_WUQ); GAS bf16* WUKV = (GAS bf16*)(F.ws + WS_WUKV);
    constexpr int I_IN = (D / 64) * (1984 / 32), I_OUT = (D / 64) * (D / 32), I_F1 = (D / 64) * (DFF / 32), I_F2 = (DFF / 64) * (D / 32), I_UQ = (256 / 64) * (768 / 32), I_UKV = (128 / 64) * (1024 / 32);
    constexpr int NITEM = DEPTH * I_IN + DEPTH * I_OUT + 2 * I_F1 + I_F2 + DEPTH * I_UQ + DEPTH * I_UKV;
    for (int it = F.gw; it < NITEM; it += F.ngw) {
        int r = it;
        if (r < DEPTH * I_IN) { const int l = r / I_IN; transpose_item(F.in[I_WIN] + (size_t)l * D * 1984, 1984, WIN + (size_t)l * NPH * D, D, scr, r % I_IN, F.lane, RmWin{}, nullptr); continue; } r -= DEPTH * I_IN;
        if (r < DEPTH * I_OUT) { const int l = r / I_OUT; transpose_item(F.in[I_WOUT] + (size_t)l * D * D, D, WOUT + (size_t)l * D * D, D, scr, r % I_OUT, F.lane, RmIdent{0}, nullptr); continue; } r -= DEPTH * I_OUT;
        if (r < I_F1) { transpose_item(F.in[I_FW1], DFF, W13, D, scr, r, F.lane, RmGlu{0}, nullptr); continue; } r -= I_F1;
        if (r < I_F1) { transpose_item(F.in[I_FW3], DFF, W13, D, scr, r, F.lane, RmGlu{1}, nullptr); continue; } r -= I_F1;
        if (r < I_F2) { transpose_item(F.in[I_FW2], D, W2, DFF, scr, r, F.lane, RmIdent{0}, nullptr); continue; } r -= I_F2;
        if (r < DEPTH * I_UQ) { const int l = r / I_UQ; transpose_item(F.in[I_WUQ] + (size_t)l * 256 * 768, 768, WUQ + (size_t)l * 768 * 256, 256, scr, r % I_UQ, F.lane, RmIdent{0}, F.in[I_QNG] + l * 256); continue; } r -= DEPTH * I_UQ;
        { const int l = r / I_UKV; transpose_item(F.in[I_WUKV] + (size_t)l * 128 * 1024, 1024, WUKV + (size_t)l * 1024 * 256, 256, scr, r % I_UKV, F.lane, RmIdent{0}, F.in[I_KVNG] + l * 128); }
    }
    const int gt = blockIdx.x * NTHR + F.tid, ngt = F.G * NTHR;
    for (int i = gt; i < DEPTH * 64 * D / 8; i += ngt) { const int l = i / (64 * D / 8), r = i % (64 * D / 8); *(GAS v4u*)(WIN + ((size_t)l * NPH + 1984) * D + (size_t)r * 8) = (v4u){0u, 0u, 0u, 0u}; }
    for (int i = gt; i < DEPTH * 1024 * 128 / 8; i += ngt) { const int row = i / 16, c = i % 16; *(GAS v4u*)(WUKV + (size_t)row * 256 + 128 + c * 8) = (v4u){0u, 0u, 0u, 0u}; }
}

__device__ __forceinline__ void mod_store_bf16(const f32x4 (&v)[4], const GAS float* sh, const GAS float* sc, GAS bf16* orow, int lane) {
    GAS unsigned long long* o8 = (GAS unsigned long long*)orow + lane;
#pragma unroll
    for (int j = 0; j < 4; ++j) { const f32x4 a = ((const GAS f32x4*)sc)[lane + 64 * j], b = ((const GAS f32x4*)sh)[lane + 64 * j];
        const f32x4 y = v[j] * (a + 1.f) + b;
        o8[64 * j] = (unsigned long long)pk2(y.x, y.y) | ((unsigned long long)pk2(y.z, y.w) << 32); }
}
__device__ __forceinline__ void p_xn0(const Frame& F0) { const Frame F = launder(F0);
    GAS bf16* XN = (GAS bf16*)(F.ws + WS_XN);
    f32x4 nx[4];
#define XN0_LOAD(mm) do { const GAS float* src_ = (mm) < TL ? F.in[I_X] + (size_t)(mm) * D : F.in[I_CTX] + (size_t)((mm) - TL) * D; _Pragma("unroll") for (int j = 0; j < 4; ++j) nx[j] = ((const GAS f32x4*)src_)[F.lane + 64 * j]; } while (0)
    int m = F.gw; if (m < MR) XN0_LOAD(m);
    for (; m < MR; m += F.ngw) {
        f32x4 v[4];
#pragma unroll
        for (int j = 0; j < 4; ++j) v[j] = nx[j];
        if (m + F.ngw < MR) XN0_LOAD(m + F.ngw);
        const int vv = row_v(m);
        mod_store_bf16(v, modv(F, 0, vv, 0), modv(F, 0, vv, 1), XN + (size_t)m * D, F.lane);
    }
#undef XN0_LOAD
}
__device__ __forceinline__ GAS float* xres(const Frame& F, int row) { return row < TL ? F.out + (size_t)row * D : (GAS float*)(F.ws + WS_XC) + (size_t)(row - TL) * D; }
__device__ __forceinline__ void p_ln(const Frame& F0, int nrows, const GAS float* g, const GAS float* b, bool want_xn, int ml, int si) { const Frame F = launder(F0);
    GAS bf16* XN = (GAS bf16*)(F.ws + WS_XN);
    f32x4 nx[4];
    int m = F.gw; if (m < nrows) { const GAS float* r_ = xres(F, m);
#pragma unroll
        for (int j = 0; j < 4; ++j) nx[j] = ((const GAS f32x4*)r_)[F.lane + 64 * j]; }
    for (; m < nrows; m += F.ngw) {
        GAS float* row = xres(F, m);
        f32x4 v[4]; float s = 0.f;
#pragma unroll
        for (int j = 0; j < 4; ++j) { v[j] = nx[j]; s += (v[j].x + v[j].y) + (v[j].z + v[j].w); }
        if (m + F.ngw < nrows) { const GAS float* r_ = xres(F, m + F.ngw);
#pragma unroll
            for (int j = 0; j < 4; ++j) nx[j] = ((const GAS f32x4*)r_)[F.lane + 64 * j]; }
        const float mean = wave_sum(s) * (1.f / D); float s2 = 0.f;
#pragma unroll
        for (int j = 0; j < 4; ++j) { v[j] = v[j] - mean; s2 += (v[j].x * v[j].x + v[j].y * v[j].y) + (v[j].z * v[j].z + v[j].w * v[j].w); }
        const float rstd = 1.f / sqrtf(wave_sum(s2) * (1.f / D) + LN_EPS);
#pragma unroll
        for (int j = 0; j < 4; ++j) { const f32x4 gg = ((const GAS f32x4*)g)[F.lane + 64 * j], bb = ((const GAS f32x4*)b)[F.lane + 64 * j]; v[j] = v[j] * rstd * gg + bb; ((GAS f32x4*)row)[F.lane + 64 * j] = v[j]; }
        if (want_xn) { const int vv = row_v(m); mod_store_bf16(v, modv(F, ml, vv, si), modv(F, ml, vv, si + 1), XN + (size_t)m * D, F.lane); }
    }
}

using pg8::f32x4; using pg8::Unit;
struct EpiStoreBf16 {
    static constexpr bool PERM = true, AFTER_DRAIN = false;
    GAS bf16* O; int ldc; float sc;
    __device__ __forceinline__ void operator()(const pg8::f32x4 (&acc)[2][2][4][2], const Unit& u, int wr, int wc, int fr, int fq) const {
        const int row0 = u.pm * 256 + wr * 64 + fr, col0 = u.pn * 256 + wc * 32 + 8 * fq;
#pragma unroll
        for (int ai = 0; ai < 2; ++ai)
#pragma unroll
            for (int m = 0; m < 4; ++m) { GAS bf16* rowp = O + (size_t)(row0 + ai * 128 + m * 16) * ldc + col0;
#pragma unroll
                for (int bj = 0; bj < 2; ++bj) { const pg8::f32x4 v0 = acc[ai][bj][m][0] * sc, v1 = acc[ai][bj][m][1] * sc;
                    v4u w; w.x = pk2(v0[0], v0[1]); w.y = pk2(v0[2], v0[3]); w.z = pk2(v1[0], v1[1]); w.w = pk2(v1[2], v1[3]);
                    *(GAS v4u*)(rowp + bj * 128) = w; } }
    }
};
struct EpiSwiglu {
    static constexpr bool PERM = true, AFTER_DRAIN = false;
    GAS bf16* G; int ldg; float sc;
    __device__ __forceinline__ void operator()(const pg8::f32x4 (&acc)[2][2][4][2], const Unit& u, int wr, int wc, int fr, int fq) const {
        const int row0 = u.pm * 256 + wr * 64 + fr, col0 = (u.pn * 256 + wc * 32 + 8 * fq) >> 1;
#pragma unroll
        for (int ai = 0; ai < 2; ++ai)
#pragma unroll
            for (int m = 0; m < 4; ++m) { GAS bf16* rowp = G + (size_t)(row0 + ai * 128 + m * 16) * ldg + col0;
#pragma unroll
                for (int bj = 0; bj < 2; ++bj) { const pg8::f32x4 a = acc[ai][bj][m][0] * sc, b = acc[ai][bj][m][1] * sc;
                    v2u w; w.x = pk2(siluf(a[0]) * b[0], siluf(a[1]) * b[1]); w.y = pk2(siluf(a[2]) * b[2], siluf(a[3]) * b[3]);
                    *(GAS v2u*)(rowp + bj * 64) = w; } }
    }
};
struct EpiSwiglu8 {
    static constexpr bool PERM = true, AFTER_DRAIN = false;
    GAS unsigned char* G; int ldg; float sc, osc;
    __device__ __forceinline__ void operator()(const pg8::f32x4 (&acc)[2][2][4][2], const Unit& u, int wr, int wc, int fr, int fq) const {
        const int row0 = u.pm * 256 + wr * 64 + fr, col0 = (u.pn * 256 + wc * 32 + 8 * fq) >> 1;
#pragma unroll
        for (int ai = 0; ai < 2; ++ai)
#pragma unroll
            for (int m = 0; m < 4; ++m) { GAS unsigned char* rowp = G + (size_t)(row0 + ai * 128 + m * 16) * ldg + col0;
#pragma unroll
                for (int bj = 0; bj < 2; ++bj) { const pg8::f32x4 a = acc[ai][bj][m][0] * sc, b = acc[ai][bj][m][1] * sc;
                    *(GAS unsigned*)(rowp + bj * 64) = pk4_fp8(siluf(a[0]) * b[0] * osc, siluf(a[1]) * b[1] * osc, siluf(a[2]) * b[2] * osc, siluf(a[3]) * b[3] * osc); } }
    }
};
struct EpiRes {
    static constexpr bool PERM = false, AFTER_DRAIN = false;
    const GAS float* xin_lat; const GAS float* xin_ctx; GAS float* out_lat; GAS float* out_ctx; const GAS float* gate0;
    __device__ __forceinline__ void operator()(const pg8::f32x4 (&acc)[2][2][4][2], const Unit& u, int wr, int wc, int fr, int fq) const {
        const bool lat = u.pm < TL / 256; const int v = lat ? (u.pm >> 6) : 2;
        const GAS float* xin = lat ? xin_lat : xin_ctx - (size_t)TL * D; GAS float* out = lat ? out_lat : out_ctx - (size_t)TL * D;
        const GAS float* gate = gate0 + (size_t)v * 6 * D;
        const int row0 = u.pm * 256 + wr * 64 + fr, col0 = u.pn * 256 + wc * 32 + 4 * fq;
        pg8::f32x4 gv[2][2];
#pragma unroll
        for (int bj = 0; bj < 2; ++bj)
#pragma unroll
            for (int n = 0; n < 2; ++n) gv[bj][n] = *(const GAS pg8::f32x4*)(gate + col0 + bj * 128 + n * 16);
#pragma unroll
        for (int ai = 0; ai < 2; ++ai)
#pragma unroll
            for (int m = 0; m < 4; ++m) { const size_t off = (size_t)(row0 + ai * 128 + m * 16) * D + col0;
#pragma unroll
                for (int bj = 0; bj < 2; ++bj)
#pragma unroll
                    for (int n = 0; n < 2; ++n) { const pg8::f32x4 xv = *(const GAS pg8::f32x4*)(xin + off + bj * 128 + n * 16);
                        *(GAS pg8::f32x4*)(out + off + bj * 128 + n * 16) = xv * ALPHA + gv[bj][n] * acc[ai][bj][m][n]; } }
    }
};


constexpr int CW_MOECNT = 2048;
constexpr size_t WS_TI = WS_SMALL + 64 * 1024;
constexpr int MOE_CHUNK_TILES = 64, MOE_NCHUNK = 5, MOE_MAXROWS = MOE_NCHUNK * MOE_CHUNK_TILES * 256;
constexpr size_t WS_HS = AB + 65 * MiB, WS_WM13 = AB + 197 * MiB, WS_WM2 = AB + 309 * MiB, WS_GC = AB + 365 * MiB;
constexpr size_t WS_H8 = WS_XN, WS_HS8 = WS_HS + 66 * MiB;
constexpr float MOE_WSCALE = 64.f, MOE_GSCALE = 16.f, MOE_W2SCALE = 256.f;
static_assert(WS_HS + (size_t)(2 * TL + NEXP * 256) * D * 2 <= WS_WM13 && WS_WM13 + (size_t)NEXP * 2 * EFF * D * 2 <= WS_WM2 && WS_WM2 + (size_t)NEXP * D * EFF * 2 <= WS_GC && WS_GC + (size_t)MOE_CHUNK_TILES * 256 * EFF * 2 <= WS_XC, "MoE map");

__device__ __forceinline__ void p_ln_route(const Frame& F0, const GAS float* g, const GAS float* b, int l) { const Frame F = launder(F0);
    GAS bf16* XN = (GAS bf16*)(F.ws + WS_XN);
    GAS int* TI_E = (GAS int*)(F.ws + WS_TI); GAS int* TI_P0 = TI_E + TL; GAS int* TI_P1 = TI_P0 + TL; GAS float* TI_W0 = (GAS float*)(TI_P1 + TL); GAS float* TI_W1 = TI_W0 + TL;
    const GAS float* wr = F.in[I_ROUTER];
    f32x4 nx[4];
    int m = F.gw; if (m < TL) {
#pragma unroll
        for (int j = 0; j < 4; ++j) nx[j] = ((const GAS f32x4*)(F.out + (size_t)m * D))[F.lane + 64 * j]; }
    for (; m < TL; m += F.ngw) {
        GAS float* row = F.out + (size_t)m * D;
        f32x4 v[4]; float s = 0.f;
#pragma unroll
        for (int j = 0; j < 4; ++j) { v[j] = nx[j]; s += (v[j].x + v[j].y) + (v[j].z + v[j].w); }
        if (m + F.ngw < TL) {
#pragma unroll
            for (int j = 0; j < 4; ++j) nx[j] = ((const GAS f32x4*)(F.out + (size_t)(m + F.ngw) * D))[F.lane + 64 * j]; }
        const float mean = wave_sum(s) * (1.f / D); float s2 = 0.f;
#pragma unroll
        for (int j = 0; j < 4; ++j) { v[j] = v[j] - mean; s2 += (v[j].x * v[j].x + v[j].y * v[j].y) + (v[j].z * v[j].z + v[j].w * v[j].w); }
        const float rstd = 1.f / sqrtf(wave_sum(s2) * (1.f / D) + LN_EPS);
        const int vv = row_v(m); const GAS float* sh = modv(F, l, vv, 3); const GAS float* sc = modv(F, l, vv, 4);
        GAS unsigned* h8 = (GAS unsigned*)(F.ws + WS_H8 + (size_t)m * D) + F.lane;
        float lg[NEXP];
#pragma unroll
        for (int e = 0; e < NEXP; ++e) lg[e] = 0.f;
#pragma unroll
        for (int j = 0; j < 4; ++j) { const f32x4 gg = ((const GAS f32x4*)g)[F.lane + 64 * j], bb = ((const GAS f32x4*)b)[F.lane + 64 * j]; v[j] = v[j] * rstd * gg + bb; ((GAS f32x4*)row)[F.lane + 64 * j] = v[j];
            const f32x4 a = ((const GAS f32x4*)sc)[F.lane + 64 * j], c = ((const GAS f32x4*)sh)[F.lane + 64 * j];
            const f32x4 y = v[j] * (a + 1.f) + c;
            h8[64 * j] = pk4_fp8(y.x, y.y, y.z, y.w);
            const GAS f32x4* w4 = (const GAS f32x4*)(wr + (size_t)(4 * F.lane + 256 * j) * NEXP);
#pragma unroll
            for (int i = 0; i < 4; ++i) { const f32x4 wa = w4[2 * i], wb = w4[2 * i + 1]; const float yi = y[i];
                lg[0] += yi * wa.x; lg[1] += yi * wa.y; lg[2] += yi * wa.z; lg[3] += yi * wa.w; lg[4] += yi * wb.x; lg[5] += yi * wb.y; lg[6] += yi * wb.z; lg[7] += yi * wb.w; } }
#pragma unroll
        for (int e = 0; e < NEXP; ++e) lg[e] = wave_sum(lg[e]);
        int i0 = 0; float v0 = lg[0];
#pragma unroll
        for (int e = 1; e < NEXP; ++e) if (lg[e] > v0) { v0 = lg[e]; i0 = e; }
        int i1 = -1; float v1 = -3.0e38f;
#pragma unroll
        for (int e = 0; e < NEXP; ++e) if (e != i0 && lg[e] > v1) { v1 = lg[e]; i1 = e; }
        if (F.lane == 0) {
            const float w0 = 1.f / (1.f + __expf(v1 - v0));
            const int p0 = (int)__hip_atomic_fetch_add((GAS unsigned*)F.ctl + CW_MOECNT + 64 * i0, 1u, RLX_AGENT);
            const int p1 = (int)__hip_atomic_fetch_add((GAS unsigned*)F.ctl + CW_MOECNT + 64 * i1, 1u, RLX_AGENT);
            TI_E[m] = i0 | (i1 << 8); TI_P0[m] = p0; TI_P1[m] = p1; TI_W0[m] = w0; TI_W1[m] = 1.f - w0;
        }
    }
}
struct MoeBase { int bt[NEXP + 1]; };
__device__ __forceinline__ MoeBase moe_base(const Frame& F) {
    MoeBase B; int acc = 0;
#pragma unroll
    for (int e = 0; e < NEXP; ++e) { B.bt[e] = acc; const unsigned c = __hip_atomic_load((GAS unsigned*)F.ctl + CW_MOECNT + 64 * e, RLX_AGENT); acc += (int)((c + 255u) >> 8); }
    B.bt[NEXP] = acc; return B;
}
__device__ __forceinline__ void p_moe_weights(const Frame& F0) { const Frame F = launder(F0);
    LAS float* scr = (LAS float*)(F.lds + F.wave * 16384);
    GAS unsigned char* WM13 = F.ws + WS_WM13; GAS unsigned char* WM2 = F.ws + WS_WM2;
    constexpr int I1 = (D / 64) * (EFF / 32), I2 = (EFF / 64) * (D / 32), NITEM = NEXP * (2 * I1 + I2);
    for (int it = F.gw; it < NITEM; it += F.ngw) {
        const int e = it / (2 * I1 + I2); int r = it % (2 * I1 + I2);
        if (r < I1) { transpose_item_f8(F.in[I_MW1] + (size_t)e * D * EFF, EFF, WM13 + (size_t)e * 2 * EFF * D, D, scr, r, F.lane, RmGlu{0}, MOE_WSCALE); continue; } r -= I1;
        if (r < I1) { transpose_item_f8(F.in[I_MW3] + (size_t)e * D * EFF, EFF, WM13 + (size_t)e * 2 * EFF * D, D, scr, r, F.lane, RmGlu{1}, MOE_WSCALE); continue; } r -= I1;
        transpose_item_f8(F.in[I_MW2] + (size_t)e * EFF * D, D, WM2 + (size_t)e * D * EFF, EFF, scr, r, F.lane, RmIdent{0}, MOE_W2SCALE);
    }
}
__device__ __forceinline__ void p_moe_scatter(const Frame& F0) { const Frame F = launder(F0);
    const MoeBase B = moe_base(F);
    const GAS unsigned char* H8 = F.ws + WS_H8; GAS unsigned char* HS8 = F.ws + WS_HS8;
    GAS int* TI_E = (GAS int*)(F.ws + WS_TI); GAS int* TI_P0 = TI_E + TL; GAS int* TI_P1 = TI_P0 + TL;
    for (int m = F.gw; m < TL; m += F.ngw) {
        const int ee = TI_E[m], e0 = ee & 255, e1 = ee >> 8;
        int b0 = 0, b1 = 0;
#pragma unroll
        for (int e = 0; e < NEXP; ++e) { if (e == e0) b0 = B.bt[e]; if (e == e1) b1 = B.bt[e]; }
        const int s0 = b0 * 256 + TI_P0[m], s1 = b1 * 256 + TI_P1[m];
        const v4u a = *((const GAS v4u*)(H8 + (size_t)m * D) + F.lane);
        *((GAS v4u*)(HS8 + (size_t)s0 * D) + F.lane) = a; *((GAS v4u*)(HS8 + (size_t)s1 * D) + F.lane) = a;
        if (F.lane == 0) { TI_P0[m] = s0; TI_P1[m] = s1; }
    }
}
constexpr int LDS_MOEBT = LDS_MISC + 64;
__device__ __forceinline__ void moe_base_to_lds(const Frame& F) {
    if (F.tid == 0) { volatile LAS int* bt = (volatile LAS int*)(F.lds + LDS_MOEBT); int acc = 0;
        for (int e = 0; e < NEXP; ++e) { bt[e] = acc; const unsigned c = __hip_atomic_load((GAS unsigned*)F.ctl + CW_MOECNT + 64 * e, RLX_AGENT); acc += (int)((c + 255u) >> 8); }
        bt[NEXP] = acc; }
    __syncthreads();
}
struct MoeOrder {
    int nM, nN, nwg, G, c, tile0; const LAS int* bt;
    __device__ void init(const LAS int* bt_, int chunk, int nN_, int G_, int c_) {
        bt = bt_; tile0 = chunk * MOE_CHUNK_TILES; int v = bt[NEXP] - tile0; nM = v < 0 ? 0 : (v > MOE_CHUNK_TILES ? MOE_CHUNK_TILES : v); nN = nN_; nwg = nM * nN; G = G_; c = c_; }
    __device__ bool next(int i, pg8::Unit& u) const {
        const long L = (long)i * G + c; if (L >= nwg) return false;
        int wgid = (int)L; { const int q = nwg / pg8::NXCD, r = nwg % pg8::NXCD, xcd = wgid % pg8::NXCD, off = wgid / pg8::NXCD; wgid = (xcd < r ? xcd * (q + 1) : r * (q + 1) + (xcd - r) * q) + off; }
        const int nig = pg8::WGM * nN, gid = wgid / nig, fm = gid * pg8::WGM, gsz = (nM - fm) < pg8::WGM ? (nM - fm) : pg8::WGM;
        u.pm = fm + ((wgid % nig) % gsz); u.pn = (wgid % nig) / gsz;
        const int gt = tile0 + u.pm; int e = 0;
#pragma unroll
        for (int k = 1; k < NEXP; ++k) e += (gt >= bt[k]) ? 1 : 0;
        u.be = __builtin_amdgcn_readfirstlane(e); return true;
    }
    __device__ __forceinline__ void a_ready(const pg8::Unit&) const {}
    __device__ __forceinline__ void done(const pg8::Unit&) const {}
};
__device__ __forceinline__ void p_ln_combine(const Frame& F0, const GAS float* g, const GAS float* b, int l) { const Frame F = launder(F0);
    const GAS bf16* YS = (const GAS bf16*)(F.ws + WS_HS);
    GAS int* TI_E = (GAS int*)(F.ws + WS_TI); GAS int* TI_P0 = TI_E + TL; GAS int* TI_P1 = TI_P0 + TL; GAS float* TI_W0 = (GAS float*)(TI_P1 + TL); GAS float* TI_W1 = TI_W0 + TL;
    for (int m = F.gw; m < TL; m += F.ngw) {
        GAS float* row = F.out + (size_t)m * D;
        const int s0 = TI_P0[m], s1 = TI_P1[m]; const float w0 = TI_W0[m], w1 = TI_W1[m];
        const GAS float* gate = modv(F, l, row_v(m), 5);
        const GAS unsigned long long* y0 = (const GAS unsigned long long*)(YS + (size_t)s0 * D) + F.lane; const GAS unsigned long long* y1 = (const GAS unsigned long long*)(YS + (size_t)s1 * D) + F.lane;
        f32x4 v[4]; float s = 0.f;
#pragma unroll
        for (int j = 0; j < 4; ++j) { const f32x4 x = ((const GAS f32x4*)row)[F.lane + 64 * j], gt = ((const GAS f32x4*)gate)[F.lane + 64 * j];
            const unsigned long long a = y0[64 * j], c = y1[64 * j];
            f32x4 f;
            f.x = w0 * bf2f((unsigned short)a) + w1 * bf2f((unsigned short)c); f.y = w0 * bf2f((unsigned short)(a >> 16)) + w1 * bf2f((unsigned short)(c >> 16));
            f.z = w0 * bf2f((unsigned short)(a >> 32)) + w1 * bf2f((unsigned short)(c >> 32)); f.w = w0 * bf2f((unsigned short)(a >> 48)) + w1 * bf2f((unsigned short)(c >> 48));
            v[j] = x * ALPHA + gt * f; s += (v[j].x + v[j].y) + (v[j].z + v[j].w); }
        const float mean = wave_sum(s) * (1.f / D); float s2 = 0.f;
#pragma unroll
        for (int j = 0; j < 4; ++j) { v[j] = v[j] - mean; s2 += (v[j].x * v[j].x + v[j].y * v[j].y) + (v[j].z * v[j].z + v[j].w * v[j].w); }
        const float rstd = 1.f / sqrtf(wave_sum(s2) * (1.f / D) + LN_EPS);
#pragma unroll
        for (int j = 0; j < 4; ++j) { const f32x4 gg = ((const GAS f32x4*)g)[F.lane + 64 * j], bb = ((const GAS f32x4*)b)[F.lane + 64 * j]; ((GAS f32x4*)row)[F.lane + 64 * j] = v[j] * rstd * gg + bb; }
    }
}

namespace att {
using bf16x8 = __attribute__((ext_vector_type(8))) short;
using s16x4  = __attribute__((ext_vector_type(4))) short;
using f32x16 = __attribute__((ext_vector_type(16))) float;
using u32x4  = __attribute__((ext_vector_type(4))) unsigned;
constexpr int DQ = 96, DV = 64, NW = 8, QBLK = 32, KVBLK = 64, NKEY = 16640;
constexpr float THR2 = 8.0f;
constexpr int SHM_K = KVBLK * 144, SHM_V = DV * 80;
typedef int i32x8 __attribute__((ext_vector_type(8)));
constexpr int NSLOT = 8;
constexpr int LDS_V = 0, LDS_K = NSLOT * SHM_V, LDS_WS = LDS_K + NSLOT * SHM_K, LDS_Q = LDS_WS + NW * 64 * 4, ATT_LDS = LDS_Q + NW * 4096;
#define KSWZ(row, colB) ((row) * 256 + ((colB) ^ (((row) & 7) << 4)))
#define SBAR() __builtin_amdgcn_sched_barrier(0)
__device__ __forceinline__ int crow(int r, int hi) { return (r & 3) + 8 * (r >> 2) + 4 * hi; }
__device__ __forceinline__ unsigned cvtpk(float lo, float hi) { unsigned r; asm volatile("v_cvt_pk_bf16_f32 %0, %1, %2" : "=v"(r) : "v"(lo), "v"(hi)); return r; }
template <bool FIRST>
__device__ __forceinline__ bool partialSM(f32x16& p0, f32x16& p1, f32x16& negm, float& alpha) {
  float a = fmaxf(fmaxf(p0[0], p0[1]), p1[0]), b = fmaxf(fmaxf(p0[2], p0[3]), p1[1]); a = fmaxf(fmaxf(a, p1[2]), p1[3]);
#pragma unroll
  for (int r = 4; r < 16; r += 4) { a = fmaxf(fmaxf(a, p0[r]), p0[r + 1]); b = fmaxf(fmaxf(b, p0[r + 2]), p0[r + 3]); a = fmaxf(fmaxf(a, p1[r]), p1[r + 1]); b = fmaxf(fmaxf(b, p1[r + 2]), p1[r + 3]); }
  float pmax = fmaxf(a, b);
  { auto rr = __builtin_amdgcn_permlane32_swap(__float_as_uint(pmax), __float_as_uint(pmax), false, false);
    pmax = fmaxf(__uint_as_float(rr[0]), __uint_as_float(rr[1])); }
  bool resc = false;
  if (FIRST || __builtin_expect(__any(pmax > THR2), 0)) {
    const float dl = FIRST ? pmax : fmaxf(pmax, 0.f);
#pragma unroll
    for (int r = 0; r < 16; ++r) { p0[r] -= dl; p1[r] -= dl; negm[r] -= dl; }
    alpha = __builtin_amdgcn_exp2f(-dl); resc = !FIRST;
  }
  return resc;
}
__device__ __forceinline__ void finishSM(f32x16& p0, f32x16& p1, i32x8& pb) {
#pragma unroll
  for (int r = 0; r < 16; ++r) p0[r] = __builtin_amdgcn_exp2f(p0[r]);
#pragma unroll
  for (int r = 0; r < 16; ++r) p1[r] = __builtin_amdgcn_exp2f(p1[r]);
#pragma unroll
  for (int w = 0; w < 4; ++w) {
    int x = __builtin_amdgcn_cvt_pk_fp8_f32(p0[4 * w], p0[4 * w + 1], __float_as_int(p0[4 * w]), false); x = __builtin_amdgcn_cvt_pk_fp8_f32(p0[4 * w + 2], p0[4 * w + 3], x, true); pb[w] = x;
    int y = __builtin_amdgcn_cvt_pk_fp8_f32(p1[4 * w], p1[4 * w + 1], __float_as_int(p1[4 * w]), false); y = __builtin_amdgcn_cvt_pk_fp8_f32(p1[4 * w + 2], p1[4 * w + 3], y, true); pb[4 + w] = y; }
}
__device__ __forceinline__ i32x8 ld32(const LAS char* p) { const u32x4 a = *reinterpret_cast<const LAS u32x4*>(p), b = *reinterpret_cast<const LAS u32x4*>(p + 16);
  return (i32x8){(int)a[0], (int)a[1], (int)a[2], (int)a[3], (int)b[0], (int)b[1], (int)b[2], (int)b[3]}; }
struct KFrag { i32x8 k00, k01, k10, k11; };
__device__ __forceinline__ void qkt_load(KFrag& k, const LAS char* Ks, int r32, int hi) {
  const LAS char* kp = Ks + r32 * 144 + hi * 32;
  k.k00 = ld32(kp); k.k01 = ld32(kp + 64); k.k10 = ld32(kp + 32 * 144); k.k11 = ld32(kp + 32 * 144 + 64);
}
__device__ __forceinline__ void qkt_mma(f32x16& p0, f32x16& p1, const KFrag& k, const i32x8& q0, const i32x8& q1, const f32x16& negm) {
  asm volatile("s_nop 1\n\tv_mfma_f32_32x32x64_f8f6f4 %0, %1, %2, %3" : "=&v"(p0) : "v"(k.k00), "v"(q0), "v"(negm));
  asm volatile("v_mfma_f32_32x32x64_f8f6f4 %0, %1, %2, %3" : "=&v"(p1) : "v"(k.k10), "v"(q0), "v"(negm));
  asm volatile("v_mfma_f32_32x32x64_f8f6f4 %0, %1, %2, %0" : "+v"(p0) : "v"(k.k01), "v"(q1));
  asm volatile("v_mfma_f32_32x32x64_f8f6f4 %0, %1, %2, %0" : "+v"(p1) : "v"(k.k11), "v"(q1));
}
__device__ __forceinline__ void qkt(f32x16& p0, f32x16& p1, const LAS char* Ks, const i32x8& q0, const i32x8& q1, const f32x16& negm, int r32, int hi) {
  KFrag k; qkt_load(k, Ks, r32, hi); qkt_mma(p0, p1, k, q0, q1, negm);
}
#define QK_DRAIN(P0, P1) asm volatile("s_nop 15\n\ts_nop 7" : "+v"(P0), "+v"(P1))
__device__ __forceinline__ void pv_d0(f32x16* o, const LAS char* Vs, const i32x8& pb, int r32, int hi) {
  const LAS char* vp = Vs + r32 * 80 + hi * 32;
  const u32x4 a0 = *reinterpret_cast<const LAS u32x4*>(vp), a1 = *reinterpret_cast<const LAS u32x4*>(vp + 16);
  const u32x4 b0 = *reinterpret_cast<const LAS u32x4*>(vp + 32 * 80), b1 = *reinterpret_cast<const LAS u32x4*>(vp + 32 * 80 + 16);
  const i32x8 va = {(int)a0[0], (int)a0[1], (int)a0[2], (int)a0[3], (int)a1[0], (int)a1[1], (int)a1[2], (int)a1[3]};
  const i32x8 vb = {(int)b0[0], (int)b0[1], (int)b0[2], (int)b0[3], (int)b1[0], (int)b1[1], (int)b1[2], (int)b1[3]};
  const i32x8 ones = {0x38383838, 0x38383838, 0x38383838, 0x38383838, 0x38383838, 0x38383838, 0x38383838, 0x38383838};
  asm volatile("s_nop 1\n\tv_mfma_f32_32x32x64_f8f6f4 %0, %1, %2, %0" : "+v"(o[0]) : "v"(va), "v"(pb));
  asm volatile("v_mfma_f32_32x32x64_f8f6f4 %0, %1, %2, %0" : "+v"(o[1]) : "v"(vb), "v"(pb));
  asm volatile("v_mfma_f32_32x32x64_f8f6f4 %0, %1, %2, %0" : "+v"(o[2]) : "v"(ones), "v"(pb));
}
#define PV_DRAIN() asm volatile("s_nop 15\n\ts_nop 7" : "+v"(o[0]), "+v"(o[1]), "+v"(o[2]))
#define QK_A(P, KA, QA) asm volatile("s_nop 1\n\tv_mfma_f32_32x32x64_f8f6f4 %0, %1, %2, %3" : "=&v"(P) : "v"(KA), "v"(QA), "v"(negm))
#define QK_B(P, KA, QA) asm volatile("v_mfma_f32_32x32x64_f8f6f4 %0, %1, %2, %3" : "=&v"(P) : "v"(KA), "v"(QA), "v"(negm))
#define QK_C(P, KA, QA) asm volatile("v_mfma_f32_32x32x64_f8f6f4 %0, %1, %2, %0" : "+v"(P) : "v"(KA), "v"(QA))
#define PV_A(O, VA) asm volatile("s_nop 1\n\tv_mfma_f32_32x32x64_f8f6f4 %0, %1, %2, %0" : "+v"(O) : "v"(VA), "v"(pb))
#define PV_B(O, VA) asm volatile("v_mfma_f32_32x32x64_f8f6f4 %0, %1, %2, %0" : "+v"(O) : "v"(VA), "v"(pb))
#define EXPS(P, lo, hi_) do { _Pragma("unroll") for (int r_ = (lo); r_ < (hi_); ++r_) P[r_] = __builtin_amdgcn_exp2f(P[r_]); } while (0)
#define CVT4(P, w_, dst) do { int x_ = __builtin_amdgcn_cvt_pk_fp8_f32(P[4 * (w_)], P[4 * (w_) + 1], __float_as_int(P[4 * (w_)]), false); dst = __builtin_amdgcn_cvt_pk_fp8_f32(P[4 * (w_) + 2], P[4 * (w_) + 3], x_, true); } while (0)
__device__ __forceinline__ float mx3(float a, float b, float c) { float r; asm("v_max3_f32 %0, %1, %2, %3" : "=v"(r) : "v"(a), "v"(b), "v"(c)); return r; }
__device__ __forceinline__ float max16(const f32x16& p) {
  float a = mx3(p[0], p[1], p[2]), b = mx3(p[3], p[4], p[5]);
  a = mx3(a, p[6], p[7]); b = mx3(b, p[8], p[9]); a = mx3(a, p[10], p[11]); b = mx3(b, p[12], p[13]);
  return mx3(a, p[14], mx3(b, p[15], p[15]));
}
__device__ __forceinline__ void attn_unit(const GAS unsigned char* __restrict__ Qb, const GAS unsigned char* __restrict__ Kh, const GAS unsigned char* __restrict__ Vh,
                                          GAS unsigned short* __restrict__ Ob, int ldo, int seq, LAS char* lds, int tid) {
  const int wid = tid >> 6, lane = tid & 63, r32 = lane & 31, hi = lane >> 5;
  LAS char* V_lds = lds + LDS_V; LAS char* K_lds = lds + LDS_K;
  f32x16 o[3] = {}; f32x16 negm = {};
  const GAS unsigned char* Qw = Qb + (long)(wid * QBLK + r32) * 128 + hi * 32;
  i32x8 q0, q1;
  { const u32x4 a = *reinterpret_cast<const GAS u32x4*>(Qw), b = *reinterpret_cast<const GAS u32x4*>(Qw + 16), c = *reinterpret_cast<const GAS u32x4*>(Qw + 64), d = *reinterpret_cast<const GAS u32x4*>(Qw + 80);
    q0 = (i32x8){(int)a[0], (int)a[1], (int)a[2], (int)a[3], (int)b[0], (int)b[1], (int)b[2], (int)b[3]}; q1 = (i32x8){(int)c[0], (int)c[1], (int)c[2], (int)c[3], (int)d[0], (int)d[1], (int)d[2], (int)d[3]}; }
  const int vst = (tid >> 3) * 80 + (tid & 7) * 8;
  const int kst0 = (tid >> 3) * 144 + (tid & 7) * 16;
  const GAS unsigned char* Ku = (const GAS unsigned char*)(((unsigned long long)(unsigned)__builtin_amdgcn_readfirstlane((unsigned)((unsigned long long)Kh >> 32)) << 32) | (unsigned long long)(unsigned)__builtin_amdgcn_readfirstlane((unsigned)(unsigned long long)Kh));
  const GAS unsigned char* Vu = (const GAS unsigned char*)(((unsigned long long)(unsigned)__builtin_amdgcn_readfirstlane((unsigned)((unsigned long long)Vh >> 32)) << 32) | (unsigned long long)(unsigned)__builtin_amdgcn_readfirstlane((unsigned)(unsigned long long)Vh));
  const unsigned ko = (unsigned)tid * 16u, vo = (unsigned)tid * 8u;
  bf16x8 sk; v2u sv;
#define SLOAD(t) do { sk = *reinterpret_cast<const GAS bf16x8*>(Ku + (size_t)(t) * (KVBLK * 128) + ko); sv = *reinterpret_cast<const GAS v2u*>(Vu + (size_t)(t) * 4096 + vo); } while (0)
#define SWRITE(t) do { *(LAS bf16x8*)(K_lds + ((t) & 7) * SHM_K + kst0) = sk; *(LAS v2u*)(V_lds + ((t) & 7) * SHM_V + vst) = sv; } while (0)
#define KS(t) (K_lds + ((t) & 7) * SHM_K)
#define VS(t) (V_lds + ((t) & 7) * SHM_V)
#define RESC(flag, a) do { if (flag) { PV_DRAIN(); _Pragma("unroll") for (int d = 0; d < 3; ++d) _Pragma("unroll") for (int r = 0; r < 16; ++r) o[d][r] *= (a); } } while (0)
#define PSM_TAIL(N0, N1, pm) do { float pmax = (pm); \
    { auto rr = __builtin_amdgcn_permlane32_swap(__float_as_uint(pmax), __float_as_uint(pmax), false, false); pmax = mx3(__uint_as_float(rr[0]), __uint_as_float(rr[1]), __uint_as_float(rr[1])); } \
    if (__builtin_expect(__any(pmax > THR2), 0)) { const float dl = fmaxf(pmax, 0.f); \
      _Pragma("unroll") for (int r = 0; r < 16; ++r) { N0[r] -= dl; N1[r] -= dl; negm[r] -= dl; } \
      const float al = __builtin_amdgcn_exp2f(-dl); RESC(true, al); } } while (0)
#define HI(j, C0, C1, N0, N1, DO_BAR, DO_QK, DO_KR, DO_SW, DO_SL) do { \
    if (DO_BAR) __syncthreads(); \
    if (DO_SW) SWRITE((j) + 4); \
    if (DO_SL) SLOAD((j) + 5); \
    SBAR(); \
    if (DO_QK) { QK_A(N0, kf.k00, q0); SBAR(); } \
    EXPS(C0, 0, 7); SBAR(); \
    if (DO_QK) { QK_B(N1, kf.k10, q0); SBAR(); } \
    EXPS(C0, 7, 14); SBAR(); \
    if (DO_QK) { QK_C(N0, kf.k01, q1); SBAR(); } \
    EXPS(C0, 14, 16); CVT4(C0, 0, pb[0]); CVT4(C0, 1, pb[1]); CVT4(C0, 2, pb[2]); EXPS(C1, 0, 2); SBAR(); \
    if (DO_QK) { QK_C(N1, kf.k11, q1); SBAR(); } \
    { const LAS char* vp = VS(j) + r32 * 80 + hi * 32; va = ld32(vp); vb = ld32(vp + 32 * 80); } \
    EXPS(C1, 2, 9); SBAR(); \
    EXPS(C1, 9, 16); CVT4(C0, 3, pb[3]); CVT4(C1, 0, pb[4]); CVT4(C1, 1, pb[5]); CVT4(C1, 2, pb[6]); CVT4(C1, 3, pb[7]); SBAR(); \
    PV_A(o[0], va); SBAR(); \
    float pm_ = 0.f; if (DO_QK) { pm_ = max16(N0); SBAR(); } \
    PV_B(o[1], vb); SBAR(); \
    if (DO_KR) { qkt_load(kf, KS((j) + 2), r32, hi); SBAR(); } \
    if (DO_QK) { pm_ = mx3(pm_, max16(N1), pm_); SBAR(); } \
    PV_B(o[2], ones); SBAR(); \
    if (DO_QK) PSM_TAIL(N0, N1, pm_); \
  } while (0)
  i32x8 ones = {0x38383838, 0x38383838, 0x38383838, 0x38383838, 0x38383838, 0x38383838, 0x38383838, 0x38383838};
  asm volatile("" : "+v"(ones));
  f32x16 pA0, pA1, pB0, pB1; i32x8 pb, va, vb; KFrag kf; const int NT = seq / KVBLK;
  SLOAD(0); SWRITE(0); SLOAD(1); SWRITE(1); SLOAD(2); SWRITE(2); SLOAD(3); SWRITE(3); if (NT > 4) SLOAD(4);
  __syncthreads();
  { float al0; qkt(pA0, pA1, KS(0), q0, q1, negm, r32, hi); QK_DRAIN(pA0, pA1); (void)partialSM<true>(pA0, pA1, negm, al0); }
  qkt_load(kf, KS(1), r32, hi);
  int j = 0;
  for (; j + 6 < NT; j += 2) {
    HI(j, pA0, pA1, pB0, pB1, true, true, true, true, true);
    HI(j + 1, pB0, pB1, pA0, pA1, false, true, true, true, true);
  }
  for (; j < NT; j += 2) {
    HI(j, pA0, pA1, pB0, pB1, true, true, (j + 2 < NT), (j + 4 < NT), (j + 5 < NT));
    HI(j + 1, pB0, pB1, pA0, pA1, false, (j + 2 < NT), (j + 3 < NT), (j + 5 < NT), (j + 6 < NT));
  }
#undef KS
#undef VS
  PV_DRAIN();
  const float rl = __builtin_amdgcn_rcpf(o[2][0]);
  GAS unsigned short* Ow = Ob + (long)(wid * QBLK + r32) * ldo + 4 * hi;
#pragma unroll
  for (int d0 = 0; d0 < 2; ++d0)
#pragma unroll
    for (int g = 0; g < 4; ++g) { unsigned long long w = (unsigned long long)cvtpk(o[d0][4 * g] * rl, o[d0][4 * g + 1] * rl) | ((unsigned long long)cvtpk(o[d0][4 * g + 2] * rl, o[d0][4 * g + 3] * rl) << 32);
      *(GAS unsigned long long*)(Ow + d0 * 32 + g * 8) = w; }
  __syncthreads();
#undef SLOAD
#undef SWRITE
#undef RESC
#undef HI
#undef PSM_TAIL
}
#undef KSWZ
}

constexpr size_t WS_ROPE = WS_SMALL;
constexpr size_t WS_RSQ = WS_SMALL + 704 * 1024, WS_RSKV = WS_RSQ + (size_t)MR * 4;
static_assert(WS_RSKV + (size_t)MR * 4 <= WS_WIN, "small map");
constexpr size_t WS_QC = WS_Q + (size_t)NBATCH * 8 * SEQ * 128;
constexpr float MLA_QS = 4.f, MLA_KS = 0.25f;
static_assert(WS_QC + (size_t)NBATCH * 8 * CTXL * 128 <= WS_K && WS_K + (size_t)NBATCH * 8 * 16640 * 128 <= WS_V, "q8/k8 map");
constexpr float MLA_C2 = 0.10206207261596575f * 1.4426950408889634f;

__device__ __forceinline__ void p0_rope_table(const Frame& F0) { const Frame F = launder(F0);
    GAS float* T = (GAS float*)(F.ws + WS_ROPE);
    for (int i = blockIdx.x * NTHR + F.tid; i < 256 * 8; i += F.G * NTHR) {
        const int pos = i >> 3, e = i & 7;
        double inv = 1.0; for (int k = 0; k < (e >> 1); ++k) inv *= 0.1; if (e & 1) inv *= 0.31622776601683794;
        double rev = (double)pos * inv * 0.15915494309189535; rev -= (double)(long long)rev;
        T[2 * i] = __builtin_amdgcn_cosf((float)rev); T[2 * i + 1] = __builtin_amdgcn_sinf((float)rev);
    }
}
__device__ __forceinline__ void p_prep_mla_rows(const Frame& F0) { const Frame F = launder(F0);
    const GAS bf16* PH = (const GAS bf16*)(F.ws + WS_PH);
    GAS float* RSQ = (GAS float*)(F.ws + WS_RSQ); GAS float* RSKV = (GAS float*)(F.ws + WS_RSKV); const GAS float* T = (const GAS float*)(F.ws + WS_ROPE);
    for (int m = F.gw; m < MR; m += F.ngw) {
        const GAS bf16* row = PH + (size_t)m * NPH;
        const unsigned long long q4 = *((const GAS unsigned long long*)(row + PH_CQ) + F.lane);
        float a0 = bf2f((unsigned short)q4), a1 = bf2f((unsigned short)(q4 >> 16)), a2 = bf2f((unsigned short)(q4 >> 32)), a3 = bf2f((unsigned short)(q4 >> 48));
        const float sq = wave_sum(a0 * a0 + a1 * a1 + a2 * a2 + a3 * a3);
        float skv = 0.f, x = 0.f;
        if (F.lane < 32) { const unsigned long long k4 = *((const GAS unsigned long long*)(row + PH_CKV) + F.lane);
            a0 = bf2f((unsigned short)k4); a1 = bf2f((unsigned short)(k4 >> 16)); a2 = bf2f((unsigned short)(k4 >> 32)); a3 = bf2f((unsigned short)(k4 >> 48));
            skv = a0 * a0 + a1 * a1 + a2 * a2 + a3 * a3; x = bf2f(row[PH_KR + F.lane]); }
        skv = wave_sum(skv);
        if (F.lane == 0) { RSQ[m] = 1.f / sqrtf(sq * (1.f / 256.f) + RMS_EPS); RSKV[m] = 1.f / sqrtf(skv * (1.f / 128.f) + RMS_EPS); }
        const float xp = __shfl_xor(x, 8);
        int b, pos; float y = x;
        if (m < TL) { b = m >> 14; const int t = m & (SEQ - 1); pos = CTXL + t;
            const int i = F.lane & 31, half = i >> 4, w = i & 15, p = half ? (t & 63) : (t >> 6); const float c = T[(p * 8 + (w & 7)) * 2], s = T[(p * 8 + (w & 7)) * 2 + 1];
            y = (w < 8) ? (x * c - xp * s) : (xp * s + x * c); }
        else { b = (m - TL) >> 8; pos = (m - TL) & 255; }
        { const unsigned char yb = (unsigned char)(pk4_fp8(F.lane < 32 ? y * MLA_KS : 0.f, 0.f, 0.f, 0.f) & 0xffu);
          GAS unsigned char* K8 = F.ws + WS_K; GAS unsigned char* Q8 = m < TL ? F.ws + WS_Q : F.ws + WS_QC; const int qrows = m < TL ? SEQ : CTXL, qt = m < TL ? (m & (SEQ - 1)) : pos;
#pragma unroll
          for (int h = 0; h < 8; ++h) { K8[((size_t)(b * 8 + h) * att::NKEY + pos) * 128 + 64 + F.lane] = yb;
              if (F.lane >= 32) Q8[((size_t)(b * 8 + h) * qrows + qt) * 128 + 64 + F.lane] = 0; } }
    }
}
struct EpiMlaQ {
    static constexpr bool PERM = true, AFTER_DRAIN = false;
    GAS unsigned char* Q; GAS unsigned char* QC; const GAS float* rsq; const GAS float* rope;
    __device__ __forceinline__ void operator()(const pg8::f32x4 (&acc)[2][2][4][2], const Unit& u, int wr, int wc, int fr, int fq) const {
        const bool lat = u.pm < TL / 256;
        const int b = lat ? (u.pm >> 6) : (u.pm - TL / 256), t0 = lat ? (u.pm & 63) * 256 : 0, rows = lat ? SEQ : CTXL;
        GAS unsigned char* base = lat ? Q : QC;
        const unsigned lane_off = (unsigned)((wr * 64 + fr) * 128 + 8 * fq);
        const GAS float* rsp = rsq + u.pm * 256 + wr * 64 + fr;
#pragma unroll
        for (int ai = 0; ai < 2; ++ai)
#pragma unroll
            for (int m = 0; m < 4; ++m) { const float rs = rsp[ai * 128 + m * 16] * (MLA_C2 * MLA_QS);
                const int trow = t0 + ai * 128 + m * 16;
#pragma unroll
                for (int bj = 0; bj < 2; ++bj) { const int g32 = 8 * u.pn + 4 * bj + wc, head = g32 / 3, part = g32 - 3 * head;
                    float x[8];
#pragma unroll
                    for (int i = 0; i < 4; ++i) { x[i] = acc[ai][bj][m][0][i] * rs; x[4 + i] = acc[ai][bj][m][1][i] * rs; }
                    if (part == 2 && lat) {
                        const int p = (fq < 2) ? ((trow >> 6) + wr) : (m * 16 + fr); const GAS f32x4* cs = (const GAS f32x4*)(rope + p * 16);
#pragma unroll
                        for (int i2 = 0; i2 < 4; ++i2) { const f32x4 c4 = cs[i2];
                            const float xa = __shfl_xor(x[2 * i2], 16), xb = __shfl_xor(x[2 * i2 + 1], 16);
                            x[2 * i2] = (fq & 1) ? (xa * c4.y + x[2 * i2] * c4.x) : (x[2 * i2] * c4.x - xa * c4.y);
                            x[2 * i2 + 1] = (fq & 1) ? (xb * c4.w + x[2 * i2 + 1] * c4.z) : (x[2 * i2 + 1] * c4.z - xb * c4.w); }
                    }
                    v2u w; w.x = pk4_fp8(x[0], x[1], x[2], x[3]); w.y = pk4_fp8(x[4], x[5], x[6], x[7]);
                    const size_t soff = (((size_t)(b * 8 + head) * rows + trow) * 128 + part * 32);
                    *(GAS v2u*)(base + soff + lane_off) = w; }
                asm volatile("" ::: "memory"); }
    }
};
struct EpiMlaKV {
    static constexpr bool PERM = true, AFTER_DRAIN = false;
    GAS unsigned char* K; GAS bf16* V; const GAS float* rskv;
    __device__ __forceinline__ void operator()(const pg8::f32x4 (&acc)[2][2][4][2], const Unit& u, int wr, int wc, int fr, int fq) const {
        const bool lat = u.pm < TL / 256;
        const int b = lat ? (u.pm >> 6) : (u.pm - TL / 256), pos0 = lat ? CTXL + (u.pm & 63) * 256 : 0;
        const bool isk = wc < 2;
        const unsigned lane_off = isk ? (unsigned)((wr * 64 + fr) * 128 + 32 * (wc & 1) + 8 * fq) : (unsigned)(((wr * 64 + fr) * 64 + 32 * (wc & 1) + 8 * fq) * 2);
        const GAS float* rsp = rskv + u.pm * 256 + wr * 64 + fr;
#pragma unroll
        for (int ai = 0; ai < 2; ++ai)
#pragma unroll
            for (int m = 0; m < 4; ++m) { const float rs = rsp[ai * 128 + m * 16];
#pragma unroll
                for (int bj = 0; bj < 2; ++bj) { const int head = 2 * u.pn + bj;
                    const size_t rk = (size_t)(b * 8 + head) * att::NKEY + pos0 + ai * 128 + m * 16;
                    if (isk) { const pg8::f32x4 v0 = acc[ai][bj][m][0] * (rs * MLA_KS), v1 = acc[ai][bj][m][1] * (rs * MLA_KS);
                        v2u w; w.x = pk4_fp8(v0[0], v0[1], v0[2], v0[3]); w.y = pk4_fp8(v1[0], v1[1], v1[2], v1[3]);
                        *(GAS v2u*)(K + rk * 128 + lane_off) = w; }
                    else { const pg8::f32x4 v0 = acc[ai][bj][m][0] * rs, v1 = acc[ai][bj][m][1] * rs;
                        v4u w; w.x = pk2(v0[0], v0[1]); w.y = pk2(v0[2], v0[3]); w.z = pk2(v1[0], v1[1]); w.w = pk2(v1[2], v1[3]);
                        *(GAS v4u*)((GAS char*)V + rk * 128 + lane_off) = w; } }
                asm volatile("" ::: "memory"); }
    }
};
constexpr size_t WS_V8T = WS_QC + (size_t)NBATCH * 8 * CTXL * 128;
static_assert(WS_V8T + (size_t)NBATCH * 8 * (att::NKEY / 64) * 4096 <= WS_K, "v8t map");
__device__ __forceinline__ void p_attn_vt_pack(const Frame& F0) { const Frame F = launder(F0);
    LAS unsigned short* VL = (LAS unsigned short*)F.lds; const int tid = F.tid;
    const GAS bf16* V = (const GAS bf16*)(F.ws + WS_V); GAS unsigned char* V8T = F.ws + WS_V8T;
    const int ntile = att::NKEY / 64;
    for (int u = blockIdx.x; u < NBATCH * 8 * ntile; u += F.G) {
        const int bh = u / ntile, t = u % ntile;
        { const int key = tid >> 3, c8 = (tid & 7) * 8; const v4u w = *(const GAS v4u*)(V + ((size_t)bh * att::NKEY + t * 64 + key) * 64 + c8);
          LAS unsigned short* d = VL + key * 66 + c8; d[0] = (unsigned short)w.x; d[1] = (unsigned short)(w.x >> 16); d[2] = (unsigned short)w.y; d[3] = (unsigned short)(w.y >> 16);
          d[4] = (unsigned short)w.z; d[5] = (unsigned short)(w.z >> 16); d[6] = (unsigned short)w.w; d[7] = (unsigned short)(w.w >> 16); }
        __syncthreads();
        { const int v = tid >> 3, s8 = (tid & 7) * 8; float x[8];
#pragma unroll
          for (int e = 0; e < 8; ++e) { const int slot = s8 + e, hi = slot >> 5, j = slot & 31, jj = j & 15, key = (j >> 4) * 32 + (jj & 3) + 8 * (jj >> 2) + 4 * hi; x[e] = bf2f(VL[key * 66 + v]); }
          v2u o; o.x = pk4_fp8(x[0], x[1], x[2], x[3]); o.y = pk4_fp8(x[4], x[5], x[6], x[7]);
          *(GAS v2u*)(V8T + (size_t)u * 4096 + v * 64 + s8) = o; }
        __syncthreads();
    }
}
__device__ __forceinline__ void p_attention(const Frame& F0, bool with_ctx) { const Frame F = launder(F0);
    const GAS unsigned char* Q = F.ws + WS_Q; const GAS unsigned char* QC = F.ws + WS_QC; const GAS unsigned char* K = F.ws + WS_K; const GAS unsigned char* V8T = F.ws + WS_V8T;
    GAS bf16* Y = (GAS bf16*)(F.ws + WS_Y);
    LAS char* lds = (LAS char*)F.lds;
    const int nlat = NBATCH * 8 * (SEQ / 256);
    for (int i = 0;; ++i) {
        const int L = i * F.G + (int)blockIdx.x; if (L >= nlat) break;
        int bh, qb;
        if (F.G == 256) { const int xcd = blockIdx.x & 7, slot = blockIdx.x >> 3; bh = xcd + 8 * (i >> 1); qb = (i & 1) * 32 + slot; }
        else { bh = L / (SEQ / 256); qb = L % (SEQ / 256); }
        const int b = bh >> 3, h = bh & 7;
        att::attn_unit(Q + ((size_t)bh * SEQ + qb * 256) * 128, K + (size_t)bh * att::NKEY * 128, V8T + (size_t)bh * (att::NKEY / 64) * 4096,
                       Y + ((size_t)b * SEQ + qb * 256) * D + 512 + h * 64, D, att::NKEY, lds, F.tid);
    }
    if (with_ctx && (int)blockIdx.x < NBATCH * 8) { const int bh = blockIdx.x, b = bh >> 3, h = bh & 7;
        att::attn_unit(QC + (size_t)bh * CTXL * 128, K + (size_t)bh * att::NKEY * 128, V8T + (size_t)bh * (att::NKEY / 64) * 4096,
                       Y + ((size_t)TL + b * CTXL) * D + 512 + h * 64, D, CTXL, lds, F.tid);
    }
}
__device__ __forceinline__ void p_ynorm_c(const Frame& F0, int nrows, const GAS float* mg) { const Frame F = launder(F0);
    GAS bf16* Y = (GAS bf16*)(F.ws + WS_Y);
    for (int m = F.gw; m < nrows; m += F.ngw) {
        GAS v4u* p = (GAS v4u*)(Y + (size_t)m * D + 512) + F.lane; const v4u w = *p;
        float x[8]; x[0] = bf2f((unsigned short)w.x); x[1] = bf2f((unsigned short)(w.x >> 16)); x[2] = bf2f((unsigned short)w.y); x[3] = bf2f((unsigned short)(w.y >> 16));
        x[4] = bf2f((unsigned short)w.z); x[5] = bf2f((unsigned short)(w.z >> 16)); x[6] = bf2f((unsigned short)w.w); x[7] = bf2f((unsigned short)(w.w >> 16));
        float s = 0.f;
#pragma unroll
        for (int i = 0; i < 8; ++i) s += x[i] * x[i];
        const float rs = 1.f / sqrtf(wave_sum(s) * (1.f / 512.f) + RMS_EPS);
        const f32x4 g0 = ((const GAS f32x4*)mg)[2 * F.lane], g1 = ((const GAS f32x4*)mg)[2 * F.lane + 1];
        v4u o; o.x = pk2(x[0] * rs * g0.x, x[1] * rs * g0.y); o.y = pk2(x[2] * rs * g0.z, x[3] * rs * g0.w); o.z = pk2(x[4] * rs * g1.x, x[5] * rs * g1.y); o.w = pk2(x[6] * rs * g1.z, x[7] * rs * g1.w);
        *p = o;
    }
}

constexpr int GLA_NCH = 4 + SEQ / 64;
constexpr size_t WS_SLOC = WS_XN, WS_GDEC = AB + 521 * MiB;
static_assert(WS_SLOC + (size_t)NBATCH * 4 * 2 * GLA_NCH * 2048 * 4 <= WS_XN + 33 * MiB && (size_t)NBATCH * 4 * 2 * GLA_NCH * 32 * 4 <= 5 * MiB && GLA_NCH % 20 == 0, "gla map");
constexpr int GB_LA = 0, GB_K = GB_LA + 16384, GB_Q = GB_K + 8192, GB_ALR = GB_Q + 8192, GB_WG = GB_ALR + 8192, GB_BG = GB_WG + 4096, GB_O = GB_BG + 256,
              GB_QF = GB_O + 64 * 65 * 4, GB_QB = GB_QF + 5120, GB_KF = GB_QB + 5120, GB_KB = GB_KF + 5120, GB_KTF = GB_KB + 5120, GB_KTB = GB_KTF + 4608, GB_VT = GB_KTB + 4608,
              GB_ATT = GB_VT + 9216, GB_STF = GB_ATT + 9216, GB_STB = GB_STF + 5120, GB_END = GB_STB + 5120;
static_assert(GB_END <= 131072 && GB_QF % 16 == 0, "gla lds");
typedef short gbf16x8 __attribute__((ext_vector_type(8)));
typedef float gf32x16 __attribute__((ext_vector_type(16)));
__device__ __forceinline__ float logsigmoidf(float z) { return fminf(z, 0.f) - __logf(1.f + __expf(-fabsf(z))); }
__device__ __forceinline__ unsigned short bf1(float x) { return (unsigned short)(pk2(x, x) & 0xffffu); }
__device__ __forceinline__ void ld8bf(const GAS bf16* p, LAS float* d) { const v4u w = *(const GAS v4u*)p;
    d[0] = bf2f((unsigned short)w.x); d[1] = bf2f((unsigned short)(w.x >> 16)); d[2] = bf2f((unsigned short)w.y); d[3] = bf2f((unsigned short)(w.y >> 16));
    d[4] = bf2f((unsigned short)w.z); d[5] = bf2f((unsigned short)(w.z >> 16)); d[6] = bf2f((unsigned short)w.w); d[7] = bf2f((unsigned short)(w.w >> 16)); }
__device__ __forceinline__ int gcrow(int r, int hi) { return (r & 3) + 8 * (r >> 2) + 4 * hi; }
template <int KD>
__device__ __forceinline__ void gmm(gf32x16& acc, const LAS unsigned char* A, int sa, int m0, const LAS unsigned char* BT, int sb, int n0, int r32, int hi) {
#pragma unroll
    for (int kt = 0; kt < KD / 16; ++kt) { const gbf16x8 a = *(const LAS gbf16x8*)(A + (m0 + r32) * sa + (kt * 16 + hi * 8) * 2), b = *(const LAS gbf16x8*)(BT + (n0 + r32) * sb + (kt * 16 + hi * 8) * 2);
        acc = __builtin_amdgcn_mfma_f32_32x32x16_bf16(a, b, acc, 0, 0, 0); }
}
__device__ __forceinline__ void gla_head(const Frame& F, int l, int b, int h, int jj, bool want_q) {
    LAS unsigned char* LB = F.lds; LAS float* LA = (LAS float*)(LB + GB_LA); LAS float* KK = (LAS float*)(LB + GB_K); LAS float* QQ = (LAS float*)(LB + GB_Q); LAS float* ALR = (LAS float*)(LB + GB_ALR);
    LAS float* WG = (LAS float*)(LB + GB_WG); LAS float* BG = (LAS float*)(LB + GB_BG); LAS unsigned short* VT = (LAS unsigned short*)(LB + GB_VT);
    const int tid = F.tid;
    const int row0 = jj < 4 ? TL + b * CTXL + jj * 64 : b * SEQ + (jj - 4) * 64;
    const GAS bf16* PH = (const GAS bf16*)(F.ws + WS_PH) + (size_t)row0 * NPH;
    { const int t = (tid & 255) >> 2, c = (tid & 3) * 8;
      if (tid < 256) { ld8bf(PH + (size_t)t * NPH + PH_KA + h * 32 + c, KK + t * 32 + c); ld8bf(PH + (size_t)t * NPH + PH_ALR + c, ALR + t * 32 + c); }
      else if (want_q) ld8bf(PH + (size_t)t * NPH + PH_QA + h * 32 + c, QQ + t * 32 + c); }
    { const int t = tid >> 3, c = (tid & 7) * 8; const v4u w = *(const GAS v4u*)(PH + (size_t)t * NPH + PH_VA + h * 64 + c);
      VT[(c + 0) * 72 + t] = (unsigned short)w.x; VT[(c + 1) * 72 + t] = (unsigned short)(w.x >> 16); VT[(c + 2) * 72 + t] = (unsigned short)w.y; VT[(c + 3) * 72 + t] = (unsigned short)(w.y >> 16);
      VT[(c + 4) * 72 + t] = (unsigned short)w.z; VT[(c + 5) * 72 + t] = (unsigned short)(w.z >> 16); VT[(c + 6) * 72 + t] = (unsigned short)w.w; VT[(c + 7) * 72 + t] = (unsigned short)(w.w >> 16); }
    { const GAS float* wg = F.in[I_GWG] + (size_t)l * 2 * 16 * 128;
      for (int i = tid; i < 1024; i += NTHR) { const int d = i >> 9, r = (i >> 5) & 15, k = i & 31; WG[i] = wg[(d * 16 + r) * 128 + h * 32 + k]; }
      if (tid < 64) BG[tid] = F.in[I_GBG][l * 256 + (tid >> 5) * 128 + h * 32 + (tid & 31)]; }
    __syncthreads();
    { const int k = tid & 31, t0 = tid >> 5;
#pragma unroll
      for (int d = 0; d < 2; ++d)
#pragma unroll
        for (int tt = 0; tt < 4; ++tt) { const int t = t0 + 16 * tt; float z = BG[d * 32 + k];
#pragma unroll
            for (int r = 0; r < 16; ++r) z += ALR[t * 32 + d * 16 + r] * WG[(d * 16 + r) * 32 + k];
            LA[(d * 64 + t) * 32 + k] = logsigmoidf(z) * (1.f / 16.f); } }
    __syncthreads();
    { const int w = tid >> 6, lane = tid & 63;
#pragma unroll
      for (int c = 0; c < 8; ++c) { const int col = w * 8 + c, d = col >> 5, k = col & 31; float v = LA[(d * 64 + lane) * 32 + k];
#pragma unroll
          for (int o = 1; o < 64; o <<= 1) { const float u = d == 0 ? __shfl_up(v, o) : __shfl_down(v, o); if (d == 0 ? lane >= o : lane + o < 64) v += u; }
          LA[(d * 64 + lane) * 32 + k] = v; } }
    __syncthreads();
}
__device__ __forceinline__ void p_gla_local(const Frame& F0, int l) { const Frame F = launder(F0);
    LAS unsigned char* LB = F.lds; LAS float* LA = (LAS float*)(LB + GB_LA); LAS float* KK = (LAS float*)(LB + GB_K); const int tid = F.tid;
    LAS unsigned short* KTF = (LAS unsigned short*)(LB + GB_KTF); LAS unsigned short* KTB = (LAS unsigned short*)(LB + GB_KTB);
    GAS float* SLOC = (GAS float*)(F.ws + WS_SLOC); GAS float* GDEC = (GAS float*)(F.ws + WS_GDEC);
    const int wv = tid >> 6, lane = tid & 63, r32 = lane & 31, hi = lane >> 5;
    for (int u = blockIdx.x; u < NBATCH * 4 * GLA_NCH; u += F.G) {
        const int b = u / (4 * GLA_NCH), h = (u / GLA_NCH) & 3, jj = u % GLA_NCH;
        gla_head(F, l, b, h, jj, false);
        for (int i = tid; i < 2048; i += NTHR) { const int t = i >> 5, k = i & 31; const float kv = KK[i];
            KTF[k * 72 + t] = bf1(kv * __expf(LA[63 * 32 + k] - LA[t * 32 + k]));
            KTB[k * 72 + t] = bf1(kv * __expf(LA[64 * 32 + k] - LA[(64 + t) * 32 + k])); }
        __syncthreads();
        if (wv < 4) { const int dir = wv >> 1, nt = wv & 1; gf32x16 acc = {};
            gmm<64>(acc, LB + (dir ? GB_KTB : GB_KTF), 144, 0, LB + GB_VT, 144, nt * 32, r32, hi);
            GAS float* dst = SLOC + ((size_t)((b * 4 + h) * 2 + dir) * GLA_NCH + jj) * 2048 + nt * 32 + r32;
#pragma unroll
            for (int r = 0; r < 16; ++r) dst[gcrow(r, hi) * 64] = acc[r]; }
        if (tid < 64) { const int d = tid >> 5, kk = tid & 31; GDEC[((size_t)((b * 4 + h) * 2 + d) * GLA_NCH + jj) * 32 + kk] = __expf(d ? LA[64 * 32 + kk] : LA[63 * 32 + kk]); }
        __syncthreads();
    }
}
__device__ __forceinline__ void p_gla_scan(const Frame& F0) { const Frame F = launder(F0);
    GAS float* SLOC = (GAS float*)(F.ws + WS_SLOC); const GAS float* GDEC = (const GAS float*)(F.ws + WS_GDEC);
    if (F.tid < 128) for (int it = blockIdx.x; it < 256; it += F.G) {
        const int chain = it >> 4, e = (it & 15) * 128 + F.tid, k = e >> 6, dir = chain & 1;
        GAS float* sl = SLOC + (size_t)chain * GLA_NCH * 2048 + e; const GAS float* dc = GDEC + (size_t)chain * GLA_NCH * 32 + k;
        float S = 0.f;
        for (int j0 = 0; j0 < GLA_NCH; j0 += 20) { float lv[20], dv[20];
#pragma unroll
            for (int q = 0; q < 20; ++q) { const int j = j0 + q, jx = dir == 0 ? j : (j < 4 ? 3 - j : GLA_NCH + 3 - j); lv[q] = sl[(size_t)jx * 2048]; dv[q] = dc[jx * 32]; }
#pragma unroll
            for (int q = 0; q < 20; ++q) { const int j = j0 + q, jx = dir == 0 ? j : (j < 4 ? 3 - j : GLA_NCH + 3 - j); sl[(size_t)jx * 2048] = S; S = dv[q] * S + lv[q]; } }
    }
}
__device__ __forceinline__ void p_gla_out(const Frame& F0, int l, bool with_ctx) { const Frame F = launder(F0);
    LAS unsigned char* LB = F.lds; LAS float* LA = (LAS float*)(LB + GB_LA); LAS float* KK = (LAS float*)(LB + GB_K); LAS float* QQ = (LAS float*)(LB + GB_Q); LAS float* OO = (LAS float*)(LB + GB_O);
    LAS unsigned short* QF = (LAS unsigned short*)(LB + GB_QF); LAS unsigned short* QB = (LAS unsigned short*)(LB + GB_QB); LAS unsigned short* KF = (LAS unsigned short*)(LB + GB_KF); LAS unsigned short* KB = (LAS unsigned short*)(LB + GB_KB);
    LAS unsigned short* ATT = (LAS unsigned short*)(LB + GB_ATT); LAS unsigned short* STF = (LAS unsigned short*)(LB + GB_STF); LAS unsigned short* STB = (LAS unsigned short*)(LB + GB_STB);
    const int tid = F.tid, wv = tid >> 6, lane = tid & 63, r32 = lane & 31, hi = lane >> 5;
    const GAS float* SLOC = (const GAS float*)(F.ws + WS_SLOC); GAS bf16* Y = (GAS bf16*)(F.ws + WS_Y); const GAS bf16* PHB = (const GAS bf16*)(F.ws + WS_PH);
    const GAS float* gng = F.in[I_GNG] + l * 64;
    for (int u = blockIdx.x; u < NBATCH * 4 * GLA_NCH; u += F.G) {
        const int b = u / (4 * GLA_NCH), h = (u / GLA_NCH) & 3, jj = u % GLA_NCH;
        if (jj < 4 && !with_ctx) continue;
        gla_head(F, l, b, h, jj, true);
        for (int i = tid; i < 2048; i += NTHR) { const int t = i >> 5, k = i & 31; const float qv = QQ[i] * 0.17677669529663687f, kv = KK[i];
            const float bf_ = LA[t * 32 + k], bb_ = LA[(64 + t) * 32 + k];
            QF[t * 40 + k] = bf1(qv * __expf(bf_)); KF[t * 40 + k] = bf1(kv * __expf(-bf_)); QB[t * 40 + k] = bf1(qv * __expf(bb_)); KB[t * 40 + k] = bf1(kv * __expf(-bb_)); }
        { const GAS float* s0 = SLOC + ((size_t)((b * 4 + h) * 2 + 0) * GLA_NCH + jj) * 2048; const GAS float* s1 = SLOC + ((size_t)((b * 4 + h) * 2 + 1) * GLA_NCH + jj) * 2048;
          const int k = tid >> 4, v4 = (tid & 15) * 4; const f32x4 a = *(const GAS f32x4*)(s0 + k * 64 + v4), c = *(const GAS f32x4*)(s1 + k * 64 + v4);
          STF[(v4 + 0) * 40 + k] = bf1(a.x); STF[(v4 + 1) * 40 + k] = bf1(a.y); STF[(v4 + 2) * 40 + k] = bf1(a.z); STF[(v4 + 3) * 40 + k] = bf1(a.w);
          STB[(v4 + 0) * 40 + k] = bf1(c.x); STB[(v4 + 1) * 40 + k] = bf1(c.y); STB[(v4 + 2) * 40 + k] = bf1(c.z); STB[(v4 + 3) * 40 + k] = bf1(c.w); }
        __syncthreads();
        gf32x16 acc = {};
        const int mt = wv & 1, nt = (wv >> 1) & 1;
        if (wv < 4) {
            gf32x16 af = {}, ab = {};
            gmm<32>(af, LB + GB_QF, 80, mt * 32, LB + GB_KF, 80, nt * 32, r32, hi); gmm<32>(ab, LB + GB_QB, 80, mt * 32, LB + GB_KB, 80, nt * 32, r32, hi);
            const int s = nt * 32 + r32;
#pragma unroll
            for (int r = 0; r < 16; ++r) { const int t = mt * 32 + gcrow(r, hi); const float a = (s <= t ? af[r] : 0.f) + (s >= t ? ab[r] : 0.f); ATT[t * 72 + s] = bf1(a); }
        } else {
            gmm<32>(acc, LB + GB_QF, 80, mt * 32, LB + GB_STF, 80, nt * 32, r32, hi); gmm<32>(acc, LB + GB_QB, 80, mt * 32, LB + GB_STB, 80, nt * 32, r32, hi);
        }
        __syncthreads();
        if (wv >= 4) { gmm<64>(acc, LB + GB_ATT, 144, mt * 32, LB + GB_VT, 144, nt * 32, r32, hi);
#pragma unroll
            for (int r = 0; r < 16; ++r) OO[(mt * 32 + gcrow(r, hi)) * 65 + nt * 32 + r32] = acc[r]; }
        __syncthreads();
        { const int t = tid >> 3, vg = tid & 7; float o8[8], ss = 0.f;
#pragma unroll
          for (int i = 0; i < 8; ++i) { o8[i] = OO[t * 65 + vg * 8 + i]; ss += o8[i] * o8[i]; }
          ss += __shfl_xor(ss, 1); ss += __shfl_xor(ss, 2); ss += __shfl_xor(ss, 4);
          const float rs = 1.f / sqrtf(ss * (1.f / 64.f) + RMS_EPS);
          const int row = (jj < 4 ? TL + b * CTXL + jj * 64 : b * SEQ + (jj - 4) * 64) + t;
          const v4u gw = *(const GAS v4u*)(PHB + (size_t)row * NPH + PH_GA + h * 64 + vg * 8);
          float ga[8]; ga[0] = bf2f((unsigned short)gw.x); ga[1] = bf2f((unsigned short)(gw.x >> 16)); ga[2] = bf2f((unsigned short)gw.y); ga[3] = bf2f((unsigned short)(gw.y >> 16));
          ga[4] = bf2f((unsigned short)gw.z); ga[5] = bf2f((unsigned short)(gw.z >> 16)); ga[6] = bf2f((unsigned short)gw.w); ga[7] = bf2f((unsigned short)(gw.w >> 16));
          float y[8];
#pragma unroll
          for (int i = 0; i < 8; ++i) y[i] = o8[i] * rs * gng[vg * 8 + i] * siluf(ga[i]);
          v4u o; o.x = pk2(y[0], y[1]); o.y = pk2(y[2], y[3]); o.z = pk2(y[4], y[5]); o.w = pk2(y[6], y[7]);
          *(GAS v4u*)(Y + (size_t)row * D + h * 64 + vg * 8) = o; }
        __syncthreads();
    }
}

constexpr int FN = 32768, FN1 = 128, FN2 = 256;
constexpr size_t WS_FA = WS_XN + 33 * MiB;
constexpr size_t WS_HT = WS_PH;
constexpr size_t WS_FA0 = WS_K, WS_FA1 = WS_VT;
constexpr size_t WS_HID = AB + 521 * MiB, WS_HTC = AB + 526 * MiB, WS_CU = AB + 527 * MiB, WS_OTC = AB + 529 * MiB, WS_NPART = AB + 530 * MiB, WS_END2 = AB + 532 * MiB;
static_assert(WS_FA0 + 64 * MiB <= WS_VT && WS_FA1 + 64 * MiB <= WS_HF && WS_END2 <= 573 * MiB, "hyena map");
constexpr size_t CTL_NRM = 256 * 1024;
constexpr int FFT_TW_OFF = 40960;
typedef float f32x2 __attribute__((ext_vector_type(2)));
__device__ __forceinline__ f32x2 cmul(f32x2 a, f32x2 b) { return (f32x2){a.x * b.x - a.y * b.y, a.x * b.y + a.y * b.x}; }
__device__ __forceinline__ unsigned pkc(f32x2 v) { return pk2(v.x, v.y); }
__device__ __forceinline__ f32x2 upc(unsigned w) { return (f32x2){__uint_as_float(w << 16), __uint_as_float(w & 0xffff0000u)}; }
__device__ __forceinline__ f32x2 twid(float rev) { return (f32x2){__builtin_amdgcn_cosf(rev), __builtin_amdgcn_sinf(rev)}; }
__device__ __forceinline__ float nrm_lat(const Frame& F, int order, int c) {
    LAS float* red = (LAS float*)(F.lds + FFT_TW_OFF + 1024); const GAS float* NP = (const GAS float*)(F.ws + WS_NPART);
    const float v = wave_sum(NP[(size_t)(F.tid & 255) * 1024 + order * 512 + (F.tid >> 8) * 256 + c]);
    __syncthreads(); if (F.lane == 0) red[F.wave] = v; __syncthreads();
    float s = 0.f;
#pragma unroll
    for (int w = 0; w < 8; ++w) s += red[w];
    return 1.f / sqrtf(s + 1e-6f);
}
__device__ __forceinline__ float nrm_ctx(const Frame& F, int order, int c) { const GAS float* NP = (const GAS float*)(F.ws + WS_NPART); float s = 0.f;
#pragma unroll
    for (int pb = 256; pb < 260; ++pb) s += NP[(size_t)pb * 1024 + order * 512 + c] + NP[(size_t)pb * 1024 + order * 512 + 256 + c];
    return 1.f / sqrtf(s + 1e-6f); }

__device__ __forceinline__ void p_filt_hidden(const Frame& F0, int l) { const Frame F = launder(F0);
    LAS float* L = (LAS float*)F.lds; LAS float* W1 = L, * W2 = L + 33 * 64, * H1 = W2 + 64 * 64, * PB = H1 + 128 * 65;
    GAS float* HID = (GAS float*)(F.ws + WS_HID); const int tid = F.tid;
    for (int i = tid; i < 33 * 64; i += NTHR) W1[i] = F.in[I_HW1][l * 33 * 64 + i];
    for (int i = tid; i < 64 * 64; i += NTHR) W2[i] = F.in[I_HW2][l * 64 * 64 + i];
    if (tid < 64) { PB[tid] = F.in[I_HB1][l * 64 + tid]; PB[64 + tid] = F.in[I_HF1][l * 64 + tid]; PB[128 + tid] = F.in[I_HB2][l * 64 + tid]; PB[192 + tid] = F.in[I_HF2][l * 64 + tid]; }
    __syncthreads();
    const int p = tid & 127, jq = tid >> 7;
    for (int blk = blockIdx.x; blk < (SEQ + CTXL) / 128; blk += F.G) {
        const int prow = blk * 128 + p; const bool lat = prow < SEQ; const int pos = lat ? prow : prow - SEQ; const float Lf = lat ? (float)SEQ : (float)CTXL;
        float z[33]; z[0] = (float)pos / (Lf - 1.f);
#pragma unroll
        for (int i = 0; i < 16; ++i) { const float fr = 1e-4f + (float)i * ((15.f - 1e-4f) / 15.f); float rev = (float)pos * fr / Lf; rev -= floorf(rev);
            z[1 + i] = __builtin_amdgcn_cosf(rev); z[17 + i] = -__builtin_amdgcn_sinf(rev); }
        for (int j = jq * 16; j < jq * 16 + 16; ++j) { float a = PB[j];
#pragma unroll
            for (int i = 0; i < 33; ++i) a += z[i] * W1[i * 64 + j];
            H1[p * 65 + j] = __sinf(PB[64 + j] * a); }
        __syncthreads();
        for (int j = jq * 16; j < jq * 16 + 16; ++j) { float a = PB[128 + j];
            for (int i = 0; i < 64; ++i) a += H1[p * 65 + i] * W2[i * 64 + j];
            HID[(size_t)prow * 64 + j] = __sinf(PB[192 + j] * a); }
        __syncthreads();
    }
}
__device__ __forceinline__ void p_filt_raw(const Frame& F0, int l) { const Frame F = launder(F0);
    LAS float* L = (LAS float*)F.lds; LAS float* HS = L, * W3 = L + 64 * 65; const int tid = F.tid;
    const GAS float* HID = (const GAS float*)(F.ws + WS_HID); GAS float* HT = (GAS float*)(F.ws + WS_HT); GAS float* HTC = (GAS float*)(F.ws + WS_HTC);
    const GAS float* w3 = F.in[I_HW3] + (size_t)l * 64 * 1024; const GAS float* b3 = F.in[I_HB3] + l * 1024;
    const int pg = tid & 15, cg = tid >> 4;
    for (int u = blockIdx.x; u < ((SEQ + CTXL) / 64) * 4; u += F.G) {
        const int pb = u >> 2, cb = u & 3, prow0 = pb * 64; const bool lat = prow0 < SEQ; const int pos0 = lat ? prow0 : prow0 - SEQ; const float Lf = lat ? (float)SEQ : (float)CTXL;
        for (int i = tid; i < 64 * 64; i += NTHR) HS[(i >> 6) * 65 + (i & 63)] = HID[(size_t)prow0 * 64 + i];
        for (int i = tid; i < 64 * 256; i += NTHR) W3[i] = w3[(size_t)(i >> 8) * 1024 + cb * 256 + (i & 255)];
        __syncthreads();
        float acc[4][8];
#pragma unroll
        for (int a = 0; a < 4; ++a)
#pragma unroll
            for (int c = 0; c < 8; ++c) acc[a][c] = 0.f;
        for (int i = 0; i < 64; ++i) { const f32x4 w0 = *(const LAS f32x4*)(W3 + i * 256 + cg * 8), w1 = *(const LAS f32x4*)(W3 + i * 256 + cg * 8 + 4);
#pragma unroll
            for (int a = 0; a < 4; ++a) { const float hv = HS[(pg * 4 + a) * 65 + i];
                acc[a][0] += hv * w0.x; acc[a][1] += hv * w0.y; acc[a][2] += hv * w0.z; acc[a][3] += hv * w0.w; acc[a][4] += hv * w1.x; acc[a][5] += hv * w1.y; acc[a][6] += hv * w1.z; acc[a][7] += hv * w1.w; } }
        float ss[8];
#pragma unroll
        for (int c = 0; c < 8; ++c) { const int col = cb * 256 + cg * 8 + c, ch = col & 255; const float delta = 3.0701134573253944f + (float)ch * (12.280453829301578f / 255.f), bias = b3[col];
            float o[4]; ss[c] = 0.f;
#pragma unroll
            for (int a = 0; a < 4; ++a) { const float t = (float)(pos0 + pg * 4 + a) / (Lf - 1.f); o[a] = (acc[a][c] + bias) * __expf(-t * delta); ss[c] += o[a] * o[a]; }
            GAS float* dst = lat ? HT + (size_t)col * SEQ + pos0 + pg * 4 : HTC + (size_t)col * CTXL + pos0 + pg * 4;
            *(GAS f32x4*)dst = (f32x4){o[0], o[1], o[2], o[3]}; }
#pragma unroll
        for (int c = 0; c < 8; ++c) { float s = ss[c]; s += __shfl_xor(s, 1); s += __shfl_xor(s, 2); s += __shfl_xor(s, 4); s += __shfl_xor(s, 8); ss[c] = s; }
        if (pg == 0) { GAS float* np = (GAS float*)(F.ws + WS_NPART) + (size_t)pb * 1024 + cb * 256 + cg * 8;
            *(GAS f32x4*)np = (f32x4){ss[0], ss[1], ss[2], ss[3]}; *(GAS f32x4*)(np + 4) = (f32x4){ss[4], ss[5], ss[6], ss[7]}; }
        __syncthreads();
    }
}
__device__ __forceinline__ void fft_tw_init(LAS unsigned char* lds, int tid) { if (tid < 128) ((LAS f32x2*)(lds + FFT_TW_OFF))[tid] = twid(-(float)tid * (1.f / 256.f)); __syncthreads(); }
__device__ __forceinline__ f32x2 cconj(f32x2 a) { return (f32x2){a.x, -a.y}; }
__device__ __forceinline__ f32x2 mul_mi(f32x2 a) { return (f32x2){a.y, -a.x}; }
__device__ __forceinline__ f32x2 mul_pi(f32x2 a) { return (f32x2){-a.y, a.x}; }
template <int ST>
__device__ __forceinline__ void dif4(LAS f32x2* X, const LAS f32x2* TW, int base, int g, int s) {
    const int h = 1 << s, p = g & ((h >> 1) - 1), i = (((g >> (s - 1)) << (s + 1)) | p);
    LAS f32x2* P0 = X + base + i * ST; LAS f32x2* P1 = P0 + (h >> 1) * ST; LAS f32x2* P2 = P0 + h * ST; LAS f32x2* P3 = P1 + h * ST;
    const f32x2 x0 = *P0, x1 = *P1, x2 = *P2, x3 = *P3, wa = TW[p << (7 - s)], wc = TW[p << (8 - s)];
    const f32x2 y0 = x0 + x2, y2 = cmul(x0 - x2, wa), y1 = x1 + x3, y3 = mul_mi(cmul(x1 - x3, wa));
    *P0 = y0 + y1; *P1 = cmul(y0 - y1, wc); *P2 = y2 + y3; *P3 = cmul(y2 - y3, wc);
}
template <int ST>
__device__ __forceinline__ void dit4(LAS f32x2* X, const LAS f32x2* TW, int base, int g, int s) {
    const int h = 1 << s, p = g & (h - 1), i = (((g >> s) << (s + 2)) | p);
    LAS f32x2* P0 = X + base + i * ST; LAS f32x2* P1 = P0 + h * ST; LAS f32x2* P2 = P1 + h * ST; LAS f32x2* P3 = P2 + h * ST;
    const f32x2 w1 = cconj(TW[p << (7 - s)]), w2 = cconj(TW[p << (6 - s)]);
    const f32x2 x0 = *P0, x1 = cmul(*P1, w1), x2 = *P2, x3 = cmul(*P3, w1);
    const f32x2 y0 = x0 + x1, y1 = x0 - x1, y2 = cmul(x2 + x3, w2), y3 = mul_pi(cmul(x2 - x3, w2));
    *P0 = y0 + y2; *P2 = y0 - y2; *P1 = y1 + y3; *P3 = y1 - y3;
}
__device__ __forceinline__ void fft128_cols_fwd(LAS f32x2* X, int tid) {
    const int j = tid & 31, q0 = tid >> 5; const LAS f32x2* TW = (const LAS f32x2*)((const LAS unsigned char*)X + FFT_TW_OFF);
#pragma unroll 1
    for (int s = 6; s >= 2; s -= 2) { dif4<32>(X, TW, j, q0, s); dif4<32>(X, TW, j, q0 + 16, s); __syncthreads(); }
#pragma unroll
    for (int i = 0; i < 4; ++i) { const int q = q0 + 16 * i; const f32x2 a = X[(2 * q) * 32 + j], b = X[(2 * q + 1) * 32 + j]; X[(2 * q) * 32 + j] = a + b; X[(2 * q + 1) * 32 + j] = a - b; }
    __syncthreads();
}
__device__ __forceinline__ void fft128_cols_inv(LAS f32x2* X, int tid) {
    const int j = tid & 31, q0 = tid >> 5; const LAS f32x2* TW = (const LAS f32x2*)((const LAS unsigned char*)X + FFT_TW_OFF);
#pragma unroll
    for (int i = 0; i < 4; ++i) { const int q = q0 + 16 * i; const f32x2 a = X[(2 * q) * 32 + j], b = X[(2 * q + 1) * 32 + j]; X[(2 * q) * 32 + j] = a + b; X[(2 * q + 1) * 32 + j] = a - b; }
    __syncthreads();
#pragma unroll 1
    for (int s = 1; s <= 5; s += 2) { dit4<32>(X, TW, j, q0, s); dit4<32>(X, TW, j, q0 + 16, s); __syncthreads(); }
}
__device__ __forceinline__ void fft256_rows_fwd(LAS f32x2* X, int tid) {
    const int g = tid & 63, r0 = tid >> 6; const LAS f32x2* TW = (const LAS f32x2*)((const LAS unsigned char*)X + FFT_TW_OFF);
#pragma unroll 1
    for (int s = 7; s >= 1; s -= 2) { dif4<1>(X, TW, r0 * 256, g, s); dif4<1>(X, TW, (r0 + 8) * 256, g, s); __syncthreads(); }
}
__device__ __forceinline__ void fft256_rows_inv(LAS f32x2* X, int tid) {
    const int g = tid & 63, r0 = tid >> 6; const LAS f32x2* TW = (const LAS f32x2*)((const LAS unsigned char*)X + FFT_TW_OFF);
#pragma unroll 1
    for (int s = 0; s <= 6; s += 2) { dit4<1>(X, TW, r0 * 256, g, s); dit4<1>(X, TW, (r0 + 8) * 256, g, s); __syncthreads(); }
}
__device__ __forceinline__ int bitrev7(int r) { return (int)(__brev((unsigned)r) >> 25); }
template <int KIND>
__device__ __forceinline__ void p_fft_pass1(const Frame& F0, int order, size_t ws_a) { const Frame F = launder(F0);
    fft_tw_init(F.lds, F.tid);
    LAS f32x2* X = (LAS f32x2*)F.lds; const int tid = F.tid, j = tid & 31, q0 = tid >> 5;
    const GAS float* VT = (const GAS float*)(F.ws + WS_VT); const GAS float* HT = (const GAS float*)(F.ws + WS_HT); GAS unsigned* A = (GAS unsigned*)(F.ws + ws_a);
    f32x2 pre[8];
#define P1_LOAD(uu) do { const int sg_ = (uu) >> 3, nb_ = (uu) & 7; _Pragma("unroll") for (int i = 0; i < 8; ++i) { const int n1 = q0 + 16 * i, n = 256 * n1 + 32 * nb_ + j; f32x2 v = {0.f, 0.f}; \
        if (KIND == 0) { if (n1 < 64) { v.x = VT[(size_t)(sg_ * 2 + 0) * SEQ + n]; v.y = VT[(size_t)(sg_ * 2 + 1) * SEQ + n]; } } \
        else { const GAS float* hf = HT + (size_t)(order * 512 + sg_) * SEQ; const GAS float* hb = HT + (size_t)(order * 512 + 256 + sg_) * SEQ; \
               if (n < SEQ) v.x = hf[n]; else if (n > SEQ) v.x = hb[2 * SEQ - n]; } \
        pre[i] = v; } } while (0)
    int u = blockIdx.x; if (u < 256 * 8) P1_LOAD(u);
    for (; u < 256 * 8; u += F.G) {
        const int sg = u >> 3, nb = u & 7;
#pragma unroll
        for (int i = 0; i < 8; ++i) X[(q0 + 16 * i) * 32 + j] = pre[i];
        __syncthreads();
        if (u + F.G < 256 * 8) P1_LOAD(u + F.G);
        fft128_cols_fwd(X, tid);
#pragma unroll
        for (int i = 0; i < 8; ++i) { const int r = q0 + 16 * i, k1 = bitrev7(r), n2 = 32 * nb + j;
            A[((size_t)sg * FN1 + r) * FN2 + n2] = pkc(cmul(X[r * 32 + j], twid(-(float)(n2 * k1) * (1.f / (float)FN)))); }
        __syncthreads();
    }
#undef P1_LOAD
}
template <int KIND>
__device__ __forceinline__ void p_fft_pass2(const Frame& F0, int l, int order, size_t ws_a) { const Frame F = launder(F0);
    fft_tw_init(F.lds, F.tid);
    LAS f32x2* X = (LAS f32x2*)F.lds; const int tid = F.tid;
    GAS unsigned* A = (GAS unsigned*)(F.ws + ws_a); GAS unsigned* HF = (GAS unsigned*)(F.ws + WS_HF);
    unsigned pa[8], ph[8];
#define P2_LOAD(uu) do { const int sg_ = (uu) >> 3, g_ = (uu) & 7; const GAS unsigned* Ab_ = A + ((size_t)sg_ * FN1 + g_ * 16) * FN2; const GAS unsigned* Hb_ = HF + ((size_t)(order * 256 + sg_) * FN1 + g_ * 16) * FN2; \
        _Pragma("unroll") for (int i = 0; i < 8; ++i) { pa[i] = Ab_[tid + NTHR * i]; if (KIND == 0) ph[i] = Hb_[tid + NTHR * i]; } } while (0)
    int u = blockIdx.x; if (u < 256 * 8) P2_LOAD(u);
    for (; u < 256 * 8; u += F.G) {
        const int sg = u >> 3, g = u & 7;
        GAS unsigned* Ab = A + ((size_t)sg * FN1 + g * 16) * FN2; GAS unsigned* Hb = HF + ((size_t)(order * 256 + sg) * FN1 + g * 16) * FN2;
        unsigned hcur[8];
#pragma unroll
        for (int i = 0; i < 8; ++i) { X[tid + NTHR * i] = upc(pa[i]); if (KIND == 0) hcur[i] = ph[i]; }
        __syncthreads();
        if (u + F.G < 256 * 8) P2_LOAD(u + F.G);
        fft256_rows_fwd(X, tid);
        if (KIND == 1) { const float nr = nrm_lat(F, order, sg);
#pragma unroll
            for (int i = 0; i < 8; ++i) { const int e = tid + NTHR * i; const f32x2 v = X[e] * nr; const _Float16 hr = (_Float16)v.x, hi = (_Float16)v.y;
                Hb[e] = (unsigned)__builtin_bit_cast(unsigned short, hr) | ((unsigned)__builtin_bit_cast(unsigned short, hi) << 16); }
            __syncthreads();
        } else {
#pragma unroll
            for (int i = 0; i < 8; ++i) { const int e = tid + NTHR * i; const unsigned hw = hcur[i];
                const f32x2 h = {(float)__builtin_bit_cast(_Float16, (unsigned short)(hw & 0xffffu)), (float)__builtin_bit_cast(_Float16, (unsigned short)(hw >> 16))};
                X[e] = cmul(X[e], h); }
            __syncthreads();
            fft256_rows_inv(X, tid);
#pragma unroll
            for (int i = 0; i < 8; ++i) { const int e = tid + NTHR * i, r = g * 16 + (e >> 8), n2 = e & 255, k1 = bitrev7(r);
                Ab[e] = pkc(cmul(X[e], twid((float)(n2 * k1) * (1.f / (float)FN))) * (1.f / (float)FN)); }
            __syncthreads();
        }
    }
#undef P2_LOAD
}
__device__ __forceinline__ void p_fft_pass3(const Frame& F0, int l, int order) { const Frame F = launder(F0);
    fft_tw_init(F.lds, F.tid);
    LAS f32x2* X = (LAS f32x2*)F.lds; const int tid = F.tid, j = tid & 31, q0 = tid >> 5;
    GAS float* VT = (GAS float*)(F.ws + WS_VT); const GAS bf16* GT = (const GAS bf16*)(F.ws + (order == 0 ? WS_X1T : WS_X2T)); const GAS unsigned* A = (const GAS unsigned*)(F.ws + WS_FA);
    const GAS float* skip = F.in[I_HSKIP] + (size_t)(l * 2 + order) * 256;
    unsigned pa[8]; float pv[4][2]; unsigned short pg[4][2];
#define P3_LOAD(uu) do { const int sg_ = (uu) >> 3, nb_ = (uu) & 7; _Pragma("unroll") for (int i = 0; i < 8; ++i) pa[i] = A[((size_t)sg_ * FN1 + q0 + 16 * i) * FN2 + 32 * nb_ + j]; \
        _Pragma("unroll") for (int i = 0; i < 4; ++i) { const int n = 256 * (q0 + 16 * i) + 32 * nb_ + j; const size_t i0 = (size_t)(sg_ * 2 + 0) * SEQ + n, i1 = (size_t)(sg_ * 2 + 1) * SEQ + n; \
            pv[i][0] = VT[i0]; pv[i][1] = VT[i1]; pg[i][0] = GT[i0]; pg[i][1] = GT[i1]; } } while (0)
    int u = blockIdx.x; if (u < 256 * 8) P3_LOAD(u);
    for (; u < 256 * 8; u += F.G) {
        const int sg = u >> 3, nb = u & 7;
        float cv[4][2], cg[4][2];
#pragma unroll
        for (int i = 0; i < 8; ++i) X[(q0 + 16 * i) * 32 + j] = upc(pa[i]);
#pragma unroll
        for (int i = 0; i < 4; ++i) { cv[i][0] = pv[i][0]; cv[i][1] = pv[i][1]; cg[i][0] = bf2f(pg[i][0]); cg[i][1] = bf2f(pg[i][1]); }
        __syncthreads();
        if (u + F.G < 256 * 8) P3_LOAD(u + F.G);
        fft128_cols_inv(X, tid);
        const float sk = skip[sg];
#pragma unroll
        for (int i = 0; i < 4; ++i) { const int n1 = q0 + 16 * i, n = 256 * n1 + 32 * nb + j; const f32x2 y = X[n1 * 32 + j];
            const size_t i0 = (size_t)(sg * 2 + 0) * SEQ + n, i1 = (size_t)(sg * 2 + 1) * SEQ + n;
            VT[i0] = cg[i][0] * (y.x + sk * cv[i][0]); VT[i1] = cg[i][1] * (y.y + sk * cv[i][1]); }
        __syncthreads();
    }
#undef P3_LOAD
}
__device__ __forceinline__ void p_fft_pass31(const Frame& F0, int l) { const Frame F = launder(F0);
    fft_tw_init(F.lds, F.tid);
    LAS f32x2* X = (LAS f32x2*)F.lds; const int tid = F.tid, j = tid & 31, q0 = tid >> 5;
    GAS float* VT = (GAS float*)(F.ws + WS_VT); const GAS bf16* GT = (const GAS bf16*)(F.ws + WS_X1T); GAS unsigned* A = (GAS unsigned*)(F.ws + WS_FA);
    const GAS float* skip = F.in[I_HSKIP] + (size_t)(l * 2 + 0) * 256;
    unsigned pa[8]; float pv[4][2]; unsigned short pg[4][2];
#define P3_LOAD(uu) do { const int sg_ = (uu) >> 3, nb_ = (uu) & 7; _Pragma("unroll") for (int i = 0; i < 8; ++i) pa[i] = A[((size_t)sg_ * FN1 + q0 + 16 * i) * FN2 + 32 * nb_ + j]; \
        _Pragma("unroll") for (int i = 0; i < 4; ++i) { const int n = 256 * (q0 + 16 * i) + 32 * nb_ + j; const size_t i0 = (size_t)(sg_ * 2 + 0) * SEQ + n, i1 = (size_t)(sg_ * 2 + 1) * SEQ + n; \
            pv[i][0] = VT[i0]; pv[i][1] = VT[i1]; pg[i][0] = GT[i0]; pg[i][1] = GT[i1]; } } while (0)
    int u = blockIdx.x; if (u < 256 * 8) P3_LOAD(u);
    for (; u < 256 * 8; u += F.G) {
        const int sg = u >> 3, nb = u & 7;
        float cv[4][2], cg[4][2];
#pragma unroll
        for (int i = 0; i < 8; ++i) X[(q0 + 16 * i) * 32 + j] = upc(pa[i]);
#pragma unroll
        for (int i = 0; i < 4; ++i) { cv[i][0] = pv[i][0]; cv[i][1] = pv[i][1]; cg[i][0] = bf2f(pg[i][0]); cg[i][1] = bf2f(pg[i][1]); }
        __syncthreads();
        if (u + F.G < 256 * 8) P3_LOAD(u + F.G);
        fft128_cols_inv(X, tid);
        const float sk = skip[sg];
#pragma unroll
        for (int i = 0; i < 4; ++i) { const int n1 = q0 + 16 * i, n = 256 * n1 + 32 * nb + j; const f32x2 y = X[n1 * 32 + j];
            const size_t i0 = (size_t)(sg * 2 + 0) * SEQ + n, i1 = (size_t)(sg * 2 + 1) * SEQ + n;
            const f32x2 z = {cg[i][0] * (y.x + sk * cv[i][0]), cg[i][1] * (y.y + sk * cv[i][1])};
            VT[i0] = z.x; VT[i1] = z.y; X[n1 * 32 + j] = z; X[(n1 + 64) * 32 + j] = (f32x2){0.f, 0.f}; }
        __syncthreads();
        fft128_cols_fwd(X, tid);
#pragma unroll
        for (int i = 0; i < 8; ++i) { const int r = q0 + 16 * i, k1 = bitrev7(r), n2 = 32 * nb + j;
            A[((size_t)sg * FN1 + r) * FN2 + n2] = pkc(cmul(X[r * 32 + j], twid(-(float)(n2 * k1) * (1.f / (float)FN)))); }
        __syncthreads();
    }
#undef P3_LOAD
}
__device__ __forceinline__ void p_hy_shortconv(const Frame& F0, int l) { const Frame F = launder(F0);
    LAS bf16* IN = (LAS bf16*)F.lds; LAS float* OT = (LAS float*)(F.lds + 66 * 256 * 2 + 64); const int tid = F.tid;
    const GAS bf16* PH = (const GAS bf16*)(F.ws + WS_PH); GAS float* VT = (GAS float*)(F.ws + WS_VT); GAS bf16* X1T = (GAS bf16*)(F.ws + WS_X1T); GAS bf16* X2T = (GAS bf16*)(F.ws + WS_X2T); GAS float* CU = (GAS float*)(F.ws + WS_CU);
    const GAS float* cw = F.in[I_HCW] + (size_t)l * 3 * 768; const GAS float* cb = F.in[I_HCB] + (size_t)l * 768;
    const int nlat = NBATCH * (SEQ / 64) * 3, nctx = NBATCH * (CTXL / 64) * 3;
    for (int u = blockIdx.x; u < nlat + nctx; u += F.G) {
        const bool lat = u < nlat; const int uu = lat ? u : u - nlat; const int grp = uu % 3, tile = (uu / 3) % (lat ? SEQ / 64 : CTXL / 64), b = (uu / 3) / (lat ? SEQ / 64 : CTXL / 64);
        const int Ls = lat ? SEQ : CTXL, t0 = tile * 64; const size_t rowb = lat ? (size_t)b * SEQ : (size_t)TL + b * CTXL;
        for (int i = tid; i < 66 * 32; i += NTHR) { const int rr = i >> 5, c8 = (i & 31) * 8, t = t0 + rr - 1; v4u w = {0u, 0u, 0u, 0u};
            if (t >= 0 && t < Ls) w = *(const GAS v4u*)(PH + (rowb + t) * NPH + PH_HY + grp * 256 + c8);
            *(LAS v4u*)(IN + rr * 256 + c8) = w; }
        __syncthreads();
        { const int c = tid & 255, th = tid >> 8, ch = grp * 256 + c; const float w0 = cw[ch], w1 = cw[768 + ch], w2 = cw[1536 + ch], bb = cb[ch];
          float a = bf2f(IN[(th * 32) * 256 + c]), m = bf2f(IN[(th * 32 + 1) * 256 + c]);
          for (int i = 0; i < 32; ++i) { const float n = bf2f(IN[(th * 32 + i + 2) * 256 + c]); const float y = bb + a * w0 + m * w1 + n * w2; a = m; m = n;
              if (lat) OT[c * 65 + th * 32 + i] = y; else CU[((size_t)b * CTXL + t0 + th * 32 + i) * 768 + ch] = y; } }
        __syncthreads();
        if (lat) { const int t4 = (tid & 15) * 4;
#pragma unroll
            for (int i = 0; i < 8; ++i) { const int c = (tid >> 4) + 32 * i; const LAS float* s = OT + c * 65 + t4; const size_t o = (size_t)(c * 2 + b) * SEQ + t0 + t4;
                if (grp == 0) *(GAS f32x4*)(VT + o) = (f32x4){s[0], s[1], s[2], s[3]};
                else { v2u w; w.x = pk2(s[0], s[1]); w.y = pk2(s[2], s[3]); *(GAS v2u*)((grp == 1 ? X1T : X2T) + o) = w; } } }
        __syncthreads();
    }
}
__device__ __forceinline__ void p_hy_ctx(const Frame& F0, int l) { const Frame F = launder(F0);
    LAS float* L = (LAS float*)F.lds; const int tid = F.tid, t = tid & 255, cs = tid >> 8;
    LAS float* SV = L + cs * 1280, * HFW = SV + 256, * HBW = SV + 512, * HF2 = SV + 768, * HB2 = SV + 1024;
    const GAS float* CU = (const GAS float*)(F.ws + WS_CU); const GAS float* HTC = (const GAS float*)(F.ws + WS_HTC); GAS float* OTC = (GAS float*)(F.ws + WS_OTC);
    for (int u = blockIdx.x; u < NBATCH * 128; u += F.G) {
        const int b = u >> 7, c = (u & 127) * 2 + cs;
        const float n0 = nrm_ctx(F, 0, c), n1 = nrm_ctx(F, 1, c);
        const GAS float* cu = CU + ((size_t)b * CTXL + t) * 768;
        const float v = cu[c], x1 = cu[256 + c], x2 = cu[512 + c];
        SV[t] = v; HFW[t] = HTC[(size_t)(0 + c) * CTXL + t] * n0; HBW[t] = HTC[(size_t)(256 + c) * CTXL + t] * n0; HF2[t] = HTC[(size_t)(512 + c) * CTXL + t] * n1; HB2[t] = HTC[(size_t)(768 + c) * CTXL + t] * n1;
        __syncthreads();
        float y = F.in[I_HSKIP][(l * 2 + 0) * 256 + c] * v;
        for (int s = 0; s <= t; ++s) y += HFW[t - s] * SV[s];
        for (int s = t + 1; s < CTXL; ++s) y += HBW[s - t] * SV[s];
        const float z = x1 * y;
        __syncthreads();
        SV[t] = z;
        __syncthreads();
        float y2 = F.in[I_HSKIP][(l * 2 + 1) * 256 + c] * z;
        for (int s = 0; s <= t; ++s) y2 += HF2[t - s] * SV[s];
        for (int s = t + 1; s < CTXL; ++s) y2 += HB2[s - t] * SV[s];
        OTC[((size_t)b * CTXL + t) * 256 + c] = x2 * y2;
        __syncthreads();
    }
}
__device__ __forceinline__ void p_ynorm_b(const Frame& F0, int l, bool with_ctx) { const Frame F = launder(F0);
    LAS float* T = (LAS float*)F.lds; LAS float* RS = T + 256 * 65; LAS float* PS = RS + 64; const int tid = F.tid;
    const GAS float* VT = (const GAS float*)(F.ws + WS_VT); const GAS float* OTC = (const GAS float*)(F.ws + WS_OTC); GAS bf16* Y = (GAS bf16*)(F.ws + WS_Y); const GAS float* hg = F.in[I_HNG] + l * 256;
    const int nlat = NBATCH * (SEQ / 64), nctx = with_ctx ? NBATCH * (CTXL / 64) : 0;
    for (int u = blockIdx.x; u < nlat + nctx; u += F.G) {
        const bool lat = u < nlat; const int uu = lat ? u : u - nlat, b = lat ? uu / (SEQ / 64) : uu / (CTXL / 64), t0 = (lat ? uu % (SEQ / 64) : uu % (CTXL / 64)) * 64;
        const size_t rowb = lat ? (size_t)b * SEQ + t0 : (size_t)TL + b * CTXL + t0;
        if (lat) { const int t4 = (tid & 15) * 4;
#pragma unroll
            for (int i = 0; i < 8; ++i) { const int c = (tid >> 4) + 32 * i; const f32x4 v = *(const GAS f32x4*)(VT + (size_t)(c * 2 + b) * SEQ + t0 + t4); LAS float* d = T + c * 65 + t4; d[0] = v.x; d[1] = v.y; d[2] = v.z; d[3] = v.w; } }
        else { for (int i = tid; i < 64 * 256; i += NTHR) { const int t = i >> 8, c = i & 255; T[c * 65 + t] = OTC[((size_t)b * CTXL + t0 + t) * 256 + c]; } }
        __syncthreads();
        { const int t = tid & 63, part = tid >> 6; float s = 0.f;
          for (int c = part * 32; c < part * 32 + 32; ++c) { const float v = T[c * 65 + t]; s += v * v; }
          PS[part * 64 + t] = s; }
        __syncthreads();
        if (tid < 64) { float s = 0.f;
#pragma unroll
            for (int p = 0; p < 8; ++p) s += PS[p * 64 + tid];
            RS[tid] = 1.f / sqrtf(s * (1.f / 256.f) + RMS_EPS); }
        __syncthreads();
        { const int t = tid >> 3, c0 = (tid & 7) * 8; const float rs = RS[t];
#pragma unroll
          for (int i = 0; i < 4; ++i) { const int c = c0 + 64 * i; float y[8];
#pragma unroll
              for (int e = 0; e < 8; ++e) y[e] = T[(c + e) * 65 + t] * rs * hg[c + e];
              v4u o; o.x = pk2(y[0], y[1]); o.y = pk2(y[2], y[3]); o.z = pk2(y[4], y[5]); o.w = pk2(y[6], y[7]);
              *(GAS v4u*)(Y + (rowb + t) * D + 256 + c) = o; } }
        __syncthreads();
    }
}

enum LP { LP_IN = 0, LP_PREP, LP_GLA2, LP_GLA3, LP_HY0, LP_HY1, LP_HY2, LP_HY3, LP_HY4, LP_HY5, LP_HY6, LP_HY7, LP_ATT, LP_YN, LP_OUT, LP_LN1, LP_F1, LP_F2, LP_M0  , LP_LN2 = LP_M0 + 9, PPL };
constexpr int NPRO = 4;
constexpr int NPHASE = NPRO + DEPTH * PPL;
template <int l>
__device__ __forceinline__ void layer_phases(const Frame& F, const XcdBarrier& bar, const int lo, const int hi) {
#define IN(k) (lo <= (k) && (k) < hi)
#define SEAM(k) do { if ((k) + 1 < hi) xcd_barrier(bar); } while (0)
    LAS unsigned char* ring = F.lds;
    constexpr int pb = NPRO + l * PPL;
#define lng (F.in[I_LNG] + (size_t)l * 2 * D)
#define lnb (F.in[I_LNB] + (size_t)l * 2 * D)
        if (IN(pb + LP_IN)) { const Frame P = launder(F);
            pg8::Gemm g{(const GAS bf16*)(P.ws + WS_XN), (const GAS bf16*)(P.ws + WS_WIN) + (size_t)l * NPH * D, MR, NPH, D, D, 0};
            pg8::StaticOrder S; S.init(MR, NPH, F.G, (int)blockIdx.x);
            EpiStoreBf16 E{(GAS bf16*)(P.ws + WS_PH), NPH, 1.f};
            pg8::gemm_phase<EpiStoreBf16, pg8::StaticOrder, true, true>(ring, g, S, E);
            SEAM(pb + LP_IN);
        }
        if (IN(pb + LP_PREP)) { const Frame P = launder(F); p_prep_mla_rows(F); p_gla_local(F, l);
            p_hy_shortconv(F, l); SEAM(pb + LP_PREP); }
        if (IN(pb + LP_GLA2)) { const Frame P = launder(F);
            { pg8::Gemm g{(const GAS bf16*)(P.ws + WS_PH) + PH_CQ, (const GAS bf16*)(P.ws + WS_WUQ) + (size_t)l * 768 * 256, MR, 768, 256, NPH, 0};
              pg8::StaticOrder S; S.init(MR, 768, F.G, (int)blockIdx.x);
              EpiMlaQ E{P.ws + WS_Q, P.ws + WS_QC, (const GAS float*)(P.ws + WS_RSQ), (const GAS float*)(P.ws + WS_ROPE)};
              pg8::gemm_phase<EpiMlaQ, pg8::StaticOrder, true, true>(ring, g, S, E); }
            { pg8::Gemm g{(const GAS bf16*)(P.ws + WS_PH) + PH_CKV, (const GAS bf16*)(P.ws + WS_WUKV) + (size_t)l * 1024 * 256, MR, 1024, 256, NPH, 0};
              pg8::StaticOrder S; S.init(MR, 1024, F.G, (int)blockIdx.x);
              EpiMlaKV E{P.ws + WS_K, (GAS bf16*)(P.ws + WS_V), (const GAS float*)(P.ws + WS_RSKV)};
              pg8::gemm_phase<EpiMlaKV, pg8::StaticOrder, true, true>(ring, g, S, E); }
            p_gla_scan(F); p_fft_pass1<0>(F, 0, WS_FA);
            SEAM(pb + LP_GLA2);
        }
        if (IN(pb + LP_GLA3)) { const Frame P = launder(F); p_gla_out(F, l, l == 0); p_attn_vt_pack(F); p_fft_pass2<0>(F, l, 0, WS_FA); if constexpr (l == 0) p_hy_ctx(F, l);
            SEAM(pb + LP_GLA3); }
        if (IN(pb + LP_HY0)) { p_fft_pass31(F, l); SEAM(pb + LP_HY0); }
        if (IN(pb + LP_HY1)) { p_fft_pass2<0>(F, l, 1, WS_FA); SEAM(pb + LP_HY1); }
        if (IN(pb + LP_HY2)) { p_fft_pass3(F, l, 1); SEAM(pb + LP_HY2); }
        if (IN(pb + LP_ATT)) { const Frame P = launder(F); p_attention(F, l == 0);
            SEAM(pb + LP_ATT); }
        if (IN(pb + LP_YN)) { const Frame P = launder(F); p_ynorm_c(F, l == 0 ? MR : TL, F.in[I_MNG] + (size_t)l * 512); p_ynorm_b(F, l, l == 0); if constexpr (l == 0) p_filt_hidden(F, 1); SEAM(pb + LP_YN); }
        if (IN(pb + LP_OUT)) { const Frame P = launder(F);
            const int M = (l == 0) ? MR : TL;
            pg8::Gemm g{(const GAS bf16*)(P.ws + WS_Y), (const GAS bf16*)(P.ws + WS_WOUT) + (size_t)l * D * D, M, D, D, D, 0};
            pg8::StaticOrder S; S.init(M, D, F.G, (int)blockIdx.x);
            EpiRes E{l == 0 ? F.in[I_X] : F.out, l == 0 ? F.in[I_CTX] : (const GAS float*)(P.ws + WS_XC), F.out, (GAS float*)(P.ws + WS_XC), modv(F, l, 0, 2)};
            pg8::gemm_phase<EpiRes, pg8::StaticOrder, true, true>(ring, g, S, E);
            if constexpr (l == 0) p_filt_raw(F, 1);
            SEAM(pb + LP_OUT);
        }
        if (IN(pb + LP_LN1)) { const Frame P = launder(F);
            if constexpr (l == 0) { p_ln(F, MR, lng, lnb, true, l, 3); p_fft_pass1<1>(F, 0, WS_FA0); p_fft_pass1<1>(F, 1, WS_FA1); }
            else { p_ln_route(F, lng, lnb, l); p_moe_weights(F); }
            SEAM(pb + LP_LN1);
        }
        if constexpr (l == 0) {
            if (IN(pb + LP_F1)) { const Frame P = launder(F);
                pg8::Gemm g{(const GAS bf16*)(P.ws + WS_XN), (const GAS bf16*)(P.ws + WS_W13), MR, 2 * DFF, D, D, 0};
                pg8::StaticOrder S; S.init(MR, 2 * DFF, F.G, (int)blockIdx.x);
                EpiSwiglu E{(GAS bf16*)(P.ws + WS_G), DFF, 1.f};
                pg8::gemm_phase<EpiSwiglu, pg8::StaticOrder, true, true>(ring, g, S, E);
                p_fft_pass2<1>(F, 1, 0, WS_FA0); p_fft_pass2<1>(F, 1, 1, WS_FA1);
                SEAM(pb + LP_F1);
            }
            if (IN(pb + LP_F2)) { const Frame P = launder(F);
                pg8::Gemm g{(const GAS bf16*)(P.ws + WS_G), (const GAS bf16*)(P.ws + WS_W2), MR, D, DFF, DFF, 0};
                pg8::StaticOrder S; S.init(MR, D, F.G, (int)blockIdx.x);
                EpiRes E{F.out, (const GAS float*)(P.ws + WS_XC), F.out, (GAS float*)(P.ws + WS_XC), modv(F, l, 0, 5)};
                pg8::gemm_phase<EpiRes, pg8::StaticOrder, true, true>(ring, g, S, E);
                SEAM(pb + LP_F2);
            }
            if (IN(pb + LP_LN2)) { const Frame P = launder(F); p_ln(F, MR, lng + D, lnb + D, true, l + 1, 0); SEAM(pb + LP_LN2); }
        } else {
            if (IN(pb + LP_F1)) { const Frame P = launder(F); p_moe_scatter(F); SEAM(pb + LP_F1); }
            for (int ch = 0; ch < MOE_NCHUNK; ++ch) {
                if (IN(pb + LP_F2 + 2 * ch)) { const Frame P = launder(F);
                    moe_base_to_lds(P);
                    pg8::Gemm g{(const GAS bf16*)(P.ws + WS_HS8 + (size_t)ch * MOE_CHUNK_TILES * 256 * D), (const GAS bf16*)(P.ws + WS_WM13), MOE_CHUNK_TILES * 256, 2 * EFF, D / 2, D / 2, (size_t)2 * EFF * D};
                    MoeOrder S; S.init((const LAS int*)(F.lds + LDS_MOEBT), ch, 2 * EFF / 256, F.G, (int)blockIdx.x);
                    EpiSwiglu8 E{P.ws + WS_GC, EFF, 1.f / MOE_WSCALE, MOE_GSCALE};
                    pg8::gemm_phase<EpiSwiglu8, MoeOrder, true, true, true>(ring, g, S, E);
                    SEAM(pb + LP_F2 + 2 * ch);
                }
                if (IN(pb + LP_F2 + 2 * ch + 1)) { const Frame P = launder(F);
                    moe_base_to_lds(P);
                    pg8::Gemm g{(const GAS bf16*)(P.ws + WS_GC), (const GAS bf16*)(P.ws + WS_WM2), MOE_CHUNK_TILES * 256, D, EFF / 2, EFF / 2, (size_t)D * EFF};
                    MoeOrder S; S.init((const LAS int*)(F.lds + LDS_MOEBT), ch, D / 256, F.G, (int)blockIdx.x);
                    EpiStoreBf16 E{(GAS bf16*)(P.ws + WS_HS) + (size_t)ch * MOE_CHUNK_TILES * 256 * D, D, 1.f / (MOE_GSCALE * MOE_W2SCALE)};
                    pg8::gemm_phase<EpiStoreBf16, MoeOrder, true, true, true>(ring, g, S, E);
                    SEAM(pb + LP_F2 + 2 * ch + 1);
                }
            }
            if (IN(pb + LP_LN2)) { const Frame P = launder(F); p_ln_combine(F, lng + D, lnb + D, l); SEAM(pb + LP_LN2); }
        }

#undef lng
#undef lnb
#undef IN
#undef SEAM
}
__global__ void __launch_bounds__(NTHR, 2) mega(Args args) {
    extern __shared__ __attribute__((aligned(16))) unsigned char lds_raw[];
    Frame F;
    F.lds = (LAS unsigned char*)lds_raw; F.ws = args.ws; F.ctl = (gu32*)(args.ws + WS_CTL); F.in = (const GAS float* const GAS*)(args.ws + WS_PTRTAB); F.out = args.out;
    F.tid = threadIdx.x; F.lane = F.tid & 63; F.wave = __builtin_amdgcn_readfirstlane(F.tid >> 6); F.G = gridDim.x;
    F.gw = blockIdx.x * NWAVES + F.wave; F.ngw = F.G * NWAVES;
    volatile LAS unsigned* MISC = (volatile LAS unsigned*)(F.lds + LDS_MISC);
    if (F.tid < 32) MISC[F.tid] = 0u;
    __syncthreads();
    XcdBarrier bar; bar.bar = (unsigned*)(F.ctl + CW_BAR); bar.x = 0; bar.st = nullptr;
#if !MK_PER_PHASE
    bar = xcd_barrier_post((unsigned*)(F.ctl + CW_BAR), MISC + 8);
#endif
    const int lo = args.ph_lo, hi = args.ph_hi;
#define IN(k) (lo <= (k) && (k) < hi)
#define SEAM(k) do { if ((k) + 1 < hi) xcd_barrier(bar); } while (0)
    LAS unsigned char* ring = F.lds;
#define LTID() ({ int t_ = F.tid; asm volatile("" : "+v"(t_)); t_; })

    if (IN(0)) { Frame FK = F; FK.in = (const GAS float* const GAS*)(const GAS void*)args.in;
        if (blockIdx.x == 0 && F.tid < 37) ((const GAS float* GAS*)(args.ws + WS_PTRTAB))[F.tid] = args.in[F.tid];
        p0_modv(FK); p0_weights(FK); p0_rope_table(FK); __syncthreads();     p_filt_hidden(FK, 0);
        SEAM(0); }
    if (IN(1)) { p_xn0(F); p_filt_raw(F, 0);
        SEAM(1); }
    if (IN(2)) { p_fft_pass1<1>(F, 0, WS_FA0); p_fft_pass1<1>(F, 1, WS_FA1); SEAM(2); }
    if (IN(3)) { p_fft_pass2<1>(F, 0, 0, WS_FA0); p_fft_pass2<1>(F, 0, 1, WS_FA1); SEAM(3); }

    layer_phases<0>(F, bar, lo, hi);
    layer_phases<1>(F, bar, lo, hi);
#undef IN
#undef SEAM
}

extern "C" void kernel_launch(void* const* d_in, const int* in_sizes, int n_in, void* d_out, int out_size, void* d_ws, size_t ws_size, hipStream_t stream) {
    static int grid = 0;
    if (grid == 0) {
        if (n_in != 37 || in_sizes[0] != TL * D || out_size != TL * D || ws_size < WS_END2) { fprintf(stderr, "kernel_launch: shape/workspace mismatch (n_in %d in0 %d out %d ws %zu need %zu)\n", n_in, n_in > 0 ? in_sizes[0] : -1, out_size, ws_size, (size_t)WS_END2); grid = -1; return; }
        int dev = 0, cus = 0, per_cu = 0;
        if (hipGetDevice(&dev) != hipSuccess || hipDeviceGetAttribute(&cus, hipDeviceAttributeMultiprocessorCount, dev) != hipSuccess) { grid = -1; return; }
        if (hipFuncSetAttribute((const void*)mega, hipFuncAttributeMaxDynamicSharedMemorySize, LDS_BYTES) != hipSuccess) { fprintf(stderr, "kernel_launch: hipFuncSetAttribute failed\n"); grid = -1; return; }
        if (hipOccupancyMaxActiveBlocksPerMultiprocessor(&per_cu, (const void*)mega, NTHR, LDS_BYTES) != hipSuccess || per_cu < 1) { fprintf(stderr, "kernel_launch: occupancy query says %d\n", per_cu); }
        (void)hipGetLastError();
        grid = cus;
    }
    if (grid < 0) return;
    if (hipMemsetAsync((char*)d_ws + WS_CTL, 0, CTL_ZERO_BYTES, stream) != hipSuccess) return;
    Args a{};
    for (int i = 0; i < 37; ++i) a.in[i] = (const GAS float*)d_in[i];
    a.out = (GAS float*)d_out; a.ws = (GAS unsigned char*)d_ws;
#if MK_PER_PHASE
    for (int p = 0; p < NPHASE; ++p) { a.ph_lo = p; a.ph_hi = p + 1; hipLaunchKernelGGL(mega, dim3(grid), dim3(NTHR), LDS_BYTES, stream, a); }
#else
    a.ph_lo = 0; a.ph_hi = NPHASE;
    hipLaunchKernelGGL(mega, dim3(grid), dim3(NTHR), LDS_BYTES, stream, a);
#endif
    const hipError_t le = hipPeekAtLastError();
    if (le != hipSuccess) fprintf(stderr, "kernel_launch: launch failed: %s\n", hipGetErrorName(le));
}
```

```cpp
#include <hip/hip_runtime.h>
#include <cstdio>
#include <cstdint>
namespace pg8 {
#define PG8_LAS __attribute__((address_space(3)))
#define PG8_GAS __attribute__((address_space(1)))
typedef unsigned short bf16_t;
typedef short bf16x8 __attribute__((ext_vector_type(8)));
typedef float f32x4 __attribute__((ext_vector_type(4)));
typedef unsigned u32x4 __attribute__((ext_vector_type(4)));
typedef int i32x8_t __attribute__((ext_vector_type(8)));
typedef short bf16x16 __attribute__((ext_vector_type(16)));
constexpr int BM = 256, BK = 64, HALF = 128, HTB = HALF * BK * 2  , STAGE_BYTES = 8 * HTB, NXCD = 8, WGM = 8;

__host__ __device__ __forceinline__ int lds_byte(int r, int c) { const int st = (r >> 4) * 2 + (c >> 5), rr = r & 15, cc = c & 31, ob = rr * 64 + cc * 2; return st * 1024 + (ob ^ (((ob >> 9) & 1) << 5)); }
__host__ __device__ __forceinline__ void stage_rc(int b, int& R, int& C) { const int st = b / 1024, sb = b % 1024, swz = sb ^ (((sb >> 9) & 1) << 5); R = (st >> 1) * 16 + swz / 64; C = (st & 1) * 32 + (swz % 64) / 2; }
__host__ __device__ __forceinline__ int perm32(int rho) { const int n = rho >> 4, i = rho & 15; return 8 * (i >> 2) + 4 * n + (i & 3); }

struct Unit { int pm, pn, be; };
struct Gemm { const PG8_GAS bf16_t* A; const PG8_GAS bf16_t* Bt; int M, N, K; int lda; size_t bstride; };

struct StaticOrder {
    int nM, nN, nwg, G, c;
    __host__ __device__ void init(int M, int N, int G_, int c_) { nM = M / BM; nN = N / BM; nwg = nM * nN; G = G_; c = c_; }
    __host__ __device__ bool next(int i, Unit& u) const {
        const long L = (long)i * G + c; if (L >= nwg) return false;
        int wgid = (int)L; { const int q = nwg / NXCD, r = nwg % NXCD, xcd = wgid % NXCD, off = wgid / NXCD; wgid = (xcd < r ? xcd * (q + 1) : r * (q + 1) + (xcd - r) * q) + off; }
        const int nig = WGM * nN, gid = wgid / nig, fm = gid * WGM, gsz = (nM - fm) < WGM ? (nM - fm) : WGM;
        u.pm = fm + ((wgid % nig) % gsz); u.pn = (wgid % nig) / gsz; u.be = 0; return true;
    }
    __device__ __forceinline__ void a_ready(const Unit&) const {}
    __device__ __forceinline__ void done(const Unit&) const {}
};


__device__ __forceinline__ unsigned cvt_pk_bf16(float lo, float hi) { unsigned r; asm volatile("v_cvt_pk_bf16_f32 %0, %1, %2" : "=v"(r) : "v"(lo), "v"(hi)); return r; }
typedef float f32x2 __attribute__((ext_vector_type(2)));
typedef unsigned u32x2 __attribute__((ext_vector_type(2)));

template <class Epi, class Sched, bool ALIGN_EPI = false, bool SP2 = false, bool F8 = false>
__device__ __forceinline__ void gemm_phase(PG8_LAS unsigned char* lds, const Gemm g, const Sched& S, const Epi& E) {
    { unsigned lb_ = (unsigned)(size_t)lds; asm volatile("" : "+s"(lb_)); lds = (PG8_LAS unsigned char*)(size_t)lb_; }
    int tid_ = threadIdx.x; asm volatile("" : "+v"(tid_));
    const int tid = tid_, wid = __builtin_amdgcn_readfirstlane(tid >> 6), lane = tid & 63, wr = wid >> 2, wc = wid & 3, fr = lane & 15, fq = lane >> 4;
    int K_ = g.K; asm volatile("" : "+s"(K_)); const int K = K_, nt = K / BK;
    unsigned voffA[2], voffB[2];
#pragma unroll
    for (int i = 0; i < 2; ++i) { int R, C; stage_rc(tid * 16 + i * 8192, R, C); const int Rb = Epi::PERM ? ((R & ~31) + perm32(R & 31)) : R;
        voffA[i] = (unsigned)(R * g.lda + C) * 2u; voffB[i] = (unsigned)(Rb * K + C) * 2u; }
    const size_t kstep = (size_t)(BK * 2);
    const size_t hstepB = (size_t)HALF * K * 2, hstepA = (size_t)HALF * g.lda * 2;
    const size_t tstepA = 2 * hstepA, tstepB = 2 * hstepB;
    const unsigned ldsw = (unsigned)wid * 1024u;
    const int aoff = lds_byte(wr * 64 + fr, fq * 8), boff = lds_byte(wc * 32 + fr, fq * 8);
#define PG8_SA(b, h) (((b) * 2 + (h)) * HTB)
#define PG8_SB(b, h) ((4 + (b) * 2 + (h)) * HTB)
#define PG8_STAGE(bufoff, gbase, voff) do { _Pragma("unroll") for (int _i = 0; _i < 2; ++_i) \
        __builtin_amdgcn_global_load_lds((const PG8_GAS unsigned*)((const PG8_GAS char*)(gbase) + (voff)[_i]), (PG8_LAS unsigned*)(lds + (bufoff) + ldsw + _i * 8192), 16, 0, 0); } while (0)
#define PG8_LDA(dst, b, h) do { _Pragma("unroll") for (int m = 0; m < 4; ++m) dst[m] = __builtin_shufflevector(*(const PG8_LAS bf16x8*)(lds + PG8_SA(b, h) + aoff + m * 2048), *(const PG8_LAS bf16x8*)(lds + PG8_SA(b, h) + aoff + m * 2048 + 1024), 0, 1, 2, 3, 4, 5, 6, 7, 8, 9, 10, 11, 12, 13, 14, 15); } while (0)
#define PG8_LDB(dst, b, h) do { _Pragma("unroll") for (int n = 0; n < 2; ++n) dst[n] = __builtin_shufflevector(*(const PG8_LAS bf16x8*)(lds + PG8_SB(b, h) + boff + n * 2048), *(const PG8_LAS bf16x8*)(lds + PG8_SB(b, h) + boff + n * 2048 + 1024), 0, 1, 2, 3, 4, 5, 6, 7, 8, 9, 10, 11, 12, 13, 14, 15); } while (0)
#define PG8_HALF(x, k) ((k) == 0 ? __builtin_shufflevector(x, x, 0, 1, 2, 3, 4, 5, 6, 7) : __builtin_shufflevector(x, x, 8, 9, 10, 11, 12, 13, 14, 15))
#define PG8_MMA(ai, bj, At, Bt) do { __builtin_amdgcn_s_setprio(1); if constexpr (F8) { _Pragma("unroll") for (int m = 0; m < 4; ++m) _Pragma("unroll") for (int n = 0; n < 2; ++n) \
        asm volatile("v_mfma_f32_16x16x128_f8f6f4 %0, %1, %2, %0" : "+v"(acc[ai][bj][m][n]) : "v"(__builtin_bit_cast(i32x8_t, Bt[n])), "v"(__builtin_bit_cast(i32x8_t, At[m]))); } \
    else { _Pragma("unroll") for (int m = 0; m < 4; ++m) _Pragma("unroll") for (int n = 0; n < 2; ++n) _Pragma("unroll") for (int k = 0; k < 2; ++k) \
        acc[ai][bj][m][n] = __builtin_amdgcn_mfma_f32_16x16x32_bf16(PG8_HALF(Bt[n], k), PG8_HALF(At[m], k), acc[ai][bj][m][n], 0, 0, 0); } __builtin_amdgcn_s_setprio(0); } while (0)
#define PG8_F8_DRAIN() do { if constexpr (F8) asm volatile("s_nop 15\n\ts_nop 15" ::: "memory"); } while (0)
#define PG8_WAIT_V(n) asm volatile("s_waitcnt vmcnt(" #n ")" ::: "memory")
#define PG8_WAIT_L(n) asm volatile("s_waitcnt lgkmcnt(" #n ")" ::: "memory")
#define PG8_BAR __builtin_amdgcn_s_barrier()
#define PG8_SCHED __builtin_amdgcn_sched_barrier(0)
    Unit cur, nxt; int ui = 0;
    if (!S.next(0, cur)) return;
    f32x4 acc[2][2][4][2];
#pragma unroll
    for (int a = 0; a < 2; ++a)
#pragma unroll
        for (int b = 0; b < 2; ++b)
#pragma unroll
            for (int m = 0; m < 4; ++m)
#pragma unroll
                for (int n = 0; n < 2; ++n) acc[a][b][m][n] = (f32x4){0.f, 0.f, 0.f, 0.f};
    bf16x16 At[4], B0[2], B1[2];
    const PG8_GAS char* cA = (const PG8_GAS char*)g.A + (size_t)cur.pm * tstepA; const PG8_GAS char* cB = (const PG8_GAS char*)g.Bt + (size_t)cur.be * g.bstride + (size_t)cur.pn * tstepB;
    S.a_ready(cur);
    if constexpr (SP2) {
        PG8_STAGE(PG8_SB(0, 0), cB, voffB); PG8_STAGE(PG8_SB(0, 1), cB + hstepB, voffB); PG8_STAGE(PG8_SA(0, 0), cA, voffA); PG8_STAGE(PG8_SA(0, 1), cA + hstepA, voffA);
        if (wr == 1) PG8_BAR;
        PG8_WAIT_V(2); PG8_BAR;
        PG8_STAGE(PG8_SB(1, 0), cB + kstep, voffB); PG8_STAGE(PG8_SA(1, 0), cA + kstep, voffA); PG8_STAGE(PG8_SB(1, 1), cB + hstepB + kstep, voffB);
        PG8_WAIT_V(6); PG8_BAR;
    } else {
        PG8_STAGE(PG8_SB(0, 0), cB, voffB); PG8_STAGE(PG8_SA(0, 0), cA, voffA); PG8_STAGE(PG8_SB(0, 1), cB + hstepB, voffB); PG8_STAGE(PG8_SA(0, 1), cA + hstepA, voffA);
        if (wr == 1) PG8_BAR;
        PG8_WAIT_V(4); PG8_BAR;
        PG8_STAGE(PG8_SB(1, 0), cB + kstep, voffB); PG8_STAGE(PG8_SA(1, 0), cA + kstep, voffA); PG8_STAGE(PG8_SB(1, 1), cB + hstepB + kstep, voffB);
        PG8_WAIT_V(6); PG8_BAR;
    }
    for (;;) {
        const bool has_next = S.next(ui + 1, nxt);
        const PG8_GAS char* nA = has_next ? (const PG8_GAS char*)g.A + (size_t)nxt.pm * tstepA : cA; const PG8_GAS char* nB = has_next ? (const PG8_GAS char*)g.Bt + (size_t)nxt.be * g.bstride + (size_t)nxt.pn * tstepB : cB;
        for (int t = 0; t < nt; t += 2) {
            const bool last = (t == nt - 2);
            const PG8_GAS char* a1 = cA + (size_t)(t + 1) * kstep;
            const PG8_GAS char* a2 = last ? nA : cA + (size_t)(t + 2) * kstep; const PG8_GAS char* b2 = last ? nB : cB + (size_t)(t + 2) * kstep;
            const PG8_GAS char* a3 = a2 + kstep; const PG8_GAS char* b3 = b2 + kstep;
            if (last && has_next) S.a_ready(nxt);
            if constexpr (SP2) {
            PG8_LDB(B0, 0, 0); PG8_LDB(B1, 0, 1); PG8_SCHED; PG8_LDA(At, 0, 0); PG8_STAGE(PG8_SA(1, 1), a1 + hstepA, voffA);
            PG8_WAIT_V(8); PG8_WAIT_L(0); PG8_BAR; PG8_MMA(0, 0, At, B0); PG8_MMA(0, 1, At, B1); PG8_BAR; PG8_SCHED;
            PG8_LDA(At, 0, 1); PG8_STAGE(PG8_SB(0, 0), b2, voffB); PG8_STAGE(PG8_SB(0, 1), b2 + hstepB, voffB); PG8_STAGE(PG8_SA(0, 0), a2, voffA);
            PG8_WAIT_V(8); PG8_WAIT_L(0); PG8_BAR; PG8_MMA(1, 0, At, B0); PG8_MMA(1, 1, At, B1); PG8_BAR; PG8_SCHED;
            PG8_LDB(B0, 1, 0); PG8_LDB(B1, 1, 1); PG8_SCHED; PG8_LDA(At, 1, 0); PG8_STAGE(PG8_SA(0, 1), a2 + hstepA, voffA);
            PG8_WAIT_V(8); PG8_WAIT_L(0); PG8_BAR; PG8_MMA(0, 0, At, B0); PG8_MMA(0, 1, At, B1); PG8_BAR; PG8_SCHED;
            PG8_LDA(At, 1, 1); PG8_STAGE(PG8_SB(1, 0), b3, voffB); PG8_STAGE(PG8_SB(1, 1), b3 + hstepB, voffB); PG8_STAGE(PG8_SA(1, 0), a3, voffA);
            PG8_WAIT_V(8); PG8_WAIT_L(0); PG8_BAR; PG8_MMA(1, 0, At, B0); PG8_MMA(1, 1, At, B1); PG8_BAR; PG8_SCHED;
            } else {
            PG8_LDB(B0, 0, 0); PG8_SCHED; PG8_LDA(At, 0, 0); PG8_STAGE(PG8_SA(1, 1), a1 + hstepA, voffA);
            PG8_WAIT_L(8); PG8_BAR; PG8_WAIT_L(0); PG8_MMA(0, 0, At, B0); PG8_BAR; PG8_SCHED;
            PG8_LDB(B1, 0, 1); PG8_STAGE(PG8_SB(0, 0), b2, voffB);
            PG8_BAR; PG8_WAIT_L(0); PG8_MMA(0, 1, At, B1); PG8_BAR;
            PG8_LDA(At, 0, 1); PG8_STAGE(PG8_SA(0, 0), a2, voffA);
            PG8_BAR; PG8_WAIT_L(0); PG8_MMA(1, 0, At, B0); PG8_BAR; PG8_SCHED;
            PG8_STAGE(PG8_SB(0, 1), b2 + hstepB, voffB);
            PG8_WAIT_V(6); PG8_BAR; PG8_MMA(1, 1, At, B1); PG8_BAR;
            PG8_LDB(B0, 1, 0); PG8_SCHED; PG8_LDA(At, 1, 0); PG8_STAGE(PG8_SA(0, 1), a2 + hstepA, voffA);
            PG8_WAIT_L(8); PG8_BAR; PG8_WAIT_L(0); PG8_MMA(0, 0, At, B0); PG8_BAR; PG8_SCHED;
            PG8_LDB(B1, 1, 1); PG8_STAGE(PG8_SB(1, 0), b3, voffB);
            PG8_BAR; PG8_WAIT_L(0); PG8_MMA(0, 1, At, B1); PG8_BAR;
            PG8_LDA(At, 1, 1); PG8_STAGE(PG8_SA(1, 0), a3, voffA);
            PG8_BAR; PG8_WAIT_L(0); PG8_MMA(1, 0, At, B0); PG8_BAR; PG8_SCHED;
            PG8_STAGE(PG8_SB(1, 1), b3 + hstepB, voffB);
            PG8_WAIT_V(6); PG8_BAR; PG8_MMA(1, 1, At, B1); PG8_BAR;
            }
        }
        if constexpr (ALIGN_EPI) { if (wr == 0) PG8_BAR; }
        PG8_F8_DRAIN();
        if constexpr (!Epi::AFTER_DRAIN) { E(acc, cur, wr, wc, fr, fq); S.done(cur); }
        if (!has_next) break;
#pragma unroll
        for (int a = 0; a < 2; ++a)
#pragma unroll
            for (int b = 0; b < 2; ++b)
#pragma unroll
                for (int m = 0; m < 4; ++m)
#pragma unroll
                    for (int n = 0; n < 2; ++n) acc[a][b][m][n] = (f32x4){0.f, 0.f, 0.f, 0.f};
        cur = nxt; cA = nA; cB = nB; ++ui;
        if constexpr (ALIGN_EPI) { if (wr == 1) PG8_BAR; }
    }
    PG8_WAIT_V(0);
    if constexpr (!ALIGN_EPI) { if (wr == 0) PG8_BAR; }
    PG8_BAR;
    if constexpr (Epi::AFTER_DRAIN) { E.fused(acc, cur, wr, wc, fr, fq, lds, wid, lane); S.done(cur); }
#undef PG8_SA
#undef PG8_SB
#undef PG8_STAGE
#undef PG8_LDA
#undef PG8_LDB
#undef PG8_MMA
#undef PG8_HALF
#undef PG8_F8_DRAIN
#undef PG8_WAIT_V
#undef PG8_WAIT_L
#undef PG8_BAR
#undef PG8_SCHED
}
}


#ifndef MK_PER_PHASE
#define MK_PER_PHASE 0
#endif

constexpr int NWAVES = 8, NTHR = 512;
constexpr int D = 1024, NBATCH = 2, SEQ = 16384, TL = NBATCH * SEQ, CTXL = 256, TC = NBATCH * CTXL, MR = TL + TC;
constexpr int NPH = 2048, DFF = 2816, NEXP = 8, EFF = 3584, DEPTH = 2;
constexpr float ALPHA = 1.41421356237309515f;
constexpr float LN_EPS = 1e-5f, RMS_EPS = 1e-6f;
constexpr int PH_QA = 0, PH_KA = 128, PH_VA = 256, PH_GA = 512, PH_HY = 768, PH_CQ = 1536, PH_CKV = 1792, PH_KR = 1920, PH_ALR = 1952;

constexpr size_t MiB = 1u << 20;
constexpr size_t WS_CTL = 0, CTL_ZERO_BYTES = 1 * MiB;
constexpr int CW_TMO = 0, CW_BAR = 4096;
constexpr size_t CTL_MODV = 64 * 1024;
constexpr size_t WS_SMALL = 1 * MiB;
constexpr size_t WS_PTRTAB = WS_SMALL + 16 * 1024;
constexpr size_t WS_WIN = 2 * MiB, WS_WOUT = 10 * MiB, WS_W13 = 14 * MiB, WS_W2 = 25 * MiB, WS_WUQ = 31 * MiB, WS_WUKV = 32 * MiB;
constexpr size_t AB = 34 * MiB;
constexpr size_t WS_XN = AB, WS_Y = AB + 65 * MiB, WS_PH = AB + 130 * MiB, WS_Q = AB + 260 * MiB, WS_K = AB + 309 * MiB, WS_V = AB + 358 * MiB;
constexpr size_t WS_VT = AB + 391 * MiB, WS_X1T = AB + 423 * MiB, WS_X2T = AB + 439 * MiB, WS_HF = AB + 455 * MiB, WS_XC = AB + 519 * MiB, WS_END = AB + 521 * MiB;
constexpr size_t WS_G = WS_PH;
static_assert(WS_W13 + (size_t)2 * DFF * D * 2 <= WS_W2 && WS_W2 + (size_t)D * DFF * 2 <= WS_WUQ, "weights map");
static_assert(WS_G + (size_t)MR * DFF * 2 <= WS_K, "G overlay");
static_assert(WS_END <= 573 * MiB, "d_ws budget");

constexpr int LDS_BYTES = 147456, LDS_MISC = 131072 + 320;

#define GAS __attribute__((address_space(1)))
#define LAS __attribute__((address_space(3)))
typedef unsigned short bf16;
typedef unsigned v4u __attribute__((ext_vector_type(4)));
typedef unsigned v2u __attribute__((ext_vector_type(2)));
typedef float f32x4 __attribute__((ext_vector_type(4)));
typedef GAS unsigned gu32;
#define RLX_AGENT __ATOMIC_RELAXED, __HIP_MEMORY_SCOPE_AGENT
#define LDS_WAIT() asm volatile("s_waitcnt lgkmcnt(0)" ::: "memory")
#define VM_WAIT() asm volatile("s_waitcnt vmcnt(0)" ::: "memory")
__device__ __forceinline__ unsigned pk2(float lo, float hi) { return pg8::cvt_pk_bf16(lo, hi); }
__device__ __forceinline__ float bf2f(unsigned short h) { return __uint_as_float((unsigned)h << 16); }
__device__ __forceinline__ float siluf(float x) { return x / (1.f + __expf(-x)); }
#define XB_TMO      128
#define XB_XCNT(j)  (256  + 64 * (j))
#define XB_XSUB(j)  (1280 + 64 * (j))
#define XB_XGEN(j)  (2304 + 64 * (j))
#define XB_TOP      3328
#define XB_TOPGEN   3392
#define XCD_BAR_WORDS 3456
#define XB_SPIN_CAP (1u << 18)

__device__ __forceinline__ unsigned xb_ld(unsigned* p)              { return __hip_atomic_load(p, __ATOMIC_RELAXED, __HIP_MEMORY_SCOPE_AGENT); }
__device__ __forceinline__ unsigned xb_add(unsigned* p, unsigned v) { return __hip_atomic_fetch_add(p, v, __ATOMIC_RELAXED, __HIP_MEMORY_SCOPE_AGENT); }
__device__ __forceinline__ unsigned xb_xcc_id() { return (unsigned)__builtin_amdgcn_s_getreg((3 << 11) | 20) & 0xFu; }
#define XB_SPIN(cond, bar) do { unsigned _sp = 0; while (cond) { __builtin_amdgcn_s_sleep(1); \
    if ((++_sp & 255u) == 0u) { if (xb_ld(&(bar)[XB_TMO])) break; if (_sp > XB_SPIN_CAP) { atomicAdd(&(bar)[XB_TMO], 1u); break; } } } } while (0)

struct XcdBarrier {
    unsigned* bar; unsigned x;
    volatile LAS unsigned* st;
};

__device__ __forceinline__ XcdBarrier xcd_barrier_post(unsigned* bar, volatile LAS unsigned* st) {
    XcdBarrier b; b.bar = bar; b.x = xb_xcc_id(); b.st = st;
    if (threadIdx.x == 0) (void)xb_add(&bar[XB_XCNT(b.x)], 1u);
    return b;
}
__device__ __forceinline__ void xcd_barrier_complete(unsigned* bar, unsigned x, unsigned& nloc, unsigned& nx) {
    const unsigned G = gridDim.x * gridDim.y * gridDim.z;
    unsigned sum, cnt, mine, sp = 0u;
    for (;;) {
        sum = 0u; cnt = 0u; mine = 0u;
#pragma unroll
        for (unsigned j = 0; j < 16; ++j) { const unsigned c = xb_ld(&bar[XB_XCNT(j)]); sum += c; cnt += (c > 0u) ? 1u : 0u; mine = (j == x) ? c : mine; }
        if (sum == G) break;
        __builtin_amdgcn_s_sleep(1);
        if ((++sp & 255u) == 0u) { if (xb_ld(&bar[XB_TMO])) break; if (sp > XB_SPIN_CAP) { atomicAdd(&bar[XB_TMO], 1u); break; } }
    }
    nloc = mine > 0u ? mine : 1u; nx = cnt > 0u ? cnt : 1u;
}

__device__ __forceinline__ void xcd_barrier(const XcdBarrier& b) {
    asm volatile("s_waitcnt vmcnt(0)" ::: "memory");
    __syncthreads();
    if (threadIdx.x == 0) {
        unsigned* bar = b.bar;
        __builtin_amdgcn_s_waitcnt(0);
        unsigned nloc = b.st[0], nx = b.st[1];
        if (nloc == 0u) { xcd_barrier_complete(bar, b.x, nloc, nx); b.st[0] = nloc; b.st[1] = nx; }
        const unsigned old = xb_add(&bar[XB_XSUB(b.x)], 1u);
        const unsigned gen = old / nloc;
        if (old + 1u == (gen + 1u) * nloc) {
            __builtin_amdgcn_fence(__ATOMIC_RELEASE, "agent");
            asm volatile("s_waitcnt vmcnt(0)" ::: "memory");
            const unsigned og = xb_add(&bar[XB_TOP], 1u);
            const unsigned tg = og / nx;
            if (og + 1u == (tg + 1u) * nx) xb_add(&bar[XB_TOPGEN], 1u);
            else XB_SPIN(xb_ld(&bar[XB_TOPGEN]) == tg, bar);
            __builtin_amdgcn_fence(__ATOMIC_ACQUIRE, "agent");
            xb_add(&bar[XB_XGEN(b.x)], 1u);
            asm volatile("s_waitcnt vmcnt(0)" ::: "memory");
        } else {
            XB_SPIN(xb_ld(&bar[XB_XGEN(b.x)]) == gen, bar);
            __builtin_amdgcn_fence(__ATOMIC_ACQUIRE, "agent");
            asm volatile("s_waitcnt vmcnt(0)" ::: "memory");
        }
    }
    __syncthreads();
}

struct Args { const GAS float* in[37]; GAS float* out; GAS unsigned char* ws; int ph_lo, ph_hi; };
enum In { I_X = 0, I_C, I_CTX, I_CCTX, I_WMOD, I_BMOD, I_WIN, I_GWG, I_GBG, I_GNG, I_HCW, I_HCB, I_HW1, I_HB1, I_HF1, I_HW2, I_HB2, I_HF2, I_HW3, I_HB3, I_HSKIP, I_HNG,
          I_QNG, I_WUQ, I_KVNG, I_WUKV, I_MNG, I_WOUT, I_LNG, I_LNB, I_FW1, I_FW3, I_FW2, I_ROUTER, I_MW1, I_MW3, I_MW2 };

struct Frame {
    LAS unsigned char* lds; GAS unsigned char* ws; gu32* ctl; const GAS float* const GAS* in; GAS float* out;
    int tid, lane, wave, G, gw, ngw;
};
__device__ __forceinline__ Frame launder(const Frame& F0) { Frame F = F0; int t = F0.tid; size_t z = 0; asm volatile("" : "+v"(t), "+s"(z)); F.tid = t; F.lane = t & 63; F.ws = F0.ws + z; F.ctl = (gu32*)(F.ws + WS_CTL); F.out = F0.out + z; return F; }
__device__ __forceinline__ float wave_sum(float v) {
#pragma unroll
    for (int o = 1; o < 64; o <<= 1) v += __shfl_xor(v, o);
    return v;
}
__device__ __forceinline__ const GAS float* modv(const Frame& F, int l, int v, int i) { return (const GAS float*)(F.ws + CTL_MODV) + ((size_t)(l * 3 + v) * 6 + i) * D; }
__device__ __forceinline__ int row_v(int row) { return row < TL ? (row >> 14) : 2; }

__device__ __forceinline__ void p0_modv(const Frame& F0) { const Frame F = launder(F0);
    const GAS float* c = F.in[I_C]; const GAS float* cc = F.in[I_CCTX]; const GAS float* wm = F.in[I_WMOD]; const GAS float* bm = F.in[I_BMOD];
    GAS float* mv = (GAS float*)(F.ws + CTL_MODV); LAS float* part = (LAS float*)F.lds;
    constexpr int NBLK = 6 * D / 64, NITEM = DEPTH * NBLK;
    for (int it = blockIdx.x; it < NITEM; it += F.G) {
        const int l = it / NBLK, nb = it % NBLK, n = nb * 64 + F.lane, k0 = F.wave * 128;
        const float s0a = siluf(c[k0 + F.lane]), s1a = siluf(c[D + k0 + F.lane]), s2a = siluf(cc[k0 + F.lane]);
        const float s0b = siluf(c[k0 + 64 + F.lane]), s1b = siluf(c[D + k0 + 64 + F.lane]), s2b = siluf(cc[k0 + 64 + F.lane]);
        float a0 = 0.f, a1 = 0.f, a2 = 0.f;
        const GAS float* w = wm + ((size_t)l * D + k0) * (6 * D) + n;
#pragma unroll 16
        for (int kk = 0; kk < 64; ++kk) { const float wv = w[(size_t)kk * (6 * D)]; a0 += __shfl(s0a, kk) * wv; a1 += __shfl(s1a, kk) * wv; a2 += __shfl(s2a, kk) * wv; }
#pragma unroll 16
        for (int kk = 0; kk < 64; ++kk) { const float wv = w[(size_t)(64 + kk) * (6 * D)]; a0 += __shfl(s0b, kk) * wv; a1 += __shfl(s1b, kk) * wv; a2 += __shfl(s2b, kk) * wv; }
        part[(F.wave * 3 + 0) * 64 + F.lane] = a0; part[(F.wave * 3 + 1) * 64 + F.lane] = a1; part[(F.wave * 3 + 2) * 64 + F.lane] = a2;
        __syncthreads();
        if (F.tid < 192) { const int v = F.tid >> 6, ln = F.tid & 63; float acc = bm[l * 6 * D + nb * 64 + ln];
#pragma unroll
            for (int wv = 0; wv < 8; ++wv) acc += part[(wv * 3 + v) * 64 + ln];
            mv[(size_t)(l * 3 + v) * 6 * D + nb * 64 + ln] = acc; }
        __syncthreads();
    }
}
template <class RowMap>
__device__ __forceinline__ void transpose_item(const GAS float* W, int N, GAS bf16* WT, int ldk, LAS float* scr, int item, int lane, const RowMap& rm, const GAS float* ks) {
    const int nblk = N / 32, kb = item / nblk, nb = item % nblk, k0 = 64 * kb, n0 = 32 * nb;
#pragma unroll 8
    for (int i = 0; i < 32; ++i) { const int kk = 2 * i + (lane >> 5); float v = W[(size_t)(k0 + kk) * N + n0 + (lane & 31)]; if (ks) v *= ks[k0 + kk]; scr[kk * 33 + (lane & 31)] = v; }
    LDS_WAIT(); asm volatile("" ::: "memory");
    const int c = lane & 7;
#pragma unroll
    for (int j = 0; j < 4; ++j) { const int n = (lane >> 3) + 8 * j; const LAS float* s = scr + (8 * c) * 33 + n;
        v4u o; o.x = pk2(s[0 * 33], s[1 * 33]); o.y = pk2(s[2 * 33], s[3 * 33]); o.z = pk2(s[4 * 33], s[5 * 33]); o.w = pk2(s[6 * 33], s[7 * 33]);
        *(GAS v4u*)(WT + (size_t)rm(n0 + n) * ldk + k0 + 8 * c) = o; }
    LDS_WAIT(); asm volatile("" ::: "memory");
}
__device__ __forceinline__ float clamp448(float x) { return fminf(fmaxf(x, -448.f), 448.f); }
__device__ __forceinline__ unsigned pk4_fp8(float a, float b, float c, float d) { unsigned w = 0; w = __builtin_amdgcn_cvt_pk_fp8_f32(clamp448(a), clamp448(b), w, false); w = __builtin_amdgcn_cvt_pk_fp8_f32(clamp448(c), clamp448(d), w, true); return w; }
template <class RowMap>
__device__ __forceinline__ void transpose_item_f8(const GAS float* W, int N, GAS unsigned char* WT, int ldk, LAS float* scr, int item, int lane, const RowMap& rm, float scale) {
    const int nblk = N / 32, kb = item / nblk, nb = item % nblk, k0 = 64 * kb, n0 = 32 * nb;
#pragma unroll 8
    for (int i = 0; i < 32; ++i) { const int kk = 2 * i + (lane >> 5); scr[kk * 33 + (lane & 31)] = W[(size_t)(k0 + kk) * N + n0 + (lane & 31)] * scale; }
    LDS_WAIT(); asm volatile("" ::: "memory");
    const int c = lane & 7;
#pragma unroll
    for (int j = 0; j < 4; ++j) { const int n = (lane >> 3) + 8 * j; const LAS float* s = scr + (8 * c) * 33 + n;
        v2u o; o.x = pk4_fp8(s[0 * 33], s[1 * 33], s[2 * 33], s[3 * 33]); o.y = pk4_fp8(s[4 * 33], s[5 * 33], s[6 * 33], s[7 * 33]);
        *(GAS v2u*)(WT + (size_t)rm(n0 + n) * ldk + k0 + 8 * c) = o; }
    LDS_WAIT(); asm volatile("" ::: "memory");
}
struct RmIdent { int off; __device__ int operator()(int n) const { return n + off; } };
struct RmWin { __device__ int operator()(int c) const {
    if (c < 768) return c; if (c < 800) return PH_ALR + (c - 768); if (c < 1568) return PH_HY + (c - 800); if (c < 1824) return PH_CQ + (c - 1568); if (c < 1952) return PH_CKV + (c - 1824); return PH_KR + (c - 1952); } };
struct RmGlu { int half; __device__ int operator()(int j) const { return (j >> 2) * 8 + half * 4 + (j & 3); } };

__device__ __forceinline__ void p0_weights(const Frame& F0) { const Frame F = launder(F0);
    LAS float* scr = (LAS float*)(F.lds + F.wave * 16384);
    GAS bf16* WIN = (GAS bf16*)(F.ws + WS_WIN); GAS bf16* WOUT = (GAS bf16*)(F.ws + WS_WOUT); GAS bf16* W13 = (GAS bf16*)(F.ws + WS_W13); GAS bf16* W2 = (GAS bf16*)(F.ws + WS_W2);
    GAS bf16* WUQ = (GAS bf16*)(F.ws + WS_WUQ); GAS bf16* WUKV = (GAS bf16*)(F.ws + WS_WUKV);
    constexpr int I_IN = (D / 64) * (1984 / 32), I_OUT = (D / 64) * (D / 32), I_F1 = (D / 64) * (DFF / 32), I_F2 = (DFF / 64) * (D / 32), I_UQ = (256 / 64) * (768 / 32), I_UKV = (128 / 64) * (1024 / 32);
    constexpr int NITEM = DEPTH * I_IN + DEPTH * I_OUT + 2 * I_F1 + I_F2 + DEPTH * I_UQ + DEPTH * I_UKV;
    for (int it = F.gw; it < NITEM; it += F.ngw) {
        int r = it;
        if (r < DEPTH * I_IN) { const int l = r / I_IN; transpose_item(F.in[I_WIN] + (size_t)l * D * 1984, 1984, WIN + (size_t)l * NPH * D, D, scr, r % I_IN, F.lane, RmWin{}, nullptr); continue; } r -= DEPTH * I_IN;
        if (r < DEPTH * I_OUT) { const int l = r / I_OUT; transpose_item(F.in[I_WOUT] + (size_t)l * D * D, D, WOUT + (size_t)l * D * D, D, scr, r % I_OUT, F.lane, RmIdent{0}, nullptr); continue; } r -= DEPTH * I_OUT;
        if (r < I_F1) { transpose_item(F.in[I_FW1], DFF, W13, D, scr, r, F.lane, RmGlu{0}, nullptr); continue; } r -= I_F1;
        if (r < I_F1) { transpose_item(F.in[I_FW3], DFF, W13, D, scr, r, F.lane, RmGlu{1}, nullptr); continue; } r -= I_F1;
        if (r < I_F2) { transpose_item(F.in[I_FW2], D, W2, DFF, scr, r, F.lane, RmIdent{0}, nullptr); continue; } r -= I_F2;
        if (r < DEPTH * I_UQ) { const int l = r / I_UQ; transpose_item(F.in[I_WUQ] + (size_t)l * 256 * 768, 768, WUQ + (size_t)l * 768 * 256, 256, scr, r % I_UQ, F.lane, RmIdent{0}, F.in[I_QNG] + l * 256); continue; } r -= DEPTH * I_UQ;
        { const int l = r / I_UKV; transpose_item(F.in[I_WUKV] + (size_t)l * 128 * 1024, 1024, WUKV + (size_t)l * 1024 * 256, 256, scr, r % I_UKV, F.lane, RmIdent{0}, F.in[I_KVNG] + l * 128); }
    }
    const int gt = blockIdx.x * NTHR + F.tid, ngt = F.G * NTHR;
    for (int i = gt; i < DEPTH * 64 * D / 8; i += ngt) { const int l = i / (64 * D / 8), r = i % (64 * D / 8); *(GAS v4u*)(WIN + ((size_t)l * NPH + 1984) * D + (size_t)r * 8) = (v4u){0u, 0u, 0u, 0u}; }
    for (int i = gt; i < DEPTH * 1024 * 128 / 8; i += ngt) { const int row = i / 16, c = i % 16; *(GAS v4u*)(WUKV + (size_t)row * 256 + 128 + c * 8) = (v4u){0u, 0u, 0u, 0u}; }
}

__device__ __forceinline__ void mod_store_bf16(const f32x4 (&v)[4], const GAS float* sh, const GAS float* sc, GAS bf16* orow, int lane) {
    GAS unsigned long long* o8 = (GAS unsigned long long*)orow + lane;
#pragma unroll
    for (int j = 0; j < 4; ++j) { const f32x4 a = ((const GAS f32x4*)sc)[lane + 64 * j], b = ((const GAS f32x4*)sh)[lane + 64 * j];
        const f32x4 y = v[j] * (a + 1.f) + b;
        o8[64 * j] = (unsigned long long)pk2(y.x, y.y) | ((unsigned long long)pk2(y.z, y.w) << 32); }
}
__device__ __forceinline__ void p_xn0(const Frame& F0) { const Frame F = launder(F0);
    GAS bf16* XN = (GAS bf16*)(F.ws + WS_XN);
    f32x4 nx[4];
#define XN0_LOAD(mm) do { const GAS float* src_ = (mm) < TL ? F.in[I_X] + (size_t)(mm) * D : F.in[I_CTX] + (size_t)((mm) - TL) * D; _Pragma("unroll") for (int j = 0; j < 4; ++j) nx[j] = ((const GAS f32x4*)src_)[F.lane + 64 * j]; } while (0)
    int m = F.gw; if (m < MR) XN0_LOAD(m);
    for (; m < MR; m += F.ngw) {
        f32x4 v[4];
#pragma unroll
        for (int j = 0; j < 4; ++j) v[j] = nx[j];
        if (m + F.ngw < MR) XN0_LOAD(m + F.ngw);
        const int vv = row_v(m);
        mod_store_bf16(v, modv(F, 0, vv, 0), modv(F, 0, vv, 1), XN + (size_t)m * D, F.lane);
    }
#undef XN0_LOAD
}
__device__ __forceinline__ GAS float* xres(const Frame& F, int row) { return row < TL ? F.out + (size_t)row * D : (GAS float*)(F.ws + WS_XC) + (size_t)(row - TL) * D; }
__device__ __forceinline__ void p_ln(const Frame& F0, int nrows, const GAS float* g, const GAS float* b, bool want_xn, int ml, int si) { const Frame F = launder(F0);
    GAS bf16* XN = (GAS bf16*)(F.ws + WS_XN);
    f32x4 nx[4];
    int m = F.gw; if (m < nrows) { const GAS float* r_ = xres(F, m);
#pragma unroll
        for (int j = 0; j < 4; ++j) nx[j] = ((const GAS f32x4*)r_)[F.lane + 64 * j]; }
    for (; m < nrows; m += F.ngw) {
        GAS float* row = xres(F, m);
        f32x4 v[4]; float s = 0.f;
#pragma unroll
        for (int j = 0; j < 4; ++j) { v[j] = nx[j]; s += (v[j].x + v[j].y) + (v[j].z + v[j].w); }
        if (m + F.ngw < nrows) { const GAS float* r_ = xres(F, m + F.ngw);
#pragma unroll
            for (int j = 0; j < 4; ++j) nx[j] = ((const GAS f32x4*)r_)[F.lane + 64 * j]; }
        const float mean = wave_sum(s) * (1.f / D); float s2 = 0.f;
#pragma unroll
        for (int j = 0; j < 4; ++j) { v[j] = v[j] - mean; s2 += (v[j].x * v[j].x + v[j].y * v[j].y) + (v[j].z * v[j].z + v[j].w * v[j].w); }
        const float rstd = 1.f / sqrtf(wave_sum(s2) * (1.f / D) + LN_EPS);
#pragma unroll
        for (int j = 0; j < 4; ++j) { const f32x4 gg = ((const GAS f32x4*)g)[F.lane + 64 * j], bb = ((const GAS f32x4*)b)[F.lane + 64 * j]; v[j] = v[j] * rstd * gg + bb; ((GAS f32x4*)row)[F.lane + 64 * j] = v[j]; }
        if (want_xn) { const int vv = row_v(m); mod_store_bf16(v, modv(F, ml, vv, si), modv(F, ml, vv, si + 1), XN + (size_t)m * D, F.lane); }
    }
}

using pg8::f32x4; using pg8::Unit;
struct EpiStoreBf16 {
    static constexpr bool PERM = true, AFTER_DRAIN = false;
    GAS bf16* O; int ldc; float sc;
    __device__ __forceinline__ void operator()(const pg8::f32x4 (&acc)[2][2][4][2], const Unit& u, int wr, int wc, int fr, int fq) const {
        const int row0 = u.pm * 256 + wr * 64 + fr, col0 = u.pn * 256 + wc * 32 + 8 * fq;
#pragma unroll
        for (int ai = 0; ai < 2; ++ai)
#pragma unroll
            for (int m = 0; m < 4; ++m) { GAS bf16* rowp = O + (size_t)(row0 + ai * 128 + m * 16) * ldc + col0;
#pragma unroll
                for (int bj = 0; bj < 2; ++bj) { const pg8::f32x4 v0 = acc[ai][bj][m][0] * sc, v1 = acc[ai][bj][m][1] * sc;
                    v4u w; w.x = pk2(v0[0], v0[1]); w.y = pk2(v0[2], v0[3]); w.z = pk2(v1[0], v1[1]); w.w = pk2(v1[2], v1[3]);
                    *(GAS v4u*)(rowp + bj * 128) = w; } }
    }
};
struct EpiSwiglu {
    static constexpr bool PERM = true, AFTER_DRAIN = false;
    GAS bf16* G; int ldg; float sc;
    __device__ __forceinline__ void operator()(const pg8::f32x4 (&acc)[2][2][4][2], const Unit& u, int wr, int wc, int fr, int fq) const {
        const int row0 = u.pm * 256 + wr * 64 + fr, col0 = (u.pn * 256 + wc * 32 + 8 * fq) >> 1;
#pragma unroll
        for (int ai = 0; ai < 2; ++ai)
#pragma unroll
            for (int m = 0; m < 4; ++m) { GAS bf16* rowp = G + (size_t)(row0 + ai * 128 + m * 16) * ldg + col0;
#pragma unroll
                for (int bj = 0; bj < 2; ++bj) { const pg8::f32x4 a = acc[ai][bj][m][0] * sc, b = acc[ai][bj][m][1] * sc;
                    v2u w; w.x = pk2(siluf(a[0]) * b[0], siluf(a[1]) * b[1]); w.y = pk2(siluf(a[2]) * b[2], siluf(a[3]) * b[3]);
                    *(GAS v2u*)(rowp + bj * 64) = w; } }
    }
};
struct EpiSwiglu8 {
    static constexpr bool PERM = true, AFTER_DRAIN = false;
    GAS unsigned char* G; int ldg; float sc, osc;
    __device__ __forceinline__ void operator()(const pg8::f32x4 (&acc)[2][2][4][2], const Unit& u, int wr, int wc, int fr, int fq) const {
        const int row0 = u.pm * 256 + wr * 64 + fr, col0 = (u.pn * 256 + wc * 32 + 8 * fq) >> 1;
#pragma unroll
        for (int ai = 0; ai < 2; ++ai)
#pragma unroll
            for (int m = 0; m < 4; ++m) { GAS unsigned char* rowp = G + (size_t)(row0 + ai * 128 + m * 16) * ldg + col0;
#pragma unroll
                for (int bj = 0; bj < 2; ++bj) { const pg8::f32x4 a = acc[ai][bj][m][0] * sc, b = acc[ai][bj][m][1] * sc;
                    *(GAS unsigned*)(rowp + bj * 64) = pk4_fp8(siluf(a[0]) * b[0] * osc, siluf(a[1]) * b[1] * osc, siluf(a[2]) * b[2] * osc, siluf(a[3]) * b[3] * osc); } }
    }
};
struct EpiRes {
    static constexpr bool PERM = false, AFTER_DRAIN = false;
    const GAS float* xin_lat; const GAS float* xin_ctx; GAS float* out_lat; GAS float* out_ctx; const GAS float* gate0;
    __device__ __forceinline__ void operator()(const pg8::f32x4 (&acc)[2][2][4][2], const Unit& u, int wr, int wc, int fr, int fq) const {
        const bool lat = u.pm < TL / 256; const int v = lat ? (u.pm >> 6) : 2;
        const GAS float* xin = lat ? xin_lat : xin_ctx - (size_t)TL * D; GAS float* out = lat ? out_lat : out_ctx - (size_t)TL * D;
        const GAS float* gate = gate0 + (size_t)v * 6 * D;
        const int row0 = u.pm * 256 + wr * 64 + fr, col0 = u.pn * 256 + wc * 32 + 4 * fq;
        pg8::f32x4 gv[2][2];
#pragma unroll
        for (int bj = 0; bj < 2; ++bj)
#pragma unroll
            for (int n = 0; n < 2; ++n) gv[bj][n] = *(const GAS pg8::f32x4*)(gate + col0 + bj * 128 + n * 16);
#pragma unroll
        for (int ai = 0; ai < 2; ++ai)
#pragma unroll
            for (int m = 0; m < 4; ++m) { const size_t off = (size_t)(row0 + ai * 128 + m * 16) * D + col0;
#pragma unroll
                for (int bj = 0; bj < 2; ++bj)
#pragma unroll
                    for (int n = 0; n < 2; ++n) { const pg8::f32x4 xv = *(const GAS pg8::f32x4*)(xin + off + bj * 128 + n * 16);
                        *(GAS pg8::f32x4*)(out + off + bj * 128 + n * 16) = xv * ALPHA + gv[bj][n] * acc[ai][bj][m][n]; } }
    }
};


constexpr int CW_MOECNT = 2048;
constexpr size_t WS_TI = WS_SMALL + 64 * 1024;
constexpr int MOE_CHUNK_TILES = 64, MOE_NCHUNK = 5, MOE_MAXROWS = MOE_NCHUNK * MOE_CHUNK_TILES * 256;
constexpr size_t WS_HS = AB + 65 * MiB, WS_WM13 = AB + 197 * MiB, WS_WM2 = AB + 309 * MiB, WS_GC = AB + 365 * MiB;
constexpr size_t WS_H8 = WS_XN, WS_HS8 = WS_HS + 66 * MiB;
constexpr float MOE_WSCALE = 64.f, MOE_GSCALE = 16.f, MOE_W2SCALE = 256.f;
static_assert(WS_HS + (size_t)(2 * TL + NEXP * 256) * D * 2 <= WS_WM13 && WS_WM13 + (size_t)NEXP * 2 * EFF * D * 2 <= WS_WM2 && WS_WM2 + (size_t)NEXP * D * EFF * 2 <= WS_GC && WS_GC + (size_t)MOE_CHUNK_TILES * 256 * EFF * 2 <= WS_XC, "MoE map");

__device__ __forceinline__ void p_ln_route(const Frame& F0, const GAS float* g, const GAS float* b, int l) { const Frame F = launder(F0);
    GAS bf16* XN = (GAS bf16*)(F.ws + WS_XN);
    GAS int* TI_E = (GAS int*)(F.ws + WS_TI); GAS int* TI_P0 = TI_E + TL; GAS int* TI_P1 = TI_P0 + TL; GAS float* TI_W0 = (GAS float*)(TI_P1 + TL); GAS float* TI_W1 = TI_W0 + TL;
    const GAS float* wr = F.in[I_ROUTER];
    f32x4 nx[4];
    int m = F.gw; if (m < TL) {
#pragma unroll
        for (int j = 0; j < 4; ++j) nx[j] = ((const GAS f32x4*)(F.out + (size_t)m * D))[F.lane + 64 * j]; }
    for (; m < TL; m += F.ngw) {
        GAS float* row = F.out + (size_t)m * D;
        f32x4 v[4]; float s = 0.f;
#pragma unroll
        for (int j = 0; j < 4; ++j) { v[j] = nx[j]; s += (v[j].x + v[j].y) + (v[j].z + v[j].w); }
        if (m + F.ngw < TL) {
#pragma unroll
            for (int j = 0; j < 4; ++j) nx[j] = ((const GAS f32x4*)(F.out + (size_t)(m + F.ngw) * D))[F.lane + 64 * j]; }
        const float mean = wave_sum(s) * (1.f / D); float s2 = 0.f;
#pragma unroll
        for (int j = 0; j < 4; ++j) { v[j] = v[j] - mean; s2 += (v[j].x * v[j].x + v[j].y * v[j].y) + (v[j].z * v[j].z + v[j].w * v[j].w); }
        const float rstd = 1.f / sqrtf(wave_sum(s2) * (1.f / D) + LN_EPS);
        const int vv = row_v(m); const GAS float* sh = modv(F, l, vv, 3); const GAS float* sc = modv(F, l, vv, 4);
        GAS unsigned* h8 = (GAS unsigned*)(F.ws + WS_H8 + (size_t)m * D) + F.lane;
        float lg[NEXP];
#pragma unroll
        for (int e = 0; e < NEXP; ++e) lg[e] = 0.f;
#pragma unroll
        for (int j = 0; j < 4; ++j) { const f32x4 gg = ((const GAS f32x4*)g)[F.lane + 64 * j], bb = ((const GAS f32x4*)b)[F.lane + 64 * j]; v[j] = v[j] * rstd * gg + bb; ((GAS f32x4*)row)[F.lane + 64 * j] = v[j];
            const f32x4 a = ((const GAS f32x4*)sc)[F.lane + 64 * j], c = ((const GAS f32x4*)sh)[F.lane + 64 * j];
            const f32x4 y = v[j] * (a + 1.f) + c;
            h8[64 * j] = pk4_fp8(y.x, y.y, y.z, y.w);
            const GAS f32x4* w4 = (const GAS f32x4*)(wr + (size_t)(4 * F.lane + 256 * j) * NEXP);
#pragma unroll
            for (int i = 0; i < 4; ++i) { const f32x4 wa = w4[2 * i], wb = w4[2 * i + 1]; const float yi = y[i];
                lg[0] += yi * wa.x; lg[1] += yi * wa.y; lg[2] += yi * wa.z; lg[3] += yi * wa.w; lg[4] += yi * wb.x; lg[5] += yi * wb.y; lg[6] += yi * wb.z; lg[7] += yi * wb.w; } }
#pragma unroll
        for (int e = 0; e < NEXP; ++e) lg[e] = wave_sum(lg[e]);
        int i0 = 0; float v0 = lg[0];
#pragma unroll
        for (int e = 1; e < NEXP; ++e) if (lg[e] > v0) { v0 = lg[e]; i0 = e; }
        int i1 = -1; float v1 = -3.0e38f;
#pragma unroll
        for (int e = 0; e < NEXP; ++e) if (e != i0 && lg[e] > v1) { v1 = lg[e]; i1 = e; }
        if (F.lane == 0) {
            const float w0 = 1.f / (1.f + __expf(v1 - v0));
            const int p0 = (int)__hip_atomic_fetch_add((GAS unsigned*)F.ctl + CW_MOECNT + 64 * i0, 1u, RLX_AGENT);
            const int p1 = (int)__hip_atomic_fetch_add((GAS unsigned*)F.ctl + CW_MOECNT + 64 * i1, 1u, RLX_AGENT);
            TI_E[m] = i0 | (i1 << 8); TI_P0[m] = p0; TI_P1[m] = p1; TI_W0[m] = w0; TI_W1[m] = 1.f - w0;
        }
    }
}
struct MoeBase { int bt[NEXP + 1]; };
__device__ __forceinline__ MoeBase moe_base(const Frame& F) {
    MoeBase B; int acc = 0;
#pragma unroll
    for (int e = 0; e < NEXP; ++e) { B.bt[e] = acc; const unsigned c = __hip_atomic_load((GAS unsigned*)F.ctl + CW_MOECNT + 64 * e, RLX_AGENT); acc += (int)((c + 255u) >> 8); }
    B.bt[NEXP] = acc; return B;
}
__device__ __forceinline__ void p_moe_weights(const Frame& F0) { const Frame F = launder(F0);
    LAS float* scr = (LAS float*)(F.lds + F.wave * 16384);
    GAS unsigned char* WM13 = F.ws + WS_WM13; GAS unsigned char* WM2 = F.ws + WS_WM2;
    constexpr int I1 = (D / 64) * (EFF / 32), I2 = (EFF / 64) * (D / 32), NITEM = NEXP * (2 * I1 + I2);
    for (int it = F.gw; it < NITEM; it += F.ngw) {
        const int e = it / (2 * I1 + I2); int r = it % (2 * I1 + I2);
        if (r < I1) { transpose_item_f8(F.in[I_MW1] + (size_t)e * D * EFF, EFF, WM13 + (size_t)e * 2 * EFF * D, D, scr, r, F.lane, RmGlu{0}, MOE_WSCALE); continue; } r -= I1;
        if (r < I1) { transpose_item_f8(F.in[I_MW3] + (size_t)e * D * EFF, EFF, WM13 + (size_t)e * 2 * EFF * D, D, scr, r, F.lane, RmGlu{1}, MOE_WSCALE); continue; } r -= I1;
        transpose_item_f8(F.in[I_MW2] + (size_t)e * EFF * D, D, WM2 + (size_t)e * D * EFF, EFF, scr, r, F.lane, RmIdent{0}, MOE_W2SCALE);
    }
}
__device__ __forceinline__ void p_moe_scatter(const Frame& F0) { const Frame F = launder(F0);
    const MoeBase B = moe_base(F);
    const GAS unsigned char* H8 = F.ws + WS_H8; GAS unsigned char* HS8 = F.ws + WS_HS8;
    GAS int* TI_E = (GAS int*)(F.ws + WS_TI); GAS int* TI_P0 = TI_E + TL; GAS int* TI_P1 = TI_P0 + TL;
    for (int m = F.gw; m < TL; m += F.ngw) {
        const int ee = TI_E[m], e0 = ee & 255, e1 = ee >> 8;
        int b0 = 0, b1 = 0;
#pragma unroll
        for (int e = 0; e < NEXP; ++e) { if (e == e0) b0 = B.bt[e]; if (e == e1) b1 = B.bt[e]; }
        const int s0 = b0 * 256 + TI_P0[m], s1 = b1 * 256 + TI_P1[m];
        const v4u a = *((const GAS v4u*)(H8 + (size_t)m * D) + F.lane);
        *((GAS v4u*)(HS8 + (size_t)s0 * D) + F.lane) = a; *((GAS v4u*)(HS8 + (size_t)s1 * D) + F.lane) = a;
        if (F.lane == 0) { TI_P0[m] = s0; TI_P1[m] = s1; }
    }
}
constexpr int LDS_MOEBT = LDS_MISC + 64;
__device__ __forceinline__ void moe_base_to_lds(const Frame& F) {
    if (F.tid == 0) { volatile LAS int* bt = (volatile LAS int*)(F.lds + LDS_MOEBT); int acc = 0;
        for (int e = 0; e < NEXP; ++e) { bt[e] = acc; const unsigned c = __hip_atomic_load((GAS unsigned*)F.ctl + CW_MOECNT + 64 * e, RLX_AGENT); acc += (int)((c + 255u) >> 8); }
        bt[NEXP] = acc; }
    __syncthreads();
}
struct MoeOrder {
    int nM, nN, nwg, G, c, tile0; const LAS int* bt;
    __device__ void init(const LAS int* bt_, int chunk, int nN_, int G_, int c_) {
        bt = bt_; tile0 = chunk * MOE_CHUNK_TILES; int v = bt[NEXP] - tile0; nM = v < 0 ? 0 : (v > MOE_CHUNK_TILES ? MOE_CHUNK_TILES : v); nN = nN_; nwg = nM * nN; G = G_; c = c_; }
    __device__ bool next(int i, pg8::Unit& u) const {
        const long L = (long)i * G + c; if (L >= nwg) return false;
        int wgid = (int)L; { const int q = nwg / pg8::NXCD, r = nwg % pg8::NXCD, xcd = wgid % pg8::NXCD, off = wgid / pg8::NXCD; wgid = (xcd < r ? xcd * (q + 1) : r * (q + 1) + (xcd - r) * q) + off; }
        const int nig = pg8::WGM * nN, gid = wgid / nig, fm = gid * pg8::WGM, gsz = (nM - fm) < pg8::WGM ? (nM - fm) : pg8::WGM;
        u.pm = fm + ((wgid % nig) % gsz); u.pn = (wgid % nig) / gsz;
        const int gt = tile0 + u.pm; int e = 0;
#pragma unroll
        for (int k = 1; k < NEXP; ++k) e += (gt >= bt[k]) ? 1 : 0;
        u.be = __builtin_amdgcn_readfirstlane(e); return true;
    }
    __device__ __forceinline__ void a_ready(const pg8::Unit&) const {}
    __device__ __forceinline__ void done(const pg8::Unit&) const {}
};
__device__ __forceinline__ void p_ln_combine(const Frame& F0, const GAS float* g, const GAS float* b, int l) { const Frame F = launder(F0);
    const GAS bf16* YS = (const GAS bf16*)(F.ws + WS_HS);
    GAS int* TI_E = (GAS int*)(F.ws + WS_TI); GAS int* TI_P0 = TI_E + TL; GAS int* TI_P1 = TI_P0 + TL; GAS float* TI_W0 = (GAS float*)(TI_P1 + TL); GAS float* TI_W1 = TI_W0 + TL;
    for (int m = F.gw; m < TL; m += F.ngw) {
        GAS float* row = F.out + (size_t)m * D;
        const int s0 = TI_P0[m], s1 = TI_P1[m]; const float w0 = TI_W0[m], w1 = TI_W1[m];
        const GAS float* gate = modv(F, l, row_v(m), 5);
        const GAS unsigned long long* y0 = (const GAS unsigned long long*)(YS + (size_t)s0 * D) + F.lane; const GAS unsigned long long* y1 = (const GAS unsigned long long*)(YS + (size_t)s1 * D) + F.lane;
        f32x4 v[4]; float s = 0.f;
#pragma unroll
        for (int j = 0; j < 4; ++j) { const f32x4 x = ((const GAS f32x4*)row)[F.lane + 64 * j], gt = ((const GAS f32x4*)gate)[F.lane + 64 * j];
            const unsigned long long a = y0[64 * j], c = y1[64 * j];
            f32x4 f;
            f.x = w0 * bf2f((unsigned short)a) + w1 * bf2f((unsigned short)c); f.y = w0 * bf2f((unsigned short)(a >> 16)) + w1 * bf2f((unsigned short)(c >> 16));
            f.z = w0 * bf2f((unsigned short)(a >> 32)) + w1 * bf2f((unsigned short)(c >> 32)); f.w = w0 * bf2f((unsigned short)(a >> 48)) + w1 * bf2f((unsigned short)(c >> 48));
            v[j] = x * ALPHA + gt * f; s += (v[j].x + v[j].y) + (v[j].z + v[j].w); }
        const float mean = wave_sum(s) * (1.f / D); float s2 = 0.f;
#pragma unroll
        for (int j = 0; j < 4; ++j) { v[j] = v[j] - mean; s2 += (v[j].x * v[j].x + v[j].y * v[j].y) + (v[j].z * v[j].z + v[j].w * v[j].w); }
        const float rstd = 1.f / sqrtf(wave_sum(s2) * (1.f / D) + LN_EPS);
#pragma unroll
        for (int j = 0; j < 4; ++j) { const f32x4 gg = ((const GAS f32x4*)g)[F.lane + 64 * j], bb = ((const GAS f32x4*)b)[F.lane + 64 * j]; ((GAS f32x4*)row)[F.lane + 64 * j] = v[j] * rstd * gg + bb; }
    }
}

namespace att {
using bf16x8 = __attribute__((ext_vector_type(8))) short;
using s16x4  = __attribute__((ext_vector_type(4))) short;
using f32x16 = __attribute__((ext_vector_type(16))) float;
using u32x4  = __attribute__((ext_vector_type(4))) unsigned;
constexpr int DQ = 96, DV = 64, NW = 8, QBLK = 32, KVBLK = 64, NKEY = 16640;
constexpr float THR2 = 8.0f;
constexpr int SHM_K = KVBLK * 144, SHM_V = DV * 80;
typedef int i32x8 __attribute__((ext_vector_type(8)));
constexpr int NSLOT = 8;
constexpr int LDS_V = 0, LDS_K = NSLOT * SHM_V, LDS_WS = LDS_K + NSLOT * SHM_K, LDS_Q = LDS_WS + NW * 64 * 4, ATT_LDS = LDS_Q + NW * 4096;
#define KSWZ(row, colB) ((row) * 256 + ((colB) ^ (((row) & 7) << 4)))
#define SBAR() __builtin_amdgcn_sched_barrier(0)
__device__ __forceinline__ int crow(int r, int hi) { return (r & 3) + 8 * (r >> 2) + 4 * hi; }
__device__ __forceinline__ unsigned cvtpk(float lo, float hi) { unsigned r; asm volatile("v_cvt_pk_bf16_f32 %0, %1, %2" : "=v"(r) : "v"(lo), "v"(hi)); return r; }
template <bool FIRST>
__device__ __forceinline__ bool partialSM(f32x16& p0, f32x16& p1, f32x16& negm, float& alpha) {
  float a = fmaxf(fmaxf(p0[0], p0[1]), p1[0]), b = fmaxf(fmaxf(p0[2], p0[3]), p1[1]); a = fmaxf(fmaxf(a, p1[2]), p1[3]);
#pragma unroll
  for (int r = 4; r < 16; r += 4) { a = fmaxf(fmaxf(a, p0[r]), p0[r + 1]); b = fmaxf(fmaxf(b, p0[r + 2]), p0[r + 3]); a = fmaxf(fmaxf(a, p1[r]), p1[r + 1]); b = fmaxf(fmaxf(b, p1[r + 2]), p1[r + 3]); }
  float pmax = fmaxf(a, b);
  { auto rr = __builtin_amdgcn_permlane32_swap(__float_as_uint(pmax), __float_as_uint(pmax), false, false);
    pmax = fmaxf(__uint_as_float(rr[0]), __uint_as_float(rr[1])); }
  bool resc = false;
  if (FIRST || __builtin_expect(__any(pmax > THR2), 0)) {
    const float dl = FIRST ? pmax : fmaxf(pmax, 0.f);
#pragma unroll
    for (int r = 0; r < 16; ++r) { p0[r] -= dl; p1[r] -= dl; negm[r] -= dl; }
    alpha = __builtin_amdgcn_exp2f(-dl); resc = !FIRST;
  }
  return resc;
}
__device__ __forceinline__ void finishSM(f32x16& p0, f32x16& p1, i32x8& pb) {
#pragma unroll
  for (int r = 0; r < 16; ++r) p0[r] = __builtin_amdgcn_exp2f(p0[r]);
#pragma unroll
  for (int r = 0; r < 16; ++r) p1[r] = __builtin_amdgcn_exp2f(p1[r]);
#pragma unroll
  for (int w = 0; w < 4; ++w) {
    int x = __builtin_amdgcn_cvt_pk_fp8_f32(p0[4 * w], p0[4 * w + 1], __float_as_int(p0[4 * w]), false); x = __builtin_amdgcn_cvt_pk_fp8_f32(p0[4 * w + 2], p0[4 * w + 3], x, true); pb[w] = x;
    int y = __builtin_amdgcn_cvt_pk_fp8_f32(p1[4 * w], p1[4 * w + 1], __float_as_int(p1[4 * w]), false); y = __builtin_amdgcn_cvt_pk_fp8_f32(p1[4 * w + 2], p1[4 * w + 3], y, true); pb[4 + w] = y; }
}
__device__ __forceinline__ i32x8 ld32(const LAS char* p) { const u32x4 a = *reinterpret_cast<const LAS u32x4*>(p), b = *reinterpret_cast<const LAS u32x4*>(p + 16);
  return (i32x8){(int)a[0], (int)a[1], (int)a[2], (int)a[3], (int)b[0], (int)b[1], (int)b[2], (int)b[3]}; }
struct KFrag { i32x8 k00, k01, k10, k11; };
__device__ __forceinline__ void qkt_load(KFrag& k, const LAS char* Ks, int r32, int hi) {
  const LAS char* kp = Ks + r32 * 144 + hi * 32;
  k.k00 = ld32(kp); k.k01 = ld32(kp + 64); k.k10 = ld32(kp + 32 * 144); k.k11 = ld32(kp + 32 * 144 + 64);
}
__device__ __forceinline__ void qkt_mma(f32x16& p0, f32x16& p1, const KFrag& k, const i32x8& q0, const i32x8& q1, const f32x16& negm) {
  asm volatile("s_nop 1\n\tv_mfma_f32_32x32x64_f8f6f4 %0, %1, %2, %3" : "=&v"(p0) : "v"(k.k00), "v"(q0), "v"(negm));
  asm volatile("v_mfma_f32_32x32x64_f8f6f4 %0, %1, %2, %3" : "=&v"(p1) : "v"(k.k10), "v"(q0), "v"(negm));
  asm volatile("v_mfma_f32_32x32x64_f8f6f4 %0, %1, %2, %0" : "+v"(p0) : "v"(k.k01), "v"(q1));
  asm volatile("v_mfma_f32_32x32x64_f8f6f4 %0, %1, %2, %0" : "+v"(p1) : "v"(k.k11), "v"(q1));
}
__device__ __forceinline__ void qkt(f32x16& p0, f32x16& p1, const LAS char* Ks, const i32x8& q0, const i32x8& q1, const f32x16& negm, int r32, int hi) {
  KFrag k; qkt_load(k, Ks, r32, hi); qkt_mma(p0, p1, k, q0, q1, negm);
}
#define QK_DRAIN(P0, P1) asm volatile("s_nop 15\n\ts_nop 7" : "+v"(P0), "+v"(P1))
__device__ __forceinline__ void pv_d0(f32x16* o, const LAS char* Vs, const i32x8& pb, int r32, int hi) {
  const LAS char* vp = Vs + r32 * 80 + hi * 32;
  const u32x4 a0 = *reinterpret_cast<const LAS u32x4*>(vp), a1 = *reinterpret_cast<const LAS u32x4*>(vp + 16);
  const u32x4 b0 = *reinterpret_cast<const LAS u32x4*>(vp + 32 * 80), b1 = *reinterpret_cast<const LAS u32x4*>(vp + 32 * 80 + 16);
  const i32x8 va = {(int)a0[0], (int)a0[1], (int)a0[2], (int)a0[3], (int)a1[0], (int)a1[1], (int)a1[2], (int)a1[3]};
  const i32x8 vb = {(int)b0[0], (int)b0[1], (int)b0[2], (int)b0[3], (int)b1[0], (int)b1[1], (int)b1[2], (int)b1[3]};
  const i32x8 ones = {0x38383838, 0x38383838, 0x38383838, 0x38383838, 0x38383838, 0x38383838, 0x38383838, 0x38383838};
  asm volatile("s_nop 1\n\tv_mfma_f32_32x32x64_f8f6f4 %0, %1, %2, %0" : "+v"(o[0]) : "v"(va), "v"(pb));
  asm volatile("v_mfma_f32_32x32x64_f8f6f4 %0, %1, %2, %0" : "+v"(o[1]) : "v"(vb), "v"(pb));
  asm volatile("v_mfma_f32_32x32x64_f8f6f4 %0, %1, %2, %0" : "+v"(o[2]) : "v"(ones), "v"(pb));
}
#define PV_DRAIN() asm volatile("s_nop 15\n\ts_nop 7" : "+v"(o[0]), "+v"(o[1]), "+v"(o[2]))
#define QK_A(P, KA, QA) asm volatile("s_nop 1\n\tv_mfma_f32_32x32x64_f8f6f4 %0, %1, %2, %3" : "=&v"(P) : "v"(KA), "v"(QA), "v"(negm))
#define QK_B(P, KA, QA) asm volatile("v_mfma_f32_32x32x64_f8f6f4 %0, %1, %2, %3" : "=&v"(P) : "v"(KA), "v"(QA), "v"(negm))
#define QK_C(P, KA, QA) asm volatile("v_mfma_f32_32x32x64_f8f6f4 %0, %1, %2, %0" : "+v"(P) : "v"(KA), "v"(QA))
#define PV_A(O, VA) asm volatile("s_nop 1\n\tv_mfma_f32_32x32x64_f8f6f4 %0, %1, %2, %0" : "+v"(O) : "v"(VA), "v"(pb))
#define PV_B(O, VA) asm volatile("v_mfma_f32_32x32x64_f8f6f4 %0, %1, %2, %0" : "+v"(O) : "v"(VA), "v"(pb))
#define EXPS(P, lo, hi_) do { _Pragma("unroll") for (int r_ = (lo); r_ < (hi_); ++r_) P[r_] = __builtin_amdgcn_exp2f(P[r_]); } while (0)
#define CVT4(P, w_, dst) do { int x_ = __builtin_amdgcn_cvt_pk_fp8_f32(P[4 * (w_)], P[4 * (w_) + 1], __float_as_int(P[4 * (w_)]), false); dst = __builtin_amdgcn_cvt_pk_fp8_f32(P[4 * (w_) + 2], P[4 * (w_) + 3], x_, true); } while (0)
__device__ __forceinline__ float mx3(float a, float b, float c) { float r; asm("v_max3_f32 %0, %1, %2, %3" : "=v"(r) : "v"(a), "v"(b), "v"(c)); return r; }
__device__ __forceinline__ float max16(const f32x16& p, float prev) {
  float a, b;
  asm("v_max3_f32 %0, %2, %3, %4\n\tv_max3_f32 %1, %5, %6, %7\n\tv_max3_f32 %0, %0, %8, %9\n\tv_max3_f32 %1, %1, %10, %11\n\t"
      "v_max3_f32 %0, %0, %12, %13\n\tv_max3_f32 %1, %1, %14, %15\n\tv_max3_f32 %0, %0, %16, %17\n\tv_max3_f32 %0, %0, %1, %18"
      : "=&v"(a), "=&v"(b)
      : "v"(p[0]), "v"(p[1]), "v"(p[2]), "v"(p[3]), "v"(p[4]), "v"(p[5]), "v"(p[6]), "v"(p[7]), "v"(p[8]), "v"(p[9]), "v"(p[10]), "v"(p[11]), "v"(p[12]), "v"(p[13]), "v"(p[14]), "v"(p[15]), "v"(prev));
  return a;
}
__device__ __forceinline__ void attn_unit(const GAS unsigned char* __restrict__ Qb, const GAS unsigned char* __restrict__ Kh, const GAS unsigned char* __restrict__ Vh,
                                          GAS unsigned short* __restrict__ Ob, int ldo, int seq, LAS char* lds, int tid) {
  const int wid = tid >> 6, lane = tid & 63, r32 = lane & 31, hi = lane >> 5;
  LAS char* V_lds = lds + LDS_V; LAS char* K_lds = lds + LDS_K;
  f32x16 o[3] = {}; f32x16 negm = {};
  const GAS unsigned char* Qw = Qb + (long)(wid * QBLK + r32) * 128 + hi * 32;
  i32x8 q0, q1;
  { const u32x4 a = *reinterpret_cast<const GAS u32x4*>(Qw), b = *reinterpret_cast<const GAS u32x4*>(Qw + 16), c = *reinterpret_cast<const GAS u32x4*>(Qw + 64), d = *reinterpret_cast<const GAS u32x4*>(Qw + 80);
    q0 = (i32x8){(int)a[0], (int)a[1], (int)a[2], (int)a[3], (int)b[0], (int)b[1], (int)b[2], (int)b[3]}; q1 = (i32x8){(int)c[0], (int)c[1], (int)c[2], (int)c[3], (int)d[0], (int)d[1], (int)d[2], (int)d[3]}; }
  const int vst = (tid >> 3) * 80 + (tid & 7) * 8;
  const int kst0 = (tid >> 3) * 144 + (tid & 7) * 16;
  const GAS unsigned char* Ku = (const GAS unsigned char*)(((unsigned long long)(unsigned)__builtin_amdgcn_readfirstlane((unsigned)((unsigned long long)Kh >> 32)) << 32) | (unsigned long long)(unsigned)__builtin_amdgcn_readfirstlane((unsigned)(unsigned long long)Kh));
  const GAS unsigned char* Vu = (const GAS unsigned char*)(((unsigned long long)(unsigned)__builtin_amdgcn_readfirstlane((unsigned)((unsigned long long)Vh >> 32)) << 32) | (unsigned long long)(unsigned)__builtin_amdgcn_readfirstlane((unsigned)(unsigned long long)Vh));
  const unsigned ko = (unsigned)tid * 16u, vo = (unsigned)tid * 8u;
  bf16x8 sk; v2u sv;
#define SLOAD(t) do { sk = *reinterpret_cast<const GAS bf16x8*>(Ku + (size_t)(t) * (KVBLK * 128) + ko); sv = *reinterpret_cast<const GAS v2u*>(Vu + (size_t)(t) * 4096 + vo); } while (0)
#define SWRITE(t) do { *(LAS bf16x8*)(K_lds + ((t) & 7) * SHM_K + kst0) = sk; *(LAS v2u*)(V_lds + ((t) & 7) * SHM_V + vst) = sv; } while (0)
#define KS(t) (K_lds + ((t) & 7) * SHM_K)
#define VS(t) (V_lds + ((t) & 7) * SHM_V)
#define RESC(flag, a) do { if (flag) { PV_DRAIN(); _Pragma("unroll") for (int d = 0; d < 3; ++d) _Pragma("unroll") for (int r = 0; r < 16; ++r) o[d][r] *= (a); } } while (0)
#define PSM_TAIL(N0, N1, pm) do { \
    if (__builtin_expect(__any((pm) > THR2), 0)) { float pmax = (pm);     \
      { auto rr = __builtin_amdgcn_permlane32_swap(__float_as_uint(pmax), __float_as_uint(pmax), false, false); pmax = fmaxf(__uint_as_float(rr[0]), __uint_as_float(rr[1])); } \
      const float dl = fmaxf(pmax, 0.f); \
      _Pragma("unroll") for (int r = 0; r < 16; ++r) { N0[r] -= dl; N1[r] -= dl; negm[r] -= dl; } \
      const float al = __builtin_amdgcn_exp2f(-dl); RESC(true, al); } } while (0)
#define HI(j, C0, C1, N0, N1, DO_BAR, DO_QK, DO_KR, DO_SW, DO_SL) do { \
    if (DO_BAR) __syncthreads(); \
    if (DO_SW) SWRITE((j) + 4); \
    if (DO_SL) SLOAD((j) + 5); \
    SBAR(); \
    if (DO_QK) { QK_A(N0, kf.k00, q0); SBAR(); } \
    EXPS(C0, 0, 7); SBAR(); \
    if (DO_QK) { QK_B(N1, kf.k10, q0); SBAR(); } \
    EXPS(C0, 7, 14); SBAR(); \
    if (DO_QK) { QK_C(N0, kf.k01, q1); SBAR(); } \
    EXPS(C0, 14, 16); CVT4(C0, 0, pb[0]); CVT4(C0, 1, pb[1]); CVT4(C0, 2, pb[2]); EXPS(C1, 0, 2); SBAR(); \
    if (DO_QK) { QK_C(N1, kf.k11, q1); SBAR(); } \
    { const LAS char* vp = VS(j) + r32 * 80 + hi * 32; va = ld32(vp); vb = ld32(vp + 32 * 80); } \
    EXPS(C1, 2, 9); SBAR(); \
    EXPS(C1, 9, 16); CVT4(C0, 3, pb[3]); CVT4(C1, 0, pb[4]); CVT4(C1, 1, pb[5]); CVT4(C1, 2, pb[6]); CVT4(C1, 3, pb[7]); SBAR(); \
    PV_A(o[0], va); SBAR(); \
    float pm_ = 0.f; if (DO_QK) { pm_ = max16(N0, N0[15]); SBAR(); } \
    PV_B(o[1], vb); SBAR(); \
    if (DO_KR) { qkt_load(kf, KS((j) + 2), r32, hi); SBAR(); } \
    if (DO_QK) { pm_ = max16(N1, pm_); SBAR(); } \
    PV_B(o[2], ones); SBAR(); \
    if (DO_QK) PSM_TAIL(N0, N1, pm_); \
  } while (0)
  i32x8 ones = {0x38383838, 0x38383838, 0x38383838, 0x38383838, 0x38383838, 0x38383838, 0x38383838, 0x38383838};
  asm volatile("" : "+v"(ones));
  f32x16 pA0, pA1, pB0, pB1; i32x8 pb, va, vb; KFrag kf; const int NT = seq / KVBLK;
  SLOAD(0); SWRITE(0); SLOAD(1); SWRITE(1); SLOAD(2); SWRITE(2); SLOAD(3); SWRITE(3); if (NT > 4) SLOAD(4);
  __syncthreads();
  { float al0; qkt(pA0, pA1, KS(0), q0, q1, negm, r32, hi); QK_DRAIN(pA0, pA1); (void)partialSM<true>(pA0, pA1, negm, al0); }
  qkt_load(kf, KS(1), r32, hi);
  int j = 0;
  for (; j + 6 < NT; j += 2) {
    HI(j, pA0, pA1, pB0, pB1, true, true, true, true, true);
    HI(j + 1, pB0, pB1, pA0, pA1, false, true, true, true, true);
  }
  for (; j < NT; j += 2) {
    HI(j, pA0, pA1, pB0, pB1, true, true, (j + 2 < NT), (j + 4 < NT), (j + 5 < NT));
    HI(j + 1, pB0, pB1, pA0, pA1, false, (j + 2 < NT), (j + 3 < NT), (j + 5 < NT), (j + 6 < NT));
  }
#undef KS
#undef VS
  PV_DRAIN();
  const float rl = __builtin_amdgcn_rcpf(o[2][0]);
  GAS unsigned short* Ow = Ob + (long)(wid * QBLK + r32) * ldo + 4 * hi;
#pragma unroll
  for (int d0 = 0; d0 < 2; ++d0)
#pragma unroll
    for (int g = 0; g < 4; ++g) { unsigned long long w = (unsigned long long)cvtpk(o[d0][4 * g] * rl, o[d0][4 * g + 1] * rl) | ((unsigned long long)cvtpk(o[d0][4 * g + 2] * rl, o[d0][4 * g + 3] * rl) << 32);
      *(GAS unsigned long long*)(Ow + d0 * 32 + g * 8) = w; }
  __syncthreads();
#undef SLOAD
#undef SWRITE
#undef RESC
#undef HI
#undef PSM_TAIL
}
#undef KSWZ
}

constexpr size_t WS_ROPE = WS_SMALL;
constexpr size_t WS_RSQ = WS_SMALL + 704 * 1024, WS_RSKV = WS_RSQ + (size_t)MR * 4;
static_assert(WS_RSKV + (size_t)MR * 4 <= WS_WIN, "small map");
constexpr size_t WS_QC = WS_Q + (size_t)NBATCH * 8 * SEQ * 128;
constexpr float MLA_QS = 4.f, MLA_KS = 0.25f;
static_assert(WS_QC + (size_t)NBATCH * 8 * CTXL * 128 <= WS_K && WS_K + (size_t)NBATCH * 8 * 16640 * 128 <= WS_V, "q8/k8 map");
constexpr float MLA_C2 = 0.10206207261596575f * 1.4426950408889634f;

__device__ __forceinline__ void p0_rope_table(const Frame& F0) { const Frame F = launder(F0);
    GAS float* T = (GAS float*)(F.ws + WS_ROPE);
    for (int i = blockIdx.x * NTHR + F.tid; i < 256 * 8; i += F.G * NTHR) {
        const int pos = i >> 3, e = i & 7;
        double inv = 1.0; for (int k = 0; k < (e >> 1); ++k) inv *= 0.1; if (e & 1) inv *= 0.31622776601683794;
        double rev = (double)pos * inv * 0.15915494309189535; rev -= (double)(long long)rev;
        T[2 * i] = __builtin_amdgcn_cosf((float)rev); T[2 * i + 1] = __builtin_amdgcn_sinf((float)rev);
    }
}
__device__ __forceinline__ void p_prep_mla_rows(const Frame& F0) { const Frame F = launder(F0);
    const GAS bf16* PH = (const GAS bf16*)(F.ws + WS_PH);
    GAS float* RSQ = (GAS float*)(F.ws + WS_RSQ); GAS float* RSKV = (GAS float*)(F.ws + WS_RSKV); const GAS float* T = (const GAS float*)(F.ws + WS_ROPE);
    for (int m = F.gw; m < MR; m += F.ngw) {
        const GAS bf16* row = PH + (size_t)m * NPH;
        const unsigned long long q4 = *((const GAS unsigned long long*)(row + PH_CQ) + F.lane);
        float a0 = bf2f((unsigned short)q4), a1 = bf2f((unsigned short)(q4 >> 16)), a2 = bf2f((unsigned short)(q4 >> 32)), a3 = bf2f((unsigned short)(q4 >> 48));
        const float sq = wave_sum(a0 * a0 + a1 * a1 + a2 * a2 + a3 * a3);
        float skv = 0.f, x = 0.f;
        if (F.lane < 32) { const unsigned long long k4 = *((const GAS unsigned long long*)(row + PH_CKV) + F.lane);
            a0 = bf2f((unsigned short)k4); a1 = bf2f((unsigned short)(k4 >> 16)); a2 = bf2f((unsigned short)(k4 >> 32)); a3 = bf2f((unsigned short)(k4 >> 48));
            skv = a0 * a0 + a1 * a1 + a2 * a2 + a3 * a3; x = bf2f(row[PH_KR + F.lane]); }
        skv = wave_sum(skv);
        if (F.lane == 0) { RSQ[m] = 1.f / sqrtf(sq * (1.f / 256.f) + RMS_EPS); RSKV[m] = 1.f / sqrtf(skv * (1.f / 128.f) + RMS_EPS); }
        const float xp = __shfl_xor(x, 8);
        int b, pos; float y = x;
        if (m < TL) { b = m >> 14; const int t = m & (SEQ - 1); pos = CTXL + t;
            const int i = F.lane & 31, half = i >> 4, w = i & 15, p = half ? (t & 63) : (t >> 6); const float c = T[(p * 8 + (w & 7)) * 2], s = T[(p * 8 + (w & 7)) * 2 + 1];
            y = (w < 8) ? (x * c - xp * s) : (xp * s + x * c); }
        else { b = (m - TL) >> 8; pos = (m - TL) & 255; }
        { const unsigned char yb = (unsigned char)(pk4_fp8(F.lane < 32 ? y * MLA_KS : 0.f, 0.f, 0.f, 0.f) & 0xffu);
          GAS unsigned char* K8 = F.ws + WS_K; GAS unsigned char* Q8 = m < TL ? F.ws + WS_Q : F.ws + WS_QC; const int qrows = m < TL ? SEQ : CTXL, qt = m < TL ? (m & (SEQ - 1)) : pos;
#pragma unroll
          for (int h = 0; h < 8; ++h) { K8[((size_t)(b * 8 + h) * att::NKEY + pos) * 128 + 64 + F.lane] = yb;
              if (F.lane >= 32) Q8[((size_t)(b * 8 + h) * qrows + qt) * 128 + 64 + F.lane] = 0; } }
    }
}
struct EpiMlaQ {
    static constexpr bool PERM = true, AFTER_DRAIN = false;
    GAS unsigned char* Q; GAS unsigned char* QC; const GAS float* rsq; const GAS float* rope;
    __device__ __forceinline__ void operator()(const pg8::f32x4 (&acc)[2][2][4][2], const Unit& u, int wr, int wc, int fr, int fq) const {
        const bool lat = u.pm < TL / 256;
        const int b = lat ? (u.pm >> 6) : (u.pm - TL / 256), t0 = lat ? (u.pm & 63) * 256 : 0, rows = lat ? SEQ : CTXL;
        GAS unsigned char* base = lat ? Q : QC;
        const unsigned lane_off = (unsigned)((wr * 64 + fr) * 128 + 8 * fq);
        const GAS float* rsp = rsq + u.pm * 256 + wr * 64 + fr;
#pragma unroll
        for (int ai = 0; ai < 2; ++ai)
#pragma unroll
            for (int m = 0; m < 4; ++m) { const float rs = rsp[ai * 128 + m * 16] * (MLA_C2 * MLA_QS);
                const int trow = t0 + ai * 128 + m * 16;
#pragma unroll
                for (int bj = 0; bj < 2; ++bj) { const int g32 = 8 * u.pn + 4 * bj + wc, head = g32 / 3, part = g32 - 3 * head;
                    float x[8];
#pragma unroll
                    for (int i = 0; i < 4; ++i) { x[i] = acc[ai][bj][m][0][i] * rs; x[4 + i] = acc[ai][bj][m][1][i] * rs; }
                    if (part == 2 && lat) {
                        const int p = (fq < 2) ? ((trow >> 6) + wr) : (m * 16 + fr); const GAS f32x4* cs = (const GAS f32x4*)(rope + p * 16);
#pragma unroll
                        for (int i2 = 0; i2 < 4; ++i2) { const f32x4 c4 = cs[i2];
                            const float xa = __shfl_xor(x[2 * i2], 16), xb = __shfl_xor(x[2 * i2 + 1], 16);
                            x[2 * i2] = (fq & 1) ? (xa * c4.y + x[2 * i2] * c4.x) : (x[2 * i2] * c4.x - xa * c4.y);
                            x[2 * i2 + 1] = (fq & 1) ? (xb * c4.w + x[2 * i2 + 1] * c4.z) : (x[2 * i2 + 1] * c4.z - xb * c4.w); }
                    }
                    v2u w; w.x = pk4_fp8(x[0], x[1], x[2], x[3]); w.y = pk4_fp8(x[4], x[5], x[6], x[7]);
                    const size_t soff = (((size_t)(b * 8 + head) * rows + trow) * 128 + part * 32);
                    *(GAS v2u*)(base + soff + lane_off) = w; }
                asm volatile("" ::: "memory"); }
    }
};
struct EpiMlaKV {
    static constexpr bool PERM = true, AFTER_DRAIN = false;
    GAS unsigned char* K; GAS bf16* V; const GAS float* rskv;
    __device__ __forceinline__ void operator()(const pg8::f32x4 (&acc)[2][2][4][2], const Unit& u, int wr, int wc, int fr, int fq) const {
        const bool lat = u.pm < TL / 256;
        const int b = lat ? (u.pm >> 6) : (u.pm - TL / 256), pos0 = lat ? CTXL + (u.pm & 63) * 256 : 0;
        const bool isk = wc < 2;
        const unsigned lane_off = isk ? (unsigned)((wr * 64 + fr) * 128 + 32 * (wc & 1) + 8 * fq) : (unsigned)(((wr * 64 + fr) * 64 + 32 * (wc & 1) + 8 * fq) * 2);
        const GAS float* rsp = rskv + u.pm * 256 + wr * 64 + fr;
#pragma unroll
        for (int ai = 0; ai < 2; ++ai)
#pragma unroll
            for (int m = 0; m < 4; ++m) { const float rs = rsp[ai * 128 + m * 16];
#pragma unroll
                for (int bj = 0; bj < 2; ++bj) { const int head = 2 * u.pn + bj;
                    const size_t rk = (size_t)(b * 8 + head) * att::NKEY + pos0 + ai * 128 + m * 16;
                    if (isk) { const pg8::f32x4 v0 = acc[ai][bj][m][0] * (rs * MLA_KS), v1 = acc[ai][bj][m][1] * (rs * MLA_KS);
                        v2u w; w.x = pk4_fp8(v0[0], v0[1], v0[2], v0[3]); w.y = pk4_fp8(v1[0], v1[1], v1[2], v1[3]);
                        *(GAS v2u*)(K + rk * 128 + lane_off) = w; }
                    else { const pg8::f32x4 v0 = acc[ai][bj][m][0] * rs, v1 = acc[ai][bj][m][1] * rs;
                        v4u w; w.x = pk2(v0[0], v0[1]); w.y = pk2(v0[2], v0[3]); w.z = pk2(v1[0], v1[1]); w.w = pk2(v1[2], v1[3]);
                        *(GAS v4u*)((GAS char*)V + rk * 128 + lane_off) = w; } }
                asm volatile("" ::: "memory"); }
    }
};
constexpr size_t WS_V8T = WS_QC + (size_t)NBATCH * 8 * CTXL * 128;
static_assert(WS_V8T + (size_t)NBATCH * 8 * (att::NKEY / 64) * 4096 <= WS_K, "v8t map");
__device__ __forceinline__ void p_attn_vt_pack(const Frame& F0) { const Frame F = launder(F0);
    LAS unsigned short* VL = (LAS unsigned short*)F.lds; const int tid = F.tid;
    const GAS bf16* V = (const GAS bf16*)(F.ws + WS_V); GAS unsigned char* V8T = F.ws + WS_V8T;
    const int ntile = att::NKEY / 64;
    for (int u = blockIdx.x; u < NBATCH * 8 * ntile; u += F.G) {
        const int bh = u / ntile, t = u % ntile;
        { const int key = tid >> 3, c8 = (tid & 7) * 8; const v4u w = *(const GAS v4u*)(V + ((size_t)bh * att::NKEY + t * 64 + key) * 64 + c8);
          LAS unsigned short* d = VL + key * 66 + c8; d[0] = (unsigned short)w.x; d[1] = (unsigned short)(w.x >> 16); d[2] = (unsigned short)w.y; d[3] = (unsigned short)(w.y >> 16);
          d[4] = (unsigned short)w.z; d[5] = (unsigned short)(w.z >> 16); d[6] = (unsigned short)w.w; d[7] = (unsigned short)(w.w >> 16); }
        __syncthreads();
        { const int v = tid >> 3, s8 = (tid & 7) * 8; float x[8];
#pragma unroll
          for (int e = 0; e < 8; ++e) { const int slot = s8 + e, hi = slot >> 5, j = slot & 31, jj = j & 15, key = (j >> 4) * 32 + (jj & 3) + 8 * (jj >> 2) + 4 * hi; x[e] = bf2f(VL[key * 66 + v]); }
          v2u o; o.x = pk4_fp8(x[0], x[1], x[2], x[3]); o.y = pk4_fp8(x[4], x[5], x[6], x[7]);
          *(GAS v2u*)(V8T + (size_t)u * 4096 + v * 64 + s8) = o; }
        __syncthreads();
    }
}
__device__ __forceinline__ void p_attention(const Frame& F0, bool with_ctx) { const Frame F = launder(F0);
    const GAS unsigned char* Q = F.ws + WS_Q; const GAS unsigned char* QC = F.ws + WS_QC; const GAS unsigned char* K = F.ws + WS_K; const GAS unsigned char* V8T = F.ws + WS_V8T;
    GAS bf16* Y = (GAS bf16*)(F.ws + WS_Y);
    LAS char* lds = (LAS char*)F.lds;
    const int nlat = NBATCH * 8 * (SEQ / 256);
    for (int i = 0;; ++i) {
        const int L = i * F.G + (int)blockIdx.x; if (L >= nlat) break;
        int bh, qb;
        if (F.G == 256) { const int xcd = blockIdx.x & 7, slot = blockIdx.x >> 3; bh = xcd + 8 * (i >> 1); qb = (i & 1) * 32 + slot; }
        else { bh = L / (SEQ / 256); qb = L % (SEQ / 256); }
        const int b = bh >> 3, h = bh & 7;
        att::attn_unit(Q + ((size_t)bh * SEQ + qb * 256) * 128, K + (size_t)bh * att::NKEY * 128, V8T + (size_t)bh * (att::NKEY / 64) * 4096,
                       Y + ((size_t)b * SEQ + qb * 256) * D + 512 + h * 64, D, att::NKEY, lds, F.tid);
    }
    if (with_ctx && (int)blockIdx.x < NBATCH * 8) { const int bh = blockIdx.x, b = bh >> 3, h = bh & 7;
        att::attn_unit(QC + (size_t)bh * CTXL * 128, K + (size_t)bh * att::NKEY * 128, V8T + (size_t)bh * (att::NKEY / 64) * 4096,
                       Y + ((size_t)TL + b * CTXL) * D + 512 + h * 64, D, CTXL, lds, F.tid);
    }
}
__device__ __forceinline__ void p_ynorm_c(const Frame& F0, int nrows, const GAS float* mg) { const Frame F = launder(F0);
    GAS bf16* Y = (GAS bf16*)(F.ws + WS_Y);
    for (int m = F.gw; m < nrows; m += F.ngw) {
        GAS v4u* p = (GAS v4u*)(Y + (size_t)m * D + 512) + F.lane; const v4u w = *p;
        float x[8]; x[0] = bf2f((unsigned short)w.x); x[1] = bf2f((unsigned short)(w.x >> 16)); x[2] = bf2f((unsigned short)w.y); x[3] = bf2f((unsigned short)(w.y >> 16));
        x[4] = bf2f((unsigned short)w.z); x[5] = bf2f((unsigned short)(w.z >> 16)); x[6] = bf2f((unsigned short)w.w); x[7] = bf2f((unsigned short)(w.w >> 16));
        float s = 0.f;
#pragma unroll
        for (int i = 0; i < 8; ++i) s += x[i] * x[i];
        const float rs = 1.f / sqrtf(wave_sum(s) * (1.f / 512.f) + RMS_EPS);
        const f32x4 g0 = ((const GAS f32x4*)mg)[2 * F.lane], g1 = ((const GAS f32x4*)mg)[2 * F.lane + 1];
        v4u o; o.x = pk2(x[0] * rs * g0.x, x[1] * rs * g0.y); o.y = pk2(x[2] * rs * g0.z, x[3] * rs * g0.w); o.z = pk2(x[4] * rs * g1.x, x[5] * rs * g1.y); o.w = pk2(x[6] * rs * g1.z, x[7] * rs * g1.w);
        *p = o;
    }
}

constexpr int GLA_NCH = 4 + SEQ / 64;
constexpr size_t WS_SLOC = WS_XN, WS_GDEC = AB + 521 * MiB;
static_assert(WS_SLOC + (size_t)NBATCH * 4 * 2 * GLA_NCH * 2048 * 4 <= WS_XN + 33 * MiB && (size_t)NBATCH * 4 * 2 * GLA_NCH * 32 * 4 <= 5 * MiB && GLA_NCH % 20 == 0, "gla map");
constexpr int GB_LA = 0, GB_K = GB_LA + 16384, GB_Q = GB_K + 8192, GB_ALR = GB_Q + 8192, GB_WG = GB_ALR + 8192, GB_BG = GB_WG + 4096, GB_O = GB_BG + 256,
              GB_QF = GB_O + 64 * 65 * 4, GB_QB = GB_QF + 5120, GB_KF = GB_QB + 5120, GB_KB = GB_KF + 5120, GB_KTF = GB_KB + 5120, GB_KTB = GB_KTF + 4608, GB_VT = GB_KTB + 4608,
              GB_ATT = GB_VT + 9216, GB_STF = GB_ATT + 9216, GB_STB = GB_STF + 5120, GB_END = GB_STB + 5120;
static_assert(GB_END <= 131072 && GB_QF % 16 == 0, "gla lds");
typedef short gbf16x8 __attribute__((ext_vector_type(8)));
typedef float gf32x16 __attribute__((ext_vector_type(16)));
__device__ __forceinline__ float logsigmoidf(float z) { return fminf(z, 0.f) - __logf(1.f + __expf(-fabsf(z))); }
__device__ __forceinline__ unsigned short bf1(float x) { return (unsigned short)(pk2(x, x) & 0xffffu); }
__device__ __forceinline__ void ld8bf(const GAS bf16* p, LAS float* d) { const v4u w = *(const GAS v4u*)p;
    d[0] = bf2f((unsigned short)w.x); d[1] = bf2f((unsigned short)(w.x >> 16)); d[2] = bf2f((unsigned short)w.y); d[3] = bf2f((unsigned short)(w.y >> 16));
    d[4] = bf2f((unsigned short)w.z); d[5] = bf2f((unsigned short)(w.z >> 16)); d[6] = bf2f((unsigned short)w.w); d[7] = bf2f((unsigned short)(w.w >> 16)); }
__device__ __forceinline__ int gcrow(int r, int hi) { return (r & 3) + 8 * (r >> 2) + 4 * hi; }
template <int KD>
__device__ __forceinline__ void gmm(gf32x16& acc, const LAS unsigned char* A, int sa, int m0, const LAS unsigned char* BT, int sb, int n0, int r32, int hi) {
#pragma unroll
    for (int kt = 0; kt < KD / 16; ++kt) { const gbf16x8 a = *(const LAS gbf16x8*)(A + (m0 + r32) * sa + (kt * 16 + hi * 8) * 2), b = *(const LAS gbf16x8*)(BT + (n0 + r32) * sb + (kt * 16 + hi * 8) * 2);
        acc = __builtin_amdgcn_mfma_f32_32x32x16_bf16(a, b, acc, 0, 0, 0); }
}
struct GlaRegs { v4u kq, al, vv; float w0, w1, bg; };
__device__ __forceinline__ int gla_row0(int b, int jj) { return jj < 4 ? TL + b * CTXL + jj * 64 : b * SEQ + (jj - 4) * 64; }
__device__ __forceinline__ void st8bf(const v4u w, LAS float* d) {
    d[0] = bf2f((unsigned short)w.x); d[1] = bf2f((unsigned short)(w.x >> 16)); d[2] = bf2f((unsigned short)w.y); d[3] = bf2f((unsigned short)(w.y >> 16));
    d[4] = bf2f((unsigned short)w.z); d[5] = bf2f((unsigned short)(w.z >> 16)); d[6] = bf2f((unsigned short)w.w); d[7] = bf2f((unsigned short)(w.w >> 16)); }
__device__ __forceinline__ void gla_issue(const Frame& F, int l, int b, int h, int jj, bool want_q, GlaRegs& R) {
    const int tid = F.tid;
    const GAS bf16* PH = (const GAS bf16*)(F.ws + WS_PH) + (size_t)gla_row0(b, jj) * NPH;
    { const int t = (tid & 255) >> 2, c = (tid & 3) * 8;
      if (tid < 256) { R.kq = *(const GAS v4u*)(PH + (size_t)t * NPH + PH_KA + h * 32 + c); R.al = *(const GAS v4u*)(PH + (size_t)t * NPH + PH_ALR + c); }
      else if (want_q) R.kq = *(const GAS v4u*)(PH + (size_t)t * NPH + PH_QA + h * 32 + c); }
    { const int t = tid >> 3, c = (tid & 7) * 8; R.vv = *(const GAS v4u*)(PH + (size_t)t * NPH + PH_VA + h * 64 + c); }
    { const GAS float* wg = F.in[I_GWG] + (size_t)l * 2 * 16 * 128;
      { const int i = tid, d = i >> 9, r = (i >> 5) & 15, k = i & 31; R.w0 = wg[(d * 16 + r) * 128 + h * 32 + k]; }
      { const int i = tid + 512, d = i >> 9, r = (i >> 5) & 15, k = i & 31; R.w1 = wg[(d * 16 + r) * 128 + h * 32 + k]; }
      if (tid < 64) R.bg = F.in[I_GBG][l * 256 + (tid >> 5) * 128 + h * 32 + (tid & 31)]; }
}
__device__ __forceinline__ void gla_head(const Frame& F, bool want_q, const GlaRegs& R) {
    LAS unsigned char* LB = F.lds; LAS float* LA = (LAS float*)(LB + GB_LA); LAS float* KK = (LAS float*)(LB + GB_K); LAS float* QQ = (LAS float*)(LB + GB_Q); LAS float* ALR = (LAS float*)(LB + GB_ALR);
    LAS float* WG = (LAS float*)(LB + GB_WG); LAS float* BG = (LAS float*)(LB + GB_BG); LAS unsigned short* VT = (LAS unsigned short*)(LB + GB_VT);
    const int tid = F.tid;
    { const int t = (tid & 255) >> 2, c = (tid & 3) * 8;
      if (tid < 256) { st8bf(R.kq, KK + t * 32 + c); st8bf(R.al, ALR + t * 32 + c); }
      else if (want_q) st8bf(R.kq, QQ + t * 32 + c); }
    { const int t = tid >> 3, c = (tid & 7) * 8; const v4u w = R.vv;
      VT[(c + 0) * 72 + t] = (unsigned short)w.x; VT[(c + 1) * 72 + t] = (unsigned short)(w.x >> 16); VT[(c + 2) * 72 + t] = (unsigned short)w.y; VT[(c + 3) * 72 + t] = (unsigned short)(w.y >> 16);
      VT[(c + 4) * 72 + t] = (unsigned short)w.z; VT[(c + 5) * 72 + t] = (unsigned short)(w.z >> 16); VT[(c + 6) * 72 + t] = (unsigned short)w.w; VT[(c + 7) * 72 + t] = (unsigned short)(w.w >> 16); }
    { WG[tid] = R.w0; WG[tid + 512] = R.w1; if (tid < 64) BG[tid] = R.bg; }
    __syncthreads();
    { const int k = tid & 31, t0 = tid >> 5;
#pragma unroll
      for (int d = 0; d < 2; ++d)
#pragma unroll
        for (int tt = 0; tt < 4; ++tt) { const int t = t0 + 16 * tt; float z = BG[d * 32 + k];
#pragma unroll
            for (int r = 0; r < 16; ++r) z += ALR[t * 32 + d * 16 + r] * WG[(d * 16 + r) * 32 + k];
            LA[(d * 64 + t) * 32 + k] = logsigmoidf(z) * (1.f / 16.f); } }
    __syncthreads();
    { const int w = tid >> 6, lane = tid & 63;
#pragma unroll
      for (int c = 0; c < 8; ++c) { const int col = w * 8 + c, d = col >> 5, k = col & 31; float v = LA[(d * 64 + lane) * 32 + k];
#pragma unroll
          for (int o = 1; o < 64; o <<= 1) { const float u = d == 0 ? __shfl_up(v, o) : __shfl_down(v, o); if (d == 0 ? lane >= o : lane + o < 64) v += u; }
          LA[(d * 64 + lane) * 32 + k] = v; } }
    __syncthreads();
}
__device__ __forceinline__ void gla_issue_kqv(const Frame& F, int b, int h, int jj, GlaRegs& R) {
    const int tid = F.tid;
    const GAS bf16* PH = (const GAS bf16*)(F.ws + WS_PH) + (size_t)gla_row0(b, jj) * NPH;
    { const int t = (tid & 255) >> 2, c = (tid & 3) * 8;
      R.kq = *(const GAS v4u*)(PH + (size_t)t * NPH + (tid < 256 ? PH_KA : PH_QA) + h * 32 + c); }
    { const int t = tid >> 3, c = (tid & 7) * 8; R.vv = *(const GAS v4u*)(PH + (size_t)t * NPH + PH_VA + h * 64 + c); }
}
__device__ __forceinline__ void gla_head_kqv(const Frame& F, const GlaRegs& R) {
    LAS unsigned char* LB = F.lds; LAS float* KK = (LAS float*)(LB + GB_K); LAS float* QQ = (LAS float*)(LB + GB_Q); LAS unsigned short* VT = (LAS unsigned short*)(LB + GB_VT);
    const int tid = F.tid;
    { const int t = (tid & 255) >> 2, c = (tid & 3) * 8; st8bf(R.kq, (tid < 256 ? KK : QQ) + t * 32 + c); }
    { const int t = tid >> 3, c = (tid & 7) * 8; const v4u w = R.vv;
      VT[(c + 0) * 72 + t] = (unsigned short)w.x; VT[(c + 1) * 72 + t] = (unsigned short)(w.x >> 16); VT[(c + 2) * 72 + t] = (unsigned short)w.y; VT[(c + 3) * 72 + t] = (unsigned short)(w.y >> 16);
      VT[(c + 4) * 72 + t] = (unsigned short)w.z; VT[(c + 5) * 72 + t] = (unsigned short)(w.z >> 16); VT[(c + 6) * 72 + t] = (unsigned short)w.w; VT[(c + 7) * 72 + t] = (unsigned short)(w.w >> 16); }
}
__device__ __forceinline__ void p_gla_local(const Frame& F0, int l) { const Frame F = launder(F0);
    LAS unsigned char* LB = F.lds; LAS float* LA = (LAS float*)(LB + GB_LA); LAS float* KK = (LAS float*)(LB + GB_K); const int tid = F.tid;
    LAS unsigned short* KTF = (LAS unsigned short*)(LB + GB_KTF); LAS unsigned short* KTB = (LAS unsigned short*)(LB + GB_KTB);
    GAS float* SLOC = (GAS float*)(F.ws + WS_SLOC); GAS float* GDEC = (GAS float*)(F.ws + WS_GDEC);
    const int wv = tid >> 6, lane = tid & 63, r32 = lane & 31, hi = lane >> 5;
    GlaRegs Rn;
    if ((int)blockIdx.x < NBATCH * 4 * GLA_NCH) { const int u = blockIdx.x; gla_issue(F, l, u / (4 * GLA_NCH), (u / GLA_NCH) & 3, u % GLA_NCH, false, Rn); }
    for (int u = blockIdx.x; u < NBATCH * 4 * GLA_NCH; u += F.G) {
        const int b = u / (4 * GLA_NCH), h = (u / GLA_NCH) & 3, jj = u % GLA_NCH;
        const GlaRegs R = Rn;
        { const int un = u + F.G; if (un < NBATCH * 4 * GLA_NCH) gla_issue(F, l, un / (4 * GLA_NCH), (un / GLA_NCH) & 3, un % GLA_NCH, false, Rn); }
        gla_head(F, false, R);
        { const int t = tid >> 3, d = (tid >> 2) & 1, kg = tid & 3;
          GAS f32x4* dst = (GAS f32x4*)((GAS unsigned char*)(F.ws + WS_Y) + (size_t)(gla_row0(b, jj) + t) * (D * 2) + 512 + h * 256 + d * 128 + kg * 32);
          const LAS f32x4* src = (const LAS f32x4*)(LA + (d * 64 + t) * 32 + kg * 8); dst[0] = src[0]; dst[1] = src[1]; }
        for (int i = tid; i < 2048; i += NTHR) { const int t = i >> 5, k = i & 31; const float kv = KK[i];
            KTF[k * 72 + t] = bf1(kv * __expf(LA[63 * 32 + k] - LA[t * 32 + k]));
            KTB[k * 72 + t] = bf1(kv * __expf(LA[64 * 32 + k] - LA[(64 + t) * 32 + k])); }
        __syncthreads();
        if (wv < 4) { const int dir = wv >> 1, nt = wv & 1; gf32x16 acc = {};
            gmm<64>(acc, LB + (dir ? GB_KTB : GB_KTF), 144, 0, LB + GB_VT, 144, nt * 32, r32, hi);
            GAS float* dst = SLOC + ((size_t)((b * 4 + h) * 2 + dir) * GLA_NCH + jj) * 2048 + nt * 32 + r32;
#pragma unroll
            for (int r = 0; r < 16; ++r) dst[gcrow(r, hi) * 64] = acc[r]; }
        if (tid < 64) { const int d = tid >> 5, kk = tid & 31; GDEC[((size_t)((b * 4 + h) * 2 + d) * GLA_NCH + jj) * 32 + kk] = __expf(d ? LA[64 * 32 + kk] : LA[63 * 32 + kk]); }
        __syncthreads();
    }
}
__device__ __forceinline__ void p_gla_scan(const Frame& F0) { const Frame F = launder(F0);
    GAS float* SLOC = (GAS float*)(F.ws + WS_SLOC); const GAS float* GDEC = (const GAS float*)(F.ws + WS_GDEC);
    if (F.tid < 128) for (int it = blockIdx.x; it < 256; it += F.G) {
        const int chain = it >> 4, e = (it & 15) * 128 + F.tid, k = e >> 6, dir = chain & 1;
        GAS float* sl = SLOC + (size_t)chain * GLA_NCH * 2048 + e; const GAS float* dc = GDEC + (size_t)chain * GLA_NCH * 32 + k;
        float S = 0.f;
        for (int j0 = 0; j0 < GLA_NCH; j0 += 20) { float lv[20], dv[20];
#pragma unroll
            for (int q = 0; q < 20; ++q) { const int j = j0 + q, jx = dir == 0 ? j : (j < 4 ? 3 - j : GLA_NCH + 3 - j); lv[q] = sl[(size_t)jx * 2048]; dv[q] = dc[jx * 32]; }
#pragma unroll
            for (int q = 0; q < 20; ++q) { const int j = j0 + q, jx = dir == 0 ? j : (j < 4 ? 3 - j : GLA_NCH + 3 - j); sl[(size_t)jx * 2048] = S; S = dv[q] * S + lv[q]; } }
    }
}
__device__ __forceinline__ void p_gla_out(const Frame& F0, int l, bool with_ctx) { const Frame F = launder(F0);
    LAS unsigned char* LB = F.lds; LAS float* LA = (LAS float*)(LB + GB_LA); LAS float* KK = (LAS float*)(LB + GB_K); LAS float* QQ = (LAS float*)(LB + GB_Q); LAS float* OO = (LAS float*)(LB + GB_O);
    LAS unsigned short* QF = (LAS unsigned short*)(LB + GB_QF); LAS unsigned short* QB = (LAS unsigned short*)(LB + GB_QB); LAS unsigned short* KF = (LAS unsigned short*)(LB + GB_KF); LAS unsigned short* KB = (LAS unsigned short*)(LB + GB_KB);
    LAS unsigned short* ATT = (LAS unsigned short*)(LB + GB_ATT); LAS unsigned short* STF = (LAS unsigned short*)(LB + GB_STF); LAS unsigned short* STB = (LAS unsigned short*)(LB + GB_STB);
    const int tid = F.tid, wv = tid >> 6, lane = tid & 63, r32 = lane & 31, hi = lane >> 5;
    const GAS float* SLOC = (const GAS float*)(F.ws + WS_SLOC); GAS bf16* Y = (GAS bf16*)(F.ws + WS_Y); const GAS bf16* PHB = (const GAS bf16*)(F.ws + WS_PH);
    const GAS float* gng = F.in[I_GNG] + l * 64;
    constexpr int NU = NBATCH * 4 * GLA_NCH;
    GlaRegs Rn; f32x4 san = {}, scn = {}, la0n = {}, la1n = {}; v4u gwn = {};
#define GLA_PF(u_) do { const int b_ = (u_) / (4 * GLA_NCH), h_ = ((u_) / GLA_NCH) & 3, j_ = (u_) % GLA_NCH; gla_issue_kqv(F, b_, h_, j_, Rn); \
        const GAS float* s0_ = SLOC + ((size_t)((b_ * 4 + h_) * 2 + 0) * GLA_NCH + j_) * 2048; const GAS float* s1_ = SLOC + ((size_t)((b_ * 4 + h_) * 2 + 1) * GLA_NCH + j_) * 2048; \
        san = *(const GAS f32x4*)(s0_ + (tid >> 4) * 64 + (tid & 15) * 4); scn = *(const GAS f32x4*)(s1_ + (tid >> 4) * 64 + (tid & 15) * 4); \
        gwn = *(const GAS v4u*)(PHB + (size_t)(gla_row0(b_, j_) + (tid >> 3)) * NPH + PH_GA + h_ * 64 + (tid & 7) * 8); \
        { const GAS f32x4* la_ = (const GAS f32x4*)((const GAS unsigned char*)(F.ws + WS_Y) + (size_t)(gla_row0(b_, j_) + (tid >> 3)) * (D * 2) + 512 + h_ * 256 + ((tid >> 2) & 1) * 128 + (tid & 3) * 32); la0n = la_[0]; la1n = la_[1]; } } while (0)
#define GLA_SKIP(u_) (((u_) % GLA_NCH) < 4 && !with_ctx)
    int u = blockIdx.x; while (u < NU && GLA_SKIP(u)) u += F.G;
    if (u < NU) GLA_PF(u);
    while (u < NU) {
        const int b = u / (4 * GLA_NCH), h = (u / GLA_NCH) & 3, jj = u % GLA_NCH;
        const GlaRegs R = Rn; const f32x4 a = san, c = scn, la0 = la0n, la1 = la1n; const v4u gw = gwn;
        int un = u + F.G; while (un < NU && GLA_SKIP(un)) un += F.G;
        if (un < NU) GLA_PF(un);
        gla_head_kqv(F, R);
        { LAS f32x4* dl = (LAS f32x4*)(LA + (((tid >> 2) & 1) * 64 + (tid >> 3)) * 32 + (tid & 3) * 8); dl[0] = la0; dl[1] = la1; }
        __syncthreads();
        for (int i = tid; i < 2048; i += NTHR) { const int t = i >> 5, k = i & 31; const float qv = QQ[i] * 0.17677669529663687f, kv = KK[i];
            const float bf_ = LA[t * 32 + k], bb_ = LA[(64 + t) * 32 + k];
            QF[t * 40 + k] = bf1(qv * __expf(bf_)); KF[t * 40 + k] = bf1(kv * __expf(-bf_)); QB[t * 40 + k] = bf1(qv * __expf(bb_)); KB[t * 40 + k] = bf1(kv * __expf(-bb_)); }
        { const int k = tid >> 4, v4 = (tid & 15) * 4;
          STF[(v4 + 0) * 40 + k] = bf1(a.x); STF[(v4 + 1) * 40 + k] = bf1(a.y); STF[(v4 + 2) * 40 + k] = bf1(a.z); STF[(v4 + 3) * 40 + k] = bf1(a.w);
          STB[(v4 + 0) * 40 + k] = bf1(c.x); STB[(v4 + 1) * 40 + k] = bf1(c.y); STB[(v4 + 2) * 40 + k] = bf1(c.z); STB[(v4 + 3) * 40 + k] = bf1(c.w); }
        __syncthreads();
        gf32x16 acc = {};
        const int mt = wv & 1, nt = (wv >> 1) & 1;
        if (wv < 4) {
            gf32x16 af = {}, ab = {};
            gmm<32>(af, LB + GB_QF, 80, mt * 32, LB + GB_KF, 80, nt * 32, r32, hi); gmm<32>(ab, LB + GB_QB, 80, mt * 32, LB + GB_KB, 80, nt * 32, r32, hi);
            const int s = nt * 32 + r32;
#pragma unroll
            for (int r = 0; r < 16; ++r) { const int t = mt * 32 + gcrow(r, hi); const float a = (s <= t ? af[r] : 0.f) + (s >= t ? ab[r] : 0.f); ATT[t * 72 + s] = bf1(a); }
        } else {
            gmm<32>(acc, LB + GB_QF, 80, mt * 32, LB + GB_STF, 80, nt * 32, r32, hi); gmm<32>(acc, LB + GB_QB, 80, mt * 32, LB + GB_STB, 80, nt * 32, r32, hi);
        }
        __syncthreads();
        if (wv >= 4) { gmm<64>(acc, LB + GB_ATT, 144, mt * 32, LB + GB_VT, 144, nt * 32, r32, hi);
#pragma unroll
            for (int r = 0; r < 16; ++r) OO[(mt * 32 + gcrow(r, hi)) * 65 + nt * 32 + r32] = acc[r]; }
        __syncthreads();
        { const int t = tid >> 3, vg = tid & 7; float o8[8], ss = 0.f;
#pragma unroll
          for (int i = 0; i < 8; ++i) { o8[i] = OO[t * 65 + vg * 8 + i]; ss += o8[i] * o8[i]; }
          ss += __shfl_xor(ss, 1); ss += __shfl_xor(ss, 2); ss += __shfl_xor(ss, 4);
          const float rs = 1.f / sqrtf(ss * (1.f / 64.f) + RMS_EPS);
          const int row = gla_row0(b, jj) + t;
          float ga[8]; ga[0] = bf2f((unsigned short)gw.x); ga[1] = bf2f((unsigned short)(gw.x >> 16)); ga[2] = bf2f((unsigned short)gw.y); ga[3] = bf2f((unsigned short)(gw.y >> 16));
          ga[4] = bf2f((unsigned short)gw.z); ga[5] = bf2f((unsigned short)(gw.z >> 16)); ga[6] = bf2f((unsigned short)gw.w); ga[7] = bf2f((unsigned short)(gw.w >> 16));
          float y[8];
#pragma unroll
          for (int i = 0; i < 8; ++i) y[i] = o8[i] * rs * gng[vg * 8 + i] * siluf(ga[i]);
          v4u o; o.x = pk2(y[0], y[1]); o.y = pk2(y[2], y[3]); o.z = pk2(y[4], y[5]); o.w = pk2(y[6], y[7]);
          *(GAS v4u*)(Y + (size_t)row * D + h * 64 + vg * 8) = o; }
        __syncthreads();
        u = un;
    }
#undef GLA_PF
#undef GLA_SKIP
}

constexpr int FN = 32768, FN1 = 128, FN2 = 256;
constexpr size_t WS_FA = WS_XN + 33 * MiB;
constexpr size_t WS_HT = WS_PH;
constexpr size_t WS_FA0 = WS_K, WS_FA1 = WS_VT;
constexpr size_t WS_HID = AB + 521 * MiB, WS_HTC = AB + 526 * MiB, WS_CU = AB + 527 * MiB, WS_OTC = AB + 529 * MiB, WS_NPART = AB + 530 * MiB, WS_END2 = AB + 532 * MiB;
static_assert(WS_FA0 + 64 * MiB <= WS_VT && WS_FA1 + 64 * MiB <= WS_HF && WS_END2 <= 573 * MiB, "hyena map");
constexpr size_t CTL_NRM = 256 * 1024;
constexpr int FFT_TW_OFF = 40960;
typedef float f32x2 __attribute__((ext_vector_type(2)));
__device__ __forceinline__ f32x2 cmul(f32x2 a, f32x2 b) { return (f32x2){a.x * b.x - a.y * b.y, a.x * b.y + a.y * b.x}; }
__device__ __forceinline__ unsigned pkc(f32x2 v) { return pk2(v.x, v.y); }
__device__ __forceinline__ f32x2 upc(unsigned w) { return (f32x2){__uint_as_float(w << 16), __uint_as_float(w & 0xffff0000u)}; }
__device__ __forceinline__ f32x2 twid(float rev) { return (f32x2){__builtin_amdgcn_cosf(rev), __builtin_amdgcn_sinf(rev)}; }
__device__ __forceinline__ float nrm_lat(const Frame& F, int order, int c) {
    LAS float* red = (LAS float*)(F.lds + FFT_TW_OFF + 1024); const GAS float* NP = (const GAS float*)(F.ws + WS_NPART);
    const float v = wave_sum(NP[(size_t)(F.tid & 255) * 1024 + order * 512 + (F.tid >> 8) * 256 + c]);
    __syncthreads(); if (F.lane == 0) red[F.wave] = v; __syncthreads();
    float s = 0.f;
#pragma unroll
    for (int w = 0; w < 8; ++w) s += red[w];
    return 1.f / sqrtf(s + 1e-6f);
}
__device__ __forceinline__ float nrm_ctx(const Frame& F, int order, int c) { const GAS float* NP = (const GAS float*)(F.ws + WS_NPART); float s = 0.f;
#pragma unroll
    for (int pb = 256; pb < 260; ++pb) s += NP[(size_t)pb * 1024 + order * 512 + c] + NP[(size_t)pb * 1024 + order * 512 + 256 + c];
    return 1.f / sqrtf(s + 1e-6f); }

__device__ __forceinline__ void p_filt_hidden(const Frame& F0, int l) { const Frame F = launder(F0);
    LAS float* L = (LAS float*)F.lds; LAS float* W1 = L, * W2 = L + 33 * 64, * H1 = W2 + 64 * 64, * PB = H1 + 128 * 65;
    GAS float* HID = (GAS float*)(F.ws + WS_HID); const int tid = F.tid;
    for (int i = tid; i < 33 * 64; i += NTHR) W1[i] = F.in[I_HW1][l * 33 * 64 + i];
    for (int i = tid; i < 64 * 64; i += NTHR) W2[i] = F.in[I_HW2][l * 64 * 64 + i];
    if (tid < 64) { PB[tid] = F.in[I_HB1][l * 64 + tid]; PB[64 + tid] = F.in[I_HF1][l * 64 + tid]; PB[128 + tid] = F.in[I_HB2][l * 64 + tid]; PB[192 + tid] = F.in[I_HF2][l * 64 + tid]; }
    __syncthreads();
    const int p = tid & 127, jq = tid >> 7;
    for (int blk = blockIdx.x; blk < (SEQ + CTXL) / 128; blk += F.G) {
        const int prow = blk * 128 + p; const bool lat = prow < SEQ; const int pos = lat ? prow : prow - SEQ; const float Lf = lat ? (float)SEQ : (float)CTXL;
        float z[33]; z[0] = (float)pos / (Lf - 1.f);
#pragma unroll
        for (int i = 0; i < 16; ++i) { const float fr = 1e-4f + (float)i * ((15.f - 1e-4f) / 15.f); float rev = (float)pos * fr / Lf; rev -= floorf(rev);
            z[1 + i] = __builtin_amdgcn_cosf(rev); z[17 + i] = -__builtin_amdgcn_sinf(rev); }
        for (int j = jq * 16; j < jq * 16 + 16; ++j) { float a = PB[j];
#pragma unroll
            for (int i = 0; i < 33; ++i) a += z[i] * W1[i * 64 + j];
            H1[p * 65 + j] = __sinf(PB[64 + j] * a); }
        __syncthreads();
        for (int j = jq * 16; j < jq * 16 + 16; ++j) { float a = PB[128 + j];
            for (int i = 0; i < 64; ++i) a += H1[p * 65 + i] * W2[i * 64 + j];
            HID[(size_t)prow * 64 + j] = __sinf(PB[192 + j] * a); }
        __syncthreads();
    }
}
__device__ __forceinline__ void p_filt_raw(const Frame& F0, int l) { const Frame F = launder(F0);
    LAS float* L = (LAS float*)F.lds; LAS float* HS = L, * W3 = L + 64 * 65; const int tid = F.tid;
    const GAS float* HID = (const GAS float*)(F.ws + WS_HID); GAS float* HT = (GAS float*)(F.ws + WS_HT); GAS float* HTC = (GAS float*)(F.ws + WS_HTC);
    const GAS float* w3 = F.in[I_HW3] + (size_t)l * 64 * 1024; const GAS float* b3 = F.in[I_HB3] + l * 1024;
    const int pg = tid & 15, cg = tid >> 4;
    for (int u = blockIdx.x; u < ((SEQ + CTXL) / 64) * 4; u += F.G) {
        const int pb = u >> 2, cb = u & 3, prow0 = pb * 64; const bool lat = prow0 < SEQ; const int pos0 = lat ? prow0 : prow0 - SEQ; const float Lf = lat ? (float)SEQ : (float)CTXL;
        for (int i = tid; i < 64 * 64; i += NTHR) HS[(i >> 6) * 65 + (i & 63)] = HID[(size_t)prow0 * 64 + i];
        for (int i = tid; i < 64 * 256; i += NTHR) W3[i] = w3[(size_t)(i >> 8) * 1024 + cb * 256 + (i & 255)];
        __syncthreads();
        float acc[4][8];
#pragma unroll
        for (int a = 0; a < 4; ++a)
#pragma unroll
            for (int c = 0; c < 8; ++c) acc[a][c] = 0.f;
        for (int i = 0; i < 64; ++i) { const f32x4 w0 = *(const LAS f32x4*)(W3 + i * 256 + cg * 8), w1 = *(const LAS f32x4*)(W3 + i * 256 + cg * 8 + 4);
#pragma unroll
            for (int a = 0; a < 4; ++a) { const float hv = HS[(pg * 4 + a) * 65 + i];
                acc[a][0] += hv * w0.x; acc[a][1] += hv * w0.y; acc[a][2] += hv * w0.z; acc[a][3] += hv * w0.w; acc[a][4] += hv * w1.x; acc[a][5] += hv * w1.y; acc[a][6] += hv * w1.z; acc[a][7] += hv * w1.w; } }
        float ss[8];
#pragma unroll
        for (int c = 0; c < 8; ++c) { const int col = cb * 256 + cg * 8 + c, ch = col & 255; const float delta = 3.0701134573253944f + (float)ch * (12.280453829301578f / 255.f), bias = b3[col];
            float o[4]; ss[c] = 0.f;
#pragma unroll
            for (int a = 0; a < 4; ++a) { const float t = (float)(pos0 + pg * 4 + a) / (Lf - 1.f); o[a] = (acc[a][c] + bias) * __expf(-t * delta); ss[c] += o[a] * o[a]; }
            GAS float* dst = lat ? HT + (size_t)col * SEQ + pos0 + pg * 4 : HTC + (size_t)col * CTXL + pos0 + pg * 4;
            *(GAS f32x4*)dst = (f32x4){o[0], o[1], o[2], o[3]}; }
#pragma unroll
        for (int c = 0; c < 8; ++c) { float s = ss[c]; s += __shfl_xor(s, 1); s += __shfl_xor(s, 2); s += __shfl_xor(s, 4); s += __shfl_xor(s, 8); ss[c] = s; }
        if (pg == 0) { GAS float* np = (GAS float*)(F.ws + WS_NPART) + (size_t)pb * 1024 + cb * 256 + cg * 8;
            *(GAS f32x4*)np = (f32x4){ss[0], ss[1], ss[2], ss[3]}; *(GAS f32x4*)(np + 4) = (f32x4){ss[4], ss[5], ss[6], ss[7]}; }
        __syncthreads();
    }
}
__device__ __forceinline__ void fft_tw_init(LAS unsigned char* lds, int tid) { if (tid < 128) ((LAS f32x2*)(lds + FFT_TW_OFF))[tid] = twid(-(float)tid * (1.f / 256.f)); __syncthreads(); }
__device__ __forceinline__ f32x2 cconj(f32x2 a) { return (f32x2){a.x, -a.y}; }
__device__ __forceinline__ f32x2 mul_mi(f32x2 a) { return (f32x2){a.y, -a.x}; }
__device__ __forceinline__ f32x2 mul_pi(f32x2 a) { return (f32x2){-a.y, a.x}; }
template <int ST>
__device__ __forceinline__ void dif4(LAS f32x2* X, const LAS f32x2* TW, int base, int g, int s) {
    const int h = 1 << s, p = g & ((h >> 1) - 1), i = (((g >> (s - 1)) << (s + 1)) | p);
    LAS f32x2* P0 = X + base + i * ST; LAS f32x2* P1 = P0 + (h >> 1) * ST; LAS f32x2* P2 = P0 + h * ST; LAS f32x2* P3 = P1 + h * ST;
    const f32x2 x0 = *P0, x1 = *P1, x2 = *P2, x3 = *P3, wa = TW[p << (7 - s)], wc = TW[p << (8 - s)];
    const f32x2 y0 = x0 + x2, y2 = cmul(x0 - x2, wa), y1 = x1 + x3, y3 = mul_mi(cmul(x1 - x3, wa));
    *P0 = y0 + y1; *P1 = cmul(y0 - y1, wc); *P2 = y2 + y3; *P3 = cmul(y2 - y3, wc);
}
template <int ST>
__device__ __forceinline__ void dit4(LAS f32x2* X, const LAS f32x2* TW, int base, int g, int s) {
    const int h = 1 << s, p = g & (h - 1), i = (((g >> s) << (s + 2)) | p);
    LAS f32x2* P0 = X + base + i * ST; LAS f32x2* P1 = P0 + h * ST; LAS f32x2* P2 = P1 + h * ST; LAS f32x2* P3 = P2 + h * ST;
    const f32x2 w1 = cconj(TW[p << (7 - s)]), w2 = cconj(TW[p << (6 - s)]);
    const f32x2 x0 = *P0, x1 = cmul(*P1, w1), x2 = *P2, x3 = cmul(*P3, w1);
    const f32x2 y0 = x0 + x1, y1 = x0 - x1, y2 = cmul(x2 + x3, w2), y3 = mul_pi(cmul(x2 - x3, w2));
    *P0 = y0 + y2; *P2 = y0 - y2; *P1 = y1 + y3; *P3 = y1 - y3;
}
__device__ __forceinline__ void fft128_cols_fwd(LAS f32x2* X, int tid) {
    const int j = tid & 31, q0 = tid >> 5; const LAS f32x2* TW = (const LAS f32x2*)((const LAS unsigned char*)X + FFT_TW_OFF);
#pragma unroll 1
    for (int s = 6; s >= 2; s -= 2) { dif4<32>(X, TW, j, q0, s); dif4<32>(X, TW, j, q0 + 16, s); __syncthreads(); }
#pragma unroll
    for (int i = 0; i < 4; ++i) { const int q = q0 + 16 * i; const f32x2 a = X[(2 * q) * 32 + j], b = X[(2 * q + 1) * 32 + j]; X[(2 * q) * 32 + j] = a + b; X[(2 * q + 1) * 32 + j] = a - b; }
    __syncthreads();
}
__device__ __forceinline__ void fft128_cols_inv(LAS f32x2* X, int tid) {
    const int j = tid & 31, q0 = tid >> 5; const LAS f32x2* TW = (const LAS f32x2*)((const LAS unsigned char*)X + FFT_TW_OFF);
#pragma unroll
    for (int i = 0; i < 4; ++i) { const int q = q0 + 16 * i; const f32x2 a = X[(2 * q) * 32 + j], b = X[(2 * q + 1) * 32 + j]; X[(2 * q) * 32 + j] = a + b; X[(2 * q + 1) * 32 + j] = a - b; }
    __syncthreads();
#pragma unroll 1
    for (int s = 1; s <= 5; s += 2) { dit4<32>(X, TW, j, q0, s); dit4<32>(X, TW, j, q0 + 16, s); __syncthreads(); }
}
__device__ __forceinline__ void fft256_rows_fwd(LAS f32x2* X, int tid) {
    const int g = tid & 63, r0 = tid >> 6; const LAS f32x2* TW = (const LAS f32x2*)((const LAS unsigned char*)X + FFT_TW_OFF);
#pragma unroll 1
    for (int s = 7; s >= 1; s -= 2) { dif4<1>(X, TW, r0 * 256, g, s); dif4<1>(X, TW, (r0 + 8) * 256, g, s); __syncthreads(); }
}
__device__ __forceinline__ void fft256_rows_inv(LAS f32x2* X, int tid) {
    const int g = tid & 63, r0 = tid >> 6; const LAS f32x2* TW = (const LAS f32x2*)((const LAS unsigned char*)X + FFT_TW_OFF);
#pragma unroll 1
    for (int s = 0; s <= 6; s += 2) { dit4<1>(X, TW, r0 * 256, g, s); dit4<1>(X, TW, (r0 + 8) * 256, g, s); __syncthreads(); }
}
__device__ __forceinline__ int bitrev7(int r) { return (int)(__brev((unsigned)r) >> 25); }
template <int KIND>
__device__ __forceinline__ void p_fft_pass1(const Frame& F0, int order, size_t ws_a) { const Frame F = launder(F0);
    fft_tw_init(F.lds, F.tid);
    LAS f32x2* X = (LAS f32x2*)F.lds; const int tid = F.tid, j = tid & 31, q0 = tid >> 5;
    const GAS float* VT = (const GAS float*)(F.ws + WS_VT); const GAS float* HT = (const GAS float*)(F.ws + WS_HT); GAS unsigned* A = (GAS unsigned*)(F.ws + ws_a);
    f32x2 pre[8];
#define P1_LOAD(uu) do { const int sg_ = (uu) >> 3, nb_ = (uu) & 7; _Pragma("unroll") for (int i = 0; i < 8; ++i) { const int n1 = q0 + 16 * i, n = 256 * n1 + 32 * nb_ + j; f32x2 v = {0.f, 0.f}; \
        if (KIND == 0) { if (n1 < 64) { v.x = VT[(size_t)(sg_ * 2 + 0) * SEQ + n]; v.y = VT[(size_t)(sg_ * 2 + 1) * SEQ + n]; } } \
        else { const GAS float* hf = HT + (size_t)(order * 512 + sg_) * SEQ; const GAS float* hb = HT + (size_t)(order * 512 + 256 + sg_) * SEQ; \
               if (n < SEQ) v.x = hf[n]; else if (n > SEQ) v.x = hb[2 * SEQ - n]; } \
        pre[i] = v; } } while (0)
    int u = blockIdx.x; if (u < 256 * 8) P1_LOAD(u);
    for (; u < 256 * 8; u += F.G) {
        const int sg = u >> 3, nb = u & 7;
#pragma unroll
        for (int i = 0; i < 8; ++i) X[(q0 + 16 * i) * 32 + j] = pre[i];
        __syncthreads();
        if (u + F.G < 256 * 8) P1_LOAD(u + F.G);
        fft128_cols_fwd(X, tid);
#pragma unroll
        for (int i = 0; i < 8; ++i) { const int r = q0 + 16 * i, k1 = bitrev7(r), n2 = 32 * nb + j;
            A[((size_t)sg * FN1 + r) * FN2 + n2] = pkc(cmul(X[r * 32 + j], twid(-(float)(n2 * k1) * (1.f / (float)FN)))); }
        __syncthreads();
    }
#undef P1_LOAD
}
template <int KIND>
__device__ __forceinline__ void p_fft_pass2(const Frame& F0, int l, int order, size_t ws_a) { const Frame F = launder(F0);
    fft_tw_init(F.lds, F.tid);
    LAS f32x2* X = (LAS f32x2*)F.lds; const int tid = F.tid;
    GAS unsigned* A = (GAS unsigned*)(F.ws + ws_a); GAS unsigned* HF = (GAS unsigned*)(F.ws + WS_HF);
    unsigned pa[8], ph[8];
#define P2_LOAD(uu) do { const int sg_ = (uu) >> 3, g_ = (uu) & 7; const GAS unsigned* Ab_ = A + ((size_t)sg_ * FN1 + g_ * 16) * FN2; const GAS unsigned* Hb_ = HF + ((size_t)(order * 256 + sg_) * FN1 + g_ * 16) * FN2; \
        _Pragma("unroll") for (int i = 0; i < 8; ++i) { pa[i] = Ab_[tid + NTHR * i]; if (KIND == 0) ph[i] = Hb_[tid + NTHR * i]; } } while (0)
    int u = blockIdx.x; if (u < 256 * 8) P2_LOAD(u);
    for (; u < 256 * 8; u += F.G) {
        const int sg = u >> 3, g = u & 7;
        GAS unsigned* Ab = A + ((size_t)sg * FN1 + g * 16) * FN2; GAS unsigned* Hb = HF + ((size_t)(order * 256 + sg) * FN1 + g * 16) * FN2;
        unsigned hcur[8];
#pragma unroll
        for (int i = 0; i < 8; ++i) { X[tid + NTHR * i] = upc(pa[i]); if (KIND == 0) hcur[i] = ph[i]; }
        __syncthreads();
        if (u + F.G < 256 * 8) P2_LOAD(u + F.G);
        fft256_rows_fwd(X, tid);
        if (KIND == 1) { const float nr = nrm_lat(F, order, sg);
#pragma unroll
            for (int i = 0; i < 8; ++i) { const int e = tid + NTHR * i; const f32x2 v = X[e] * nr; const _Float16 hr = (_Float16)v.x, hi = (_Float16)v.y;
                Hb[e] = (unsigned)__builtin_bit_cast(unsigned short, hr) | ((unsigned)__builtin_bit_cast(unsigned short, hi) << 16); }
            __syncthreads();
        } else {
#pragma unroll
            for (int i = 0; i < 8; ++i) { const int e = tid + NTHR * i; const unsigned hw = hcur[i];
                const f32x2 h = {(float)__builtin_bit_cast(_Float16, (unsigned short)(hw & 0xffffu)), (float)__builtin_bit_cast(_Float16, (unsigned short)(hw >> 16))};
                X[e] = cmul(X[e], h); }
            __syncthreads();
            fft256_rows_inv(X, tid);
#pragma unroll
            for (int i = 0; i < 8; ++i) { const int e = tid + NTHR * i, r = g * 16 + (e >> 8), n2 = e & 255, k1 = bitrev7(r);
                Ab[e] = pkc(cmul(X[e], twid((float)(n2 * k1) * (1.f / (float)FN))) * (1.f / (float)FN)); }
            __syncthreads();
        }
    }
#undef P2_LOAD
}
__device__ __forceinline__ void p_fft_pass3(const Frame& F0, int l, int order) { const Frame F = launder(F0);
    fft_tw_init(F.lds, F.tid);
    LAS f32x2* X = (LAS f32x2*)F.lds; const int tid = F.tid, j = tid & 31, q0 = tid >> 5;
    GAS float* VT = (GAS float*)(F.ws + WS_VT); const GAS bf16* GT = (const GAS bf16*)(F.ws + (order == 0 ? WS_X1T : WS_X2T)); const GAS unsigned* A = (const GAS unsigned*)(F.ws + WS_FA);
    const GAS float* skip = F.in[I_HSKIP] + (size_t)(l * 2 + order) * 256;
    unsigned pa[8]; float pv[4][2]; unsigned short pg[4][2];
#define P3_LOAD(uu) do { const int sg_ = (uu) >> 3, nb_ = (uu) & 7; _Pragma("unroll") for (int i = 0; i < 8; ++i) pa[i] = A[((size_t)sg_ * FN1 + q0 + 16 * i) * FN2 + 32 * nb_ + j]; \
        _Pragma("unroll") for (int i = 0; i < 4; ++i) { const int n = 256 * (q0 + 16 * i) + 32 * nb_ + j; const size_t i0 = (size_t)(sg_ * 2 + 0) * SEQ + n, i1 = (size_t)(sg_ * 2 + 1) * SEQ + n; \
            pv[i][0] = VT[i0]; pv[i][1] = VT[i1]; pg[i][0] = GT[i0]; pg[i][1] = GT[i1]; } } while (0)
    int u = blockIdx.x; if (u < 256 * 8) P3_LOAD(u);
    for (; u < 256 * 8; u += F.G) {
        const int sg = u >> 3, nb = u & 7;
        float cv[4][2], cg[4][2];
#pragma unroll
        for (int i = 0; i < 8; ++i) X[(q0 + 16 * i) * 32 + j] = upc(pa[i]);
#pragma unroll
        for (int i = 0; i < 4; ++i) { cv[i][0] = pv[i][0]; cv[i][1] = pv[i][1]; cg[i][0] = bf2f(pg[i][0]); cg[i][1] = bf2f(pg[i][1]); }
        __syncthreads();
        if (u + F.G < 256 * 8) P3_LOAD(u + F.G);
        fft128_cols_inv(X, tid);
        const float sk = skip[sg];
#pragma unroll
        for (int i = 0; i < 4; ++i) { const int n1 = q0 + 16 * i, n = 256 * n1 + 32 * nb + j; const f32x2 y = X[n1 * 32 + j];
            const size_t i0 = (size_t)(sg * 2 + 0) * SEQ + n, i1 = (size_t)(sg * 2 + 1) * SEQ + n;
            VT[i0] = cg[i][0] * (y.x + sk * cv[i][0]); VT[i1] = cg[i][1] * (y.y + sk * cv[i][1]); }
        __syncthreads();
    }
#undef P3_LOAD
}
__device__ __forceinline__ void p_fft_pass31(const Frame& F0, int l) { const Frame F = launder(F0);
    fft_tw_init(F.lds, F.tid);
    LAS f32x2* X = (LAS f32x2*)F.lds; const int tid = F.tid, j = tid & 31, q0 = tid >> 5;
    GAS float* VT = (GAS float*)(F.ws + WS_VT); const GAS bf16* GT = (const GAS bf16*)(F.ws + WS_X1T); GAS unsigned* A = (GAS unsigned*)(F.ws + WS_FA);
    const GAS float* skip = F.in[I_HSKIP] + (size_t)(l * 2 + 0) * 256;
    unsigned pa[8]; float pv[4][2]; unsigned short pg[4][2];
#define P3_LOAD(uu) do { const int sg_ = (uu) >> 3, nb_ = (uu) & 7; _Pragma("unroll") for (int i = 0; i < 8; ++i) pa[i] = A[((size_t)sg_ * FN1 + q0 + 16 * i) * FN2 + 32 * nb_ + j]; \
        _Pragma("unroll") for (int i = 0; i < 4; ++i) { const int n = 256 * (q0 + 16 * i) + 32 * nb_ + j; const size_t i0 = (size_t)(sg_ * 2 + 0) * SEQ + n, i1 = (size_t)(sg_ * 2 + 1) * SEQ + n; \
            pv[i][0] = VT[i0]; pv[i][1] = VT[i1]; pg[i][0] = GT[i0]; pg[i][1] = GT[i1]; } } while (0)
    int u = blockIdx.x; if (u < 256 * 8) P3_LOAD(u);
    for (; u < 256 * 8; u += F.G) {
        const int sg = u >> 3, nb = u & 7;
        float cv[4][2], cg[4][2];
#pragma unroll
        for (int i = 0; i < 8; ++i) X[(q0 + 16 * i) * 32 + j] = upc(pa[i]);
#pragma unroll
        for (int i = 0; i < 4; ++i) { cv[i][0] = pv[i][0]; cv[i][1] = pv[i][1]; cg[i][0] = bf2f(pg[i][0]); cg[i][1] = bf2f(pg[i][1]); }
        __syncthreads();
        if (u + F.G < 256 * 8) P3_LOAD(u + F.G);
        fft128_cols_inv(X, tid);
        const float sk = skip[sg];
#pragma unroll
        for (int i = 0; i < 4; ++i) { const int n1 = q0 + 16 * i, n = 256 * n1 + 32 * nb + j; const f32x2 y = X[n1 * 32 + j];
            const size_t i0 = (size_t)(sg * 2 + 0) * SEQ + n, i1 = (size_t)(sg * 2 + 1) * SEQ + n;
            const f32x2 z = {cg[i][0] * (y.x + sk * cv[i][0]), cg[i][1] * (y.y + sk * cv[i][1])};
            VT[i0] = z.x; VT[i1] = z.y; X[n1 * 32 + j] = z; X[(n1 + 64) * 32 + j] = (f32x2){0.f, 0.f}; }
        __syncthreads();
        fft128_cols_fwd(X, tid);
#pragma unroll
        for (int i = 0; i < 8; ++i) { const int r = q0 + 16 * i, k1 = bitrev7(r), n2 = 32 * nb + j;
            A[((size_t)sg * FN1 + r) * FN2 + n2] = pkc(cmul(X[r * 32 + j], twid(-(float)(n2 * k1) * (1.f / (float)FN)))); }
        __syncthreads();
    }
#undef P3_LOAD
}
__device__ __forceinline__ void p_hy_shortconv(const Frame& F0, int l) { const Frame F = launder(F0);
    LAS bf16* IN = (LAS bf16*)F.lds; LAS float* OT = (LAS float*)(F.lds + 66 * 256 * 2 + 64); const int tid = F.tid;
    const GAS bf16* PH = (const GAS bf16*)(F.ws + WS_PH); GAS float* VT = (GAS float*)(F.ws + WS_VT); GAS bf16* X1T = (GAS bf16*)(F.ws + WS_X1T); GAS bf16* X2T = (GAS bf16*)(F.ws + WS_X2T); GAS float* CU = (GAS float*)(F.ws + WS_CU);
    const GAS float* cw = F.in[I_HCW] + (size_t)l * 3 * 768; const GAS float* cb = F.in[I_HCB] + (size_t)l * 768;
    const int nlat = NBATCH * (SEQ / 64) * 3, nctx = NBATCH * (CTXL / 64) * 3;
    for (int u = blockIdx.x; u < nlat + nctx; u += F.G) {
        const bool lat = u < nlat; const int uu = lat ? u : u - nlat; const int grp = uu % 3, tile = (uu / 3) % (lat ? SEQ / 64 : CTXL / 64), b = (uu / 3) / (lat ? SEQ / 64 : CTXL / 64);
        const int Ls = lat ? SEQ : CTXL, t0 = tile * 64; const size_t rowb = lat ? (size_t)b * SEQ : (size_t)TL + b * CTXL;
        for (int i = tid; i < 66 * 32; i += NTHR) { const int rr = i >> 5, c8 = (i & 31) * 8, t = t0 + rr - 1; v4u w = {0u, 0u, 0u, 0u};
            if (t >= 0 && t < Ls) w = *(const GAS v4u*)(PH + (rowb + t) * NPH + PH_HY + grp * 256 + c8);
            *(LAS v4u*)(IN + rr * 256 + c8) = w; }
        __syncthreads();
        { const int c = tid & 255, th = tid >> 8, ch = grp * 256 + c; const float w0 = cw[ch], w1 = cw[768 + ch], w2 = cw[1536 + ch], bb = cb[ch];
          float a = bf2f(IN[(th * 32) * 256 + c]), m = bf2f(IN[(th * 32 + 1) * 256 + c]);
          for (int i = 0; i < 32; ++i) { const float n = bf2f(IN[(th * 32 + i + 2) * 256 + c]); const float y = bb + a * w0 + m * w1 + n * w2; a = m; m = n;
              if (lat) OT[c * 65 + th * 32 + i] = y; else CU[((size_t)b * CTXL + t0 + th * 32 + i) * 768 + ch] = y; } }
        __syncthreads();
        if (lat) { const int t4 = (tid & 15) * 4;
#pragma unroll
            for (int i = 0; i < 8; ++i) { const int c = (tid >> 4) + 32 * i; const LAS float* s = OT + c * 65 + t4; const size_t o = (size_t)(c * 2 + b) * SEQ + t0 + t4;
                if (grp == 0) *(GAS f32x4*)(VT + o) = (f32x4){s[0], s[1], s[2], s[3]};
                else { v2u w; w.x = pk2(s[0], s[1]); w.y = pk2(s[2], s[3]); *(GAS v2u*)((grp == 1 ? X1T : X2T) + o) = w; } } }
        __syncthreads();
    }
}
__device__ __forceinline__ void p_hy_ctx(const Frame& F0, int l) { const Frame F = launder(F0);
    LAS float* L = (LAS float*)F.lds; const int tid = F.tid, t = tid & 255, cs = tid >> 8;
    LAS float* SV = L + cs * 1280, * HFW = SV + 256, * HBW = SV + 512, * HF2 = SV + 768, * HB2 = SV + 1024;
    const GAS float* CU = (const GAS float*)(F.ws + WS_CU); const GAS float* HTC = (const GAS float*)(F.ws + WS_HTC); GAS float* OTC = (GAS float*)(F.ws + WS_OTC);
    for (int u = blockIdx.x; u < NBATCH * 128; u += F.G) {
        const int b = u >> 7, c = (u & 127) * 2 + cs;
        const float n0 = nrm_ctx(F, 0, c), n1 = nrm_ctx(F, 1, c);
        const GAS float* cu = CU + ((size_t)b * CTXL + t) * 768;
        const float v = cu[c], x1 = cu[256 + c], x2 = cu[512 + c];
        SV[t] = v; HFW[t] = HTC[(size_t)(0 + c) * CTXL + t] * n0; HBW[t] = HTC[(size_t)(256 + c) * CTXL + t] * n0; HF2[t] = HTC[(size_t)(512 + c) * CTXL + t] * n1; HB2[t] = HTC[(size_t)(768 + c) * CTXL + t] * n1;
        __syncthreads();
        float y = F.in[I_HSKIP][(l * 2 + 0) * 256 + c] * v;
        for (int s = 0; s <= t; ++s) y += HFW[t - s] * SV[s];
        for (int s = t + 1; s < CTXL; ++s) y += HBW[s - t] * SV[s];
        const float z = x1 * y;
        __syncthreads();
        SV[t] = z;
        __syncthreads();
        float y2 = F.in[I_HSKIP][(l * 2 + 1) * 256 + c] * z;
        for (int s = 0; s <= t; ++s) y2 += HF2[t - s] * SV[s];
        for (int s = t + 1; s < CTXL; ++s) y2 += HB2[s - t] * SV[s];
        OTC[((size_t)b * CTXL + t) * 256 + c] = x2 * y2;
        __syncthreads();
    }
}
__device__ __forceinline__ void p_ynorm_b(const Frame& F0, int l, bool with_ctx) { const Frame F = launder(F0);
    LAS float* T = (LAS float*)F.lds; LAS float* RS = T + 256 * 65; LAS float* PS = RS + 64; const int tid = F.tid;
    const GAS float* VT = (const GAS float*)(F.ws + WS_VT); const GAS float* OTC = (const GAS float*)(F.ws + WS_OTC); GAS bf16* Y = (GAS bf16*)(F.ws + WS_Y); const GAS float* hg = F.in[I_HNG] + l * 256;
    const int nlat = NBATCH * (SEQ / 64), nctx = with_ctx ? NBATCH * (CTXL / 64) : 0;
    for (int u = blockIdx.x; u < nlat + nctx; u += F.G) {
        const bool lat = u < nlat; const int uu = lat ? u : u - nlat, b = lat ? uu / (SEQ / 64) : uu / (CTXL / 64), t0 = (lat ? uu % (SEQ / 64) : uu % (CTXL / 64)) * 64;
        const size_t rowb = lat ? (size_t)b * SEQ + t0 : (size_t)TL + b * CTXL + t0;
        if (lat) { const int t4 = (tid & 15) * 4;
#pragma unroll
            for (int i = 0; i < 8; ++i) { const int c = (tid >> 4) + 32 * i; const f32x4 v = *(const GAS f32x4*)(VT + (size_t)(c * 2 + b) * SEQ + t0 + t4); LAS float* d = T + c * 65 + t4; d[0] = v.x; d[1] = v.y; d[2] = v.z; d[3] = v.w; } }
        else { for (int i = tid; i < 64 * 256; i += NTHR) { const int t = i >> 8, c = i & 255; T[c * 65 + t] = OTC[((size_t)b * CTXL + t0 + t) * 256 + c]; } }
        __syncthreads();
        { const int t = tid & 63, part = tid >> 6; float s = 0.f;
          for (int c = part * 32; c < part * 32 + 32; ++c) { const float v = T[c * 65 + t]; s += v * v; }
          PS[part * 64 + t] = s; }
        __syncthreads();
        if (tid < 64) { float s = 0.f;
#pragma unroll
            for (int p = 0; p < 8; ++p) s += PS[p * 64 + tid];
            RS[tid] = 1.f / sqrtf(s * (1.f / 256.f) + RMS_EPS); }
        __syncthreads();
        { const int t = tid >> 3, c0 = (tid & 7) * 8; const float rs = RS[t];
#pragma unroll
          for (int i = 0; i < 4; ++i) { const int c = c0 + 64 * i; float y[8];
#pragma unroll
              for (int e = 0; e < 8; ++e) y[e] = T[(c + e) * 65 + t] * rs * hg[c + e];
              v4u o; o.x = pk2(y[0], y[1]); o.y = pk2(y[2], y[3]); o.z = pk2(y[4], y[5]); o.w = pk2(y[6], y[7]);
              *(GAS v4u*)(Y + (rowb + t) * D + 256 + c) = o; } }
        __syncthreads();
    }
}

enum LP { LP_IN = 0, LP_PREP, LP_GLA2, LP_GLA3, LP_HY0, LP_HY1, LP_HY2, LP_HY3, LP_HY4, LP_HY5, LP_HY6, LP_HY7, LP_ATT, LP_YN, LP_OUT, LP_LN1, LP_F1, LP_F2, LP_M0  , LP_LN2 = LP_M0 + 9, PPL };
constexpr int NPRO = 4;
constexpr int NPHASE = NPRO + DEPTH * PPL;
template <int l>
__device__ __forceinline__ void layer_phases(const Frame& F, const XcdBarrier& bar, const int lo, const int hi) {
#define IN(k) (lo <= (k) && (k) < hi)
#define SEAM(k) do { if ((k) + 1 < hi) xcd_barrier(bar); } while (0)
    LAS unsigned char* ring = F.lds;
    constexpr int pb = NPRO + l * PPL;
#define lng (F.in[I_LNG] + (size_t)l * 2 * D)
#define lnb (F.in[I_LNB] + (size_t)l * 2 * D)
        if (IN(pb + LP_IN)) { const Frame P = launder(F);
            pg8::Gemm g{(const GAS bf16*)(P.ws + WS_XN), (const GAS bf16*)(P.ws + WS_WIN) + (size_t)l * NPH * D, MR, NPH, D, D, 0};
            pg8::StaticOrder S; S.init(MR, NPH, F.G, (int)blockIdx.x);
            EpiStoreBf16 E{(GAS bf16*)(P.ws + WS_PH), NPH, 1.f};
            pg8::gemm_phase<EpiStoreBf16, pg8::StaticOrder, true, true>(ring, g, S, E);
            SEAM(pb + LP_IN);
        }
        if (IN(pb + LP_PREP)) { const Frame P = launder(F); p_prep_mla_rows(F); p_gla_local(F, l);
            p_hy_shortconv(F, l); SEAM(pb + LP_PREP); }
        if (IN(pb + LP_GLA2)) { const Frame P = launder(F);
            { pg8::Gemm g{(const GAS bf16*)(P.ws + WS_PH) + PH_CQ, (const GAS bf16*)(P.ws + WS_WUQ) + (size_t)l * 768 * 256, MR, 768, 256, NPH, 0};
              pg8::StaticOrder S; S.init(MR, 768, F.G, (int)blockIdx.x);
              EpiMlaQ E{P.ws + WS_Q, P.ws + WS_QC, (const GAS float*)(P.ws + WS_RSQ), (const GAS float*)(P.ws + WS_ROPE)};
              pg8::gemm_phase<EpiMlaQ, pg8::StaticOrder, true, true>(ring, g, S, E); }
            { pg8::Gemm g{(const GAS bf16*)(P.ws + WS_PH) + PH_CKV, (const GAS bf16*)(P.ws + WS_WUKV) + (size_t)l * 1024 * 256, MR, 1024, 256, NPH, 0};
              pg8::StaticOrder S; S.init(MR, 1024, F.G, (int)blockIdx.x);
              EpiMlaKV E{P.ws + WS_K, (GAS bf16*)(P.ws + WS_V), (const GAS float*)(P.ws + WS_RSKV)};
              pg8::gemm_phase<EpiMlaKV, pg8::StaticOrder, true, true>(ring, g, S, E); }
            p_gla_scan(F); p_fft_pass1<0>(F, 0, WS_FA);
            SEAM(pb + LP_GLA2);
        }
        if (IN(pb + LP_GLA3)) { const Frame P = launder(F); p_gla_out(F, l, l == 0); p_attn_vt_pack(F); p_fft_pass2<0>(F, l, 0, WS_FA); if constexpr (l == 0) p_hy_ctx(F, l);
            SEAM(pb + LP_GLA3); }
        if (IN(pb + LP_HY0)) { p_fft_pass31(F, l); SEAM(pb + LP_HY0); }
        if (IN(pb + LP_HY1)) { p_fft_pass2<0>(F, l, 1, WS_FA); SEAM(pb + LP_HY1); }
        if (IN(pb + LP_HY2)) { p_fft_pass3(F, l, 1); SEAM(pb + LP_HY2); }
        if (IN(pb + LP_ATT)) { const Frame P = launder(F); p_attention(F, l == 0);
            SEAM(pb + LP_ATT); }
        if (IN(pb + LP_YN)) { const Frame P = launder(F); p_ynorm_c(F, l == 0 ? MR : TL, F.in[I_MNG] + (size_t)l * 512); p_ynorm_b(F, l, l == 0); if constexpr (l == 0) p_filt_hidden(F, 1); SEAM(pb + LP_YN); }
        if (IN(pb + LP_OUT)) { const Frame P = launder(F);
            const int M = (l == 0) ? MR : TL;
            pg8::Gemm g{(const GAS bf16*)(P.ws + WS_Y), (const GAS bf16*)(P.ws + WS_WOUT) + (size_t)l * D * D, M, D, D, D, 0};
            pg8::StaticOrder S; S.init(M, D, F.G, (int)blockIdx.x);
            EpiRes E{l == 0 ? F.in[I_X] : F.out, l == 0 ? F.in[I_CTX] : (const GAS float*)(P.ws + WS_XC), F.out, (GAS float*)(P.ws + WS_XC), modv(F, l, 0, 2)};
            pg8::gemm_phase<EpiRes, pg8::StaticOrder, true, true>(ring, g, S, E);
            if constexpr (l == 0) p_filt_raw(F, 1);
            SEAM(pb + LP_OUT);
        }
        if (IN(pb + LP_LN1)) { const Frame P = launder(F);
            if constexpr (l == 0) { p_ln(F, MR, lng, lnb, true, l, 3); p_fft_pass1<1>(F, 0, WS_FA0); p_fft_pass1<1>(F, 1, WS_FA1); }
            else { p_ln_route(F, lng, lnb, l); p_moe_weights(F); }
            SEAM(pb + LP_LN1);
        }
        if constexpr (l == 0) {
            if (IN(pb + LP_F1)) { const Frame P = launder(F);
                pg8::Gemm g{(const GAS bf16*)(P.ws + WS_XN), (const GAS bf16*)(P.ws + WS_W13), MR, 2 * DFF, D, D, 0};
                pg8::StaticOrder S; S.init(MR, 2 * DFF, F.G, (int)blockIdx.x);
                EpiSwiglu E{(GAS bf16*)(P.ws + WS_G), DFF, 1.f};
                pg8::gemm_phase<EpiSwiglu, pg8::StaticOrder, true, true>(ring, g, S, E);
                p_fft_pass2<1>(F, 1, 0, WS_FA0); p_fft_pass2<1>(F, 1, 1, WS_FA1);
                SEAM(pb + LP_F1);
            }
            if (IN(pb + LP_F2)) { const Frame P = launder(F);
                pg8::Gemm g{(const GAS bf16*)(P.ws + WS_G), (const GAS bf16*)(P.ws + WS_W2), MR, D, DFF, DFF, 0};
                pg8::StaticOrder S; S.init(MR, D, F.G, (int)blockIdx.x);
                EpiRes E{F.out, (const GAS float*)(P.ws + WS_XC), F.out, (GAS float*)(P.ws + WS_XC), modv(F, l, 0, 5)};
                pg8::gemm_phase<EpiRes, pg8::StaticOrder, true, true>(ring, g, S, E);
                SEAM(pb + LP_F2);
            }
            if (IN(pb + LP_LN2)) { const Frame P = launder(F); p_ln(F, MR, lng + D, lnb + D, true, l + 1, 0); SEAM(pb + LP_LN2); }
        } else {
            if (IN(pb + LP_F1)) { const Frame P = launder(F); p_moe_scatter(F); SEAM(pb + LP_F1); }
            for (int ch = 0; ch < MOE_NCHUNK; ++ch) {
                if (IN(pb + LP_F2 + 2 * ch)) { const Frame P = launder(F);
                    moe_base_to_lds(P);
                    pg8::Gemm g{(const GAS bf16*)(P.ws + WS_HS8 + (size_t)ch * MOE_CHUNK_TILES * 256 * D), (const GAS bf16*)(P.ws + WS_WM13), MOE_CHUNK_TILES * 256, 2 * EFF, D / 2, D / 2, (size_t)2 * EFF * D};
                    MoeOrder S; S.init((const LAS int*)(F.lds + LDS_MOEBT), ch, 2 * EFF / 256, F.G, (int)blockIdx.x);
                    EpiSwiglu8 E{P.ws + WS_GC, EFF, 1.f / MOE_WSCALE, MOE_GSCALE};
                    pg8::gemm_phase<EpiSwiglu8, MoeOrder, true, true, true>(ring, g, S, E);
                    SEAM(pb + LP_F2 + 2 * ch);
                }
                if (IN(pb + LP_F2 + 2 * ch + 1)) { const Frame P = launder(F);
                    moe_base_to_lds(P);
                    pg8::Gemm g{(const GAS bf16*)(P.ws + WS_GC), (const GAS bf16*)(P.ws + WS_WM2), MOE_CHUNK_TILES * 256, D, EFF / 2, EFF / 2, (size_t)D * EFF};
                    MoeOrder S; S.init((const LAS int*)(F.lds + LDS_MOEBT), ch, D / 256, F.G, (int)blockIdx.x);
                    EpiStoreBf16 E{(GAS bf16*)(P.ws + WS_HS) + (size_t)ch * MOE_CHUNK_TILES * 256 * D, D, 1.f / (MOE_GSCALE * MOE_W2SCALE)};
                    pg8::gemm_phase<EpiStoreBf16, MoeOrder, true, true, true>(ring, g, S, E);
                    SEAM(pb + LP_F2 + 2 * ch + 1);
                }
            }
            if (IN(pb + LP_LN2)) { const Frame P = launder(F); p_ln_combine(F, lng + D, lnb + D, l); SEAM(pb + LP_LN2); }
        }

#undef lng
#undef lnb
#undef IN
#undef SEAM
}
__global__ void __launch_bounds__(NTHR, 2) mega(Args args) {
    extern __shared__ __attribute__((aligned(16))) unsigned char lds_raw[];
    Frame F;
    F.lds = (LAS unsigned char*)lds_raw; F.ws = args.ws; F.ctl = (gu32*)(args.ws + WS_CTL); F.in = (const GAS float* const GAS*)(args.ws + WS_PTRTAB); F.out = args.out;
    F.tid = threadIdx.x; F.lane = F.tid & 63; F.wave = __builtin_amdgcn_readfirstlane(F.tid >> 6); F.G = gridDim.x;
    F.gw = blockIdx.x * NWAVES + F.wave; F.ngw = F.G * NWAVES;
    volatile LAS unsigned* MISC = (volatile LAS unsigned*)(F.lds + LDS_MISC);
    if (F.tid < 32) MISC[F.tid] = 0u;
    __syncthreads();
    XcdBarrier bar; bar.bar = (unsigned*)(F.ctl + CW_BAR); bar.x = 0; bar.st = nullptr;
#if !MK_PER_PHASE
    bar = xcd_barrier_post((unsigned*)(F.ctl + CW_BAR), MISC + 8);
#endif
    const int lo = args.ph_lo, hi = args.ph_hi;
#define IN(k) (lo <= (k) && (k) < hi)
#define SEAM(k) do { if ((k) + 1 < hi) xcd_barrier(bar); } while (0)
    LAS unsigned char* ring = F.lds;
#define LTID() ({ int t_ = F.tid; asm volatile("" : "+v"(t_)); t_; })

    if (IN(0)) { Frame FK = F; FK.in = (const GAS float* const GAS*)(const GAS void*)args.in;
        if (blockIdx.x == 0 && F.tid < 37) ((const GAS float* GAS*)(args.ws + WS_PTRTAB))[F.tid] = args.in[F.tid];
        p0_modv(FK); p0_weights(FK); p0_rope_table(FK); __syncthreads();     p_filt_hidden(FK, 0);
        SEAM(0); }
    if (IN(1)) { p_xn0(F); p_filt_raw(F, 0);
        SEAM(1); }
    if (IN(2)) { p_fft_pass1<1>(F, 0, WS_FA0); p_fft_pass1<1>(F, 1, WS_FA1); SEAM(2); }
    if (IN(3)) { p_fft_pass2<1>(F, 0, 0, WS_FA0); p_fft_pass2<1>(F, 0, 1, WS_FA1); SEAM(3); }

    layer_phases<0>(F, bar, lo, hi);
    layer_phases<1>(F, bar, lo, hi);
#undef IN
#undef SEAM
}

extern "C" void kernel_launch(void* const* d_in, const int* in_sizes, int n_in, void* d_out, int out_size, void* d_ws, size_t ws_size, hipStream_t stream) {
    static int grid = 0;
    if (grid == 0) {
        if (n_in != 37 || in_sizes[0] != TL * D || out_size != TL * D || ws_size < WS_END2) { fprintf(stderr, "kernel_launch: shape/workspace mismatch (n_in %d in0 %d out %d ws %zu need %zu)\n", n_in, n_in > 0 ? in_sizes[0] : -1, out_size, ws_size, (size_t)WS_END2); grid = -1; return; }
        int dev = 0, cus = 0, per_cu = 0;
        if (hipGetDevice(&dev) != hipSuccess || hipDeviceGetAttribute(&cus, hipDeviceAttributeMultiprocessorCount, dev) != hipSuccess) { grid = -1; return; }
        if (hipFuncSetAttribute((const void*)mega, hipFuncAttributeMaxDynamicSharedMemorySize, LDS_BYTES) != hipSuccess) { fprintf(stderr, "kernel_launch: hipFuncSetAttribute failed\n"); grid = -1; return; }
        if (hipOccupancyMaxActiveBlocksPerMultiprocessor(&per_cu, (const void*)mega, NTHR, LDS_BYTES) != hipSuccess || per_cu < 1) { fprintf(stderr, "kernel_launch: occupancy query says %d\n", per_cu); }
        (void)hipGetLastError();
        grid = cus;
    }
    if (grid < 0) return;
    if (hipMemsetAsync((char*)d_ws + WS_CTL, 0, CTL_ZERO_BYTES, stream) != hipSuccess) return;
    Args a{};
    for (int i = 0; i < 37; ++i) a.in[i] = (const GAS float*)d_in[i];
    a.out = (GAS float*)d_out; a.ws = (GAS unsigned char*)d_ws;
#if MK_PER_PHASE
    for (int p = 0; p < NPHASE; ++p) { a.ph_lo = p; a.ph_hi = p + 1; hipLaunchKernelGGL(mega, dim3(grid), dim3(NTHR), LDS_BYTES, stream, a); }
#else
    a.ph_lo = 0; a.ph_hi = NPHASE;
    hipLaunchKernelGGL(mega, dim3(grid), dim3(NTHR), LDS_BYTES, stream, a);
#endif
    const hipError_t le = hipPeekAtLastError();
    if (le != hipSuccess) fprintf(stderr, "kernel_launch: launch failed: %s\n", hipGetErrorName(le));
}
```

```cpp
#include <hip/hip_runtime.h>
#include <cstdio>
#include <cstdint>
namespace pg8 {
#define PG8_LAS __attribute__((address_space(3)))
#define PG8_GAS __attribute__((address_space(1)))
typedef unsigned short bf16_t;
typedef short bf16x8 __attribute__((ext_vector_type(8)));
typedef float f32x4 __attribute__((ext_vector_type(4)));
typedef unsigned u32x4 __attribute__((ext_vector_type(4)));
typedef int i32x8_t __attribute__((ext_vector_type(8)));
typedef short bf16x16 __attribute__((ext_vector_type(16)));
constexpr int BM = 256, BK = 64, HALF = 128, HTB = HALF * BK * 2  , STAGE_BYTES = 8 * HTB, NXCD = 8, WGM = 8;

__host__ __device__ __forceinline__ int lds_byte(int r, int c) { const int st = (r >> 4) * 2 + (c >> 5), rr = r & 15, cc = c & 31, ob = rr * 64 + cc * 2; return st * 1024 + (ob ^ (((ob >> 9) & 1) << 5)); }
__host__ __device__ __forceinline__ void stage_rc(int b, int& R, int& C) { const int st = b / 1024, sb = b % 1024, swz = sb ^ (((sb >> 9) & 1) << 5); R = (st >> 1) * 16 + swz / 64; C = (st & 1) * 32 + (swz % 64) / 2; }
__host__ __device__ __forceinline__ int perm32(int rho) { const int n = rho >> 4, i = rho & 15; return 8 * (i >> 2) + 4 * n + (i & 3); }

struct Unit { int pm, pn, be; };
struct Gemm { const PG8_GAS bf16_t* A; const PG8_GAS bf16_t* Bt; int M, N, K; int lda; size_t bstride; };

struct StaticOrder {
    int nM, nN, nwg, G, c;
    __host__ __device__ void init(int M, int N, int G_, int c_) { nM = M / BM; nN = N / BM; nwg = nM * nN; G = G_; c = c_; }
    __host__ __device__ bool next(int i, Unit& u) const {
        const long L = (long)i * G + c; if (L >= nwg) return false;
        int wgid = (int)L; { const int q = nwg / NXCD, r = nwg % NXCD, xcd = wgid % NXCD, off = wgid / NXCD; wgid = (xcd < r ? xcd * (q + 1) : r * (q + 1) + (xcd - r) * q) + off; }
        const int nig = WGM * nN, gid = wgid / nig, fm = gid * WGM, gsz = (nM - fm) < WGM ? (nM - fm) : WGM;
        u.pm = fm + ((wgid % nig) % gsz); u.pn = (wgid % nig) / gsz; u.be = 0; return true;
    }
    __device__ __forceinline__ void a_ready(const Unit&) const {}
    __device__ __forceinline__ void done(const Unit&) const {}
};


__device__ __forceinline__ unsigned cvt_pk_bf16(float lo, float hi) { unsigned r; asm volatile("v_cvt_pk_bf16_f32 %0, %1, %2" : "=v"(r) : "v"(lo), "v"(hi)); return r; }
typedef float f32x2 __attribute__((ext_vector_type(2)));
typedef unsigned u32x2 __attribute__((ext_vector_type(2)));

template <class Epi, class Sched, bool ALIGN_EPI = false, bool SP2 = false, bool F8 = false>
__device__ __forceinline__ void gemm_phase(PG8_LAS unsigned char* lds, const Gemm g, const Sched& S, const Epi& E) {
    { unsigned lb_ = (unsigned)(size_t)lds; asm volatile("" : "+s"(lb_)); lds = (PG8_LAS unsigned char*)(size_t)lb_; }
    int tid_ = threadIdx.x; asm volatile("" : "+v"(tid_));
    const int tid = tid_, wid = __builtin_amdgcn_readfirstlane(tid >> 6), lane = tid & 63, wr = wid >> 2, wc = wid & 3, fr = lane & 15, fq = lane >> 4;
    int K_ = g.K; asm volatile("" : "+s"(K_)); const int K = K_, nt = K / BK;
    unsigned voffA[2], voffB[2];
#pragma unroll
    for (int i = 0; i < 2; ++i) { int R, C; stage_rc(tid * 16 + i * 8192, R, C); const int Rb = Epi::PERM ? ((R & ~31) + perm32(R & 31)) : R;
        voffA[i] = (unsigned)(R * g.lda + C) * 2u; voffB[i] = (unsigned)(Rb * K + C) * 2u; }
    const size_t kstep = (size_t)(BK * 2);
    const size_t hstepB = (size_t)HALF * K * 2, hstepA = (size_t)HALF * g.lda * 2;
    const size_t tstepA = 2 * hstepA, tstepB = 2 * hstepB;
    const unsigned ldsw = (unsigned)wid * 1024u;
    const int aoff = lds_byte(wr * 64 + fr, fq * 8), boff = lds_byte(wc * 32 + fr, fq * 8);
#define PG8_SA(b, h) (((b) * 2 + (h)) * HTB)
#define PG8_SB(b, h) ((4 + (b) * 2 + (h)) * HTB)
#define PG8_STAGE(bufoff, gbase, voff) do { _Pragma("unroll") for (int _i = 0; _i < 2; ++_i) \
        __builtin_amdgcn_global_load_lds((const PG8_GAS unsigned*)((const PG8_GAS char*)(gbase) + (voff)[_i]), (PG8_LAS unsigned*)(lds + (bufoff) + ldsw + _i * 8192), 16, 0, 0); } while (0)
#define PG8_LDA(dst, b, h) do { _Pragma("unroll") for (int m = 0; m < 4; ++m) dst[m] = __builtin_shufflevector(*(const PG8_LAS bf16x8*)(lds + PG8_SA(b, h) + aoff + m * 2048), *(const PG8_LAS bf16x8*)(lds + PG8_SA(b, h) + aoff + m * 2048 + 1024), 0, 1, 2, 3, 4, 5, 6, 7, 8, 9, 10, 11, 12, 13, 14, 15); } while (0)
#define PG8_LDB(dst, b, h) do { _Pragma("unroll") for (int n = 0; n < 2; ++n) dst[n] = __builtin_shufflevector(*(const PG8_LAS bf16x8*)(lds + PG8_SB(b, h) + boff + n * 2048), *(const PG8_LAS bf16x8*)(lds + PG8_SB(b, h) + boff + n * 2048 + 1024), 0, 1, 2, 3, 4, 5, 6, 7, 8, 9, 10, 11, 12, 13, 14, 15); } while (0)
#define PG8_HALF(x, k) ((k) == 0 ? __builtin_shufflevector(x, x, 0, 1, 2, 3, 4, 5, 6, 7) : __builtin_shufflevector(x, x, 8, 9, 10, 11, 12, 13, 14, 15))
#define PG8_MMA(ai, bj, At, Bt) do { __builtin_amdgcn_s_setprio(1); if constexpr (F8) { _Pragma("unroll") for (int m = 0; m < 4; ++m) _Pragma("unroll") for (int n = 0; n < 2; ++n) \
        asm volatile("v_mfma_f32_16x16x128_f8f6f4 %0, %1, %2, %0" : "+v"(acc[ai][bj][m][n]) : "v"(__builtin_bit_cast(i32x8_t, Bt[n])), "v"(__builtin_bit_cast(i32x8_t, At[m]))); } \
    else { _Pragma("unroll") for (int m = 0; m < 4; ++m) _Pragma("unroll") for (int n = 0; n < 2; ++n) _Pragma("unroll") for (int k = 0; k < 2; ++k) \
        acc[ai][bj][m][n] = __builtin_amdgcn_mfma_f32_16x16x32_bf16(PG8_HALF(Bt[n], k), PG8_HALF(At[m], k), acc[ai][bj][m][n], 0, 0, 0); } __builtin_amdgcn_s_setprio(0); } while (0)
#define PG8_F8_DRAIN() do { if constexpr (F8) asm volatile("s_nop 15\n\ts_nop 15" ::: "memory"); } while (0)
#define PG8_WAIT_V(n) asm volatile("s_waitcnt vmcnt(" #n ")" ::: "memory")
#define PG8_WAIT_L(n) asm volatile("s_waitcnt lgkmcnt(" #n ")" ::: "memory")
#define PG8_BAR __builtin_amdgcn_s_barrier()
#define PG8_SCHED __builtin_amdgcn_sched_barrier(0)
    Unit cur, nxt; int ui = 0;
    if (!S.next(0, cur)) return;
    f32x4 acc[2][2][4][2];
#pragma unroll
    for (int a = 0; a < 2; ++a)
#pragma unroll
        for (int b = 0; b < 2; ++b)
#pragma unroll
            for (int m = 0; m < 4; ++m)
#pragma unroll
                for (int n = 0; n < 2; ++n) acc[a][b][m][n] = (f32x4){0.f, 0.f, 0.f, 0.f};
    bf16x16 At[4], B0[2], B1[2];
    const PG8_GAS char* cA = (const PG8_GAS char*)g.A + (size_t)cur.pm * tstepA; const PG8_GAS char* cB = (const PG8_GAS char*)g.Bt + (size_t)cur.be * g.bstride + (size_t)cur.pn * tstepB;
    S.a_ready(cur);
    if constexpr (SP2) {
        PG8_STAGE(PG8_SB(0, 0), cB, voffB); PG8_STAGE(PG8_SB(0, 1), cB + hstepB, voffB); PG8_STAGE(PG8_SA(0, 0), cA, voffA); PG8_STAGE(PG8_SA(0, 1), cA + hstepA, voffA);
        if (wr == 1) PG8_BAR;
        PG8_WAIT_V(2); PG8_BAR;
        PG8_STAGE(PG8_SB(1, 0), cB + kstep, voffB); PG8_STAGE(PG8_SA(1, 0), cA + kstep, voffA); PG8_STAGE(PG8_SB(1, 1), cB + hstepB + kstep, voffB);
        PG8_WAIT_V(6); PG8_BAR;
    } else {
        PG8_STAGE(PG8_SB(0, 0), cB, voffB); PG8_STAGE(PG8_SA(0, 0), cA, voffA); PG8_STAGE(PG8_SB(0, 1), cB + hstepB, voffB); PG8_STAGE(PG8_SA(0, 1), cA + hstepA, voffA);
        if (wr == 1) PG8_BAR;
        PG8_WAIT_V(4); PG8_BAR;
        PG8_STAGE(PG8_SB(1, 0), cB + kstep, voffB); PG8_STAGE(PG8_SA(1, 0), cA + kstep, voffA); PG8_STAGE(PG8_SB(1, 1), cB + hstepB + kstep, voffB);
        PG8_WAIT_V(6); PG8_BAR;
    }
    for (;;) {
        const bool has_next = S.next(ui + 1, nxt);
        const PG8_GAS char* nA = has_next ? (const PG8_GAS char*)g.A + (size_t)nxt.pm * tstepA : cA; const PG8_GAS char* nB = has_next ? (const PG8_GAS char*)g.Bt + (size_t)nxt.be * g.bstride + (size_t)nxt.pn * tstepB : cB;
        for (int t = 0; t < nt; t += 2) {
            const bool last = (t == nt - 2);
            const PG8_GAS char* a1 = cA + (size_t)(t + 1) * kstep;
            const PG8_GAS char* a2 = last ? nA : cA + (size_t)(t + 2) * kstep; const PG8_GAS char* b2 = last ? nB : cB + (size_t)(t + 2) * kstep;
            const PG8_GAS char* a3 = a2 + kstep; const PG8_GAS char* b3 = b2 + kstep;
            if (last && has_next) S.a_ready(nxt);
            if constexpr (SP2) {
            PG8_LDB(B0, 0, 0); PG8_LDB(B1, 0, 1); PG8_SCHED; PG8_LDA(At, 0, 0); PG8_STAGE(PG8_SA(1, 1), a1 + hstepA, voffA);
            PG8_WAIT_V(8); PG8_WAIT_L(0); PG8_BAR; PG8_MMA(0, 0, At, B0); PG8_MMA(0, 1, At, B1); PG8_BAR; PG8_SCHED;
            PG8_LDA(At, 0, 1); PG8_STAGE(PG8_SB(0, 0), b2, voffB); PG8_STAGE(PG8_SB(0, 1), b2 + hstepB, voffB); PG8_STAGE(PG8_SA(0, 0), a2, voffA);
            PG8_WAIT_V(8); PG8_WAIT_L(0); PG8_BAR; PG8_MMA(1, 0, At, B0); PG8_MMA(1, 1, At, B1); PG8_BAR; PG8_SCHED;
            PG8_LDB(B0, 1, 0); PG8_LDB(B1, 1, 1); PG8_SCHED; PG8_LDA(At, 1, 0); PG8_STAGE(PG8_SA(0, 1), a2 + hstepA, voffA);
            PG8_WAIT_V(8); PG8_WAIT_L(0); PG8_BAR; PG8_MMA(0, 0, At, B0); PG8_MMA(0, 1, At, B1); PG8_BAR; PG8_SCHED;
            PG8_LDA(At, 1, 1); PG8_STAGE(PG8_SB(1, 0), b3, voffB); PG8_STAGE(PG8_SB(1, 1), b3 + hstepB, voffB); PG8_STAGE(PG8_SA(1, 0), a3, voffA);
            PG8_WAIT_V(8); PG8_WAIT_L(0); PG8_BAR; PG8_MMA(1, 0, At, B0); PG8_MMA(1, 1, At, B1); PG8_BAR; PG8_SCHED;
            } else {
            PG8_LDB(B0, 0, 0); PG8_SCHED; PG8_LDA(At, 0, 0); PG8_STAGE(PG8_SA(1, 1), a1 + hstepA, voffA);
            PG8_WAIT_L(8); PG8_BAR; PG8_WAIT_L(0); PG8_MMA(0, 0, At, B0); PG8_BAR; PG8_SCHED;
            PG8_LDB(B1, 0, 1); PG8_STAGE(PG8_SB(0, 0), b2, voffB);
            PG8_BAR; PG8_WAIT_L(0); PG8_MMA(0, 1, At, B1); PG8_BAR;
            PG8_LDA(At, 0, 1); PG8_STAGE(PG8_SA(0, 0), a2, voffA);
            PG8_BAR; PG8_WAIT_L(0); PG8_MMA(1, 0, At, B0); PG8_BAR; PG8_SCHED;
            PG8_STAGE(PG8_SB(0, 1), b2 + hstepB, voffB);
            PG8_WAIT_V(6); PG8_BAR; PG8_MMA(1, 1, At, B1); PG8_BAR;
            PG8_LDB(B0, 1, 0); PG8_SCHED; PG8_LDA(At, 1, 0); PG8_STAGE(PG8_SA(0, 1), a2 + hstepA, voffA);
            PG8_WAIT_L(8); PG8_BAR; PG8_WAIT_L(0); PG8_MMA(0, 0, At, B0); PG8_BAR; PG8_SCHED;
            PG8_LDB(B1, 1, 1); PG8_STAGE(PG8_SB(1, 0), b3, voffB);
            PG8_BAR; PG8_WAIT_L(0); PG8_MMA(0, 1, At, B1); PG8_BAR;
            PG8_LDA(At, 1, 1); PG8_STAGE(PG8_SA(1, 0), a3, voffA);
            PG8_BAR; PG8_WAIT_L(0); PG8_MMA(1, 0, At, B0); PG8_BAR; PG8_SCHED;
            PG8_STAGE(PG8_SB(1, 1), b3 + hstepB, voffB);
            PG8_WAIT_V(6); PG8_BAR; PG8_MMA(1, 1, At, B1); PG8_BAR;
            }
        }
        if constexpr (ALIGN_EPI) { if (wr == 0) PG8_BAR; }
        PG8_F8_DRAIN();
        if constexpr (!Epi::AFTER_DRAIN) { E(acc, cur, wr, wc, fr, fq); S.done(cur); }
        if (!has_next) break;
#pragma unroll
        for (int a = 0; a < 2; ++a)
#pragma unroll
            for (int b = 0; b < 2; ++b)
#pragma unroll
                for (int m = 0; m < 4; ++m)
#pragma unroll
                    for (int n = 0; n < 2; ++n) acc[a][b][m][n] = (f32x4){0.f, 0.f, 0.f, 0.f};
        cur = nxt; cA = nA; cB = nB; ++ui;
        if constexpr (ALIGN_EPI) { if (wr == 1) PG8_BAR; }
    }
    PG8_WAIT_V(0);
    if constexpr (!ALIGN_EPI) { if (wr == 0) PG8_BAR; }
    PG8_BAR;
    if constexpr (Epi::AFTER_DRAIN) { E.fused(acc, cur, wr, wc, fr, fq, lds, wid, lane); S.done(cur); }
#undef PG8_SA
#undef PG8_SB
#undef PG8_STAGE
#undef PG8_LDA
#undef PG8_LDB
#undef PG8_MMA
#undef PG8_HALF
#undef PG8_F8_DRAIN
#undef PG8_WAIT_V
#undef PG8_WAIT_L
#undef PG8_BAR
#undef PG8_SCHED
}
}


#ifndef MK_PER_PHASE
#define MK_PER_PHASE 0
#endif

constexpr int NWAVES = 8, NTHR = 512;
constexpr int D = 1024, NBATCH = 2, SEQ = 16384, TL = NBATCH * SEQ, CTXL = 256, TC = NBATCH * CTXL, MR = TL + TC;
constexpr int NPH = 2048, DFF = 2816, NEXP = 8, EFF = 3584, DEPTH = 2;
constexpr float ALPHA = 1.41421356237309515f;
constexpr float LN_EPS = 1e-5f, RMS_EPS = 1e-6f;
constexpr int PH_QA = 0, PH_KA = 128, PH_VA = 256, PH_GA = 512, PH_HY = 768, PH_CQ = 1536, PH_CKV = 1792, PH_KR = 1920, PH_ALR = 1952;

constexpr size_t MiB = 1u << 20;
constexpr size_t WS_CTL = 0, CTL_ZERO_BYTES = 1 * MiB;
constexpr int CW_TMO = 0, CW_BAR = 4096;
constexpr size_t CTL_MODV = 64 * 1024;
constexpr size_t WS_SMALL = 1 * MiB;
constexpr size_t WS_PTRTAB = WS_SMALL + 16 * 1024;
constexpr size_t WS_WIN = 2 * MiB, WS_WOUT = 10 * MiB, WS_W13 = 14 * MiB, WS_W2 = 25 * MiB, WS_WUQ = 31 * MiB, WS_WUKV = 32 * MiB;
constexpr size_t AB = 34 * MiB;
constexpr size_t WS_XN = AB, WS_Y = AB + 65 * MiB, WS_PH = AB + 130 * MiB, WS_Q = AB + 260 * MiB, WS_K = AB + 309 * MiB, WS_V = AB + 358 * MiB;
constexpr size_t WS_VT = AB + 391 * MiB, WS_X1T = AB + 423 * MiB, WS_X2T = AB + 439 * MiB, WS_HF = AB + 455 * MiB, WS_XC = AB + 519 * MiB, WS_END = AB + 521 * MiB;
constexpr size_t WS_G = WS_PH;
static_assert(WS_W13 + (size_t)2 * DFF * D * 2 <= WS_W2 && WS_W2 + (size_t)D * DFF * 2 <= WS_WUQ, "weights map");
static_assert(WS_G + (size_t)MR * DFF * 2 <= WS_K, "G overlay");
static_assert(WS_END <= 573 * MiB, "d_ws budget");

constexpr int LDS_BYTES = 147456, LDS_MISC = 131072 + 320;

#define GAS __attribute__((address_space(1)))
#define LAS __attribute__((address_space(3)))
typedef unsigned short bf16;
typedef unsigned v4u __attribute__((ext_vector_type(4)));
typedef unsigned v2u __attribute__((ext_vector_type(2)));
typedef float f32x4 __attribute__((ext_vector_type(4)));
typedef GAS unsigned gu32;
#define RLX_AGENT __ATOMIC_RELAXED, __HIP_MEMORY_SCOPE_AGENT
#define LDS_WAIT() asm volatile("s_waitcnt lgkmcnt(0)" ::: "memory")
#define VM_WAIT() asm volatile("s_waitcnt vmcnt(0)" ::: "memory")
__device__ __forceinline__ unsigned pk2(float lo, float hi) { return pg8::cvt_pk_bf16(lo, hi); }
__device__ __forceinline__ float bf2f(unsigned short h) { return __uint_as_float((unsigned)h << 16); }
__device__ __forceinline__ float siluf(float x) { return x / (1.f + __expf(-x)); }
#define XB_TMO      128
#define XB_XCNT(j)  (256  + 64 * (j))
#define XB_XSUB(j)  (1280 + 64 * (j))
#define XB_XGEN(j)  (2304 + 64 * (j))
#define XB_TOP      3328
#define XB_TOPGEN   3392
#define XCD_BAR_WORDS 3456
#define XB_SPIN_CAP (1u << 18)

__device__ __forceinline__ unsigned xb_ld(unsigned* p)              { return __hip_atomic_load(p, __ATOMIC_RELAXED, __HIP_MEMORY_SCOPE_AGENT); }
__device__ __forceinline__ unsigned xb_add(unsigned* p, unsigned v) { return __hip_atomic_fetch_add(p, v, __ATOMIC_RELAXED, __HIP_MEMORY_SCOPE_AGENT); }
__device__ __forceinline__ unsigned xb_xcc_id() { return (unsigned)__builtin_amdgcn_s_getreg((3 << 11) | 20) & 0xFu; }
#define XB_SPIN(cond, bar) do { unsigned _sp = 0; while (cond) { __builtin_amdgcn_s_sleep(1); \
    if ((++_sp & 255u) == 0u) { if (xb_ld(&(bar)[XB_TMO])) break; if (_sp > XB_SPIN_CAP) { atomicAdd(&(bar)[XB_TMO], 1u); break; } } } } while (0)

struct XcdBarrier {
    unsigned* bar; unsigned x;
    volatile LAS unsigned* st;
};

__device__ __forceinline__ XcdBarrier xcd_barrier_post(unsigned* bar, volatile LAS unsigned* st) {
    XcdBarrier b; b.bar = bar; b.x = xb_xcc_id(); b.st = st;
    if (threadIdx.x == 0) (void)xb_add(&bar[XB_XCNT(b.x)], 1u);
    return b;
}
__device__ __forceinline__ void xcd_barrier_complete(unsigned* bar, unsigned x, unsigned& nloc, unsigned& nx) {
    const unsigned G = gridDim.x * gridDim.y * gridDim.z;
    unsigned sum, cnt, mine, sp = 0u;
    for (;;) {
        sum = 0u; cnt = 0u; mine = 0u;
#pragma unroll
        for (unsigned j = 0; j < 16; ++j) { const unsigned c = xb_ld(&bar[XB_XCNT(j)]); sum += c; cnt += (c > 0u) ? 1u : 0u; mine = (j == x) ? c : mine; }
        if (sum == G) break;
        __builtin_amdgcn_s_sleep(1);
        if ((++sp & 255u) == 0u) { if (xb_ld(&bar[XB_TMO])) break; if (sp > XB_SPIN_CAP) { atomicAdd(&bar[XB_TMO], 1u); break; } }
    }
    nloc = mine > 0u ? mine : 1u; nx = cnt > 0u ? cnt : 1u;
}

__device__ __forceinline__ void xcd_barrier(const XcdBarrier& b) {
    asm volatile("s_waitcnt vmcnt(0)" ::: "memory");
    __syncthreads();
    if (threadIdx.x == 0) {
        unsigned* bar = b.bar;
        __builtin_amdgcn_s_waitcnt(0);
        unsigned nloc = b.st[0], nx = b.st[1];
        if (nloc == 0u) { xcd_barrier_complete(bar, b.x, nloc, nx); b.st[0] = nloc; b.st[1] = nx; }
        const unsigned old = xb_add(&bar[XB_XSUB(b.x)], 1u);
        const unsigned gen = old / nloc;
        if (old + 1u == (gen + 1u) * nloc) {
            __builtin_amdgcn_fence(__ATOMIC_RELEASE, "agent");
            asm volatile("s_waitcnt vmcnt(0)" ::: "memory");
            const unsigned og = xb_add(&bar[XB_TOP], 1u);
            const unsigned tg = og / nx;
            if (og + 1u == (tg + 1u) * nx) xb_add(&bar[XB_TOPGEN], 1u);
            else XB_SPIN(xb_ld(&bar[XB_TOPGEN]) == tg, bar);
            __builtin_amdgcn_fence(__ATOMIC_ACQUIRE, "agent");
            xb_add(&bar[XB_XGEN(b.x)], 1u);
            asm volatile("s_waitcnt vmcnt(0)" ::: "memory");
        } else {
            XB_SPIN(xb_ld(&bar[XB_XGEN(b.x)]) == gen, bar);
            __builtin_amdgcn_fence(__ATOMIC_ACQUIRE, "agent");
            asm volatile("s_waitcnt vmcnt(0)" ::: "memory");
        }
    }
    __syncthreads();
}

struct Args { const GAS float* in[37]; GAS float* out; GAS unsigned char* ws; int ph_lo, ph_hi; };
enum In { I_X = 0, I_C, I_CTX, I_CCTX, I_WMOD, I_BMOD, I_WIN, I_GWG, I_GBG, I_GNG, I_HCW, I_HCB, I_HW1, I_HB1, I_HF1, I_HW2, I_HB2, I_HF2, I_HW3, I_HB3, I_HSKIP, I_HNG,
          I_QNG, I_WUQ, I_KVNG, I_WUKV, I_MNG, I_WOUT, I_LNG, I_LNB, I_FW1, I_FW3, I_FW2, I_ROUTER, I_MW1, I_MW3, I_MW2 };

struct Frame {
    LAS unsigned char* lds; GAS unsigned char* ws; gu32* ctl; const GAS float* const GAS* in; GAS float* out;
    int tid, lane, wave, G, gw, ngw;
};
__device__ __forceinline__ Frame launder(const Frame& F0) { Frame F = F0; int t = F0.tid; size_t z = 0; asm volatile("" : "+v"(t), "+s"(z)); F.tid = t; F.lane = t & 63; F.ws = F0.ws + z; F.ctl = (gu32*)(F.ws + WS_CTL); F.out = F0.out + z; return F; }
__device__ __forceinline__ float wave_sum(float v) {
#pragma unroll
    for (int o = 1; o < 64; o <<= 1) v += __shfl_xor(v, o);
    return v;
}
__device__ __forceinline__ const GAS float* modv(const Frame& F, int l, int v, int i) { return (const GAS float*)(F.ws + CTL_MODV) + ((size_t)(l * 3 + v) * 6 + i) * D; }
__device__ __forceinline__ int row_v(int row) { return row < TL ? (row >> 14) : 2; }

__device__ __forceinline__ void p0_modv(const Frame& F0) { const Frame F = launder(F0);
    const GAS float* c = F.in[I_C]; const GAS float* cc = F.in[I_CCTX]; const GAS float* wm = F.in[I_WMOD]; const GAS float* bm = F.in[I_BMOD];
    GAS float* mv = (GAS float*)(F.ws + CTL_MODV); LAS float* part = (LAS float*)F.lds;
    constexpr int NBLK = 6 * D / 64, NITEM = DEPTH * NBLK;
    for (int it = blockIdx.x; it < NITEM; it += F.G) {
        const int l = it / NBLK, nb = it % NBLK, n = nb * 64 + F.lane, k0 = F.wave * 128;
        const float s0a = siluf(c[k0 + F.lane]), s1a = siluf(c[D + k0 + F.lane]), s2a = siluf(cc[k0 + F.lane]);
        const float s0b = siluf(c[k0 + 64 + F.lane]), s1b = siluf(c[D + k0 + 64 + F.lane]), s2b = siluf(cc[k0 + 64 + F.lane]);
        float a0 = 0.f, a1 = 0.f, a2 = 0.f;
        const GAS float* w = wm + ((size_t)l * D + k0) * (6 * D) + n;
#pragma unroll 16
        for (int kk = 0; kk < 64; ++kk) { const float wv = w[(size_t)kk * (6 * D)]; a0 += __shfl(s0a, kk) * wv; a1 += __shfl(s1a, kk) * wv; a2 += __shfl(s2a, kk) * wv; }
#pragma unroll 16
        for (int kk = 0; kk < 64; ++kk) { const float wv = w[(size_t)(64 + kk) * (6 * D)]; a0 += __shfl(s0b, kk) * wv; a1 += __shfl(s1b, kk) * wv; a2 += __shfl(s2b, kk) * wv; }
        part[(F.wave * 3 + 0) * 64 + F.lane] = a0; part[(F.wave * 3 + 1) * 64 + F.lane] = a1; part[(F.wave * 3 + 2) * 64 + F.lane] = a2;
        __syncthreads();
        if (F.tid < 192) { const int v = F.tid >> 6, ln = F.tid & 63; float acc = bm[l * 6 * D + nb * 64 + ln];
#pragma unroll
            for (int wv = 0; wv < 8; ++wv) acc += part[(wv * 3 + v) * 64 + ln];
            mv[(size_t)(l * 3 + v) * 6 * D + nb * 64 + ln] = acc; }
        __syncthreads();
    }
}
template <class RowMap>
__device__ __forceinline__ void transpose_item(const GAS float* W, int N, GAS bf16* WT, int ldk, LAS float* scr, int item, int lane, const RowMap& rm, const GAS float* ks) {
    const int nblk = N / 32, kb = item / nblk, nb = item % nblk, k0 = 64 * kb, n0 = 32 * nb;
#pragma unroll 8
    for (int i = 0; i < 32; ++i) { const int kk = 2 * i + (lane >> 5); float v = W[(size_t)(k0 + kk) * N + n0 + (lane & 31)]; if (ks) v *= ks[k0 + kk]; scr[kk * 33 + (lane & 31)] = v; }
    LDS_WAIT(); asm volatile("" ::: "memory");
    const int c = lane & 7;
#pragma unroll
    for (int j = 0; j < 4; ++j) { const int n = (lane >> 3) + 8 * j; const LAS float* s = scr + (8 * c) * 33 + n;
        v4u o; o.x = pk2(s[0 * 33], s[1 * 33]); o.y = pk2(s[2 * 33], s[3 * 33]); o.z = pk2(s[4 * 33], s[5 * 33]); o.w = pk2(s[6 * 33], s[7 * 33]);
        *(GAS v4u*)(WT + (size_t)rm(n0 + n) * ldk + k0 + 8 * c) = o; }
    LDS_WAIT(); asm volatile("" ::: "memory");
}
__device__ __forceinline__ float clamp448(float x) { return fminf(fmaxf(x, -448.f), 448.f); }
__device__ __forceinline__ unsigned pk4_fp8(float a, float b, float c, float d) { unsigned w = 0; w = __builtin_amdgcn_cvt_pk_fp8_f32(clamp448(a), clamp448(b), w, false); w = __builtin_amdgcn_cvt_pk_fp8_f32(clamp448(c), clamp448(d), w, true); return w; }
template <class RowMap>
__device__ __forceinline__ void transpose_item_f8(const GAS float* W, int N, GAS unsigned char* WT, int ldk, LAS float* scr, int item, int lane, const RowMap& rm, float scale) {
    const int nblk = N / 32, kb = item / nblk, nb = item % nblk, k0 = 64 * kb, n0 = 32 * nb;
#pragma unroll 8
    for (int i = 0; i < 32; ++i) { const int kk = 2 * i + (lane >> 5); scr[kk * 33 + (lane & 31)] = W[(size_t)(k0 + kk) * N + n0 + (lane & 31)] * scale; }
    LDS_WAIT(); asm volatile("" ::: "memory");
    const int c = lane & 7;
#pragma unroll
    for (int j = 0; j < 4; ++j) { const int n = (lane >> 3) + 8 * j; const LAS float* s = scr + (8 * c) * 33 + n;
        v2u o; o.x = pk4_fp8(s[0 * 33], s[1 * 33], s[2 * 33], s[3 * 33]); o.y = pk4_fp8(s[4 * 33], s[5 * 33], s[6 * 33], s[7 * 33]);
        *(GAS v2u*)(WT + (size_t)rm(n0 + n) * ldk + k0 + 8 * c) = o; }
    LDS_WAIT(); asm volatile("" ::: "memory");
}
struct RmIdent { int off; __device__ int operator()(int n) const { return n + off; } };
struct RmWin { __device__ int operator()(int c) const {
    if (c < 768) return c; if (c < 800) return PH_ALR + (c - 768); if (c < 1568) return PH_HY + (c - 800); if (c < 1824) return PH_CQ + (c - 1568); if (c < 1952) return PH_CKV + (c - 1824); return PH_KR + (c - 1952); } };
struct RmGlu { int half; __device__ int operator()(int j) const { return (j >> 2) * 8 + half * 4 + (j & 3); } };

__device__ __forceinline__ void p0_weights(const Frame& F0) { const Frame F = launder(F0);
    LAS float* scr = (LAS float*)(F.lds + F.wave * 16384);
    GAS bf16* WIN = (GAS bf16*)(F.ws + WS_WIN); GAS bf16* WOUT = (GAS bf16*)(F.ws + WS_WOUT); GAS bf16* W13 = (GAS bf16*)(F.ws + WS_W13); GAS bf16* W2 = (GAS bf16*)(F.ws + WS_W2);
    GAS bf16* WUQ = (GAS bf16*)(F.ws + WS_WUQ); GAS bf16* WUKV = (GAS bf16*)(F.ws + WS_WUKV);
    constexpr int I_IN = (D / 64) * (1984 / 32), I_OUT = (D / 64) * (D / 32), I_F1 = (D / 64) * (DFF / 32), I_F2 = (DFF / 64) * (D / 32), I_UQ = (256 / 64) * (768 / 32), I_UKV = (128 / 64) * (1024 / 32);
    constexpr int NITEM = DEPTH * I_IN + DEPTH * I_OUT + 2 * I_F1 + I_F2 + DEPTH * I_UQ + DEPTH * I_UKV;
    for (int it = F.gw; it < NITEM; it += F.ngw) {
        int r = it;
        if (r < DEPTH * I_IN) { const int l = r / I_IN; transpose_item(F.in[I_WIN] + (size_t)l * D * 1984, 1984, WIN + (size_t)l * NPH * D, D, scr, r % I_IN, F.lane, RmWin{}, nullptr); continue; } r -= DEPTH * I_IN;
        if (r < DEPTH * I_OUT) { const int l = r / I_OUT; transpose_item(F.in[I_WOUT] + (size_t)l * D * D, D, WOUT + (size_t)l * D * D, D, scr, r % I_OUT, F.lane, RmIdent{0}, nullptr); continue; } r -= DEPTH * I_OUT;
        if (r < I_F1) { transpose_item(F.in[I_FW1], DFF, W13, D, scr, r, F.lane, RmGlu{0}, nullptr); continue; } r -= I_F1;
        if (r < I_F1) { transpose_item(F.in[I_FW3], DFF, W13, D, scr, r, F.lane, RmGlu{1}, nullptr); continue; } r -= I_F1;
        if (r < I_F2) { transpose_item(F.in[I_FW2], D, W2, DFF, scr, r, F.lane, RmIdent{0}, nullptr); continue; } r -= I_F2;
        if (r < DEPTH * I_UQ) { const int l = r / I_UQ; transpose_item(F.in[I_WUQ] + (size_t)l * 256 * 768, 768, WUQ + (size_t)l * 768 * 256, 256, scr, r % I_UQ, F.lane, RmIdent{0}, F.in[I_QNG] + l * 256); continue; } r -= DEPTH * I_UQ;
        { const int l = r / I_UKV; transpose_item(F.in[I_WUKV] + (size_t)l * 128 * 1024, 1024, WUKV + (size_t)l * 1024 * 256, 256, scr, r % I_UKV, F.lane, RmIdent{0}, F.in[I_KVNG] + l * 128); }
    }
    const int gt = blockIdx.x * NTHR + F.tid, ngt = F.G * NTHR;
    for (int i = gt; i < DEPTH * 64 * D / 8; i += ngt) { const int l = i / (64 * D / 8), r = i % (64 * D / 8); *(GAS v4u*)(WIN + ((size_t)l * NPH + 1984) * D + (size_t)r * 8) = (v4u){0u, 0u, 0u, 0u}; }
    for (int i = gt; i < DEPTH * 1024 * 128 / 8; i += ngt) { const int row = i / 16, c = i % 16; *(GAS v4u*)(WUKV + (size_t)row * 256 + 128 + c * 8) = (v4u){0u, 0u, 0u, 0u}; }
}

__device__ __forceinline__ void mod_store_bf16(const f32x4 (&v)[4], const GAS float* sh, const GAS float* sc, GAS bf16* orow, int lane) {
    GAS unsigned long long* o8 = (GAS unsigned long long*)orow + lane;
#pragma unroll
    for (int j = 0; j < 4; ++j) { const f32x4 a = ((const GAS f32x4*)sc)[lane + 64 * j], b = ((const GAS f32x4*)sh)[lane + 64 * j];
        const f32x4 y = v[j] * (a + 1.f) + b;
        o8[64 * j] = (unsigned long long)pk2(y.x, y.y) | ((unsigned long long)pk2(y.z, y.w) << 32); }
}
__device__ __forceinline__ void p_xn0(const Frame& F0) { const Frame F = launder(F0);
    GAS bf16* XN = (GAS bf16*)(F.ws + WS_XN);
    f32x4 nx[4];
#define XN0_LOAD(mm) do { const GAS float* src_ = (mm) < TL ? F.in[I_X] + (size_t)(mm) * D : F.in[I_CTX] + (size_t)((mm) - TL) * D; _Pragma("unroll") for (int j = 0; j < 4; ++j) nx[j] = ((const GAS f32x4*)src_)[F.lane + 64 * j]; } while (0)
    int m = F.gw; if (m < MR) XN0_LOAD(m);
    for (; m < MR; m += F.ngw) {
        f32x4 v[4];
#pragma unroll
        for (int j = 0; j < 4; ++j) v[j] = nx[j];
        if (m + F.ngw < MR) XN0_LOAD(m + F.ngw);
        const int vv = row_v(m);
        mod_store_bf16(v, modv(F, 0, vv, 0), modv(F, 0, vv, 1), XN + (size_t)m * D, F.lane);
    }
#undef XN0_LOAD
}
__device__ __forceinline__ GAS float* xres(const Frame& F, int row) { return row < TL ? F.out + (size_t)row * D : (GAS float*)(F.ws + WS_XC) + (size_t)(row - TL) * D; }
__device__ __forceinline__ void p_ln(const Frame& F0, int nrows, const GAS float* g, const GAS float* b, bool want_xn, int ml, int si) { const Frame F = launder(F0);
    GAS bf16* XN = (GAS bf16*)(F.ws + WS_XN);
    f32x4 nx[4];
    int m = F.gw; if (m < nrows) { const GAS float* r_ = xres(F, m);
#pragma unroll
        for (int j = 0; j < 4; ++j) nx[j] = ((const GAS f32x4*)r_)[F.lane + 64 * j]; }
    for (; m < nrows; m += F.ngw) {
        GAS float* row = xres(F, m);
        f32x4 v[4]; float s = 0.f;
#pragma unroll
        for (int j = 0; j < 4; ++j) { v[j] = nx[j]; s += (v[j].x + v[j].y) + (v[j].z + v[j].w); }
        if (m + F.ngw < nrows) { const GAS float* r_ = xres(F, m + F.ngw);
#pragma unroll
            for (int j = 0; j < 4; ++j) nx[j] = ((const GAS f32x4*)r_)[F.lane + 64 * j]; }
        const float mean = wave_sum(s) * (1.f / D); float s2 = 0.f;
#pragma unroll
        for (int j = 0; j < 4; ++j) { v[j] = v[j] - mean; s2 += (v[j].x * v[j].x + v[j].y * v[j].y) + (v[j].z * v[j].z + v[j].w * v[j].w); }
        const float rstd = 1.f / sqrtf(wave_sum(s2) * (1.f / D) + LN_EPS);
#pragma unroll
        for (int j = 0; j < 4; ++j) { const f32x4 gg = ((const GAS f32x4*)g)[F.lane + 64 * j], bb = ((const GAS f32x4*)b)[F.lane + 64 * j]; v[j] = v[j] * rstd * gg + bb; ((GAS f32x4*)row)[F.lane + 64 * j] = v[j]; }
        if (want_xn) { const int vv = row_v(m); mod_store_bf16(v, modv(F, ml, vv, si), modv(F, ml, vv, si + 1), XN + (size_t)m * D, F.lane); }
    }
}

using pg8::f32x4; using pg8::Unit;
struct EpiStoreBf16 {
    static constexpr bool PERM = true, AFTER_DRAIN = false;
    GAS bf16* O; int ldc; float sc;
    __device__ __forceinline__ void operator()(const pg8::f32x4 (&acc)[2][2][4][2], const Unit& u, int wr, int wc, int fr, int fq) const {
        const int row0 = u.pm * 256 + wr * 64 + fr, col0 = u.pn * 256 + wc * 32 + 8 * fq;
#pragma unroll
        for (int ai = 0; ai < 2; ++ai)
#pragma unroll
            for (int m = 0; m < 4; ++m) { GAS bf16* rowp = O + (size_t)(row0 + ai * 128 + m * 16) * ldc + col0;
#pragma unroll
                for (int bj = 0; bj < 2; ++bj) { const pg8::f32x4 v0 = acc[ai][bj][m][0] * sc, v1 = acc[ai][bj][m][1] * sc;
                    v4u w; w.x = pk2(v0[0], v0[1]); w.y = pk2(v0[2], v0[3]); w.z = pk2(v1[0], v1[1]); w.w = pk2(v1[2], v1[3]);
                    *(GAS v4u*)(rowp + bj * 128) = w; } }
    }
};
struct EpiSwiglu {
    static constexpr bool PERM = true, AFTER_DRAIN = false;
    GAS bf16* G; int ldg; float sc;
    __device__ __forceinline__ void operator()(const pg8::f32x4 (&acc)[2][2][4][2], const Unit& u, int wr, int wc, int fr, int fq) const {
        const int row0 = u.pm * 256 + wr * 64 + fr, col0 = (u.pn * 256 + wc * 32 + 8 * fq) >> 1;
#pragma unroll
        for (int ai = 0; ai < 2; ++ai)
#pragma unroll
            for (int m = 0; m < 4; ++m) { GAS bf16* rowp = G + (size_t)(row0 + ai * 128 + m * 16) * ldg + col0;
#pragma unroll
                for (int bj = 0; bj < 2; ++bj) { const pg8::f32x4 a = acc[ai][bj][m][0] * sc, b = acc[ai][bj][m][1] * sc;
                    v2u w; w.x = pk2(siluf(a[0]) * b[0], siluf(a[1]) * b[1]); w.y = pk2(siluf(a[2]) * b[2], siluf(a[3]) * b[3]);
                    *(GAS v2u*)(rowp + bj * 64) = w; } }
    }
};
struct EpiSwiglu8 {
    static constexpr bool PERM = true, AFTER_DRAIN = false;
    GAS unsigned char* G; int ldg; float sc, osc;
    __device__ __forceinline__ void operator()(const pg8::f32x4 (&acc)[2][2][4][2], const Unit& u, int wr, int wc, int fr, int fq) const {
        const int row0 = u.pm * 256 + wr * 64 + fr, col0 = (u.pn * 256 + wc * 32 + 8 * fq) >> 1;
#pragma unroll
        for (int ai = 0; ai < 2; ++ai)
#pragma unroll
            for (int m = 0; m < 4; ++m) { GAS unsigned char* rowp = G + (size_t)(row0 + ai * 128 + m * 16) * ldg + col0;
#pragma unroll
                for (int bj = 0; bj < 2; ++bj) { const pg8::f32x4 a = acc[ai][bj][m][0] * sc, b = acc[ai][bj][m][1] * sc;
                    *(GAS unsigned*)(rowp + bj * 64) = pk4_fp8(siluf(a[0]) * b[0] * osc, siluf(a[1]) * b[1] * osc, siluf(a[2]) * b[2] * osc, siluf(a[3]) * b[3] * osc); } }
    }
};
struct EpiRes {
    static constexpr bool PERM = false, AFTER_DRAIN = false;
    const GAS float* xin_lat; const GAS float* xin_ctx; GAS float* out_lat; GAS float* out_ctx; const GAS float* gate0;
    __device__ __forceinline__ void operator()(const pg8::f32x4 (&acc)[2][2][4][2], const Unit& u, int wr, int wc, int fr, int fq) const {
        const bool lat = u.pm < TL / 256; const int v = lat ? (u.pm >> 6) : 2;
        const GAS float* xin = lat ? xin_lat : xin_ctx - (size_t)TL * D; GAS float* out = lat ? out_lat : out_ctx - (size_t)TL * D;
        const GAS float* gate = gate0 + (size_t)v * 6 * D;
        const int row0 = u.pm * 256 + wr * 64 + fr, col0 = u.pn * 256 + wc * 32 + 4 * fq;
        pg8::f32x4 gv[2][2];
#pragma unroll
        for (int bj = 0; bj < 2; ++bj)
#pragma unroll
            for (int n = 0; n < 2; ++n) gv[bj][n] = *(const GAS pg8::f32x4*)(gate + col0 + bj * 128 + n * 16);
#pragma unroll
        for (int ai = 0; ai < 2; ++ai)
#pragma unroll
            for (int m = 0; m < 4; ++m) { const size_t off = (size_t)(row0 + ai * 128 + m * 16) * D + col0;
#pragma unroll
                for (int bj = 0; bj < 2; ++bj)
#pragma unroll
                    for (int n = 0; n < 2; ++n) { const pg8::f32x4 xv = *(const GAS pg8::f32x4*)(xin + off + bj * 128 + n * 16);
                        *(GAS pg8::f32x4*)(out + off + bj * 128 + n * 16) = xv * ALPHA + gv[bj][n] * acc[ai][bj][m][n]; } }
    }
};


constexpr int CW_MOECNT = 2048;
constexpr size_t WS_TI = WS_SMALL + 64 * 1024;
constexpr int MOE_CHUNK_TILES = 64, MOE_NCHUNK = 5, MOE_MAXROWS = MOE_NCHUNK * MOE_CHUNK_TILES * 256;
constexpr size_t WS_HS = AB + 65 * MiB, WS_WM13 = AB + 197 * MiB, WS_WM2 = AB + 309 * MiB, WS_GC = AB + 365 * MiB;
constexpr size_t WS_H8 = WS_XN, WS_HS8 = WS_HS + 66 * MiB;
constexpr float MOE_WSCALE = 64.f, MOE_GSCALE = 16.f, MOE_W2SCALE = 256.f;
static_assert(WS_HS + (size_t)(2 * TL + NEXP * 256) * D * 2 <= WS_WM13 && WS_WM13 + (size_t)NEXP * 2 * EFF * D * 2 <= WS_WM2 && WS_WM2 + (size_t)NEXP * D * EFF * 2 <= WS_GC && WS_GC + (size_t)MOE_CHUNK_TILES * 256 * EFF * 2 <= WS_XC, "MoE map");

__device__ __forceinline__ void p_ln_route(const Frame& F0, const GAS float* g, const GAS float* b, int l) { const Frame F = launder(F0);
    GAS bf16* XN = (GAS bf16*)(F.ws + WS_XN);
    GAS int* TI_E = (GAS int*)(F.ws + WS_TI); GAS int* TI_P0 = TI_E + TL; GAS int* TI_P1 = TI_P0 + TL; GAS float* TI_W0 = (GAS float*)(TI_P1 + TL); GAS float* TI_W1 = TI_W0 + TL;
    const GAS float* wr = F.in[I_ROUTER];
    f32x4 nx[4];
    int m = F.gw; if (m < TL) {
#pragma unroll
        for (int j = 0; j < 4; ++j) nx[j] = ((const GAS f32x4*)(F.out + (size_t)m * D))[F.lane + 64 * j]; }
    for (; m < TL; m += F.ngw) {
        GAS float* row = F.out + (size_t)m * D;
        f32x4 v[4]; float s = 0.f;
#pragma unroll
        for (int j = 0; j < 4; ++j) { v[j] = nx[j]; s += (v[j].x + v[j].y) + (v[j].z + v[j].w); }
        if (m + F.ngw < TL) {
#pragma unroll
            for (int j = 0; j < 4; ++j) nx[j] = ((const GAS f32x4*)(F.out + (size_t)(m + F.ngw) * D))[F.lane + 64 * j]; }
        const float mean = wave_sum(s) * (1.f / D); float s2 = 0.f;
#pragma unroll
        for (int j = 0; j < 4; ++j) { v[j] = v[j] - mean; s2 += (v[j].x * v[j].x + v[j].y * v[j].y) + (v[j].z * v[j].z + v[j].w * v[j].w); }
        const float rstd = 1.f / sqrtf(wave_sum(s2) * (1.f / D) + LN_EPS);
        const int vv = row_v(m); const GAS float* sh = modv(F, l, vv, 3); const GAS float* sc = modv(F, l, vv, 4);
        GAS unsigned* h8 = (GAS unsigned*)(F.ws + WS_H8 + (size_t)m * D) + F.lane;
        float lg[NEXP];
#pragma unroll
        for (int e = 0; e < NEXP; ++e) lg[e] = 0.f;
#pragma unroll
        for (int j = 0; j < 4; ++j) { const f32x4 gg = ((const GAS f32x4*)g)[F.lane + 64 * j], bb = ((const GAS f32x4*)b)[F.lane + 64 * j]; v[j] = v[j] * rstd * gg + bb; ((GAS f32x4*)row)[F.lane + 64 * j] = v[j];
            const f32x4 a = ((const GAS f32x4*)sc)[F.lane + 64 * j], c = ((const GAS f32x4*)sh)[F.lane + 64 * j];
            const f32x4 y = v[j] * (a + 1.f) + c;
            h8[64 * j] = pk4_fp8(y.x, y.y, y.z, y.w);
            const GAS f32x4* w4 = (const GAS f32x4*)(wr + (size_t)(4 * F.lane + 256 * j) * NEXP);
#pragma unroll
            for (int i = 0; i < 4; ++i) { const f32x4 wa = w4[2 * i], wb = w4[2 * i + 1]; const float yi = y[i];
                lg[0] += yi * wa.x; lg[1] += yi * wa.y; lg[2] += yi * wa.z; lg[3] += yi * wa.w; lg[4] += yi * wb.x; lg[5] += yi * wb.y; lg[6] += yi * wb.z; lg[7] += yi * wb.w; } }
#pragma unroll
        for (int e = 0; e < NEXP; ++e) lg[e] = wave_sum(lg[e]);
        int i0 = 0; float v0 = lg[0];
#pragma unroll
        for (int e = 1; e < NEXP; ++e) if (lg[e] > v0) { v0 = lg[e]; i0 = e; }
        int i1 = -1; float v1 = -3.0e38f;
#pragma unroll
        for (int e = 0; e < NEXP; ++e) if (e != i0 && lg[e] > v1) { v1 = lg[e]; i1 = e; }
        if (F.lane == 0) {
            const float w0 = 1.f / (1.f + __expf(v1 - v0));
            const int p0 = (int)__hip_atomic_fetch_add((GAS unsigned*)F.ctl + CW_MOECNT + 64 * i0, 1u, RLX_AGENT);
            const int p1 = (int)__hip_atomic_fetch_add((GAS unsigned*)F.ctl + CW_MOECNT + 64 * i1, 1u, RLX_AGENT);
            TI_E[m] = i0 | (i1 << 8); TI_P0[m] = p0; TI_P1[m] = p1; TI_W0[m] = w0; TI_W1[m] = 1.f - w0;
        }
    }
}
struct MoeBase { int bt[NEXP + 1]; };
__device__ __forceinline__ MoeBase moe_base(const Frame& F) {
    MoeBase B; int acc = 0;
#pragma unroll
    for (int e = 0; e < NEXP; ++e) { B.bt[e] = acc; const unsigned c = __hip_atomic_load((GAS unsigned*)F.ctl + CW_MOECNT + 64 * e, RLX_AGENT); acc += (int)((c + 255u) >> 8); }
    B.bt[NEXP] = acc; return B;
}
__device__ __forceinline__ void p_moe_weights(const Frame& F0) { const Frame F = launder(F0);
    LAS float* scr = (LAS float*)(F.lds + F.wave * 16384);
    GAS unsigned char* WM13 = F.ws + WS_WM13; GAS unsigned char* WM2 = F.ws + WS_WM2;
    constexpr int I1 = (D / 64) * (EFF / 32), I2 = (EFF / 64) * (D / 32), NITEM = NEXP * (2 * I1 + I2);
    for (int it = F.gw; it < NITEM; it += F.ngw) {
        const int e = it / (2 * I1 + I2); int r = it % (2 * I1 + I2);
        if (r < I1) { transpose_item_f8(F.in[I_MW1] + (size_t)e * D * EFF, EFF, WM13 + (size_t)e * 2 * EFF * D, D, scr, r, F.lane, RmGlu{0}, MOE_WSCALE); continue; } r -= I1;
        if (r < I1) { transpose_item_f8(F.in[I_MW3] + (size_t)e * D * EFF, EFF, WM13 + (size_t)e * 2 * EFF * D, D, scr, r, F.lane, RmGlu{1}, MOE_WSCALE); continue; } r -= I1;
        transpose_item_f8(F.in[I_MW2] + (size_t)e * EFF * D, D, WM2 + (size_t)e * D * EFF, EFF, scr, r, F.lane, RmIdent{0}, MOE_W2SCALE);
    }
}
__device__ __forceinline__ void p_moe_scatter(const Frame& F0) { const Frame F = launder(F0);
    const MoeBase B = moe_base(F);
    const GAS unsigned char* H8 = F.ws + WS_H8; GAS unsigned char* HS8 = F.ws + WS_HS8;
    GAS int* TI_E = (GAS int*)(F.ws + WS_TI); GAS int* TI_P0 = TI_E + TL; GAS int* TI_P1 = TI_P0 + TL;
    for (int m = F.gw; m < TL; m += F.ngw) {
        const int ee = TI_E[m], e0 = ee & 255, e1 = ee >> 8;
        int b0 = 0, b1 = 0;
#pragma unroll
        for (int e = 0; e < NEXP; ++e) { if (e == e0) b0 = B.bt[e]; if (e == e1) b1 = B.bt[e]; }
        const int s0 = b0 * 256 + TI_P0[m], s1 = b1 * 256 + TI_P1[m];
        const v4u a = *((const GAS v4u*)(H8 + (size_t)m * D) + F.lane);
        *((GAS v4u*)(HS8 + (size_t)s0 * D) + F.lane) = a; *((GAS v4u*)(HS8 + (size_t)s1 * D) + F.lane) = a;
        if (F.lane == 0) { TI_P0[m] = s0; TI_P1[m] = s1; }
    }
}
constexpr int LDS_MOEBT = LDS_MISC + 64;
__device__ __forceinline__ void moe_base_to_lds(const Frame& F) {
    if (F.tid == 0) { volatile LAS int* bt = (volatile LAS int*)(F.lds + LDS_MOEBT); int acc = 0;
        for (int e = 0; e < NEXP; ++e) { bt[e] = acc; const unsigned c = __hip_atomic_load((GAS unsigned*)F.ctl + CW_MOECNT + 64 * e, RLX_AGENT); acc += (int)((c + 255u) >> 8); }
        bt[NEXP] = acc; }
    __syncthreads();
}
struct MoeOrder {
    int nM, nN, nwg, G, c, tile0; const LAS int* bt;
    __device__ void init(const LAS int* bt_, int chunk, int nN_, int G_, int c_) {
        bt = bt_; tile0 = chunk * MOE_CHUNK_TILES; int v = bt[NEXP] - tile0; nM = v < 0 ? 0 : (v > MOE_CHUNK_TILES ? MOE_CHUNK_TILES : v); nN = nN_; nwg = nM * nN; G = G_; c = c_; }
    __device__ bool next(int i, pg8::Unit& u) const {
        const long L = (long)i * G + c; if (L >= nwg) return false;
        int wgid = (int)L; { const int q = nwg / pg8::NXCD, r = nwg % pg8::NXCD, xcd = wgid % pg8::NXCD, off = wgid / pg8::NXCD; wgid = (xcd < r ? xcd * (q + 1) : r * (q + 1) + (xcd - r) * q) + off; }
        const int nig = pg8::WGM * nN, gid = wgid / nig, fm = gid * pg8::WGM, gsz = (nM - fm) < pg8::WGM ? (nM - fm) : pg8::WGM;
        u.pm = fm + ((wgid % nig) % gsz); u.pn = (wgid % nig) / gsz;
        const int gt = tile0 + u.pm; int e = 0;
#pragma unroll
        for (int k = 1; k < NEXP; ++k) e += (gt >= bt[k]) ? 1 : 0;
        u.be = __builtin_amdgcn_readfirstlane(e); return true;
    }
    __device__ __forceinline__ void a_ready(const pg8::Unit&) const {}
    __device__ __forceinline__ void done(const pg8::Unit&) const {}
};
__device__ __forceinline__ void p_ln_combine(const Frame& F0, const GAS float* g, const GAS float* b, int l) { const Frame F = launder(F0);
    const GAS bf16* YS = (const GAS bf16*)(F.ws + WS_HS);
    GAS int* TI_E = (GAS int*)(F.ws + WS_TI); GAS int* TI_P0 = TI_E + TL; GAS int* TI_P1 = TI_P0 + TL; GAS float* TI_W0 = (GAS float*)(TI_P1 + TL); GAS float* TI_W1 = TI_W0 + TL;
    typedef unsigned long long u64_;
    int s0n = 0, s1n = 0; float w0n = 0.f, w1n = 0.f;
    f32x4 nx[4]; u64_ na[4], nc[4]; float w0c = 0.f, w1c = 0.f;
#define CMB_IDX(mm) do { s0n = TI_P0[mm]; s1n = TI_P1[mm]; w0n = TI_W0[mm]; w1n = TI_W1[mm]; } while (0)
#define CMB_DATA(mm) do { const GAS float* r_ = F.out + (size_t)(mm) * D; const GAS u64_* y0_ = (const GAS u64_*)(YS + (size_t)s0n * D) + F.lane; const GAS u64_* y1_ = (const GAS u64_*)(YS + (size_t)s1n * D) + F.lane; \
        _Pragma("unroll") for (int j = 0; j < 4; ++j) { nx[j] = ((const GAS f32x4*)r_)[F.lane + 64 * j]; na[j] = y0_[64 * j]; nc[j] = y1_[64 * j]; } w0c = w0n; w1c = w1n; } while (0)
    int m = F.gw;
    if (m < TL) { CMB_IDX(m); CMB_DATA(m); if (m + F.ngw < TL) CMB_IDX(m + F.ngw); }
    for (; m < TL; m += F.ngw) {
        GAS float* row = F.out + (size_t)m * D;
        const float w0 = w0c, w1 = w1c;
        const GAS float* gate = modv(F, l, row_v(m), 5);
        f32x4 xv[4]; u64_ av[4], cv[4];
#pragma unroll
        for (int j = 0; j < 4; ++j) { xv[j] = nx[j]; av[j] = na[j]; cv[j] = nc[j]; }
        if (m + F.ngw < TL) { CMB_DATA(m + F.ngw); if (m + 2 * F.ngw < TL) CMB_IDX(m + 2 * F.ngw); }
        f32x4 v[4]; float s = 0.f;
#pragma unroll
        for (int j = 0; j < 4; ++j) { const f32x4 x = xv[j], gt = ((const GAS f32x4*)gate)[F.lane + 64 * j];
            const u64_ a = av[j], c = cv[j];
            f32x4 f;
            f.x = w0 * bf2f((unsigned short)a) + w1 * bf2f((unsigned short)c); f.y = w0 * bf2f((unsigned short)(a >> 16)) + w1 * bf2f((unsigned short)(c >> 16));
            f.z = w0 * bf2f((unsigned short)(a >> 32)) + w1 * bf2f((unsigned short)(c >> 32)); f.w = w0 * bf2f((unsigned short)(a >> 48)) + w1 * bf2f((unsigned short)(c >> 48));
            v[j] = x * ALPHA + gt * f; s += (v[j].x + v[j].y) + (v[j].z + v[j].w); }
        const float mean = wave_sum(s) * (1.f / D); float s2 = 0.f;
#pragma unroll
        for (int j = 0; j < 4; ++j) { v[j] = v[j] - mean; s2 += (v[j].x * v[j].x + v[j].y * v[j].y) + (v[j].z * v[j].z + v[j].w * v[j].w); }
        const float rstd = 1.f / sqrtf(wave_sum(s2) * (1.f / D) + LN_EPS);
#pragma unroll
        for (int j = 0; j < 4; ++j) { const f32x4 gg = ((const GAS f32x4*)g)[F.lane + 64 * j], bb = ((const GAS f32x4*)b)[F.lane + 64 * j]; ((GAS f32x4*)row)[F.lane + 64 * j] = v[j] * rstd * gg + bb; }
    }
#undef CMB_IDX
#undef CMB_DATA
}

namespace att {
using bf16x8 = __attribute__((ext_vector_type(8))) short;
using s16x4  = __attribute__((ext_vector_type(4))) short;
using f32x16 = __attribute__((ext_vector_type(16))) float;
using u32x4  = __attribute__((ext_vector_type(4))) unsigned;
constexpr int DQ = 96, DV = 64, NW = 8, QBLK = 32, KVBLK = 64, NKEY = 16640;
constexpr float THR2 = 8.0f;
constexpr int SHM_K = KVBLK * 144, SHM_V = DV * 80;
typedef int i32x8 __attribute__((ext_vector_type(8)));
constexpr int NSLOT = 8;
constexpr int LDS_V = 0, LDS_K = NSLOT * SHM_V, LDS_WS = LDS_K + NSLOT * SHM_K, LDS_Q = LDS_WS + NW * 64 * 4, ATT_LDS = LDS_Q + NW * 4096;
#define KSWZ(row, colB) ((row) * 256 + ((colB) ^ (((row) & 7) << 4)))
#define SBAR() __builtin_amdgcn_sched_barrier(0)
__device__ __forceinline__ int crow(int r, int hi) { return (r & 3) + 8 * (r >> 2) + 4 * hi; }
__device__ __forceinline__ unsigned cvtpk(float lo, float hi) { unsigned r; asm volatile("v_cvt_pk_bf16_f32 %0, %1, %2" : "=v"(r) : "v"(lo), "v"(hi)); return r; }
template <bool FIRST>
__device__ __forceinline__ bool partialSM(f32x16& p0, f32x16& p1, f32x16& negm, float& alpha) {
  float a = fmaxf(fmaxf(p0[0], p0[1]), p1[0]), b = fmaxf(fmaxf(p0[2], p0[3]), p1[1]); a = fmaxf(fmaxf(a, p1[2]), p1[3]);
#pragma unroll
  for (int r = 4; r < 16; r += 4) { a = fmaxf(fmaxf(a, p0[r]), p0[r + 1]); b = fmaxf(fmaxf(b, p0[r + 2]), p0[r + 3]); a = fmaxf(fmaxf(a, p1[r]), p1[r + 1]); b = fmaxf(fmaxf(b, p1[r + 2]), p1[r + 3]); }
  float pmax = fmaxf(a, b);
  { auto rr = __builtin_amdgcn_permlane32_swap(__float_as_uint(pmax), __float_as_uint(pmax), false, false);
    pmax = fmaxf(__uint_as_float(rr[0]), __uint_as_float(rr[1])); }
  bool resc = false;
  if (FIRST || __builtin_expect(__any(pmax > THR2), 0)) {
    const float dl = FIRST ? pmax : fmaxf(pmax, 0.f);
#pragma unroll
    for (int r = 0; r < 16; ++r) { p0[r] -= dl; p1[r] -= dl; negm[r] -= dl; }
    alpha = __builtin_amdgcn_exp2f(-dl); resc = !FIRST;
  }
  return resc;
}
__device__ __forceinline__ void finishSM(f32x16& p0, f32x16& p1, i32x8& pb) {
#pragma unroll
  for (int r = 0; r < 16; ++r) p0[r] = __builtin_amdgcn_exp2f(p0[r]);
#pragma unroll
  for (int r = 0; r < 16; ++r) p1[r] = __builtin_amdgcn_exp2f(p1[r]);
#pragma unroll
  for (int w = 0; w < 4; ++w) {
    int x = __builtin_amdgcn_cvt_pk_fp8_f32(p0[4 * w], p0[4 * w + 1], __float_as_int(p0[4 * w]), false); x = __builtin_amdgcn_cvt_pk_fp8_f32(p0[4 * w + 2], p0[4 * w + 3], x, true); pb[w] = x;
    int y = __builtin_amdgcn_cvt_pk_fp8_f32(p1[4 * w], p1[4 * w + 1], __float_as_int(p1[4 * w]), false); y = __builtin_amdgcn_cvt_pk_fp8_f32(p1[4 * w + 2], p1[4 * w + 3], y, true); pb[4 + w] = y; }
}
__device__ __forceinline__ i32x8 ld32(const LAS char* p) { const u32x4 a = *reinterpret_cast<const LAS u32x4*>(p), b = *reinterpret_cast<const LAS u32x4*>(p + 16);
  return (i32x8){(int)a[0], (int)a[1], (int)a[2], (int)a[3], (int)b[0], (int)b[1], (int)b[2], (int)b[3]}; }
struct KFrag { i32x8 k00, k01, k10, k11; };
__device__ __forceinline__ void qkt_load(KFrag& k, const LAS char* Ks, int r32, int hi) {
  const LAS char* kp = Ks + r32 * 144 + hi * 32;
  k.k00 = ld32(kp); k.k01 = ld32(kp + 64); k.k10 = ld32(kp + 32 * 144); k.k11 = ld32(kp + 32 * 144 + 64);
}
__device__ __forceinline__ void qkt_mma(f32x16& p0, f32x16& p1, const KFrag& k, const i32x8& q0, const i32x8& q1, const f32x16& negm) {
  asm volatile("s_nop 1\n\tv_mfma_f32_32x32x64_f8f6f4 %0, %1, %2, %3" : "=&v"(p0) : "v"(k.k00), "v"(q0), "v"(negm));
  asm volatile("v_mfma_f32_32x32x64_f8f6f4 %0, %1, %2, %3" : "=&v"(p1) : "v"(k.k10), "v"(q0), "v"(negm));
  asm volatile("v_mfma_f32_32x32x64_f8f6f4 %0, %1, %2, %0" : "+v"(p0) : "v"(k.k01), "v"(q1));
  asm volatile("v_mfma_f32_32x32x64_f8f6f4 %0, %1, %2, %0" : "+v"(p1) : "v"(k.k11), "v"(q1));
}
__device__ __forceinline__ void qkt(f32x16& p0, f32x16& p1, const LAS char* Ks, const i32x8& q0, const i32x8& q1, const f32x16& negm, int r32, int hi) {
  KFrag k; qkt_load(k, Ks, r32, hi); qkt_mma(p0, p1, k, q0, q1, negm);
}
#define QK_DRAIN(P0, P1) asm volatile("s_nop 15\n\ts_nop 7" : "+v"(P0), "+v"(P1))
__device__ __forceinline__ void pv_d0(f32x16* o, const LAS char* Vs, const i32x8& pb, int r32, int hi) {
  const LAS char* vp = Vs + r32 * 80 + hi * 32;
  const u32x4 a0 = *reinterpret_cast<const LAS u32x4*>(vp), a1 = *reinterpret_cast<const LAS u32x4*>(vp + 16);
  const u32x4 b0 = *reinterpret_cast<const LAS u32x4*>(vp + 32 * 80), b1 = *reinterpret_cast<const LAS u32x4*>(vp + 32 * 80 + 16);
  const i32x8 va = {(int)a0[0], (int)a0[1], (int)a0[2], (int)a0[3], (int)a1[0], (int)a1[1], (int)a1[2], (int)a1[3]};
  const i32x8 vb = {(int)b0[0], (int)b0[1], (int)b0[2], (int)b0[3], (int)b1[0], (int)b1[1], (int)b1[2], (int)b1[3]};
  const i32x8 ones = {0x38383838, 0x38383838, 0x38383838, 0x38383838, 0x38383838, 0x38383838, 0x38383838, 0x38383838};
  asm volatile("s_nop 1\n\tv_mfma_f32_32x32x64_f8f6f4 %0, %1, %2, %0" : "+v"(o[0]) : "v"(va), "v"(pb));
  asm volatile("v_mfma_f32_32x32x64_f8f6f4 %0, %1, %2, %0" : "+v"(o[1]) : "v"(vb), "v"(pb));
  asm volatile("v_mfma_f32_32x32x64_f8f6f4 %0, %1, %2, %0" : "+v"(o[2]) : "v"(ones), "v"(pb));
}
#define PV_DRAIN() asm volatile("s_nop 15\n\ts_nop 7" : "+v"(o[0]), "+v"(o[1]), "+v"(o[2]))
#define QK_A(P, KA, QA) asm volatile("s_nop 1\n\tv_mfma_f32_32x32x64_f8f6f4 %0, %1, %2, %3" : "=&v"(P) : "v"(KA), "v"(QA), "v"(negm))
#define QK_B(P, KA, QA) asm volatile("v_mfma_f32_32x32x64_f8f6f4 %0, %1, %2, %3" : "=&v"(P) : "v"(KA), "v"(QA), "v"(negm))
#define QK_C(P, KA, QA) asm volatile("v_mfma_f32_32x32x64_f8f6f4 %0, %1, %2, %0" : "+v"(P) : "v"(KA), "v"(QA))
#define PV_A(O, VA) asm volatile("s_nop 1\n\tv_mfma_f32_32x32x64_f8f6f4 %0, %1, %2, %0" : "+v"(O) : "v"(VA), "v"(pb))
#define PV_B(O, VA) asm volatile("v_mfma_f32_32x32x64_f8f6f4 %0, %1, %2, %0" : "+v"(O) : "v"(VA), "v"(pb))
#define EXPS(P, lo, hi_) do { _Pragma("unroll") for (int r_ = (lo); r_ < (hi_); ++r_) P[r_] = __builtin_amdgcn_exp2f(P[r_]); } while (0)
#define CVT4(P, w_, dst) do { int x_ = __builtin_amdgcn_cvt_pk_fp8_f32(P[4 * (w_)], P[4 * (w_) + 1], __float_as_int(P[4 * (w_)]), false); dst = __builtin_amdgcn_cvt_pk_fp8_f32(P[4 * (w_) + 2], P[4 * (w_) + 3], x_, true); } while (0)
__device__ __forceinline__ float mx3(float a, float b, float c) { float r; asm("v_max3_f32 %0, %1, %2, %3" : "=v"(r) : "v"(a), "v"(b), "v"(c)); return r; }
__device__ __forceinline__ float max16(const f32x16& p, float prev) {
  float a, b;
  asm("v_max3_f32 %0, %2, %3, %4\n\tv_max3_f32 %1, %5, %6, %7\n\tv_max3_f32 %0, %0, %8, %9\n\tv_max3_f32 %1, %1, %10, %11\n\t"
      "v_max3_f32 %0, %0, %12, %13\n\tv_max3_f32 %1, %1, %14, %15\n\tv_max3_f32 %0, %0, %16, %17\n\tv_max3_f32 %0, %0, %1, %18"
      : "=&v"(a), "=&v"(b)
      : "v"(p[0]), "v"(p[1]), "v"(p[2]), "v"(p[3]), "v"(p[4]), "v"(p[5]), "v"(p[6]), "v"(p[7]), "v"(p[8]), "v"(p[9]), "v"(p[10]), "v"(p[11]), "v"(p[12]), "v"(p[13]), "v"(p[14]), "v"(p[15]), "v"(prev));
  return a;
}
__device__ __forceinline__ void attn_unit(const GAS unsigned char* __restrict__ Qb, const GAS unsigned char* __restrict__ Kh, const GAS unsigned char* __restrict__ Vh,
                                          GAS unsigned short* __restrict__ Ob, int ldo, int seq, LAS char* lds, int tid) {
  const int wid = tid >> 6, lane = tid & 63, r32 = lane & 31, hi = lane >> 5;
  LAS char* V_lds = lds + LDS_V; LAS char* K_lds = lds + LDS_K;
  f32x16 o[3] = {}; f32x16 negm = {};
  const GAS unsigned char* Qw = Qb + (long)(wid * QBLK + r32) * 128 + hi * 32;
  i32x8 q0, q1;
  { const u32x4 a = *reinterpret_cast<const GAS u32x4*>(Qw), b = *reinterpret_cast<const GAS u32x4*>(Qw + 16), c = *reinterpret_cast<const GAS u32x4*>(Qw + 64), d = *reinterpret_cast<const GAS u32x4*>(Qw + 80);
    q0 = (i32x8){(int)a[0], (int)a[1], (int)a[2], (int)a[3], (int)b[0], (int)b[1], (int)b[2], (int)b[3]}; q1 = (i32x8){(int)c[0], (int)c[1], (int)c[2], (int)c[3], (int)d[0], (int)d[1], (int)d[2], (int)d[3]}; }
  const int vst = (tid >> 3) * 80 + (tid & 7) * 8;
  const int kst0 = (tid >> 3) * 144 + (tid & 7) * 16;
  const GAS unsigned char* Ku = (const GAS unsigned char*)(((unsigned long long)(unsigned)__builtin_amdgcn_readfirstlane((unsigned)((unsigned long long)Kh >> 32)) << 32) | (unsigned long long)(unsigned)__builtin_amdgcn_readfirstlane((unsigned)(unsigned long long)Kh));
  const GAS unsigned char* Vu = (const GAS unsigned char*)(((unsigned long long)(unsigned)__builtin_amdgcn_readfirstlane((unsigned)((unsigned long long)Vh >> 32)) << 32) | (unsigned long long)(unsigned)__builtin_amdgcn_readfirstlane((unsigned)(unsigned long long)Vh));
  const unsigned ko = (unsigned)tid * 16u, vo = (unsigned)tid * 8u;
  bf16x8 sk; v2u sv;
#define SLOAD(t) do { sk = *reinterpret_cast<const GAS bf16x8*>(Ku + (size_t)(t) * (KVBLK * 128) + ko); sv = *reinterpret_cast<const GAS v2u*>(Vu + (size_t)(t) * 4096 + vo); } while (0)
#define SWRITE(t) do { *(LAS bf16x8*)(K_lds + ((t) & 7) * SHM_K + kst0) = sk; *(LAS v2u*)(V_lds + ((t) & 7) * SHM_V + vst) = sv; } while (0)
#define KS(t) (K_lds + ((t) & 7) * SHM_K)
#define VS(t) (V_lds + ((t) & 7) * SHM_V)
#define RESC(flag, a) do { if (flag) { PV_DRAIN(); _Pragma("unroll") for (int d = 0; d < 3; ++d) _Pragma("unroll") for (int r = 0; r < 16; ++r) o[d][r] *= (a); } } while (0)
#define PSM_TAIL(N0, N1, pm) do { \
    if (__builtin_expect(__any((pm) > THR2), 0)) { float pmax = (pm);     \
      { auto rr = __builtin_amdgcn_permlane32_swap(__float_as_uint(pmax), __float_as_uint(pmax), false, false); pmax = fmaxf(__uint_as_float(rr[0]), __uint_as_float(rr[1])); } \
      const float dl = fmaxf(pmax, 0.f); \
      _Pragma("unroll") for (int r = 0; r < 16; ++r) { N0[r] -= dl; N1[r] -= dl; negm[r] -= dl; } \
      const float al = __builtin_amdgcn_exp2f(-dl); RESC(true, al); } } while (0)
#define HI(j, C0, C1, N0, N1, DO_BAR, DO_QK, DO_KR, DO_SW, DO_SL) do { \
    if (DO_BAR) __syncthreads(); \
    if (DO_SW) SWRITE((j) + 4); \
    if (DO_SL) SLOAD((j) + 5); \
    SBAR(); \
    if (DO_QK) { QK_A(N0, kf.k00, q0); SBAR(); } \
    EXPS(C0, 0, 7); SBAR(); \
    if (DO_QK) { QK_B(N1, kf.k10, q0); SBAR(); } \
    EXPS(C0, 7, 14); SBAR(); \
    if (DO_QK) { QK_C(N0, kf.k01, q1); SBAR(); } \
    EXPS(C0, 14, 16); CVT4(C0, 0, pb[0]); CVT4(C0, 1, pb[1]); CVT4(C0, 2, pb[2]); EXPS(C1, 0, 2); SBAR(); \
    if (DO_QK) { QK_C(N1, kf.k11, q1); SBAR(); } \
    { const LAS char* vp = VS(j) + r32 * 80 + hi * 32; va = ld32(vp); vb = ld32(vp + 32 * 80); } \
    EXPS(C1, 2, 9); SBAR(); \
    EXPS(C1, 9, 16); CVT4(C0, 3, pb[3]); CVT4(C1, 0, pb[4]); CVT4(C1, 1, pb[5]); CVT4(C1, 2, pb[6]); CVT4(C1, 3, pb[7]); SBAR(); \
    PV_A(o[0], va); SBAR(); \
    float pm_ = 0.f; if (DO_QK) { pm_ = max16(N0, N0[15]); SBAR(); } \
    PV_B(o[1], vb); SBAR(); \
    if (DO_KR) { qkt_load(kf, KS((j) + 2), r32, hi); SBAR(); } \
    if (DO_QK) { pm_ = max16(N1, pm_); SBAR(); } \
    PV_B(o[2], ones); SBAR(); \
    if (DO_QK) PSM_TAIL(N0, N1, pm_); \
  } while (0)
  i32x8 ones = {0x38383838, 0x38383838, 0x38383838, 0x38383838, 0x38383838, 0x38383838, 0x38383838, 0x38383838};
  asm volatile("" : "+v"(ones));
  f32x16 pA0, pA1, pB0, pB1; i32x8 pb, va, vb; KFrag kf; const int NT = seq / KVBLK;
  SLOAD(0); SWRITE(0); SLOAD(1); SWRITE(1); SLOAD(2); SWRITE(2); SLOAD(3); SWRITE(3); if (NT > 4) SLOAD(4);
  __syncthreads();
  { float al0; qkt(pA0, pA1, KS(0), q0, q1, negm, r32, hi); QK_DRAIN(pA0, pA1); (void)partialSM<true>(pA0, pA1, negm, al0); }
  qkt_load(kf, KS(1), r32, hi);
  int j = 0;
  for (; j + 6 < NT; j += 2) {
    HI(j, pA0, pA1, pB0, pB1, true, true, true, true, true);
    HI(j + 1, pB0, pB1, pA0, pA1, false, true, true, true, true);
  }
  for (; j < NT; j += 2) {
    HI(j, pA0, pA1, pB0, pB1, true, true, (j + 2 < NT), (j + 4 < NT), (j + 5 < NT));
    HI(j + 1, pB0, pB1, pA0, pA1, false, (j + 2 < NT), (j + 3 < NT), (j + 5 < NT), (j + 6 < NT));
  }
#undef KS
#undef VS
  PV_DRAIN();
  const float rl = __builtin_amdgcn_rcpf(o[2][0]);
  GAS unsigned short* Ow = Ob + (long)(wid * QBLK + r32) * ldo + 4 * hi;
#pragma unroll
  for (int d0 = 0; d0 < 2; ++d0)
#pragma unroll
    for (int g = 0; g < 4; ++g) { unsigned long long w = (unsigned long long)cvtpk(o[d0][4 * g] * rl, o[d0][4 * g + 1] * rl) | ((unsigned long long)cvtpk(o[d0][4 * g + 2] * rl, o[d0][4 * g + 3] * rl) << 32);
      *(GAS unsigned long long*)(Ow + d0 * 32 + g * 8) = w; }
  __syncthreads();
#undef SLOAD
#undef SWRITE
#undef RESC
#undef HI
#undef PSM_TAIL
}
#undef KSWZ
}

constexpr size_t WS_ROPE = WS_SMALL;
constexpr size_t WS_RSQ = WS_SMALL + 704 * 1024, WS_RSKV = WS_RSQ + (size_t)MR * 4;
static_assert(WS_RSKV + (size_t)MR * 4 <= WS_WIN, "small map");
constexpr size_t WS_QC = WS_Q + (size_t)NBATCH * 8 * SEQ * 128;
constexpr float MLA_QS = 4.f, MLA_KS = 0.25f;
static_assert(WS_QC + (size_t)NBATCH * 8 * CTXL * 128 <= WS_K && WS_K + (size_t)NBATCH * 8 * 16640 * 128 <= WS_V, "q8/k8 map");
constexpr float MLA_C2 = 0.10206207261596575f * 1.4426950408889634f;

__device__ __forceinline__ void p0_rope_table(const Frame& F0) { const Frame F = launder(F0);
    GAS float* T = (GAS float*)(F.ws + WS_ROPE);
    for (int i = blockIdx.x * NTHR + F.tid; i < 256 * 8; i += F.G * NTHR) {
        const int pos = i >> 3, e = i & 7;
        double inv = 1.0; for (int k = 0; k < (e >> 1); ++k) inv *= 0.1; if (e & 1) inv *= 0.31622776601683794;
        double rev = (double)pos * inv * 0.15915494309189535; rev -= (double)(long long)rev;
        T[2 * i] = __builtin_amdgcn_cosf((float)rev); T[2 * i + 1] = __builtin_amdgcn_sinf((float)rev);
    }
}
__device__ __forceinline__ void p_prep_mla_rows(const Frame& F0) { const Frame F = launder(F0);
    const GAS bf16* PH = (const GAS bf16*)(F.ws + WS_PH);
    GAS float* RSQ = (GAS float*)(F.ws + WS_RSQ); GAS float* RSKV = (GAS float*)(F.ws + WS_RSKV); const GAS float* T = (const GAS float*)(F.ws + WS_ROPE);
    constexpr int RB = 4;
    for (int m0 = F.gw; m0 < MR; m0 += RB * F.ngw) {
        unsigned long long q4[RB], k4[RB]; float xr[RB];
#pragma unroll
        for (int j = 0; j < RB; ++j) { const int m = m0 + j * F.ngw; q4[j] = 0; k4[j] = 0; xr[j] = 0.f;
            if (m < MR) { const GAS bf16* row = PH + (size_t)m * NPH; q4[j] = *((const GAS unsigned long long*)(row + PH_CQ) + F.lane);
                if (F.lane < 32) { k4[j] = *((const GAS unsigned long long*)(row + PH_CKV) + F.lane); xr[j] = bf2f(row[PH_KR + F.lane]); } } }
#pragma unroll
        for (int j = 0; j < RB; ++j) { const int m = m0 + j * F.ngw; if (m >= MR) break;
        float a0 = bf2f((unsigned short)q4[j]), a1 = bf2f((unsigned short)(q4[j] >> 16)), a2 = bf2f((unsigned short)(q4[j] >> 32)), a3 = bf2f((unsigned short)(q4[j] >> 48));
        const float sq = wave_sum(a0 * a0 + a1 * a1 + a2 * a2 + a3 * a3);
        float skv = 0.f; const float x = xr[j];
        if (F.lane < 32) { a0 = bf2f((unsigned short)k4[j]); a1 = bf2f((unsigned short)(k4[j] >> 16)); a2 = bf2f((unsigned short)(k4[j] >> 32)); a3 = bf2f((unsigned short)(k4[j] >> 48));
            skv = a0 * a0 + a1 * a1 + a2 * a2 + a3 * a3; }
        skv = wave_sum(skv);
        if (F.lane == 0) { RSQ[m] = 1.f / sqrtf(sq * (1.f / 256.f) + RMS_EPS); RSKV[m] = 1.f / sqrtf(skv * (1.f / 128.f) + RMS_EPS); }
        const float xp = __shfl_xor(x, 8);
        int b, pos; float y = x;
        if (m < TL) { b = m >> 14; const int t = m & (SEQ - 1); pos = CTXL + t;
            const int i = F.lane & 31, half = i >> 4, w = i & 15, p = half ? (t & 63) : (t >> 6); const float c = T[(p * 8 + (w & 7)) * 2], s = T[(p * 8 + (w & 7)) * 2 + 1];
            y = (w < 8) ? (x * c - xp * s) : (xp * s + x * c); }
        else { b = (m - TL) >> 8; pos = (m - TL) & 255; }
        {
          const unsigned yb = pk4_fp8(F.lane < 32 ? y * MLA_KS : 0.f, 0.f, 0.f, 0.f) & 0xffu;
          const int q0 = (F.lane & 7) * 4;
          const unsigned dw = (unsigned)__shfl((int)yb, q0) | ((unsigned)__shfl((int)yb, q0 + 1) << 8) | ((unsigned)__shfl((int)yb, q0 + 2) << 16) | ((unsigned)__shfl((int)yb, q0 + 3) << 24);
          const unsigned kv = (F.lane & 8) ? 0u : dw;
          GAS unsigned char* K8 = F.ws + WS_K; GAS unsigned char* Q8 = m < TL ? F.ws + WS_Q : F.ws + WS_QC; const int qrows = m < TL ? SEQ : CTXL, qt = m < TL ? (m & (SEQ - 1)) : pos;
#pragma unroll
          for (int hh = 0; hh < 2; ++hh) { const int h = hh * 4 + (F.lane >> 4); *(GAS unsigned*)(K8 + ((size_t)(b * 8 + h) * att::NKEY + pos) * 128 + 64 + (F.lane & 15) * 4) = kv; }
          { const int h = F.lane >> 3; *(GAS unsigned*)(Q8 + ((size_t)(b * 8 + h) * qrows + qt) * 128 + 96 + (F.lane & 7) * 4) = 0u; } }
        }
    }
}
struct EpiMlaQ {
    static constexpr bool PERM = true, AFTER_DRAIN = false;
    GAS unsigned char* Q; GAS unsigned char* QC; const GAS float* rsq; const GAS float* rope;
    __device__ __forceinline__ void operator()(const pg8::f32x4 (&acc)[2][2][4][2], const Unit& u, int wr, int wc, int fr, int fq) const {
        const bool lat = u.pm < TL / 256;
        const int b = lat ? (u.pm >> 6) : (u.pm - TL / 256), t0 = lat ? (u.pm & 63) * 256 : 0, rows = lat ? SEQ : CTXL;
        GAS unsigned char* base = lat ? Q : QC;
        const unsigned lane_off = (unsigned)((wr * 64 + fr) * 128 + 8 * fq);
        const GAS float* rsp = rsq + u.pm * 256 + wr * 64 + fr;
#pragma unroll
        for (int ai = 0; ai < 2; ++ai)
#pragma unroll
            for (int m = 0; m < 4; ++m) { const float rs = rsp[ai * 128 + m * 16] * (MLA_C2 * MLA_QS);
                const int trow = t0 + ai * 128 + m * 16;
#pragma unroll
                for (int bj = 0; bj < 2; ++bj) { const int g32 = 8 * u.pn + 4 * bj + wc, head = g32 / 3, part = g32 - 3 * head;
                    float x[8];
#pragma unroll
                    for (int i = 0; i < 4; ++i) { x[i] = acc[ai][bj][m][0][i] * rs; x[4 + i] = acc[ai][bj][m][1][i] * rs; }
                    if (part == 2 && lat) {
                        const int p = (fq < 2) ? ((trow >> 6) + wr) : (m * 16 + fr); const GAS f32x4* cs = (const GAS f32x4*)(rope + p * 16);
#pragma unroll
                        for (int i2 = 0; i2 < 4; ++i2) { const f32x4 c4 = cs[i2];
                            const float xa = __shfl_xor(x[2 * i2], 16), xb = __shfl_xor(x[2 * i2 + 1], 16);
                            x[2 * i2] = (fq & 1) ? (xa * c4.y + x[2 * i2] * c4.x) : (x[2 * i2] * c4.x - xa * c4.y);
                            x[2 * i2 + 1] = (fq & 1) ? (xb * c4.w + x[2 * i2 + 1] * c4.z) : (x[2 * i2 + 1] * c4.z - xb * c4.w); }
                    }
                    v2u w; w.x = pk4_fp8(x[0], x[1], x[2], x[3]); w.y = pk4_fp8(x[4], x[5], x[6], x[7]);
                    const size_t soff = (((size_t)(b * 8 + head) * rows + trow) * 128 + part * 32);
                    *(GAS v2u*)(base + soff + lane_off) = w; }
                asm volatile("" ::: "memory"); }
    }
};
struct EpiMlaKV {
    static constexpr bool PERM = true, AFTER_DRAIN = false;
    GAS unsigned char* K; GAS bf16* V; const GAS float* rskv;
    __device__ __forceinline__ void operator()(const pg8::f32x4 (&acc)[2][2][4][2], const Unit& u, int wr, int wc, int fr, int fq) const {
        const bool lat = u.pm < TL / 256;
        const int b = lat ? (u.pm >> 6) : (u.pm - TL / 256), pos0 = lat ? CTXL + (u.pm & 63) * 256 : 0;
        const bool isk = wc < 2;
        const unsigned lane_off = isk ? (unsigned)((wr * 64 + fr) * 128 + 32 * (wc & 1) + 8 * fq) : (unsigned)(((wr * 64 + fr) * 64 + 32 * (wc & 1) + 8 * fq) * 2);
        const GAS float* rsp = rskv + u.pm * 256 + wr * 64 + fr;
#pragma unroll
        for (int ai = 0; ai < 2; ++ai)
#pragma unroll
            for (int m = 0; m < 4; ++m) { const float rs = rsp[ai * 128 + m * 16];
#pragma unroll
                for (int bj = 0; bj < 2; ++bj) { const int head = 2 * u.pn + bj;
                    const size_t rk = (size_t)(b * 8 + head) * att::NKEY + pos0 + ai * 128 + m * 16;
                    if (isk) { const pg8::f32x4 v0 = acc[ai][bj][m][0] * (rs * MLA_KS), v1 = acc[ai][bj][m][1] * (rs * MLA_KS);
                        v2u w; w.x = pk4_fp8(v0[0], v0[1], v0[2], v0[3]); w.y = pk4_fp8(v1[0], v1[1], v1[2], v1[3]);
                        *(GAS v2u*)(K + rk * 128 + lane_off) = w; }
                    else { const pg8::f32x4 v0 = acc[ai][bj][m][0] * rs, v1 = acc[ai][bj][m][1] * rs;
                        v4u w; w.x = pk2(v0[0], v0[1]); w.y = pk2(v0[2], v0[3]); w.z = pk2(v1[0], v1[1]); w.w = pk2(v1[2], v1[3]);
                        *(GAS v4u*)((GAS char*)V + rk * 128 + lane_off) = w; } }
                asm volatile("" ::: "memory"); }
    }
};
constexpr size_t WS_V8T = WS_QC + (size_t)NBATCH * 8 * CTXL * 128;
static_assert(WS_V8T + (size_t)NBATCH * 8 * (att::NKEY / 64) * 4096 <= WS_K, "v8t map");
__device__ __forceinline__ void p_attn_vt_pack(const Frame& F0) { const Frame F = launder(F0);
    LAS unsigned short* VL = (LAS unsigned short*)F.lds; const int tid = F.tid;
    const GAS bf16* V = (const GAS bf16*)(F.ws + WS_V); GAS unsigned char* V8T = F.ws + WS_V8T;
    const int ntile = att::NKEY / 64;
    for (int u = blockIdx.x; u < NBATCH * 8 * ntile; u += F.G) {
        const int bh = u / ntile, t = u % ntile;
        { const int key = tid >> 3, c8 = (tid & 7) * 8; const v4u w = *(const GAS v4u*)(V + ((size_t)bh * att::NKEY + t * 64 + key) * 64 + c8);
          LAS unsigned short* d = VL + key * 66 + c8; d[0] = (unsigned short)w.x; d[1] = (unsigned short)(w.x >> 16); d[2] = (unsigned short)w.y; d[3] = (unsigned short)(w.y >> 16);
          d[4] = (unsigned short)w.z; d[5] = (unsigned short)(w.z >> 16); d[6] = (unsigned short)w.w; d[7] = (unsigned short)(w.w >> 16); }
        __syncthreads();
        { const int v = tid >> 3, s8 = (tid & 7) * 8; float x[8];
#pragma unroll
          for (int e = 0; e < 8; ++e) { const int slot = s8 + e, hi = slot >> 5, j = slot & 31, jj = j & 15, key = (j >> 4) * 32 + (jj & 3) + 8 * (jj >> 2) + 4 * hi; x[e] = bf2f(VL[key * 66 + v]); }
          v2u o; o.x = pk4_fp8(x[0], x[1], x[2], x[3]); o.y = pk4_fp8(x[4], x[5], x[6], x[7]);
          *(GAS v2u*)(V8T + (size_t)u * 4096 + v * 64 + s8) = o; }
        __syncthreads();
    }
}
__device__ __forceinline__ void p_attention(const Frame& F0, bool with_ctx) { const Frame F = launder(F0);
    const GAS unsigned char* Q = F.ws + WS_Q; const GAS unsigned char* QC = F.ws + WS_QC; const GAS unsigned char* K = F.ws + WS_K; const GAS unsigned char* V8T = F.ws + WS_V8T;
    GAS bf16* Y = (GAS bf16*)(F.ws + WS_Y);
    LAS char* lds = (LAS char*)F.lds;
    const int nlat = NBATCH * 8 * (SEQ / 256);
    for (int i = 0;; ++i) {
        const int L = i * F.G + (int)blockIdx.x; if (L >= nlat) break;
        int bh, qb;
        if (F.G == 256) { const int xcd = blockIdx.x & 7, slot = blockIdx.x >> 3; bh = xcd + 8 * (i >> 1); qb = (i & 1) * 32 + slot; }
        else { bh = L / (SEQ / 256); qb = L % (SEQ / 256); }
        const int b = bh >> 3, h = bh & 7;
        att::attn_unit(Q + ((size_t)bh * SEQ + qb * 256) * 128, K + (size_t)bh * att::NKEY * 128, V8T + (size_t)bh * (att::NKEY / 64) * 4096,
                       Y + ((size_t)b * SEQ + qb * 256) * D + 512 + h * 64, D, att::NKEY, lds, F.tid);
    }
    if (with_ctx && (int)blockIdx.x < NBATCH * 8) { const int bh = blockIdx.x, b = bh >> 3, h = bh & 7;
        att::attn_unit(QC + (size_t)bh * CTXL * 128, K + (size_t)bh * att::NKEY * 128, V8T + (size_t)bh * (att::NKEY / 64) * 4096,
                       Y + ((size_t)TL + b * CTXL) * D + 512 + h * 64, D, CTXL, lds, F.tid);
    }
}
__device__ __forceinline__ void p_ynorm_c(const Frame& F0, int nrows, const GAS float* mg) { const Frame F = launder(F0);
    GAS bf16* Y = (GAS bf16*)(F.ws + WS_Y);
    const f32x4 g0 = ((const GAS f32x4*)mg)[2 * F.lane], g1 = ((const GAS f32x4*)mg)[2 * F.lane + 1];
    constexpr int RB = 4;
    for (int m0 = F.gw; m0 < nrows; m0 += RB * F.ngw) {
        v4u w[RB];
#pragma unroll
        for (int j = 0; j < RB; ++j) { const int m = m0 + j * F.ngw; w[j] = (v4u){0u, 0u, 0u, 0u}; if (m < nrows) w[j] = *((const GAS v4u*)(Y + (size_t)m * D + 512) + F.lane); }
#pragma unroll
        for (int j = 0; j < RB; ++j) { const int m = m0 + j * F.ngw; if (m >= nrows) break;
            float x[8]; x[0] = bf2f((unsigned short)w[j].x); x[1] = bf2f((unsigned short)(w[j].x >> 16)); x[2] = bf2f((unsigned short)w[j].y); x[3] = bf2f((unsigned short)(w[j].y >> 16));
            x[4] = bf2f((unsigned short)w[j].z); x[5] = bf2f((unsigned short)(w[j].z >> 16)); x[6] = bf2f((unsigned short)w[j].w); x[7] = bf2f((unsigned short)(w[j].w >> 16));
            float s = 0.f;
#pragma unroll
            for (int i = 0; i < 8; ++i) s += x[i] * x[i];
            const float rs = 1.f / sqrtf(wave_sum(s) * (1.f / 512.f) + RMS_EPS);
            v4u o; o.x = pk2(x[0] * rs * g0.x, x[1] * rs * g0.y); o.y = pk2(x[2] * rs * g0.z, x[3] * rs * g0.w); o.z = pk2(x[4] * rs * g1.x, x[5] * rs * g1.y); o.w = pk2(x[6] * rs * g1.z, x[7] * rs * g1.w);
            *((GAS v4u*)(Y + (size_t)m * D + 512) + F.lane) = o; }
    }
}

constexpr int GLA_NCH = 4 + SEQ / 64;
constexpr size_t WS_SLOC = WS_XN, WS_GDEC = AB + 521 * MiB;
static_assert(WS_SLOC + (size_t)NBATCH * 4 * 2 * GLA_NCH * 2048 * 4 <= WS_XN + 33 * MiB && (size_t)NBATCH * 4 * 2 * GLA_NCH * 32 * 4 <= 5 * MiB && GLA_NCH % 20 == 0, "gla map");
constexpr int GB_LA = 0, GB_K = GB_LA + 16384, GB_Q = GB_K + 8192, GB_ALR = GB_Q + 8192, GB_WG = GB_ALR + 8192, GB_BG = GB_WG + 4096, GB_O = GB_BG + 256,
              GB_QF = GB_O + 64 * 65 * 4, GB_QB = GB_QF + 5120, GB_KF = GB_QB + 5120, GB_KB = GB_KF + 5120, GB_KTF = GB_KB + 5120, GB_KTB = GB_KTF + 4608, GB_VT = GB_KTB + 4608,
              GB_ATT = GB_VT + 9216, GB_STF = GB_ATT + 9216, GB_STB = GB_STF + 5120, GB_END = GB_STB + 5120;
static_assert(GB_END <= 131072 && GB_QF % 16 == 0, "gla lds");
typedef short gbf16x8 __attribute__((ext_vector_type(8)));
typedef float gf32x16 __attribute__((ext_vector_type(16)));
__device__ __forceinline__ float logsigmoidf(float z) { return fminf(z, 0.f) - __logf(1.f + __expf(-fabsf(z))); }
__device__ __forceinline__ unsigned short bf1(float x) { return (unsigned short)(pk2(x, x) & 0xffffu); }
__device__ __forceinline__ void ld8bf(const GAS bf16* p, LAS float* d) { const v4u w = *(const GAS v4u*)p;
    d[0] = bf2f((unsigned short)w.x); d[1] = bf2f((unsigned short)(w.x >> 16)); d[2] = bf2f((unsigned short)w.y); d[3] = bf2f((unsigned short)(w.y >> 16));
    d[4] = bf2f((unsigned short)w.z); d[5] = bf2f((unsigned short)(w.z >> 16)); d[6] = bf2f((unsigned short)w.w); d[7] = bf2f((unsigned short)(w.w >> 16)); }
__device__ __forceinline__ int gcrow(int r, int hi) { return (r & 3) + 8 * (r >> 2) + 4 * hi; }
template <int KD>
__device__ __forceinline__ void gmm(gf32x16& acc, const LAS unsigned char* A, int sa, int m0, const LAS unsigned char* BT, int sb, int n0, int r32, int hi) {
#pragma unroll
    for (int kt = 0; kt < KD / 16; ++kt) { const gbf16x8 a = *(const LAS gbf16x8*)(A + (m0 + r32) * sa + (kt * 16 + hi * 8) * 2), b = *(const LAS gbf16x8*)(BT + (n0 + r32) * sb + (kt * 16 + hi * 8) * 2);
        acc = __builtin_amdgcn_mfma_f32_32x32x16_bf16(a, b, acc, 0, 0, 0); }
}
template <int CTRL, int RM> __device__ __forceinline__ float gdpp(float v) { return __int_as_float(__builtin_amdgcn_update_dpp(0, __float_as_int(v), CTRL, RM, 0xf, false)); }
struct GlaRegs { v4u kq, al, vv; float w0, w1, bg; };
__device__ __forceinline__ int gla_row0(int b, int jj) { return jj < 4 ? TL + b * CTXL + jj * 64 : b * SEQ + (jj - 4) * 64; }
__device__ __forceinline__ void st8bf(const v4u w, LAS float* d) {
    d[0] = bf2f((unsigned short)w.x); d[1] = bf2f((unsigned short)(w.x >> 16)); d[2] = bf2f((unsigned short)w.y); d[3] = bf2f((unsigned short)(w.y >> 16));
    d[4] = bf2f((unsigned short)w.z); d[5] = bf2f((unsigned short)(w.z >> 16)); d[6] = bf2f((unsigned short)w.w); d[7] = bf2f((unsigned short)(w.w >> 16)); }
__device__ __forceinline__ void gla_issue(const Frame& F, int l, int b, int h, int jj, bool want_q, GlaRegs& R) {
    const int tid = F.tid;
    const GAS bf16* PH = (const GAS bf16*)(F.ws + WS_PH) + (size_t)gla_row0(b, jj) * NPH;
    { const int t = (tid & 255) >> 2, c = (tid & 3) * 8;
      if (tid < 256) { R.kq = *(const GAS v4u*)(PH + (size_t)t * NPH + PH_KA + h * 32 + c); R.al = *(const GAS v4u*)(PH + (size_t)t * NPH + PH_ALR + c); }
      else if (want_q) R.kq = *(const GAS v4u*)(PH + (size_t)t * NPH + PH_QA + h * 32 + c); }
    { const int t = tid >> 3, c = (tid & 7) * 8; R.vv = *(const GAS v4u*)(PH + (size_t)t * NPH + PH_VA + h * 64 + c); }
    { const GAS float* wg = F.in[I_GWG] + (size_t)l * 2 * 16 * 128;
      { const int i = tid, d = i >> 9, r = (i >> 5) & 15, k = i & 31; R.w0 = wg[(d * 16 + r) * 128 + h * 32 + k]; }
      { const int i = tid + 512, d = i >> 9, r = (i >> 5) & 15, k = i & 31; R.w1 = wg[(d * 16 + r) * 128 + h * 32 + k]; }
      if (tid < 64) R.bg = F.in[I_GBG][l * 256 + (tid >> 5) * 128 + h * 32 + (tid & 31)]; }
}
__device__ __forceinline__ void gla_head(const Frame& F, bool want_q, const GlaRegs& R) {
    LAS unsigned char* LB = F.lds; LAS float* LA = (LAS float*)(LB + GB_LA); LAS float* KK = (LAS float*)(LB + GB_K); LAS float* QQ = (LAS float*)(LB + GB_Q); LAS float* ALR = (LAS float*)(LB + GB_ALR);
    LAS float* WG = (LAS float*)(LB + GB_WG); LAS float* BG = (LAS float*)(LB + GB_BG); LAS unsigned short* VT = (LAS unsigned short*)(LB + GB_VT);
    const int tid = F.tid;
    { const int t = (tid & 255) >> 2, c = (tid & 3) * 8;
      if (tid < 256) { st8bf(R.kq, KK + t * 32 + c); st8bf(R.al, ALR + t * 32 + c); }
      else if (want_q) st8bf(R.kq, QQ + t * 32 + c); }
    { const int t = tid >> 3, c = (tid & 7) * 8; const v4u w = R.vv;
      VT[(c + 0) * 72 + t] = (unsigned short)w.x; VT[(c + 1) * 72 + t] = (unsigned short)(w.x >> 16); VT[(c + 2) * 72 + t] = (unsigned short)w.y; VT[(c + 3) * 72 + t] = (unsigned short)(w.y >> 16);
      VT[(c + 4) * 72 + t] = (unsigned short)w.z; VT[(c + 5) * 72 + t] = (unsigned short)(w.z >> 16); VT[(c + 6) * 72 + t] = (unsigned short)w.w; VT[(c + 7) * 72 + t] = (unsigned short)(w.w >> 16); }
    { WG[tid] = R.w0; WG[tid + 512] = R.w1; if (tid < 64) BG[tid] = R.bg; }
    __syncthreads();
    { const int k = tid & 31, t0 = tid >> 5;
#pragma unroll
      for (int d = 0; d < 2; ++d)
#pragma unroll
        for (int tt = 0; tt < 4; ++tt) { const int t = t0 + 16 * tt; float z = BG[d * 32 + k];
#pragma unroll
            for (int r = 0; r < 16; ++r) z += ALR[t * 32 + d * 16 + r] * WG[(d * 16 + r) * 32 + k];
            LA[(d * 64 + t) * 32 + k] = logsigmoidf(z) * (1.f / 16.f); } }
    __syncthreads();
    { const int w = tid >> 6, lane = tid & 63;
#pragma unroll
      for (int c = 0; c < 8; ++c) { const int col = w * 8 + c, d = col >> 5, k = col & 31; float v = LA[(d * 64 + lane) * 32 + k];
          const float x0 = v;
          v += gdpp<0x111, 0xf>(v); v += gdpp<0x112, 0xf>(v); v += gdpp<0x114, 0xf>(v); v += gdpp<0x118, 0xf>(v); v += gdpp<0x142, 0xa>(v); v += gdpp<0x143, 0xc>(v);
          if (d != 0) v = __shfl(v, 63) - v + x0;
          LA[(d * 64 + lane) * 32 + k] = v; } }
    __syncthreads();
}
__device__ __forceinline__ void gla_issue_kqv(const Frame& F, int b, int h, int jj, GlaRegs& R) {
    const int tid = F.tid;
    const GAS bf16* PH = (const GAS bf16*)(F.ws + WS_PH) + (size_t)gla_row0(b, jj) * NPH;
    { const int t = (tid & 255) >> 2, c = (tid & 3) * 8;
      R.kq = *(const GAS v4u*)(PH + (size_t)t * NPH + (tid < 256 ? PH_KA : PH_QA) + h * 32 + c); }
    { const int t = tid >> 3, c = (tid & 7) * 8; R.vv = *(const GAS v4u*)(PH + (size_t)t * NPH + PH_VA + h * 64 + c); }
}
__device__ __forceinline__ void gla_head_kqv(const Frame& F, const GlaRegs& R) {
    LAS unsigned char* LB = F.lds; LAS float* KK = (LAS float*)(LB + GB_K); LAS float* QQ = (LAS float*)(LB + GB_Q); LAS unsigned short* VT = (LAS unsigned short*)(LB + GB_VT);
    const int tid = F.tid;
    { const int t = (tid & 255) >> 2, c = (tid & 3) * 8; st8bf(R.kq, (tid < 256 ? KK : QQ) + t * 32 + c); }
    { const int t = tid >> 3, c = (tid & 7) * 8; const v4u w = R.vv;
      VT[(c + 0) * 72 + t] = (unsigned short)w.x; VT[(c + 1) * 72 + t] = (unsigned short)(w.x >> 16); VT[(c + 2) * 72 + t] = (unsigned short)w.y; VT[(c + 3) * 72 + t] = (unsigned short)(w.y >> 16);
      VT[(c + 4) * 72 + t] = (unsigned short)w.z; VT[(c + 5) * 72 + t] = (unsigned short)(w.z >> 16); VT[(c + 6) * 72 + t] = (unsigned short)w.w; VT[(c + 7) * 72 + t] = (unsigned short)(w.w >> 16); }
}
__device__ __forceinline__ void p_gla_local(const Frame& F0, int l) { const Frame F = launder(F0);
    LAS unsigned char* LB = F.lds; LAS float* LA = (LAS float*)(LB + GB_LA); LAS float* KK = (LAS float*)(LB + GB_K); const int tid = F.tid;
    LAS unsigned short* KTF = (LAS unsigned short*)(LB + GB_KTF); LAS unsigned short* KTB = (LAS unsigned short*)(LB + GB_KTB);
    GAS float* SLOC = (GAS float*)(F.ws + WS_SLOC); GAS float* GDEC = (GAS float*)(F.ws + WS_GDEC);
    const int wv = tid >> 6, lane = tid & 63, r32 = lane & 31, hi = lane >> 5;
    GlaRegs Rn;
    if ((int)blockIdx.x < NBATCH * 4 * GLA_NCH) { const int u = blockIdx.x; gla_issue(F, l, u / (4 * GLA_NCH), (u / GLA_NCH) & 3, u % GLA_NCH, false, Rn); }
    for (int u = blockIdx.x; u < NBATCH * 4 * GLA_NCH; u += F.G) {
        const int b = u / (4 * GLA_NCH), h = (u / GLA_NCH) & 3, jj = u % GLA_NCH;
        const GlaRegs R = Rn;
        { const int un = u + F.G; if (un < NBATCH * 4 * GLA_NCH) gla_issue(F, l, un / (4 * GLA_NCH), (un / GLA_NCH) & 3, un % GLA_NCH, false, Rn); }
        gla_head(F, false, R);
        { const int t = tid >> 3, d = (tid >> 2) & 1, kg = tid & 3;
          GAS f32x4* dst = (GAS f32x4*)((GAS unsigned char*)(F.ws + WS_Y) + (size_t)(gla_row0(b, jj) + t) * (D * 2) + 512 + h * 256 + d * 128 + kg * 32);
          const LAS f32x4* src = (const LAS f32x4*)(LA + (d * 64 + t) * 32 + kg * 8); dst[0] = src[0]; dst[1] = src[1]; }
        for (int i = tid; i < 2048; i += NTHR) { const int t = i >> 5, k = i & 31; const float kv = KK[i];
            KTF[k * 72 + t] = bf1(kv * __expf(LA[63 * 32 + k] - LA[t * 32 + k]));
            KTB[k * 72 + t] = bf1(kv * __expf(LA[64 * 32 + k] - LA[(64 + t) * 32 + k])); }
        __syncthreads();
        if (wv < 4) { const int dir = wv >> 1, nt = wv & 1; gf32x16 acc = {};
            gmm<64>(acc, LB + (dir ? GB_KTB : GB_KTF), 144, 0, LB + GB_VT, 144, nt * 32, r32, hi);
            GAS float* dst = SLOC + ((size_t)((b * 4 + h) * 2 + dir) * GLA_NCH + jj) * 2048 + nt * 32 + r32;
#pragma unroll
            for (int r = 0; r < 16; ++r) dst[gcrow(r, hi) * 64] = acc[r]; }
        if (tid < 64) { const int d = tid >> 5, kk = tid & 31; GDEC[((size_t)((b * 4 + h) * 2 + d) * GLA_NCH + jj) * 32 + kk] = __expf(d ? LA[64 * 32 + kk] : LA[63 * 32 + kk]); }
        __syncthreads();
    }
}
__device__ __forceinline__ void p_gla_scan(const Frame& F0) { const Frame F = launder(F0);
    GAS float* SLOC = (GAS float*)(F.ws + WS_SLOC); const GAS float* GDEC = (const GAS float*)(F.ws + WS_GDEC);
    if (F.tid < 128) for (int it = blockIdx.x; it < 256; it += F.G) {
        const int chain = it >> 4, e = (it & 15) * 128 + F.tid, k = e >> 6, dir = chain & 1;
        GAS float* sl = SLOC + (size_t)chain * GLA_NCH * 2048 + e; const GAS float* dc = GDEC + (size_t)chain * GLA_NCH * 32 + k;
        float S = 0.f;
        for (int j0 = 0; j0 < GLA_NCH; j0 += 20) { float lv[20], dv[20];
#pragma unroll
            for (int q = 0; q < 20; ++q) { const int j = j0 + q, jx = dir == 0 ? j : (j < 4 ? 3 - j : GLA_NCH + 3 - j); lv[q] = sl[(size_t)jx * 2048]; dv[q] = dc[jx * 32]; }
#pragma unroll
            for (int q = 0; q < 20; ++q) { const int j = j0 + q, jx = dir == 0 ? j : (j < 4 ? 3 - j : GLA_NCH + 3 - j); sl[(size_t)jx * 2048] = S; S = dv[q] * S + lv[q]; } }
    }
}
__device__ __forceinline__ void p_gla_out(const Frame& F0, int l, bool with_ctx) { const Frame F = launder(F0);
    LAS unsigned char* LB = F.lds; LAS float* LA = (LAS float*)(LB + GB_LA); LAS float* KK = (LAS float*)(LB + GB_K); LAS float* QQ = (LAS float*)(LB + GB_Q); LAS float* OO = (LAS float*)(LB + GB_O);
    LAS unsigned short* QF = (LAS unsigned short*)(LB + GB_QF); LAS unsigned short* QB = (LAS unsigned short*)(LB + GB_QB); LAS unsigned short* KF = (LAS unsigned short*)(LB + GB_KF); LAS unsigned short* KB = (LAS unsigned short*)(LB + GB_KB);
    LAS unsigned short* ATT = (LAS unsigned short*)(LB + GB_ATT); LAS unsigned short* STF = (LAS unsigned short*)(LB + GB_STF); LAS unsigned short* STB = (LAS unsigned short*)(LB + GB_STB);
    const int tid = F.tid, wv = tid >> 6, lane = tid & 63, r32 = lane & 31, hi = lane >> 5;
    const GAS float* SLOC = (const GAS float*)(F.ws + WS_SLOC); GAS bf16* Y = (GAS bf16*)(F.ws + WS_Y); const GAS bf16* PHB = (const GAS bf16*)(F.ws + WS_PH);
    const GAS float* gng = F.in[I_GNG] + l * 64;
    constexpr int NU = NBATCH * 4 * GLA_NCH;
    GlaRegs Rn; f32x4 san = {}, scn = {}, la0n = {}, la1n = {}; v4u gwn = {};
#define GLA_PF(u_) do { const int b_ = (u_) / (4 * GLA_NCH), h_ = ((u_) / GLA_NCH) & 3, j_ = (u_) % GLA_NCH; gla_issue_kqv(F, b_, h_, j_, Rn); \
        const GAS float* s0_ = SLOC + ((size_t)((b_ * 4 + h_) * 2 + 0) * GLA_NCH + j_) * 2048; const GAS float* s1_ = SLOC + ((size_t)((b_ * 4 + h_) * 2 + 1) * GLA_NCH + j_) * 2048; \
        san = *(const GAS f32x4*)(s0_ + (tid >> 4) * 64 + (tid & 15) * 4); scn = *(const GAS f32x4*)(s1_ + (tid >> 4) * 64 + (tid & 15) * 4); \
        gwn = *(const GAS v4u*)(PHB + (size_t)(gla_row0(b_, j_) + (tid >> 3)) * NPH + PH_GA + h_ * 64 + (tid & 7) * 8); \
        { const GAS f32x4* la_ = (const GAS f32x4*)((const GAS unsigned char*)(F.ws + WS_Y) + (size_t)(gla_row0(b_, j_) + (tid >> 3)) * (D * 2) + 512 + h_ * 256 + ((tid >> 2) & 1) * 128 + (tid & 3) * 32); la0n = la_[0]; la1n = la_[1]; } } while (0)
#define GLA_SKIP(u_) (((u_) % GLA_NCH) < 4 && !with_ctx)
    int u = blockIdx.x; while (u < NU && GLA_SKIP(u)) u += F.G;
    if (u < NU) GLA_PF(u);
    while (u < NU) {
        const int b = u / (4 * GLA_NCH), h = (u / GLA_NCH) & 3, jj = u % GLA_NCH;
        const GlaRegs R = Rn; const f32x4 a = san, c = scn, la0 = la0n, la1 = la1n; const v4u gw = gwn;
        int un = u + F.G; while (un < NU && GLA_SKIP(un)) un += F.G;
        if (un < NU) GLA_PF(un);
        gla_head_kqv(F, R);
        { LAS f32x4* dl = (LAS f32x4*)(LA + (((tid >> 2) & 1) * 64 + (tid >> 3)) * 32 + (tid & 3) * 8); dl[0] = la0; dl[1] = la1; }
        __syncthreads();
        for (int i = tid; i < 2048; i += NTHR) { const int t = i >> 5, k = i & 31; const float qv = QQ[i] * 0.17677669529663687f, kv = KK[i];
            const float bf_ = LA[t * 32 + k], bb_ = LA[(64 + t) * 32 + k];
            QF[t * 40 + k] = bf1(qv * __expf(bf_)); KF[t * 40 + k] = bf1(kv * __expf(-bf_)); QB[t * 40 + k] = bf1(qv * __expf(bb_)); KB[t * 40 + k] = bf1(kv * __expf(-bb_)); }
        { const int k = tid >> 4, v4 = (tid & 15) * 4;
          STF[(v4 + 0) * 40 + k] = bf1(a.x); STF[(v4 + 1) * 40 + k] = bf1(a.y); STF[(v4 + 2) * 40 + k] = bf1(a.z); STF[(v4 + 3) * 40 + k] = bf1(a.w);
          STB[(v4 + 0) * 40 + k] = bf1(c.x); STB[(v4 + 1) * 40 + k] = bf1(c.y); STB[(v4 + 2) * 40 + k] = bf1(c.z); STB[(v4 + 3) * 40 + k] = bf1(c.w); }
        __syncthreads();
        gf32x16 acc = {};
        const int mt = wv & 1, nt = (wv >> 1) & 1;
        if (wv < 4) {
            gf32x16 af = {}, ab = {};
            gmm<32>(af, LB + GB_QF, 80, mt * 32, LB + GB_KF, 80, nt * 32, r32, hi); gmm<32>(ab, LB + GB_QB, 80, mt * 32, LB + GB_KB, 80, nt * 32, r32, hi);
            const int s = nt * 32 + r32;
#pragma unroll
            for (int r = 0; r < 16; ++r) { const int t = mt * 32 + gcrow(r, hi); const float a = (s <= t ? af[r] : 0.f) + (s >= t ? ab[r] : 0.f); ATT[t * 72 + s] = bf1(a); }
        } else {
            gmm<32>(acc, LB + GB_QF, 80, mt * 32, LB + GB_STF, 80, nt * 32, r32, hi); gmm<32>(acc, LB + GB_QB, 80, mt * 32, LB + GB_STB, 80, nt * 32, r32, hi);
        }
        __syncthreads();
        if (wv >= 4) { gmm<64>(acc, LB + GB_ATT, 144, mt * 32, LB + GB_VT, 144, nt * 32, r32, hi);
#pragma unroll
            for (int r = 0; r < 16; ++r) OO[(mt * 32 + gcrow(r, hi)) * 65 + nt * 32 + r32] = acc[r]; }
        __syncthreads();
        { const int t = tid >> 3, vg = tid & 7; float o8[8], ss = 0.f;
#pragma unroll
          for (int i = 0; i < 8; ++i) { o8[i] = OO[t * 65 + vg * 8 + i]; ss += o8[i] * o8[i]; }
          ss += __shfl_xor(ss, 1); ss += __shfl_xor(ss, 2); ss += __shfl_xor(ss, 4);
          const float rs = 1.f / sqrtf(ss * (1.f / 64.f) + RMS_EPS);
          const int row = gla_row0(b, jj) + t;
          float ga[8]; ga[0] = bf2f((unsigned short)gw.x); ga[1] = bf2f((unsigned short)(gw.x >> 16)); ga[2] = bf2f((unsigned short)gw.y); ga[3] = bf2f((unsigned short)(gw.y >> 16));
          ga[4] = bf2f((unsigned short)gw.z); ga[5] = bf2f((unsigned short)(gw.z >> 16)); ga[6] = bf2f((unsigned short)gw.w); ga[7] = bf2f((unsigned short)(gw.w >> 16));
          float y[8];
#pragma unroll
          for (int i = 0; i < 8; ++i) y[i] = o8[i] * rs * gng[vg * 8 + i] * siluf(ga[i]);
          v4u o; o.x = pk2(y[0], y[1]); o.y = pk2(y[2], y[3]); o.z = pk2(y[4], y[5]); o.w = pk2(y[6], y[7]);
          *(GAS v4u*)(Y + (size_t)row * D + h * 64 + vg * 8) = o; }
        __syncthreads();
        u = un;
    }
#undef GLA_PF
#undef GLA_SKIP
}

constexpr int FN = 32768, FN1 = 128, FN2 = 256;
constexpr size_t WS_FA = WS_XN + 33 * MiB;
constexpr size_t WS_HT = WS_PH;
constexpr size_t WS_FA0 = WS_K, WS_FA1 = WS_VT;
constexpr size_t WS_HID = AB + 521 * MiB, WS_HTC = AB + 526 * MiB, WS_CU = AB + 527 * MiB, WS_OTC = AB + 529 * MiB, WS_NPART = AB + 530 * MiB, WS_END2 = AB + 532 * MiB;
static_assert(WS_FA0 + 64 * MiB <= WS_VT && WS_FA1 + 64 * MiB <= WS_HF && WS_END2 <= 573 * MiB, "hyena map");
constexpr size_t CTL_NRM = 256 * 1024;
constexpr int FFT_TW_OFF = 40960;
typedef float f32x2 __attribute__((ext_vector_type(2)));
__device__ __forceinline__ f32x2 cmul(f32x2 a, f32x2 b) { return (f32x2){a.x * b.x - a.y * b.y, a.x * b.y + a.y * b.x}; }
__device__ __forceinline__ unsigned pkc(f32x2 v) { return pk2(v.x, v.y); }
__device__ __forceinline__ f32x2 upc(unsigned w) { return (f32x2){__uint_as_float(w << 16), __uint_as_float(w & 0xffff0000u)}; }
__device__ __forceinline__ f32x2 twid(float rev) { return (f32x2){__builtin_amdgcn_cosf(rev), __builtin_amdgcn_sinf(rev)}; }
__device__ __forceinline__ float nrm_lat(const Frame& F, int order, int c) {
    LAS float* red = (LAS float*)(F.lds + FFT_TW_OFF + 1024); const GAS float* NP = (const GAS float*)(F.ws + WS_NPART);
    const float v = wave_sum(NP[(size_t)(F.tid & 255) * 1024 + order * 512 + (F.tid >> 8) * 256 + c]);
    __syncthreads(); if (F.lane == 0) red[F.wave] = v; __syncthreads();
    float s = 0.f;
#pragma unroll
    for (int w = 0; w < 8; ++w) s += red[w];
    return 1.f / sqrtf(s + 1e-6f);
}
__device__ __forceinline__ float nrm_ctx(const Frame& F, int order, int c) { const GAS float* NP = (const GAS float*)(F.ws + WS_NPART); float s = 0.f;
#pragma unroll
    for (int pb = 256; pb < 260; ++pb) s += NP[(size_t)pb * 1024 + order * 512 + c] + NP[(size_t)pb * 1024 + order * 512 + 256 + c];
    return 1.f / sqrtf(s + 1e-6f); }

__device__ __forceinline__ void p_filt_hidden(const Frame& F0, int l) { const Frame F = launder(F0);
    LAS float* L = (LAS float*)F.lds; LAS float* W1 = L, * W2 = L + 33 * 64, * H1 = W2 + 64 * 64, * PB = H1 + 128 * 65;
    GAS float* HID = (GAS float*)(F.ws + WS_HID); const int tid = F.tid;
    for (int i = tid; i < 33 * 64; i += NTHR) W1[i] = F.in[I_HW1][l * 33 * 64 + i];
    for (int i = tid; i < 64 * 64; i += NTHR) W2[i] = F.in[I_HW2][l * 64 * 64 + i];
    if (tid < 64) { PB[tid] = F.in[I_HB1][l * 64 + tid]; PB[64 + tid] = F.in[I_HF1][l * 64 + tid]; PB[128 + tid] = F.in[I_HB2][l * 64 + tid]; PB[192 + tid] = F.in[I_HF2][l * 64 + tid]; }
    __syncthreads();
    const int p = tid & 127, jq = tid >> 7;
    for (int blk = blockIdx.x; blk < (SEQ + CTXL) / 128; blk += F.G) {
        const int prow = blk * 128 + p; const bool lat = prow < SEQ; const int pos = lat ? prow : prow - SEQ; const float Lf = lat ? (float)SEQ : (float)CTXL;
        float z[33]; z[0] = (float)pos / (Lf - 1.f);
#pragma unroll
        for (int i = 0; i < 16; ++i) { const float fr = 1e-4f + (float)i * ((15.f - 1e-4f) / 15.f); float rev = (float)pos * fr / Lf; rev -= floorf(rev);
            z[1 + i] = __builtin_amdgcn_cosf(rev); z[17 + i] = -__builtin_amdgcn_sinf(rev); }
        for (int j = jq * 16; j < jq * 16 + 16; ++j) { float a = PB[j];
#pragma unroll
            for (int i = 0; i < 33; ++i) a += z[i] * W1[i * 64 + j];
            H1[p * 65 + j] = __sinf(PB[64 + j] * a); }
        __syncthreads();
        for (int j = jq * 16; j < jq * 16 + 16; ++j) { float a = PB[128 + j];
            for (int i = 0; i < 64; ++i) a += H1[p * 65 + i] * W2[i * 64 + j];
            HID[(size_t)prow * 64 + j] = __sinf(PB[192 + j] * a); }
        __syncthreads();
    }
}
__device__ __forceinline__ void p_filt_raw(const Frame& F0, int l) { const Frame F = launder(F0);
    LAS float* L = (LAS float*)F.lds; LAS float* HS = L, * W3 = L + 64 * 65; const int tid = F.tid;
    const GAS float* HID = (const GAS float*)(F.ws + WS_HID); GAS float* HT = (GAS float*)(F.ws + WS_HT); GAS float* HTC = (GAS float*)(F.ws + WS_HTC);
    const GAS float* w3 = F.in[I_HW3] + (size_t)l * 64 * 1024; const GAS float* b3 = F.in[I_HB3] + l * 1024;
    const int pg = tid & 15, cg = tid >> 4;
    for (int u = blockIdx.x; u < ((SEQ + CTXL) / 64) * 4; u += F.G) {
        const int pb = u >> 2, cb = u & 3, prow0 = pb * 64; const bool lat = prow0 < SEQ; const int pos0 = lat ? prow0 : prow0 - SEQ; const float Lf = lat ? (float)SEQ : (float)CTXL;
        for (int i = tid; i < 64 * 64; i += NTHR) HS[(i >> 6) * 65 + (i & 63)] = HID[(size_t)prow0 * 64 + i];
        for (int i = tid; i < 64 * 256; i += NTHR) W3[i] = w3[(size_t)(i >> 8) * 1024 + cb * 256 + (i & 255)];
        __syncthreads();
        float acc[4][8];
#pragma unroll
        for (int a = 0; a < 4; ++a)
#pragma unroll
            for (int c = 0; c < 8; ++c) acc[a][c] = 0.f;
        for (int i = 0; i < 64; ++i) { const f32x4 w0 = *(const LAS f32x4*)(W3 + i * 256 + cg * 8), w1 = *(const LAS f32x4*)(W3 + i * 256 + cg * 8 + 4);
#pragma unroll
            for (int a = 0; a < 4; ++a) { const float hv = HS[(pg * 4 + a) * 65 + i];
                acc[a][0] += hv * w0.x; acc[a][1] += hv * w0.y; acc[a][2] += hv * w0.z; acc[a][3] += hv * w0.w; acc[a][4] += hv * w1.x; acc[a][5] += hv * w1.y; acc[a][6] += hv * w1.z; acc[a][7] += hv * w1.w; } }
        float ss[8];
#pragma unroll
        for (int c = 0; c < 8; ++c) { const int col = cb * 256 + cg * 8 + c, ch = col & 255; const float delta = 3.0701134573253944f + (float)ch * (12.280453829301578f / 255.f), bias = b3[col];
            float o[4]; ss[c] = 0.f;
#pragma unroll
            for (int a = 0; a < 4; ++a) { const float t = (float)(pos0 + pg * 4 + a) / (Lf - 1.f); o[a] = (acc[a][c] + bias) * __expf(-t * delta); ss[c] += o[a] * o[a]; }
            GAS float* dst = lat ? HT + (size_t)col * SEQ + pos0 + pg * 4 : HTC + (size_t)col * CTXL + pos0 + pg * 4;
            *(GAS f32x4*)dst = (f32x4){o[0], o[1], o[2], o[3]}; }
#pragma unroll
        for (int c = 0; c < 8; ++c) { float s = ss[c]; s += __shfl_xor(s, 1); s += __shfl_xor(s, 2); s += __shfl_xor(s, 4); s += __shfl_xor(s, 8); ss[c] = s; }
        if (pg == 0) { GAS float* np = (GAS float*)(F.ws + WS_NPART) + (size_t)pb * 1024 + cb * 256 + cg * 8;
            *(GAS f32x4*)np = (f32x4){ss[0], ss[1], ss[2], ss[3]}; *(GAS f32x4*)(np + 4) = (f32x4){ss[4], ss[5], ss[6], ss[7]}; }
        __syncthreads();
    }
}
__device__ __forceinline__ void fft_tw_init(LAS unsigned char* lds, int tid) { if (tid < 128) ((LAS f32x2*)(lds + FFT_TW_OFF))[tid] = twid(-(float)tid * (1.f / 256.f)); __syncthreads(); }
__device__ __forceinline__ f32x2 cconj(f32x2 a) { return (f32x2){a.x, -a.y}; }
__device__ __forceinline__ f32x2 mul_mi(f32x2 a) { return (f32x2){a.y, -a.x}; }
__device__ __forceinline__ f32x2 mul_pi(f32x2 a) { return (f32x2){-a.y, a.x}; }
template <int ST>
__device__ __forceinline__ void dif4(LAS f32x2* X, const LAS f32x2* TW, int base, int g, int s) {
    const int h = 1 << s, p = g & ((h >> 1) - 1), i = (((g >> (s - 1)) << (s + 1)) | p);
    LAS f32x2* P0 = X + base + i * ST; LAS f32x2* P1 = P0 + (h >> 1) * ST; LAS f32x2* P2 = P0 + h * ST; LAS f32x2* P3 = P1 + h * ST;
    const f32x2 x0 = *P0, x1 = *P1, x2 = *P2, x3 = *P3, wa = TW[p << (7 - s)], wc = TW[p << (8 - s)];
    const f32x2 y0 = x0 + x2, y2 = cmul(x0 - x2, wa), y1 = x1 + x3, y3 = mul_mi(cmul(x1 - x3, wa));
    *P0 = y0 + y1; *P1 = cmul(y0 - y1, wc); *P2 = y2 + y3; *P3 = cmul(y2 - y3, wc);
}
template <int ST>
__device__ __forceinline__ void dit4(LAS f32x2* X, const LAS f32x2* TW, int base, int g, int s) {
    const int h = 1 << s, p = g & (h - 1), i = (((g >> s) << (s + 2)) | p);
    LAS f32x2* P0 = X + base + i * ST; LAS f32x2* P1 = P0 + h * ST; LAS f32x2* P2 = P1 + h * ST; LAS f32x2* P3 = P2 + h * ST;
    const f32x2 w1 = cconj(TW[p << (7 - s)]), w2 = cconj(TW[p << (6 - s)]);
    const f32x2 x0 = *P0, x1 = cmul(*P1, w1), x2 = *P2, x3 = cmul(*P3, w1);
    const f32x2 y0 = x0 + x1, y1 = x0 - x1, y2 = cmul(x2 + x3, w2), y3 = mul_pi(cmul(x2 - x3, w2));
    *P0 = y0 + y2; *P2 = y0 - y2; *P1 = y1 + y3; *P3 = y1 - y3;
}
__device__ __forceinline__ void fft128_cols_fwd(LAS f32x2* X, int tid) {
    const int j = tid & 31, q0 = tid >> 5; const LAS f32x2* TW = (const LAS f32x2*)((const LAS unsigned char*)X + FFT_TW_OFF);
#pragma unroll 1
    for (int s = 6; s >= 2; s -= 2) { dif4<32>(X, TW, j, q0, s); dif4<32>(X, TW, j, q0 + 16, s); __syncthreads(); }
#pragma unroll
    for (int i = 0; i < 4; ++i) { const int q = q0 + 16 * i; const f32x2 a = X[(2 * q) * 32 + j], b = X[(2 * q + 1) * 32 + j]; X[(2 * q) * 32 + j] = a + b; X[(2 * q + 1) * 32 + j] = a - b; }
    __syncthreads();
}
__device__ __forceinline__ void fft128_cols_inv(LAS f32x2* X, int tid) {
    const int j = tid & 31, q0 = tid >> 5; const LAS f32x2* TW = (const LAS f32x2*)((const LAS unsigned char*)X + FFT_TW_OFF);
#pragma unroll
    for (int i = 0; i < 4; ++i) { const int q = q0 + 16 * i; const f32x2 a = X[(2 * q) * 32 + j], b = X[(2 * q + 1) * 32 + j]; X[(2 * q) * 32 + j] = a + b; X[(2 * q + 1) * 32 + j] = a - b; }
    __syncthreads();
#pragma unroll 1
    for (int s = 1; s <= 5; s += 2) { dit4<32>(X, TW, j, q0, s); dit4<32>(X, TW, j, q0 + 16, s); __syncthreads(); }
}
__device__ __forceinline__ void fft256_rows_fwd(LAS f32x2* X, int tid) {
    const int g = tid & 63, r0 = tid >> 6; const LAS f32x2* TW = (const LAS f32x2*)((const LAS unsigned char*)X + FFT_TW_OFF);
#pragma unroll 1
    for (int s = 7; s >= 1; s -= 2) { dif4<1>(X, TW, r0 * 256, g, s); dif4<1>(X, TW, (r0 + 8) * 256, g, s); __syncthreads(); }
}
__device__ __forceinline__ void fft256_rows_inv(LAS f32x2* X, int tid) {
    const int g = tid & 63, r0 = tid >> 6; const LAS f32x2* TW = (const LAS f32x2*)((const LAS unsigned char*)X + FFT_TW_OFF);
#pragma unroll 1
    for (int s = 0; s <= 6; s += 2) { dit4<1>(X, TW, r0 * 256, g, s); dit4<1>(X, TW, (r0 + 8) * 256, g, s); __syncthreads(); }
}
__device__ __forceinline__ int bitrev7(int r) { return (int)(__brev((unsigned)r) >> 25); }
template <int KIND>
__device__ __forceinline__ void p_fft_pass1(const Frame& F0, int order, size_t ws_a) { const Frame F = launder(F0);
    fft_tw_init(F.lds, F.tid);
    LAS f32x2* X = (LAS f32x2*)F.lds; const int tid = F.tid, j = tid & 31, q0 = tid >> 5;
    const GAS float* VT = (const GAS float*)(F.ws + WS_VT); const GAS float* HT = (const GAS float*)(F.ws + WS_HT); GAS unsigned* A = (GAS unsigned*)(F.ws + ws_a);
    f32x2 pre[8];
#define P1_LOAD(uu) do { const int sg_ = (uu) >> 3, nb_ = (uu) & 7; _Pragma("unroll") for (int i = 0; i < 8; ++i) { const int n1 = q0 + 16 * i, n = 256 * n1 + 32 * nb_ + j; f32x2 v = {0.f, 0.f}; \
        if (KIND == 0) { if (n1 < 64) { v.x = VT[(size_t)(sg_ * 2 + 0) * SEQ + n]; v.y = VT[(size_t)(sg_ * 2 + 1) * SEQ + n]; } } \
        else { const GAS float* hf = HT + (size_t)(order * 512 + sg_) * SEQ; const GAS float* hb = HT + (size_t)(order * 512 + 256 + sg_) * SEQ; \
               if (n < SEQ) v.x = hf[n]; else if (n > SEQ) v.x = hb[2 * SEQ - n]; } \
        pre[i] = v; } } while (0)
    int u = blockIdx.x; if (u < 256 * 8) P1_LOAD(u);
    for (; u < 256 * 8; u += F.G) {
        const int sg = u >> 3, nb = u & 7;
#pragma unroll
        for (int i = 0; i < 8; ++i) X[(q0 + 16 * i) * 32 + j] = pre[i];
        __syncthreads();
        if (u + F.G < 256 * 8) P1_LOAD(u + F.G);
        fft128_cols_fwd(X, tid);
#pragma unroll
        for (int i = 0; i < 8; ++i) { const int r = q0 + 16 * i, k1 = bitrev7(r), n2 = 32 * nb + j;
            A[((size_t)sg * FN1 + r) * FN2 + n2] = pkc(cmul(X[r * 32 + j], twid(-(float)(n2 * k1) * (1.f / (float)FN)))); }
        __syncthreads();
    }
#undef P1_LOAD
}
template <int KIND>
__device__ __forceinline__ void p_fft_pass2(const Frame& F0, int l, int order, size_t ws_a) { const Frame F = launder(F0);
    fft_tw_init(F.lds, F.tid);
    LAS f32x2* X = (LAS f32x2*)F.lds; const int tid = F.tid;
    GAS unsigned* A = (GAS unsigned*)(F.ws + ws_a); GAS unsigned* HF = (GAS unsigned*)(F.ws + WS_HF);
    unsigned pa[8], ph[8];
#define P2_LOAD(uu) do { const int sg_ = (uu) >> 3, g_ = (uu) & 7; const GAS unsigned* Ab_ = A + ((size_t)sg_ * FN1 + g_ * 16) * FN2; const GAS unsigned* Hb_ = HF + ((size_t)(order * 256 + sg_) * FN1 + g_ * 16) * FN2; \
        _Pragma("unroll") for (int i = 0; i < 8; ++i) { pa[i] = Ab_[tid + NTHR * i]; if (KIND == 0) ph[i] = Hb_[tid + NTHR * i]; } } while (0)
    int u = blockIdx.x; if (u < 256 * 8) P2_LOAD(u);
    for (; u < 256 * 8; u += F.G) {
        const int sg = u >> 3, g = u & 7;
        GAS unsigned* Ab = A + ((size_t)sg * FN1 + g * 16) * FN2; GAS unsigned* Hb = HF + ((size_t)(order * 256 + sg) * FN1 + g * 16) * FN2;
        unsigned hcur[8];
#pragma unroll
        for (int i = 0; i < 8; ++i) { X[tid + NTHR * i] = upc(pa[i]); if (KIND == 0) hcur[i] = ph[i]; }
        __syncthreads();
        if (u + F.G < 256 * 8) P2_LOAD(u + F.G);
        fft256_rows_fwd(X, tid);
        if (KIND == 1) { const float nr = nrm_lat(F, order, sg);
#pragma unroll
            for (int i = 0; i < 8; ++i) { const int e = tid + NTHR * i; const f32x2 v = X[e] * nr; const _Float16 hr = (_Float16)v.x, hi = (_Float16)v.y;
                Hb[e] = (unsigned)__builtin_bit_cast(unsigned short, hr) | ((unsigned)__builtin_bit_cast(unsigned short, hi) << 16); }
            __syncthreads();
        } else {
#pragma unroll
            for (int i = 0; i < 8; ++i) { const int e = tid + NTHR * i; const unsigned hw = hcur[i];
                const f32x2 h = {(float)__builtin_bit_cast(_Float16, (unsigned short)(hw & 0xffffu)), (float)__builtin_bit_cast(_Float16, (unsigned short)(hw >> 16))};
                X[e] = cmul(X[e], h); }
            __syncthreads();
            fft256_rows_inv(X, tid);
#pragma unroll
            for (int i = 0; i < 8; ++i) { const int e = tid + NTHR * i, r = g * 16 + (e >> 8), n2 = e & 255, k1 = bitrev7(r);
                Ab[e] = pkc(cmul(X[e], twid((float)(n2 * k1) * (1.f / (float)FN))) * (1.f / (float)FN)); }
            __syncthreads();
        }
    }
#undef P2_LOAD
}
__device__ __forceinline__ void p_fft_pass3(const Frame& F0, int l, int order) { const Frame F = launder(F0);
    fft_tw_init(F.lds, F.tid);
    LAS f32x2* X = (LAS f32x2*)F.lds; const int tid = F.tid, j = tid & 31, q0 = tid >> 5;
    GAS float* VT = (GAS float*)(F.ws + WS_VT); const GAS bf16* GT = (const GAS bf16*)(F.ws + (order == 0 ? WS_X1T : WS_X2T)); const GAS unsigned* A = (const GAS unsigned*)(F.ws + WS_FA);
    const GAS float* skip = F.in[I_HSKIP] + (size_t)(l * 2 + order) * 256;
    unsigned pa[8]; float pv[4][2]; unsigned short pg[4][2];
#define P3_LOAD(uu) do { const int sg_ = (uu) >> 3, nb_ = (uu) & 7; _Pragma("unroll") for (int i = 0; i < 8; ++i) pa[i] = A[((size_t)sg_ * FN1 + q0 + 16 * i) * FN2 + 32 * nb_ + j]; \
        _Pragma("unroll") for (int i = 0; i < 4; ++i) { const int n = 256 * (q0 + 16 * i) + 32 * nb_ + j; const size_t i0 = (size_t)(sg_ * 2 + 0) * SEQ + n, i1 = (size_t)(sg_ * 2 + 1) * SEQ + n; \
            pv[i][0] = VT[i0]; pv[i][1] = VT[i1]; pg[i][0] = GT[i0]; pg[i][1] = GT[i1]; } } while (0)
    int u = blockIdx.x; if (u < 256 * 8) P3_LOAD(u);
    for (; u < 256 * 8; u += F.G) {
        const int sg = u >> 3, nb = u & 7;
        float cv[4][2], cg[4][2];
#pragma unroll
        for (int i = 0; i < 8; ++i) X[(q0 + 16 * i) * 32 + j] = upc(pa[i]);
#pragma unroll
        for (int i = 0; i < 4; ++i) { cv[i][0] = pv[i][0]; cv[i][1] = pv[i][1]; cg[i][0] = bf2f(pg[i][0]); cg[i][1] = bf2f(pg[i][1]); }
        __syncthreads();
        if (u + F.G < 256 * 8) P3_LOAD(u + F.G);
        fft128_cols_inv(X, tid);
        const float sk = skip[sg];
#pragma unroll
        for (int i = 0; i < 4; ++i) { const int n1 = q0 + 16 * i, n = 256 * n1 + 32 * nb + j; const f32x2 y = X[n1 * 32 + j];
            const size_t i0 = (size_t)(sg * 2 + 0) * SEQ + n, i1 = (size_t)(sg * 2 + 1) * SEQ + n;
            VT[i0] = cg[i][0] * (y.x + sk * cv[i][0]); VT[i1] = cg[i][1] * (y.y + sk * cv[i][1]); }
        __syncthreads();
    }
#undef P3_LOAD
}
__device__ __forceinline__ void p_fft_pass31(const Frame& F0, int l) { const Frame F = launder(F0);
    fft_tw_init(F.lds, F.tid);
    LAS f32x2* X = (LAS f32x2*)F.lds; const int tid = F.tid, j = tid & 31, q0 = tid >> 5;
    GAS float* VT = (GAS float*)(F.ws + WS_VT); const GAS bf16* GT = (const GAS bf16*)(F.ws + WS_X1T); GAS unsigned* A = (GAS unsigned*)(F.ws + WS_FA);
    const GAS float* skip = F.in[I_HSKIP] + (size_t)(l * 2 + 0) * 256;
    unsigned pa[8]; float pv[4][2]; unsigned short pg[4][2];
#define P3_LOAD(uu) do { const int sg_ = (uu) >> 3, nb_ = (uu) & 7; _Pragma("unroll") for (int i = 0; i < 8; ++i) pa[i] = A[((size_t)sg_ * FN1 + q0 + 16 * i) * FN2 + 32 * nb_ + j]; \
        _Pragma("unroll") for (int i = 0; i < 4; ++i) { const int n = 256 * (q0 + 16 * i) + 32 * nb_ + j; const size_t i0 = (size_t)(sg_ * 2 + 0) * SEQ + n, i1 = (size_t)(sg_ * 2 + 1) * SEQ + n; \
            pv[i][0] = VT[i0]; pv[i][1] = VT[i1]; pg[i][0] = GT[i0]; pg[i][1] = GT[i1]; } } while (0)
    int u = blockIdx.x; if (u < 256 * 8) P3_LOAD(u);
    for (; u < 256 * 8; u += F.G) {
        const int sg = u >> 3, nb = u & 7;
        float cv[4][2], cg[4][2];
#pragma unroll
        for (int i = 0; i < 8; ++i) X[(q0 + 16 * i) * 32 + j] = upc(pa[i]);
#pragma unroll
        for (int i = 0; i < 4; ++i) { cv[i][0] = pv[i][0]; cv[i][1] = pv[i][1]; cg[i][0] = bf2f(pg[i][0]); cg[i][1] = bf2f(pg[i][1]); }
        __syncthreads();
        if (u + F.G < 256 * 8) P3_LOAD(u + F.G);
        fft128_cols_inv(X, tid);
        const float sk = skip[sg];
#pragma unroll
        for (int i = 0; i < 4; ++i) { const int n1 = q0 + 16 * i, n = 256 * n1 + 32 * nb + j; const f32x2 y = X[n1 * 32 + j];
            const size_t i0 = (size_t)(sg * 2 + 0) * SEQ + n, i1 = (size_t)(sg * 2 + 1) * SEQ + n;
            const f32x2 z = {cg[i][0] * (y.x + sk * cv[i][0]), cg[i][1] * (y.y + sk * cv[i][1])};
            VT[i0] = z.x; VT[i1] = z.y; X[n1 * 32 + j] = z; X[(n1 + 64) * 32 + j] = (f32x2){0.f, 0.f}; }
        __syncthreads();
        fft128_cols_fwd(X, tid);
#pragma unroll
        for (int i = 0; i < 8; ++i) { const int r = q0 + 16 * i, k1 = bitrev7(r), n2 = 32 * nb + j;
            A[((size_t)sg * FN1 + r) * FN2 + n2] = pkc(cmul(X[r * 32 + j], twid(-(float)(n2 * k1) * (1.f / (float)FN)))); }
        __syncthreads();
    }
#undef P3_LOAD
}
__device__ __forceinline__ void p_hy_shortconv(const Frame& F0, int l) { const Frame F = launder(F0);
    LAS bf16* IN = (LAS bf16*)F.lds; LAS float* OT = (LAS float*)(F.lds + 66 * 256 * 2 + 64); const int tid = F.tid;
    const GAS bf16* PH = (const GAS bf16*)(F.ws + WS_PH); GAS float* VT = (GAS float*)(F.ws + WS_VT); GAS bf16* X1T = (GAS bf16*)(F.ws + WS_X1T); GAS bf16* X2T = (GAS bf16*)(F.ws + WS_X2T); GAS float* CU = (GAS float*)(F.ws + WS_CU);
    const GAS float* cw = F.in[I_HCW] + (size_t)l * 3 * 768; const GAS float* cb = F.in[I_HCB] + (size_t)l * 768;
    const int nlat = NBATCH * (SEQ / 64) * 3, nctx = NBATCH * (CTXL / 64) * 3;
    for (int u = blockIdx.x; u < nlat + nctx; u += F.G) {
        const bool lat = u < nlat; const int uu = lat ? u : u - nlat; const int grp = uu % 3, tile = (uu / 3) % (lat ? SEQ / 64 : CTXL / 64), b = (uu / 3) / (lat ? SEQ / 64 : CTXL / 64);
        const int Ls = lat ? SEQ : CTXL, t0 = tile * 64; const size_t rowb = lat ? (size_t)b * SEQ : (size_t)TL + b * CTXL;
        for (int i = tid; i < 66 * 32; i += NTHR) { const int rr = i >> 5, c8 = (i & 31) * 8, t = t0 + rr - 1; v4u w = {0u, 0u, 0u, 0u};
            if (t >= 0 && t < Ls) w = *(const GAS v4u*)(PH + (rowb + t) * NPH + PH_HY + grp * 256 + c8);
            *(LAS v4u*)(IN + rr * 256 + c8) = w; }
        __syncthreads();
        { const int c = tid & 255, th = tid >> 8, ch = grp * 256 + c; const float w0 = cw[ch], w1 = cw[768 + ch], w2 = cw[1536 + ch], bb = cb[ch];
          float a = bf2f(IN[(th * 32) * 256 + c]), m = bf2f(IN[(th * 32 + 1) * 256 + c]);
          for (int i = 0; i < 32; ++i) { const float n = bf2f(IN[(th * 32 + i + 2) * 256 + c]); const float y = bb + a * w0 + m * w1 + n * w2; a = m; m = n;
              if (lat) OT[c * 65 + th * 32 + i] = y; else CU[((size_t)b * CTXL + t0 + th * 32 + i) * 768 + ch] = y; } }
        __syncthreads();
        if (lat) { const int t4 = (tid & 15) * 4;
#pragma unroll
            for (int i = 0; i < 8; ++i) { const int c = (tid >> 4) + 32 * i; const LAS float* s = OT + c * 65 + t4; const size_t o = (size_t)(c * 2 + b) * SEQ + t0 + t4;
                if (grp == 0) *(GAS f32x4*)(VT + o) = (f32x4){s[0], s[1], s[2], s[3]};
                else { v2u w; w.x = pk2(s[0], s[1]); w.y = pk2(s[2], s[3]); *(GAS v2u*)((grp == 1 ? X1T : X2T) + o) = w; } } }
        __syncthreads();
    }
}
__device__ __forceinline__ void p_hy_ctx(const Frame& F0, int l) { const Frame F = launder(F0);
    LAS float* L = (LAS float*)F.lds; const int tid = F.tid, t = tid & 255, cs = tid >> 8;
    LAS float* SV = L + cs * 1280, * HFW = SV + 256, * HBW = SV + 512, * HF2 = SV + 768, * HB2 = SV + 1024;
    const GAS float* CU = (const GAS float*)(F.ws + WS_CU); const GAS float* HTC = (const GAS float*)(F.ws + WS_HTC); GAS float* OTC = (GAS float*)(F.ws + WS_OTC);
    for (int u = blockIdx.x; u < NBATCH * 128; u += F.G) {
        const int b = u >> 7, c = (u & 127) * 2 + cs;
        const float n0 = nrm_ctx(F, 0, c), n1 = nrm_ctx(F, 1, c);
        const GAS float* cu = CU + ((size_t)b * CTXL + t) * 768;
        const float v = cu[c], x1 = cu[256 + c], x2 = cu[512 + c];
        SV[t] = v; HFW[t] = HTC[(size_t)(0 + c) * CTXL + t] * n0; HBW[t] = HTC[(size_t)(256 + c) * CTXL + t] * n0; HF2[t] = HTC[(size_t)(512 + c) * CTXL + t] * n1; HB2[t] = HTC[(size_t)(768 + c) * CTXL + t] * n1;
        __syncthreads();
        float y = F.in[I_HSKIP][(l * 2 + 0) * 256 + c] * v;
        for (int s = 0; s <= t; ++s) y += HFW[t - s] * SV[s];
        for (int s = t + 1; s < CTXL; ++s) y += HBW[s - t] * SV[s];
        const float z = x1 * y;
        __syncthreads();
        SV[t] = z;
        __syncthreads();
        float y2 = F.in[I_HSKIP][(l * 2 + 1) * 256 + c] * z;
        for (int s = 0; s <= t; ++s) y2 += HF2[t - s] * SV[s];
        for (int s = t + 1; s < CTXL; ++s) y2 += HB2[s - t] * SV[s];
        OTC[((size_t)b * CTXL + t) * 256 + c] = x2 * y2;
        __syncthreads();
    }
}
__device__ __forceinline__ void p_ynorm_b(const Frame& F0, int l, bool with_ctx) { const Frame F = launder(F0);
    LAS float* T = (LAS float*)F.lds; LAS float* RS = T + 256 * 65; LAS float* PS = RS + 64; const int tid = F.tid;
    const GAS float* VT = (const GAS float*)(F.ws + WS_VT); const GAS float* OTC = (const GAS float*)(F.ws + WS_OTC); GAS bf16* Y = (GAS bf16*)(F.ws + WS_Y); const GAS float* hg = F.in[I_HNG] + l * 256;
    const int nlat = NBATCH * (SEQ / 64), nctx = with_ctx ? NBATCH * (CTXL / 64) : 0;
    for (int u = blockIdx.x; u < nlat + nctx; u += F.G) {
        const bool lat = u < nlat; const int uu = lat ? u : u - nlat, b = lat ? uu / (SEQ / 64) : uu / (CTXL / 64), t0 = (lat ? uu % (SEQ / 64) : uu % (CTXL / 64)) * 64;
        const size_t rowb = lat ? (size_t)b * SEQ + t0 : (size_t)TL + b * CTXL + t0;
        if (lat) { const int t4 = (tid & 15) * 4;
#pragma unroll
            for (int i = 0; i < 8; ++i) { const int c = (tid >> 4) + 32 * i; const f32x4 v = *(const GAS f32x4*)(VT + (size_t)(c * 2 + b) * SEQ + t0 + t4); LAS float* d = T + c * 65 + t4; d[0] = v.x; d[1] = v.y; d[2] = v.z; d[3] = v.w; } }
        else { for (int i = tid; i < 64 * 256; i += NTHR) { const int t = i >> 8, c = i & 255; T[c * 65 + t] = OTC[((size_t)b * CTXL + t0 + t) * 256 + c]; } }
        __syncthreads();
        { const int t = tid & 63, part = tid >> 6; float s = 0.f;
          for (int c = part * 32; c < part * 32 + 32; ++c) { const float v = T[c * 65 + t]; s += v * v; }
          PS[part * 64 + t] = s; }
        __syncthreads();
        if (tid < 64) { float s = 0.f;
#pragma unroll
            for (int p = 0; p < 8; ++p) s += PS[p * 64 + tid];
            RS[tid] = 1.f / sqrtf(s * (1.f / 256.f) + RMS_EPS); }
        __syncthreads();
        { const int t = tid >> 3, c0 = (tid & 7) * 8; const float rs = RS[t];
#pragma unroll
          for (int i = 0; i < 4; ++i) { const int c = c0 + 64 * i; float y[8];
#pragma unroll
              for (int e = 0; e < 8; ++e) y[e] = T[(c + e) * 65 + t] * rs * hg[c + e];
              v4u o; o.x = pk2(y[0], y[1]); o.y = pk2(y[2], y[3]); o.z = pk2(y[4], y[5]); o.w = pk2(y[6], y[7]);
              *(GAS v4u*)(Y + (rowb + t) * D + 256 + c) = o; } }
        __syncthreads();
    }
}

enum LP { LP_IN = 0, LP_PREP, LP_GLA2, LP_GLA3, LP_HY0, LP_HY1, LP_HY2, LP_HY3, LP_HY4, LP_HY5, LP_HY6, LP_HY7, LP_ATT, LP_YN, LP_OUT, LP_LN1, LP_F1, LP_F2, LP_M0  , LP_LN2 = LP_M0 + 9, PPL };
constexpr int NPRO = 4;
constexpr int NPHASE = NPRO + DEPTH * PPL;
template <int l>
__device__ __forceinline__ void layer_phases(const Frame& F, const XcdBarrier& bar, const int lo, const int hi) {
#define IN(k) (lo <= (k) && (k) < hi)
#define SEAM(k) do { if ((k) + 1 < hi) xcd_barrier(bar); } while (0)
    LAS unsigned char* ring = F.lds;
    constexpr int pb = NPRO + l * PPL;
#define lng (F.in[I_LNG] + (size_t)l * 2 * D)
#define lnb (F.in[I_LNB] + (size_t)l * 2 * D)
        if (IN(pb + LP_IN)) { const Frame P = launder(F);
            pg8::Gemm g{(const GAS bf16*)(P.ws + WS_XN), (const GAS bf16*)(P.ws + WS_WIN) + (size_t)l * NPH * D, MR, NPH, D, D, 0};
            pg8::StaticOrder S; S.init(MR, NPH, F.G, (int)blockIdx.x);
            EpiStoreBf16 E{(GAS bf16*)(P.ws + WS_PH), NPH, 1.f};
            pg8::gemm_phase<EpiStoreBf16, pg8::StaticOrder, true, true>(ring, g, S, E);
            SEAM(pb + LP_IN);
        }
        if (IN(pb + LP_PREP)) { const Frame P = launder(F); p_prep_mla_rows(F); p_gla_local(F, l);
            p_hy_shortconv(F, l); SEAM(pb + LP_PREP); }
        if (IN(pb + LP_GLA2)) { const Frame P = launder(F);
            { pg8::Gemm g{(const GAS bf16*)(P.ws + WS_PH) + PH_CQ, (const GAS bf16*)(P.ws + WS_WUQ) + (size_t)l * 768 * 256, MR, 768, 256, NPH, 0};
              pg8::StaticOrder S; S.init(MR, 768, F.G, (int)blockIdx.x);
              EpiMlaQ E{P.ws + WS_Q, P.ws + WS_QC, (const GAS float*)(P.ws + WS_RSQ), (const GAS float*)(P.ws + WS_ROPE)};
              pg8::gemm_phase<EpiMlaQ, pg8::StaticOrder, true, true>(ring, g, S, E); }
            { pg8::Gemm g{(const GAS bf16*)(P.ws + WS_PH) + PH_CKV, (const GAS bf16*)(P.ws + WS_WUKV) + (size_t)l * 1024 * 256, MR, 1024, 256, NPH, 0};
              pg8::StaticOrder S; S.init(MR, 1024, F.G, (int)blockIdx.x);
              EpiMlaKV E{P.ws + WS_K, (GAS bf16*)(P.ws + WS_V), (const GAS float*)(P.ws + WS_RSKV)};
              pg8::gemm_phase<EpiMlaKV, pg8::StaticOrder, true, true>(ring, g, S, E); }
            p_gla_scan(F); p_fft_pass1<0>(F, 0, WS_FA);
            SEAM(pb + LP_GLA2);
        }
        if (IN(pb + LP_GLA3)) { const Frame P = launder(F); p_gla_out(F, l, l == 0); p_attn_vt_pack(F); p_fft_pass2<0>(F, l, 0, WS_FA); if constexpr (l == 0) p_hy_ctx(F, l);
            SEAM(pb + LP_GLA3); }
        if (IN(pb + LP_HY0)) { p_fft_pass31(F, l); SEAM(pb + LP_HY0); }
        if (IN(pb + LP_HY1)) { p_fft_pass2<0>(F, l, 1, WS_FA); SEAM(pb + LP_HY1); }
        if (IN(pb + LP_HY2)) { p_fft_pass3(F, l, 1); SEAM(pb + LP_HY2); }
        if (IN(pb + LP_ATT)) { const Frame P = launder(F); p_attention(F, l == 0);
            SEAM(pb + LP_ATT); }
        if (IN(pb + LP_YN)) { const Frame P = launder(F); p_ynorm_c(F, l == 0 ? MR : TL, F.in[I_MNG] + (size_t)l * 512); p_ynorm_b(F, l, l == 0); if constexpr (l == 0) p_filt_hidden(F, 1); SEAM(pb + LP_YN); }
        if (IN(pb + LP_OUT)) { const Frame P = launder(F);
            const int M = (l == 0) ? MR : TL;
            pg8::Gemm g{(const GAS bf16*)(P.ws + WS_Y), (const GAS bf16*)(P.ws + WS_WOUT) + (size_t)l * D * D, M, D, D, D, 0};
            pg8::StaticOrder S; S.init(M, D, F.G, (int)blockIdx.x);
            EpiRes E{l == 0 ? F.in[I_X] : F.out, l == 0 ? F.in[I_CTX] : (const GAS float*)(P.ws + WS_XC), F.out, (GAS float*)(P.ws + WS_XC), modv(F, l, 0, 2)};
            pg8::gemm_phase<EpiRes, pg8::StaticOrder, true, true>(ring, g, S, E);
            if constexpr (l == 0) p_filt_raw(F, 1);
            SEAM(pb + LP_OUT);
        }
        if (IN(pb + LP_LN1)) { const Frame P = launder(F);
            if constexpr (l == 0) { p_ln(F, MR, lng, lnb, true, l, 3); p_fft_pass1<1>(F, 0, WS_FA0); p_fft_pass1<1>(F, 1, WS_FA1); }
            else { p_ln_route(F, lng, lnb, l); p_moe_weights(F); }
            SEAM(pb + LP_LN1);
        }
        if constexpr (l == 0) {
            if (IN(pb + LP_F1)) { const Frame P = launder(F);
                pg8::Gemm g{(const GAS bf16*)(P.ws + WS_XN), (const GAS bf16*)(P.ws + WS_W13), MR, 2 * DFF, D, D, 0};
                pg8::StaticOrder S; S.init(MR, 2 * DFF, F.G, (int)blockIdx.x);
                EpiSwiglu E{(GAS bf16*)(P.ws + WS_G), DFF, 1.f};
                pg8::gemm_phase<EpiSwiglu, pg8::StaticOrder, true, true>(ring, g, S, E);
                p_fft_pass2<1>(F, 1, 0, WS_FA0); p_fft_pass2<1>(F, 1, 1, WS_FA1);
                SEAM(pb + LP_F1);
            }
            if (IN(pb + LP_F2)) { const Frame P = launder(F);
                pg8::Gemm g{(const GAS bf16*)(P.ws + WS_G), (const GAS bf16*)(P.ws + WS_W2), MR, D, DFF, DFF, 0};
                pg8::StaticOrder S; S.init(MR, D, F.G, (int)blockIdx.x);
                EpiRes E{F.out, (const GAS float*)(P.ws + WS_XC), F.out, (GAS float*)(P.ws + WS_XC), modv(F, l, 0, 5)};
                pg8::gemm_phase<EpiRes, pg8::StaticOrder, true, true>(ring, g, S, E);
                SEAM(pb + LP_F2);
            }
            if (IN(pb + LP_LN2)) { const Frame P = launder(F); p_ln(F, MR, lng + D, lnb + D, true, l + 1, 0); SEAM(pb + LP_LN2); }
        } else {
            if (IN(pb + LP_F1)) { const Frame P = launder(F); p_moe_scatter(F); SEAM(pb + LP_F1); }
            for (int ch = 0; ch < MOE_NCHUNK; ++ch) {
                if (IN(pb + LP_F2 + 2 * ch)) { const Frame P = launder(F);
                    moe_base_to_lds(P);
                    pg8::Gemm g{(const GAS bf16*)(P.ws + WS_HS8 + (size_t)ch * MOE_CHUNK_TILES * 256 * D), (const GAS bf16*)(P.ws + WS_WM13), MOE_CHUNK_TILES * 256, 2 * EFF, D / 2, D / 2, (size_t)2 * EFF * D};
                    MoeOrder S; S.init((const LAS int*)(F.lds + LDS_MOEBT), ch, 2 * EFF / 256, F.G, (int)blockIdx.x);
                    EpiSwiglu8 E{P.ws + WS_GC, EFF, 1.f / MOE_WSCALE, MOE_GSCALE};
                    pg8::gemm_phase<EpiSwiglu8, MoeOrder, true, true, true>(ring, g, S, E);
                    SEAM(pb + LP_F2 + 2 * ch);
                }
                if (IN(pb + LP_F2 + 2 * ch + 1)) { const Frame P = launder(F);
                    moe_base_to_lds(P);
                    pg8::Gemm g{(const GAS bf16*)(P.ws + WS_GC), (const GAS bf16*)(P.ws + WS_WM2), MOE_CHUNK_TILES * 256, D, EFF / 2, EFF / 2, (size_t)D * EFF};
                    MoeOrder S; S.init((const LAS int*)(F.lds + LDS_MOEBT), ch, D / 256, F.G, (int)blockIdx.x);
                    EpiStoreBf16 E{(GAS bf16*)(P.ws + WS_HS) + (size_t)ch * MOE_CHUNK_TILES * 256 * D, D, 1.f / (MOE_GSCALE * MOE_W2SCALE)};
                    pg8::gemm_phase<EpiStoreBf16, MoeOrder, true, true, true>(ring, g, S, E);
                    SEAM(pb + LP_F2 + 2 * ch + 1);
                }
            }
            if (IN(pb + LP_LN2)) { const Frame P = launder(F); p_ln_combine(F, lng + D, lnb + D, l); SEAM(pb + LP_LN2); }
        }

#undef lng
#undef lnb
#undef IN
#undef SEAM
}
__global__ void __launch_bounds__(NTHR, 2) mega(Args args) {
    extern __shared__ __attribute__((aligned(16))) unsigned char lds_raw[];
    Frame F;
    F.lds = (LAS unsigned char*)lds_raw; F.ws = args.ws; F.ctl = (gu32*)(args.ws + WS_CTL); F.in = (const GAS float* const GAS*)(args.ws + WS_PTRTAB); F.out = args.out;
    F.tid = threadIdx.x; F.lane = F.tid & 63; F.wave = __builtin_amdgcn_readfirstlane(F.tid >> 6); F.G = gridDim.x;
    F.gw = blockIdx.x * NWAVES + F.wave; F.ngw = F.G * NWAVES;
    volatile LAS unsigned* MISC = (volatile LAS unsigned*)(F.lds + LDS_MISC);
    if (F.tid < 32) MISC[F.tid] = 0u;
    __syncthreads();
    XcdBarrier bar; bar.bar = (unsigned*)(F.ctl + CW_BAR); bar.x = 0; bar.st = nullptr;
#if !MK_PER_PHASE
    bar = xcd_barrier_post((unsigned*)(F.ctl + CW_BAR), MISC + 8);
#endif
    const int lo = args.ph_lo, hi = args.ph_hi;
#define IN(k) (lo <= (k) && (k) < hi)
#define SEAM(k) do { if ((k) + 1 < hi) xcd_barrier(bar); } while (0)
    LAS unsigned char* ring = F.lds;
#define LTID() ({ int t_ = F.tid; asm volatile("" : "+v"(t_)); t_; })

    if (IN(0)) { Frame FK = F; FK.in = (const GAS float* const GAS*)(const GAS void*)args.in;
        if (blockIdx.x == 0 && F.tid < 37) ((const GAS float* GAS*)(args.ws + WS_PTRTAB))[F.tid] = args.in[F.tid];
        p0_modv(FK); p0_weights(FK); p0_rope_table(FK); __syncthreads();     p_filt_hidden(FK, 0);
        SEAM(0); }
    if (IN(1)) { p_xn0(F); p_filt_raw(F, 0);
        SEAM(1); }
    if (IN(2)) { p_fft_pass1<1>(F, 0, WS_FA0); p_fft_pass1<1>(F, 1, WS_FA1); SEAM(2); }
    if (IN(3)) { p_fft_pass2<1>(F, 0, 0, WS_FA0); p_fft_pass2<1>(F, 0, 1, WS_FA1); SEAM(3); }

    layer_phases<0>(F, bar, lo, hi);
    layer_phases<1>(F, bar, lo, hi);
#undef IN
#undef SEAM
}

extern "C" void kernel_launch(void* const* d_in, const int* in_sizes, int n_in, void* d_out, int out_size, void* d_ws, size_t ws_size, hipStream_t stream) {
    static int grid = 0;
    if (grid == 0) {
        if (n_in != 37 || in_sizes[0] != TL * D || out_size != TL * D || ws_size < WS_END2) { fprintf(stderr, "kernel_launch: shape/workspace mismatch (n_in %d in0 %d out %d ws %zu need %zu)\n", n_in, n_in > 0 ? in_sizes[0] : -1, out_size, ws_size, (size_t)WS_END2); grid = -1; return; }
        int dev = 0, cus = 0, per_cu = 0;
        if (hipGetDevice(&dev) != hipSuccess || hipDeviceGetAttribute(&cus, hipDeviceAttributeMultiprocessorCount, dev) != hipSuccess) { grid = -1; return; }
        if (hipFuncSetAttribute((const void*)mega, hipFuncAttributeMaxDynamicSharedMemorySize, LDS_BYTES) != hipSuccess) { fprintf(stderr, "kernel_launch: hipFuncSetAttribute failed\n"); grid = -1; return; }
        if (hipOccupancyMaxActiveBlocksPerMultiprocessor(&per_cu, (const void*)mega, NTHR, LDS_BYTES) != hipSuccess || per_cu < 1) { fprintf(stderr, "kernel_launch: occupancy query says %d\n", per_cu); }
        (void)hipGetLastError();
        grid = cus;
    }
    if (grid < 0) return;
    if (hipMemsetAsync((char*)d_ws + WS_CTL, 0, CTL_ZERO_BYTES, stream) != hipSuccess) return;
    Args a{};
    for (int i = 0; i < 37; ++i) a.in[i] = (const GAS float*)d_in[i];
    a.out = (GAS float*)d_out; a.ws = (GAS unsigned char*)d_ws;
#if MK_PER_PHASE
    for (int p = 0; p < NPHASE; ++p) { a.ph_lo = p; a.ph_hi = p + 1; hipLaunchKernelGGL(mega, dim3(grid), dim3(NTHR), LDS_BYTES, stream, a); }
#else
    a.ph_lo = 0; a.ph_hi = NPHASE;
    hipLaunchKernelGGL(mega, dim3(grid), dim3(NTHR), LDS_BYTES, stream, a);
#endif
    const hipError_t le = hipPeekAtLastError();
    if (le != hipSuccess) fprintf(stderr, "kernel_launch: launch failed: %s\n", hipGetErrorName(le));
}
```

```cpp
#include <hip/hip_runtime.h>
#include <cstdio>
#include <cstdint>
namespace pg8 {
#define PG8_LAS __attribute__((address_space(3)))
#define PG8_GAS __attribute__((address_space(1)))
typedef unsigned short bf16_t;
typedef short bf16x8 __attribute__((ext_vector_type(8)));
typedef float f32x4 __attribute__((ext_vector_type(4)));
typedef unsigned u32x4 __attribute__((ext_vector_type(4)));
typedef int i32x8_t __attribute__((ext_vector_type(8)));
typedef short bf16x16 __attribute__((ext_vector_type(16)));
constexpr int BM = 256, BK = 64, HALF = 128, HTB = HALF * BK * 2  , STAGE_BYTES = 8 * HTB, NXCD = 8, WGM = 8;

__host__ __device__ __forceinline__ int lds_byte(int r, int c) { const int st = (r >> 4) * 2 + (c >> 5), rr = r & 15, cc = c & 31, ob = rr * 64 + cc * 2; return st * 1024 + (ob ^ (((ob >> 9) & 1) << 5)); }
__host__ __device__ __forceinline__ void stage_rc(int b, int& R, int& C) { const int st = b / 1024, sb = b % 1024, swz = sb ^ (((sb >> 9) & 1) << 5); R = (st >> 1) * 16 + swz / 64; C = (st & 1) * 32 + (swz % 64) / 2; }
__host__ __device__ __forceinline__ int perm32(int rho) { const int n = rho >> 4, i = rho & 15; return 8 * (i >> 2) + 4 * n + (i & 3); }

struct Unit { int pm, pn, be; };
struct Gemm { const PG8_GAS bf16_t* A; const PG8_GAS bf16_t* Bt; int M, N, K; int lda; size_t bstride; };

struct StaticOrder {
    int nM, nN, nwg, G, c;
    __host__ __device__ void init(int M, int N, int G_, int c_) { nM = M / BM; nN = N / BM; nwg = nM * nN; G = G_; c = c_; }
    __host__ __device__ bool next(int i, Unit& u) const {
        const long L = (long)i * G + c; if (L >= nwg) return false;
        int wgid = (int)L; { const int q = nwg / NXCD, r = nwg % NXCD, xcd = wgid % NXCD, off = wgid / NXCD; wgid = (xcd < r ? xcd * (q + 1) : r * (q + 1) + (xcd - r) * q) + off; }
        const int nig = WGM * nN, gid = wgid / nig, fm = gid * WGM, gsz = (nM - fm) < WGM ? (nM - fm) : WGM;
        u.pm = fm + ((wgid % nig) % gsz); u.pn = (wgid % nig) / gsz; u.be = 0; return true;
    }
    __device__ __forceinline__ void a_ready(const Unit&) const {}
    __device__ __forceinline__ void done(const Unit&) const {}
};


__device__ __forceinline__ unsigned cvt_pk_bf16(float lo, float hi) { unsigned r; asm volatile("v_cvt_pk_bf16_f32 %0, %1, %2" : "=v"(r) : "v"(lo), "v"(hi)); return r; }
typedef float f32x2 __attribute__((ext_vector_type(2)));
typedef unsigned u32x2 __attribute__((ext_vector_type(2)));

template <class Epi, class Sched, bool ALIGN_EPI = false, bool SP2 = false, bool F8 = false>
__device__ __forceinline__ void gemm_phase(PG8_LAS unsigned char* lds, const Gemm g, const Sched& S, const Epi& E) {
    { unsigned lb_ = (unsigned)(size_t)lds; asm volatile("" : "+s"(lb_)); lds = (PG8_LAS unsigned char*)(size_t)lb_; }
    int tid_ = threadIdx.x; asm volatile("" : "+v"(tid_));
    const int tid = tid_, wid = __builtin_amdgcn_readfirstlane(tid >> 6), lane = tid & 63, wr = wid >> 2, wc = wid & 3, fr = lane & 15, fq = lane >> 4;
    int K_ = g.K; asm volatile("" : "+s"(K_)); const int K = K_, nt = K / BK;
    unsigned voffA[2], voffB[2];
#pragma unroll
    for (int i = 0; i < 2; ++i) { int R, C; stage_rc(tid * 16 + i * 8192, R, C); const int Rb = Epi::PERM ? ((R & ~31) + perm32(R & 31)) : R;
        voffA[i] = (unsigned)(R * g.lda + C) * 2u; voffB[i] = (unsigned)(Rb * K + C) * 2u; }
    const size_t kstep = (size_t)(BK * 2);
    const size_t hstepB = (size_t)HALF * K * 2, hstepA = (size_t)HALF * g.lda * 2;
    const size_t tstepA = 2 * hstepA, tstepB = 2 * hstepB;
    const unsigned ldsw = (unsigned)wid * 1024u;
    const int aoff = lds_byte(wr * 64 + fr, fq * 8), boff = lds_byte(wc * 32 + fr, fq * 8);
#define PG8_SA(b, h) (((b) * 2 + (h)) * HTB)
#define PG8_SB(b, h) ((4 + (b) * 2 + (h)) * HTB)
#define PG8_STAGE(bufoff, gbase, voff) do { _Pragma("unroll") for (int _i = 0; _i < 2; ++_i) \
        __builtin_amdgcn_global_load_lds((const PG8_GAS unsigned*)((const PG8_GAS char*)(gbase) + (voff)[_i]), (PG8_LAS unsigned*)(lds + (bufoff) + ldsw + _i * 8192), 16, 0, 0); } while (0)
#define PG8_LDA(dst, b, h) do { _Pragma("unroll") for (int m = 0; m < 4; ++m) dst[m] = __builtin_shufflevector(*(const PG8_LAS bf16x8*)(lds + PG8_SA(b, h) + aoff + m * 2048), *(const PG8_LAS bf16x8*)(lds + PG8_SA(b, h) + aoff + m * 2048 + 1024), 0, 1, 2, 3, 4, 5, 6, 7, 8, 9, 10, 11, 12, 13, 14, 15); } while (0)
#define PG8_LDB(dst, b, h) do { _Pragma("unroll") for (int n = 0; n < 2; ++n) dst[n] = __builtin_shufflevector(*(const PG8_LAS bf16x8*)(lds + PG8_SB(b, h) + boff + n * 2048), *(const PG8_LAS bf16x8*)(lds + PG8_SB(b, h) + boff + n * 2048 + 1024), 0, 1, 2, 3, 4, 5, 6, 7, 8, 9, 10, 11, 12, 13, 14, 15); } while (0)
#define PG8_HALF(x, k) ((k) == 0 ? __builtin_shufflevector(x, x, 0, 1, 2, 3, 4, 5, 6, 7) : __builtin_shufflevector(x, x, 8, 9, 10, 11, 12, 13, 14, 15))
#define PG8_MMA(ai, bj, At, Bt) do { __builtin_amdgcn_s_setprio(1); if constexpr (F8) { _Pragma("unroll") for (int m = 0; m < 4; ++m) _Pragma("unroll") for (int n = 0; n < 2; ++n) \
        asm volatile("v_mfma_f32_16x16x128_f8f6f4 %0, %1, %2, %0" : "+v"(acc[ai][bj][m][n]) : "v"(__builtin_bit_cast(i32x8_t, Bt[n])), "v"(__builtin_bit_cast(i32x8_t, At[m]))); } \
    else { _Pragma("unroll") for (int m = 0; m < 4; ++m) _Pragma("unroll") for (int n = 0; n < 2; ++n) _Pragma("unroll") for (int k = 0; k < 2; ++k) \
        acc[ai][bj][m][n] = __builtin_amdgcn_mfma_f32_16x16x32_bf16(PG8_HALF(Bt[n], k), PG8_HALF(At[m], k), acc[ai][bj][m][n], 0, 0, 0); } __builtin_amdgcn_s_setprio(0); } while (0)
#define PG8_F8_DRAIN() do { if constexpr (F8) asm volatile("s_nop 15\n\ts_nop 15" ::: "memory"); } while (0)
#define PG8_WAIT_V(n) asm volatile("s_waitcnt vmcnt(" #n ")" ::: "memory")
#define PG8_WAIT_L(n) asm volatile("s_waitcnt lgkmcnt(" #n ")" ::: "memory")
#define PG8_BAR __builtin_amdgcn_s_barrier()
#define PG8_SCHED __builtin_amdgcn_sched_barrier(0)
    Unit cur, nxt; int ui = 0;
    if (!S.next(0, cur)) return;
    f32x4 acc[2][2][4][2];
#pragma unroll
    for (int a = 0; a < 2; ++a)
#pragma unroll
        for (int b = 0; b < 2; ++b)
#pragma unroll
            for (int m = 0; m < 4; ++m)
#pragma unroll
                for (int n = 0; n < 2; ++n) acc[a][b][m][n] = (f32x4){0.f, 0.f, 0.f, 0.f};
    bf16x16 At[4], B0[2], B1[2];
    const PG8_GAS char* cA = (const PG8_GAS char*)g.A + (size_t)cur.pm * tstepA; const PG8_GAS char* cB = (const PG8_GAS char*)g.Bt + (size_t)cur.be * g.bstride + (size_t)cur.pn * tstepB;
    S.a_ready(cur);
    if constexpr (SP2) {
        PG8_STAGE(PG8_SB(0, 0), cB, voffB); PG8_STAGE(PG8_SB(0, 1), cB + hstepB, voffB); PG8_STAGE(PG8_SA(0, 0), cA, voffA); PG8_STAGE(PG8_SA(0, 1), cA + hstepA, voffA);
        if (wr == 1) PG8_BAR;
        PG8_WAIT_V(2); PG8_BAR;
        PG8_STAGE(PG8_SB(1, 0), cB + kstep, voffB); PG8_STAGE(PG8_SA(1, 0), cA + kstep, voffA); PG8_STAGE(PG8_SB(1, 1), cB + hstepB + kstep, voffB);
        PG8_WAIT_V(6); PG8_BAR;
    } else {
        PG8_STAGE(PG8_SB(0, 0), cB, voffB); PG8_STAGE(PG8_SA(0, 0), cA, voffA); PG8_STAGE(PG8_SB(0, 1), cB + hstepB, voffB); PG8_STAGE(PG8_SA(0, 1), cA + hstepA, voffA);
        if (wr == 1) PG8_BAR;
        PG8_WAIT_V(4); PG8_BAR;
        PG8_STAGE(PG8_SB(1, 0), cB + kstep, voffB); PG8_STAGE(PG8_SA(1, 0), cA + kstep, voffA); PG8_STAGE(PG8_SB(1, 1), cB + hstepB + kstep, voffB);
        PG8_WAIT_V(6); PG8_BAR;
    }
    for (;;) {
        const bool has_next = S.next(ui + 1, nxt);
        const PG8_GAS char* nA = has_next ? (const PG8_GAS char*)g.A + (size_t)nxt.pm * tstepA : cA; const PG8_GAS char* nB = has_next ? (const PG8_GAS char*)g.Bt + (size_t)nxt.be * g.bstride + (size_t)nxt.pn * tstepB : cB;
        for (int t = 0; t < nt; t += 2) {
            const bool last = (t == nt - 2);
            const PG8_GAS char* a1 = cA + (size_t)(t + 1) * kstep;
            const PG8_GAS char* a2 = last ? nA : cA + (size_t)(t + 2) * kstep; const PG8_GAS char* b2 = last ? nB : cB + (size_t)(t + 2) * kstep;
            const PG8_GAS char* a3 = a2 + kstep; const PG8_GAS char* b3 = b2 + kstep;
            if (last && has_next) S.a_ready(nxt);
            if constexpr (SP2) {
            PG8_LDB(B0, 0, 0); PG8_LDB(B1, 0, 1); PG8_SCHED; PG8_LDA(At, 0, 0); PG8_STAGE(PG8_SA(1, 1), a1 + hstepA, voffA);
            PG8_WAIT_V(8); PG8_WAIT_L(0); PG8_BAR; PG8_MMA(0, 0, At, B0); PG8_MMA(0, 1, At, B1); PG8_BAR; PG8_SCHED;
            PG8_LDA(At, 0, 1); PG8_STAGE(PG8_SB(0, 0), b2, voffB); PG8_STAGE(PG8_SB(0, 1), b2 + hstepB, voffB); PG8_STAGE(PG8_SA(0, 0), a2, voffA);
            PG8_WAIT_V(8); PG8_WAIT_L(0); PG8_BAR; PG8_MMA(1, 0, At, B0); PG8_MMA(1, 1, At, B1); PG8_BAR; PG8_SCHED;
            PG8_LDB(B0, 1, 0); PG8_LDB(B1, 1, 1); PG8_SCHED; PG8_LDA(At, 1, 0); PG8_STAGE(PG8_SA(0, 1), a2 + hstepA, voffA);
            PG8_WAIT_V(8); PG8_WAIT_L(0); PG8_BAR; PG8_MMA(0, 0, At, B0); PG8_MMA(0, 1, At, B1); PG8_BAR; PG8_SCHED;
            PG8_LDA(At, 1, 1); PG8_STAGE(PG8_SB(1, 0), b3, voffB); PG8_STAGE(PG8_SB(1, 1), b3 + hstepB, voffB); PG8_STAGE(PG8_SA(1, 0), a3, voffA);
            PG8_WAIT_V(8); PG8_WAIT_L(0); PG8_BAR; PG8_MMA(1, 0, At, B0); PG8_MMA(1, 1, At, B1); PG8_BAR; PG8_SCHED;
            } else {
            PG8_LDB(B0, 0, 0); PG8_SCHED; PG8_LDA(At, 0, 0); PG8_STAGE(PG8_SA(1, 1), a1 + hstepA, voffA);
            PG8_WAIT_L(8); PG8_BAR; PG8_WAIT_L(0); PG8_MMA(0, 0, At, B0); PG8_BAR; PG8_SCHED;
            PG8_LDB(B1, 0, 1); PG8_STAGE(PG8_SB(0, 0), b2, voffB);
            PG8_BAR; PG8_WAIT_L(0); PG8_MMA(0, 1, At, B1); PG8_BAR;
            PG8_LDA(At, 0, 1); PG8_STAGE(PG8_SA(0, 0), a2, voffA);
            PG8_BAR; PG8_WAIT_L(0); PG8_MMA(1, 0, At, B0); PG8_BAR; PG8_SCHED;
            PG8_STAGE(PG8_SB(0, 1), b2 + hstepB, voffB);
            PG8_WAIT_V(6); PG8_BAR; PG8_MMA(1, 1, At, B1); PG8_BAR;
            PG8_LDB(B0, 1, 0); PG8_SCHED; PG8_LDA(At, 1, 0); PG8_STAGE(PG8_SA(0, 1), a2 + hstepA, voffA);
            PG8_WAIT_L(8); PG8_BAR; PG8_WAIT_L(0); PG8_MMA(0, 0, At, B0); PG8_BAR; PG8_SCHED;
            PG8_LDB(B1, 1, 1); PG8_STAGE(PG8_SB(1, 0), b3, voffB);
            PG8_BAR; PG8_WAIT_L(0); PG8_MMA(0, 1, At, B1); PG8_BAR;
            PG8_LDA(At, 1, 1); PG8_STAGE(PG8_SA(1, 0), a3, voffA);
            PG8_BAR; PG8_WAIT_L(0); PG8_MMA(1, 0, At, B0); PG8_BAR; PG8_SCHED;
            PG8_STAGE(PG8_SB(1, 1), b3 + hstepB, voffB);
            PG8_WAIT_V(6); PG8_BAR; PG8_MMA(1, 1, At, B1); PG8_BAR;
            }
        }
        if constexpr (ALIGN_EPI) { if (wr == 0) PG8_BAR; }
        PG8_F8_DRAIN();
        if constexpr (!Epi::AFTER_DRAIN) { E(acc, cur, wr, wc, fr, fq); S.done(cur); }
        if (!has_next) break;
#pragma unroll
        for (int a = 0; a < 2; ++a)
#pragma unroll
            for (int b = 0; b < 2; ++b)
#pragma unroll
                for (int m = 0; m < 4; ++m)
#pragma unroll
                    for (int n = 0; n < 2; ++n) acc[a][b][m][n] = (f32x4){0.f, 0.f, 0.f, 0.f};
        cur = nxt; cA = nA; cB = nB; ++ui;
        if constexpr (ALIGN_EPI) { if (wr == 1) PG8_BAR; }
    }
    PG8_WAIT_V(0);
    if constexpr (!ALIGN_EPI) { if (wr == 0) PG8_BAR; }
    PG8_BAR;
    if constexpr (Epi::AFTER_DRAIN) { E.fused(acc, cur, wr, wc, fr, fq, lds, wid, lane); S.done(cur); }
#undef PG8_SA
#undef PG8_SB
#undef PG8_STAGE
#undef PG8_LDA
#undef PG8_LDB
#undef PG8_MMA
#undef PG8_HALF
#undef PG8_F8_DRAIN
#undef PG8_WAIT_V
#undef PG8_WAIT_L
#undef PG8_BAR
#undef PG8_SCHED
}
}


#ifndef MK_PER_PHASE
#define MK_PER_PHASE 0
#endif

constexpr int NWAVES = 8, NTHR = 512;
constexpr int D = 1024, NBATCH = 2, SEQ = 16384, TL = NBATCH * SEQ, CTXL = 256, TC = NBATCH * CTXL, MR = TL + TC;
constexpr int NPH = 2048, DFF = 2816, NEXP = 8, EFF = 3584, DEPTH = 2;
constexpr float ALPHA = 1.41421356237309515f;
constexpr float LN_EPS = 1e-5f, RMS_EPS = 1e-6f;
constexpr int PH_QA = 0, PH_KA = 128, PH_VA = 256, PH_GA = 512, PH_HY = 768, PH_CQ = 1536, PH_CKV = 1792, PH_KR = 1920, PH_ALR = 1952;

constexpr size_t MiB = 1u << 20;
constexpr size_t WS_CTL = 0, CTL_ZERO_BYTES = 1 * MiB;
constexpr int CW_TMO = 0, CW_BAR = 4096;
constexpr size_t CTL_MODV = 64 * 1024;
constexpr size_t WS_SMALL = 1 * MiB;
constexpr size_t WS_PTRTAB = WS_SMALL + 16 * 1024;
constexpr size_t WS_WIN = 2 * MiB, WS_WOUT = 10 * MiB, WS_W13 = 14 * MiB, WS_W2 = 25 * MiB, WS_WUQ = 31 * MiB, WS_WUKV = 32 * MiB;
constexpr size_t AB = 34 * MiB;
constexpr size_t WS_XN = AB, WS_Y = AB + 65 * MiB, WS_PH = AB + 130 * MiB, WS_Q = AB + 260 * MiB, WS_K = AB + 309 * MiB, WS_V = AB + 358 * MiB;
constexpr size_t WS_VT = AB + 391 * MiB, WS_X1T = AB + 423 * MiB, WS_X2T = AB + 439 * MiB, WS_HF = AB + 455 * MiB, WS_XC = AB + 519 * MiB, WS_END = AB + 521 * MiB;
constexpr size_t WS_G = WS_PH;
static_assert(WS_W13 + (size_t)2 * DFF * D * 2 <= WS_W2 && WS_W2 + (size_t)D * DFF * 2 <= WS_WUQ, "weights map");
static_assert(WS_G + (size_t)MR * DFF * 2 <= WS_K, "G overlay");
static_assert(WS_END <= 573 * MiB, "d_ws budget");

constexpr int LDS_BYTES = 147456, LDS_MISC = 131072 + 320;

#define GAS __attribute__((address_space(1)))
#define LAS __attribute__((address_space(3)))
typedef unsigned short bf16;
typedef unsigned v4u __attribute__((ext_vector_type(4)));
typedef unsigned v2u __attribute__((ext_vector_type(2)));
typedef float f32x4 __attribute__((ext_vector_type(4)));
typedef GAS unsigned gu32;
#define RLX_AGENT __ATOMIC_RELAXED, __HIP_MEMORY_SCOPE_AGENT
#define LDS_WAIT() asm volatile("s_waitcnt lgkmcnt(0)" ::: "memory")
#define VM_WAIT() asm volatile("s_waitcnt vmcnt(0)" ::: "memory")
__device__ __forceinline__ unsigned pk2(float lo, float hi) { return pg8::cvt_pk_bf16(lo, hi); }
__device__ __forceinline__ float bf2f(unsigned short h) { return __uint_as_float((unsigned)h << 16); }
__device__ __forceinline__ float siluf(float x) { return x / (1.f + __expf(-x)); }
#define XB_TMO      128
#define XB_XCNT(j)  (256  + 64 * (j))
#define XB_XSUB(j)  (1280 + 64 * (j))
#define XB_XGEN(j)  (2304 + 64 * (j))
#define XB_TOP      3328
#define XB_TOPGEN   3392
#define XCD_BAR_WORDS 3456
#define XB_SPIN_CAP (1u << 18)

__device__ __forceinline__ unsigned xb_ld(unsigned* p)              { return __hip_atomic_load(p, __ATOMIC_RELAXED, __HIP_MEMORY_SCOPE_AGENT); }
__device__ __forceinline__ unsigned xb_add(unsigned* p, unsigned v) { return __hip_atomic_fetch_add(p, v, __ATOMIC_RELAXED, __HIP_MEMORY_SCOPE_AGENT); }
__device__ __forceinline__ unsigned xb_xcc_id() { return (unsigned)__builtin_amdgcn_s_getreg((3 << 11) | 20) & 0xFu; }
#define XB_SPIN(cond, bar) do { unsigned _sp = 0; while (cond) { __builtin_amdgcn_s_sleep(1); \
    if ((++_sp & 255u) == 0u) { if (xb_ld(&(bar)[XB_TMO])) break; if (_sp > XB_SPIN_CAP) { atomicAdd(&(bar)[XB_TMO], 1u); break; } } } } while (0)

struct XcdBarrier {
    unsigned* bar; unsigned x;
    volatile LAS unsigned* st;
};

__device__ __forceinline__ XcdBarrier xcd_barrier_post(unsigned* bar, volatile LAS unsigned* st) {
    XcdBarrier b; b.bar = bar; b.x = xb_xcc_id(); b.st = st;
    if (threadIdx.x == 0) (void)xb_add(&bar[XB_XCNT(b.x)], 1u);
    return b;
}
__device__ __forceinline__ void xcd_barrier_complete(unsigned* bar, unsigned x, unsigned& nloc, unsigned& nx) {
    const unsigned G = gridDim.x * gridDim.y * gridDim.z;
    unsigned sum, cnt, mine, sp = 0u;
    for (;;) {
        sum = 0u; cnt = 0u; mine = 0u;
#pragma unroll
        for (unsigned j = 0; j < 16; ++j) { const unsigned c = xb_ld(&bar[XB_XCNT(j)]); sum += c; cnt += (c > 0u) ? 1u : 0u; mine = (j == x) ? c : mine; }
        if (sum == G) break;
        __builtin_amdgcn_s_sleep(1);
        if ((++sp & 255u) == 0u) { if (xb_ld(&bar[XB_TMO])) break; if (sp > XB_SPIN_CAP) { atomicAdd(&bar[XB_TMO], 1u); break; } }
    }
    nloc = mine > 0u ? mine : 1u; nx = cnt > 0u ? cnt : 1u;
}

__device__ __forceinline__ void xcd_barrier(const XcdBarrier& b) {
    asm volatile("s_waitcnt vmcnt(0)" ::: "memory");
    __syncthreads();
    if (threadIdx.x == 0) {
        unsigned* bar = b.bar;
        __builtin_amdgcn_s_waitcnt(0);
        unsigned nloc = b.st[0], nx = b.st[1];
        if (nloc == 0u) { xcd_barrier_complete(bar, b.x, nloc, nx); b.st[0] = nloc; b.st[1] = nx; }
        const unsigned old = xb_add(&bar[XB_XSUB(b.x)], 1u);
        const unsigned gen = old / nloc;
        if (old + 1u == (gen + 1u) * nloc) {
            __builtin_amdgcn_fence(__ATOMIC_RELEASE, "agent");
            asm volatile("s_waitcnt vmcnt(0)" ::: "memory");
            const unsigned og = xb_add(&bar[XB_TOP], 1u);
            const unsigned tg = og / nx;
            if (og + 1u == (tg + 1u) * nx) xb_add(&bar[XB_TOPGEN], 1u);
            else XB_SPIN(xb_ld(&bar[XB_TOPGEN]) == tg, bar);
            __builtin_amdgcn_fence(__ATOMIC_ACQUIRE, "agent");
            xb_add(&bar[XB_XGEN(b.x)], 1u);
            asm volatile("s_waitcnt vmcnt(0)" ::: "memory");
        } else {
            XB_SPIN(xb_ld(&bar[XB_XGEN(b.x)]) == gen, bar);
            __builtin_amdgcn_fence(__ATOMIC_ACQUIRE, "agent");
            asm volatile("s_waitcnt vmcnt(0)" ::: "memory");
        }
    }
    __syncthreads();
}

struct Args { const GAS float* in[37]; GAS float* out; GAS unsigned char* ws; int ph_lo, ph_hi; };
enum In { I_X = 0, I_C, I_CTX, I_CCTX, I_WMOD, I_BMOD, I_WIN, I_GWG, I_GBG, I_GNG, I_HCW, I_HCB, I_HW1, I_HB1, I_HF1, I_HW2, I_HB2, I_HF2, I_HW3, I_HB3, I_HSKIP, I_HNG,
          I_QNG, I_WUQ, I_KVNG, I_WUKV, I_MNG, I_WOUT, I_LNG, I_LNB, I_FW1, I_FW3, I_FW2, I_ROUTER, I_MW1, I_MW3, I_MW2 };

struct Frame {
    LAS unsigned char* lds; GAS unsigned char* ws; gu32* ctl; const GAS float* const GAS* in; GAS float* out;
    int tid, lane, wave, G, gw, ngw;
};
__device__ __forceinline__ Frame launder(const Frame& F0) { Frame F = F0; int t = F0.tid; size_t z = 0; asm volatile("" : "+v"(t), "+s"(z)); F.tid = t; F.lane = t & 63; F.ws = F0.ws + z; F.ctl = (gu32*)(F.ws + WS_CTL); F.out = F0.out + z; return F; }
__device__ __forceinline__ float wave_sum(float v) {
#pragma unroll
    for (int o = 1; o < 64; o <<= 1) v += __shfl_xor(v, o);
    return v;
}
__device__ __forceinline__ const GAS float* modv(const Frame& F, int l, int v, int i) { return (const GAS float*)(F.ws + CTL_MODV) + ((size_t)(l * 3 + v) * 6 + i) * D; }
__device__ __forceinline__ int row_v(int row) { return row < TL ? (row >> 14) : 2; }

__device__ __forceinline__ void p0_modv(const Frame& F0) { const Frame F = launder(F0);
    const GAS float* c = F.in[I_C]; const GAS float* cc = F.in[I_CCTX]; const GAS float* wm = F.in[I_WMOD]; const GAS float* bm = F.in[I_BMOD];
    GAS float* mv = (GAS float*)(F.ws + CTL_MODV); LAS float* part = (LAS float*)F.lds;
    constexpr int NBLK = 6 * D / 64, NITEM = DEPTH * NBLK;
    for (int it = blockIdx.x; it < NITEM; it += F.G) {
        const int l = it / NBLK, nb = it % NBLK, n = nb * 64 + F.lane, k0 = F.wave * 128;
        const float s0a = siluf(c[k0 + F.lane]), s1a = siluf(c[D + k0 + F.lane]), s2a = siluf(cc[k0 + F.lane]);
        const float s0b = siluf(c[k0 + 64 + F.lane]), s1b = siluf(c[D + k0 + 64 + F.lane]), s2b = siluf(cc[k0 + 64 + F.lane]);
        float a0 = 0.f, a1 = 0.f, a2 = 0.f;
        const GAS float* w = wm + ((size_t)l * D + k0) * (6 * D) + n;
#pragma unroll 16
        for (int kk = 0; kk < 64; ++kk) { const float wv = w[(size_t)kk * (6 * D)]; a0 += __shfl(s0a, kk) * wv; a1 += __shfl(s1a, kk) * wv; a2 += __shfl(s2a, kk) * wv; }
#pragma unroll 16
        for (int kk = 0; kk < 64; ++kk) { const float wv = w[(size_t)(64 + kk) * (6 * D)]; a0 += __shfl(s0b, kk) * wv; a1 += __shfl(s1b, kk) * wv; a2 += __shfl(s2b, kk) * wv; }
        part[(F.wave * 3 + 0) * 64 + F.lane] = a0; part[(F.wave * 3 + 1) * 64 + F.lane] = a1; part[(F.wave * 3 + 2) * 64 + F.lane] = a2;
        __syncthreads();
        if (F.tid < 192) { const int v = F.tid >> 6, ln = F.tid & 63; float acc = bm[l * 6 * D + nb * 64 + ln];
#pragma unroll
            for (int wv = 0; wv < 8; ++wv) acc += part[(wv * 3 + v) * 64 + ln];
            mv[(size_t)(l * 3 + v) * 6 * D + nb * 64 + ln] = acc; }
        __syncthreads();
    }
}
template <class RowMap>
__device__ __forceinline__ void transpose_item(const GAS float* W, int N, GAS bf16* WT, int ldk, LAS float* scr, int item, int lane, const RowMap& rm, const GAS float* ks) {
    const int nblk = N / 32, kb = item / nblk, nb = item % nblk, k0 = 64 * kb, n0 = 32 * nb;
#pragma unroll 8
    for (int i = 0; i < 32; ++i) { const int kk = 2 * i + (lane >> 5); float v = W[(size_t)(k0 + kk) * N + n0 + (lane & 31)]; if (ks) v *= ks[k0 + kk]; scr[kk * 33 + (lane & 31)] = v; }
    LDS_WAIT(); asm volatile("" ::: "memory");
    const int c = lane & 7;
#pragma unroll
    for (int j = 0; j < 4; ++j) { const int n = (lane >> 3) + 8 * j; const LAS float* s = scr + (8 * c) * 33 + n;
        v4u o; o.x = pk2(s[0 * 33], s[1 * 33]); o.y = pk2(s[2 * 33], s[3 * 33]); o.z = pk2(s[4 * 33], s[5 * 33]); o.w = pk2(s[6 * 33], s[7 * 33]);
        *(GAS v4u*)(WT + (size_t)rm(n0 + n) * ldk + k0 + 8 * c) = o; }
    LDS_WAIT(); asm volatile("" ::: "memory");
}
__device__ __forceinline__ float clamp448(float x) { return fminf(fmaxf(x, -448.f), 448.f); }
__device__ __forceinline__ unsigned pk4_fp8(float a, float b, float c, float d) { unsigned w = 0; w = __builtin_amdgcn_cvt_pk_fp8_f32(clamp448(a), clamp448(b), w, false); w = __builtin_amdgcn_cvt_pk_fp8_f32(clamp448(c), clamp448(d), w, true); return w; }
template <class RowMap>
__device__ __forceinline__ void transpose_item_f8(const GAS float* W, int N, GAS unsigned char* WT, int ldk, LAS float* scr, int item, int lane, const RowMap& rm, float scale) {
    const int nblk = N / 32, kb = item / nblk, nb = item % nblk, k0 = 64 * kb, n0 = 32 * nb;
#pragma unroll 8
    for (int i = 0; i < 32; ++i) { const int kk = 2 * i + (lane >> 5); scr[kk * 33 + (lane & 31)] = W[(size_t)(k0 + kk) * N + n0 + (lane & 31)] * scale; }
    LDS_WAIT(); asm volatile("" ::: "memory");
    const int c = lane & 7;
#pragma unroll
    for (int j = 0; j < 4; ++j) { const int n = (lane >> 3) + 8 * j; const LAS float* s = scr + (8 * c) * 33 + n;
        v2u o; o.x = pk4_fp8(s[0 * 33], s[1 * 33], s[2 * 33], s[3 * 33]); o.y = pk4_fp8(s[4 * 33], s[5 * 33], s[6 * 33], s[7 * 33]);
        *(GAS v2u*)(WT + (size_t)rm(n0 + n) * ldk + k0 + 8 * c) = o; }
    LDS_WAIT(); asm volatile("" ::: "memory");
}
struct RmIdent { int off; __device__ int operator()(int n) const { return n + off; } };
struct RmWin { __device__ int operator()(int c) const {
    if (c < 768) return c; if (c < 800) return PH_ALR + (c - 768); if (c < 1568) return PH_HY + (c - 800); if (c < 1824) return PH_CQ + (c - 1568); if (c < 1952) return PH_CKV + (c - 1824); return PH_KR + (c - 1952); } };
struct RmGlu { int half; __device__ int operator()(int j) const { return (j >> 2) * 8 + half * 4 + (j & 3); } };

__device__ __forceinline__ void p0_weights(const Frame& F0) { const Frame F = launder(F0);
    LAS float* scr = (LAS float*)(F.lds + F.wave * 16384);
    GAS bf16* WIN = (GAS bf16*)(F.ws + WS_WIN); GAS bf16* WOUT = (GAS bf16*)(F.ws + WS_WOUT); GAS bf16* W13 = (GAS bf16*)(F.ws + WS_W13); GAS bf16* W2 = (GAS bf16*)(F.ws + WS_W2);
    GAS bf16* WUQ = (GAS bf16*)(F.ws + WS_WUQ); GAS bf16* WUKV = (GAS bf16*)(F.ws + WS_WUKV);
    constexpr int I_IN = (D / 64) * (1984 / 32), I_OUT = (D / 64) * (D / 32), I_F1 = (D / 64) * (DFF / 32), I_F2 = (DFF / 64) * (D / 32), I_UQ = (256 / 64) * (768 / 32), I_UKV = (128 / 64) * (1024 / 32);
    constexpr int NITEM = DEPTH * I_IN + DEPTH * I_OUT + 2 * I_F1 + I_F2 + DEPTH * I_UQ + DEPTH * I_UKV;
    for (int it = F.gw; it < NITEM; it += F.ngw) {
        int r = it;
        if (r < DEPTH * I_IN) { const int l = r / I_IN; transpose_item(F.in[I_WIN] + (size_t)l * D * 1984, 1984, WIN + (size_t)l * NPH * D, D, scr, r % I_IN, F.lane, RmWin{}, nullptr); continue; } r -= DEPTH * I_IN;
        if (r < DEPTH * I_OUT) { const int l = r / I_OUT; transpose_item(F.in[I_WOUT] + (size_t)l * D * D, D, WOUT + (size_t)l * D * D, D, scr, r % I_OUT, F.lane, RmIdent{0}, nullptr); continue; } r -= DEPTH * I_OUT;
        if (r < I_F1) { transpose_item(F.in[I_FW1], DFF, W13, D, scr, r, F.lane, RmGlu{0}, nullptr); continue; } r -= I_F1;
        if (r < I_F1) { transpose_item(F.in[I_FW3], DFF, W13, D, scr, r, F.lane, RmGlu{1}, nullptr); continue; } r -= I_F1;
        if (r < I_F2) { transpose_item(F.in[I_FW2], D, W2, DFF, scr, r, F.lane, RmIdent{0}, nullptr); continue; } r -= I_F2;
        if (r < DEPTH * I_UQ) { const int l = r / I_UQ; transpose_item(F.in[I_WUQ] + (size_t)l * 256 * 768, 768, WUQ + (size_t)l * 768 * 256, 256, scr, r % I_UQ, F.lane, RmIdent{0}, F.in[I_QNG] + l * 256); continue; } r -= DEPTH * I_UQ;
        { const int l = r / I_UKV; transpose_item(F.in[I_WUKV] + (size_t)l * 128 * 1024, 1024, WUKV + (size_t)l * 1024 * 256, 256, scr, r % I_UKV, F.lane, RmIdent{0}, F.in[I_KVNG] + l * 128); }
    }
    const int gt = blockIdx.x * NTHR + F.tid, ngt = F.G * NTHR;
    for (int i = gt; i < DEPTH * 64 * D / 8; i += ngt) { const int l = i / (64 * D / 8), r = i % (64 * D / 8); *(GAS v4u*)(WIN + ((size_t)l * NPH + 1984) * D + (size_t)r * 8) = (v4u){0u, 0u, 0u, 0u}; }
    for (int i = gt; i < DEPTH * 1024 * 128 / 8; i += ngt) { const int row = i / 16, c = i % 16; *(GAS v4u*)(WUKV + (size_t)row * 256 + 128 + c * 8) = (v4u){0u, 0u, 0u, 0u}; }
}

__device__ __forceinline__ void mod_store_bf16(const f32x4 (&v)[4], const GAS float* sh, const GAS float* sc, GAS bf16* orow, int lane) {
    GAS unsigned long long* o8 = (GAS unsigned long long*)orow + lane;
#pragma unroll
    for (int j = 0; j < 4; ++j) { const f32x4 a = ((const GAS f32x4*)sc)[lane + 64 * j], b = ((const GAS f32x4*)sh)[lane + 64 * j];
        const f32x4 y = v[j] * (a + 1.f) + b;
        o8[64 * j] = (unsigned long long)pk2(y.x, y.y) | ((unsigned long long)pk2(y.z, y.w) << 32); }
}
__device__ __forceinline__ void p_xn0(const Frame& F0) { const Frame F = launder(F0);
    GAS bf16* XN = (GAS bf16*)(F.ws + WS_XN);
    f32x4 nx[4];
#define XN0_LOAD(mm) do { const GAS float* src_ = (mm) < TL ? F.in[I_X] + (size_t)(mm) * D : F.in[I_CTX] + (size_t)((mm) - TL) * D; _Pragma("unroll") for (int j = 0; j < 4; ++j) nx[j] = ((const GAS f32x4*)src_)[F.lane + 64 * j]; } while (0)
    int m = F.gw; if (m < MR) XN0_LOAD(m);
    for (; m < MR; m += F.ngw) {
        f32x4 v[4];
#pragma unroll
        for (int j = 0; j < 4; ++j) v[j] = nx[j];
        if (m + F.ngw < MR) XN0_LOAD(m + F.ngw);
        const int vv = row_v(m);
        mod_store_bf16(v, modv(F, 0, vv, 0), modv(F, 0, vv, 1), XN + (size_t)m * D, F.lane);
    }
#undef XN0_LOAD
}
__device__ __forceinline__ GAS float* xres(const Frame& F, int row) { return row < TL ? F.out + (size_t)row * D : (GAS float*)(F.ws + WS_XC) + (size_t)(row - TL) * D; }
__device__ __forceinline__ void p_ln(const Frame& F0, int nrows, const GAS float* g, const GAS float* b, bool want_xn, int ml, int si) { const Frame F = launder(F0);
    GAS bf16* XN = (GAS bf16*)(F.ws + WS_XN);
    f32x4 nx[4];
    int m = F.gw; if (m < nrows) { const GAS float* r_ = xres(F, m);
#pragma unroll
        for (int j = 0; j < 4; ++j) nx[j] = ((const GAS f32x4*)r_)[F.lane + 64 * j]; }
    for (; m < nrows; m += F.ngw) {
        GAS float* row = xres(F, m);
        f32x4 v[4]; float s = 0.f;
#pragma unroll
        for (int j = 0; j < 4; ++j) { v[j] = nx[j]; s += (v[j].x + v[j].y) + (v[j].z + v[j].w); }
        if (m + F.ngw < nrows) { const GAS float* r_ = xres(F, m + F.ngw);
#pragma unroll
            for (int j = 0; j < 4; ++j) nx[j] = ((const GAS f32x4*)r_)[F.lane + 64 * j]; }
        const float mean = wave_sum(s) * (1.f / D); float s2 = 0.f;
#pragma unroll
        for (int j = 0; j < 4; ++j) { v[j] = v[j] - mean; s2 += (v[j].x * v[j].x + v[j].y * v[j].y) + (v[j].z * v[j].z + v[j].w * v[j].w); }
        const float rstd = 1.f / sqrtf(wave_sum(s2) * (1.f / D) + LN_EPS);
#pragma unroll
        for (int j = 0; j < 4; ++j) { const f32x4 gg = ((const GAS f32x4*)g)[F.lane + 64 * j], bb = ((const GAS f32x4*)b)[F.lane + 64 * j]; v[j] = v[j] * rstd * gg + bb; ((GAS f32x4*)row)[F.lane + 64 * j] = v[j]; }
        if (want_xn) { const int vv = row_v(m); mod_store_bf16(v, modv(F, ml, vv, si), modv(F, ml, vv, si + 1), XN + (size_t)m * D, F.lane); }
    }
}

using pg8::f32x4; using pg8::Unit;
struct EpiStoreBf16 {
    static constexpr bool PERM = true, AFTER_DRAIN = false;
    GAS bf16* O; int ldc; float sc;
    __device__ __forceinline__ void operator()(const pg8::f32x4 (&acc)[2][2][4][2], const Unit& u, int wr, int wc, int fr, int fq) const {
        const int row0 = u.pm * 256 + wr * 64 + fr, col0 = u.pn * 256 + wc * 32 + 8 * fq;
#pragma unroll
        for (int ai = 0; ai < 2; ++ai)
#pragma unroll
            for (int m = 0; m < 4; ++m) { GAS bf16* rowp = O + (size_t)(row0 + ai * 128 + m * 16) * ldc + col0;
#pragma unroll
                for (int bj = 0; bj < 2; ++bj) { const pg8::f32x4 v0 = acc[ai][bj][m][0] * sc, v1 = acc[ai][bj][m][1] * sc;
                    v4u w; w.x = pk2(v0[0], v0[1]); w.y = pk2(v0[2], v0[3]); w.z = pk2(v1[0], v1[1]); w.w = pk2(v1[2], v1[3]);
                    *(GAS v4u*)(rowp + bj * 128) = w; } }
    }
};
struct EpiSwiglu {
    static constexpr bool PERM = true, AFTER_DRAIN = false;
    GAS bf16* G; int ldg; float sc;
    __device__ __forceinline__ void operator()(const pg8::f32x4 (&acc)[2][2][4][2], const Unit& u, int wr, int wc, int fr, int fq) const {
        const int row0 = u.pm * 256 + wr * 64 + fr, col0 = (u.pn * 256 + wc * 32 + 8 * fq) >> 1;
#pragma unroll
        for (int ai = 0; ai < 2; ++ai)
#pragma unroll
            for (int m = 0; m < 4; ++m) { GAS bf16* rowp = G + (size_t)(row0 + ai * 128 + m * 16) * ldg + col0;
#pragma unroll
                for (int bj = 0; bj < 2; ++bj) { const pg8::f32x4 a = acc[ai][bj][m][0] * sc, b = acc[ai][bj][m][1] * sc;
                    v2u w; w.x = pk2(siluf(a[0]) * b[0], siluf(a[1]) * b[1]); w.y = pk2(siluf(a[2]) * b[2], siluf(a[3]) * b[3]);
                    *(GAS v2u*)(rowp + bj * 64) = w; } }
    }
};
struct EpiSwiglu8 {
    static constexpr bool PERM = true, AFTER_DRAIN = false;
    GAS unsigned char* G; int ldg; float sc, osc;
    __device__ __forceinline__ void operator()(const pg8::f32x4 (&acc)[2][2][4][2], const Unit& u, int wr, int wc, int fr, int fq) const {
        const int row0 = u.pm * 256 + wr * 64 + fr, col0 = (u.pn * 256 + wc * 32 + 8 * fq) >> 1;
#pragma unroll
        for (int ai = 0; ai < 2; ++ai)
#pragma unroll
            for (int m = 0; m < 4; ++m) { GAS unsigned char* rowp = G + (size_t)(row0 + ai * 128 + m * 16) * ldg + col0;
#pragma unroll
                for (int bj = 0; bj < 2; ++bj) { const pg8::f32x4 a = acc[ai][bj][m][0] * sc, b = acc[ai][bj][m][1] * sc;
                    *(GAS unsigned*)(rowp + bj * 64) = pk4_fp8(siluf(a[0]) * b[0] * osc, siluf(a[1]) * b[1] * osc, siluf(a[2]) * b[2] * osc, siluf(a[3]) * b[3] * osc); } }
    }
};
struct EpiRes {
    static constexpr bool PERM = false, AFTER_DRAIN = false;
    const GAS float* xin_lat; const GAS float* xin_ctx; GAS float* out_lat; GAS float* out_ctx; const GAS float* gate0;
    __device__ __forceinline__ void operator()(const pg8::f32x4 (&acc)[2][2][4][2], const Unit& u, int wr, int wc, int fr, int fq) const {
        const bool lat = u.pm < TL / 256; const int v = lat ? (u.pm >> 6) : 2;
        const GAS float* xin = lat ? xin_lat : xin_ctx - (size_t)TL * D; GAS float* out = lat ? out_lat : out_ctx - (size_t)TL * D;
        const GAS float* gate = gate0 + (size_t)v * 6 * D;
        const int row0 = u.pm * 256 + wr * 64 + fr, col0 = u.pn * 256 + wc * 32 + 4 * fq;
        pg8::f32x4 gv[2][2];
#pragma unroll
        for (int bj = 0; bj < 2; ++bj)
#pragma unroll
            for (int n = 0; n < 2; ++n) gv[bj][n] = *(const GAS pg8::f32x4*)(gate + col0 + bj * 128 + n * 16);
#pragma unroll
        for (int ai = 0; ai < 2; ++ai)
#pragma unroll
            for (int m = 0; m < 4; ++m) { const size_t off = (size_t)(row0 + ai * 128 + m * 16) * D + col0;
#pragma unroll
                for (int bj = 0; bj < 2; ++bj)
#pragma unroll
                    for (int n = 0; n < 2; ++n) { const pg8::f32x4 xv = *(const GAS pg8::f32x4*)(xin + off + bj * 128 + n * 16);
                        *(GAS pg8::f32x4*)(out + off + bj * 128 + n * 16) = xv * ALPHA + gv[bj][n] * acc[ai][bj][m][n]; } }
    }
};


constexpr int CW_MOECNT = 2048;
constexpr size_t WS_TI = WS_SMALL + 64 * 1024;
constexpr int MOE_CHUNK_TILES = 64, MOE_NCHUNK = 5, MOE_MAXROWS = MOE_NCHUNK * MOE_CHUNK_TILES * 256;
constexpr size_t WS_HS = AB + 65 * MiB, WS_WM13 = AB + 197 * MiB, WS_WM2 = AB + 309 * MiB, WS_GC = AB + 365 * MiB;
constexpr size_t WS_H8 = WS_XN, WS_HS8 = WS_HS + 66 * MiB;
constexpr float MOE_WSCALE = 64.f, MOE_GSCALE = 16.f, MOE_W2SCALE = 256.f;
static_assert(WS_HS + (size_t)(2 * TL + NEXP * 256) * D * 2 <= WS_WM13 && WS_WM13 + (size_t)NEXP * 2 * EFF * D * 2 <= WS_WM2 && WS_WM2 + (size_t)NEXP * D * EFF * 2 <= WS_GC && WS_GC + (size_t)MOE_CHUNK_TILES * 256 * EFF * 2 <= WS_XC, "MoE map");

__device__ __forceinline__ void p_ln_route(const Frame& F0, const GAS float* g, const GAS float* b, int l) { const Frame F = launder(F0);
    GAS bf16* XN = (GAS bf16*)(F.ws + WS_XN);
    GAS int* TI_E = (GAS int*)(F.ws + WS_TI); GAS int* TI_P0 = TI_E + TL; GAS int* TI_P1 = TI_P0 + TL; GAS float* TI_W0 = (GAS float*)(TI_P1 + TL); GAS float* TI_W1 = TI_W0 + TL;
    const GAS float* wr = F.in[I_ROUTER];
    f32x4 nx[4];
    int m = F.gw; if (m < TL) {
#pragma unroll
        for (int j = 0; j < 4; ++j) nx[j] = ((const GAS f32x4*)(F.out + (size_t)m * D))[F.lane + 64 * j]; }
    for (; m < TL; m += F.ngw) {
        GAS float* row = F.out + (size_t)m * D;
        f32x4 v[4]; float s = 0.f;
#pragma unroll
        for (int j = 0; j < 4; ++j) { v[j] = nx[j]; s += (v[j].x + v[j].y) + (v[j].z + v[j].w); }
        if (m + F.ngw < TL) {
#pragma unroll
            for (int j = 0; j < 4; ++j) nx[j] = ((const GAS f32x4*)(F.out + (size_t)(m + F.ngw) * D))[F.lane + 64 * j]; }
        const float mean = wave_sum(s) * (1.f / D); float s2 = 0.f;
#pragma unroll
        for (int j = 0; j < 4; ++j) { v[j] = v[j] - mean; s2 += (v[j].x * v[j].x + v[j].y * v[j].y) + (v[j].z * v[j].z + v[j].w * v[j].w); }
        const float rstd = 1.f / sqrtf(wave_sum(s2) * (1.f / D) + LN_EPS);
        const int vv = row_v(m); const GAS float* sh = modv(F, l, vv, 3); const GAS float* sc = modv(F, l, vv, 4);
        GAS unsigned* h8 = (GAS unsigned*)(F.ws + WS_H8 + (size_t)m * D) + F.lane;
        float lg[NEXP];
#pragma unroll
        for (int e = 0; e < NEXP; ++e) lg[e] = 0.f;
#pragma unroll
        for (int j = 0; j < 4; ++j) { const f32x4 gg = ((const GAS f32x4*)g)[F.lane + 64 * j], bb = ((const GAS f32x4*)b)[F.lane + 64 * j]; v[j] = v[j] * rstd * gg + bb; ((GAS f32x4*)row)[F.lane + 64 * j] = v[j];
            const f32x4 a = ((const GAS f32x4*)sc)[F.lane + 64 * j], c = ((const GAS f32x4*)sh)[F.lane + 64 * j];
            const f32x4 y = v[j] * (a + 1.f) + c;
            h8[64 * j] = pk4_fp8(y.x, y.y, y.z, y.w);
            const GAS f32x4* w4 = (const GAS f32x4*)(wr + (size_t)(4 * F.lane + 256 * j) * NEXP);
#pragma unroll
            for (int i = 0; i < 4; ++i) { const f32x4 wa = w4[2 * i], wb = w4[2 * i + 1]; const float yi = y[i];
                lg[0] += yi * wa.x; lg[1] += yi * wa.y; lg[2] += yi * wa.z; lg[3] += yi * wa.w; lg[4] += yi * wb.x; lg[5] += yi * wb.y; lg[6] += yi * wb.z; lg[7] += yi * wb.w; } }
#pragma unroll
        for (int e = 0; e < NEXP; ++e) lg[e] = wave_sum(lg[e]);
        int i0 = 0; float v0 = lg[0];
#pragma unroll
        for (int e = 1; e < NEXP; ++e) if (lg[e] > v0) { v0 = lg[e]; i0 = e; }
        int i1 = -1; float v1 = -3.0e38f;
#pragma unroll
        for (int e = 0; e < NEXP; ++e) if (e != i0 && lg[e] > v1) { v1 = lg[e]; i1 = e; }
        if (F.lane == 0) {
            const float w0 = 1.f / (1.f + __expf(v1 - v0));
            const int p0 = (int)__hip_atomic_fetch_add((GAS unsigned*)F.ctl + CW_MOECNT + 64 * i0, 1u, RLX_AGENT);
            const int p1 = (int)__hip_atomic_fetch_add((GAS unsigned*)F.ctl + CW_MOECNT + 64 * i1, 1u, RLX_AGENT);
            TI_E[m] = i0 | (i1 << 8); TI_P0[m] = p0; TI_P1[m] = p1; TI_W0[m] = w0; TI_W1[m] = 1.f - w0;
        }
    }
}
struct MoeBase { int bt[NEXP + 1]; };
__device__ __forceinline__ MoeBase moe_base(const Frame& F) {
    MoeBase B; int acc = 0;
#pragma unroll
    for (int e = 0; e < NEXP; ++e) { B.bt[e] = acc; const unsigned c = __hip_atomic_load((GAS unsigned*)F.ctl + CW_MOECNT + 64 * e, RLX_AGENT); acc += (int)((c + 255u) >> 8); }
    B.bt[NEXP] = acc; return B;
}
__device__ __forceinline__ void p_moe_weights(const Frame& F0) { const Frame F = launder(F0);
    LAS float* scr = (LAS float*)(F.lds + F.wave * 16384);
    GAS unsigned char* WM13 = F.ws + WS_WM13; GAS unsigned char* WM2 = F.ws + WS_WM2;
    constexpr int I1 = (D / 64) * (EFF / 32), I2 = (EFF / 64) * (D / 32), NITEM = NEXP * (2 * I1 + I2);
    for (int it = F.gw; it < NITEM; it += F.ngw) {
        const int e = it / (2 * I1 + I2); int r = it % (2 * I1 + I2);
        if (r < I1) { transpose_item_f8(F.in[I_MW1] + (size_t)e * D * EFF, EFF, WM13 + (size_t)e * 2 * EFF * D, D, scr, r, F.lane, RmGlu{0}, MOE_WSCALE); continue; } r -= I1;
        if (r < I1) { transpose_item_f8(F.in[I_MW3] + (size_t)e * D * EFF, EFF, WM13 + (size_t)e * 2 * EFF * D, D, scr, r, F.lane, RmGlu{1}, MOE_WSCALE); continue; } r -= I1;
        transpose_item_f8(F.in[I_MW2] + (size_t)e * EFF * D, D, WM2 + (size_t)e * D * EFF, EFF, scr, r, F.lane, RmIdent{0}, MOE_W2SCALE);
    }
}
__device__ __forceinline__ void p_moe_scatter(const Frame& F0) { const Frame F = launder(F0);
    const MoeBase B = moe_base(F);
    const GAS unsigned char* H8 = F.ws + WS_H8; GAS unsigned char* HS8 = F.ws + WS_HS8;
    GAS int* TI_E = (GAS int*)(F.ws + WS_TI); GAS int* TI_P0 = TI_E + TL; GAS int* TI_P1 = TI_P0 + TL;
    for (int m = F.gw; m < TL; m += F.ngw) {
        const int ee = TI_E[m], e0 = ee & 255, e1 = ee >> 8;
        int b0 = 0, b1 = 0;
#pragma unroll
        for (int e = 0; e < NEXP; ++e) { if (e == e0) b0 = B.bt[e]; if (e == e1) b1 = B.bt[e]; }
        const int s0 = b0 * 256 + TI_P0[m], s1 = b1 * 256 + TI_P1[m];
        const v4u a = *((const GAS v4u*)(H8 + (size_t)m * D) + F.lane);
        *((GAS v4u*)(HS8 + (size_t)s0 * D) + F.lane) = a; *((GAS v4u*)(HS8 + (size_t)s1 * D) + F.lane) = a;
        if (F.lane == 0) { TI_P0[m] = s0; TI_P1[m] = s1; }
    }
}
constexpr int LDS_MOEBT = LDS_MISC + 64;
__device__ __forceinline__ void moe_base_to_lds(const Frame& F) {
    if (F.tid == 0) { volatile LAS int* bt = (volatile LAS int*)(F.lds + LDS_MOEBT); int acc = 0;
        for (int e = 0; e < NEXP; ++e) { bt[e] = acc; const unsigned c = __hip_atomic_load((GAS unsigned*)F.ctl + CW_MOECNT + 64 * e, RLX_AGENT); acc += (int)((c + 255u) >> 8); }
        bt[NEXP] = acc; }
    __syncthreads();
}
struct MoeOrder {
    int nM, nN, nwg, G, c, tile0; const LAS int* bt;
    __device__ void init(const LAS int* bt_, int chunk, int nN_, int G_, int c_) {
        bt = bt_; tile0 = chunk * MOE_CHUNK_TILES; int v = bt[NEXP] - tile0; nM = v < 0 ? 0 : (v > MOE_CHUNK_TILES ? MOE_CHUNK_TILES : v); nN = nN_; nwg = nM * nN; G = G_; c = c_; }
    __device__ bool next(int i, pg8::Unit& u) const {
        const long L = (long)i * G + c; if (L >= nwg) return false;
        int wgid = (int)L; { const int q = nwg / pg8::NXCD, r = nwg % pg8::NXCD, xcd = wgid % pg8::NXCD, off = wgid / pg8::NXCD; wgid = (xcd < r ? xcd * (q + 1) : r * (q + 1) + (xcd - r) * q) + off; }
        const int nig = pg8::WGM * nN, gid = wgid / nig, fm = gid * pg8::WGM, gsz = (nM - fm) < pg8::WGM ? (nM - fm) : pg8::WGM;
        u.pm = fm + ((wgid % nig) % gsz); u.pn = (wgid % nig) / gsz;
        const int gt = tile0 + u.pm; int e = 0;
#pragma unroll
        for (int k = 1; k < NEXP; ++k) e += (gt >= bt[k]) ? 1 : 0;
        u.be = __builtin_amdgcn_readfirstlane(e); return true;
    }
    __device__ __forceinline__ void a_ready(const pg8::Unit&) const {}
    __device__ __forceinline__ void done(const pg8::Unit&) const {}
};
__device__ __forceinline__ void p_ln_combine(const Frame& F0, const GAS float* g, const GAS float* b, int l) { const Frame F = launder(F0);
    const GAS bf16* YS = (const GAS bf16*)(F.ws + WS_HS);
    GAS int* TI_E = (GAS int*)(F.ws + WS_TI); GAS int* TI_P0 = TI_E + TL; GAS int* TI_P1 = TI_P0 + TL; GAS float* TI_W0 = (GAS float*)(TI_P1 + TL); GAS float* TI_W1 = TI_W0 + TL;
    typedef unsigned long long u64_;
    int s0n = 0, s1n = 0; float w0n = 0.f, w1n = 0.f;
    f32x4 nx[4]; u64_ na[4], nc[4]; float w0c = 0.f, w1c = 0.f;
#define CMB_IDX(mm) do { s0n = TI_P0[mm]; s1n = TI_P1[mm]; w0n = TI_W0[mm]; w1n = TI_W1[mm]; } while (0)
#define CMB_DATA(mm) do { const GAS float* r_ = F.out + (size_t)(mm) * D; const GAS u64_* y0_ = (const GAS u64_*)(YS + (size_t)s0n * D) + F.lane; const GAS u64_* y1_ = (const GAS u64_*)(YS + (size_t)s1n * D) + F.lane; \
        _Pragma("unroll") for (int j = 0; j < 4; ++j) { nx[j] = ((const GAS f32x4*)r_)[F.lane + 64 * j]; na[j] = y0_[64 * j]; nc[j] = y1_[64 * j]; } w0c = w0n; w1c = w1n; } while (0)
    int m = F.gw;
    if (m < TL) { CMB_IDX(m); CMB_DATA(m); if (m + F.ngw < TL) CMB_IDX(m + F.ngw); }
    for (; m < TL; m += F.ngw) {
        GAS float* row = F.out + (size_t)m * D;
        const float w0 = w0c, w1 = w1c;
        const GAS float* gate = modv(F, l, row_v(m), 5);
        f32x4 xv[4]; u64_ av[4], cv[4];
#pragma unroll
        for (int j = 0; j < 4; ++j) { xv[j] = nx[j]; av[j] = na[j]; cv[j] = nc[j]; }
        if (m + F.ngw < TL) { CMB_DATA(m + F.ngw); if (m + 2 * F.ngw < TL) CMB_IDX(m + 2 * F.ngw); }
        f32x4 v[4]; float s = 0.f;
#pragma unroll
        for (int j = 0; j < 4; ++j) { const f32x4 x = xv[j], gt = ((const GAS f32x4*)gate)[F.lane + 64 * j];
            const u64_ a = av[j], c = cv[j];
            f32x4 f;
            f.x = w0 * bf2f((unsigned short)a) + w1 * bf2f((unsigned short)c); f.y = w0 * bf2f((unsigned short)(a >> 16)) + w1 * bf2f((unsigned short)(c >> 16));
            f.z = w0 * bf2f((unsigned short)(a >> 32)) + w1 * bf2f((unsigned short)(c >> 32)); f.w = w0 * bf2f((unsigned short)(a >> 48)) + w1 * bf2f((unsigned short)(c >> 48));
            v[j] = x * ALPHA + gt * f; s += (v[j].x + v[j].y) + (v[j].z + v[j].w); }
        const float mean = wave_sum(s) * (1.f / D); float s2 = 0.f;
#pragma unroll
        for (int j = 0; j < 4; ++j) { v[j] = v[j] - mean; s2 += (v[j].x * v[j].x + v[j].y * v[j].y) + (v[j].z * v[j].z + v[j].w * v[j].w); }
        const float rstd = 1.f / sqrtf(wave_sum(s2) * (1.f / D) + LN_EPS);
#pragma unroll
        for (int j = 0; j < 4; ++j) { const f32x4 gg = ((const GAS f32x4*)g)[F.lane + 64 * j], bb = ((const GAS f32x4*)b)[F.lane + 64 * j]; ((GAS f32x4*)row)[F.lane + 64 * j] = v[j] * rstd * gg + bb; }
    }
#undef CMB_IDX
#undef CMB_DATA
}

namespace att {
using bf16x8 = __attribute__((ext_vector_type(8))) short;
using s16x4  = __attribute__((ext_vector_type(4))) short;
using f32x16 = __attribute__((ext_vector_type(16))) float;
using u32x4  = __attribute__((ext_vector_type(4))) unsigned;
constexpr int DQ = 96, DV = 64, NW = 8, QBLK = 32, KVBLK = 64, NKEY = 16640;
constexpr float THR2 = 8.0f;
constexpr int SHM_K = KVBLK * 144, SHM_V = DV * 80;
typedef int i32x8 __attribute__((ext_vector_type(8)));
constexpr int NSLOT = 8;
constexpr int LDS_V = 0, LDS_K = NSLOT * SHM_V, LDS_WS = LDS_K + NSLOT * SHM_K, LDS_Q = LDS_WS + NW * 64 * 4, ATT_LDS = LDS_Q + NW * 4096;
#define KSWZ(row, colB) ((row) * 256 + ((colB) ^ (((row) & 7) << 4)))
#define SBAR() __builtin_amdgcn_sched_barrier(0)
__device__ __forceinline__ int crow(int r, int hi) { return (r & 3) + 8 * (r >> 2) + 4 * hi; }
__device__ __forceinline__ unsigned cvtpk(float lo, float hi) { unsigned r; asm volatile("v_cvt_pk_bf16_f32 %0, %1, %2" : "=v"(r) : "v"(lo), "v"(hi)); return r; }
template <bool FIRST>
__device__ __forceinline__ bool partialSM(f32x16& p0, f32x16& p1, f32x16& negm, float& alpha) {
  float a = fmaxf(fmaxf(p0[0], p0[1]), p1[0]), b = fmaxf(fmaxf(p0[2], p0[3]), p1[1]); a = fmaxf(fmaxf(a, p1[2]), p1[3]);
#pragma unroll
  for (int r = 4; r < 16; r += 4) { a = fmaxf(fmaxf(a, p0[r]), p0[r + 1]); b = fmaxf(fmaxf(b, p0[r + 2]), p0[r + 3]); a = fmaxf(fmaxf(a, p1[r]), p1[r + 1]); b = fmaxf(fmaxf(b, p1[r + 2]), p1[r + 3]); }
  float pmax = fmaxf(a, b);
  { auto rr = __builtin_amdgcn_permlane32_swap(__float_as_uint(pmax), __float_as_uint(pmax), false, false);
    pmax = fmaxf(__uint_as_float(rr[0]), __uint_as_float(rr[1])); }
  bool resc = false;
  if (FIRST || __builtin_expect(__any(pmax > THR2), 0)) {
    const float dl = FIRST ? pmax : fmaxf(pmax, 0.f);
#pragma unroll
    for (int r = 0; r < 16; ++r) { p0[r] -= dl; p1[r] -= dl; negm[r] -= dl; }
    alpha = __builtin_amdgcn_exp2f(-dl); resc = !FIRST;
  }
  return resc;
}
__device__ __forceinline__ void finishSM(f32x16& p0, f32x16& p1, i32x8& pb) {
#pragma unroll
  for (int r = 0; r < 16; ++r) p0[r] = __builtin_amdgcn_exp2f(p0[r]);
#pragma unroll
  for (int r = 0; r < 16; ++r) p1[r] = __builtin_amdgcn_exp2f(p1[r]);
#pragma unroll
  for (int w = 0; w < 4; ++w) {
    int x = __builtin_amdgcn_cvt_pk_fp8_f32(p0[4 * w], p0[4 * w + 1], __float_as_int(p0[4 * w]), false); x = __builtin_amdgcn_cvt_pk_fp8_f32(p0[4 * w + 2], p0[4 * w + 3], x, true); pb[w] = x;
    int y = __builtin_amdgcn_cvt_pk_fp8_f32(p1[4 * w], p1[4 * w + 1], __float_as_int(p1[4 * w]), false); y = __builtin_amdgcn_cvt_pk_fp8_f32(p1[4 * w + 2], p1[4 * w + 3], y, true); pb[4 + w] = y; }
}
__device__ __forceinline__ i32x8 ld32(const LAS char* p) { const u32x4 a = *reinterpret_cast<const LAS u32x4*>(p), b = *reinterpret_cast<const LAS u32x4*>(p + 16);
  return (i32x8){(int)a[0], (int)a[1], (int)a[2], (int)a[3], (int)b[0], (int)b[1], (int)b[2], (int)b[3]}; }
struct KFrag { i32x8 k00, k01, k10, k11; };
__device__ __forceinline__ void qkt_load(KFrag& k, const LAS char* Ks, int r32, int hi) {
  const LAS char* kp = Ks + r32 * 144 + hi * 32;
  k.k00 = ld32(kp); k.k01 = ld32(kp + 64); k.k10 = ld32(kp + 32 * 144); k.k11 = ld32(kp + 32 * 144 + 64);
}
__device__ __forceinline__ void qkt_mma(f32x16& p0, f32x16& p1, const KFrag& k, const i32x8& q0, const i32x8& q1, const f32x16& negm) {
  asm volatile("s_nop 1\n\tv_mfma_f32_32x32x64_f8f6f4 %0, %1, %2, %3" : "=&v"(p0) : "v"(k.k00), "v"(q0), "v"(negm));
  asm volatile("v_mfma_f32_32x32x64_f8f6f4 %0, %1, %2, %3" : "=&v"(p1) : "v"(k.k10), "v"(q0), "v"(negm));
  asm volatile("v_mfma_f32_32x32x64_f8f6f4 %0, %1, %2, %0" : "+v"(p0) : "v"(k.k01), "v"(q1));
  asm volatile("v_mfma_f32_32x32x64_f8f6f4 %0, %1, %2, %0" : "+v"(p1) : "v"(k.k11), "v"(q1));
}
__device__ __forceinline__ void qkt(f32x16& p0, f32x16& p1, const LAS char* Ks, const i32x8& q0, const i32x8& q1, const f32x16& negm, int r32, int hi) {
  KFrag k; qkt_load(k, Ks, r32, hi); qkt_mma(p0, p1, k, q0, q1, negm);
}
#define QK_DRAIN(P0, P1) asm volatile("s_nop 15\n\ts_nop 7" : "+v"(P0), "+v"(P1))
__device__ __forceinline__ void pv_d0(f32x16* o, const LAS char* Vs, const i32x8& pb, int r32, int hi) {
  const LAS char* vp = Vs + r32 * 80 + hi * 32;
  const u32x4 a0 = *reinterpret_cast<const LAS u32x4*>(vp), a1 = *reinterpret_cast<const LAS u32x4*>(vp + 16);
  const u32x4 b0 = *reinterpret_cast<const LAS u32x4*>(vp + 32 * 80), b1 = *reinterpret_cast<const LAS u32x4*>(vp + 32 * 80 + 16);
  const i32x8 va = {(int)a0[0], (int)a0[1], (int)a0[2], (int)a0[3], (int)a1[0], (int)a1[1], (int)a1[2], (int)a1[3]};
  const i32x8 vb = {(int)b0[0], (int)b0[1], (int)b0[2], (int)b0[3], (int)b1[0], (int)b1[1], (int)b1[2], (int)b1[3]};
  const i32x8 ones = {0x38383838, 0x38383838, 0x38383838, 0x38383838, 0x38383838, 0x38383838, 0x38383838, 0x38383838};
  asm volatile("s_nop 1\n\tv_mfma_f32_32x32x64_f8f6f4 %0, %1, %2, %0" : "+v"(o[0]) : "v"(va), "v"(pb));
  asm volatile("v_mfma_f32_32x32x64_f8f6f4 %0, %1, %2, %0" : "+v"(o[1]) : "v"(vb), "v"(pb));
  asm volatile("v_mfma_f32_32x32x64_f8f6f4 %0, %1, %2, %0" : "+v"(o[2]) : "v"(ones), "v"(pb));
}
#define PV_DRAIN() asm volatile("s_nop 15\n\ts_nop 7" : "+v"(o[0]), "+v"(o[1]), "+v"(o[2]))
#define QK_A(P, KA, QA) asm volatile("s_nop 1\n\tv_mfma_f32_32x32x64_f8f6f4 %0, %1, %2, %3" : "=&v"(P) : "v"(KA), "v"(QA), "v"(negm))
#define QK_B(P, KA, QA) asm volatile("v_mfma_f32_32x32x64_f8f6f4 %0, %1, %2, %3" : "=&v"(P) : "v"(KA), "v"(QA), "v"(negm))
#define QK_C(P, KA, QA) asm volatile("v_mfma_f32_32x32x64_f8f6f4 %0, %1, %2, %0" : "+v"(P) : "v"(KA), "v"(QA))
#define PV_A(O, VA) asm volatile("s_nop 1\n\tv_mfma_f32_32x32x64_f8f6f4 %0, %1, %2, %0" : "+v"(O) : "v"(VA), "v"(pb))
#define PV_B(O, VA) asm volatile("v_mfma_f32_32x32x64_f8f6f4 %0, %1, %2, %0" : "+v"(O) : "v"(VA), "v"(pb))
#define EXPS(P, lo, hi_) do { _Pragma("unroll") for (int r_ = (lo); r_ < (hi_); ++r_) P[r_] = __builtin_amdgcn_exp2f(P[r_]); } while (0)
#define CVT4(P, w_, dst) do { int x_ = __builtin_amdgcn_cvt_pk_fp8_f32(P[4 * (w_)], P[4 * (w_) + 1], __float_as_int(P[4 * (w_)]), false); dst = __builtin_amdgcn_cvt_pk_fp8_f32(P[4 * (w_) + 2], P[4 * (w_) + 3], x_, true); } while (0)
__device__ __forceinline__ float mx3(float a, float b, float c) { float r; asm("v_max3_f32 %0, %1, %2, %3" : "=v"(r) : "v"(a), "v"(b), "v"(c)); return r; }
__device__ __forceinline__ float max16(const f32x16& p, float prev) {
  float a, b;
  asm("v_max3_f32 %0, %2, %3, %4\n\tv_max3_f32 %1, %5, %6, %7\n\tv_max3_f32 %0, %0, %8, %9\n\tv_max3_f32 %1, %1, %10, %11\n\t"
      "v_max3_f32 %0, %0, %12, %13\n\tv_max3_f32 %1, %1, %14, %15\n\tv_max3_f32 %0, %0, %16, %17\n\tv_max3_f32 %0, %0, %1, %18"
      : "=&v"(a), "=&v"(b)
      : "v"(p[0]), "v"(p[1]), "v"(p[2]), "v"(p[3]), "v"(p[4]), "v"(p[5]), "v"(p[6]), "v"(p[7]), "v"(p[8]), "v"(p[9]), "v"(p[10]), "v"(p[11]), "v"(p[12]), "v"(p[13]), "v"(p[14]), "v"(p[15]), "v"(prev));
  return a;
}
__device__ __forceinline__ void attn_unit(const GAS unsigned char* __restrict__ Qb, const GAS unsigned char* __restrict__ Kh, const GAS unsigned char* __restrict__ Vh,
                                          GAS unsigned short* __restrict__ Ob, int ldo, int seq, LAS char* lds, int tid) {
  const int wid = tid >> 6, lane = tid & 63, r32 = lane & 31, hi = lane >> 5;
  LAS char* V_lds = lds + LDS_V; LAS char* K_lds = lds + LDS_K;
  f32x16 o[3] = {}; f32x16 negm = {};
  const GAS unsigned char* Qw = Qb + (long)(wid * QBLK + r32) * 128 + hi * 32;
  i32x8 q0, q1;
  { const u32x4 a = *reinterpret_cast<const GAS u32x4*>(Qw), b = *reinterpret_cast<const GAS u32x4*>(Qw + 16), c = *reinterpret_cast<const GAS u32x4*>(Qw + 64), d = *reinterpret_cast<const GAS u32x4*>(Qw + 80);
    q0 = (i32x8){(int)a[0], (int)a[1], (int)a[2], (int)a[3], (int)b[0], (int)b[1], (int)b[2], (int)b[3]}; q1 = (i32x8){(int)c[0], (int)c[1], (int)c[2], (int)c[3], (int)d[0], (int)d[1], (int)d[2], (int)d[3]}; }
  const int vst = (tid >> 3) * 80 + (tid & 7) * 8;
  const int kst0 = (tid >> 3) * 144 + (tid & 7) * 16;
  const GAS unsigned char* Ku = (const GAS unsigned char*)(((unsigned long long)(unsigned)__builtin_amdgcn_readfirstlane((unsigned)((unsigned long long)Kh >> 32)) << 32) | (unsigned long long)(unsigned)__builtin_amdgcn_readfirstlane((unsigned)(unsigned long long)Kh));
  const GAS unsigned char* Vu = (const GAS unsigned char*)(((unsigned long long)(unsigned)__builtin_amdgcn_readfirstlane((unsigned)((unsigned long long)Vh >> 32)) << 32) | (unsigned long long)(unsigned)__builtin_amdgcn_readfirstlane((unsigned)(unsigned long long)Vh));
  const unsigned ko = (unsigned)tid * 16u, vo = (unsigned)tid * 8u;
  bf16x8 sk; v2u sv;
#define SLOAD(t) do { sk = *reinterpret_cast<const GAS bf16x8*>(Ku + (size_t)(t) * (KVBLK * 128) + ko); sv = *reinterpret_cast<const GAS v2u*>(Vu + (size_t)(t) * 4096 + vo); } while (0)
#define SWRITE(t) do { *(LAS bf16x8*)(K_lds + ((t) & 7) * SHM_K + kst0) = sk; *(LAS v2u*)(V_lds + ((t) & 7) * SHM_V + vst) = sv; } while (0)
#define KS(t) (K_lds + ((t) & 7) * SHM_K)
#define VS(t) (V_lds + ((t) & 7) * SHM_V)
#define RESC(flag, a) do { if (flag) { PV_DRAIN(); _Pragma("unroll") for (int d = 0; d < 3; ++d) _Pragma("unroll") for (int r = 0; r < 16; ++r) o[d][r] *= (a); } } while (0)
#define PSM_TAIL(N0, N1, pm) do { \
    if (__builtin_expect(__any((pm) > THR2), 0)) { float pmax = (pm);     \
      { auto rr = __builtin_amdgcn_permlane32_swap(__float_as_uint(pmax), __float_as_uint(pmax), false, false); pmax = fmaxf(__uint_as_float(rr[0]), __uint_as_float(rr[1])); } \
      const float dl = fmaxf(pmax, 0.f); \
      _Pragma("unroll") for (int r = 0; r < 16; ++r) { N0[r] -= dl; N1[r] -= dl; negm[r] -= dl; } \
      const float al = __builtin_amdgcn_exp2f(-dl); RESC(true, al); } } while (0)
#define HI(j, C0, C1, N0, N1, DO_BAR, DO_QK, DO_KR, DO_SW, DO_SL) do { \
    if (DO_BAR) __syncthreads(); \
    if (DO_SW) SWRITE((j) + 4); \
    if (DO_SL) SLOAD((j) + 5); \
    SBAR(); \
    if (DO_QK) { QK_A(N0, kf.k00, q0); SBAR(); } \
    EXPS(C0, 0, 7); SBAR(); \
    if (DO_QK) { QK_B(N1, kf.k10, q0); SBAR(); } \
    EXPS(C0, 7, 14); SBAR(); \
    if (DO_QK) { QK_C(N0, kf.k01, q1); SBAR(); } \
    EXPS(C0, 14, 16); CVT4(C0, 0, pb[0]); CVT4(C0, 1, pb[1]); CVT4(C0, 2, pb[2]); EXPS(C1, 0, 2); SBAR(); \
    if (DO_QK) { QK_C(N1, kf.k11, q1); SBAR(); } \
    { const LAS char* vp = VS(j) + r32 * 80 + hi * 32; va = ld32(vp); vb = ld32(vp + 32 * 80); } \
    EXPS(C1, 2, 9); SBAR(); \
    EXPS(C1, 9, 16); CVT4(C0, 3, pb[3]); CVT4(C1, 0, pb[4]); CVT4(C1, 1, pb[5]); CVT4(C1, 2, pb[6]); CVT4(C1, 3, pb[7]); SBAR(); \
    PV_A(o[0], va); SBAR(); \
    float pm_ = 0.f; if (DO_QK) { pm_ = max16(N0, N0[15]); SBAR(); } \
    PV_B(o[1], vb); SBAR(); \
    if (DO_KR) { qkt_load(kf, KS((j) + 2), r32, hi); SBAR(); } \
    if (DO_QK) { pm_ = max16(N1, pm_); SBAR(); } \
    PV_B(o[2], ones); SBAR(); \
    if (DO_QK) PSM_TAIL(N0, N1, pm_); \
  } while (0)
  i32x8 ones = {0x38383838, 0x38383838, 0x38383838, 0x38383838, 0x38383838, 0x38383838, 0x38383838, 0x38383838};
  asm volatile("" : "+v"(ones));
  f32x16 pA0, pA1, pB0, pB1; i32x8 pb, va, vb; KFrag kf; const int NT = seq / KVBLK;
  SLOAD(0); SWRITE(0); SLOAD(1); SWRITE(1); SLOAD(2); SWRITE(2); SLOAD(3); SWRITE(3); if (NT > 4) SLOAD(4);
  __syncthreads();
  { float al0; qkt(pA0, pA1, KS(0), q0, q1, negm, r32, hi); QK_DRAIN(pA0, pA1); (void)partialSM<true>(pA0, pA1, negm, al0); }
  qkt_load(kf, KS(1), r32, hi);
  int j = 0;
  for (; j + 6 < NT; j += 2) {
    HI(j, pA0, pA1, pB0, pB1, true, true, true, true, true);
    HI(j + 1, pB0, pB1, pA0, pA1, false, true, true, true, true);
  }
  for (; j < NT; j += 2) {
    HI(j, pA0, pA1, pB0, pB1, true, true, (j + 2 < NT), (j + 4 < NT), (j + 5 < NT));
    HI(j + 1, pB0, pB1, pA0, pA1, false, (j + 2 < NT), (j + 3 < NT), (j + 5 < NT), (j + 6 < NT));
  }
#undef KS
#undef VS
  PV_DRAIN();
  const float rl = __builtin_amdgcn_rcpf(o[2][0]);
  GAS unsigned short* Ow = Ob + (long)(wid * QBLK + r32) * ldo + 4 * hi;
#pragma unroll
  for (int d0 = 0; d0 < 2; ++d0)
#pragma unroll
    for (int g = 0; g < 4; ++g) { unsigned long long w = (unsigned long long)cvtpk(o[d0][4 * g] * rl, o[d0][4 * g + 1] * rl) | ((unsigned long long)cvtpk(o[d0][4 * g + 2] * rl, o[d0][4 * g + 3] * rl) << 32);
      *(GAS unsigned long long*)(Ow + d0 * 32 + g * 8) = w; }
  __syncthreads();
#undef SLOAD
#undef SWRITE
#undef RESC
#undef HI
#undef PSM_TAIL
}
#undef KSWZ
}

constexpr size_t WS_ROPE = WS_SMALL;
constexpr size_t WS_RSQ = WS_SMALL + 704 * 1024, WS_RSKV = WS_RSQ + (size_t)MR * 4;
static_assert(WS_RSKV + (size_t)MR * 4 <= WS_WIN, "small map");
constexpr size_t WS_QC = WS_Q + (size_t)NBATCH * 8 * SEQ * 128;
constexpr float MLA_QS = 4.f, MLA_KS = 0.25f;
static_assert(WS_QC + (size_t)NBATCH * 8 * CTXL * 128 <= WS_K && WS_K + (size_t)NBATCH * 8 * 16640 * 128 <= WS_V, "q8/k8 map");
constexpr float MLA_C2 = 0.10206207261596575f * 1.4426950408889634f;

__device__ __forceinline__ void p0_rope_table(const Frame& F0) { const Frame F = launder(F0);
    GAS float* T = (GAS float*)(F.ws + WS_ROPE);
    for (int i = blockIdx.x * NTHR + F.tid; i < 256 * 8; i += F.G * NTHR) {
        const int pos = i >> 3, e = i & 7;
        double inv = 1.0; for (int k = 0; k < (e >> 1); ++k) inv *= 0.1; if (e & 1) inv *= 0.31622776601683794;
        double rev = (double)pos * inv * 0.15915494309189535; rev -= (double)(long long)rev;
        T[2 * i] = __builtin_amdgcn_cosf((float)rev); T[2 * i + 1] = __builtin_amdgcn_sinf((float)rev);
    }
}
__device__ __forceinline__ void p_prep_mla_rows(const Frame& F0) { const Frame F = launder(F0);
    const GAS bf16* PH = (const GAS bf16*)(F.ws + WS_PH);
    GAS float* RSQ = (GAS float*)(F.ws + WS_RSQ); GAS float* RSKV = (GAS float*)(F.ws + WS_RSKV); const GAS float* T = (const GAS float*)(F.ws + WS_ROPE);
    constexpr int RB = 4;
    for (int m0 = F.gw; m0 < MR; m0 += RB * F.ngw) {
        unsigned long long q4[RB], k4[RB]; float xr[RB];
#pragma unroll
        for (int j = 0; j < RB; ++j) { const int m = m0 + j * F.ngw; q4[j] = 0; k4[j] = 0; xr[j] = 0.f;
            if (m < MR) { const GAS bf16* row = PH + (size_t)m * NPH; q4[j] = *((const GAS unsigned long long*)(row + PH_CQ) + F.lane);
                if (F.lane < 32) { k4[j] = *((const GAS unsigned long long*)(row + PH_CKV) + F.lane); xr[j] = bf2f(row[PH_KR + F.lane]); } } }
#pragma unroll
        for (int j = 0; j < RB; ++j) { const int m = m0 + j * F.ngw; if (m >= MR) break;
        float a0 = bf2f((unsigned short)q4[j]), a1 = bf2f((unsigned short)(q4[j] >> 16)), a2 = bf2f((unsigned short)(q4[j] >> 32)), a3 = bf2f((unsigned short)(q4[j] >> 48));
        const float sq = wave_sum(a0 * a0 + a1 * a1 + a2 * a2 + a3 * a3);
        float skv = 0.f; const float x = xr[j];
        if (F.lane < 32) { a0 = bf2f((unsigned short)k4[j]); a1 = bf2f((unsigned short)(k4[j] >> 16)); a2 = bf2f((unsigned short)(k4[j] >> 32)); a3 = bf2f((unsigned short)(k4[j] >> 48));
            skv = a0 * a0 + a1 * a1 + a2 * a2 + a3 * a3; }
        skv = wave_sum(skv);
        if (F.lane == 0) { RSQ[m] = 1.f / sqrtf(sq * (1.f / 256.f) + RMS_EPS); RSKV[m] = 1.f / sqrtf(skv * (1.f / 128.f) + RMS_EPS); }
        const float xp = __shfl_xor(x, 8);
        int b, pos; float y = x;
        if (m < TL) { b = m >> 14; const int t = m & (SEQ - 1); pos = CTXL + t;
            const int i = F.lane & 31, half = i >> 4, w = i & 15, p = half ? (t & 63) : (t >> 6); const float c = T[(p * 8 + (w & 7)) * 2], s = T[(p * 8 + (w & 7)) * 2 + 1];
            y = (w < 8) ? (x * c - xp * s) : (xp * s + x * c); }
        else { b = (m - TL) >> 8; pos = (m - TL) & 255; }
        {
          const unsigned yb = pk4_fp8(F.lane < 32 ? y * MLA_KS : 0.f, 0.f, 0.f, 0.f) & 0xffu;
          const int q0 = (F.lane & 7) * 4;
          const unsigned dw = (unsigned)__shfl((int)yb, q0) | ((unsigned)__shfl((int)yb, q0 + 1) << 8) | ((unsigned)__shfl((int)yb, q0 + 2) << 16) | ((unsigned)__shfl((int)yb, q0 + 3) << 24);
          const unsigned kv = (F.lane & 8) ? 0u : dw;
          GAS unsigned char* K8 = F.ws + WS_K; GAS unsigned char* Q8 = m < TL ? F.ws + WS_Q : F.ws + WS_QC; const int qrows = m < TL ? SEQ : CTXL, qt = m < TL ? (m & (SEQ - 1)) : pos;
#pragma unroll
          for (int hh = 0; hh < 2; ++hh) { const int h = hh * 4 + (F.lane >> 4); *(GAS unsigned*)(K8 + ((size_t)(b * 8 + h) * att::NKEY + pos) * 128 + 64 + (F.lane & 15) * 4) = kv; }
          { const int h = F.lane >> 3; *(GAS unsigned*)(Q8 + ((size_t)(b * 8 + h) * qrows + qt) * 128 + 96 + (F.lane & 7) * 4) = 0u; } }
        }
    }
}
struct EpiMlaQ {
    static constexpr bool PERM = true, AFTER_DRAIN = false;
    GAS unsigned char* Q; GAS unsigned char* QC; const GAS float* rsq; const GAS float* rope;
    __device__ __forceinline__ void operator()(const pg8::f32x4 (&acc)[2][2][4][2], const Unit& u, int wr, int wc, int fr, int fq) const {
        const bool lat = u.pm < TL / 256;
        const int b = lat ? (u.pm >> 6) : (u.pm - TL / 256), t0 = lat ? (u.pm & 63) * 256 : 0, rows = lat ? SEQ : CTXL;
        GAS unsigned char* base = lat ? Q : QC;
        const unsigned lane_off = (unsigned)((wr * 64 + fr) * 128 + 8 * fq);
        const GAS float* rsp = rsq + u.pm * 256 + wr * 64 + fr;
#pragma unroll
        for (int ai = 0; ai < 2; ++ai)
#pragma unroll
            for (int m = 0; m < 4; ++m) { const float rs = rsp[ai * 128 + m * 16] * (MLA_C2 * MLA_QS);
                const int trow = t0 + ai * 128 + m * 16;
#pragma unroll
                for (int bj = 0; bj < 2; ++bj) { const int g32 = 8 * u.pn + 4 * bj + wc, head = g32 / 3, part = g32 - 3 * head;
                    float x[8];
#pragma unroll
                    for (int i = 0; i < 4; ++i) { x[i] = acc[ai][bj][m][0][i] * rs; x[4 + i] = acc[ai][bj][m][1][i] * rs; }
                    if (part == 2 && lat) {
                        const int p = (fq < 2) ? ((trow >> 6) + wr) : (m * 16 + fr); const GAS f32x4* cs = (const GAS f32x4*)(rope + p * 16);
#pragma unroll
                        for (int i2 = 0; i2 < 4; ++i2) { const f32x4 c4 = cs[i2];
                            const float xa = __shfl_xor(x[2 * i2], 16), xb = __shfl_xor(x[2 * i2 + 1], 16);
                            x[2 * i2] = (fq & 1) ? (xa * c4.y + x[2 * i2] * c4.x) : (x[2 * i2] * c4.x - xa * c4.y);
                            x[2 * i2 + 1] = (fq & 1) ? (xb * c4.w + x[2 * i2 + 1] * c4.z) : (x[2 * i2 + 1] * c4.z - xb * c4.w); }
                    }
                    v2u w; w.x = pk4_fp8(x[0], x[1], x[2], x[3]); w.y = pk4_fp8(x[4], x[5], x[6], x[7]);
                    const size_t soff = (((size_t)(b * 8 + head) * rows + trow) * 128 + part * 32);
                    *(GAS v2u*)(base + soff + lane_off) = w; }
                asm volatile("" ::: "memory"); }
    }
};
struct EpiMlaKV {
    static constexpr bool PERM = true, AFTER_DRAIN = false;
    GAS unsigned char* K; GAS bf16* V; const GAS float* rskv;
    __device__ __forceinline__ void operator()(const pg8::f32x4 (&acc)[2][2][4][2], const Unit& u, int wr, int wc, int fr, int fq) const {
        const bool lat = u.pm < TL / 256;
        const int b = lat ? (u.pm >> 6) : (u.pm - TL / 256), pos0 = lat ? CTXL + (u.pm & 63) * 256 : 0;
        const bool isk = wc < 2;
        const unsigned lane_off = isk ? (unsigned)((wr * 64 + fr) * 128 + 32 * (wc & 1) + 8 * fq) : (unsigned)(((wr * 64 + fr) * 64 + 32 * (wc & 1) + 8 * fq) * 2);
        const GAS float* rsp = rskv + u.pm * 256 + wr * 64 + fr;
#pragma unroll
        for (int ai = 0; ai < 2; ++ai)
#pragma unroll
            for (int m = 0; m < 4; ++m) { const float rs = rsp[ai * 128 + m * 16];
#pragma unroll
                for (int bj = 0; bj < 2; ++bj) { const int head = 2 * u.pn + bj;
                    const size_t rk = (size_t)(b * 8 + head) * att::NKEY + pos0 + ai * 128 + m * 16;
                    if (isk) { const pg8::f32x4 v0 = acc[ai][bj][m][0] * (rs * MLA_KS), v1 = acc[ai][bj][m][1] * (rs * MLA_KS);
                        v2u w; w.x = pk4_fp8(v0[0], v0[1], v0[2], v0[3]); w.y = pk4_fp8(v1[0], v1[1], v1[2], v1[3]);
                        *(GAS v2u*)(K + rk * 128 + lane_off) = w; }
                    else { const pg8::f32x4 v0 = acc[ai][bj][m][0] * rs, v1 = acc[ai][bj][m][1] * rs;
                        v4u w; w.x = pk2(v0[0], v0[1]); w.y = pk2(v0[2], v0[3]); w.z = pk2(v1[0], v1[1]); w.w = pk2(v1[2], v1[3]);
                        *(GAS v4u*)((GAS char*)V + rk * 128 + lane_off) = w; } }
                asm volatile("" ::: "memory"); }
    }
};
constexpr size_t WS_V8T = WS_QC + (size_t)NBATCH * 8 * CTXL * 128;
static_assert(WS_V8T + (size_t)NBATCH * 8 * (att::NKEY / 64) * 4096 <= WS_K, "v8t map");
__device__ __forceinline__ void p_attn_vt_pack(const Frame& F0) { const Frame F = launder(F0);
    LAS unsigned short* VL = (LAS unsigned short*)F.lds; const int tid = F.tid;
    const GAS bf16* V = (const GAS bf16*)(F.ws + WS_V); GAS unsigned char* V8T = F.ws + WS_V8T;
    const int ntile = att::NKEY / 64;
    for (int u = blockIdx.x; u < NBATCH * 8 * ntile; u += F.G) {
        const int bh = u / ntile, t = u % ntile;
        { const int key = tid >> 3, c8 = (tid & 7) * 8; const v4u w = *(const GAS v4u*)(V + ((size_t)bh * att::NKEY + t * 64 + key) * 64 + c8);
          LAS unsigned short* d = VL + key * 66 + c8; d[0] = (unsigned short)w.x; d[1] = (unsigned short)(w.x >> 16); d[2] = (unsigned short)w.y; d[3] = (unsigned short)(w.y >> 16);
          d[4] = (unsigned short)w.z; d[5] = (unsigned short)(w.z >> 16); d[6] = (unsigned short)w.w; d[7] = (unsigned short)(w.w >> 16); }
        __syncthreads();
        { const int v = tid >> 3, s8 = (tid & 7) * 8; float x[8];
#pragma unroll
          for (int e = 0; e < 8; ++e) { const int slot = s8 + e, hi = slot >> 5, j = slot & 31, jj = j & 15, key = (j >> 4) * 32 + (jj & 3) + 8 * (jj >> 2) + 4 * hi; x[e] = bf2f(VL[key * 66 + v]); }
          v2u o; o.x = pk4_fp8(x[0], x[1], x[2], x[3]); o.y = pk4_fp8(x[4], x[5], x[6], x[7]);
          *(GAS v2u*)(V8T + (size_t)u * 4096 + v * 64 + s8) = o; }
        __syncthreads();
    }
}
__device__ __forceinline__ void p_attention(const Frame& F0, bool with_ctx) { const Frame F = launder(F0);
    const GAS unsigned char* Q = F.ws + WS_Q; const GAS unsigned char* QC = F.ws + WS_QC; const GAS unsigned char* K = F.ws + WS_K; const GAS unsigned char* V8T = F.ws + WS_V8T;
    GAS bf16* Y = (GAS bf16*)(F.ws + WS_Y);
    LAS char* lds = (LAS char*)F.lds;
    const int nlat = NBATCH * 8 * (SEQ / 256);
    for (int i = 0;; ++i) {
        const int L = i * F.G + (int)blockIdx.x; if (L >= nlat) break;
        int bh, qb;
        if (F.G == 256) { const int xcd = blockIdx.x & 7, slot = blockIdx.x >> 3; bh = xcd + 8 * (i >> 1); qb = (i & 1) * 32 + slot; }
        else { bh = L / (SEQ / 256); qb = L % (SEQ / 256); }
        const int b = bh >> 3, h = bh & 7;
        att::attn_unit(Q + ((size_t)bh * SEQ + qb * 256) * 128, K + (size_t)bh * att::NKEY * 128, V8T + (size_t)bh * (att::NKEY / 64) * 4096,
                       Y + ((size_t)b * SEQ + qb * 256) * D + 512 + h * 64, D, att::NKEY, lds, F.tid);
    }
    if (with_ctx && (int)blockIdx.x < NBATCH * 8) { const int bh = blockIdx.x, b = bh >> 3, h = bh & 7;
        att::attn_unit(QC + (size_t)bh * CTXL * 128, K + (size_t)bh * att::NKEY * 128, V8T + (size_t)bh * (att::NKEY / 64) * 4096,
                       Y + ((size_t)TL + b * CTXL) * D + 512 + h * 64, D, CTXL, lds, F.tid);
    }
}
__device__ __forceinline__ void p_ynorm_c(const Frame& F0, int nrows, const GAS float* mg) { const Frame F = launder(F0);
    GAS bf16* Y = (GAS bf16*)(F.ws + WS_Y);
    const f32x4 g0 = ((const GAS f32x4*)mg)[2 * F.lane], g1 = ((const GAS f32x4*)mg)[2 * F.lane + 1];
    constexpr int RB = 4;
    for (int m0 = F.gw; m0 < nrows; m0 += RB * F.ngw) {
        v4u w[RB];
#pragma unroll
        for (int j = 0; j < RB; ++j) { const int m = m0 + j * F.ngw; w[j] = (v4u){0u, 0u, 0u, 0u}; if (m < nrows) w[j] = *((const GAS v4u*)(Y + (size_t)m * D + 512) + F.lane); }
#pragma unroll
        for (int j = 0; j < RB; ++j) { const int m = m0 + j * F.ngw; if (m >= nrows) break;
            float x[8]; x[0] = bf2f((unsigned short)w[j].x); x[1] = bf2f((unsigned short)(w[j].x >> 16)); x[2] = bf2f((unsigned short)w[j].y); x[3] = bf2f((unsigned short)(w[j].y >> 16));
            x[4] = bf2f((unsigned short)w[j].z); x[5] = bf2f((unsigned short)(w[j].z >> 16)); x[6] = bf2f((unsigned short)w[j].w); x[7] = bf2f((unsigned short)(w[j].w >> 16));
            float s = 0.f;
#pragma unroll
            for (int i = 0; i < 8; ++i) s += x[i] * x[i];
            const float rs = 1.f / sqrtf(wave_sum(s) * (1.f / 512.f) + RMS_EPS);
            v4u o; o.x = pk2(x[0] * rs * g0.x, x[1] * rs * g0.y); o.y = pk2(x[2] * rs * g0.z, x[3] * rs * g0.w); o.z = pk2(x[4] * rs * g1.x, x[5] * rs * g1.y); o.w = pk2(x[6] * rs * g1.z, x[7] * rs * g1.w);
            *((GAS v4u*)(Y + (size_t)m * D + 512) + F.lane) = o; }
    }
}

constexpr int GLA_NCH = 4 + SEQ / 64;
constexpr size_t WS_SLOC = WS_XN, WS_GDEC = AB + 521 * MiB;
static_assert(WS_SLOC + (size_t)NBATCH * 4 * 2 * GLA_NCH * 2048 * 4 <= WS_XN + 33 * MiB && (size_t)NBATCH * 4 * 2 * GLA_NCH * 32 * 4 <= 5 * MiB && GLA_NCH % 20 == 0, "gla map");
constexpr int GB_LA = 0, GB_K = GB_LA + 16384, GB_Q = GB_K + 8192, GB_ALR = GB_Q + 8192, GB_WG = GB_ALR + 8192, GB_BG = GB_WG + 4096, GB_O = GB_BG + 256,
              GB_QF = GB_O + 64 * 65 * 4, GB_QB = GB_QF + 5120, GB_KF = GB_QB + 5120, GB_KB = GB_KF + 5120, GB_KTF = GB_KB + 5120, GB_KTB = GB_KTF + 4608, GB_VT = GB_KTB + 4608,
              GB_ATT = GB_VT + 9216, GB_STF = GB_ATT + 9216, GB_STB = GB_STF + 5120, GB_END = GB_STB + 5120;
static_assert(GB_END <= 131072 && GB_QF % 16 == 0, "gla lds");
typedef short gbf16x8 __attribute__((ext_vector_type(8)));
typedef float gf32x16 __attribute__((ext_vector_type(16)));
__device__ __forceinline__ float logsigmoidf(float z) { return fminf(z, 0.f) - __logf(1.f + __expf(-fabsf(z))); }
__device__ __forceinline__ unsigned short bf1(float x) { return (unsigned short)(pk2(x, x) & 0xffffu); }
__device__ __forceinline__ void ld8bf(const GAS bf16* p, LAS float* d) { const v4u w = *(const GAS v4u*)p;
    d[0] = bf2f((unsigned short)w.x); d[1] = bf2f((unsigned short)(w.x >> 16)); d[2] = bf2f((unsigned short)w.y); d[3] = bf2f((unsigned short)(w.y >> 16));
    d[4] = bf2f((unsigned short)w.z); d[5] = bf2f((unsigned short)(w.z >> 16)); d[6] = bf2f((unsigned short)w.w); d[7] = bf2f((unsigned short)(w.w >> 16)); }
__device__ __forceinline__ int gcrow(int r, int hi) { return (r & 3) + 8 * (r >> 2) + 4 * hi; }
template <int KD>
__device__ __forceinline__ void gmm(gf32x16& acc, const LAS unsigned char* A, int sa, int m0, const LAS unsigned char* BT, int sb, int n0, int r32, int hi) {
#pragma unroll
    for (int kt = 0; kt < KD / 16; ++kt) { const gbf16x8 a = *(const LAS gbf16x8*)(A + (m0 + r32) * sa + (kt * 16 + hi * 8) * 2), b = *(const LAS gbf16x8*)(BT + (n0 + r32) * sb + (kt * 16 + hi * 8) * 2);
        acc = __builtin_amdgcn_mfma_f32_32x32x16_bf16(a, b, acc, 0, 0, 0); }
}
template <int CTRL, int RM> __device__ __forceinline__ float gdpp(float v) { return __int_as_float(__builtin_amdgcn_update_dpp(0, __float_as_int(v), CTRL, RM, 0xf, false)); }
struct GlaRegs { v4u kq, al, vv; float w0, w1, bg; };
__device__ __forceinline__ int gla_row0(int b, int jj) { return jj < 4 ? TL + b * CTXL + jj * 64 : b * SEQ + (jj - 4) * 64; }
__device__ __forceinline__ void st8bf(const v4u w, LAS float* d) {
    d[0] = bf2f((unsigned short)w.x); d[1] = bf2f((unsigned short)(w.x >> 16)); d[2] = bf2f((unsigned short)w.y); d[3] = bf2f((unsigned short)(w.y >> 16));
    d[4] = bf2f((unsigned short)w.z); d[5] = bf2f((unsigned short)(w.z >> 16)); d[6] = bf2f((unsigned short)w.w); d[7] = bf2f((unsigned short)(w.w >> 16)); }
__device__ __forceinline__ void gla_issue(const Frame& F, int l, int b, int h, int jj, bool want_q, GlaRegs& R) {
    const int tid = F.tid;
    const GAS bf16* PH = (const GAS bf16*)(F.ws + WS_PH) + (size_t)gla_row0(b, jj) * NPH;
    { const int t = (tid & 255) >> 2, c = (tid & 3) * 8;
      if (tid < 256) { R.kq = *(const GAS v4u*)(PH + (size_t)t * NPH + PH_KA + h * 32 + c); R.al = *(const GAS v4u*)(PH + (size_t)t * NPH + PH_ALR + c); }
      else if (want_q) R.kq = *(const GAS v4u*)(PH + (size_t)t * NPH + PH_QA + h * 32 + c); }
    { const int t = tid >> 3, c = (tid & 7) * 8; R.vv = *(const GAS v4u*)(PH + (size_t)t * NPH + PH_VA + h * 64 + c); }
    { const GAS float* wg = F.in[I_GWG] + (size_t)l * 2 * 16 * 128;
      { const int i = tid, d = i >> 9, r = (i >> 5) & 15, k = i & 31; R.w0 = wg[(d * 16 + r) * 128 + h * 32 + k]; }
      { const int i = tid + 512, d = i >> 9, r = (i >> 5) & 15, k = i & 31; R.w1 = wg[(d * 16 + r) * 128 + h * 32 + k]; }
      if (tid < 64) R.bg = F.in[I_GBG][l * 256 + (tid >> 5) * 128 + h * 32 + (tid & 31)]; }
}
__device__ __forceinline__ void gla_head(const Frame& F, bool want_q, const GlaRegs& R) {
    LAS unsigned char* LB = F.lds; LAS float* LA = (LAS float*)(LB + GB_LA); LAS float* KK = (LAS float*)(LB + GB_K); LAS float* QQ = (LAS float*)(LB + GB_Q); LAS float* ALR = (LAS float*)(LB + GB_ALR);
    LAS float* WG = (LAS float*)(LB + GB_WG); LAS float* BG = (LAS float*)(LB + GB_BG); LAS unsigned short* VT = (LAS unsigned short*)(LB + GB_VT);
    const int tid = F.tid;
    { const int t = (tid & 255) >> 2, c = (tid & 3) * 8;
      if (tid < 256) { st8bf(R.kq, KK + t * 32 + c); st8bf(R.al, ALR + t * 32 + c); }
      else if (want_q) st8bf(R.kq, QQ + t * 32 + c); }
    { const int t = tid >> 3, c = (tid & 7) * 8; const v4u w = R.vv;
      VT[(c + 0) * 72 + t] = (unsigned short)w.x; VT[(c + 1) * 72 + t] = (unsigned short)(w.x >> 16); VT[(c + 2) * 72 + t] = (unsigned short)w.y; VT[(c + 3) * 72 + t] = (unsigned short)(w.y >> 16);
      VT[(c + 4) * 72 + t] = (unsigned short)w.z; VT[(c + 5) * 72 + t] = (unsigned short)(w.z >> 16); VT[(c + 6) * 72 + t] = (unsigned short)w.w; VT[(c + 7) * 72 + t] = (unsigned short)(w.w >> 16); }
    { WG[tid] = R.w0; WG[tid + 512] = R.w1; if (tid < 64) BG[tid] = R.bg; }
    __syncthreads();
    { const int k = tid & 31, t0 = tid >> 5;
#pragma unroll
      for (int d = 0; d < 2; ++d)
#pragma unroll
        for (int tt = 0; tt < 4; ++tt) { const int t = t0 + 16 * tt; float z = BG[d * 32 + k];
#pragma unroll
            for (int r = 0; r < 16; ++r) z += ALR[t * 32 + d * 16 + r] * WG[(d * 16 + r) * 32 + k];
            LA[(d * 64 + t) * 32 + k] = logsigmoidf(z) * (1.f / 16.f); } }
    __syncthreads();
    { const int w = tid >> 6, lane = tid & 63;
#pragma unroll
      for (int c = 0; c < 8; ++c) { const int col = w * 8 + c, d = col >> 5, k = col & 31; float v = LA[(d * 64 + lane) * 32 + k];
          const float x0 = v;
          v += gdpp<0x111, 0xf>(v); v += gdpp<0x112, 0xf>(v); v += gdpp<0x114, 0xf>(v); v += gdpp<0x118, 0xf>(v); v += gdpp<0x142, 0xa>(v); v += gdpp<0x143, 0xc>(v);
          if (d != 0) v = __shfl(v, 63) - v + x0;
          LA[(d * 64 + lane) * 32 + k] = v; } }
    __syncthreads();
}
__device__ __forceinline__ void gla_issue_kqv(const Frame& F, int b, int h, int jj, GlaRegs& R) {
    const int tid = F.tid;
    const GAS bf16* PH = (const GAS bf16*)(F.ws + WS_PH) + (size_t)gla_row0(b, jj) * NPH;
    { const int t = (tid & 255) >> 2, c = (tid & 3) * 8;
      R.kq = *(const GAS v4u*)(PH + (size_t)t * NPH + (tid < 256 ? PH_KA : PH_QA) + h * 32 + c); }
    { const int t = tid >> 3, c = (tid & 7) * 8; R.vv = *(const GAS v4u*)(PH + (size_t)t * NPH + PH_VA + h * 64 + c); }
}
__device__ __forceinline__ void gla_head_kqv(const Frame& F, const GlaRegs& R) {
    LAS unsigned char* LB = F.lds; LAS float* KK = (LAS float*)(LB + GB_K); LAS float* QQ = (LAS float*)(LB + GB_Q); LAS unsigned short* VT = (LAS unsigned short*)(LB + GB_VT);
    const int tid = F.tid;
    { const int t = (tid & 255) >> 2, c = (tid & 3) * 8; st8bf(R.kq, (tid < 256 ? KK : QQ) + t * 32 + c); }
    { const int t = tid >> 3, c = (tid & 7) * 8; const v4u w = R.vv;
      VT[(c + 0) * 72 + t] = (unsigned short)w.x; VT[(c + 1) * 72 + t] = (unsigned short)(w.x >> 16); VT[(c + 2) * 72 + t] = (unsigned short)w.y; VT[(c + 3) * 72 + t] = (unsigned short)(w.y >> 16);
      VT[(c + 4) * 72 + t] = (unsigned short)w.z; VT[(c + 5) * 72 + t] = (unsigned short)(w.z >> 16); VT[(c + 6) * 72 + t] = (unsigned short)w.w; VT[(c + 7) * 72 + t] = (unsigned short)(w.w >> 16); }
}
__device__ __forceinline__ void p_gla_local(const Frame& F0, int l) { const Frame F = launder(F0);
    LAS unsigned char* LB = F.lds; LAS float* LA = (LAS float*)(LB + GB_LA); LAS float* KK = (LAS float*)(LB + GB_K); const int tid = F.tid;
    LAS unsigned short* KTF = (LAS unsigned short*)(LB + GB_KTF); LAS unsigned short* KTB = (LAS unsigned short*)(LB + GB_KTB);
    GAS float* SLOC = (GAS float*)(F.ws + WS_SLOC); GAS float* GDEC = (GAS float*)(F.ws + WS_GDEC);
    const int wv = tid >> 6, lane = tid & 63, r32 = lane & 31, hi = lane >> 5;
    GlaRegs Rn;
    if ((int)blockIdx.x < NBATCH * 4 * GLA_NCH) { const int u = blockIdx.x; gla_issue(F, l, u / (4 * GLA_NCH), (u / GLA_NCH) & 3, u % GLA_NCH, false, Rn); }
    for (int u = blockIdx.x; u < NBATCH * 4 * GLA_NCH; u += F.G) {
        const int b = u / (4 * GLA_NCH), h = (u / GLA_NCH) & 3, jj = u % GLA_NCH;
        const GlaRegs R = Rn;
        { const int un = u + F.G; if (un < NBATCH * 4 * GLA_NCH) gla_issue(F, l, un / (4 * GLA_NCH), (un / GLA_NCH) & 3, un % GLA_NCH, false, Rn); }
        gla_head(F, false, R);
        { const int t = tid >> 3, d = (tid >> 2) & 1, kg = tid & 3;
          GAS f32x4* dst = (GAS f32x4*)((GAS unsigned char*)(F.ws + WS_Y) + (size_t)(gla_row0(b, jj) + t) * (D * 2) + 512 + h * 256 + d * 128 + kg * 32);
          const LAS f32x4* src = (const LAS f32x4*)(LA + (d * 64 + t) * 32 + kg * 8); dst[0] = src[0]; dst[1] = src[1]; }
        for (int i = tid; i < 2048; i += NTHR) { const int t = i >> 5, k = i & 31; const float kv = KK[i];
            KTF[k * 72 + t] = bf1(kv * __expf(LA[63 * 32 + k] - LA[t * 32 + k]));
            KTB[k * 72 + t] = bf1(kv * __expf(LA[64 * 32 + k] - LA[(64 + t) * 32 + k])); }
        __syncthreads();
        if (wv < 4) { const int dir = wv >> 1, nt = wv & 1; gf32x16 acc = {};
            gmm<64>(acc, LB + (dir ? GB_KTB : GB_KTF), 144, 0, LB + GB_VT, 144, nt * 32, r32, hi);
            GAS float* dst = SLOC + ((size_t)((b * 4 + h) * 2 + dir) * GLA_NCH + jj) * 2048 + nt * 32 + r32;
#pragma unroll
            for (int r = 0; r < 16; ++r) dst[gcrow(r, hi) * 64] = acc[r]; }
        if (tid < 64) { const int d = tid >> 5, kk = tid & 31; GDEC[((size_t)((b * 4 + h) * 2 + d) * GLA_NCH + jj) * 32 + kk] = __expf(d ? LA[64 * 32 + kk] : LA[63 * 32 + kk]); }
        __syncthreads();
    }
}
__device__ __forceinline__ void p_gla_scan(const Frame& F0) { const Frame F = launder(F0);
    GAS float* SLOC = (GAS float*)(F.ws + WS_SLOC); const GAS float* GDEC = (const GAS float*)(F.ws + WS_GDEC);
    if (F.tid < 128) for (int it = blockIdx.x; it < 256; it += F.G) {
        const int chain = it >> 4, e = (it & 15) * 128 + F.tid, k = e >> 6, dir = chain & 1;
        GAS float* sl = SLOC + (size_t)chain * GLA_NCH * 2048 + e; const GAS float* dc = GDEC + (size_t)chain * GLA_NCH * 32 + k;
        float S = 0.f;
        for (int j0 = 0; j0 < GLA_NCH; j0 += 20) { float lv[20], dv[20];
#pragma unroll
            for (int q = 0; q < 20; ++q) { const int j = j0 + q, jx = dir == 0 ? j : (j < 4 ? 3 - j : GLA_NCH + 3 - j); lv[q] = sl[(size_t)jx * 2048]; dv[q] = dc[jx * 32]; }
#pragma unroll
            for (int q = 0; q < 20; ++q) { const int j = j0 + q, jx = dir == 0 ? j : (j < 4 ? 3 - j : GLA_NCH + 3 - j); sl[(size_t)jx * 2048] = S; S = dv[q] * S + lv[q]; } }
    }
}
__device__ __forceinline__ void p_gla_out(const Frame& F0, int l, bool with_ctx) { const Frame F = launder(F0);
    LAS unsigned char* LB = F.lds; LAS float* LA = (LAS float*)(LB + GB_LA); LAS float* KK = (LAS float*)(LB + GB_K); LAS float* QQ = (LAS float*)(LB + GB_Q); LAS float* OO = (LAS float*)(LB + GB_O);
    LAS unsigned short* QF = (LAS unsigned short*)(LB + GB_QF); LAS unsigned short* QB = (LAS unsigned short*)(LB + GB_QB); LAS unsigned short* KF = (LAS unsigned short*)(LB + GB_KF); LAS unsigned short* KB = (LAS unsigned short*)(LB + GB_KB);
    LAS unsigned short* ATT = (LAS unsigned short*)(LB + GB_ATT); LAS unsigned short* STF = (LAS unsigned short*)(LB + GB_STF); LAS unsigned short* STB = (LAS unsigned short*)(LB + GB_STB);
    const int tid = F.tid, wv = tid >> 6, lane = tid & 63, r32 = lane & 31, hi = lane >> 5;
    const GAS float* SLOC = (const GAS float*)(F.ws + WS_SLOC); GAS bf16* Y = (GAS bf16*)(F.ws + WS_Y); const GAS bf16* PHB = (const GAS bf16*)(F.ws + WS_PH);
    const GAS float* gng = F.in[I_GNG] + l * 64;
    constexpr int NU = NBATCH * 4 * GLA_NCH;
    GlaRegs Rn; f32x4 san = {}, scn = {}, la0n = {}, la1n = {}; v4u gwn = {};
#define GLA_PF(u_) do { const int b_ = (u_) / (4 * GLA_NCH), h_ = ((u_) / GLA_NCH) & 3, j_ = (u_) % GLA_NCH; gla_issue_kqv(F, b_, h_, j_, Rn); \
        const GAS float* s0_ = SLOC + ((size_t)((b_ * 4 + h_) * 2 + 0) * GLA_NCH + j_) * 2048; const GAS float* s1_ = SLOC + ((size_t)((b_ * 4 + h_) * 2 + 1) * GLA_NCH + j_) * 2048; \
        san = *(const GAS f32x4*)(s0_ + (tid >> 4) * 64 + (tid & 15) * 4); scn = *(const GAS f32x4*)(s1_ + (tid >> 4) * 64 + (tid & 15) * 4); \
        gwn = *(const GAS v4u*)(PHB + (size_t)(gla_row0(b_, j_) + (tid >> 3)) * NPH + PH_GA + h_ * 64 + (tid & 7) * 8); \
        { const GAS f32x4* la_ = (const GAS f32x4*)((const GAS unsigned char*)(F.ws + WS_Y) + (size_t)(gla_row0(b_, j_) + (tid >> 3)) * (D * 2) + 512 + h_ * 256 + ((tid >> 2) & 1) * 128 + (tid & 3) * 32); la0n = la_[0]; la1n = la_[1]; } } while (0)
#define GLA_SKIP(u_) (((u_) % GLA_NCH) < 4 && !with_ctx)
    int u = blockIdx.x; while (u < NU && GLA_SKIP(u)) u += F.G;
    if (u < NU) GLA_PF(u);
    while (u < NU) {
        const int b = u / (4 * GLA_NCH), h = (u / GLA_NCH) & 3, jj = u % GLA_NCH;
        const GlaRegs R = Rn; const f32x4 a = san, c = scn, la0 = la0n, la1 = la1n; const v4u gw = gwn;
        int un = u + F.G; while (un < NU && GLA_SKIP(un)) un += F.G;
        if (un < NU) GLA_PF(un);
        gla_head_kqv(F, R);
        { LAS f32x4* dl = (LAS f32x4*)(LA + (((tid >> 2) & 1) * 64 + (tid >> 3)) * 32 + (tid & 3) * 8); dl[0] = la0; dl[1] = la1; }
        __syncthreads();
        for (int i = tid; i < 2048; i += NTHR) { const int t = i >> 5, k = i & 31; const float qv = QQ[i] * 0.17677669529663687f, kv = KK[i];
            const float bf_ = LA[t * 32 + k], bb_ = LA[(64 + t) * 32 + k];
            QF[t * 40 + k] = bf1(qv * __expf(bf_)); KF[t * 40 + k] = bf1(kv * __expf(-bf_)); QB[t * 40 + k] = bf1(qv * __expf(bb_)); KB[t * 40 + k] = bf1(kv * __expf(-bb_)); }
        { const int k = tid >> 4, v4 = (tid & 15) * 4;
          STF[(v4 + 0) * 40 + k] = bf1(a.x); STF[(v4 + 1) * 40 + k] = bf1(a.y); STF[(v4 + 2) * 40 + k] = bf1(a.z); STF[(v4 + 3) * 40 + k] = bf1(a.w);
          STB[(v4 + 0) * 40 + k] = bf1(c.x); STB[(v4 + 1) * 40 + k] = bf1(c.y); STB[(v4 + 2) * 40 + k] = bf1(c.z); STB[(v4 + 3) * 40 + k] = bf1(c.w); }
        __syncthreads();
        gf32x16 acc = {};
        const int mt = wv & 1, nt = (wv >> 1) & 1;
        if (wv < 4) {
            gf32x16 af = {}, ab = {};
            gmm<32>(af, LB + GB_QF, 80, mt * 32, LB + GB_KF, 80, nt * 32, r32, hi); gmm<32>(ab, LB + GB_QB, 80, mt * 32, LB + GB_KB, 80, nt * 32, r32, hi);
            const int s = nt * 32 + r32;
#pragma unroll
            for (int r = 0; r < 16; ++r) { const int t = mt * 32 + gcrow(r, hi); const float a = (s <= t ? af[r] : 0.f) + (s >= t ? ab[r] : 0.f); ATT[t * 72 + s] = bf1(a); }
        } else {
            gmm<32>(acc, LB + GB_QF, 80, mt * 32, LB + GB_STF, 80, nt * 32, r32, hi); gmm<32>(acc, LB + GB_QB, 80, mt * 32, LB + GB_STB, 80, nt * 32, r32, hi);
        }
        __syncthreads();
        if (wv >= 4) { gmm<64>(acc, LB + GB_ATT, 144, mt * 32, LB + GB_VT, 144, nt * 32, r32, hi);
#pragma unroll
            for (int r = 0; r < 16; ++r) OO[(mt * 32 + gcrow(r, hi)) * 65 + nt * 32 + r32] = acc[r]; }
        __syncthreads();
        { const int t = tid >> 3, vg = tid & 7; float o8[8], ss = 0.f;
#pragma unroll
          for (int i = 0; i < 8; ++i) { o8[i] = OO[t * 65 + vg * 8 + i]; ss += o8[i] * o8[i]; }
          ss += __shfl_xor(ss, 1); ss += __shfl_xor(ss, 2); ss += __shfl_xor(ss, 4);
          const float rs = 1.f / sqrtf(ss * (1.f / 64.f) + RMS_EPS);
          const int row = gla_row0(b, jj) + t;
          float ga[8]; ga[0] = bf2f((unsigned short)gw.x); ga[1] = bf2f((unsigned short)(gw.x >> 16)); ga[2] = bf2f((unsigned short)gw.y); ga[3] = bf2f((unsigned short)(gw.y >> 16));
          ga[4] = bf2f((unsigned short)gw.z); ga[5] = bf2f((unsigned short)(gw.z >> 16)); ga[6] = bf2f((unsigned short)gw.w); ga[7] = bf2f((unsigned short)(gw.w >> 16));
          float y[8];
#pragma unroll
          for (int i = 0; i < 8; ++i) y[i] = o8[i] * rs * gng[vg * 8 + i] * siluf(ga[i]);
          v4u o; o.x = pk2(y[0], y[1]); o.y = pk2(y[2], y[3]); o.z = pk2(y[4], y[5]); o.w = pk2(y[6], y[7]);
          *(GAS v4u*)(Y + (size_t)row * D + h * 64 + vg * 8) = o; }
        __syncthreads();
        u = un;
    }
#undef GLA_PF
#undef GLA_SKIP
}

constexpr int FN = 32768, FN1 = 128, FN2 = 256;
constexpr size_t WS_FA = WS_XN + 33 * MiB;
constexpr size_t WS_HT = WS_PH;
constexpr size_t WS_FA0 = WS_K, WS_FA1 = WS_VT;
constexpr size_t WS_HID = AB + 521 * MiB, WS_HTC = AB + 526 * MiB, WS_CU = AB + 527 * MiB, WS_OTC = AB + 529 * MiB, WS_NPART = AB + 530 * MiB, WS_END2 = AB + 532 * MiB;
static_assert(WS_FA0 + 64 * MiB <= WS_VT && WS_FA1 + 64 * MiB <= WS_HF && WS_END2 <= 573 * MiB, "hyena map");
constexpr size_t CTL_NRM = 256 * 1024;
constexpr int FFT_TW_OFF = 40960;
typedef float f32x2 __attribute__((ext_vector_type(2)));
__device__ __forceinline__ f32x2 cmul(f32x2 a, f32x2 b) { return (f32x2){a.x * b.x - a.y * b.y, a.x * b.y + a.y * b.x}; }
__device__ __forceinline__ unsigned pkc(f32x2 v) { return pk2(v.x, v.y); }
__device__ __forceinline__ f32x2 upc(unsigned w) { return (f32x2){__uint_as_float(w << 16), __uint_as_float(w & 0xffff0000u)}; }
__device__ __forceinline__ f32x2 twid(float rev) { return (f32x2){__builtin_amdgcn_cosf(rev), __builtin_amdgcn_sinf(rev)}; }
__device__ __forceinline__ float nrm_lat(const Frame& F, int order, int c) {
    LAS float* red = (LAS float*)(F.lds + FFT_TW_OFF + 1024); const GAS float* NP = (const GAS float*)(F.ws + WS_NPART);
    const float v = wave_sum(NP[(size_t)(F.tid & 255) * 1024 + order * 512 + (F.tid >> 8) * 256 + c]);
    __syncthreads(); if (F.lane == 0) red[F.wave] = v; __syncthreads();
    float s = 0.f;
#pragma unroll
    for (int w = 0; w < 8; ++w) s += red[w];
    return 1.f / sqrtf(s + 1e-6f);
}
__device__ __forceinline__ float nrm_ctx(const Frame& F, int order, int c) { const GAS float* NP = (const GAS float*)(F.ws + WS_NPART); float s = 0.f;
#pragma unroll
    for (int pb = 256; pb < 260; ++pb) s += NP[(size_t)pb * 1024 + order * 512 + c] + NP[(size_t)pb * 1024 + order * 512 + 256 + c];
    return 1.f / sqrtf(s + 1e-6f); }

__device__ __forceinline__ void p_filt_hidden(const Frame& F0, int l) { const Frame F = launder(F0);
    LAS float* L = (LAS float*)F.lds; LAS float* W1 = L, * W2 = L + 33 * 64, * H1 = W2 + 64 * 64, * PB = H1 + 128 * 65;
    GAS float* HID = (GAS float*)(F.ws + WS_HID); const int tid = F.tid;
    for (int i = tid; i < 33 * 64; i += NTHR) W1[i] = F.in[I_HW1][l * 33 * 64 + i];
    for (int i = tid; i < 64 * 64; i += NTHR) W2[i] = F.in[I_HW2][l * 64 * 64 + i];
    if (tid < 64) { PB[tid] = F.in[I_HB1][l * 64 + tid]; PB[64 + tid] = F.in[I_HF1][l * 64 + tid]; PB[128 + tid] = F.in[I_HB2][l * 64 + tid]; PB[192 + tid] = F.in[I_HF2][l * 64 + tid]; }
    __syncthreads();
    const int p = tid & 127, jq = tid >> 7;
    for (int blk = blockIdx.x; blk < (SEQ + CTXL) / 128; blk += F.G) {
        const int prow = blk * 128 + p; const bool lat = prow < SEQ; const int pos = lat ? prow : prow - SEQ; const float Lf = lat ? (float)SEQ : (float)CTXL;
        float z[33]; z[0] = (float)pos / (Lf - 1.f);
#pragma unroll
        for (int i = 0; i < 16; ++i) { const float fr = 1e-4f + (float)i * ((15.f - 1e-4f) / 15.f); float rev = (float)pos * fr / Lf; rev -= floorf(rev);
            z[1 + i] = __builtin_amdgcn_cosf(rev); z[17 + i] = -__builtin_amdgcn_sinf(rev); }
        for (int j = jq * 16; j < jq * 16 + 16; ++j) { float a = PB[j];
#pragma unroll
            for (int i = 0; i < 33; ++i) a += z[i] * W1[i * 64 + j];
            H1[p * 65 + j] = __sinf(PB[64 + j] * a); }
        __syncthreads();
        for (int j = jq * 16; j < jq * 16 + 16; ++j) { float a = PB[128 + j];
            for (int i = 0; i < 64; ++i) a += H1[p * 65 + i] * W2[i * 64 + j];
            HID[(size_t)prow * 64 + j] = __sinf(PB[192 + j] * a); }
        __syncthreads();
    }
}
__device__ __forceinline__ void p_filt_raw(const Frame& F0, int l) { const Frame F = launder(F0);
    LAS float* L = (LAS float*)F.lds; LAS float* HS = L, * W3 = L + 64 * 65; const int tid = F.tid;
    const GAS float* HID = (const GAS float*)(F.ws + WS_HID); GAS float* HT = (GAS float*)(F.ws + WS_HT); GAS float* HTC = (GAS float*)(F.ws + WS_HTC);
    const GAS float* w3 = F.in[I_HW3] + (size_t)l * 64 * 1024; const GAS float* b3 = F.in[I_HB3] + l * 1024;
    const int pg = tid & 15, cg = tid >> 4;
    for (int u = blockIdx.x; u < ((SEQ + CTXL) / 64) * 4; u += F.G) {
        const int pb = u >> 2, cb = u & 3, prow0 = pb * 64; const bool lat = prow0 < SEQ; const int pos0 = lat ? prow0 : prow0 - SEQ; const float Lf = lat ? (float)SEQ : (float)CTXL;
        for (int i = tid; i < 64 * 64; i += NTHR) HS[(i >> 6) * 65 + (i & 63)] = HID[(size_t)prow0 * 64 + i];
        for (int i = tid; i < 64 * 256; i += NTHR) W3[i] = w3[(size_t)(i >> 8) * 1024 + cb * 256 + (i & 255)];
        __syncthreads();
        float acc[4][8];
#pragma unroll
        for (int a = 0; a < 4; ++a)
#pragma unroll
            for (int c = 0; c < 8; ++c) acc[a][c] = 0.f;
        for (int i = 0; i < 64; ++i) { const f32x4 w0 = *(const LAS f32x4*)(W3 + i * 256 + cg * 8), w1 = *(const LAS f32x4*)(W3 + i * 256 + cg * 8 + 4);
#pragma unroll
            for (int a = 0; a < 4; ++a) { const float hv = HS[(pg * 4 + a) * 65 + i];
                acc[a][0] += hv * w0.x; acc[a][1] += hv * w0.y; acc[a][2] += hv * w0.z; acc[a][3] += hv * w0.w; acc[a][4] += hv * w1.x; acc[a][5] += hv * w1.y; acc[a][6] += hv * w1.z; acc[a][7] += hv * w1.w; } }
        float ss[8];
#pragma unroll
        for (int c = 0; c < 8; ++c) { const int col = cb * 256 + cg * 8 + c, ch = col & 255; const float delta = 3.0701134573253944f + (float)ch * (12.280453829301578f / 255.f), bias = b3[col];
            float o[4]; ss[c] = 0.f;
#pragma unroll
            for (int a = 0; a < 4; ++a) { const float t = (float)(pos0 + pg * 4 + a) / (Lf - 1.f); o[a] = (acc[a][c] + bias) * __expf(-t * delta); ss[c] += o[a] * o[a]; }
            GAS float* dst = lat ? HT + (size_t)col * SEQ + pos0 + pg * 4 : HTC + (size_t)col * CTXL + pos0 + pg * 4;
            *(GAS f32x4*)dst = (f32x4){o[0], o[1], o[2], o[3]}; }
#pragma unroll
        for (int c = 0; c < 8; ++c) { float s = ss[c]; s += __shfl_xor(s, 1); s += __shfl_xor(s, 2); s += __shfl_xor(s, 4); s += __shfl_xor(s, 8); ss[c] = s; }
        if (pg == 0) { GAS float* np = (GAS float*)(F.ws + WS_NPART) + (size_t)pb * 1024 + cb * 256 + cg * 8;
            *(GAS f32x4*)np = (f32x4){ss[0], ss[1], ss[2], ss[3]}; *(GAS f32x4*)(np + 4) = (f32x4){ss[4], ss[5], ss[6], ss[7]}; }
        __syncthreads();
    }
}
__device__ __forceinline__ void fft_tw_init(LAS unsigned char* lds, int tid) { if (tid < 128) ((LAS f32x2*)(lds + FFT_TW_OFF))[tid] = twid(-(float)tid * (1.f / 256.f)); __syncthreads(); }
__device__ __forceinline__ f32x2 cconj(f32x2 a) { return (f32x2){a.x, -a.y}; }
__device__ __forceinline__ f32x2 mul_mi(f32x2 a) { return (f32x2){a.y, -a.x}; }
__device__ __forceinline__ f32x2 mul_pi(f32x2 a) { return (f32x2){-a.y, a.x}; }
template <int ST>
__device__ __forceinline__ void dif4(LAS f32x2* X, const LAS f32x2* TW, int base, int g, int s) {
    const int h = 1 << s, p = g & ((h >> 1) - 1), i = (((g >> (s - 1)) << (s + 1)) | p);
    LAS f32x2* P0 = X + base + i * ST; LAS f32x2* P1 = P0 + (h >> 1) * ST; LAS f32x2* P2 = P0 + h * ST; LAS f32x2* P3 = P1 + h * ST;
    const f32x2 x0 = *P0, x1 = *P1, x2 = *P2, x3 = *P3, wa = TW[p << (7 - s)], wc = TW[p << (8 - s)];
    const f32x2 y0 = x0 + x2, y2 = cmul(x0 - x2, wa), y1 = x1 + x3, y3 = mul_mi(cmul(x1 - x3, wa));
    *P0 = y0 + y1; *P1 = cmul(y0 - y1, wc); *P2 = y2 + y3; *P3 = cmul(y2 - y3, wc);
}
template <int ST>
__device__ __forceinline__ void dit4(LAS f32x2* X, const LAS f32x2* TW, int base, int g, int s) {
    const int h = 1 << s, p = g & (h - 1), i = (((g >> s) << (s + 2)) | p);
    LAS f32x2* P0 = X + base + i * ST; LAS f32x2* P1 = P0 + h * ST; LAS f32x2* P2 = P1 + h * ST; LAS f32x2* P3 = P2 + h * ST;
    const f32x2 w1 = cconj(TW[p << (7 - s)]), w2 = cconj(TW[p << (6 - s)]);
    const f32x2 x0 = *P0, x1 = cmul(*P1, w1), x2 = *P2, x3 = cmul(*P3, w1);
    const f32x2 y0 = x0 + x1, y1 = x0 - x1, y2 = cmul(x2 + x3, w2), y3 = mul_pi(cmul(x2 - x3, w2));
    *P0 = y0 + y2; *P2 = y0 - y2; *P1 = y1 + y3; *P3 = y1 - y3;
}
__device__ __forceinline__ void fft128_cols_fwd(LAS f32x2* X, int tid) {
    const int j = tid & 31, q0 = tid >> 5; const LAS f32x2* TW = (const LAS f32x2*)((const LAS unsigned char*)X + FFT_TW_OFF);
#pragma unroll 1
    for (int s = 6; s >= 2; s -= 2) { dif4<32>(X, TW, j, q0, s); dif4<32>(X, TW, j, q0 + 16, s); __syncthreads(); }
#pragma unroll
    for (int i = 0; i < 4; ++i) { const int q = q0 + 16 * i; const f32x2 a = X[(2 * q) * 32 + j], b = X[(2 * q + 1) * 32 + j]; X[(2 * q) * 32 + j] = a + b; X[(2 * q + 1) * 32 + j] = a - b; }
    __syncthreads();
}
__device__ __forceinline__ void fft128_cols_inv(LAS f32x2* X, int tid) {
    const int j = tid & 31, q0 = tid >> 5; const LAS f32x2* TW = (const LAS f32x2*)((const LAS unsigned char*)X + FFT_TW_OFF);
#pragma unroll
    for (int i = 0; i < 4; ++i) { const int q = q0 + 16 * i; const f32x2 a = X[(2 * q) * 32 + j], b = X[(2 * q + 1) * 32 + j]; X[(2 * q) * 32 + j] = a + b; X[(2 * q + 1) * 32 + j] = a - b; }
    __syncthreads();
#pragma unroll 1
    for (int s = 1; s <= 5; s += 2) { dit4<32>(X, TW, j, q0, s); dit4<32>(X, TW, j, q0 + 16, s); __syncthreads(); }
}
__device__ __forceinline__ void fft256_rows_fwd(LAS f32x2* X, int tid) {
    const int g = tid & 63, r0 = tid >> 6; const LAS f32x2* TW = (const LAS f32x2*)((const LAS unsigned char*)X + FFT_TW_OFF);
#pragma unroll 1
    for (int s = 7; s >= 1; s -= 2) { dif4<1>(X, TW, r0 * 256, g, s); dif4<1>(X, TW, (r0 + 8) * 256, g, s); __syncthreads(); }
}
__device__ __forceinline__ void fft256_rows_inv(LAS f32x2* X, int tid) {
    const int g = tid & 63, r0 = tid >> 6; const LAS f32x2* TW = (const LAS f32x2*)((const LAS unsigned char*)X + FFT_TW_OFF);
#pragma unroll 1
    for (int s = 0; s <= 6; s += 2) { dit4<1>(X, TW, r0 * 256, g, s); dit4<1>(X, TW, (r0 + 8) * 256, g, s); __syncthreads(); }
}
__device__ __forceinline__ int bitrev7(int r) { return (int)(__brev((unsigned)r) >> 25); }
template <int KIND>
__device__ __forceinline__ void p_fft_pass1(const Frame& F0, int order, size_t ws_a) { const Frame F = launder(F0);
    fft_tw_init(F.lds, F.tid);
    LAS f32x2* X = (LAS f32x2*)F.lds; const int tid = F.tid, j = tid & 31, q0 = tid >> 5;
    const GAS float* VT = (const GAS float*)(F.ws + WS_VT); const GAS float* HT = (const GAS float*)(F.ws + WS_HT); GAS unsigned* A = (GAS unsigned*)(F.ws + ws_a);
    f32x2 pre[8];
#define P1_LOAD(uu) do { const int sg_ = (uu) >> 3, nb_ = (uu) & 7; _Pragma("unroll") for (int i = 0; i < 8; ++i) { const int n1 = q0 + 16 * i, n = 256 * n1 + 32 * nb_ + j; f32x2 v = {0.f, 0.f}; \
        if (KIND == 0) { if (n1 < 64) { v.x = VT[(size_t)(sg_ * 2 + 0) * SEQ + n]; v.y = VT[(size_t)(sg_ * 2 + 1) * SEQ + n]; } } \
        else { const GAS float* hf = HT + (size_t)(order * 512 + sg_) * SEQ; const GAS float* hb = HT + (size_t)(order * 512 + 256 + sg_) * SEQ; \
               if (n < SEQ) v.x = hf[n]; else if (n > SEQ) v.x = hb[2 * SEQ - n]; } \
        pre[i] = v; } } while (0)
    int u = blockIdx.x; if (u < 256 * 8) P1_LOAD(u);
    for (; u < 256 * 8; u += F.G) {
        const int sg = u >> 3, nb = u & 7;
#pragma unroll
        for (int i = 0; i < 8; ++i) X[(q0 + 16 * i) * 32 + j] = pre[i];
        __syncthreads();
        if (u + F.G < 256 * 8) P1_LOAD(u + F.G);
        fft128_cols_fwd(X, tid);
#pragma unroll
        for (int i = 0; i < 8; ++i) { const int r = q0 + 16 * i, k1 = bitrev7(r), n2 = 32 * nb + j;
            A[((size_t)sg * FN1 + r) * FN2 + n2] = pkc(cmul(X[r * 32 + j], twid(-(float)(n2 * k1) * (1.f / (float)FN)))); }
        __syncthreads();
    }
#undef P1_LOAD
}
template <int KIND>
__device__ __forceinline__ void p_fft_pass2(const Frame& F0, int l, int order, size_t ws_a) { const Frame F = launder(F0);
    fft_tw_init(F.lds, F.tid);
    LAS f32x2* X = (LAS f32x2*)F.lds; const int tid = F.tid;
    GAS unsigned* A = (GAS unsigned*)(F.ws + ws_a); GAS unsigned* HF = (GAS unsigned*)(F.ws + WS_HF);
    unsigned pa[8], ph[8];
#define P2_LOAD(uu) do { const int sg_ = (uu) >> 3, g_ = (uu) & 7; const GAS unsigned* Ab_ = A + ((size_t)sg_ * FN1 + g_ * 16) * FN2; const GAS unsigned* Hb_ = HF + ((size_t)(order * 256 + sg_) * FN1 + g_ * 16) * FN2; \
        _Pragma("unroll") for (int i = 0; i < 8; ++i) { pa[i] = Ab_[tid + NTHR * i]; if (KIND == 0) ph[i] = Hb_[tid + NTHR * i]; } } while (0)
    int u = blockIdx.x; if (u < 256 * 8) P2_LOAD(u);
    for (; u < 256 * 8; u += F.G) {
        const int sg = u >> 3, g = u & 7;
        GAS unsigned* Ab = A + ((size_t)sg * FN1 + g * 16) * FN2; GAS unsigned* Hb = HF + ((size_t)(order * 256 + sg) * FN1 + g * 16) * FN2;
        unsigned hcur[8];
#pragma unroll
        for (int i = 0; i < 8; ++i) { X[tid + NTHR * i] = upc(pa[i]); if (KIND == 0) hcur[i] = ph[i]; }
        __syncthreads();
        if (u + F.G < 256 * 8) P2_LOAD(u + F.G);
        fft256_rows_fwd(X, tid);
        if (KIND == 1) { const float nr = nrm_lat(F, order, sg);
#pragma unroll
            for (int i = 0; i < 8; ++i) { const int e = tid + NTHR * i; const f32x2 v = X[e] * nr; const _Float16 hr = (_Float16)v.x, hi = (_Float16)v.y;
                Hb[e] = (unsigned)__builtin_bit_cast(unsigned short, hr) | ((unsigned)__builtin_bit_cast(unsigned short, hi) << 16); }
            __syncthreads();
        } else {
#pragma unroll
            for (int i = 0; i < 8; ++i) { const int e = tid + NTHR * i; const unsigned hw = hcur[i];
                const f32x2 h = {(float)__builtin_bit_cast(_Float16, (unsigned short)(hw & 0xffffu)), (float)__builtin_bit_cast(_Float16, (unsigned short)(hw >> 16))};
                X[e] = cmul(X[e], h); }
            __syncthreads();
            fft256_rows_inv(X, tid);
#pragma unroll
            for (int i = 0; i < 8; ++i) { const int e = tid + NTHR * i, r = g * 16 + (e >> 8), n2 = e & 255, k1 = bitrev7(r);
                Ab[e] = pkc(cmul(X[e], twid((float)(n2 * k1) * (1.f / (float)FN))) * (1.f / (float)FN)); }
            __syncthreads();
        }
    }
#undef P2_LOAD
}
__device__ __forceinline__ void p_fft_pass3(const Frame& F0, int l, int order) { const Frame F = launder(F0);
    fft_tw_init(F.lds, F.tid);
    LAS f32x2* X = (LAS f32x2*)F.lds; const int tid = F.tid, j = tid & 31, q0 = tid >> 5;
    GAS float* VT = (GAS float*)(F.ws + WS_VT); const GAS bf16* GT = (const GAS bf16*)(F.ws + (order == 0 ? WS_X1T : WS_X2T)); const GAS unsigned* A = (const GAS unsigned*)(F.ws + WS_FA);
    const GAS float* skip = F.in[I_HSKIP] + (size_t)(l * 2 + order) * 256;
    unsigned pa[8]; float pv[4][2]; unsigned short pg[4][2];
#define P3_LOAD(uu) do { const int sg_ = (uu) >> 3, nb_ = (uu) & 7; _Pragma("unroll") for (int i = 0; i < 8; ++i) pa[i] = A[((size_t)sg_ * FN1 + q0 + 16 * i) * FN2 + 32 * nb_ + j]; \
        _Pragma("unroll") for (int i = 0; i < 4; ++i) { const int n = 256 * (q0 + 16 * i) + 32 * nb_ + j; const size_t i0 = (size_t)(sg_ * 2 + 0) * SEQ + n, i1 = (size_t)(sg_ * 2 + 1) * SEQ + n; \
            pv[i][0] = VT[i0]; pv[i][1] = VT[i1]; pg[i][0] = GT[i0]; pg[i][1] = GT[i1]; } } while (0)
    int u = blockIdx.x; if (u < 256 * 8) P3_LOAD(u);
    for (; u < 256 * 8; u += F.G) {
        const int sg = u >> 3, nb = u & 7;
        float cv[4][2], cg[4][2];
#pragma unroll
        for (int i = 0; i < 8; ++i) X[(q0 + 16 * i) * 32 + j] = upc(pa[i]);
#pragma unroll
        for (int i = 0; i < 4; ++i) { cv[i][0] = pv[i][0]; cv[i][1] = pv[i][1]; cg[i][0] = bf2f(pg[i][0]); cg[i][1] = bf2f(pg[i][1]); }
        __syncthreads();
        if (u + F.G < 256 * 8) P3_LOAD(u + F.G);
        fft128_cols_inv(X, tid);
        const float sk = skip[sg];
#pragma unroll
        for (int i = 0; i < 4; ++i) { const int n1 = q0 + 16 * i, n = 256 * n1 + 32 * nb + j; const f32x2 y = X[n1 * 32 + j];
            const size_t i0 = (size_t)(sg * 2 + 0) * SEQ + n, i1 = (size_t)(sg * 2 + 1) * SEQ + n;
            VT[i0] = cg[i][0] * (y.x + sk * cv[i][0]); VT[i1] = cg[i][1] * (y.y + sk * cv[i][1]); }
        __syncthreads();
    }
#undef P3_LOAD
}
__device__ __forceinline__ void p_fft_pass31(const Frame& F0, int l) { const Frame F = launder(F0);
    fft_tw_init(F.lds, F.tid);
    LAS f32x2* X = (LAS f32x2*)F.lds; const int tid = F.tid, j = tid & 31, q0 = tid >> 5;
    GAS float* VT = (GAS float*)(F.ws + WS_VT); const GAS bf16* GT = (const GAS bf16*)(F.ws + WS_X1T); GAS unsigned* A = (GAS unsigned*)(F.ws + WS_FA);
    const GAS float* skip = F.in[I_HSKIP] + (size_t)(l * 2 + 0) * 256;
    unsigned pa[8]; float pv[4][2]; unsigned short pg[4][2];
#define P3_LOAD(uu) do { const int sg_ = (uu) >> 3, nb_ = (uu) & 7; _Pragma("unroll") for (int i = 0; i < 8; ++i) pa[i] = A[((size_t)sg_ * FN1 + q0 + 16 * i) * FN2 + 32 * nb_ + j]; \
        _Pragma("unroll") for (int i = 0; i < 4; ++i) { const int n = 256 * (q0 + 16 * i) + 32 * nb_ + j; const size_t i0 = (size_t)(sg_ * 2 + 0) * SEQ + n, i1 = (size_t)(sg_ * 2 + 1) * SEQ + n; \
            pv[i][0] = VT[i0]; pv[i][1] = VT[i1]; pg[i][0] = GT[i0]; pg[i][1] = GT[i1]; } } while (0)
    int u = blockIdx.x; if (u < 256 * 8) P3_LOAD(u);
    for (; u < 256 * 8; u += F.G) {
        const int sg = u >> 3, nb = u & 7;
        float cv[4][2], cg[4][2];
#pragma unroll
        for (int i = 0; i < 8; ++i) X[(q0 + 16 * i) * 32 + j] = upc(pa[i]);
#pragma unroll
        for (int i = 0; i < 4; ++i) { cv[i][0] = pv[i][0]; cv[i][1] = pv[i][1]; cg[i][0] = bf2f(pg[i][0]); cg[i][1] = bf2f(pg[i][1]); }
        __syncthreads();
        if (u + F.G < 256 * 8) P3_LOAD(u + F.G);
        fft128_cols_inv(X, tid);
        const float sk = skip[sg];
#pragma unroll
        for (int i = 0; i < 4; ++i) { const int n1 = q0 + 16 * i, n = 256 * n1 + 32 * nb + j; const f32x2 y = X[n1 * 32 + j];
            const size_t i0 = (size_t)(sg * 2 + 0) * SEQ + n, i1 = (size_t)(sg * 2 + 1) * SEQ + n;
            const f32x2 z = {cg[i][0] * (y.x + sk * cv[i][0]), cg[i][1] * (y.y + sk * cv[i][1])};
            VT[i0] = z.x; VT[i1] = z.y; X[n1 * 32 + j] = z; X[(n1 + 64) * 32 + j] = (f32x2){0.f, 0.f}; }
        __syncthreads();
        fft128_cols_fwd(X, tid);
#pragma unroll
        for (int i = 0; i < 8; ++i) { const int r = q0 + 16 * i, k1 = bitrev7(r), n2 = 32 * nb + j;
            A[((size_t)sg * FN1 + r) * FN2 + n2] = pkc(cmul(X[r * 32 + j], twid(-(float)(n2 * k1) * (1.f / (float)FN)))); }
        __syncthreads();
    }
#undef P3_LOAD
}
__device__ __forceinline__ void p_hy_shortconv(const Frame& F0, int l) { const Frame F = launder(F0);
    LAS bf16* IN = (LAS bf16*)F.lds; LAS float* OT = (LAS float*)(F.lds + 66 * 256 * 2 + 64); const int tid = F.tid;
    const GAS bf16* PH = (const GAS bf16*)(F.ws + WS_PH); GAS float* VT = (GAS float*)(F.ws + WS_VT); GAS bf16* X1T = (GAS bf16*)(F.ws + WS_X1T); GAS bf16* X2T = (GAS bf16*)(F.ws + WS_X2T); GAS float* CU = (GAS float*)(F.ws + WS_CU);
    const GAS float* cw = F.in[I_HCW] + (size_t)l * 3 * 768; const GAS float* cb = F.in[I_HCB] + (size_t)l * 768;
    const int nlat = NBATCH * (SEQ / 64) * 3, nctx = NBATCH * (CTXL / 64) * 3;
    v4u pw[5];
#define SC_LOAD(u_) do { const bool lat_ = (u_) < nlat; const int uu_ = lat_ ? (u_) : (u_) - nlat; const int grp_ = uu_ % 3, tile_ = (uu_ / 3) % (lat_ ? SEQ / 64 : CTXL / 64), b_ = (uu_ / 3) / (lat_ ? SEQ / 64 : CTXL / 64); \
        const int Ls_ = lat_ ? SEQ : CTXL, t0_ = tile_ * 64; const size_t rowb_ = lat_ ? (size_t)b_ * SEQ : (size_t)TL + b_ * CTXL; \
        _Pragma("unroll") for (int k_ = 0; k_ < 5; ++k_) { const int i_ = tid + NTHR * k_; const int rr_ = i_ >> 5, c8_ = (i_ & 31) * 8, t_ = t0_ + rr_ - 1; pw[k_] = (v4u){0u, 0u, 0u, 0u}; \
            if (i_ < 66 * 32 && t_ >= 0 && t_ < Ls_) pw[k_] = *(const GAS v4u*)(PH + (rowb_ + t_) * NPH + PH_HY + grp_ * 256 + c8_); } } while (0)
    if ((int)blockIdx.x < nlat + nctx) SC_LOAD((int)blockIdx.x);
    for (int u = blockIdx.x; u < nlat + nctx; u += F.G) {
        const bool lat = u < nlat; const int uu = lat ? u : u - nlat; const int grp = uu % 3, tile = (uu / 3) % (lat ? SEQ / 64 : CTXL / 64), b = (uu / 3) / (lat ? SEQ / 64 : CTXL / 64);
        const int t0 = tile * 64;
#pragma unroll
        for (int k = 0; k < 5; ++k) { const int i = tid + NTHR * k; if (i < 66 * 32) *(LAS v4u*)(IN + (i >> 5) * 256 + (i & 31) * 8) = pw[k]; }
        if (u + F.G < nlat + nctx) SC_LOAD(u + F.G);
        __syncthreads();
        { const int c = tid & 255, th = tid >> 8, ch = grp * 256 + c; const float w0 = cw[ch], w1 = cw[768 + ch], w2 = cw[1536 + ch], bb = cb[ch];
          float a = bf2f(IN[(th * 32) * 256 + c]), m = bf2f(IN[(th * 32 + 1) * 256 + c]);
          for (int i = 0; i < 32; ++i) { const float n = bf2f(IN[(th * 32 + i + 2) * 256 + c]); const float y = bb + a * w0 + m * w1 + n * w2; a = m; m = n;
              if (lat) OT[c * 65 + th * 32 + i] = y; else CU[((size_t)b * CTXL + t0 + th * 32 + i) * 768 + ch] = y; } }
        __syncthreads();
        if (lat) { const int t4 = (tid & 15) * 4;
#pragma unroll
            for (int i = 0; i < 8; ++i) { const int c = (tid >> 4) + 32 * i; const LAS float* s = OT + c * 65 + t4; const size_t o = (size_t)(c * 2 + b) * SEQ + t0 + t4;
                if (grp == 0) *(GAS f32x4*)(VT + o) = (f32x4){s[0], s[1], s[2], s[3]};
                else { v2u w; w.x = pk2(s[0], s[1]); w.y = pk2(s[2], s[3]); *(GAS v2u*)((grp == 1 ? X1T : X2T) + o) = w; } } }
        __syncthreads();
    }
}
#undef SC_LOAD
__device__ __forceinline__ void p_hy_ctx(const Frame& F0, int l) { const Frame F = launder(F0);
    LAS float* L = (LAS float*)F.lds; const int tid = F.tid, t = tid & 255, cs = tid >> 8;
    LAS float* SV = L + cs * 1280, * HFW = SV + 256, * HBW = SV + 512, * HF2 = SV + 768, * HB2 = SV + 1024;
    const GAS float* CU = (const GAS float*)(F.ws + WS_CU); const GAS float* HTC = (const GAS float*)(F.ws + WS_HTC); GAS float* OTC = (GAS float*)(F.ws + WS_OTC);
    for (int u = blockIdx.x; u < NBATCH * 128; u += F.G) {
        const int b = u >> 7, c = (u & 127) * 2 + cs;
        const float n0 = nrm_ctx(F, 0, c), n1 = nrm_ctx(F, 1, c);
        const GAS float* cu = CU + ((size_t)b * CTXL + t) * 768;
        const float v = cu[c], x1 = cu[256 + c], x2 = cu[512 + c];
        SV[t] = v; HFW[t] = HTC[(size_t)(0 + c) * CTXL + t] * n0; HBW[t] = HTC[(size_t)(256 + c) * CTXL + t] * n0; HF2[t] = HTC[(size_t)(512 + c) * CTXL + t] * n1; HB2[t] = HTC[(size_t)(768 + c) * CTXL + t] * n1;
        __syncthreads();
        float y = F.in[I_HSKIP][(l * 2 + 0) * 256 + c] * v;
        for (int s = 0; s <= t; ++s) y += HFW[t - s] * SV[s];
        for (int s = t + 1; s < CTXL; ++s) y += HBW[s - t] * SV[s];
        const float z = x1 * y;
        __syncthreads();
        SV[t] = z;
        __syncthreads();
        float y2 = F.in[I_HSKIP][(l * 2 + 1) * 256 + c] * z;
        for (int s = 0; s <= t; ++s) y2 += HF2[t - s] * SV[s];
        for (int s = t + 1; s < CTXL; ++s) y2 += HB2[s - t] * SV[s];
        OTC[((size_t)b * CTXL + t) * 256 + c] = x2 * y2;
        __syncthreads();
    }
}
__device__ __forceinline__ void p_ynorm_b(const Frame& F0, int l, bool with_ctx) { const Frame F = launder(F0);
    LAS float* T = (LAS float*)F.lds; LAS float* RS = T + 256 * 65; LAS float* PS = RS + 64; const int tid = F.tid;
    const GAS float* VT = (const GAS float*)(F.ws + WS_VT); const GAS float* OTC = (const GAS float*)(F.ws + WS_OTC); GAS bf16* Y = (GAS bf16*)(F.ws + WS_Y); const GAS float* hg = F.in[I_HNG] + l * 256;
    const int nlat = NBATCH * (SEQ / 64), nctx = with_ctx ? NBATCH * (CTXL / 64) : 0;
    for (int u = blockIdx.x; u < nlat + nctx; u += F.G) {
        const bool lat = u < nlat; const int uu = lat ? u : u - nlat, b = lat ? uu / (SEQ / 64) : uu / (CTXL / 64), t0 = (lat ? uu % (SEQ / 64) : uu % (CTXL / 64)) * 64;
        const size_t rowb = lat ? (size_t)b * SEQ + t0 : (size_t)TL + b * CTXL + t0;
        if (lat) { const int t4 = (tid & 15) * 4;
#pragma unroll
            for (int i = 0; i < 8; ++i) { const int c = (tid >> 4) + 32 * i; const f32x4 v = *(const GAS f32x4*)(VT + (size_t)(c * 2 + b) * SEQ + t0 + t4); LAS float* d = T + c * 65 + t4; d[0] = v.x; d[1] = v.y; d[2] = v.z; d[3] = v.w; } }
        else { for (int i = tid; i < 64 * 256; i += NTHR) { const int t = i >> 8, c = i & 255; T[c * 65 + t] = OTC[((size_t)b * CTXL + t0 + t) * 256 + c]; } }
        __syncthreads();
        { const int t = tid & 63, part = tid >> 6; float s = 0.f;
          for (int c = part * 32; c < part * 32 + 32; ++c) { const float v = T[c * 65 + t]; s += v * v; }
          PS[part * 64 + t] = s; }
        __syncthreads();
        if (tid < 64) { float s = 0.f;
#pragma unroll
            for (int p = 0; p < 8; ++p) s += PS[p * 64 + tid];
            RS[tid] = 1.f / sqrtf(s * (1.f / 256.f) + RMS_EPS); }
        __syncthreads();
        { const int t = tid >> 3, c0 = (tid & 7) * 8; const float rs = RS[t];
#pragma unroll
          for (int i = 0; i < 4; ++i) { const int c = c0 + 64 * i; float y[8];
#pragma unroll
              for (int e = 0; e < 8; ++e) y[e] = T[(c + e) * 65 + t] * rs * hg[c + e];
              v4u o; o.x = pk2(y[0], y[1]); o.y = pk2(y[2], y[3]); o.z = pk2(y[4], y[5]); o.w = pk2(y[6], y[7]);
              *(GAS v4u*)(Y + (rowb + t) * D + 256 + c) = o; } }
        __syncthreads();
    }
}

enum LP { LP_IN = 0, LP_PREP, LP_GLA2, LP_GLA3, LP_HY0, LP_HY1, LP_HY2, LP_HY3, LP_HY4, LP_HY5, LP_HY6, LP_HY7, LP_ATT, LP_YN, LP_OUT, LP_LN1, LP_F1, LP_F2, LP_M0  , LP_LN2 = LP_M0 + 9, PPL };
constexpr int NPRO = 4;
constexpr int NPHASE = NPRO + DEPTH * PPL;
template <int l>
__device__ __forceinline__ void layer_phases(const Frame& F, const XcdBarrier& bar, const int lo, const int hi) {
#define IN(k) (lo <= (k) && (k) < hi)
#define SEAM(k) do { if ((k) + 1 < hi) xcd_barrier(bar); } while (0)
    LAS unsigned char* ring = F.lds;
    constexpr int pb = NPRO + l * PPL;
#define lng (F.in[I_LNG] + (size_t)l * 2 * D)
#define lnb (F.in[I_LNB] + (size_t)l * 2 * D)
        if (IN(pb + LP_IN)) { const Frame P = launder(F);
            pg8::Gemm g{(const GAS bf16*)(P.ws + WS_XN), (const GAS bf16*)(P.ws + WS_WIN) + (size_t)l * NPH * D, MR, NPH, D, D, 0};
            pg8::StaticOrder S; S.init(MR, NPH, F.G, (int)blockIdx.x);
            EpiStoreBf16 E{(GAS bf16*)(P.ws + WS_PH), NPH, 1.f};
            pg8::gemm_phase<EpiStoreBf16, pg8::StaticOrder, true, true>(ring, g, S, E);
            SEAM(pb + LP_IN);
        }
        if (IN(pb + LP_PREP)) { const Frame P = launder(F); p_prep_mla_rows(F); p_gla_local(F, l);
            p_hy_shortconv(F, l); SEAM(pb + LP_PREP); }
        if (IN(pb + LP_GLA2)) { const Frame P = launder(F);
            { pg8::Gemm g{(const GAS bf16*)(P.ws + WS_PH) + PH_CQ, (const GAS bf16*)(P.ws + WS_WUQ) + (size_t)l * 768 * 256, MR, 768, 256, NPH, 0};
              pg8::StaticOrder S; S.init(MR, 768, F.G, (int)blockIdx.x);
              EpiMlaQ E{P.ws + WS_Q, P.ws + WS_QC, (const GAS float*)(P.ws + WS_RSQ), (const GAS float*)(P.ws + WS_ROPE)};
              pg8::gemm_phase<EpiMlaQ, pg8::StaticOrder, true, true>(ring, g, S, E); }
            { pg8::Gemm g{(const GAS bf16*)(P.ws + WS_PH) + PH_CKV, (const GAS bf16*)(P.ws + WS_WUKV) + (size_t)l * 1024 * 256, MR, 1024, 256, NPH, 0};
              pg8::StaticOrder S; S.init(MR, 1024, F.G, (int)blockIdx.x);
              EpiMlaKV E{P.ws + WS_K, (GAS bf16*)(P.ws + WS_V), (const GAS float*)(P.ws + WS_RSKV)};
              pg8::gemm_phase<EpiMlaKV, pg8::StaticOrder, true, true>(ring, g, S, E); }
            p_gla_scan(F); p_fft_pass1<0>(F, 0, WS_FA);
            SEAM(pb + LP_GLA2);
        }
        if (IN(pb + LP_GLA3)) { const Frame P = launder(F); p_gla_out(F, l, l == 0); p_attn_vt_pack(F); p_fft_pass2<0>(F, l, 0, WS_FA); if constexpr (l == 0) p_hy_ctx(F, l);
            SEAM(pb + LP_GLA3); }
        if (IN(pb + LP_HY0)) { p_fft_pass31(F, l); SEAM(pb + LP_HY0); }
        if (IN(pb + LP_HY1)) { p_fft_pass2<0>(F, l, 1, WS_FA); SEAM(pb + LP_HY1); }
        if (IN(pb + LP_HY2)) { p_fft_pass3(F, l, 1); SEAM(pb + LP_HY2); }
        if (IN(pb + LP_ATT)) { const Frame P = launder(F); p_attention(F, l == 0);
            SEAM(pb + LP_ATT); }
        if (IN(pb + LP_YN)) { const Frame P = launder(F); p_ynorm_c(F, l == 0 ? MR : TL, F.in[I_MNG] + (size_t)l * 512); p_ynorm_b(F, l, l == 0); if constexpr (l == 0) p_filt_hidden(F, 1); SEAM(pb + LP_YN); }
        if (IN(pb + LP_OUT)) { const Frame P = launder(F);
            const int M = (l == 0) ? MR : TL;
            pg8::Gemm g{(const GAS bf16*)(P.ws + WS_Y), (const GAS bf16*)(P.ws + WS_WOUT) + (size_t)l * D * D, M, D, D, D, 0};
            pg8::StaticOrder S; S.init(M, D, F.G, (int)blockIdx.x);
            EpiRes E{l == 0 ? F.in[I_X] : F.out, l == 0 ? F.in[I_CTX] : (const GAS float*)(P.ws + WS_XC), F.out, (GAS float*)(P.ws + WS_XC), modv(F, l, 0, 2)};
            pg8::gemm_phase<EpiRes, pg8::StaticOrder, true, true>(ring, g, S, E);
            if constexpr (l == 0) p_filt_raw(F, 1);
            SEAM(pb + LP_OUT);
        }
        if (IN(pb + LP_LN1)) { const Frame P = launder(F);
            if constexpr (l == 0) { p_ln(F, MR, lng, lnb, true, l, 3); p_fft_pass1<1>(F, 0, WS_FA0); p_fft_pass1<1>(F, 1, WS_FA1); }
            else { p_ln_route(F, lng, lnb, l); p_moe_weights(F); }
            SEAM(pb + LP_LN1);
        }
        if constexpr (l == 0) {
            if (IN(pb + LP_F1)) { const Frame P = launder(F);
                pg8::Gemm g{(const GAS bf16*)(P.ws + WS_XN), (const GAS bf16*)(P.ws + WS_W13), MR, 2 * DFF, D, D, 0};
                pg8::StaticOrder S; S.init(MR, 2 * DFF, F.G, (int)blockIdx.x);
                EpiSwiglu E{(GAS bf16*)(P.ws + WS_G), DFF, 1.f};
                pg8::gemm_phase<EpiSwiglu, pg8::StaticOrder, true, true>(ring, g, S, E);
                p_fft_pass2<1>(F, 1, 0, WS_FA0); p_fft_pass2<1>(F, 1, 1, WS_FA1);
                SEAM(pb + LP_F1);
            }
            if (IN(pb + LP_F2)) { const Frame P = launder(F);
                pg8::Gemm g{(const GAS bf16*)(P.ws + WS_G), (const GAS bf16*)(P.ws + WS_W2), MR, D, DFF, DFF, 0};
                pg8::StaticOrder S; S.init(MR, D, F.G, (int)blockIdx.x);
                EpiRes E{F.out, (const GAS float*)(P.ws + WS_XC), F.out, (GAS float*)(P.ws + WS_XC), modv(F, l, 0, 5)};
                pg8::gemm_phase<EpiRes, pg8::StaticOrder, true, true>(ring, g, S, E);
                SEAM(pb + LP_F2);
            }
            if (IN(pb + LP_LN2)) { const Frame P = launder(F); p_ln(F, MR, lng + D, lnb + D, true, l + 1, 0); SEAM(pb + LP_LN2); }
        } else {
            if (IN(pb + LP_F1)) { const Frame P = launder(F); p_moe_scatter(F); SEAM(pb + LP_F1); }
            for (int ch = 0; ch < MOE_NCHUNK; ++ch) {
                if (IN(pb + LP_F2 + 2 * ch)) { const Frame P = launder(F);
                    moe_base_to_lds(P);
                    pg8::Gemm g{(const GAS bf16*)(P.ws + WS_HS8 + (size_t)ch * MOE_CHUNK_TILES * 256 * D), (const GAS bf16*)(P.ws + WS_WM13), MOE_CHUNK_TILES * 256, 2 * EFF, D / 2, D / 2, (size_t)2 * EFF * D};
                    MoeOrder S; S.init((const LAS int*)(F.lds + LDS_MOEBT), ch, 2 * EFF / 256, F.G, (int)blockIdx.x);
                    EpiSwiglu8 E{P.ws + WS_GC, EFF, 1.f / MOE_WSCALE, MOE_GSCALE};
                    pg8::gemm_phase<EpiSwiglu8, MoeOrder, true, true, true>(ring, g, S, E);
                    SEAM(pb + LP_F2 + 2 * ch);
                }
                if (IN(pb + LP_F2 + 2 * ch + 1)) { const Frame P = launder(F);
                    moe_base_to_lds(P);
                    pg8::Gemm g{(const GAS bf16*)(P.ws + WS_GC), (const GAS bf16*)(P.ws + WS_WM2), MOE_CHUNK_TILES * 256, D, EFF / 2, EFF / 2, (size_t)D * EFF};
                    MoeOrder S; S.init((const LAS int*)(F.lds + LDS_MOEBT), ch, D / 256, F.G, (int)blockIdx.x);
                    EpiStoreBf16 E{(GAS bf16*)(P.ws + WS_HS) + (size_t)ch * MOE_CHUNK_TILES * 256 * D, D, 1.f / (MOE_GSCALE * MOE_W2SCALE)};
                    pg8::gemm_phase<EpiStoreBf16, MoeOrder, true, true, true>(ring, g, S, E);
                    SEAM(pb + LP_F2 + 2 * ch + 1);
                }
            }
            if (IN(pb + LP_LN2)) { const Frame P = launder(F); p_ln_combine(F, lng + D, lnb + D, l); SEAM(pb + LP_LN2); }
        }

#undef lng
#undef lnb
#undef IN
#undef SEAM
}
__global__ void __launch_bounds__(NTHR, 2) mega(Args args) {
    extern __shared__ __attribute__((aligned(16))) unsigned char lds_raw[];
    Frame F;
    F.lds = (LAS unsigned char*)lds_raw; F.ws = args.ws; F.ctl = (gu32*)(args.ws + WS_CTL); F.in = (const GAS float* const GAS*)(args.ws + WS_PTRTAB); F.out = args.out;
    F.tid = threadIdx.x; F.lane = F.tid & 63; F.wave = __builtin_amdgcn_readfirstlane(F.tid >> 6); F.G = gridDim.x;
    F.gw = blockIdx.x * NWAVES + F.wave; F.ngw = F.G * NWAVES;
    volatile LAS unsigned* MISC = (volatile LAS unsigned*)(F.lds + LDS_MISC);
    if (F.tid < 32) MISC[F.tid] = 0u;
    __syncthreads();
    XcdBarrier bar; bar.bar = (unsigned*)(F.ctl + CW_BAR); bar.x = 0; bar.st = nullptr;
#if !MK_PER_PHASE
    bar = xcd_barrier_post((unsigned*)(F.ctl + CW_BAR), MISC + 8);
#endif
    const int lo = args.ph_lo, hi = args.ph_hi;
#define IN(k) (lo <= (k) && (k) < hi)
#define SEAM(k) do { if ((k) + 1 < hi) xcd_barrier(bar); } while (0)
    LAS unsigned char* ring = F.lds;
#define LTID() ({ int t_ = F.tid; asm volatile("" : "+v"(t_)); t_; })

    if (IN(0)) { Frame FK = F; FK.in = (const GAS float* const GAS*)(const GAS void*)args.in;
        if (blockIdx.x == 0 && F.tid < 37) ((const GAS float* GAS*)(args.ws + WS_PTRTAB))[F.tid] = args.in[F.tid];
        p0_modv(FK); p0_weights(FK); p0_rope_table(FK); __syncthreads();     p_filt_hidden(FK, 0);
        SEAM(0); }
    if (IN(1)) { p_xn0(F); p_filt_raw(F, 0);
        SEAM(1); }
    if (IN(2)) { p_fft_pass1<1>(F, 0, WS_FA0); p_fft_pass1<1>(F, 1, WS_FA1); SEAM(2); }
    if (IN(3)) { p_fft_pass2<1>(F, 0, 0, WS_FA0); p_fft_pass2<1>(F, 0, 1, WS_FA1); SEAM(3); }

    layer_phases<0>(F, bar, lo, hi);
    layer_phases<1>(F, bar, lo, hi);
#undef IN
#undef SEAM
}

extern "C" void kernel_launch(void* const* d_in, const int* in_sizes, int n_in, void* d_out, int out_size, void* d_ws, size_t ws_size, hipStream_t stream) {
    static int grid = 0;
    if (grid == 0) {
        if (n_in != 37 || in_sizes[0] != TL * D || out_size != TL * D || ws_size < WS_END2) { fprintf(stderr, "kernel_launch: shape/workspace mismatch (n_in %d in0 %d out %d ws %zu need %zu)\n", n_in, n_in > 0 ? in_sizes[0] : -1, out_size, ws_size, (size_t)WS_END2); grid = -1; return; }
        int dev = 0, cus = 0, per_cu = 0;
        if (hipGetDevice(&dev) != hipSuccess || hipDeviceGetAttribute(&cus, hipDeviceAttributeMultiprocessorCount, dev) != hipSuccess) { grid = -1; return; }
        if (hipFuncSetAttribute((const void*)mega, hipFuncAttributeMaxDynamicSharedMemorySize, LDS_BYTES) != hipSuccess) { fprintf(stderr, "kernel_launch: hipFuncSetAttribute failed\n"); grid = -1; return; }
        if (hipOccupancyMaxActiveBlocksPerMultiprocessor(&per_cu, (const void*)mega, NTHR, LDS_BYTES) != hipSuccess || per_cu < 1) { fprintf(stderr, "kernel_launch: occupancy query says %d\n", per_cu); }
        (void)hipGetLastError();
        grid = cus;
    }
    if (grid < 0) return;
    if (hipMemsetAsync((char*)d_ws + WS_CTL, 0, CTL_ZERO_BYTES, stream) != hipSuccess) return;
    Args a{};
    for (int i = 0; i < 37; ++i) a.in[i] = (const GAS float*)d_in[i];
    a.out = (GAS float*)d_out; a.ws = (GAS unsigned char*)d_ws;
#if MK_PER_PHASE
    for (int p = 0; p < NPHASE; ++p) { a.ph_lo = p; a.ph_hi = p + 1; hipLaunchKernelGGL(mega, dim3(grid), dim3(NTHR), LDS_BYTES, stream, a); }
#else
    a.ph_lo = 0; a.ph_hi = NPHASE;
    hipLaunchKernelGGL(mega, dim3(grid), dim3(NTHR), LDS_BYTES, stream, a);
#endif
    const hipError_t le = hipPeekAtLastError();
    if (le != hipSuccess) fprintf(stderr, "kernel_launch: launch failed: %s\n", hipGetErrorName(le));
}
```

```cpp
#include <hip/hip_runtime.h>
#include <cstdio>
#include <cstdint>
namespace pg8 {
#define PG8_LAS __attribute__((address_space(3)))
#define PG8_GAS __attribute__((address_space(1)))
typedef unsigned short bf16_t;
typedef short bf16x8 __attribute__((ext_vector_type(8)));
typedef float f32x4 __attribute__((ext_vector_type(4)));
typedef unsigned u32x4 __attribute__((ext_vector_type(4)));
typedef int i32x8_t __attribute__((ext_vector_type(8)));
typedef short bf16x16 __attribute__((ext_vector_type(16)));
constexpr int BM = 256, BK = 64, HALF = 128, HTB = HALF * BK * 2  , STAGE_BYTES = 8 * HTB, NXCD = 8, WGM = 8;

__host__ __device__ __forceinline__ int lds_byte(int r, int c) { const int st = (r >> 4) * 2 + (c >> 5), rr = r & 15, cc = c & 31, ob = rr * 64 + cc * 2; return st * 1024 + (ob ^ (((ob >> 9) & 1) << 5)); }
__host__ __device__ __forceinline__ void stage_rc(int b, int& R, int& C) { const int st = b / 1024, sb = b % 1024, swz = sb ^ (((sb >> 9) & 1) << 5); R = (st >> 1) * 16 + swz / 64; C = (st & 1) * 32 + (swz % 64) / 2; }
__host__ __device__ __forceinline__ int perm32(int rho) { const int n = rho >> 4, i = rho & 15; return 8 * (i >> 2) + 4 * n + (i & 3); }

struct Unit { int pm, pn, be; };
struct Gemm { const PG8_GAS bf16_t* A; const PG8_GAS bf16_t* Bt; int M, N, K; int lda; size_t bstride; };

struct StaticOrder {
    int nM, nN, nwg, G, c;
    __host__ __device__ void init(int M, int N, int G_, int c_) { nM = M / BM; nN = N / BM; nwg = nM * nN; G = G_; c = c_; }
    __host__ __device__ bool next(int i, Unit& u) const {
        const long L = (long)i * G + c; if (L >= nwg) return false;
        int wgid = (int)L; { const int q = nwg / NXCD, r = nwg % NXCD, xcd = wgid % NXCD, off = wgid / NXCD; wgid = (xcd < r ? xcd * (q + 1) : r * (q + 1) + (xcd - r) * q) + off; }
        const int nig = WGM * nN, gid = wgid / nig, fm = gid * WGM, gsz = (nM - fm) < WGM ? (nM - fm) : WGM;
        u.pm = fm + ((wgid % nig) % gsz); u.pn = (wgid % nig) / gsz; u.be = 0; return true;
    }
    __device__ __forceinline__ void a_ready(const Unit&) const {}
    __device__ __forceinline__ void done(const Unit&) const {}
};


__device__ __forceinline__ unsigned cvt_pk_bf16(float lo, float hi) { unsigned r; asm volatile("v_cvt_pk_bf16_f32 %0, %1, %2" : "=v"(r) : "v"(lo), "v"(hi)); return r; }
typedef float f32x2 __attribute__((ext_vector_type(2)));
typedef unsigned u32x2 __attribute__((ext_vector_type(2)));

template <class Epi, class Sched, bool ALIGN_EPI = false, bool SP2 = false, bool F8 = false>
__device__ __forceinline__ void gemm_phase(PG8_LAS unsigned char* lds, const Gemm g, const Sched& S, const Epi& E) {
    { unsigned lb_ = (unsigned)(size_t)lds; asm volatile("" : "+s"(lb_)); lds = (PG8_LAS unsigned char*)(size_t)lb_; }
    int tid_ = threadIdx.x; asm volatile("" : "+v"(tid_));
    const int tid = tid_, wid = __builtin_amdgcn_readfirstlane(tid >> 6), lane = tid & 63, wr = wid >> 2, wc = wid & 3, fr = lane & 15, fq = lane >> 4;
    int K_ = g.K; asm volatile("" : "+s"(K_)); const int K = K_, nt = K / BK;
    unsigned voffA[2], voffB[2];
#pragma unroll
    for (int i = 0; i < 2; ++i) { int R, C; stage_rc(tid * 16 + i * 8192, R, C); const int Rb = Epi::PERM ? ((R & ~31) + perm32(R & 31)) : R;
        voffA[i] = (unsigned)(R * g.lda + C) * 2u; voffB[i] = (unsigned)(Rb * K + C) * 2u; }
    const size_t kstep = (size_t)(BK * 2);
    const size_t hstepB = (size_t)HALF * K * 2, hstepA = (size_t)HALF * g.lda * 2;
    const size_t tstepA = 2 * hstepA, tstepB = 2 * hstepB;
    const unsigned ldsw = (unsigned)wid * 1024u;
    const int aoff = lds_byte(wr * 64 + fr, fq * 8), boff = lds_byte(wc * 32 + fr, fq * 8);
#define PG8_SA(b, h) (((b) * 2 + (h)) * HTB)
#define PG8_SB(b, h) ((4 + (b) * 2 + (h)) * HTB)
#define PG8_STAGE(bufoff, gbase, voff) do { _Pragma("unroll") for (int _i = 0; _i < 2; ++_i) \
        __builtin_amdgcn_global_load_lds((const PG8_GAS unsigned*)((const PG8_GAS char*)(gbase) + (voff)[_i]), (PG8_LAS unsigned*)(lds + (bufoff) + ldsw + _i * 8192), 16, 0, 0); } while (0)
#define PG8_LDA(dst, b, h) do { _Pragma("unroll") for (int m = 0; m < 4; ++m) dst[m] = __builtin_shufflevector(*(const PG8_LAS bf16x8*)(lds + PG8_SA(b, h) + aoff + m * 2048), *(const PG8_LAS bf16x8*)(lds + PG8_SA(b, h) + aoff + m * 2048 + 1024), 0, 1, 2, 3, 4, 5, 6, 7, 8, 9, 10, 11, 12, 13, 14, 15); } while (0)
#define PG8_LDB(dst, b, h) do { _Pragma("unroll") for (int n = 0; n < 2; ++n) dst[n] = __builtin_shufflevector(*(const PG8_LAS bf16x8*)(lds + PG8_SB(b, h) + boff + n * 2048), *(const PG8_LAS bf16x8*)(lds + PG8_SB(b, h) + boff + n * 2048 + 1024), 0, 1, 2, 3, 4, 5, 6, 7, 8, 9, 10, 11, 12, 13, 14, 15); } while (0)
#define PG8_HALF(x, k) ((k) == 0 ? __builtin_shufflevector(x, x, 0, 1, 2, 3, 4, 5, 6, 7) : __builtin_shufflevector(x, x, 8, 9, 10, 11, 12, 13, 14, 15))
#define PG8_MMA(ai, bj, At, Bt) do { __builtin_amdgcn_s_setprio(1); if constexpr (F8) { _Pragma("unroll") for (int m = 0; m < 4; ++m) _Pragma("unroll") for (int n = 0; n < 2; ++n) \
        asm volatile("v_mfma_f32_16x16x128_f8f6f4 %0, %1, %2, %0" : "+v"(acc[ai][bj][m][n]) : "v"(__builtin_bit_cast(i32x8_t, Bt[n])), "v"(__builtin_bit_cast(i32x8_t, At[m]))); } \
    else { _Pragma("unroll") for (int m = 0; m < 4; ++m) _Pragma("unroll") for (int n = 0; n < 2; ++n) _Pragma("unroll") for (int k = 0; k < 2; ++k) \
        acc[ai][bj][m][n] = __builtin_amdgcn_mfma_f32_16x16x32_bf16(PG8_HALF(Bt[n], k), PG8_HALF(At[m], k), acc[ai][bj][m][n], 0, 0, 0); } __builtin_amdgcn_s_setprio(0); } while (0)
#define PG8_F8_DRAIN() do { if constexpr (F8) asm volatile("s_nop 15\n\ts_nop 15" ::: "memory"); } while (0)
#define PG8_WAIT_V(n) asm volatile("s_waitcnt vmcnt(" #n ")" ::: "memory")
#define PG8_WAIT_L(n) asm volatile("s_waitcnt lgkmcnt(" #n ")" ::: "memory")
#define PG8_BAR __builtin_amdgcn_s_barrier()
#define PG8_SCHED __builtin_amdgcn_sched_barrier(0)
    Unit cur, nxt; int ui = 0;
    if (!S.next(0, cur)) return;
    f32x4 acc[2][2][4][2];
#pragma unroll
    for (int a = 0; a < 2; ++a)
#pragma unroll
        for (int b = 0; b < 2; ++b)
#pragma unroll
            for (int m = 0; m < 4; ++m)
#pragma unroll
                for (int n = 0; n < 2; ++n) acc[a][b][m][n] = (f32x4){0.f, 0.f, 0.f, 0.f};
    bf16x16 At[4], B0[2], B1[2];
    const PG8_GAS char* cA = (const PG8_GAS char*)g.A + (size_t)cur.pm * tstepA; const PG8_GAS char* cB = (const PG8_GAS char*)g.Bt + (size_t)cur.be * g.bstride + (size_t)cur.pn * tstepB;
    S.a_ready(cur);
    if constexpr (SP2) {
        PG8_STAGE(PG8_SB(0, 0), cB, voffB); PG8_STAGE(PG8_SB(0, 1), cB + hstepB, voffB); PG8_STAGE(PG8_SA(0, 0), cA, voffA); PG8_STAGE(PG8_SA(0, 1), cA + hstepA, voffA);
        if (wr == 1) PG8_BAR;
        PG8_WAIT_V(2); PG8_BAR;
        PG8_STAGE(PG8_SB(1, 0), cB + kstep, voffB); PG8_STAGE(PG8_SA(1, 0), cA + kstep, voffA); PG8_STAGE(PG8_SB(1, 1), cB + hstepB + kstep, voffB);
        PG8_WAIT_V(6); PG8_BAR;
    } else {
        PG8_STAGE(PG8_SB(0, 0), cB, voffB); PG8_STAGE(PG8_SA(0, 0), cA, voffA); PG8_STAGE(PG8_SB(0, 1), cB + hstepB, voffB); PG8_STAGE(PG8_SA(0, 1), cA + hstepA, voffA);
        if (wr == 1) PG8_BAR;
        PG8_WAIT_V(4); PG8_BAR;
        PG8_STAGE(PG8_SB(1, 0), cB + kstep, voffB); PG8_STAGE(PG8_SA(1, 0), cA + kstep, voffA); PG8_STAGE(PG8_SB(1, 1), cB + hstepB + kstep, voffB);
        PG8_WAIT_V(6); PG8_BAR;
    }
    for (;;) {
        const bool has_next = S.next(ui + 1, nxt);
        const PG8_GAS char* nA = has_next ? (const PG8_GAS char*)g.A + (size_t)nxt.pm * tstepA : cA; const PG8_GAS char* nB = has_next ? (const PG8_GAS char*)g.Bt + (size_t)nxt.be * g.bstride + (size_t)nxt.pn * tstepB : cB;
        for (int t = 0; t < nt; t += 2) {
            const bool last = (t == nt - 2);
            const PG8_GAS char* a1 = cA + (size_t)(t + 1) * kstep;
            const PG8_GAS char* a2 = last ? nA : cA + (size_t)(t + 2) * kstep; const PG8_GAS char* b2 = last ? nB : cB + (size_t)(t + 2) * kstep;
            const PG8_GAS char* a3 = a2 + kstep; const PG8_GAS char* b3 = b2 + kstep;
            if (last && has_next) S.a_ready(nxt);
            if constexpr (SP2) {
            PG8_LDB(B0, 0, 0); PG8_LDB(B1, 0, 1); PG8_SCHED; PG8_LDA(At, 0, 0); PG8_STAGE(PG8_SA(1, 1), a1 + hstepA, voffA);
            PG8_WAIT_V(8); PG8_WAIT_L(0); PG8_BAR; PG8_MMA(0, 0, At, B0); PG8_MMA(0, 1, At, B1); PG8_BAR; PG8_SCHED;
            PG8_LDA(At, 0, 1); PG8_STAGE(PG8_SB(0, 0), b2, voffB); PG8_STAGE(PG8_SB(0, 1), b2 + hstepB, voffB); PG8_STAGE(PG8_SA(0, 0), a2, voffA);
            PG8_WAIT_V(8); PG8_WAIT_L(0); PG8_BAR; PG8_MMA(1, 0, At, B0); PG8_MMA(1, 1, At, B1); PG8_BAR; PG8_SCHED;
            PG8_LDB(B0, 1, 0); PG8_LDB(B1, 1, 1); PG8_SCHED; PG8_LDA(At, 1, 0); PG8_STAGE(PG8_SA(0, 1), a2 + hstepA, voffA);
            PG8_WAIT_V(8); PG8_WAIT_L(0); PG8_BAR; PG8_MMA(0, 0, At, B0); PG8_MMA(0, 1, At, B1); PG8_BAR; PG8_SCHED;
            PG8_LDA(At, 1, 1); PG8_STAGE(PG8_SB(1, 0), b3, voffB); PG8_STAGE(PG8_SB(1, 1), b3 + hstepB, voffB); PG8_STAGE(PG8_SA(1, 0), a3, voffA);
            PG8_WAIT_V(8); PG8_WAIT_L(0); PG8_BAR; PG8_MMA(1, 0, At, B0); PG8_MMA(1, 1, At, B1); PG8_BAR; PG8_SCHED;
            } else {
            PG8_LDB(B0, 0, 0); PG8_SCHED; PG8_LDA(At, 0, 0); PG8_STAGE(PG8_SA(1, 1), a1 + hstepA, voffA);
            PG8_WAIT_L(8); PG8_BAR; PG8_WAIT_L(0); PG8_MMA(0, 0, At, B0); PG8_BAR; PG8_SCHED;
            PG8_LDB(B1, 0, 1); PG8_STAGE(PG8_SB(0, 0), b2, voffB);
            PG8_BAR; PG8_WAIT_L(0); PG8_MMA(0, 1, At, B1); PG8_BAR;
            PG8_LDA(At, 0, 1); PG8_STAGE(PG8_SA(0, 0), a2, voffA);
            PG8_BAR; PG8_WAIT_L(0); PG8_MMA(1, 0, At, B0); PG8_BAR; PG8_SCHED;
            PG8_STAGE(PG8_SB(0, 1), b2 + hstepB, voffB);
            PG8_WAIT_V(6); PG8_BAR; PG8_MMA(1, 1, At, B1); PG8_BAR;
            PG8_LDB(B0, 1, 0); PG8_SCHED; PG8_LDA(At, 1, 0); PG8_STAGE(PG8_SA(0, 1), a2 + hstepA, voffA);
            PG8_WAIT_L(8); PG8_BAR; PG8_WAIT_L(0); PG8_MMA(0, 0, At, B0); PG8_BAR; PG8_SCHED;
            PG8_LDB(B1, 1, 1); PG8_STAGE(PG8_SB(1, 0), b3, voffB);
            PG8_BAR; PG8_WAIT_L(0); PG8_MMA(0, 1, At, B1); PG8_BAR;
            PG8_LDA(At, 1, 1); PG8_STAGE(PG8_SA(1, 0), a3, voffA);
            PG8_BAR; PG8_WAIT_L(0); PG8_MMA(1, 0, At, B0); PG8_BAR; PG8_SCHED;
            PG8_STAGE(PG8_SB(1, 1), b3 + hstepB, voffB);
            PG8_WAIT_V(6); PG8_BAR; PG8_MMA(1, 1, At, B1); PG8_BAR;
            }
        }
        if constexpr (ALIGN_EPI) { if (wr == 0) PG8_BAR; }
        PG8_F8_DRAIN();
        if constexpr (!Epi::AFTER_DRAIN) { E(acc, cur, wr, wc, fr, fq); S.done(cur); }
        if (!has_next) break;
#pragma unroll
        for (int a = 0; a < 2; ++a)
#pragma unroll
            for (int b = 0; b < 2; ++b)
#pragma unroll
                for (int m = 0; m < 4; ++m)
#pragma unroll
                    for (int n = 0; n < 2; ++n) acc[a][b][m][n] = (f32x4){0.f, 0.f, 0.f, 0.f};
        cur = nxt; cA = nA; cB = nB; ++ui;
        if constexpr (ALIGN_EPI) { if (wr == 1) PG8_BAR; }
    }
    PG8_WAIT_V(0);
    if constexpr (!ALIGN_EPI) { if (wr == 0) PG8_BAR; }
    PG8_BAR;
    if constexpr (Epi::AFTER_DRAIN) { E.fused(acc, cur, wr, wc, fr, fq, lds, wid, lane); S.done(cur); }
#undef PG8_SA
#undef PG8_SB
#undef PG8_STAGE
#undef PG8_LDA
#undef PG8_LDB
#undef PG8_MMA
#undef PG8_HALF
#undef PG8_F8_DRAIN
#undef PG8_WAIT_V
#undef PG8_WAIT_L
#undef PG8_BAR
#undef PG8_SCHED
}
}


#ifndef MK_PER_PHASE
#define MK_PER_PHASE 0
#endif

constexpr int NWAVES = 8, NTHR = 512;
constexpr int D = 1024, NBATCH = 2, SEQ = 16384, TL = NBATCH * SEQ, CTXL = 256, TC = NBATCH * CTXL, MR = TL + TC;
constexpr int NPH = 2048, DFF = 2816, NEXP = 8, EFF = 3584, DEPTH = 2;
constexpr float ALPHA = 1.41421356237309515f;
constexpr float LN_EPS = 1e-5f, RMS_EPS = 1e-6f;
constexpr int PH_QA = 0, PH_KA = 128, PH_VA = 256, PH_GA = 512, PH_HY = 768, PH_CQ = 1536, PH_CKV = 1792, PH_KR = 1920, PH_ALR = 1952;

constexpr size_t MiB = 1u << 20;
constexpr size_t WS_CTL = 0, CTL_ZERO_BYTES = 1 * MiB;
constexpr int CW_TMO = 0, CW_BAR = 4096;
constexpr size_t CTL_MODV = 64 * 1024;
constexpr size_t WS_SMALL = 1 * MiB;
constexpr size_t WS_PTRTAB = WS_SMALL + 16 * 1024;
constexpr size_t WS_WIN = 2 * MiB, WS_WOUT = 10 * MiB, WS_W13 = 14 * MiB, WS_W2 = 25 * MiB, WS_WUQ = 31 * MiB, WS_WUKV = 32 * MiB;
constexpr size_t AB = 34 * MiB;
constexpr size_t WS_XN = AB, WS_Y = AB + 65 * MiB, WS_PH = AB + 130 * MiB, WS_Q = AB + 260 * MiB, WS_K = AB + 309 * MiB, WS_V = AB + 358 * MiB;
constexpr size_t WS_VT = AB + 391 * MiB, WS_X1T = AB + 423 * MiB, WS_X2T = AB + 439 * MiB, WS_HF = AB + 455 * MiB, WS_XC = AB + 519 * MiB, WS_END = AB + 521 * MiB;
constexpr size_t WS_G = WS_PH;
static_assert(WS_W13 + (size_t)2 * DFF * D * 2 <= WS_W2 && WS_W2 + (size_t)D * DFF * 2 <= WS_WUQ, "weights map");
static_assert(WS_G + (size_t)MR * DFF * 2 <= WS_K, "G overlay");
static_assert(WS_END <= 573 * MiB, "d_ws budget");

constexpr int LDS_BYTES = 147456, LDS_MISC = 131072 + 320;

#define GAS __attribute__((address_space(1)))
#define LAS __attribute__((address_space(3)))
typedef unsigned short bf16;
typedef unsigned v4u __attribute__((ext_vector_type(4)));
typedef unsigned v2u __attribute__((ext_vector_type(2)));
typedef float f32x4 __attribute__((ext_vector_type(4)));
typedef GAS unsigned gu32;
#define RLX_AGENT __ATOMIC_RELAXED, __HIP_MEMORY_SCOPE_AGENT
#define LDS_WAIT() asm volatile("s_waitcnt lgkmcnt(0)" ::: "memory")
#define VM_WAIT() asm volatile("s_waitcnt vmcnt(0)" ::: "memory")
__device__ __forceinline__ unsigned pk2(float lo, float hi) { return pg8::cvt_pk_bf16(lo, hi); }
__device__ __forceinline__ float bf2f(unsigned short h) { return __uint_as_float((unsigned)h << 16); }
__device__ __forceinline__ float siluf(float x) { return x / (1.f + __expf(-x)); }
#define XB_TMO      128
#define XB_XCNT(j)  (256  + 64 * (j))
#define XB_XSUB(j)  (1280 + 64 * (j))
#define XB_XGEN(j)  (2304 + 64 * (j))
#define XB_TOP      3328
#define XB_TOPGEN   3392
#define XCD_BAR_WORDS 3456
#define XB_SPIN_CAP (1u << 18)

__device__ __forceinline__ unsigned xb_ld(unsigned* p)              { return __hip_atomic_load(p, __ATOMIC_RELAXED, __HIP_MEMORY_SCOPE_AGENT); }
__device__ __forceinline__ unsigned xb_add(unsigned* p, unsigned v) { return __hip_atomic_fetch_add(p, v, __ATOMIC_RELAXED, __HIP_MEMORY_SCOPE_AGENT); }
__device__ __forceinline__ unsigned xb_xcc_id() { return (unsigned)__builtin_amdgcn_s_getreg((3 << 11) | 20) & 0xFu; }
#define XB_SPIN(cond, bar) do { unsigned _sp = 0; while (cond) { __builtin_amdgcn_s_sleep(1); \
    if ((++_sp & 255u) == 0u) { if (xb_ld(&(bar)[XB_TMO])) break; if (_sp > XB_SPIN_CAP) { atomicAdd(&(bar)[XB_TMO], 1u); break; } } } } while (0)

struct XcdBarrier {
    unsigned* bar; unsigned x;
    volatile LAS unsigned* st;
};

__device__ __forceinline__ XcdBarrier xcd_barrier_post(unsigned* bar, volatile LAS unsigned* st) {
    XcdBarrier b; b.bar = bar; b.x = xb_xcc_id(); b.st = st;
    if (threadIdx.x == 0) (void)xb_add(&bar[XB_XCNT(b.x)], 1u);
    return b;
}
__device__ __forceinline__ void xcd_barrier_complete(unsigned* bar, unsigned x, unsigned& nloc, unsigned& nx) {
    const unsigned G = gridDim.x * gridDim.y * gridDim.z;
    unsigned sum, cnt, mine, sp = 0u;
    for (;;) {
        sum = 0u; cnt = 0u; mine = 0u;
#pragma unroll
        for (unsigned j = 0; j < 16; ++j) { const unsigned c = xb_ld(&bar[XB_XCNT(j)]); sum += c; cnt += (c > 0u) ? 1u : 0u; mine = (j == x) ? c : mine; }
        if (sum == G) break;
        __builtin_amdgcn_s_sleep(1);
        if ((++sp & 255u) == 0u) { if (xb_ld(&bar[XB_TMO])) break; if (sp > XB_SPIN_CAP) { atomicAdd(&bar[XB_TMO], 1u); break; } }
    }
    nloc = mine > 0u ? mine : 1u; nx = cnt > 0u ? cnt : 1u;
}

__device__ __forceinline__ void xcd_barrier(const XcdBarrier& b) {
    asm volatile("s_waitcnt vmcnt(0)" ::: "memory");
    __syncthreads();
    if (threadIdx.x == 0) {
        unsigned* bar = b.bar;
        __builtin_amdgcn_s_waitcnt(0);
        unsigned nloc = b.st[0], nx = b.st[1];
        if (nloc == 0u) { xcd_barrier_complete(bar, b.x, nloc, nx); b.st[0] = nloc; b.st[1] = nx; }
        const unsigned old = xb_add(&bar[XB_XSUB(b.x)], 1u);
        const unsigned gen = old / nloc;
        if (old + 1u == (gen + 1u) * nloc) {
            __builtin_amdgcn_fence(__ATOMIC_RELEASE, "agent");
            asm volatile("s_waitcnt vmcnt(0)" ::: "memory");
            const unsigned og = xb_add(&bar[XB_TOP], 1u);
            const unsigned tg = og / nx;
            if (og + 1u == (tg + 1u) * nx) xb_add(&bar[XB_TOPGEN], 1u);
            else XB_SPIN(xb_ld(&bar[XB_TOPGEN]) == tg, bar);
            __builtin_amdgcn_fence(__ATOMIC_ACQUIRE, "agent");
            xb_add(&bar[XB_XGEN(b.x)], 1u);
            asm volatile("s_waitcnt vmcnt(0)" ::: "memory");
        } else {
            XB_SPIN(xb_ld(&bar[XB_XGEN(b.x)]) == gen, bar);
            __builtin_amdgcn_fence(__ATOMIC_ACQUIRE, "agent");
            asm volatile("s_waitcnt vmcnt(0)" ::: "memory");
        }
    }
    __syncthreads();
}

struct Args { const GAS float* in[37]; GAS float* out; GAS unsigned char* ws; int ph_lo, ph_hi; };
enum In { I_X = 0, I_C, I_CTX, I_CCTX, I_WMOD, I_BMOD, I_WIN, I_GWG, I_GBG, I_GNG, I_HCW, I_HCB, I_HW1, I_HB1, I_HF1, I_HW2, I_HB2, I_HF2, I_HW3, I_HB3, I_HSKIP, I_HNG,
          I_QNG, I_WUQ, I_KVNG, I_WUKV, I_MNG, I_WOUT, I_LNG, I_LNB, I_FW1, I_FW3, I_FW2, I_ROUTER, I_MW1, I_MW3, I_MW2 };

struct Frame {
    LAS unsigned char* lds; GAS unsigned char* ws; gu32* ctl; const GAS float* const GAS* in; GAS float* out;
    int tid, lane, wave, G, gw, ngw;
};
__device__ __forceinline__ Frame launder(const Frame& F0) { Frame F = F0; int t = F0.tid; size_t z = 0; asm volatile("" : "+v"(t), "+s"(z)); F.tid = t; F.lane = t & 63; F.ws = F0.ws + z; F.ctl = (gu32*)(F.ws + WS_CTL); F.out = F0.out + z; return F; }
__device__ __forceinline__ float wave_sum(float v) {
#pragma unroll
    for (int o = 1; o < 64; o <<= 1) v += __shfl_xor(v, o);
    return v;
}
template <int CTRL, int RM> __device__ __forceinline__ float wdpp(float v) { return __int_as_float(__builtin_amdgcn_update_dpp(0, __float_as_int(v), CTRL, RM, 0xf, false)); }
__device__ __forceinline__ float wave_sum_dpp(float v) {
    v += wdpp<0x111, 0xf>(v); v += wdpp<0x112, 0xf>(v); v += wdpp<0x114, 0xf>(v); v += wdpp<0x118, 0xf>(v); v += wdpp<0x142, 0xa>(v); v += wdpp<0x143, 0xc>(v);
    return __int_as_float(__builtin_amdgcn_readlane(__float_as_int(v), 63));
}
__device__ __forceinline__ const GAS float* modv(const Frame& F, int l, int v, int i) { return (const GAS float*)(F.ws + CTL_MODV) + ((size_t)(l * 3 + v) * 6 + i) * D; }
__device__ __forceinline__ int row_v(int row) { return row < TL ? (row >> 14) : 2; }

__device__ __forceinline__ void p0_modv(const Frame& F0) { const Frame F = launder(F0);
    const GAS float* c = F.in[I_C]; const GAS float* cc = F.in[I_CCTX]; const GAS float* wm = F.in[I_WMOD]; const GAS float* bm = F.in[I_BMOD];
    GAS float* mv = (GAS float*)(F.ws + CTL_MODV); LAS float* part = (LAS float*)F.lds;
    constexpr int NBLK = 6 * D / 64, NITEM = DEPTH * NBLK;
    for (int it = blockIdx.x; it < NITEM; it += F.G) {
        const int l = it / NBLK, nb = it % NBLK, n = nb * 64 + F.lane, k0 = F.wave * 128;
        const float s0a = siluf(c[k0 + F.lane]), s1a = siluf(c[D + k0 + F.lane]), s2a = siluf(cc[k0 + F.lane]);
        const float s0b = siluf(c[k0 + 64 + F.lane]), s1b = siluf(c[D + k0 + 64 + F.lane]), s2b = siluf(cc[k0 + 64 + F.lane]);
        float a0 = 0.f, a1 = 0.f, a2 = 0.f;
        const GAS float* w = wm + ((size_t)l * D + k0) * (6 * D) + n;
#pragma unroll 16
        for (int kk = 0; kk < 64; ++kk) { const float wv = w[(size_t)kk * (6 * D)]; a0 += __shfl(s0a, kk) * wv; a1 += __shfl(s1a, kk) * wv; a2 += __shfl(s2a, kk) * wv; }
#pragma unroll 16
        for (int kk = 0; kk < 64; ++kk) { const float wv = w[(size_t)(64 + kk) * (6 * D)]; a0 += __shfl(s0b, kk) * wv; a1 += __shfl(s1b, kk) * wv; a2 += __shfl(s2b, kk) * wv; }
        part[(F.wave * 3 + 0) * 64 + F.lane] = a0; part[(F.wave * 3 + 1) * 64 + F.lane] = a1; part[(F.wave * 3 + 2) * 64 + F.lane] = a2;
        __syncthreads();
        if (F.tid < 192) { const int v = F.tid >> 6, ln = F.tid & 63; float acc = bm[l * 6 * D + nb * 64 + ln];
#pragma unroll
            for (int wv = 0; wv < 8; ++wv) acc += part[(wv * 3 + v) * 64 + ln];
            mv[(size_t)(l * 3 + v) * 6 * D + nb * 64 + ln] = acc; }
        __syncthreads();
    }
}
template <class RowMap>
__device__ __forceinline__ void transpose_item(const GAS float* W, int N, GAS bf16* WT, int ldk, LAS float* scr, int item, int lane, const RowMap& rm, const GAS float* ks) {
    const int nblk = N / 32, kb = item / nblk, nb = item % nblk, k0 = 64 * kb, n0 = 32 * nb;
#pragma unroll 8
    for (int i = 0; i < 32; ++i) { const int kk = 2 * i + (lane >> 5); float v = W[(size_t)(k0 + kk) * N + n0 + (lane & 31)]; if (ks) v *= ks[k0 + kk]; scr[kk * 33 + (lane & 31)] = v; }
    LDS_WAIT(); asm volatile("" ::: "memory");
    const int c = lane & 7;
#pragma unroll
    for (int j = 0; j < 4; ++j) { const int n = (lane >> 3) + 8 * j; const LAS float* s = scr + (8 * c) * 33 + n;
        v4u o; o.x = pk2(s[0 * 33], s[1 * 33]); o.y = pk2(s[2 * 33], s[3 * 33]); o.z = pk2(s[4 * 33], s[5 * 33]); o.w = pk2(s[6 * 33], s[7 * 33]);
        *(GAS v4u*)(WT + (size_t)rm(n0 + n) * ldk + k0 + 8 * c) = o; }
    LDS_WAIT(); asm volatile("" ::: "memory");
}
__device__ __forceinline__ float clamp448(float x) { return fminf(fmaxf(x, -448.f), 448.f); }
__device__ __forceinline__ unsigned pk4_fp8(float a, float b, float c, float d) { unsigned w = 0; w = __builtin_amdgcn_cvt_pk_fp8_f32(clamp448(a), clamp448(b), w, false); w = __builtin_amdgcn_cvt_pk_fp8_f32(clamp448(c), clamp448(d), w, true); return w; }
template <class RowMap>
__device__ __forceinline__ void transpose_item_f8(const GAS float* W, int N, GAS unsigned char* WT, int ldk, LAS float* scr, int item, int lane, const RowMap& rm, float scale) {
    const int nblk = N / 32, kb = item / nblk, nb = item % nblk, k0 = 64 * kb, n0 = 32 * nb;
#pragma unroll 8
    for (int i = 0; i < 32; ++i) { const int kk = 2 * i + (lane >> 5); scr[kk * 33 + (lane & 31)] = W[(size_t)(k0 + kk) * N + n0 + (lane & 31)] * scale; }
    LDS_WAIT(); asm volatile("" ::: "memory");
    const int c = lane & 7;
#pragma unroll
    for (int j = 0; j < 4; ++j) { const int n = (lane >> 3) + 8 * j; const LAS float* s = scr + (8 * c) * 33 + n;
        v2u o; o.x = pk4_fp8(s[0 * 33], s[1 * 33], s[2 * 33], s[3 * 33]); o.y = pk4_fp8(s[4 * 33], s[5 * 33], s[6 * 33], s[7 * 33]);
        *(GAS v2u*)(WT + (size_t)rm(n0 + n) * ldk + k0 + 8 * c) = o; }
    LDS_WAIT(); asm volatile("" ::: "memory");
}
struct RmIdent { int off; __device__ int operator()(int n) const { return n + off; } };
struct RmWin { __device__ int operator()(int c) const {
    if (c < 768) return c; if (c < 800) return PH_ALR + (c - 768); if (c < 1568) return PH_HY + (c - 800); if (c < 1824) return PH_CQ + (c - 1568); if (c < 1952) return PH_CKV + (c - 1824); return PH_KR + (c - 1952); } };
struct RmGlu { int half; __device__ int operator()(int j) const { return (j >> 2) * 8 + half * 4 + (j & 3); } };

__device__ __forceinline__ void p0_weights(const Frame& F0) { const Frame F = launder(F0);
    LAS float* scr = (LAS float*)(F.lds + F.wave * 16384);
    GAS bf16* WIN = (GAS bf16*)(F.ws + WS_WIN); GAS bf16* WOUT = (GAS bf16*)(F.ws + WS_WOUT); GAS bf16* W13 = (GAS bf16*)(F.ws + WS_W13); GAS bf16* W2 = (GAS bf16*)(F.ws + WS_W2);
    GAS bf16* WUQ = (GAS bf16*)(F.ws + WS_WUQ); GAS bf16* WUKV = (GAS bf16*)(F.ws + WS_WUKV);
    constexpr int I_IN = (D / 64) * (1984 / 32), I_OUT = (D / 64) * (D / 32), I_F1 = (D / 64) * (DFF / 32), I_F2 = (DFF / 64) * (D / 32), I_UQ = (256 / 64) * (768 / 32), I_UKV = (128 / 64) * (1024 / 32);
    constexpr int NITEM = DEPTH * I_IN + DEPTH * I_OUT + 2 * I_F1 + I_F2 + DEPTH * I_UQ + DEPTH * I_UKV;
    for (int it = F.gw; it < NITEM; it += F.ngw) {
        int r = it;
        if (r < DEPTH * I_IN) { const int l = r / I_IN; transpose_item(F.in[I_WIN] + (size_t)l * D * 1984, 1984, WIN + (size_t)l * NPH * D, D, scr, r % I_IN, F.lane, RmWin{}, nullptr); continue; } r -= DEPTH * I_IN;
        if (r < DEPTH * I_OUT) { const int l = r / I_OUT; transpose_item(F.in[I_WOUT] + (size_t)l * D * D, D, WOUT + (size_t)l * D * D, D, scr, r % I_OUT, F.lane, RmIdent{0}, nullptr); continue; } r -= DEPTH * I_OUT;
        if (r < I_F1) { transpose_item(F.in[I_FW1], DFF, W13, D, scr, r, F.lane, RmGlu{0}, nullptr); continue; } r -= I_F1;
        if (r < I_F1) { transpose_item(F.in[I_FW3], DFF, W13, D, scr, r, F.lane, RmGlu{1}, nullptr); continue; } r -= I_F1;
        if (r < I_F2) { transpose_item(F.in[I_FW2], D, W2, DFF, scr, r, F.lane, RmIdent{0}, nullptr); continue; } r -= I_F2;
        if (r < DEPTH * I_UQ) { const int l = r / I_UQ; transpose_item(F.in[I_WUQ] + (size_t)l * 256 * 768, 768, WUQ + (size_t)l * 768 * 256, 256, scr, r % I_UQ, F.lane, RmIdent{0}, F.in[I_QNG] + l * 256); continue; } r -= DEPTH * I_UQ;
        { const int l = r / I_UKV; transpose_item(F.in[I_WUKV] + (size_t)l * 128 * 1024, 1024, WUKV + (size_t)l * 1024 * 256, 256, scr, r % I_UKV, F.lane, RmIdent{0}, F.in[I_KVNG] + l * 128); }
    }
    const int gt = blockIdx.x * NTHR + F.tid, ngt = F.G * NTHR;
    for (int i = gt; i < DEPTH * 64 * D / 8; i += ngt) { const int l = i / (64 * D / 8), r = i % (64 * D / 8); *(GAS v4u*)(WIN + ((size_t)l * NPH + 1984) * D + (size_t)r * 8) = (v4u){0u, 0u, 0u, 0u}; }
    for (int i = gt; i < DEPTH * 1024 * 128 / 8; i += ngt) { const int row = i / 16, c = i % 16; *(GAS v4u*)(WUKV + (size_t)row * 256 + 128 + c * 8) = (v4u){0u, 0u, 0u, 0u}; }
}

__device__ __forceinline__ void mod_store_bf16(const f32x4 (&v)[4], const GAS float* sh, const GAS float* sc, GAS bf16* orow, int lane) {
    GAS unsigned long long* o8 = (GAS unsigned long long*)orow + lane;
#pragma unroll
    for (int j = 0; j < 4; ++j) { const f32x4 a = ((const GAS f32x4*)sc)[lane + 64 * j], b = ((const GAS f32x4*)sh)[lane + 64 * j];
        const f32x4 y = v[j] * (a + 1.f) + b;
        o8[64 * j] = (unsigned long long)pk2(y.x, y.y) | ((unsigned long long)pk2(y.z, y.w) << 32); }
}
__device__ __forceinline__ void p_xn0(const Frame& F0) { const Frame F = launder(F0);
    GAS bf16* XN = (GAS bf16*)(F.ws + WS_XN);
    f32x4 nx[4];
#define XN0_LOAD(mm) do { const GAS float* src_ = (mm) < TL ? F.in[I_X] + (size_t)(mm) * D : F.in[I_CTX] + (size_t)((mm) - TL) * D; _Pragma("unroll") for (int j = 0; j < 4; ++j) nx[j] = ((const GAS f32x4*)src_)[F.lane + 64 * j]; } while (0)
    int m = F.gw; if (m < MR) XN0_LOAD(m);
    for (; m < MR; m += F.ngw) {
        f32x4 v[4];
#pragma unroll
        for (int j = 0; j < 4; ++j) v[j] = nx[j];
        if (m + F.ngw < MR) XN0_LOAD(m + F.ngw);
        const int vv = row_v(m);
        mod_store_bf16(v, modv(F, 0, vv, 0), modv(F, 0, vv, 1), XN + (size_t)m * D, F.lane);
    }
#undef XN0_LOAD
}
__device__ __forceinline__ GAS float* xres(const Frame& F, int row) { return row < TL ? F.out + (size_t)row * D : (GAS float*)(F.ws + WS_XC) + (size_t)(row - TL) * D; }
__device__ __forceinline__ void p_ln(const Frame& F0, int nrows, const GAS float* g, const GAS float* b, bool want_xn, int ml, int si) { const Frame F = launder(F0);
    GAS bf16* XN = (GAS bf16*)(F.ws + WS_XN);
    f32x4 nx[4];
    int m = F.gw; if (m < nrows) { const GAS float* r_ = xres(F, m);
#pragma unroll
        for (int j = 0; j < 4; ++j) nx[j] = ((const GAS f32x4*)r_)[F.lane + 64 * j]; }
    for (; m < nrows; m += F.ngw) {
        GAS float* row = xres(F, m);
        f32x4 v[4]; float s = 0.f;
#pragma unroll
        for (int j = 0; j < 4; ++j) { v[j] = nx[j]; s += (v[j].x + v[j].y) + (v[j].z + v[j].w); }
        if (m + F.ngw < nrows) { const GAS float* r_ = xres(F, m + F.ngw);
#pragma unroll
            for (int j = 0; j < 4; ++j) nx[j] = ((const GAS f32x4*)r_)[F.lane + 64 * j]; }
        const float mean = wave_sum(s) * (1.f / D); float s2 = 0.f;
#pragma unroll
        for (int j = 0; j < 4; ++j) { v[j] = v[j] - mean; s2 += (v[j].x * v[j].x + v[j].y * v[j].y) + (v[j].z * v[j].z + v[j].w * v[j].w); }
        const float rstd = 1.f / sqrtf(wave_sum(s2) * (1.f / D) + LN_EPS);
#pragma unroll
        for (int j = 0; j < 4; ++j) { const f32x4 gg = ((const GAS f32x4*)g)[F.lane + 64 * j], bb = ((const GAS f32x4*)b)[F.lane + 64 * j]; v[j] = v[j] * rstd * gg + bb; ((GAS f32x4*)row)[F.lane + 64 * j] = v[j]; }
        if (want_xn) { const int vv = row_v(m); mod_store_bf16(v, modv(F, ml, vv, si), modv(F, ml, vv, si + 1), XN + (size_t)m * D, F.lane); }
    }
}

using pg8::f32x4; using pg8::Unit;
struct EpiStoreBf16 {
    static constexpr bool PERM = true, AFTER_DRAIN = false;
    GAS bf16* O; int ldc; float sc;
    __device__ __forceinline__ void operator()(const pg8::f32x4 (&acc)[2][2][4][2], const Unit& u, int wr, int wc, int fr, int fq) const {
        const int row0 = u.pm * 256 + wr * 64 + fr, col0 = u.pn * 256 + wc * 32 + 8 * fq;
#pragma unroll
        for (int ai = 0; ai < 2; ++ai)
#pragma unroll
            for (int m = 0; m < 4; ++m) { GAS bf16* rowp = O + (size_t)(row0 + ai * 128 + m * 16) * ldc + col0;
#pragma unroll
                for (int bj = 0; bj < 2; ++bj) { const pg8::f32x4 v0 = acc[ai][bj][m][0] * sc, v1 = acc[ai][bj][m][1] * sc;
                    v4u w; w.x = pk2(v0[0], v0[1]); w.y = pk2(v0[2], v0[3]); w.z = pk2(v1[0], v1[1]); w.w = pk2(v1[2], v1[3]);
                    *(GAS v4u*)(rowp + bj * 128) = w; } }
    }
};
struct EpiSwiglu {
    static constexpr bool PERM = true, AFTER_DRAIN = false;
    GAS bf16* G; int ldg; float sc;
    __device__ __forceinline__ void operator()(const pg8::f32x4 (&acc)[2][2][4][2], const Unit& u, int wr, int wc, int fr, int fq) const {
        const int row0 = u.pm * 256 + wr * 64 + fr, col0 = (u.pn * 256 + wc * 32 + 8 * fq) >> 1;
#pragma unroll
        for (int ai = 0; ai < 2; ++ai)
#pragma unroll
            for (int m = 0; m < 4; ++m) { GAS bf16* rowp = G + (size_t)(row0 + ai * 128 + m * 16) * ldg + col0;
#pragma unroll
                for (int bj = 0; bj < 2; ++bj) { const pg8::f32x4 a = acc[ai][bj][m][0] * sc, b = acc[ai][bj][m][1] * sc;
                    v2u w; w.x = pk2(siluf(a[0]) * b[0], siluf(a[1]) * b[1]); w.y = pk2(siluf(a[2]) * b[2], siluf(a[3]) * b[3]);
                    *(GAS v2u*)(rowp + bj * 64) = w; } }
    }
};
struct EpiSwiglu8 {
    static constexpr bool PERM = true, AFTER_DRAIN = false;
    GAS unsigned char* G; int ldg; float sc, osc;
    __device__ __forceinline__ void operator()(const pg8::f32x4 (&acc)[2][2][4][2], const Unit& u, int wr, int wc, int fr, int fq) const {
        const int row0 = u.pm * 256 + wr * 64 + fr, col0 = (u.pn * 256 + wc * 32 + 8 * fq) >> 1;
#pragma unroll
        for (int ai = 0; ai < 2; ++ai)
#pragma unroll
            for (int m = 0; m < 4; ++m) { GAS unsigned char* rowp = G + (size_t)(row0 + ai * 128 + m * 16) * ldg + col0;
#pragma unroll
                for (int bj = 0; bj < 2; ++bj) { const pg8::f32x4 a = acc[ai][bj][m][0] * sc, b = acc[ai][bj][m][1] * sc;
                    *(GAS unsigned*)(rowp + bj * 64) = pk4_fp8(siluf(a[0]) * b[0] * osc, siluf(a[1]) * b[1] * osc, siluf(a[2]) * b[2] * osc, siluf(a[3]) * b[3] * osc); } }
    }
};
struct EpiRes {
    static constexpr bool PERM = false, AFTER_DRAIN = false;
    const GAS float* xin_lat; const GAS float* xin_ctx; GAS float* out_lat; GAS float* out_ctx; const GAS float* gate0;
    __device__ __forceinline__ void operator()(const pg8::f32x4 (&acc)[2][2][4][2], const Unit& u, int wr, int wc, int fr, int fq) const {
        const bool lat = u.pm < TL / 256; const int v = lat ? (u.pm >> 6) : 2;
        const GAS float* xin = lat ? xin_lat : xin_ctx - (size_t)TL * D; GAS float* out = lat ? out_lat : out_ctx - (size_t)TL * D;
        const GAS float* gate = gate0 + (size_t)v * 6 * D;
        const int row0 = u.pm * 256 + wr * 64 + fr, col0 = u.pn * 256 + wc * 32 + 4 * fq;
        pg8::f32x4 gv[2][2];
#pragma unroll
        for (int bj = 0; bj < 2; ++bj)
#pragma unroll
            for (int n = 0; n < 2; ++n) gv[bj][n] = *(const GAS pg8::f32x4*)(gate + col0 + bj * 128 + n * 16);
#pragma unroll
        for (int ai = 0; ai < 2; ++ai)
#pragma unroll
            for (int m = 0; m < 4; ++m) { const size_t off = (size_t)(row0 + ai * 128 + m * 16) * D + col0;
#pragma unroll
                for (int bj = 0; bj < 2; ++bj)
#pragma unroll
                    for (int n = 0; n < 2; ++n) { const pg8::f32x4 xv = *(const GAS pg8::f32x4*)(xin + off + bj * 128 + n * 16);
                        *(GAS pg8::f32x4*)(out + off + bj * 128 + n * 16) = xv * ALPHA + gv[bj][n] * acc[ai][bj][m][n]; } }
    }
};


constexpr int CW_MOECNT = 2048;
constexpr size_t WS_TI = WS_SMALL + 64 * 1024;
constexpr int MOE_CHUNK_TILES = 64, MOE_NCHUNK = 5, MOE_MAXROWS = MOE_NCHUNK * MOE_CHUNK_TILES * 256;
constexpr size_t WS_HS = AB + 65 * MiB, WS_WM13 = AB + 197 * MiB, WS_WM2 = AB + 309 * MiB, WS_GC = AB + 365 * MiB;
constexpr size_t WS_H8 = WS_XN, WS_HS8 = WS_HS + 66 * MiB;
constexpr float MOE_WSCALE = 64.f, MOE_GSCALE = 16.f, MOE_W2SCALE = 256.f;
static_assert(WS_HS + (size_t)(2 * TL + NEXP * 256) * D * 2 <= WS_WM13 && WS_WM13 + (size_t)NEXP * 2 * EFF * D * 2 <= WS_WM2 && WS_WM2 + (size_t)NEXP * D * EFF * 2 <= WS_GC && WS_GC + (size_t)MOE_CHUNK_TILES * 256 * EFF * 2 <= WS_XC, "MoE map");

__device__ __forceinline__ void p_ln_route(const Frame& F0, const GAS float* g, const GAS float* b, int l) { const Frame F = launder(F0);
    GAS bf16* XN = (GAS bf16*)(F.ws + WS_XN);
    GAS int* TI_E = (GAS int*)(F.ws + WS_TI); GAS int* TI_P0 = TI_E + TL; GAS int* TI_P1 = TI_P0 + TL; GAS float* TI_W0 = (GAS float*)(TI_P1 + TL); GAS float* TI_W1 = TI_W0 + TL;
    const GAS float* wr = F.in[I_ROUTER];
    f32x4 rw[4][4][2];
#pragma unroll
    for (int j = 0; j < 4; ++j) { const GAS f32x4* w4 = (const GAS f32x4*)(wr + (size_t)(4 * F.lane + 256 * j) * NEXP);
#pragma unroll
        for (int i = 0; i < 4; ++i) { rw[j][i][0] = w4[2 * i]; rw[j][i][1] = w4[2 * i + 1]; } }
    f32x4 nx[4];
    int e0r = 0, e1r = 0, it = 0;
    int m = F.gw; if (m < TL) {
#pragma unroll
        for (int j = 0; j < 4; ++j) nx[j] = ((const GAS f32x4*)(F.out + (size_t)m * D))[F.lane + 64 * j]; }
    for (; m < TL; m += F.ngw) {
        GAS float* row = F.out + (size_t)m * D;
        f32x4 v[4]; float s = 0.f;
#pragma unroll
        for (int j = 0; j < 4; ++j) { v[j] = nx[j]; s += (v[j].x + v[j].y) + (v[j].z + v[j].w); }
        if (m + F.ngw < TL) {
#pragma unroll
            for (int j = 0; j < 4; ++j) nx[j] = ((const GAS f32x4*)(F.out + (size_t)(m + F.ngw) * D))[F.lane + 64 * j]; }
        const float mean = wave_sum_dpp(s) * (1.f / D); float s2 = 0.f;
#pragma unroll
        for (int j = 0; j < 4; ++j) { v[j] = v[j] - mean; s2 += (v[j].x * v[j].x + v[j].y * v[j].y) + (v[j].z * v[j].z + v[j].w * v[j].w); }
        const float rstd = 1.f / sqrtf(wave_sum_dpp(s2) * (1.f / D) + LN_EPS);
        const int vv = row_v(m); const GAS float* sh = modv(F, l, vv, 3); const GAS float* sc = modv(F, l, vv, 4);
        GAS unsigned* h8 = (GAS unsigned*)(F.ws + WS_H8 + (size_t)m * D) + F.lane;
        float lg[NEXP];
#pragma unroll
        for (int e = 0; e < NEXP; ++e) lg[e] = 0.f;
#pragma unroll
        for (int j = 0; j < 4; ++j) { const f32x4 gg = ((const GAS f32x4*)g)[F.lane + 64 * j], bb = ((const GAS f32x4*)b)[F.lane + 64 * j]; v[j] = v[j] * rstd * gg + bb; ((GAS f32x4*)row)[F.lane + 64 * j] = v[j];
            const f32x4 a = ((const GAS f32x4*)sc)[F.lane + 64 * j], c = ((const GAS f32x4*)sh)[F.lane + 64 * j];
            const f32x4 y = v[j] * (a + 1.f) + c;
            h8[64 * j] = pk4_fp8(y.x, y.y, y.z, y.w);
#pragma unroll
            for (int i = 0; i < 4; ++i) { const f32x4 wa = rw[j][i][0], wb = rw[j][i][1]; const float yi = y[i];
                lg[0] += yi * wa.x; lg[1] += yi * wa.y; lg[2] += yi * wa.z; lg[3] += yi * wa.w; lg[4] += yi * wb.x; lg[5] += yi * wb.y; lg[6] += yi * wb.z; lg[7] += yi * wb.w; } }
#pragma unroll
        for (int e = 0; e < NEXP; ++e) lg[e] = wave_sum_dpp(lg[e]);
        int i0 = 0; float v0 = lg[0];
#pragma unroll
        for (int e = 1; e < NEXP; ++e) if (lg[e] > v0) { v0 = lg[e]; i0 = e; }
        int i1 = -1; float v1 = -3.0e38f;
#pragma unroll
        for (int e = 0; e < NEXP; ++e) if (e != i0 && lg[e] > v1) { v1 = lg[e]; i1 = e; }
        if (F.lane == 0) { const float w0 = 1.f / (1.f + __expf(v1 - v0)); TI_E[m] = i0 | (i1 << 8); TI_W0[m] = w0; TI_W1[m] = 1.f - w0; }
        if (F.lane == it) { e0r = i0; e1r = i1; }
        ++it;
    }
    {
        const bool act = F.lane < it; int rk0 = 0, rk1 = 0, mycnt = 0;
#pragma unroll
        for (int e = 0; e < NEXP; ++e) { const unsigned long long m0 = __ballot(act && e0r == e), m1 = __ballot(act && e1r == e);
            const int n0 = __popcll(m0), n1 = __popcll(m1);
            const int b0 = (int)__builtin_amdgcn_mbcnt_hi((unsigned)(m0 >> 32), __builtin_amdgcn_mbcnt_lo((unsigned)m0, 0u)), b1 = (int)__builtin_amdgcn_mbcnt_hi((unsigned)(m1 >> 32), __builtin_amdgcn_mbcnt_lo((unsigned)m1, 0u));
            if (e0r == e) rk0 = b0; if (e1r == e) rk1 = n0 + b1; if (F.lane == e) mycnt = n0 + n1; }
        int mybase = 0;
        if (F.lane < NEXP && mycnt > 0) mybase = (int)__hip_atomic_fetch_add((GAS unsigned*)F.ctl + CW_MOECNT + 64 * F.lane, (unsigned)mycnt, RLX_AGENT);
        const int p0 = __shfl(mybase, e0r) + rk0, p1 = __shfl(mybase, e1r) + rk1;
        if (act) { const int mr = F.gw + F.lane * F.ngw; TI_P0[mr] = p0; TI_P1[mr] = p1; }
    }
}
struct MoeBase { int bt[NEXP + 1]; };
__device__ __forceinline__ MoeBase moe_base(const Frame& F) {
    MoeBase B; int acc = 0;
#pragma unroll
    for (int e = 0; e < NEXP; ++e) { B.bt[e] = acc; const unsigned c = __hip_atomic_load((GAS unsigned*)F.ctl + CW_MOECNT + 64 * e, RLX_AGENT); acc += (int)((c + 255u) >> 8); }
    B.bt[NEXP] = acc; return B;
}
__device__ __forceinline__ void p_moe_weights(const Frame& F0) { const Frame F = launder(F0);
    LAS float* scr = (LAS float*)(F.lds + F.wave * 16384);
    GAS unsigned char* WM13 = F.ws + WS_WM13; GAS unsigned char* WM2 = F.ws + WS_WM2;
    constexpr int I1 = (D / 64) * (EFF / 32), I2 = (EFF / 64) * (D / 32), NITEM = NEXP * (2 * I1 + I2);
    for (int it = F.gw; it < NITEM; it += F.ngw) {
        const int e = it / (2 * I1 + I2); int r = it % (2 * I1 + I2);
        if (r < I1) { transpose_item_f8(F.in[I_MW1] + (size_t)e * D * EFF, EFF, WM13 + (size_t)e * 2 * EFF * D, D, scr, r, F.lane, RmGlu{0}, MOE_WSCALE); continue; } r -= I1;
        if (r < I1) { transpose_item_f8(F.in[I_MW3] + (size_t)e * D * EFF, EFF, WM13 + (size_t)e * 2 * EFF * D, D, scr, r, F.lane, RmGlu{1}, MOE_WSCALE); continue; } r -= I1;
        transpose_item_f8(F.in[I_MW2] + (size_t)e * EFF * D, D, WM2 + (size_t)e * D * EFF, EFF, scr, r, F.lane, RmIdent{0}, MOE_W2SCALE);
    }
}
__device__ __forceinline__ void p_moe_scatter(const Frame& F0) { const Frame F = launder(F0);
    const MoeBase B = moe_base(F);
    const GAS unsigned char* H8 = F.ws + WS_H8; GAS unsigned char* HS8 = F.ws + WS_HS8;
    GAS int* TI_E = (GAS int*)(F.ws + WS_TI); GAS int* TI_P0 = TI_E + TL; GAS int* TI_P1 = TI_P0 + TL;
    for (int m = F.gw; m < TL; m += F.ngw) {
        const int ee = TI_E[m], e0 = ee & 255, e1 = ee >> 8;
        int b0 = 0, b1 = 0;
#pragma unroll
        for (int e = 0; e < NEXP; ++e) { if (e == e0) b0 = B.bt[e]; if (e == e1) b1 = B.bt[e]; }
        const int s0 = b0 * 256 + TI_P0[m], s1 = b1 * 256 + TI_P1[m];
        const v4u a = *((const GAS v4u*)(H8 + (size_t)m * D) + F.lane);
        *((GAS v4u*)(HS8 + (size_t)s0 * D) + F.lane) = a; *((GAS v4u*)(HS8 + (size_t)s1 * D) + F.lane) = a;
        if (F.lane == 0) { TI_P0[m] = s0; TI_P1[m] = s1; }
    }
}
constexpr int LDS_MOEBT = LDS_MISC + 64;
__device__ __forceinline__ void moe_base_to_lds(const Frame& F) {
    if (F.tid == 0) { volatile LAS int* bt = (volatile LAS int*)(F.lds + LDS_MOEBT); int acc = 0;
        for (int e = 0; e < NEXP; ++e) { bt[e] = acc; const unsigned c = __hip_atomic_load((GAS unsigned*)F.ctl + CW_MOECNT + 64 * e, RLX_AGENT); acc += (int)((c + 255u) >> 8); }
        bt[NEXP] = acc; }
    __syncthreads();
}
struct MoeOrder {
    int nM, nN, nwg, G, c, tile0; const LAS int* bt;
    __device__ void init(const LAS int* bt_, int chunk, int nN_, int G_, int c_) {
        bt = bt_; tile0 = chunk * MOE_CHUNK_TILES; int v = bt[NEXP] - tile0; nM = v < 0 ? 0 : (v > MOE_CHUNK_TILES ? MOE_CHUNK_TILES : v); nN = nN_; nwg = nM * nN; G = G_; c = c_; }
    __device__ bool next(int i, pg8::Unit& u) const {
        const long L = (long)i * G + c; if (L >= nwg) return false;
        int wgid = (int)L; { const int q = nwg / pg8::NXCD, r = nwg % pg8::NXCD, xcd = wgid % pg8::NXCD, off = wgid / pg8::NXCD; wgid = (xcd < r ? xcd * (q + 1) : r * (q + 1) + (xcd - r) * q) + off; }
        const int nig = pg8::WGM * nN, gid = wgid / nig, fm = gid * pg8::WGM, gsz = (nM - fm) < pg8::WGM ? (nM - fm) : pg8::WGM;
        u.pm = fm + ((wgid % nig) % gsz); u.pn = (wgid % nig) / gsz;
        const int gt = tile0 + u.pm; int e = 0;
#pragma unroll
        for (int k = 1; k < NEXP; ++k) e += (gt >= bt[k]) ? 1 : 0;
        u.be = __builtin_amdgcn_readfirstlane(e); return true;
    }
    __device__ __forceinline__ void a_ready(const pg8::Unit&) const {}
    __device__ __forceinline__ void done(const pg8::Unit&) const {}
};
__device__ __forceinline__ void p_ln_combine(const Frame& F0, const GAS float* g, const GAS float* b, int l) { const Frame F = launder(F0);
    const GAS bf16* YS = (const GAS bf16*)(F.ws + WS_HS);
    GAS int* TI_E = (GAS int*)(F.ws + WS_TI); GAS int* TI_P0 = TI_E + TL; GAS int* TI_P1 = TI_P0 + TL; GAS float* TI_W0 = (GAS float*)(TI_P1 + TL); GAS float* TI_W1 = TI_W0 + TL;
    typedef unsigned long long u64_;
    int s0n = 0, s1n = 0; float w0n = 0.f, w1n = 0.f;
    f32x4 nx[4]; u64_ na[4], nc[4]; float w0c = 0.f, w1c = 0.f;
#define CMB_IDX(mm) do { s0n = TI_P0[mm]; s1n = TI_P1[mm]; w0n = TI_W0[mm]; w1n = TI_W1[mm]; } while (0)
#define CMB_DATA(mm) do { const GAS float* r_ = F.out + (size_t)(mm) * D; const GAS u64_* y0_ = (const GAS u64_*)(YS + (size_t)s0n * D) + F.lane; const GAS u64_* y1_ = (const GAS u64_*)(YS + (size_t)s1n * D) + F.lane; \
        _Pragma("unroll") for (int j = 0; j < 4; ++j) { nx[j] = ((const GAS f32x4*)r_)[F.lane + 64 * j]; na[j] = y0_[64 * j]; nc[j] = y1_[64 * j]; } w0c = w0n; w1c = w1n; } while (0)
    int m = F.gw;
    if (m < TL) { CMB_IDX(m); CMB_DATA(m); if (m + F.ngw < TL) CMB_IDX(m + F.ngw); }
    for (; m < TL; m += F.ngw) {
        GAS float* row = F.out + (size_t)m * D;
        const float w0 = w0c, w1 = w1c;
        const GAS float* gate = modv(F, l, row_v(m), 5);
        f32x4 xv[4]; u64_ av[4], cv[4];
#pragma unroll
        for (int j = 0; j < 4; ++j) { xv[j] = nx[j]; av[j] = na[j]; cv[j] = nc[j]; }
        if (m + F.ngw < TL) { CMB_DATA(m + F.ngw); if (m + 2 * F.ngw < TL) CMB_IDX(m + 2 * F.ngw); }
        f32x4 v[4]; float s = 0.f;
#pragma unroll
        for (int j = 0; j < 4; ++j) { const f32x4 x = xv[j], gt = ((const GAS f32x4*)gate)[F.lane + 64 * j];
            const u64_ a = av[j], c = cv[j];
            f32x4 f;
            f.x = w0 * bf2f((unsigned short)a) + w1 * bf2f((unsigned short)c); f.y = w0 * bf2f((unsigned short)(a >> 16)) + w1 * bf2f((unsigned short)(c >> 16));
            f.z = w0 * bf2f((unsigned short)(a >> 32)) + w1 * bf2f((unsigned short)(c >> 32)); f.w = w0 * bf2f((unsigned short)(a >> 48)) + w1 * bf2f((unsigned short)(c >> 48));
            v[j] = x * ALPHA + gt * f; s += (v[j].x + v[j].y) + (v[j].z + v[j].w); }
        const float mean = wave_sum(s) * (1.f / D); float s2 = 0.f;
#pragma unroll
        for (int j = 0; j < 4; ++j) { v[j] = v[j] - mean; s2 += (v[j].x * v[j].x + v[j].y * v[j].y) + (v[j].z * v[j].z + v[j].w * v[j].w); }
        const float rstd = 1.f / sqrtf(wave_sum(s2) * (1.f / D) + LN_EPS);
#pragma unroll
        for (int j = 0; j < 4; ++j) { const f32x4 gg = ((const GAS f32x4*)g)[F.lane + 64 * j], bb = ((const GAS f32x4*)b)[F.lane + 64 * j]; ((GAS f32x4*)row)[F.lane + 64 * j] = v[j] * rstd * gg + bb; }
    }
#undef CMB_IDX
#undef CMB_DATA
}

namespace att {
using bf16x8 = __attribute__((ext_vector_type(8))) short;
using s16x4  = __attribute__((ext_vector_type(4))) short;
using f32x16 = __attribute__((ext_vector_type(16))) float;
using u32x4  = __attribute__((ext_vector_type(4))) unsigned;
constexpr int DQ = 96, DV = 64, NW = 8, QBLK = 32, KVBLK = 64, NKEY = 16640;
constexpr float THR2 = 8.0f;
constexpr int SHM_K = KVBLK * 144, SHM_V = DV * 80;
typedef int i32x8 __attribute__((ext_vector_type(8)));
constexpr int NSLOT = 8;
constexpr int LDS_V = 0, LDS_K = NSLOT * SHM_V, LDS_WS = LDS_K + NSLOT * SHM_K, LDS_Q = LDS_WS + NW * 64 * 4, ATT_LDS = LDS_Q + NW * 4096;
#define KSWZ(row, colB) ((row) * 256 + ((colB) ^ (((row) & 7) << 4)))
#define SBAR() __builtin_amdgcn_sched_barrier(0)
__device__ __forceinline__ int crow(int r, int hi) { return (r & 3) + 8 * (r >> 2) + 4 * hi; }
__device__ __forceinline__ unsigned cvtpk(float lo, float hi) { unsigned r; asm volatile("v_cvt_pk_bf16_f32 %0, %1, %2" : "=v"(r) : "v"(lo), "v"(hi)); return r; }
template <bool FIRST>
__device__ __forceinline__ bool partialSM(f32x16& p0, f32x16& p1, f32x16& negm, float& alpha) {
  float a = fmaxf(fmaxf(p0[0], p0[1]), p1[0]), b = fmaxf(fmaxf(p0[2], p0[3]), p1[1]); a = fmaxf(fmaxf(a, p1[2]), p1[3]);
#pragma unroll
  for (int r = 4; r < 16; r += 4) { a = fmaxf(fmaxf(a, p0[r]), p0[r + 1]); b = fmaxf(fmaxf(b, p0[r + 2]), p0[r + 3]); a = fmaxf(fmaxf(a, p1[r]), p1[r + 1]); b = fmaxf(fmaxf(b, p1[r + 2]), p1[r + 3]); }
  float pmax = fmaxf(a, b);
  { auto rr = __builtin_amdgcn_permlane32_swap(__float_as_uint(pmax), __float_as_uint(pmax), false, false);
    pmax = fmaxf(__uint_as_float(rr[0]), __uint_as_float(rr[1])); }
  bool resc = false;
  if (FIRST || __builtin_expect(__any(pmax > THR2), 0)) {
    const float dl = FIRST ? pmax : fmaxf(pmax, 0.f);
#pragma unroll
    for (int r = 0; r < 16; ++r) { p0[r] -= dl; p1[r] -= dl; negm[r] -= dl; }
    alpha = __builtin_amdgcn_exp2f(-dl); resc = !FIRST;
  }
  return resc;
}
__device__ __forceinline__ void finishSM(f32x16& p0, f32x16& p1, i32x8& pb) {
#pragma unroll
  for (int r = 0; r < 16; ++r) p0[r] = __builtin_amdgcn_exp2f(p0[r]);
#pragma unroll
  for (int r = 0; r < 16; ++r) p1[r] = __builtin_amdgcn_exp2f(p1[r]);
#pragma unroll
  for (int w = 0; w < 4; ++w) {
    int x = __builtin_amdgcn_cvt_pk_fp8_f32(p0[4 * w], p0[4 * w + 1], __float_as_int(p0[4 * w]), false); x = __builtin_amdgcn_cvt_pk_fp8_f32(p0[4 * w + 2], p0[4 * w + 3], x, true); pb[w] = x;
    int y = __builtin_amdgcn_cvt_pk_fp8_f32(p1[4 * w], p1[4 * w + 1], __float_as_int(p1[4 * w]), false); y = __builtin_amdgcn_cvt_pk_fp8_f32(p1[4 * w + 2], p1[4 * w + 3], y, true); pb[4 + w] = y; }
}
__device__ __forceinline__ i32x8 ld32(const LAS char* p) { const u32x4 a = *reinterpret_cast<const LAS u32x4*>(p), b = *reinterpret_cast<const LAS u32x4*>(p + 16);
  return (i32x8){(int)a[0], (int)a[1], (int)a[2], (int)a[3], (int)b[0], (int)b[1], (int)b[2], (int)b[3]}; }
struct KFrag { i32x8 k00, k01, k10, k11; };
__device__ __forceinline__ void qkt_load(KFrag& k, const LAS char* Ks, int r32, int hi) {
  const LAS char* kp = Ks + r32 * 144 + hi * 32;
  k.k00 = ld32(kp); k.k01 = ld32(kp + 64); k.k10 = ld32(kp + 32 * 144); k.k11 = ld32(kp + 32 * 144 + 64);
}
__device__ __forceinline__ void qkt_mma(f32x16& p0, f32x16& p1, const KFrag& k, const i32x8& q0, const i32x8& q1, const f32x16& negm) {
  asm volatile("s_nop 1\n\tv_mfma_f32_32x32x64_f8f6f4 %0, %1, %2, %3" : "=&v"(p0) : "v"(k.k00), "v"(q0), "v"(negm));
  asm volatile("v_mfma_f32_32x32x64_f8f6f4 %0, %1, %2, %3" : "=&v"(p1) : "v"(k.k10), "v"(q0), "v"(negm));
  asm volatile("v_mfma_f32_32x32x64_f8f6f4 %0, %1, %2, %0" : "+v"(p0) : "v"(k.k01), "v"(q1));
  asm volatile("v_mfma_f32_32x32x64_f8f6f4 %0, %1, %2, %0" : "+v"(p1) : "v"(k.k11), "v"(q1));
}
__device__ __forceinline__ void qkt(f32x16& p0, f32x16& p1, const LAS char* Ks, const i32x8& q0, const i32x8& q1, const f32x16& negm, int r32, int hi) {
  KFrag k; qkt_load(k, Ks, r32, hi); qkt_mma(p0, p1, k, q0, q1, negm);
}
#define QK_DRAIN(P0, P1) asm volatile("s_nop 15\n\ts_nop 7" : "+v"(P0), "+v"(P1))
__device__ __forceinline__ void pv_d0(f32x16* o, const LAS char* Vs, const i32x8& pb, int r32, int hi) {
  const LAS char* vp = Vs + r32 * 80 + hi * 32;
  const u32x4 a0 = *reinterpret_cast<const LAS u32x4*>(vp), a1 = *reinterpret_cast<const LAS u32x4*>(vp + 16);
  const u32x4 b0 = *reinterpret_cast<const LAS u32x4*>(vp + 32 * 80), b1 = *reinterpret_cast<const LAS u32x4*>(vp + 32 * 80 + 16);
  const i32x8 va = {(int)a0[0], (int)a0[1], (int)a0[2], (int)a0[3], (int)a1[0], (int)a1[1], (int)a1[2], (int)a1[3]};
  const i32x8 vb = {(int)b0[0], (int)b0[1], (int)b0[2], (int)b0[3], (int)b1[0], (int)b1[1], (int)b1[2], (int)b1[3]};
  const i32x8 ones = {0x38383838, 0x38383838, 0x38383838, 0x38383838, 0x38383838, 0x38383838, 0x38383838, 0x38383838};
  asm volatile("s_nop 1\n\tv_mfma_f32_32x32x64_f8f6f4 %0, %1, %2, %0" : "+v"(o[0]) : "v"(va), "v"(pb));
  asm volatile("v_mfma_f32_32x32x64_f8f6f4 %0, %1, %2, %0" : "+v"(o[1]) : "v"(vb), "v"(pb));
  asm volatile("v_mfma_f32_32x32x64_f8f6f4 %0, %1, %2, %0" : "+v"(o[2]) : "v"(ones), "v"(pb));
}
#define PV_DRAIN() asm volatile("s_nop 15\n\ts_nop 7" : "+v"(o[0]), "+v"(o[1]), "+v"(o[2]))
#define QK_A(P, KA, QA) asm volatile("s_nop 1\n\tv_mfma_f32_32x32x64_f8f6f4 %0, %1, %2, %3" : "=&v"(P) : "v"(KA), "v"(QA), "v"(negm))
#define QK_B(P, KA, QA) asm volatile("v_mfma_f32_32x32x64_f8f6f4 %0, %1, %2, %3" : "=&v"(P) : "v"(KA), "v"(QA), "v"(negm))
#define QK_C(P, KA, QA) asm volatile("v_mfma_f32_32x32x64_f8f6f4 %0, %1, %2, %0" : "+v"(P) : "v"(KA), "v"(QA))
#define PV_A(O, VA) asm volatile("s_nop 1\n\tv_mfma_f32_32x32x64_f8f6f4 %0, %1, %2, %0" : "+v"(O) : "v"(VA), "v"(pb))
#define PV_B(O, VA) asm volatile("v_mfma_f32_32x32x64_f8f6f4 %0, %1, %2, %0" : "+v"(O) : "v"(VA), "v"(pb))
#define EXPS(P, lo, hi_) do { _Pragma("unroll") for (int r_ = (lo); r_ < (hi_); ++r_) P[r_] = __builtin_amdgcn_exp2f(P[r_]); } while (0)
#define CVT4(P, w_, dst) do { int x_ = __builtin_amdgcn_cvt_pk_fp8_f32(P[4 * (w_)], P[4 * (w_) + 1], __float_as_int(P[4 * (w_)]), false); dst = __builtin_amdgcn_cvt_pk_fp8_f32(P[4 * (w_) + 2], P[4 * (w_) + 3], x_, true); } while (0)
__device__ __forceinline__ float mx3(float a, float b, float c) { float r; asm("v_max3_f32 %0, %1, %2, %3" : "=v"(r) : "v"(a), "v"(b), "v"(c)); return r; }
__device__ __forceinline__ float max16(const f32x16& p, float prev) {
  float a, b;
  asm("v_max3_f32 %0, %2, %3, %4\n\tv_max3_f32 %1, %5, %6, %7\n\tv_max3_f32 %0, %0, %8, %9\n\tv_max3_f32 %1, %1, %10, %11\n\t"
      "v_max3_f32 %0, %0, %12, %13\n\tv_max3_f32 %1, %1, %14, %15\n\tv_max3_f32 %0, %0, %16, %17\n\tv_max3_f32 %0, %0, %1, %18"
      : "=&v"(a), "=&v"(b)
      : "v"(p[0]), "v"(p[1]), "v"(p[2]), "v"(p[3]), "v"(p[4]), "v"(p[5]), "v"(p[6]), "v"(p[7]), "v"(p[8]), "v"(p[9]), "v"(p[10]), "v"(p[11]), "v"(p[12]), "v"(p[13]), "v"(p[14]), "v"(p[15]), "v"(prev));
  return a;
}
__device__ __forceinline__ void attn_unit(const GAS unsigned char* __restrict__ Qb, const GAS unsigned char* __restrict__ Kh, const GAS unsigned char* __restrict__ Vh,
                                          GAS unsigned short* __restrict__ Ob, int ldo, int seq, LAS char* lds, int tid) {
  const int wid = tid >> 6, lane = tid & 63, r32 = lane & 31, hi = lane >> 5;
  LAS char* V_lds = lds + LDS_V; LAS char* K_lds = lds + LDS_K;
  f32x16 o[3] = {}; f32x16 negm = {};
  const GAS unsigned char* Qw = Qb + (long)(wid * QBLK + r32) * 128 + hi * 32;
  i32x8 q0, q1;
  { const u32x4 a = *reinterpret_cast<const GAS u32x4*>(Qw), b = *reinterpret_cast<const GAS u32x4*>(Qw + 16), c = *reinterpret_cast<const GAS u32x4*>(Qw + 64), d = *reinterpret_cast<const GAS u32x4*>(Qw + 80);
    q0 = (i32x8){(int)a[0], (int)a[1], (int)a[2], (int)a[3], (int)b[0], (int)b[1], (int)b[2], (int)b[3]}; q1 = (i32x8){(int)c[0], (int)c[1], (int)c[2], (int)c[3], (int)d[0], (int)d[1], (int)d[2], (int)d[3]}; }
  const int vst = (tid >> 3) * 80 + (tid & 7) * 8;
  const int kst0 = (tid >> 3) * 144 + (tid & 7) * 16;
  const GAS unsigned char* Ku = (const GAS unsigned char*)(((unsigned long long)(unsigned)__builtin_amdgcn_readfirstlane((unsigned)((unsigned long long)Kh >> 32)) << 32) | (unsigned long long)(unsigned)__builtin_amdgcn_readfirstlane((unsigned)(unsigned long long)Kh));
  const GAS unsigned char* Vu = (const GAS unsigned char*)(((unsigned long long)(unsigned)__builtin_amdgcn_readfirstlane((unsigned)((unsigned long long)Vh >> 32)) << 32) | (unsigned long long)(unsigned)__builtin_amdgcn_readfirstlane((unsigned)(unsigned long long)Vh));
  const unsigned ko = (unsigned)tid * 16u, vo = (unsigned)tid * 8u;
  bf16x8 sk; v2u sv;
#define SLOAD(t) do { sk = *reinterpret_cast<const GAS bf16x8*>(Ku + (size_t)(t) * (KVBLK * 128) + ko); sv = *reinterpret_cast<const GAS v2u*>(Vu + (size_t)(t) * 4096 + vo); } while (0)
#define SWRITE(t) do { *(LAS bf16x8*)(K_lds + ((t) & 7) * SHM_K + kst0) = sk; *(LAS v2u*)(V_lds + ((t) & 7) * SHM_V + vst) = sv; } while (0)
#define KS(t) (K_lds + ((t) & 7) * SHM_K)
#define VS(t) (V_lds + ((t) & 7) * SHM_V)
#define RESC(flag, a) do { if (flag) { PV_DRAIN(); _Pragma("unroll") for (int d = 0; d < 3; ++d) _Pragma("unroll") for (int r = 0; r < 16; ++r) o[d][r] *= (a); } } while (0)
#define PSM_TAIL(N0, N1, pm) do { \
    if (__builtin_expect(__any((pm) > THR2), 0)) { float pmax = (pm);     \
      { auto rr = __builtin_amdgcn_permlane32_swap(__float_as_uint(pmax), __float_as_uint(pmax), false, false); pmax = fmaxf(__uint_as_float(rr[0]), __uint_as_float(rr[1])); } \
      const float dl = fmaxf(pmax, 0.f); \
      _Pragma("unroll") for (int r = 0; r < 16; ++r) { N0[r] -= dl; N1[r] -= dl; negm[r] -= dl; } \
      const float al = __builtin_amdgcn_exp2f(-dl); RESC(true, al); } } while (0)
#define HI(j, C0, C1, N0, N1, DO_BAR, DO_QK, DO_KR, DO_SW, DO_SL) do { \
    if (DO_BAR) __syncthreads(); \
    if (DO_SW) SWRITE((j) + 4); \
    if (DO_SL) SLOAD((j) + 5); \
    SBAR(); \
    if (DO_QK) { QK_A(N0, kf.k00, q0); SBAR(); } \
    EXPS(C0, 0, 7); SBAR(); \
    if (DO_QK) { QK_B(N1, kf.k10, q0); SBAR(); } \
    EXPS(C0, 7, 14); SBAR(); \
    if (DO_QK) { QK_C(N0, kf.k01, q1); SBAR(); } \
    EXPS(C0, 14, 16); CVT4(C0, 0, pb[0]); CVT4(C0, 1, pb[1]); CVT4(C0, 2, pb[2]); EXPS(C1, 0, 2); SBAR(); \
    if (DO_QK) { QK_C(N1, kf.k11, q1); SBAR(); } \
    { const LAS char* vp = VS(j) + r32 * 80 + hi * 32; va = ld32(vp); vb = ld32(vp + 32 * 80); } \
    EXPS(C1, 2, 9); SBAR(); \
    EXPS(C1, 9, 16); CVT4(C0, 3, pb[3]); CVT4(C1, 0, pb[4]); CVT4(C1, 1, pb[5]); CVT4(C1, 2, pb[6]); CVT4(C1, 3, pb[7]); SBAR(); \
    PV_A(o[0], va); SBAR(); \
    float pm_ = 0.f; if (DO_QK) { pm_ = max16(N0, N0[15]); SBAR(); } \
    PV_B(o[1], vb); SBAR(); \
    if (DO_KR) { qkt_load(kf, KS((j) + 2), r32, hi); SBAR(); } \
    if (DO_QK) { pm_ = max16(N1, pm_); SBAR(); } \
    PV_B(o[2], ones); SBAR(); \
    if (DO_QK) PSM_TAIL(N0, N1, pm_); \
  } while (0)
  i32x8 ones = {0x38383838, 0x38383838, 0x38383838, 0x38383838, 0x38383838, 0x38383838, 0x38383838, 0x38383838};
  asm volatile("" : "+v"(ones));
  f32x16 pA0, pA1, pB0, pB1; i32x8 pb, va, vb; KFrag kf; const int NT = seq / KVBLK;
  SLOAD(0); SWRITE(0); SLOAD(1); SWRITE(1); SLOAD(2); SWRITE(2); SLOAD(3); SWRITE(3); if (NT > 4) SLOAD(4);
  __syncthreads();
  { float al0; qkt(pA0, pA1, KS(0), q0, q1, negm, r32, hi); QK_DRAIN(pA0, pA1); (void)partialSM<true>(pA0, pA1, negm, al0); }
  qkt_load(kf, KS(1), r32, hi);
  int j = 0;
  for (; j + 6 < NT; j += 2) {
    HI(j, pA0, pA1, pB0, pB1, true, true, true, true, true);
    HI(j + 1, pB0, pB1, pA0, pA1, false, true, true, true, true);
  }
  for (; j < NT; j += 2) {
    HI(j, pA0, pA1, pB0, pB1, true, true, (j + 2 < NT), (j + 4 < NT), (j + 5 < NT));
    HI(j + 1, pB0, pB1, pA0, pA1, false, (j + 2 < NT), (j + 3 < NT), (j + 5 < NT), (j + 6 < NT));
  }
#undef KS
#undef VS
  PV_DRAIN();
  const float rl = __builtin_amdgcn_rcpf(o[2][0]);
  GAS unsigned short* Ow = Ob + (long)(wid * QBLK + r32) * ldo + 4 * hi;
#pragma unroll
  for (int d0 = 0; d0 < 2; ++d0)
#pragma unroll
    for (int g = 0; g < 4; ++g) { unsigned long long w = (unsigned long long)cvtpk(o[d0][4 * g] * rl, o[d0][4 * g + 1] * rl) | ((unsigned long long)cvtpk(o[d0][4 * g + 2] * rl, o[d0][4 * g + 3] * rl) << 32);
      *(GAS unsigned long long*)(Ow + d0 * 32 + g * 8) = w; }
  __syncthreads();
#undef SLOAD
#undef SWRITE
#undef RESC
#undef HI
#undef PSM_TAIL
}
#undef KSWZ
}

constexpr size_t WS_ROPE = WS_SMALL;
constexpr size_t WS_RSQ = WS_SMALL + 704 * 1024, WS_RSKV = WS_RSQ + (size_t)MR * 4;
static_assert(WS_RSKV + (size_t)MR * 4 <= WS_WIN, "small map");
constexpr size_t WS_QC = WS_Q + (size_t)NBATCH * 8 * SEQ * 128;
constexpr float MLA_QS = 4.f, MLA_KS = 0.25f;
static_assert(WS_QC + (size_t)NBATCH * 8 * CTXL * 128 <= WS_K && WS_K + (size_t)NBATCH * 8 * 16640 * 128 <= WS_V, "q8/k8 map");
constexpr float MLA_C2 = 0.10206207261596575f * 1.4426950408889634f;

__device__ __forceinline__ void p0_rope_table(const Frame& F0) { const Frame F = launder(F0);
    GAS float* T = (GAS float*)(F.ws + WS_ROPE);
    for (int i = blockIdx.x * NTHR + F.tid; i < 256 * 8; i += F.G * NTHR) {
        const int pos = i >> 3, e = i & 7;
        double inv = 1.0; for (int k = 0; k < (e >> 1); ++k) inv *= 0.1; if (e & 1) inv *= 0.31622776601683794;
        double rev = (double)pos * inv * 0.15915494309189535; rev -= (double)(long long)rev;
        T[2 * i] = __builtin_amdgcn_cosf((float)rev); T[2 * i + 1] = __builtin_amdgcn_sinf((float)rev);
    }
}
__device__ __forceinline__ void p_prep_mla_rows(const Frame& F0) { const Frame F = launder(F0);
    const GAS bf16* PH = (const GAS bf16*)(F.ws + WS_PH);
    GAS float* RSQ = (GAS float*)(F.ws + WS_RSQ); GAS float* RSKV = (GAS float*)(F.ws + WS_RSKV); const GAS float* T = (const GAS float*)(F.ws + WS_ROPE);
    constexpr int RB = 4;
    for (int m0 = F.gw; m0 < MR; m0 += RB * F.ngw) {
        unsigned long long q4[RB], k4[RB]; float xr[RB];
#pragma unroll
        for (int j = 0; j < RB; ++j) { const int m = m0 + j * F.ngw; q4[j] = 0; k4[j] = 0; xr[j] = 0.f;
            if (m < MR) { const GAS bf16* row = PH + (size_t)m * NPH; q4[j] = *((const GAS unsigned long long*)(row + PH_CQ) + F.lane);
                if (F.lane < 32) { k4[j] = *((const GAS unsigned long long*)(row + PH_CKV) + F.lane); xr[j] = bf2f(row[PH_KR + F.lane]); } } }
#pragma unroll
        for (int j = 0; j < RB; ++j) { const int m = m0 + j * F.ngw; if (m >= MR) break;
        float a0 = bf2f((unsigned short)q4[j]), a1 = bf2f((unsigned short)(q4[j] >> 16)), a2 = bf2f((unsigned short)(q4[j] >> 32)), a3 = bf2f((unsigned short)(q4[j] >> 48));
        const float sq = wave_sum(a0 * a0 + a1 * a1 + a2 * a2 + a3 * a3);
        float skv = 0.f; const float x = xr[j];
        if (F.lane < 32) { a0 = bf2f((unsigned short)k4[j]); a1 = bf2f((unsigned short)(k4[j] >> 16)); a2 = bf2f((unsigned short)(k4[j] >> 32)); a3 = bf2f((unsigned short)(k4[j] >> 48));
            skv = a0 * a0 + a1 * a1 + a2 * a2 + a3 * a3; }
        skv = wave_sum(skv);
        if (F.lane == 0) { RSQ[m] = 1.f / sqrtf(sq * (1.f / 256.f) + RMS_EPS); RSKV[m] = 1.f / sqrtf(skv * (1.f / 128.f) + RMS_EPS); }
        const float xp = __shfl_xor(x, 8);
        int b, pos; float y = x;
        if (m < TL) { b = m >> 14; const int t = m & (SEQ - 1); pos = CTXL + t;
            const int i = F.lane & 31, half = i >> 4, w = i & 15, p = half ? (t & 63) : (t >> 6); const float c = T[(p * 8 + (w & 7)) * 2], s = T[(p * 8 + (w & 7)) * 2 + 1];
            y = (w < 8) ? (x * c - xp * s) : (xp * s + x * c); }
        else { b = (m - TL) >> 8; pos = (m - TL) & 255; }
        {
          const unsigned yb = pk4_fp8(F.lane < 32 ? y * MLA_KS : 0.f, 0.f, 0.f, 0.f) & 0xffu;
          const int q0 = (F.lane & 7) * 4;
          const unsigned dw = (unsigned)__shfl((int)yb, q0) | ((unsigned)__shfl((int)yb, q0 + 1) << 8) | ((unsigned)__shfl((int)yb, q0 + 2) << 16) | ((unsigned)__shfl((int)yb, q0 + 3) << 24);
          const unsigned kv = (F.lane & 8) ? 0u : dw;
          GAS unsigned char* K8 = F.ws + WS_K; GAS unsigned char* Q8 = m < TL ? F.ws + WS_Q : F.ws + WS_QC; const int qrows = m < TL ? SEQ : CTXL, qt = m < TL ? (m & (SEQ - 1)) : pos;
#pragma unroll
          for (int hh = 0; hh < 2; ++hh) { const int h = hh * 4 + (F.lane >> 4); *(GAS unsigned*)(K8 + ((size_t)(b * 8 + h) * att::NKEY + pos) * 128 + 64 + (F.lane & 15) * 4) = kv; }
          { const int h = F.lane >> 3; *(GAS unsigned*)(Q8 + ((size_t)(b * 8 + h) * qrows + qt) * 128 + 96 + (F.lane & 7) * 4) = 0u; } }
        }
    }
}
struct EpiMlaQ {
    static constexpr bool PERM = true, AFTER_DRAIN = false;
    GAS unsigned char* Q; GAS unsigned char* QC; const GAS float* rsq; const GAS float* rope;
    __device__ __forceinline__ void operator()(const pg8::f32x4 (&acc)[2][2][4][2], const Unit& u, int wr, int wc, int fr, int fq) const {
        const bool lat = u.pm < TL / 256;
        const int b = lat ? (u.pm >> 6) : (u.pm - TL / 256), t0 = lat ? (u.pm & 63) * 256 : 0, rows = lat ? SEQ : CTXL;
        GAS unsigned char* base = lat ? Q : QC;
        const unsigned lane_off = (unsigned)((wr * 64 + fr) * 128 + 8 * fq);
        const GAS float* rsp = rsq + u.pm * 256 + wr * 64 + fr;
#pragma unroll
        for (int ai = 0; ai < 2; ++ai)
#pragma unroll
            for (int m = 0; m < 4; ++m) { const float rs = rsp[ai * 128 + m * 16] * (MLA_C2 * MLA_QS);
                const int trow = t0 + ai * 128 + m * 16;
#pragma unroll
                for (int bj = 0; bj < 2; ++bj) { const int g32 = 8 * u.pn + 4 * bj + wc, head = g32 / 3, part = g32 - 3 * head;
                    float x[8];
#pragma unroll
                    for (int i = 0; i < 4; ++i) { x[i] = acc[ai][bj][m][0][i] * rs; x[4 + i] = acc[ai][bj][m][1][i] * rs; }
                    if (part == 2 && lat) {
                        const int p = (fq < 2) ? ((trow >> 6) + wr) : (m * 16 + fr); const GAS f32x4* cs = (const GAS f32x4*)(rope + p * 16);
#pragma unroll
                        for (int i2 = 0; i2 < 4; ++i2) { const f32x4 c4 = cs[i2];
                            const float xa = __shfl_xor(x[2 * i2], 16), xb = __shfl_xor(x[2 * i2 + 1], 16);
                            x[2 * i2] = (fq & 1) ? (xa * c4.y + x[2 * i2] * c4.x) : (x[2 * i2] * c4.x - xa * c4.y);
                            x[2 * i2 + 1] = (fq & 1) ? (xb * c4.w + x[2 * i2 + 1] * c4.z) : (x[2 * i2 + 1] * c4.z - xb * c4.w); }
                    }
                    v2u w; w.x = pk4_fp8(x[0], x[1], x[2], x[3]); w.y = pk4_fp8(x[4], x[5], x[6], x[7]);
                    const size_t soff = (((size_t)(b * 8 + head) * rows + trow) * 128 + part * 32);
                    *(GAS v2u*)(base + soff + lane_off) = w; }
                asm volatile("" ::: "memory"); }
    }
};
struct EpiMlaKV {
    static constexpr bool PERM = true, AFTER_DRAIN = false;
    GAS unsigned char* K; GAS bf16* V; const GAS float* rskv;
    __device__ __forceinline__ void operator()(const pg8::f32x4 (&acc)[2][2][4][2], const Unit& u, int wr, int wc, int fr, int fq) const {
        const bool lat = u.pm < TL / 256;
        const int b = lat ? (u.pm >> 6) : (u.pm - TL / 256), pos0 = lat ? CTXL + (u.pm & 63) * 256 : 0;
        const bool isk = wc < 2;
        const unsigned lane_off = isk ? (unsigned)((wr * 64 + fr) * 128 + 32 * (wc & 1) + 8 * fq) : (unsigned)(((wr * 64 + fr) * 64 + 32 * (wc & 1) + 8 * fq) * 2);
        const GAS float* rsp = rskv + u.pm * 256 + wr * 64 + fr;
#pragma unroll
        for (int ai = 0; ai < 2; ++ai)
#pragma unroll
            for (int m = 0; m < 4; ++m) { const float rs = rsp[ai * 128 + m * 16];
#pragma unroll
                for (int bj = 0; bj < 2; ++bj) { const int head = 2 * u.pn + bj;
                    const size_t rk = (size_t)(b * 8 + head) * att::NKEY + pos0 + ai * 128 + m * 16;
                    if (isk) { const pg8::f32x4 v0 = acc[ai][bj][m][0] * (rs * MLA_KS), v1 = acc[ai][bj][m][1] * (rs * MLA_KS);
                        v2u w; w.x = pk4_fp8(v0[0], v0[1], v0[2], v0[3]); w.y = pk4_fp8(v1[0], v1[1], v1[2], v1[3]);
                        *(GAS v2u*)(K + rk * 128 + lane_off) = w; }
                    else { const pg8::f32x4 v0 = acc[ai][bj][m][0] * rs, v1 = acc[ai][bj][m][1] * rs;
                        v4u w; w.x = pk2(v0[0], v0[1]); w.y = pk2(v0[2], v0[3]); w.z = pk2(v1[0], v1[1]); w.w = pk2(v1[2], v1[3]);
                        *(GAS v4u*)((GAS char*)V + rk * 128 + lane_off) = w; } }
                asm volatile("" ::: "memory"); }
    }
};
constexpr size_t WS_V8T = WS_QC + (size_t)NBATCH * 8 * CTXL * 128;
static_assert(WS_V8T + (size_t)NBATCH * 8 * (att::NKEY / 64) * 4096 <= WS_K, "v8t map");
__device__ __forceinline__ void p_attn_vt_pack(const Frame& F0) { const Frame F = launder(F0);
    LAS unsigned short* VL = (LAS unsigned short*)F.lds; const int tid = F.tid;
    const GAS bf16* V = (const GAS bf16*)(F.ws + WS_V); GAS unsigned char* V8T = F.ws + WS_V8T;
    const int ntile = att::NKEY / 64;
    for (int u = blockIdx.x; u < NBATCH * 8 * ntile; u += F.G) {
        const int bh = u / ntile, t = u % ntile;
        { const int key = tid >> 3, c8 = (tid & 7) * 8; const v4u w = *(const GAS v4u*)(V + ((size_t)bh * att::NKEY + t * 64 + key) * 64 + c8);
          LAS unsigned short* d = VL + key * 66 + c8; d[0] = (unsigned short)w.x; d[1] = (unsigned short)(w.x >> 16); d[2] = (unsigned short)w.y; d[3] = (unsigned short)(w.y >> 16);
          d[4] = (unsigned short)w.z; d[5] = (unsigned short)(w.z >> 16); d[6] = (unsigned short)w.w; d[7] = (unsigned short)(w.w >> 16); }
        __syncthreads();
        { const int v = tid >> 3, s8 = (tid & 7) * 8; float x[8];
#pragma unroll
          for (int e = 0; e < 8; ++e) { const int slot = s8 + e, hi = slot >> 5, j = slot & 31, jj = j & 15, key = (j >> 4) * 32 + (jj & 3) + 8 * (jj >> 2) + 4 * hi; x[e] = bf2f(VL[key * 66 + v]); }
          v2u o; o.x = pk4_fp8(x[0], x[1], x[2], x[3]); o.y = pk4_fp8(x[4], x[5], x[6], x[7]);
          *(GAS v2u*)(V8T + (size_t)u * 4096 + v * 64 + s8) = o; }
        __syncthreads();
    }
}
__device__ __forceinline__ void p_attention(const Frame& F0, bool with_ctx) { const Frame F = launder(F0);
    const GAS unsigned char* Q = F.ws + WS_Q; const GAS unsigned char* QC = F.ws + WS_QC; const GAS unsigned char* K = F.ws + WS_K; const GAS unsigned char* V8T = F.ws + WS_V8T;
    GAS bf16* Y = (GAS bf16*)(F.ws + WS_Y);
    LAS char* lds = (LAS char*)F.lds;
    const int nlat = NBATCH * 8 * (SEQ / 256);
    for (int i = 0;; ++i) {
        const int L = i * F.G + (int)blockIdx.x; if (L >= nlat) break;
        int bh, qb;
        if (F.G == 256) { const int xcd = blockIdx.x & 7, slot = blockIdx.x >> 3; bh = xcd + 8 * (i >> 1); qb = (i & 1) * 32 + slot; }
        else { bh = L / (SEQ / 256); qb = L % (SEQ / 256); }
        const int b = bh >> 3, h = bh & 7;
        att::attn_unit(Q + ((size_t)bh * SEQ + qb * 256) * 128, K + (size_t)bh * att::NKEY * 128, V8T + (size_t)bh * (att::NKEY / 64) * 4096,
                       Y + ((size_t)b * SEQ + qb * 256) * D + 512 + h * 64, D, att::NKEY, lds, F.tid);
    }
    if (with_ctx && (int)blockIdx.x < NBATCH * 8) { const int bh = blockIdx.x, b = bh >> 3, h = bh & 7;
        att::attn_unit(QC + (size_t)bh * CTXL * 128, K + (size_t)bh * att::NKEY * 128, V8T + (size_t)bh * (att::NKEY / 64) * 4096,
                       Y + ((size_t)TL + b * CTXL) * D + 512 + h * 64, D, CTXL, lds, F.tid);
    }
}
__device__ __forceinline__ void p_ynorm_c(const Frame& F0, int nrows, const GAS float* mg) { const Frame F = launder(F0);
    GAS bf16* Y = (GAS bf16*)(F.ws + WS_Y);
    const f32x4 g0 = ((const GAS f32x4*)mg)[2 * F.lane], g1 = ((const GAS f32x4*)mg)[2 * F.lane + 1];
    constexpr int RB = 4;
    for (int m0 = F.gw; m0 < nrows; m0 += RB * F.ngw) {
        v4u w[RB];
#pragma unroll
        for (int j = 0; j < RB; ++j) { const int m = m0 + j * F.ngw; w[j] = (v4u){0u, 0u, 0u, 0u}; if (m < nrows) w[j] = *((const GAS v4u*)(Y + (size_t)m * D + 512) + F.lane); }
#pragma unroll
        for (int j = 0; j < RB; ++j) { const int m = m0 + j * F.ngw; if (m >= nrows) break;
            float x[8]; x[0] = bf2f((unsigned short)w[j].x); x[1] = bf2f((unsigned short)(w[j].x >> 16)); x[2] = bf2f((unsigned short)w[j].y); x[3] = bf2f((unsigned short)(w[j].y >> 16));
            x[4] = bf2f((unsigned short)w[j].z); x[5] = bf2f((unsigned short)(w[j].z >> 16)); x[6] = bf2f((unsigned short)w[j].w); x[7] = bf2f((unsigned short)(w[j].w >> 16));
            float s = 0.f;
#pragma unroll
            for (int i = 0; i < 8; ++i) s += x[i] * x[i];
            const float rs = 1.f / sqrtf(wave_sum(s) * (1.f / 512.f) + RMS_EPS);
            v4u o; o.x = pk2(x[0] * rs * g0.x, x[1] * rs * g0.y); o.y = pk2(x[2] * rs * g0.z, x[3] * rs * g0.w); o.z = pk2(x[4] * rs * g1.x, x[5] * rs * g1.y); o.w = pk2(x[6] * rs * g1.z, x[7] * rs * g1.w);
            *((GAS v4u*)(Y + (size_t)m * D + 512) + F.lane) = o; }
    }
}

constexpr int GLA_NCH = 4 + SEQ / 64;
constexpr size_t WS_SLOC = WS_XN, WS_GDEC = AB + 521 * MiB;
static_assert(WS_SLOC + (size_t)NBATCH * 4 * 2 * GLA_NCH * 2048 * 4 <= WS_XN + 33 * MiB && (size_t)NBATCH * 4 * 2 * GLA_NCH * 32 * 4 <= 5 * MiB && GLA_NCH % 20 == 0, "gla map");
constexpr int GB_LA = 0, GB_K = GB_LA + 16384, GB_Q = GB_K + 8192, GB_ALR = GB_Q + 8192, GB_WG = GB_ALR + 8192, GB_BG = GB_WG + 4096, GB_O = GB_BG + 256,
              GB_QF = GB_O + 64 * 65 * 4, GB_QB = GB_QF + 5120, GB_KF = GB_QB + 5120, GB_KB = GB_KF + 5120, GB_KTF = GB_KB + 5120, GB_KTB = GB_KTF + 4608, GB_VT = GB_KTB + 4608,
              GB_ATT = GB_VT + 9216, GB_STF = GB_ATT + 9216, GB_STB = GB_STF + 5120, GB_END = GB_STB + 5120;
static_assert(GB_END <= 131072 && GB_QF % 16 == 0, "gla lds");
typedef short gbf16x8 __attribute__((ext_vector_type(8)));
typedef float gf32x16 __attribute__((ext_vector_type(16)));
__device__ __forceinline__ float logsigmoidf(float z) { return fminf(z, 0.f) - __logf(1.f + __expf(-fabsf(z))); }
__device__ __forceinline__ unsigned short bf1(float x) { return (unsigned short)(pk2(x, x) & 0xffffu); }
__device__ __forceinline__ void ld8bf(const GAS bf16* p, LAS float* d) { const v4u w = *(const GAS v4u*)p;
    d[0] = bf2f((unsigned short)w.x); d[1] = bf2f((unsigned short)(w.x >> 16)); d[2] = bf2f((unsigned short)w.y); d[3] = bf2f((unsigned short)(w.y >> 16));
    d[4] = bf2f((unsigned short)w.z); d[5] = bf2f((unsigned short)(w.z >> 16)); d[6] = bf2f((unsigned short)w.w); d[7] = bf2f((unsigned short)(w.w >> 16)); }
__device__ __forceinline__ int gcrow(int r, int hi) { return (r & 3) + 8 * (r >> 2) + 4 * hi; }
template <int KD>
__device__ __forceinline__ void gmm(gf32x16& acc, const LAS unsigned char* A, int sa, int m0, const LAS unsigned char* BT, int sb, int n0, int r32, int hi) {
#pragma unroll
    for (int kt = 0; kt < KD / 16; ++kt) { const gbf16x8 a = *(const LAS gbf16x8*)(A + (m0 + r32) * sa + (kt * 16 + hi * 8) * 2), b = *(const LAS gbf16x8*)(BT + (n0 + r32) * sb + (kt * 16 + hi * 8) * 2);
        acc = __builtin_amdgcn_mfma_f32_32x32x16_bf16(a, b, acc, 0, 0, 0); }
}
template <int CTRL, int RM> __device__ __forceinline__ float gdpp(float v) { return __int_as_float(__builtin_amdgcn_update_dpp(0, __float_as_int(v), CTRL, RM, 0xf, false)); }
struct GlaRegs { v4u kq, al, vv; float w0, w1, bg; };
__device__ __forceinline__ int gla_row0(int b, int jj) { return jj < 4 ? TL + b * CTXL + jj * 64 : b * SEQ + (jj - 4) * 64; }
__device__ __forceinline__ void st8bf(const v4u w, LAS float* d) {
    d[0] = bf2f((unsigned short)w.x); d[1] = bf2f((unsigned short)(w.x >> 16)); d[2] = bf2f((unsigned short)w.y); d[3] = bf2f((unsigned short)(w.y >> 16));
    d[4] = bf2f((unsigned short)w.z); d[5] = bf2f((unsigned short)(w.z >> 16)); d[6] = bf2f((unsigned short)w.w); d[7] = bf2f((unsigned short)(w.w >> 16)); }
__device__ __forceinline__ void gla_issue(const Frame& F, int l, int b, int h, int jj, bool want_q, GlaRegs& R) {
    const int tid = F.tid;
    const GAS bf16* PH = (const GAS bf16*)(F.ws + WS_PH) + (size_t)gla_row0(b, jj) * NPH;
    { const int t = (tid & 255) >> 2, c = (tid & 3) * 8;
      if (tid < 256) { R.kq = *(const GAS v4u*)(PH + (size_t)t * NPH + PH_KA + h * 32 + c); R.al = *(const GAS v4u*)(PH + (size_t)t * NPH + PH_ALR + c); }
      else if (want_q) R.kq = *(const GAS v4u*)(PH + (size_t)t * NPH + PH_QA + h * 32 + c); }
    { const int t = tid >> 3, c = (tid & 7) * 8; R.vv = *(const GAS v4u*)(PH + (size_t)t * NPH + PH_VA + h * 64 + c); }
    { const GAS float* wg = F.in[I_GWG] + (size_t)l * 2 * 16 * 128;
      { const int i = tid, d = i >> 9, r = (i >> 5) & 15, k = i & 31; R.w0 = wg[(d * 16 + r) * 128 + h * 32 + k]; }
      { const int i = tid + 512, d = i >> 9, r = (i >> 5) & 15, k = i & 31; R.w1 = wg[(d * 16 + r) * 128 + h * 32 + k]; }
      if (tid < 64) R.bg = F.in[I_GBG][l * 256 + (tid >> 5) * 128 + h * 32 + (tid & 31)]; }
}
__device__ __forceinline__ void gla_head(const Frame& F, bool want_q, const GlaRegs& R) {
    LAS unsigned char* LB = F.lds; LAS float* LA = (LAS float*)(LB + GB_LA); LAS float* KK = (LAS float*)(LB + GB_K); LAS float* QQ = (LAS float*)(LB + GB_Q);
    LAS float* BG = (LAS float*)(LB + GB_BG); LAS unsigned short* VT = (LAS unsigned short*)(LB + GB_VT);
    LAS unsigned char* ALRB = LB + GB_ALR; LAS unsigned char* WGB = LB + GB_WG; LAS unsigned char* WGL = LB + GB_Q;
    const int tid = F.tid;
    { const int t = (tid & 255) >> 2, c = (tid & 3) * 8;
      if (tid < 256) { st8bf(R.kq, KK + t * 32 + c); *(LAS v4u*)(ALRB + ((c >> 4) * 64 + t) * 48 + (c & 15) * 2) = R.al; } }
    { const int t = tid >> 3, c = (tid & 7) * 8; const v4u w = R.vv;
      VT[(c + 0) * 72 + t] = (unsigned short)w.x; VT[(c + 1) * 72 + t] = (unsigned short)(w.x >> 16); VT[(c + 2) * 72 + t] = (unsigned short)w.y; VT[(c + 3) * 72 + t] = (unsigned short)(w.y >> 16);
      VT[(c + 4) * 72 + t] = (unsigned short)w.z; VT[(c + 5) * 72 + t] = (unsigned short)(w.z >> 16); VT[(c + 6) * 72 + t] = (unsigned short)w.w; VT[(c + 7) * 72 + t] = (unsigned short)(w.w >> 16); }
    { const int r = (tid >> 5) & 15, k = tid & 31;
      const unsigned short h0 = bf1(R.w0), h1 = bf1(R.w1);
      *(LAS unsigned short*)(WGB + (0 * 32 + k) * 48 + r * 2) = h0; *(LAS unsigned short*)(WGL + (0 * 32 + k) * 48 + r * 2) = bf1(R.w0 - bf2f(h0));
      *(LAS unsigned short*)(WGB + (1 * 32 + k) * 48 + r * 2) = h1; *(LAS unsigned short*)(WGL + (1 * 32 + k) * 48 + r * 2) = bf1(R.w1 - bf2f(h1));
      if (tid < 64) BG[tid] = R.bg; }
    (void)want_q; (void)QQ;
    __syncthreads();
    { const int wv = tid >> 6, lane = tid & 63, r32 = lane & 31, hi = lane >> 5;
      if (wv < 4) { const int d = wv >> 1, mt = wv & 1; gf32x16 acc = {};
          gmm<16>(acc, ALRB + d * 64 * 48, 48, mt * 32, WGB + d * 32 * 48, 48, 0, r32, hi);
          gmm<16>(acc, ALRB + d * 64 * 48, 48, mt * 32, WGL + d * 32 * 48, 48, 0, r32, hi);
          const float bgv = BG[d * 32 + r32];
#pragma unroll
          for (int r = 0; r < 16; ++r) LA[(d * 64 + mt * 32 + gcrow(r, hi)) * 32 + r32] = logsigmoidf(acc[r] + bgv) * (1.f / 16.f); } }
    __syncthreads();
    { const int w = tid >> 6, lane = tid & 63;
#pragma unroll
      for (int c = 0; c < 8; ++c) { const int col = w * 8 + c, d = col >> 5, k = col & 31; float v = LA[(d * 64 + lane) * 32 + k];
          const float x0 = v;
          v += gdpp<0x111, 0xf>(v); v += gdpp<0x112, 0xf>(v); v += gdpp<0x114, 0xf>(v); v += gdpp<0x118, 0xf>(v); v += gdpp<0x142, 0xa>(v); v += gdpp<0x143, 0xc>(v);
          if (d != 0) v = __shfl(v, 63) - v + x0;
          LA[(d * 64 + lane) * 32 + k] = v; } }
    __syncthreads();
}
__device__ __forceinline__ void gla_issue_kqv(const Frame& F, int b, int h, int jj, GlaRegs& R) {
    const int tid = F.tid;
    const GAS bf16* PH = (const GAS bf16*)(F.ws + WS_PH) + (size_t)gla_row0(b, jj) * NPH;
    { const int t = (tid & 255) >> 2, c = (tid & 3) * 8;
      R.kq = *(const GAS v4u*)(PH + (size_t)t * NPH + (tid < 256 ? PH_KA : PH_QA) + h * 32 + c); }
    { const int t = tid >> 3, c = (tid & 7) * 8; R.vv = *(const GAS v4u*)(PH + (size_t)t * NPH + PH_VA + h * 64 + c); }
}
__device__ __forceinline__ void gla_head_kqv(const Frame& F, const GlaRegs& R) {
    LAS unsigned char* LB = F.lds; LAS float* KK = (LAS float*)(LB + GB_K); LAS float* QQ = (LAS float*)(LB + GB_Q); LAS unsigned short* VT = (LAS unsigned short*)(LB + GB_VT);
    const int tid = F.tid;
    { const int t = (tid & 255) >> 2, c = (tid & 3) * 8; st8bf(R.kq, (tid < 256 ? KK : QQ) + t * 32 + c); }
    { const int t = tid >> 3, c = (tid & 7) * 8; const v4u w = R.vv;
      VT[(c + 0) * 72 + t] = (unsigned short)w.x; VT[(c + 1) * 72 + t] = (unsigned short)(w.x >> 16); VT[(c + 2) * 72 + t] = (unsigned short)w.y; VT[(c + 3) * 72 + t] = (unsigned short)(w.y >> 16);
      VT[(c + 4) * 72 + t] = (unsigned short)w.z; VT[(c + 5) * 72 + t] = (unsigned short)(w.z >> 16); VT[(c + 6) * 72 + t] = (unsigned short)w.w; VT[(c + 7) * 72 + t] = (unsigned short)(w.w >> 16); }
}
__device__ __forceinline__ void p_gla_local(const Frame& F0, int l) { const Frame F = launder(F0);
    LAS unsigned char* LB = F.lds; LAS float* LA = (LAS float*)(LB + GB_LA); LAS float* KK = (LAS float*)(LB + GB_K); const int tid = F.tid;
    LAS unsigned short* KTF = (LAS unsigned short*)(LB + GB_KTF); LAS unsigned short* KTB = (LAS unsigned short*)(LB + GB_KTB);
    GAS float* SLOC = (GAS float*)(F.ws + WS_SLOC); GAS float* GDEC = (GAS float*)(F.ws + WS_GDEC);
    const int wv = tid >> 6, lane = tid & 63, r32 = lane & 31, hi = lane >> 5;
    GlaRegs Rn;
    if ((int)blockIdx.x < NBATCH * 4 * GLA_NCH) { const int u = blockIdx.x; gla_issue(F, l, u / (4 * GLA_NCH), (u / GLA_NCH) & 3, u % GLA_NCH, false, Rn); }
    for (int u = blockIdx.x; u < NBATCH * 4 * GLA_NCH; u += F.G) {
        const int b = u / (4 * GLA_NCH), h = (u / GLA_NCH) & 3, jj = u % GLA_NCH;
        const GlaRegs R = Rn;
        { const int un = u + F.G; if (un < NBATCH * 4 * GLA_NCH) gla_issue(F, l, un / (4 * GLA_NCH), (un / GLA_NCH) & 3, un % GLA_NCH, false, Rn); }
        gla_head(F, false, R);
        { const int t = tid >> 3, d = (tid >> 2) & 1, kg = tid & 3;
          GAS f32x4* dst = (GAS f32x4*)((GAS unsigned char*)(F.ws + WS_Y) + (size_t)(gla_row0(b, jj) + t) * (D * 2) + 512 + h * 256 + d * 128 + kg * 32);
          const LAS f32x4* src = (const LAS f32x4*)(LA + (d * 64 + t) * 32 + kg * 8); dst[0] = src[0]; dst[1] = src[1]; }
        for (int i = tid; i < 2048; i += NTHR) { const int t = i >> 5, k = i & 31; const float kv = KK[i];
            KTF[k * 72 + t] = bf1(kv * __expf(LA[63 * 32 + k] - LA[t * 32 + k]));
            KTB[k * 72 + t] = bf1(kv * __expf(LA[64 * 32 + k] - LA[(64 + t) * 32 + k])); }
        __syncthreads();
        if (wv < 4) { const int dir = wv >> 1, nt = wv & 1; gf32x16 acc = {};
            gmm<64>(acc, LB + (dir ? GB_KTB : GB_KTF), 144, 0, LB + GB_VT, 144, nt * 32, r32, hi);
            GAS float* dst = SLOC + ((size_t)((b * 4 + h) * 2 + dir) * GLA_NCH + jj) * 2048 + nt * 32 + r32;
#pragma unroll
            for (int r = 0; r < 16; ++r) dst[gcrow(r, hi) * 64] = acc[r]; }
        if (tid < 64) { const int d = tid >> 5, kk = tid & 31; GDEC[((size_t)((b * 4 + h) * 2 + d) * GLA_NCH + jj) * 32 + kk] = __expf(d ? LA[64 * 32 + kk] : LA[63 * 32 + kk]); }
        __syncthreads();
    }
}
__device__ __forceinline__ void p_gla_scan(const Frame& F0) { const Frame F = launder(F0);
    GAS float* SLOC = (GAS float*)(F.ws + WS_SLOC); const GAS float* GDEC = (const GAS float*)(F.ws + WS_GDEC);
    if (F.tid < 128) for (int it = blockIdx.x; it < 256; it += F.G) {
        const int chain = it >> 4, e = (it & 15) * 128 + F.tid, k = e >> 6, dir = chain & 1;
        GAS float* sl = SLOC + (size_t)chain * GLA_NCH * 2048 + e; const GAS float* dc = GDEC + (size_t)chain * GLA_NCH * 32 + k;
        float S = 0.f;
        for (int j0 = 0; j0 < GLA_NCH; j0 += 20) { float lv[20], dv[20];
#pragma unroll
            for (int q = 0; q < 20; ++q) { const int j = j0 + q, jx = dir == 0 ? j : (j < 4 ? 3 - j : GLA_NCH + 3 - j); lv[q] = sl[(size_t)jx * 2048]; dv[q] = dc[jx * 32]; }
#pragma unroll
            for (int q = 0; q < 20; ++q) { const int j = j0 + q, jx = dir == 0 ? j : (j < 4 ? 3 - j : GLA_NCH + 3 - j); sl[(size_t)jx * 2048] = S; S = dv[q] * S + lv[q]; } }
    }
}
__device__ __forceinline__ void p_gla_out(const Frame& F0, int l, bool with_ctx) { const Frame F = launder(F0);
    LAS unsigned char* LB = F.lds; LAS float* LA = (LAS float*)(LB + GB_LA); LAS float* KK = (LAS float*)(LB + GB_K); LAS float* QQ = (LAS float*)(LB + GB_Q); LAS float* OO = (LAS float*)(LB + GB_O);
    LAS unsigned short* QF = (LAS unsigned short*)(LB + GB_QF); LAS unsigned short* QB = (LAS unsigned short*)(LB + GB_QB); LAS unsigned short* KF = (LAS unsigned short*)(LB + GB_KF); LAS unsigned short* KB = (LAS unsigned short*)(LB + GB_KB);
    LAS unsigned short* ATT = (LAS unsigned short*)(LB + GB_ATT); LAS unsigned short* STF = (LAS unsigned short*)(LB + GB_STF); LAS unsigned short* STB = (LAS unsigned short*)(LB + GB_STB);
    const int tid = F.tid, wv = tid >> 6, lane = tid & 63, r32 = lane & 31, hi = lane >> 5;
    const GAS float* SLOC = (const GAS float*)(F.ws + WS_SLOC); GAS bf16* Y = (GAS bf16*)(F.ws + WS_Y); const GAS bf16* PHB = (const GAS bf16*)(F.ws + WS_PH);
    const GAS float* gng = F.in[I_GNG] + l * 64;
    constexpr int NU = NBATCH * 4 * GLA_NCH;
    GlaRegs Rn; f32x4 san = {}, scn = {}, la0n = {}, la1n = {}; v4u gwn = {};
#define GLA_PF(u_) do { const int b_ = (u_) / (4 * GLA_NCH), h_ = ((u_) / GLA_NCH) & 3, j_ = (u_) % GLA_NCH; gla_issue_kqv(F, b_, h_, j_, Rn); \
        const GAS float* s0_ = SLOC + ((size_t)((b_ * 4 + h_) * 2 + 0) * GLA_NCH + j_) * 2048; const GAS float* s1_ = SLOC + ((size_t)((b_ * 4 + h_) * 2 + 1) * GLA_NCH + j_) * 2048; \
        san = *(const GAS f32x4*)(s0_ + (tid >> 4) * 64 + (tid & 15) * 4); scn = *(const GAS f32x4*)(s1_ + (tid >> 4) * 64 + (tid & 15) * 4); \
        gwn = *(const GAS v4u*)(PHB + (size_t)(gla_row0(b_, j_) + (tid >> 3)) * NPH + PH_GA + h_ * 64 + (tid & 7) * 8); \
        { const GAS f32x4* la_ = (const GAS f32x4*)((const GAS unsigned char*)(F.ws + WS_Y) + (size_t)(gla_row0(b_, j_) + (tid >> 3)) * (D * 2) + 512 + h_ * 256 + ((tid >> 2) & 1) * 128 + (tid & 3) * 32); la0n = la_[0]; la1n = la_[1]; } } while (0)
#define GLA_SKIP(u_) (((u_) % GLA_NCH) < 4 && !with_ctx)
    int u = blockIdx.x; while (u < NU && GLA_SKIP(u)) u += F.G;
    if (u < NU) GLA_PF(u);
    while (u < NU) {
        const int b = u / (4 * GLA_NCH), h = (u / GLA_NCH) & 3, jj = u % GLA_NCH;
        const GlaRegs R = Rn; const f32x4 a = san, c = scn, la0 = la0n, la1 = la1n; const v4u gw = gwn;
        int un = u + F.G; while (un < NU && GLA_SKIP(un)) un += F.G;
        if (un < NU) GLA_PF(un);
        gla_head_kqv(F, R);
        { LAS f32x4* dl = (LAS f32x4*)(LA + (((tid >> 2) & 1) * 64 + (tid >> 3)) * 32 + (tid & 3) * 8); dl[0] = la0; dl[1] = la1; }
        __syncthreads();
        for (int i = tid; i < 2048; i += NTHR) { const int t = i >> 5, k = i & 31; const float qv = QQ[i] * 0.17677669529663687f, kv = KK[i];
            const float bf_ = LA[t * 32 + k], bb_ = LA[(64 + t) * 32 + k];
            QF[t * 40 + k] = bf1(qv * __expf(bf_)); KF[t * 40 + k] = bf1(kv * __expf(-bf_)); QB[t * 40 + k] = bf1(qv * __expf(bb_)); KB[t * 40 + k] = bf1(kv * __expf(-bb_)); }
        { const int k = tid >> 4, v4 = (tid & 15) * 4;
          STF[(v4 + 0) * 40 + k] = bf1(a.x); STF[(v4 + 1) * 40 + k] = bf1(a.y); STF[(v4 + 2) * 40 + k] = bf1(a.z); STF[(v4 + 3) * 40 + k] = bf1(a.w);
          STB[(v4 + 0) * 40 + k] = bf1(c.x); STB[(v4 + 1) * 40 + k] = bf1(c.y); STB[(v4 + 2) * 40 + k] = bf1(c.z); STB[(v4 + 3) * 40 + k] = bf1(c.w); }
        __syncthreads();
        gf32x16 acc = {};
        const int mt = wv & 1, nt = (wv >> 1) & 1;
        if (wv < 4) {
            gf32x16 af = {}, ab = {};
            gmm<32>(af, LB + GB_QF, 80, mt * 32, LB + GB_KF, 80, nt * 32, r32, hi); gmm<32>(ab, LB + GB_QB, 80, mt * 32, LB + GB_KB, 80, nt * 32, r32, hi);
            const int s = nt * 32 + r32;
#pragma unroll
            for (int r = 0; r < 16; ++r) { const int t = mt * 32 + gcrow(r, hi); const float a = (s <= t ? af[r] : 0.f) + (s >= t ? ab[r] : 0.f); ATT[t * 72 + s] = bf1(a); }
        } else {
            gmm<32>(acc, LB + GB_QF, 80, mt * 32, LB + GB_STF, 80, nt * 32, r32, hi); gmm<32>(acc, LB + GB_QB, 80, mt * 32, LB + GB_STB, 80, nt * 32, r32, hi);
        }
        __syncthreads();
        if (wv >= 4) { gmm<64>(acc, LB + GB_ATT, 144, mt * 32, LB + GB_VT, 144, nt * 32, r32, hi);
#pragma unroll
            for (int r = 0; r < 16; ++r) OO[(mt * 32 + gcrow(r, hi)) * 65 + nt * 32 + r32] = acc[r]; }
        __syncthreads();
        { const int t = tid >> 3, vg = tid & 7; float o8[8], ss = 0.f;
#pragma unroll
          for (int i = 0; i < 8; ++i) { o8[i] = OO[t * 65 + vg * 8 + i]; ss += o8[i] * o8[i]; }
          ss += __shfl_xor(ss, 1); ss += __shfl_xor(ss, 2); ss += __shfl_xor(ss, 4);
          const float rs = 1.f / sqrtf(ss * (1.f / 64.f) + RMS_EPS);
          const int row = gla_row0(b, jj) + t;
          float ga[8]; ga[0] = bf2f((unsigned short)gw.x); ga[1] = bf2f((unsigned short)(gw.x >> 16)); ga[2] = bf2f((unsigned short)gw.y); ga[3] = bf2f((unsigned short)(gw.y >> 16));
          ga[4] = bf2f((unsigned short)gw.z); ga[5] = bf2f((unsigned short)(gw.z >> 16)); ga[6] = bf2f((unsigned short)gw.w); ga[7] = bf2f((unsigned short)(gw.w >> 16));
          float y[8];
#pragma unroll
          for (int i = 0; i < 8; ++i) y[i] = o8[i] * rs * gng[vg * 8 + i] * siluf(ga[i]);
          v4u o; o.x = pk2(y[0], y[1]); o.y = pk2(y[2], y[3]); o.z = pk2(y[4], y[5]); o.w = pk2(y[6], y[7]);
          *(GAS v4u*)(Y + (size_t)row * D + h * 64 + vg * 8) = o; }
        __syncthreads();
        u = un;
    }
#undef GLA_PF
#undef GLA_SKIP
}

constexpr int FN = 32768, FN1 = 128, FN2 = 256;
constexpr size_t WS_FA = WS_XN + 33 * MiB;
constexpr size_t WS_HT = WS_PH;
constexpr size_t WS_FA0 = WS_K, WS_FA1 = WS_VT;
constexpr size_t WS_HID = AB + 521 * MiB, WS_HTC = AB + 526 * MiB, WS_CU = AB + 527 * MiB, WS_OTC = AB + 529 * MiB, WS_NPART = AB + 530 * MiB, WS_END2 = AB + 532 * MiB;
static_assert(WS_FA0 + 64 * MiB <= WS_VT && WS_FA1 + 64 * MiB <= WS_HF && WS_END2 <= 573 * MiB, "hyena map");
constexpr size_t CTL_NRM = 256 * 1024;
constexpr int FFT_TW_OFF = 40960;
typedef float f32x2 __attribute__((ext_vector_type(2)));
__device__ __forceinline__ f32x2 cmul(f32x2 a, f32x2 b) { return (f32x2){a.x * b.x - a.y * b.y, a.x * b.y + a.y * b.x}; }
__device__ __forceinline__ unsigned pkc(f32x2 v) { return pk2(v.x, v.y); }
__device__ __forceinline__ f32x2 upc(unsigned w) { return (f32x2){__uint_as_float(w << 16), __uint_as_float(w & 0xffff0000u)}; }
__device__ __forceinline__ f32x2 twid(float rev) { return (f32x2){__builtin_amdgcn_cosf(rev), __builtin_amdgcn_sinf(rev)}; }
__device__ __forceinline__ float nrm_lat(const Frame& F, int order, int c) {
    LAS float* red = (LAS float*)(F.lds + FFT_TW_OFF + 1024); const GAS float* NP = (const GAS float*)(F.ws + WS_NPART);
    const float v = wave_sum(NP[(size_t)(F.tid & 255) * 1024 + order * 512 + (F.tid >> 8) * 256 + c]);
    __syncthreads(); if (F.lane == 0) red[F.wave] = v; __syncthreads();
    float s = 0.f;
#pragma unroll
    for (int w = 0; w < 8; ++w) s += red[w];
    return 1.f / sqrtf(s + 1e-6f);
}
__device__ __forceinline__ float nrm_ctx(const Frame& F, int order, int c) { const GAS float* NP = (const GAS float*)(F.ws + WS_NPART); float s = 0.f;
#pragma unroll
    for (int pb = 256; pb < 260; ++pb) s += NP[(size_t)pb * 1024 + order * 512 + c] + NP[(size_t)pb * 1024 + order * 512 + 256 + c];
    return 1.f / sqrtf(s + 1e-6f); }

__device__ __forceinline__ void p_filt_hidden(const Frame& F0, int l) { const Frame F = launder(F0);
    LAS float* L = (LAS float*)F.lds; LAS float* W1 = L, * W2 = L + 33 * 64, * H1 = W2 + 64 * 64, * PB = H1 + 128 * 65;
    GAS float* HID = (GAS float*)(F.ws + WS_HID); const int tid = F.tid;
    for (int i = tid; i < 33 * 64; i += NTHR) W1[i] = F.in[I_HW1][l * 33 * 64 + i];
    for (int i = tid; i < 64 * 64; i += NTHR) W2[i] = F.in[I_HW2][l * 64 * 64 + i];
    if (tid < 64) { PB[tid] = F.in[I_HB1][l * 64 + tid]; PB[64 + tid] = F.in[I_HF1][l * 64 + tid]; PB[128 + tid] = F.in[I_HB2][l * 64 + tid]; PB[192 + tid] = F.in[I_HF2][l * 64 + tid]; }
    __syncthreads();
    const int p = tid & 127, jq = tid >> 7;
    for (int blk = blockIdx.x; blk < (SEQ + CTXL) / 128; blk += F.G) {
        const int prow = blk * 128 + p; const bool lat = prow < SEQ; const int pos = lat ? prow : prow - SEQ; const float Lf = lat ? (float)SEQ : (float)CTXL;
        float z[33]; z[0] = (float)pos / (Lf - 1.f);
#pragma unroll
        for (int i = 0; i < 16; ++i) { const float fr = 1e-4f + (float)i * ((15.f - 1e-4f) / 15.f); float rev = (float)pos * fr / Lf; rev -= floorf(rev);
            z[1 + i] = __builtin_amdgcn_cosf(rev); z[17 + i] = -__builtin_amdgcn_sinf(rev); }
        for (int j = jq * 16; j < jq * 16 + 16; ++j) { float a = PB[j];
#pragma unroll
            for (int i = 0; i < 33; ++i) a += z[i] * W1[i * 64 + j];
            H1[p * 65 + j] = __sinf(PB[64 + j] * a); }
        __syncthreads();
        for (int j = jq * 16; j < jq * 16 + 16; ++j) { float a = PB[128 + j];
            for (int i = 0; i < 64; ++i) a += H1[p * 65 + i] * W2[i * 64 + j];
            HID[(size_t)prow * 64 + j] = __sinf(PB[192 + j] * a); }
        __syncthreads();
    }
}
__device__ __forceinline__ void p_filt_raw(const Frame& F0, int l) { const Frame F = launder(F0);
    LAS unsigned char* LB = F.lds; LAS unsigned char* HSH = LB, * HSL = LB + 9216, * W3H = LB + 18432, * W3L = LB + 18432 + 36864; const int tid = F.tid;
    const GAS float* HID = (const GAS float*)(F.ws + WS_HID); GAS float* HT = (GAS float*)(F.ws + WS_HT); GAS float* HTC = (GAS float*)(F.ws + WS_HTC);
    const GAS float* w3 = F.in[I_HW3] + (size_t)l * 64 * 1024; const GAS float* b3 = F.in[I_HB3] + l * 1024;
    const int wv = tid >> 6, lane = tid & 63, r32 = lane & 31, hi = lane >> 5;
    int cbl = -1;
    __syncthreads();
    for (int u = blockIdx.x; u < ((SEQ + CTXL) / 64) * 4; u += F.G) {
        const int pb = u >> 2, cb = u & 3, prow0 = pb * 64; const bool lat = prow0 < SEQ; const int pos0 = lat ? prow0 : prow0 - SEQ; const float Lf = lat ? (float)SEQ : (float)CTXL;
        if (cb != cbl) { cbl = cb;
            for (int i = tid; i < 32 * 256; i += NTHR) { const int ip = i >> 8, col = i & 255;
                const float wa = w3[(size_t)(2 * ip) * 1024 + cb * 256 + col], wb = w3[(size_t)(2 * ip + 1) * 1024 + cb * 256 + col];
                const unsigned short ha = bf1(wa), hb = bf1(wb);
                *(LAS unsigned*)(W3H + col * 144 + ip * 4) = (unsigned)ha | ((unsigned)hb << 16);
                *(LAS unsigned*)(W3L + col * 144 + ip * 4) = pk2(wa - bf2f(ha), wb - bf2f(hb)); } }
        { const int p = tid >> 3, c8 = (tid & 7) * 8; const GAS f32x4* src = (const GAS f32x4*)(HID + (size_t)(prow0 + p) * 64 + c8); const f32x4 x0 = src[0], x1 = src[1];
          const unsigned short h0 = bf1(x0.x), h1 = bf1(x0.y), h2 = bf1(x0.z), h3 = bf1(x0.w), h4 = bf1(x1.x), h5 = bf1(x1.y), h6 = bf1(x1.z), h7 = bf1(x1.w);
          v4u vh, vl; vh.x = (unsigned)h0 | ((unsigned)h1 << 16); vh.y = (unsigned)h2 | ((unsigned)h3 << 16); vh.z = (unsigned)h4 | ((unsigned)h5 << 16); vh.w = (unsigned)h6 | ((unsigned)h7 << 16);
          vl.x = pk2(x0.x - bf2f(h0), x0.y - bf2f(h1)); vl.y = pk2(x0.z - bf2f(h2), x0.w - bf2f(h3)); vl.z = pk2(x1.x - bf2f(h4), x1.y - bf2f(h5)); vl.w = pk2(x1.z - bf2f(h6), x1.w - bf2f(h7));
          *(LAS v4u*)(HSH + p * 144 + c8 * 2) = vh; *(LAS v4u*)(HSL + p * 144 + c8 * 2) = vl; }
        __syncthreads();
        const int col = cb * 256 + wv * 32 + r32, ch = col & 255; const float delta = 3.0701134573253944f + (float)ch * (12.280453829301578f / 255.f), bias = b3[col];
        GAS float* dcol = lat ? HT + (size_t)col * SEQ + pos0 : HTC + (size_t)col * CTXL + pos0;
        float ss = 0.f;
#pragma unroll
        for (int mt = 0; mt < 2; ++mt) { gf32x16 acc = {};
            gmm<64>(acc, HSH, 144, mt * 32, W3H, 144, wv * 32, r32, hi); gmm<64>(acc, HSL, 144, mt * 32, W3H, 144, wv * 32, r32, hi); gmm<64>(acc, HSH, 144, mt * 32, W3L, 144, wv * 32, r32, hi);
#pragma unroll
            for (int g = 0; g < 4; ++g) { float o[4];
#pragma unroll
                for (int a = 0; a < 4; ++a) { const int pp = mt * 32 + 8 * g + 4 * hi + a; const float t = (float)(pos0 + pp) / (Lf - 1.f); o[a] = (acc[4 * g + a] + bias) * __expf(-t * delta); ss += o[a] * o[a]; }
                *(GAS f32x4*)(dcol + mt * 32 + 8 * g + 4 * hi) = (f32x4){o[0], o[1], o[2], o[3]}; } }
        ss += __shfl_xor(ss, 32);
        if (hi == 0) ((GAS float*)(F.ws + WS_NPART))[(size_t)pb * 1024 + col] = ss;
        __syncthreads();
    }
}
__device__ __forceinline__ void fft_tw_init(LAS unsigned char* lds, int tid) { if (tid < 128) ((LAS f32x2*)(lds + FFT_TW_OFF))[tid] = twid(-(float)tid * (1.f / 256.f)); __syncthreads(); }
__device__ __forceinline__ f32x2 cconj(f32x2 a) { return (f32x2){a.x, -a.y}; }
__device__ __forceinline__ f32x2 mul_mi(f32x2 a) { return (f32x2){a.y, -a.x}; }
__device__ __forceinline__ f32x2 mul_pi(f32x2 a) { return (f32x2){-a.y, a.x}; }
template <int ST>
__device__ __forceinline__ void dif4(LAS f32x2* X, const LAS f32x2* TW, int base, int g, int s) {
    const int h = 1 << s, p = g & ((h >> 1) - 1), i = (((g >> (s - 1)) << (s + 1)) | p);
    LAS f32x2* P0 = X + base + i * ST; LAS f32x2* P1 = P0 + (h >> 1) * ST; LAS f32x2* P2 = P0 + h * ST; LAS f32x2* P3 = P1 + h * ST;
    const f32x2 x0 = *P0, x1 = *P1, x2 = *P2, x3 = *P3, wa = TW[p << (7 - s)], wc = TW[p << (8 - s)];
    const f32x2 y0 = x0 + x2, y2 = cmul(x0 - x2, wa), y1 = x1 + x3, y3 = mul_mi(cmul(x1 - x3, wa));
    *P0 = y0 + y1; *P1 = cmul(y0 - y1, wc); *P2 = y2 + y3; *P3 = cmul(y2 - y3, wc);
}
template <int ST>
__device__ __forceinline__ void dit4(LAS f32x2* X, const LAS f32x2* TW, int base, int g, int s) {
    const int h = 1 << s, p = g & (h - 1), i = (((g >> s) << (s + 2)) | p);
    LAS f32x2* P0 = X + base + i * ST; LAS f32x2* P1 = P0 + h * ST; LAS f32x2* P2 = P1 + h * ST; LAS f32x2* P3 = P2 + h * ST;
    const f32x2 w1 = cconj(TW[p << (7 - s)]), w2 = cconj(TW[p << (6 - s)]);
    const f32x2 x0 = *P0, x1 = cmul(*P1, w1), x2 = *P2, x3 = cmul(*P3, w1);
    const f32x2 y0 = x0 + x1, y1 = x0 - x1, y2 = cmul(x2 + x3, w2), y3 = mul_pi(cmul(x2 - x3, w2));
    *P0 = y0 + y2; *P2 = y0 - y2; *P1 = y1 + y3; *P3 = y1 - y3;
}
__device__ __forceinline__ void fft128_cols_fwd(LAS f32x2* X, int tid) {
    const int j = tid & 31, q0 = tid >> 5; const LAS f32x2* TW = (const LAS f32x2*)((const LAS unsigned char*)X + FFT_TW_OFF);
#pragma unroll 1
    for (int s = 6; s >= 2; s -= 2) { dif4<32>(X, TW, j, q0, s); dif4<32>(X, TW, j, q0 + 16, s); __syncthreads(); }
#pragma unroll
    for (int i = 0; i < 4; ++i) { const int q = q0 + 16 * i; const f32x2 a = X[(2 * q) * 32 + j], b = X[(2 * q + 1) * 32 + j]; X[(2 * q) * 32 + j] = a + b; X[(2 * q + 1) * 32 + j] = a - b; }
    __syncthreads();
}
__device__ __forceinline__ void fft128_cols_inv(LAS f32x2* X, int tid) {
    const int j = tid & 31, q0 = tid >> 5; const LAS f32x2* TW = (const LAS f32x2*)((const LAS unsigned char*)X + FFT_TW_OFF);
#pragma unroll
    for (int i = 0; i < 4; ++i) { const int q = q0 + 16 * i; const f32x2 a = X[(2 * q) * 32 + j], b = X[(2 * q + 1) * 32 + j]; X[(2 * q) * 32 + j] = a + b; X[(2 * q + 1) * 32 + j] = a - b; }
    __syncthreads();
#pragma unroll 1
    for (int s = 1; s <= 5; s += 2) { dit4<32>(X, TW, j, q0, s); dit4<32>(X, TW, j, q0 + 16, s); __syncthreads(); }
}
__device__ __forceinline__ void fft256_rows_fwd(LAS f32x2* X, int tid) {
    const int g = tid & 63, r0 = tid >> 6; const LAS f32x2* TW = (const LAS f32x2*)((const LAS unsigned char*)X + FFT_TW_OFF);
#pragma unroll 1
    for (int s = 7; s >= 1; s -= 2) { dif4<1>(X, TW, r0 * 256, g, s); dif4<1>(X, TW, (r0 + 8) * 256, g, s); __syncthreads(); }
}
__device__ __forceinline__ void fft256_rows_inv(LAS f32x2* X, int tid) {
    const int g = tid & 63, r0 = tid >> 6; const LAS f32x2* TW = (const LAS f32x2*)((const LAS unsigned char*)X + FFT_TW_OFF);
#pragma unroll 1
    for (int s = 0; s <= 6; s += 2) { dit4<1>(X, TW, r0 * 256, g, s); dit4<1>(X, TW, (r0 + 8) * 256, g, s); __syncthreads(); }
}
__device__ __forceinline__ int bitrev7(int r) { return (int)(__brev((unsigned)r) >> 25); }
template <int KIND>
__device__ __forceinline__ void p_fft_pass1(const Frame& F0, int order, size_t ws_a) { const Frame F = launder(F0);
    fft_tw_init(F.lds, F.tid);
    LAS f32x2* X = (LAS f32x2*)F.lds; const int tid = F.tid, j = tid & 31, q0 = tid >> 5;
    const GAS float* VT = (const GAS float*)(F.ws + WS_VT); const GAS float* HT = (const GAS float*)(F.ws + WS_HT); GAS unsigned* A = (GAS unsigned*)(F.ws + ws_a);
    f32x2 pre[8];
#define P1_LOAD(uu) do { const int sg_ = (uu) >> 3, nb_ = (uu) & 7; _Pragma("unroll") for (int i = 0; i < 8; ++i) { const int n1 = q0 + 16 * i, n = 256 * n1 + 32 * nb_ + j; f32x2 v = {0.f, 0.f}; \
        if (KIND == 0) { if (n1 < 64) { v.x = VT[(size_t)(sg_ * 2 + 0) * SEQ + n]; v.y = VT[(size_t)(sg_ * 2 + 1) * SEQ + n]; } } \
        else { const GAS float* hf = HT + (size_t)(order * 512 + sg_) * SEQ; const GAS float* hb = HT + (size_t)(order * 512 + 256 + sg_) * SEQ; \
               if (n < SEQ) v.x = hf[n]; else if (n > SEQ) v.x = hb[2 * SEQ - n]; } \
        pre[i] = v; } } while (0)
    int u = blockIdx.x; if (u < 256 * 8) P1_LOAD(u);
    for (; u < 256 * 8; u += F.G) {
        const int sg = u >> 3, nb = u & 7;
#pragma unroll
        for (int i = 0; i < 8; ++i) X[(q0 + 16 * i) * 32 + j] = pre[i];
        __syncthreads();
        if (u + F.G < 256 * 8) P1_LOAD(u + F.G);
        fft128_cols_fwd(X, tid);
#pragma unroll
        for (int i = 0; i < 8; ++i) { const int r = q0 + 16 * i, k1 = bitrev7(r), n2 = 32 * nb + j;
            A[((size_t)sg * FN1 + r) * FN2 + n2] = pkc(cmul(X[r * 32 + j], twid(-(float)(n2 * k1) * (1.f / (float)FN)))); }
        __syncthreads();
    }
#undef P1_LOAD
}
template <int KIND>
__device__ __forceinline__ void p_fft_pass2(const Frame& F0, int l, int order, size_t ws_a) { const Frame F = launder(F0);
    fft_tw_init(F.lds, F.tid);
    LAS f32x2* X = (LAS f32x2*)F.lds; const int tid = F.tid;
    GAS unsigned* A = (GAS unsigned*)(F.ws + ws_a); GAS unsigned* HF = (GAS unsigned*)(F.ws + WS_HF);
    unsigned pa[8], ph[8];
#define P2_LOAD(uu) do { const int sg_ = (uu) >> 3, g_ = (uu) & 7; const GAS unsigned* Ab_ = A + ((size_t)sg_ * FN1 + g_ * 16) * FN2; const GAS unsigned* Hb_ = HF + ((size_t)(order * 256 + sg_) * FN1 + g_ * 16) * FN2; \
        _Pragma("unroll") for (int i = 0; i < 8; ++i) { pa[i] = Ab_[tid + NTHR * i]; if (KIND == 0) ph[i] = Hb_[tid + NTHR * i]; } } while (0)
    int u = blockIdx.x; if (u < 256 * 8) P2_LOAD(u);
    for (; u < 256 * 8; u += F.G) {
        const int sg = u >> 3, g = u & 7;
        GAS unsigned* Ab = A + ((size_t)sg * FN1 + g * 16) * FN2; GAS unsigned* Hb = HF + ((size_t)(order * 256 + sg) * FN1 + g * 16) * FN2;
        unsigned hcur[8];
#pragma unroll
        for (int i = 0; i < 8; ++i) { X[tid + NTHR * i] = upc(pa[i]); if (KIND == 0) hcur[i] = ph[i]; }
        __syncthreads();
        if (u + F.G < 256 * 8) P2_LOAD(u + F.G);
        fft256_rows_fwd(X, tid);
        if (KIND == 1) { const float nr = nrm_lat(F, order, sg);
#pragma unroll
            for (int i = 0; i < 8; ++i) { const int e = tid + NTHR * i; const f32x2 v = X[e] * nr; const _Float16 hr = (_Float16)v.x, hi = (_Float16)v.y;
                Hb[e] = (unsigned)__builtin_bit_cast(unsigned short, hr) | ((unsigned)__builtin_bit_cast(unsigned short, hi) << 16); }
            __syncthreads();
        } else {
#pragma unroll
            for (int i = 0; i < 8; ++i) { const int e = tid + NTHR * i; const unsigned hw = hcur[i];
                const f32x2 h = {(float)__builtin_bit_cast(_Float16, (unsigned short)(hw & 0xffffu)), (float)__builtin_bit_cast(_Float16, (unsigned short)(hw >> 16))};
                X[e] = cmul(X[e], h); }
            __syncthreads();
            fft256_rows_inv(X, tid);
#pragma unroll
            for (int i = 0; i < 8; ++i) { const int e = tid + NTHR * i, r = g * 16 + (e >> 8), n2 = e & 255, k1 = bitrev7(r);
                Ab[e] = pkc(cmul(X[e], twid((float)(n2 * k1) * (1.f / (float)FN))) * (1.f / (float)FN)); }
            __syncthreads();
        }
    }
#undef P2_LOAD
}
__device__ __forceinline__ void p_fft_pass3(const Frame& F0, int l, int order) { const Frame F = launder(F0);
    fft_tw_init(F.lds, F.tid);
    LAS f32x2* X = (LAS f32x2*)F.lds; const int tid = F.tid, j = tid & 31, q0 = tid >> 5;
    GAS float* VT = (GAS float*)(F.ws + WS_VT); const GAS bf16* GT = (const GAS bf16*)(F.ws + (order == 0 ? WS_X1T : WS_X2T)); const GAS unsigned* A = (const GAS unsigned*)(F.ws + WS_FA);
    const GAS float* skip = F.in[I_HSKIP] + (size_t)(l * 2 + order) * 256;
    unsigned pa[8]; float pv[4][2]; unsigned short pg[4][2];
#define P3_LOAD(uu) do { const int sg_ = (uu) >> 3, nb_ = (uu) & 7; _Pragma("unroll") for (int i = 0; i < 8; ++i) pa[i] = A[((size_t)sg_ * FN1 + q0 + 16 * i) * FN2 + 32 * nb_ + j]; \
        _Pragma("unroll") for (int i = 0; i < 4; ++i) { const int n = 256 * (q0 + 16 * i) + 32 * nb_ + j; const size_t i0 = (size_t)(sg_ * 2 + 0) * SEQ + n, i1 = (size_t)(sg_ * 2 + 1) * SEQ + n; \
            pv[i][0] = VT[i0]; pv[i][1] = VT[i1]; pg[i][0] = GT[i0]; pg[i][1] = GT[i1]; } } while (0)
    int u = blockIdx.x; if (u < 256 * 8) P3_LOAD(u);
    for (; u < 256 * 8; u += F.G) {
        const int sg = u >> 3, nb = u & 7;
        float cv[4][2], cg[4][2];
#pragma unroll
        for (int i = 0; i < 8; ++i) X[(q0 + 16 * i) * 32 + j] = upc(pa[i]);
#pragma unroll
        for (int i = 0; i < 4; ++i) { cv[i][0] = pv[i][0]; cv[i][1] = pv[i][1]; cg[i][0] = bf2f(pg[i][0]); cg[i][1] = bf2f(pg[i][1]); }
        __syncthreads();
        if (u + F.G < 256 * 8) P3_LOAD(u + F.G);
        fft128_cols_inv(X, tid);
        const float sk = skip[sg];
#pragma unroll
        for (int i = 0; i < 4; ++i) { const int n1 = q0 + 16 * i, n = 256 * n1 + 32 * nb + j; const f32x2 y = X[n1 * 32 + j];
            const size_t i0 = (size_t)(sg * 2 + 0) * SEQ + n, i1 = (size_t)(sg * 2 + 1) * SEQ + n;
            VT[i0] = cg[i][0] * (y.x + sk * cv[i][0]); VT[i1] = cg[i][1] * (y.y + sk * cv[i][1]); }
        __syncthreads();
    }
#undef P3_LOAD
}
__device__ __forceinline__ void p_fft_pass31(const Frame& F0, int l) { const Frame F = launder(F0);
    fft_tw_init(F.lds, F.tid);
    LAS f32x2* X = (LAS f32x2*)F.lds; const int tid = F.tid, j = tid & 31, q0 = tid >> 5;
    GAS float* VT = (GAS float*)(F.ws + WS_VT); const GAS bf16* GT = (const GAS bf16*)(F.ws + WS_X1T); GAS unsigned* A = (GAS unsigned*)(F.ws + WS_FA);
    const GAS float* skip = F.in[I_HSKIP] + (size_t)(l * 2 + 0) * 256;
    unsigned pa[8]; float pv[4][2]; unsigned short pg[4][2];
#define P3_LOAD(uu) do { const int sg_ = (uu) >> 3, nb_ = (uu) & 7; _Pragma("unroll") for (int i = 0; i < 8; ++i) pa[i] = A[((size_t)sg_ * FN1 + q0 + 16 * i) * FN2 + 32 * nb_ + j]; \
        _Pragma("unroll") for (int i = 0; i < 4; ++i) { const int n = 256 * (q0 + 16 * i) + 32 * nb_ + j; const size_t i0 = (size_t)(sg_ * 2 + 0) * SEQ + n, i1 = (size_t)(sg_ * 2 + 1) * SEQ + n; \
            pv[i][0] = VT[i0]; pv[i][1] = VT[i1]; pg[i][0] = GT[i0]; pg[i][1] = GT[i1]; } } while (0)
    int u = blockIdx.x; if (u < 256 * 8) P3_LOAD(u);
    for (; u < 256 * 8; u += F.G) {
        const int sg = u >> 3, nb = u & 7;
        float cv[4][2], cg[4][2];
#pragma unroll
        for (int i = 0; i < 8; ++i) X[(q0 + 16 * i) * 32 + j] = upc(pa[i]);
#pragma unroll
        for (int i = 0; i < 4; ++i) { cv[i][0] = pv[i][0]; cv[i][1] = pv[i][1]; cg[i][0] = bf2f(pg[i][0]); cg[i][1] = bf2f(pg[i][1]); }
        __syncthreads();
        if (u + F.G < 256 * 8) P3_LOAD(u + F.G);
        fft128_cols_inv(X, tid);
        const float sk = skip[sg];
#pragma unroll
        for (int i = 0; i < 4; ++i) { const int n1 = q0 + 16 * i, n = 256 * n1 + 32 * nb + j; const f32x2 y = X[n1 * 32 + j];
            const size_t i0 = (size_t)(sg * 2 + 0) * SEQ + n, i1 = (size_t)(sg * 2 + 1) * SEQ + n;
            const f32x2 z = {cg[i][0] * (y.x + sk * cv[i][0]), cg[i][1] * (y.y + sk * cv[i][1])};
            VT[i0] = z.x; VT[i1] = z.y; X[n1 * 32 + j] = z; X[(n1 + 64) * 32 + j] = (f32x2){0.f, 0.f}; }
        __syncthreads();
        fft128_cols_fwd(X, tid);
#pragma unroll
        for (int i = 0; i < 8; ++i) { const int r = q0 + 16 * i, k1 = bitrev7(r), n2 = 32 * nb + j;
            A[((size_t)sg * FN1 + r) * FN2 + n2] = pkc(cmul(X[r * 32 + j], twid(-(float)(n2 * k1) * (1.f / (float)FN)))); }
        __syncthreads();
    }
#undef P3_LOAD
}
__device__ __forceinline__ void p_hy_shortconv(const Frame& F0, int l) { const Frame F = launder(F0);
    LAS bf16* IN = (LAS bf16*)F.lds; LAS float* OT = (LAS float*)(F.lds + 66 * 256 * 2 + 64); const int tid = F.tid;
    const GAS bf16* PH = (const GAS bf16*)(F.ws + WS_PH); GAS float* VT = (GAS float*)(F.ws + WS_VT); GAS bf16* X1T = (GAS bf16*)(F.ws + WS_X1T); GAS bf16* X2T = (GAS bf16*)(F.ws + WS_X2T); GAS float* CU = (GAS float*)(F.ws + WS_CU);
    const GAS float* cw = F.in[I_HCW] + (size_t)l * 3 * 768; const GAS float* cb = F.in[I_HCB] + (size_t)l * 768;
    const int nlat = NBATCH * (SEQ / 64) * 3, nctx = NBATCH * (CTXL / 64) * 3;
    v4u pw[5];
#define SC_LOAD(u_) do { const bool lat_ = (u_) < nlat; const int uu_ = lat_ ? (u_) : (u_) - nlat; const int grp_ = uu_ % 3, tile_ = (uu_ / 3) % (lat_ ? SEQ / 64 : CTXL / 64), b_ = (uu_ / 3) / (lat_ ? SEQ / 64 : CTXL / 64); \
        const int Ls_ = lat_ ? SEQ : CTXL, t0_ = tile_ * 64; const size_t rowb_ = lat_ ? (size_t)b_ * SEQ : (size_t)TL + b_ * CTXL; \
        _Pragma("unroll") for (int k_ = 0; k_ < 5; ++k_) { const int i_ = tid + NTHR * k_; const int rr_ = i_ >> 5, c8_ = (i_ & 31) * 8, t_ = t0_ + rr_ - 1; pw[k_] = (v4u){0u, 0u, 0u, 0u}; \
            if (i_ < 66 * 32 && t_ >= 0 && t_ < Ls_) pw[k_] = *(const GAS v4u*)(PH + (rowb_ + t_) * NPH + PH_HY + grp_ * 256 + c8_); } } while (0)
    if ((int)blockIdx.x < nlat + nctx) SC_LOAD((int)blockIdx.x);
    for (int u = blockIdx.x; u < nlat + nctx; u += F.G) {
        const bool lat = u < nlat; const int uu = lat ? u : u - nlat; const int grp = uu % 3, tile = (uu / 3) % (lat ? SEQ / 64 : CTXL / 64), b = (uu / 3) / (lat ? SEQ / 64 : CTXL / 64);
        const int t0 = tile * 64;
#pragma unroll
        for (int k = 0; k < 5; ++k) { const int i = tid + NTHR * k; if (i < 66 * 32) *(LAS v4u*)(IN + (i >> 5) * 256 + (i & 31) * 8) = pw[k]; }
        if (u + F.G < nlat + nctx) SC_LOAD(u + F.G);
        __syncthreads();
        { const int c = tid & 255, th = tid >> 8, ch = grp * 256 + c; const float w0 = cw[ch], w1 = cw[768 + ch], w2 = cw[1536 + ch], bb = cb[ch];
          float a = bf2f(IN[(th * 32) * 256 + c]), m = bf2f(IN[(th * 32 + 1) * 256 + c]);
          for (int i = 0; i < 32; ++i) { const float n = bf2f(IN[(th * 32 + i + 2) * 256 + c]); const float y = bb + a * w0 + m * w1 + n * w2; a = m; m = n;
              if (lat) OT[c * 65 + th * 32 + i] = y; else CU[((size_t)b * CTXL + t0 + th * 32 + i) * 768 + ch] = y; } }
        __syncthreads();
        if (lat) { const int t4 = (tid & 15) * 4;
#pragma unroll
            for (int i = 0; i < 8; ++i) { const int c = (tid >> 4) + 32 * i; const LAS float* s = OT + c * 65 + t4; const size_t o = (size_t)(c * 2 + b) * SEQ + t0 + t4;
                if (grp == 0) *(GAS f32x4*)(VT + o) = (f32x4){s[0], s[1], s[2], s[3]};
                else { v2u w; w.x = pk2(s[0], s[1]); w.y = pk2(s[2], s[3]); *(GAS v2u*)((grp == 1 ? X1T : X2T) + o) = w; } } }
        __syncthreads();
    }
}
#undef SC_LOAD
__device__ __forceinline__ void p_hy_ctx(const Frame& F0, int l) { const Frame F = launder(F0);
    LAS float* L = (LAS float*)F.lds; const int tid = F.tid, t = tid & 255, cs = tid >> 8;
    LAS float* SV = L + cs * 1280, * HFW = SV + 256, * HBW = SV + 512, * HF2 = SV + 768, * HB2 = SV + 1024;
    const GAS float* CU = (const GAS float*)(F.ws + WS_CU); const GAS float* HTC = (const GAS float*)(F.ws + WS_HTC); GAS float* OTC = (GAS float*)(F.ws + WS_OTC);
    for (int u = blockIdx.x; u < NBATCH * 128; u += F.G) {
        const int b = u >> 7, c = (u & 127) * 2 + cs;
        const float n0 = nrm_ctx(F, 0, c), n1 = nrm_ctx(F, 1, c);
        const GAS float* cu = CU + ((size_t)b * CTXL + t) * 768;
        const float v = cu[c], x1 = cu[256 + c], x2 = cu[512 + c];
        SV[t] = v; HFW[t] = HTC[(size_t)(0 + c) * CTXL + t] * n0; HBW[t] = HTC[(size_t)(256 + c) * CTXL + t] * n0; HF2[t] = HTC[(size_t)(512 + c) * CTXL + t] * n1; HB2[t] = HTC[(size_t)(768 + c) * CTXL + t] * n1;
        __syncthreads();
        float y = F.in[I_HSKIP][(l * 2 + 0) * 256 + c] * v;
        for (int s = 0; s <= t; ++s) y += HFW[t - s] * SV[s];
        for (int s = t + 1; s < CTXL; ++s) y += HBW[s - t] * SV[s];
        const float z = x1 * y;
        __syncthreads();
        SV[t] = z;
        __syncthreads();
        float y2 = F.in[I_HSKIP][(l * 2 + 1) * 256 + c] * z;
        for (int s = 0; s <= t; ++s) y2 += HF2[t - s] * SV[s];
        for (int s = t + 1; s < CTXL; ++s) y2 += HB2[s - t] * SV[s];
        OTC[((size_t)b * CTXL + t) * 256 + c] = x2 * y2;
        __syncthreads();
    }
}
__device__ __forceinline__ void p_ynorm_b(const Frame& F0, int l, bool with_ctx) { const Frame F = launder(F0);
    LAS float* T = (LAS float*)F.lds; LAS float* RS = T + 256 * 65; LAS float* PS = RS + 64; const int tid = F.tid;
    const GAS float* VT = (const GAS float*)(F.ws + WS_VT); const GAS float* OTC = (const GAS float*)(F.ws + WS_OTC); GAS bf16* Y = (GAS bf16*)(F.ws + WS_Y); const GAS float* hg = F.in[I_HNG] + l * 256;
    const int nlat = NBATCH * (SEQ / 64), nctx = with_ctx ? NBATCH * (CTXL / 64) : 0;
    for (int u = blockIdx.x; u < nlat + nctx; u += F.G) {
        const bool lat = u < nlat; const int uu = lat ? u : u - nlat, b = lat ? uu / (SEQ / 64) : uu / (CTXL / 64), t0 = (lat ? uu % (SEQ / 64) : uu % (CTXL / 64)) * 64;
        const size_t rowb = lat ? (size_t)b * SEQ + t0 : (size_t)TL + b * CTXL + t0;
        if (lat) { const int t4 = (tid & 15) * 4;
#pragma unroll
            for (int i = 0; i < 8; ++i) { const int c = (tid >> 4) + 32 * i; const f32x4 v = *(const GAS f32x4*)(VT + (size_t)(c * 2 + b) * SEQ + t0 + t4); LAS float* d = T + c * 65 + t4; d[0] = v.x; d[1] = v.y; d[2] = v.z; d[3] = v.w; } }
        else { for (int i = tid; i < 64 * 256; i += NTHR) { const int t = i >> 8, c = i & 255; T[c * 65 + t] = OTC[((size_t)b * CTXL + t0 + t) * 256 + c]; } }
        __syncthreads();
        { const int t = tid & 63, part = tid >> 6; float s = 0.f;
          for (int c = part * 32; c < part * 32 + 32; ++c) { const float v = T[c * 65 + t]; s += v * v; }
          PS[part * 64 + t] = s; }
        __syncthreads();
        if (tid < 64) { float s = 0.f;
#pragma unroll
            for (int p = 0; p < 8; ++p) s += PS[p * 64 + tid];
            RS[tid] = 1.f / sqrtf(s * (1.f / 256.f) + RMS_EPS); }
        __syncthreads();
        { const int t = tid >> 3, c0 = (tid & 7) * 8; const float rs = RS[t];
#pragma unroll
          for (int i = 0; i < 4; ++i) { const int c = c0 + 64 * i; float y[8];
#pragma unroll
              for (int e = 0; e < 8; ++e) y[e] = T[(c + e) * 65 + t] * rs * hg[c + e];
              v4u o; o.x = pk2(y[0], y[1]); o.y = pk2(y[2], y[3]); o.z = pk2(y[4], y[5]); o.w = pk2(y[6], y[7]);
              *(GAS v4u*)(Y + (rowb + t) * D + 256 + c) = o; } }
        __syncthreads();
    }
}

enum LP { LP_IN = 0, LP_PREP, LP_GLA2, LP_GLA3, LP_HY0, LP_HY1, LP_HY2, LP_HY3, LP_HY4, LP_HY5, LP_HY6, LP_HY7, LP_ATT, LP_YN, LP_OUT, LP_LN1, LP_F1, LP_F2, LP_M0  , LP_LN2 = LP_M0 + 9, PPL };
constexpr int NPRO = 4;
constexpr int NPHASE = NPRO + DEPTH * PPL;
template <int l>
__device__ __forceinline__ void layer_phases(const Frame& F, const XcdBarrier& bar, const int lo, const int hi) {
#define IN(k) (lo <= (k) && (k) < hi)
#define SEAM(k) do { if ((k) + 1 < hi) xcd_barrier(bar); } while (0)
    LAS unsigned char* ring = F.lds;
    constexpr int pb = NPRO + l * PPL;
#define lng (F.in[I_LNG] + (size_t)l * 2 * D)
#define lnb (F.in[I_LNB] + (size_t)l * 2 * D)
        if (IN(pb + LP_IN)) { const Frame P = launder(F);
            pg8::Gemm g{(const GAS bf16*)(P.ws + WS_XN), (const GAS bf16*)(P.ws + WS_WIN) + (size_t)l * NPH * D, MR, NPH, D, D, 0};
            pg8::StaticOrder S; S.init(MR, NPH, F.G, (int)blockIdx.x);
            EpiStoreBf16 E{(GAS bf16*)(P.ws + WS_PH), NPH, 1.f};
            pg8::gemm_phase<EpiStoreBf16, pg8::StaticOrder, true, true>(ring, g, S, E);
            SEAM(pb + LP_IN);
        }
        if (IN(pb + LP_PREP)) { const Frame P = launder(F); p_prep_mla_rows(F); p_gla_local(F, l);
            p_hy_shortconv(F, l); SEAM(pb + LP_PREP); }
        if (IN(pb + LP_GLA2)) { const Frame P = launder(F);
            { pg8::Gemm g{(const GAS bf16*)(P.ws + WS_PH) + PH_CQ, (const GAS bf16*)(P.ws + WS_WUQ) + (size_t)l * 768 * 256, MR, 768, 256, NPH, 0};
              pg8::StaticOrder S; S.init(MR, 768, F.G, (int)blockIdx.x);
              EpiMlaQ E{P.ws + WS_Q, P.ws + WS_QC, (const GAS float*)(P.ws + WS_RSQ), (const GAS float*)(P.ws + WS_ROPE)};
              pg8::gemm_phase<EpiMlaQ, pg8::StaticOrder, true, true>(ring, g, S, E); }
            { pg8::Gemm g{(const GAS bf16*)(P.ws + WS_PH) + PH_CKV, (const GAS bf16*)(P.ws + WS_WUKV) + (size_t)l * 1024 * 256, MR, 1024, 256, NPH, 0};
              pg8::StaticOrder S; S.init(MR, 1024, F.G, (int)blockIdx.x);
              EpiMlaKV E{P.ws + WS_K, (GAS bf16*)(P.ws + WS_V), (const GAS float*)(P.ws + WS_RSKV)};
              pg8::gemm_phase<EpiMlaKV, pg8::StaticOrder, true, true>(ring, g, S, E); }
            p_gla_scan(F); p_fft_pass1<0>(F, 0, WS_FA);
            SEAM(pb + LP_GLA2);
        }
        if (IN(pb + LP_GLA3)) { const Frame P = launder(F); p_gla_out(F, l, l == 0); p_attn_vt_pack(F); p_fft_pass2<0>(F, l, 0, WS_FA); if constexpr (l == 0) p_hy_ctx(F, l);
            SEAM(pb + LP_GLA3); }
        if (IN(pb + LP_HY0)) { p_fft_pass31(F, l); SEAM(pb + LP_HY0); }
        if (IN(pb + LP_HY1)) { p_fft_pass2<0>(F, l, 1, WS_FA); SEAM(pb + LP_HY1); }
        if (IN(pb + LP_HY2)) { p_fft_pass3(F, l, 1); SEAM(pb + LP_HY2); }
        if (IN(pb + LP_ATT)) { const Frame P = launder(F); p_attention(F, l == 0);
            SEAM(pb + LP_ATT); }
        if (IN(pb + LP_YN)) { const Frame P = launder(F); p_ynorm_c(F, l == 0 ? MR : TL, F.in[I_MNG] + (size_t)l * 512); p_ynorm_b(F, l, l == 0); if constexpr (l == 0) p_filt_hidden(F, 1); SEAM(pb + LP_YN); }
        if (IN(pb + LP_OUT)) { const Frame P = launder(F);
            const int M = (l == 0) ? MR : TL;
            pg8::Gemm g{(const GAS bf16*)(P.ws + WS_Y), (const GAS bf16*)(P.ws + WS_WOUT) + (size_t)l * D * D, M, D, D, D, 0};
            pg8::StaticOrder S; S.init(M, D, F.G, (int)blockIdx.x);
            EpiRes E{l == 0 ? F.in[I_X] : F.out, l == 0 ? F.in[I_CTX] : (const GAS float*)(P.ws + WS_XC), F.out, (GAS float*)(P.ws + WS_XC), modv(F, l, 0, 2)};
            pg8::gemm_phase<EpiRes, pg8::StaticOrder, true, true>(ring, g, S, E);
            if constexpr (l == 0) p_filt_raw(F, 1);
            SEAM(pb + LP_OUT);
        }
        if (IN(pb + LP_LN1)) { const Frame P = launder(F);
            if constexpr (l == 0) { p_ln(F, MR, lng, lnb, true, l, 3); p_fft_pass1<1>(F, 0, WS_FA0); p_fft_pass1<1>(F, 1, WS_FA1); }
            else { p_ln_route(F, lng, lnb, l); p_moe_weights(F); }
            SEAM(pb + LP_LN1);
        }
        if constexpr (l == 0) {
            if (IN(pb + LP_F1)) { const Frame P = launder(F);
                pg8::Gemm g{(const GAS bf16*)(P.ws + WS_XN), (const GAS bf16*)(P.ws + WS_W13), MR, 2 * DFF, D, D, 0};
                pg8::StaticOrder S; S.init(MR, 2 * DFF, F.G, (int)blockIdx.x);
                EpiSwiglu E{(GAS bf16*)(P.ws + WS_G), DFF, 1.f};
                pg8::gemm_phase<EpiSwiglu, pg8::StaticOrder, true, true>(ring, g, S, E);
                p_fft_pass2<1>(F, 1, 0, WS_FA0); p_fft_pass2<1>(F, 1, 1, WS_FA1);
                SEAM(pb + LP_F1);
            }
            if (IN(pb + LP_F2)) { const Frame P = launder(F);
                pg8::Gemm g{(const GAS bf16*)(P.ws + WS_G), (const GAS bf16*)(P.ws + WS_W2), MR, D, DFF, DFF, 0};
                pg8::StaticOrder S; S.init(MR, D, F.G, (int)blockIdx.x);
                EpiRes E{F.out, (const GAS float*)(P.ws + WS_XC), F.out, (GAS float*)(P.ws + WS_XC), modv(F, l, 0, 5)};
                pg8::gemm_phase<EpiRes, pg8::StaticOrder, true, true>(ring, g, S, E);
                SEAM(pb + LP_F2);
            }
            if (IN(pb + LP_LN2)) { const Frame P = launder(F); p_ln(F, MR, lng + D, lnb + D, true, l + 1, 0); SEAM(pb + LP_LN2); }
        } else {
            if (IN(pb + LP_F1)) { const Frame P = launder(F); p_moe_scatter(F); SEAM(pb + LP_F1); }
            for (int ch = 0; ch < MOE_NCHUNK; ++ch) {
                if (IN(pb + LP_F2 + 2 * ch)) { const Frame P = launder(F);
                    moe_base_to_lds(P);
                    pg8::Gemm g{(const GAS bf16*)(P.ws + WS_HS8 + (size_t)ch * MOE_CHUNK_TILES * 256 * D), (const GAS bf16*)(P.ws + WS_WM13), MOE_CHUNK_TILES * 256, 2 * EFF, D / 2, D / 2, (size_t)2 * EFF * D};
                    MoeOrder S; S.init((const LAS int*)(F.lds + LDS_MOEBT), ch, 2 * EFF / 256, F.G, (int)blockIdx.x);
                    EpiSwiglu8 E{P.ws + WS_GC, EFF, 1.f / MOE_WSCALE, MOE_GSCALE};
                    pg8::gemm_phase<EpiSwiglu8, MoeOrder, true, true, true>(ring, g, S, E);
                    SEAM(pb + LP_F2 + 2 * ch);
                }
                if (IN(pb + LP_F2 + 2 * ch + 1)) { const Frame P = launder(F);
                    moe_base_to_lds(P);
                    pg8::Gemm g{(const GAS bf16*)(P.ws + WS_GC), (const GAS bf16*)(P.ws + WS_WM2), MOE_CHUNK_TILES * 256, D, EFF / 2, EFF / 2, (size_t)D * EFF};
                    MoeOrder S; S.init((const LAS int*)(F.lds + LDS_MOEBT), ch, D / 256, F.G, (int)blockIdx.x);
                    EpiStoreBf16 E{(GAS bf16*)(P.ws + WS_HS) + (size_t)ch * MOE_CHUNK_TILES * 256 * D, D, 1.f / (MOE_GSCALE * MOE_W2SCALE)};
                    pg8::gemm_phase<EpiStoreBf16, MoeOrder, true, true, true>(ring, g, S, E);
                    SEAM(pb + LP_F2 + 2 * ch + 1);
                }
            }
            if (IN(pb + LP_LN2)) { const Frame P = launder(F); p_ln_combine(F, lng + D, lnb + D, l); SEAM(pb + LP_LN2); }
        }

#undef lng
#undef lnb
#undef IN
#undef SEAM
}
__global__ void __launch_bounds__(NTHR, 2) mega(Args args) {
    extern __shared__ __attribute__((aligned(16))) unsigned char lds_raw[];
    Frame F;
    F.lds = (LAS unsigned char*)lds_raw; F.ws = args.ws; F.ctl = (gu32*)(args.ws + WS_CTL); F.in = (const GAS float* const GAS*)(args.ws + WS_PTRTAB); F.out = args.out;
    F.tid = threadIdx.x; F.lane = F.tid & 63; F.wave = __builtin_amdgcn_readfirstlane(F.tid >> 6); F.G = gridDim.x;
    F.gw = blockIdx.x * NWAVES + F.wave; F.ngw = F.G * NWAVES;
    volatile LAS unsigned* MISC = (volatile LAS unsigned*)(F.lds + LDS_MISC);
    if (F.tid < 32) MISC[F.tid] = 0u;
    __syncthreads();
    XcdBarrier bar; bar.bar = (unsigned*)(F.ctl + CW_BAR); bar.x = 0; bar.st = nullptr;
#if !MK_PER_PHASE
    bar = xcd_barrier_post((unsigned*)(F.ctl + CW_BAR), MISC + 8);
#endif
    const int lo = args.ph_lo, hi = args.ph_hi;
#define IN(k) (lo <= (k) && (k) < hi)
#define SEAM(k) do { if ((k) + 1 < hi) xcd_barrier(bar); } while (0)
    LAS unsigned char* ring = F.lds;
#define LTID() ({ int t_ = F.tid; asm volatile("" : "+v"(t_)); t_; })

    if (IN(0)) { Frame FK = F; FK.in = (const GAS float* const GAS*)(const GAS void*)args.in;
        if (blockIdx.x == 0 && F.tid < 37) ((const GAS float* GAS*)(args.ws + WS_PTRTAB))[F.tid] = args.in[F.tid];
        p0_modv(FK); p0_weights(FK); p0_rope_table(FK); __syncthreads();     p_filt_hidden(FK, 0);
        SEAM(0); }
    if (IN(1)) { p_xn0(F); p_filt_raw(F, 0);
        SEAM(1); }
    if (IN(2)) { p_fft_pass1<1>(F, 0, WS_FA0); p_fft_pass1<1>(F, 1, WS_FA1); SEAM(2); }
    if (IN(3)) { p_fft_pass2<1>(F, 0, 0, WS_FA0); p_fft_pass2<1>(F, 0, 1, WS_FA1); SEAM(3); }

    layer_phases<0>(F, bar, lo, hi);
    layer_phases<1>(F, bar, lo, hi);
#undef IN
#undef SEAM
}

extern "C" void kernel_launch(void* const* d_in, const int* in_sizes, int n_in, void* d_out, int out_size, void* d_ws, size_t ws_size, hipStream_t stream) {
    static int grid = 0;
    if (grid == 0) {
        if (n_in != 37 || in_sizes[0] != TL * D || out_size != TL * D || ws_size < WS_END2) { fprintf(stderr, "kernel_launch: shape/workspace mismatch (n_in %d in0 %d out %d ws %zu need %zu)\n", n_in, n_in > 0 ? in_sizes[0] : -1, out_size, ws_size, (size_t)WS_END2); grid = -1; return; }
        int dev = 0, cus = 0, per_cu = 0;
        if (hipGetDevice(&dev) != hipSuccess || hipDeviceGetAttribute(&cus, hipDeviceAttributeMultiprocessorCount, dev) != hipSuccess) { grid = -1; return; }
        if (hipFuncSetAttribute((const void*)mega, hipFuncAttributeMaxDynamicSharedMemorySize, LDS_BYTES) != hipSuccess) { fprintf(stderr, "kernel_launch: hipFuncSetAttribute failed\n"); grid = -1; return; }
        if (hipOccupancyMaxActiveBlocksPerMultiprocessor(&per_cu, (const void*)mega, NTHR, LDS_BYTES) != hipSuccess || per_cu < 1) { fprintf(stderr, "kernel_launch: occupancy query says %d\n", per_cu); }
        (void)hipGetLastError();
        grid = cus;
    }
    if (grid < 0) return;
    if (hipMemsetAsync((char*)d_ws + WS_CTL, 0, CTL_ZERO_BYTES, stream) != hipSuccess) return;
    Args a{};
    for (int i = 0; i < 37; ++i) a.in[i] = (const GAS float*)d_in[i];
    a.out = (GAS float*)d_out; a.ws = (GAS unsigned char*)d_ws;
#if MK_PER_PHASE
    for (int p = 0; p < NPHASE; ++p) { a.ph_lo = p; a.ph_hi = p + 1; hipLaunchKernelGGL(mega, dim3(grid), dim3(NTHR), LDS_BYTES, stream, a); }
#else
    a.ph_lo = 0; a.ph_hi = NPHASE;
    hipLaunchKernelGGL(mega, dim3(grid), dim3(NTHR), LDS_BYTES, stream, a);
#endif
    const hipError_t le = hipPeekAtLastError();
    if (le != hipSuccess) fprintf(stderr, "kernel_launch: launch failed: %s\n", hipGetErrorName(le));
}
```

```cpp
#include <hip/hip_runtime.h>
#include <cstdio>
#include <cstdint>
namespace pg8 {
#define PG8_LAS __attribute__((address_space(3)))
#define PG8_GAS __attribute__((address_space(1)))
typedef unsigned short bf16_t;
typedef short bf16x8 __attribute__((ext_vector_type(8)));
typedef float f32x4 __attribute__((ext_vector_type(4)));
typedef unsigned u32x4 __attribute__((ext_vector_type(4)));
typedef int i32x8_t __attribute__((ext_vector_type(8)));
typedef short bf16x16 __attribute__((ext_vector_type(16)));
constexpr int BM = 256, BK = 64, HALF = 128, HTB = HALF * BK * 2  , STAGE_BYTES = 8 * HTB, NXCD = 8, WGM = 8;

__host__ __device__ __forceinline__ int lds_byte(int r, int c) { const int st = (r >> 4) * 2 + (c >> 5), rr = r & 15, cc = c & 31, ob = rr * 64 + cc * 2; return st * 1024 + (ob ^ (((ob >> 9) & 1) << 5)); }
__host__ __device__ __forceinline__ void stage_rc(int b, int& R, int& C) { const int st = b / 1024, sb = b % 1024, swz = sb ^ (((sb >> 9) & 1) << 5); R = (st >> 1) * 16 + swz / 64; C = (st & 1) * 32 + (swz % 64) / 2; }
__host__ __device__ __forceinline__ int perm32(int rho) { const int n = rho >> 4, i = rho & 15; return 8 * (i >> 2) + 4 * n + (i & 3); }

struct Unit { int pm, pn, be; };
struct Gemm { const PG8_GAS bf16_t* A; const PG8_GAS bf16_t* Bt; int M, N, K; int lda; size_t bstride; };

struct StaticOrder {
    int nM, nN, nwg, G, c;
    __host__ __device__ void init(int M, int N, int G_, int c_) { nM = M / BM; nN = N / BM; nwg = nM * nN; G = G_; c = c_; }
    __host__ __device__ bool next(int i, Unit& u) const {
        const long L = (long)i * G + c; if (L >= nwg) return false;
        int wgid = (int)L; { const int q = nwg / NXCD, r = nwg % NXCD, xcd = wgid % NXCD, off = wgid / NXCD; wgid = (xcd < r ? xcd * (q + 1) : r * (q + 1) + (xcd - r) * q) + off; }
        const int nig = WGM * nN, gid = wgid / nig, fm = gid * WGM, gsz = (nM - fm) < WGM ? (nM - fm) : WGM;
        u.pm = fm + ((wgid % nig) % gsz); u.pn = (wgid % nig) / gsz; u.be = 0; return true;
    }
    __device__ __forceinline__ void a_ready(const Unit&) const {}
    __device__ __forceinline__ void done(const Unit&) const {}
};


__device__ __forceinline__ unsigned cvt_pk_bf16(float lo, float hi) { unsigned r; asm volatile("v_cvt_pk_bf16_f32 %0, %1, %2" : "=v"(r) : "v"(lo), "v"(hi)); return r; }
typedef float f32x2 __attribute__((ext_vector_type(2)));
typedef unsigned u32x2 __attribute__((ext_vector_type(2)));

template <class Epi, class Sched, bool ALIGN_EPI = false, bool SP2 = false, bool F8 = false>
__device__ __forceinline__ void gemm_phase(PG8_LAS unsigned char* lds, const Gemm g, const Sched& S, const Epi& E) {
    { unsigned lb_ = (unsigned)(size_t)lds; asm volatile("" : "+s"(lb_)); lds = (PG8_LAS unsigned char*)(size_t)lb_; }
    int tid_ = threadIdx.x; asm volatile("" : "+v"(tid_));
    const int tid = tid_, wid = __builtin_amdgcn_readfirstlane(tid >> 6), lane = tid & 63, wr = wid >> 2, wc = wid & 3, fr = lane & 15, fq = lane >> 4;
    int K_ = g.K; asm volatile("" : "+s"(K_)); const int K = K_, nt = K / BK;
    unsigned voffA[2], voffB[2];
#pragma unroll
    for (int i = 0; i < 2; ++i) { int R, C; stage_rc(tid * 16 + i * 8192, R, C); const int Rb = Epi::PERM ? ((R & ~31) + perm32(R & 31)) : R;
        voffA[i] = (unsigned)(R * g.lda + C) * 2u; voffB[i] = (unsigned)(Rb * K + C) * 2u; }
    const size_t kstep = (size_t)(BK * 2);
    const size_t hstepB = (size_t)HALF * K * 2, hstepA = (size_t)HALF * g.lda * 2;
    const size_t tstepA = 2 * hstepA, tstepB = 2 * hstepB;
    const unsigned ldsw = (unsigned)wid * 1024u;
    const int aoff = lds_byte(wr * 64 + fr, fq * 8), boff = lds_byte(wc * 32 + fr, fq * 8);
#define PG8_SA(b, h) (((b) * 2 + (h)) * HTB)
#define PG8_SB(b, h) ((4 + (b) * 2 + (h)) * HTB)
#define PG8_STAGE(bufoff, gbase, voff) do { _Pragma("unroll") for (int _i = 0; _i < 2; ++_i) \
        __builtin_amdgcn_global_load_lds((const PG8_GAS unsigned*)((const PG8_GAS char*)(gbase) + (voff)[_i]), (PG8_LAS unsigned*)(lds + (bufoff) + ldsw + _i * 8192), 16, 0, 0); } while (0)
#define PG8_LDA(dst, b, h) do { _Pragma("unroll") for (int m = 0; m < 4; ++m) dst[m] = __builtin_shufflevector(*(const PG8_LAS bf16x8*)(lds + PG8_SA(b, h) + aoff + m * 2048), *(const PG8_LAS bf16x8*)(lds + PG8_SA(b, h) + aoff + m * 2048 + 1024), 0, 1, 2, 3, 4, 5, 6, 7, 8, 9, 10, 11, 12, 13, 14, 15); } while (0)
#define PG8_LDB(dst, b, h) do { _Pragma("unroll") for (int n = 0; n < 2; ++n) dst[n] = __builtin_shufflevector(*(const PG8_LAS bf16x8*)(lds + PG8_SB(b, h) + boff + n * 2048), *(const PG8_LAS bf16x8*)(lds + PG8_SB(b, h) + boff + n * 2048 + 1024), 0, 1, 2, 3, 4, 5, 6, 7, 8, 9, 10, 11, 12, 13, 14, 15); } while (0)
#define PG8_HALF(x, k) ((k) == 0 ? __builtin_shufflevector(x, x, 0, 1, 2, 3, 4, 5, 6, 7) : __builtin_shufflevector(x, x, 8, 9, 10, 11, 12, 13, 14, 15))
#define PG8_MMA(ai, bj, At, Bt) do { __builtin_amdgcn_s_setprio(1); if constexpr (F8) { _Pragma("unroll") for (int m = 0; m < 4; ++m) _Pragma("unroll") for (int n = 0; n < 2; ++n) \
        asm volatile("v_mfma_f32_16x16x128_f8f6f4 %0, %1, %2, %0" : "+v"(acc[ai][bj][m][n]) : "v"(__builtin_bit_cast(i32x8_t, Bt[n])), "v"(__builtin_bit_cast(i32x8_t, At[m]))); } \
    else { _Pragma("unroll") for (int m = 0; m < 4; ++m) _Pragma("unroll") for (int n = 0; n < 2; ++n) _Pragma("unroll") for (int k = 0; k < 2; ++k) \
        acc[ai][bj][m][n] = __builtin_amdgcn_mfma_f32_16x16x32_bf16(PG8_HALF(Bt[n], k), PG8_HALF(At[m], k), acc[ai][bj][m][n], 0, 0, 0); } __builtin_amdgcn_s_setprio(0); } while (0)
#define PG8_F8_DRAIN() do { if constexpr (F8) asm volatile("s_nop 15\n\ts_nop 15" ::: "memory"); } while (0)
#define PG8_WAIT_V(n) asm volatile("s_waitcnt vmcnt(" #n ")" ::: "memory")
#define PG8_WAIT_L(n) asm volatile("s_waitcnt lgkmcnt(" #n ")" ::: "memory")
#define PG8_BAR __builtin_amdgcn_s_barrier()
#define PG8_SCHED __builtin_amdgcn_sched_barrier(0)
    Unit cur, nxt; int ui = 0;
    if (!S.next(0, cur)) return;
    f32x4 acc[2][2][4][2];
#pragma unroll
    for (int a = 0; a < 2; ++a)
#pragma unroll
        for (int b = 0; b < 2; ++b)
#pragma unroll
            for (int m = 0; m < 4; ++m)
#pragma unroll
                for (int n = 0; n < 2; ++n) acc[a][b][m][n] = (f32x4){0.f, 0.f, 0.f, 0.f};
    bf16x16 At[4], B0[2], B1[2];
    const PG8_GAS char* cA = (const PG8_GAS char*)g.A + (size_t)cur.pm * tstepA; const PG8_GAS char* cB = (const PG8_GAS char*)g.Bt + (size_t)cur.be * g.bstride + (size_t)cur.pn * tstepB;
    S.a_ready(cur);
    if constexpr (SP2) {
        PG8_STAGE(PG8_SB(0, 0), cB, voffB); PG8_STAGE(PG8_SB(0, 1), cB + hstepB, voffB); PG8_STAGE(PG8_SA(0, 0), cA, voffA); PG8_STAGE(PG8_SA(0, 1), cA + hstepA, voffA);
        if (wr == 1) PG8_BAR;
        PG8_WAIT_V(2); PG8_BAR;
        PG8_STAGE(PG8_SB(1, 0), cB + kstep, voffB); PG8_STAGE(PG8_SA(1, 0), cA + kstep, voffA); PG8_STAGE(PG8_SB(1, 1), cB + hstepB + kstep, voffB);
        PG8_WAIT_V(6); PG8_BAR;
    } else {
        PG8_STAGE(PG8_SB(0, 0), cB, voffB); PG8_STAGE(PG8_SA(0, 0), cA, voffA); PG8_STAGE(PG8_SB(0, 1), cB + hstepB, voffB); PG8_STAGE(PG8_SA(0, 1), cA + hstepA, voffA);
        if (wr == 1) PG8_BAR;
        PG8_WAIT_V(4); PG8_BAR;
        PG8_STAGE(PG8_SB(1, 0), cB + kstep, voffB); PG8_STAGE(PG8_SA(1, 0), cA + kstep, voffA); PG8_STAGE(PG8_SB(1, 1), cB + hstepB + kstep, voffB);
        PG8_WAIT_V(6); PG8_BAR;
    }
    for (;;) {
        const bool has_next = S.next(ui + 1, nxt);
        const PG8_GAS char* nA = has_next ? (const PG8_GAS char*)g.A + (size_t)nxt.pm * tstepA : cA; const PG8_GAS char* nB = has_next ? (const PG8_GAS char*)g.Bt + (size_t)nxt.be * g.bstride + (size_t)nxt.pn * tstepB : cB;
        for (int t = 0; t < nt; t += 2) {
            const bool last = (t == nt - 2);
            const PG8_GAS char* a1 = cA + (size_t)(t + 1) * kstep;
            const PG8_GAS char* a2 = last ? nA : cA + (size_t)(t + 2) * kstep; const PG8_GAS char* b2 = last ? nB : cB + (size_t)(t + 2) * kstep;
            const PG8_GAS char* a3 = a2 + kstep; const PG8_GAS char* b3 = b2 + kstep;
            if (last && has_next) S.a_ready(nxt);
            if constexpr (SP2) {
            PG8_LDB(B0, 0, 0); PG8_LDB(B1, 0, 1); PG8_SCHED; PG8_LDA(At, 0, 0); PG8_STAGE(PG8_SA(1, 1), a1 + hstepA, voffA);
            PG8_WAIT_V(8); PG8_WAIT_L(0); PG8_BAR; PG8_MMA(0, 0, At, B0); PG8_MMA(0, 1, At, B1); PG8_BAR; PG8_SCHED;
            PG8_LDA(At, 0, 1); PG8_STAGE(PG8_SB(0, 0), b2, voffB); PG8_STAGE(PG8_SB(0, 1), b2 + hstepB, voffB); PG8_STAGE(PG8_SA(0, 0), a2, voffA);
            PG8_WAIT_V(8); PG8_WAIT_L(0); PG8_BAR; PG8_MMA(1, 0, At, B0); PG8_MMA(1, 1, At, B1); PG8_BAR; PG8_SCHED;
            PG8_LDB(B0, 1, 0); PG8_LDB(B1, 1, 1); PG8_SCHED; PG8_LDA(At, 1, 0); PG8_STAGE(PG8_SA(0, 1), a2 + hstepA, voffA);
            PG8_WAIT_V(8); PG8_WAIT_L(0); PG8_BAR; PG8_MMA(0, 0, At, B0); PG8_MMA(0, 1, At, B1); PG8_BAR; PG8_SCHED;
            PG8_LDA(At, 1, 1); PG8_STAGE(PG8_SB(1, 0), b3, voffB); PG8_STAGE(PG8_SB(1, 1), b3 + hstepB, voffB); PG8_STAGE(PG8_SA(1, 0), a3, voffA);
            PG8_WAIT_V(8); PG8_WAIT_L(0); PG8_BAR; PG8_MMA(1, 0, At, B0); PG8_MMA(1, 1, At, B1); PG8_BAR; PG8_SCHED;
            } else {
            PG8_LDB(B0, 0, 0); PG8_SCHED; PG8_LDA(At, 0, 0); PG8_STAGE(PG8_SA(1, 1), a1 + hstepA, voffA);
            PG8_WAIT_L(8); PG8_BAR; PG8_WAIT_L(0); PG8_MMA(0, 0, At, B0); PG8_BAR; PG8_SCHED;
            PG8_LDB(B1, 0, 1); PG8_STAGE(PG8_SB(0, 0), b2, voffB);
            PG8_BAR; PG8_WAIT_L(0); PG8_MMA(0, 1, At, B1); PG8_BAR;
            PG8_LDA(At, 0, 1); PG8_STAGE(PG8_SA(0, 0), a2, voffA);
            PG8_BAR; PG8_WAIT_L(0); PG8_MMA(1, 0, At, B0); PG8_BAR; PG8_SCHED;
            PG8_STAGE(PG8_SB(0, 1), b2 + hstepB, voffB);
            PG8_WAIT_V(6); PG8_BAR; PG8_MMA(1, 1, At, B1); PG8_BAR;
            PG8_LDB(B0, 1, 0); PG8_SCHED; PG8_LDA(At, 1, 0); PG8_STAGE(PG8_SA(0, 1), a2 + hstepA, voffA);
            PG8_WAIT_L(8); PG8_BAR; PG8_WAIT_L(0); PG8_MMA(0, 0, At, B0); PG8_BAR; PG8_SCHED;
            PG8_LDB(B1, 1, 1); PG8_STAGE(PG8_SB(1, 0), b3, voffB);
            PG8_BAR; PG8_WAIT_L(0); PG8_MMA(0, 1, At, B1); PG8_BAR;
            PG8_LDA(At, 1, 1); PG8_STAGE(PG8_SA(1, 0), a3, voffA);
            PG8_BAR; PG8_WAIT_L(0); PG8_MMA(1, 0, At, B0); PG8_BAR; PG8_SCHED;
            PG8_STAGE(PG8_SB(1, 1), b3 + hstepB, voffB);
            PG8_WAIT_V(6); PG8_BAR; PG8_MMA(1, 1, At, B1); PG8_BAR;
            }
        }
        if constexpr (ALIGN_EPI) { if (wr == 0) PG8_BAR; }
        PG8_F8_DRAIN();
        if constexpr (!Epi::AFTER_DRAIN) { E(acc, cur, wr, wc, fr, fq); S.done(cur); }
        if (!has_next) break;
#pragma unroll
        for (int a = 0; a < 2; ++a)
#pragma unroll
            for (int b = 0; b < 2; ++b)
#pragma unroll
                for (int m = 0; m < 4; ++m)
#pragma unroll
                    for (int n = 0; n < 2; ++n) acc[a][b][m][n] = (f32x4){0.f, 0.f, 0.f, 0.f};
        cur = nxt; cA = nA; cB = nB; ++ui;
        if constexpr (ALIGN_EPI) { if (wr == 1) PG8_BAR; }
    }
    PG8_WAIT_V(0);
    if constexpr (!ALIGN_EPI) { if (wr == 0) PG8_BAR; }
    PG8_BAR;
    if constexpr (Epi::AFTER_DRAIN) { E.fused(acc, cur, wr, wc, fr, fq, lds, wid, lane); S.done(cur); }
#undef PG8_SA
#undef PG8_SB
#undef PG8_STAGE
#undef PG8_LDA
#undef PG8_LDB
#undef PG8_MMA
#undef PG8_HALF
#undef PG8_F8_DRAIN
#undef PG8_WAIT_V
#undef PG8_WAIT_L
#undef PG8_BAR
#undef PG8_SCHED
}
}


#ifndef MK_PER_PHASE
#define MK_PER_PHASE 0
#endif

constexpr int NWAVES = 8, NTHR = 512;
constexpr int D = 1024, NBATCH = 2, SEQ = 16384, TL = NBATCH * SEQ, CTXL = 256, TC = NBATCH * CTXL, MR = TL + TC;
constexpr int NPH = 2048, DFF = 2816, NEXP = 8, EFF = 3584, DEPTH = 2;
constexpr float ALPHA = 1.41421356237309515f;
constexpr float LN_EPS = 1e-5f, RMS_EPS = 1e-6f;
constexpr int PH_QA = 0, PH_KA = 128, PH_VA = 256, PH_GA = 512, PH_HY = 768, PH_CQ = 1536, PH_CKV = 1792, PH_KR = 1920, PH_ALR = 1952;

constexpr size_t MiB = 1u << 20;
constexpr size_t WS_CTL = 0, CTL_ZERO_BYTES = 1 * MiB;
constexpr int CW_TMO = 0, CW_BAR = 4096;
constexpr size_t CTL_MODV = 64 * 1024;
constexpr size_t WS_SMALL = 1 * MiB;
constexpr size_t WS_PTRTAB = WS_SMALL + 16 * 1024;
constexpr size_t WS_WIN = 2 * MiB, WS_WOUT = 10 * MiB, WS_W13 = 14 * MiB, WS_W2 = 25 * MiB, WS_WUQ = 31 * MiB, WS_WUKV = 32 * MiB;
constexpr size_t AB = 34 * MiB;
constexpr size_t WS_XN = AB, WS_Y = AB + 65 * MiB, WS_PH = AB + 130 * MiB, WS_Q = AB + 260 * MiB, WS_K = AB + 309 * MiB, WS_V = AB + 358 * MiB;
constexpr size_t WS_VT = AB + 391 * MiB, WS_X1T = AB + 423 * MiB, WS_X2T = AB + 439 * MiB, WS_HF = AB + 455 * MiB, WS_XC = AB + 519 * MiB, WS_END = AB + 521 * MiB;
constexpr size_t WS_G = WS_PH;
static_assert(WS_W13 + (size_t)2 * DFF * D * 2 <= WS_W2 && WS_W2 + (size_t)D * DFF * 2 <= WS_WUQ, "weights map");
static_assert(WS_G + (size_t)MR * DFF * 2 <= WS_K, "G overlay");
static_assert(WS_END <= 573 * MiB, "d_ws budget");

constexpr int LDS_BYTES = 147456, LDS_MISC = 131072 + 320;

#define GAS __attribute__((address_space(1)))
#define LAS __attribute__((address_space(3)))
typedef unsigned short bf16;
typedef unsigned v4u __attribute__((ext_vector_type(4)));
typedef unsigned v2u __attribute__((ext_vector_type(2)));
typedef float f32x4 __attribute__((ext_vector_type(4)));
typedef GAS unsigned gu32;
#define RLX_AGENT __ATOMIC_RELAXED, __HIP_MEMORY_SCOPE_AGENT
#define LDS_WAIT() asm volatile("s_waitcnt lgkmcnt(0)" ::: "memory")
#define VM_WAIT() asm volatile("s_waitcnt vmcnt(0)" ::: "memory")
__device__ __forceinline__ unsigned pk2(float lo, float hi) { return pg8::cvt_pk_bf16(lo, hi); }
__device__ __forceinline__ float bf2f(unsigned short h) { return __uint_as_float((unsigned)h << 16); }
__device__ __forceinline__ float siluf(float x) { return x / (1.f + __expf(-x)); }
#define XB_TMO      128
#define XB_XCNT(j)  (256  + 64 * (j))
#define XB_XSUB(j)  (1280 + 64 * (j))
#define XB_XGEN(j)  (2304 + 64 * (j))
#define XB_TOP      3328
#define XB_TOPGEN   3392
#define XCD_BAR_WORDS 3456
#define XB_SPIN_CAP (1u << 18)

__device__ __forceinline__ unsigned xb_ld(unsigned* p)              { return __hip_atomic_load(p, __ATOMIC_RELAXED, __HIP_MEMORY_SCOPE_AGENT); }
__device__ __forceinline__ unsigned xb_add(unsigned* p, unsigned v) { return __hip_atomic_fetch_add(p, v, __ATOMIC_RELAXED, __HIP_MEMORY_SCOPE_AGENT); }
__device__ __forceinline__ unsigned xb_xcc_id() { return (unsigned)__builtin_amdgcn_s_getreg((3 << 11) | 20) & 0xFu; }
#define XB_SPIN(cond, bar) do { unsigned _sp = 0; while (cond) { __builtin_amdgcn_s_sleep(1); \
    if ((++_sp & 255u) == 0u) { if (xb_ld(&(bar)[XB_TMO])) break; if (_sp > XB_SPIN_CAP) { atomicAdd(&(bar)[XB_TMO], 1u); break; } } } } while (0)

struct XcdBarrier {
    unsigned* bar; unsigned x;
    volatile LAS unsigned* st;
};

__device__ __forceinline__ XcdBarrier xcd_barrier_post(unsigned* bar, volatile LAS unsigned* st) {
    XcdBarrier b; b.bar = bar; b.x = xb_xcc_id(); b.st = st;
    if (threadIdx.x == 0) (void)xb_add(&bar[XB_XCNT(b.x)], 1u);
    return b;
}
__device__ __forceinline__ void xcd_barrier_complete(unsigned* bar, unsigned x, unsigned& nloc, unsigned& nx) {
    const unsigned G = gridDim.x * gridDim.y * gridDim.z;
    unsigned sum, cnt, mine, sp = 0u;
    for (;;) {
        sum = 0u; cnt = 0u; mine = 0u;
#pragma unroll
        for (unsigned j = 0; j < 16; ++j) { const unsigned c = xb_ld(&bar[XB_XCNT(j)]); sum += c; cnt += (c > 0u) ? 1u : 0u; mine = (j == x) ? c : mine; }
        if (sum == G) break;
        __builtin_amdgcn_s_sleep(1);
        if ((++sp & 255u) == 0u) { if (xb_ld(&bar[XB_TMO])) break; if (sp > XB_SPIN_CAP) { atomicAdd(&bar[XB_TMO], 1u); break; } }
    }
    nloc = mine > 0u ? mine : 1u; nx = cnt > 0u ? cnt : 1u;
}

__device__ __forceinline__ void xcd_barrier(const XcdBarrier& b) {
    asm volatile("s_waitcnt vmcnt(0)" ::: "memory");
    __syncthreads();
    if (threadIdx.x == 0) {
        unsigned* bar = b.bar;
        __builtin_amdgcn_s_waitcnt(0);
        unsigned nloc = b.st[0], nx = b.st[1];
        if (nloc == 0u) { xcd_barrier_complete(bar, b.x, nloc, nx); b.st[0] = nloc; b.st[1] = nx; }
        const unsigned old = xb_add(&bar[XB_XSUB(b.x)], 1u);
        const unsigned gen = old / nloc;
        if (old + 1u == (gen + 1u) * nloc) {
            __builtin_amdgcn_fence(__ATOMIC_RELEASE, "agent");
            asm volatile("s_waitcnt vmcnt(0)" ::: "memory");
            const unsigned og = xb_add(&bar[XB_TOP], 1u);
            const unsigned tg = og / nx;
            if (og + 1u == (tg + 1u) * nx) xb_add(&bar[XB_TOPGEN], 1u);
            else XB_SPIN(xb_ld(&bar[XB_TOPGEN]) == tg, bar);
            __builtin_amdgcn_fence(__ATOMIC_ACQUIRE, "agent");
            xb_add(&bar[XB_XGEN(b.x)], 1u);
            asm volatile("s_waitcnt vmcnt(0)" ::: "memory");
        } else {
            XB_SPIN(xb_ld(&bar[XB_XGEN(b.x)]) == gen, bar);
            __builtin_amdgcn_fence(__ATOMIC_ACQUIRE, "agent");
            asm volatile("s_waitcnt vmcnt(0)" ::: "memory");
        }
    }
    __syncthreads();
}

struct Args { const GAS float* in[37]; GAS float* out; GAS unsigned char* ws; int ph_lo, ph_hi; };
enum In { I_X = 0, I_C, I_CTX, I_CCTX, I_WMOD, I_BMOD, I_WIN, I_GWG, I_GBG, I_GNG, I_HCW, I_HCB, I_HW1, I_HB1, I_HF1, I_HW2, I_HB2, I_HF2, I_HW3, I_HB3, I_HSKIP, I_HNG,
          I_QNG, I_WUQ, I_KVNG, I_WUKV, I_MNG, I_WOUT, I_LNG, I_LNB, I_FW1, I_FW3, I_FW2, I_ROUTER, I_MW1, I_MW3, I_MW2 };

struct Frame {
    LAS unsigned char* lds; GAS unsigned char* ws; gu32* ctl; const GAS float* const GAS* in; GAS float* out;
    int tid, lane, wave, G, gw, ngw;
};
__device__ __forceinline__ Frame launder(const Frame& F0) { Frame F = F0; int t = F0.tid; size_t z = 0; asm volatile("" : "+v"(t), "+s"(z)); F.tid = t; F.lane = t & 63; F.ws = F0.ws + z; F.ctl = (gu32*)(F.ws + WS_CTL); F.out = F0.out + z; return F; }
__device__ __forceinline__ float wave_sum(float v) {
#pragma unroll
    for (int o = 1; o < 64; o <<= 1) v += __shfl_xor(v, o);
    return v;
}
template <int CTRL, int RM> __device__ __forceinline__ float wdpp(float v) { return __int_as_float(__builtin_amdgcn_update_dpp(0, __float_as_int(v), CTRL, RM, 0xf, false)); }
__device__ __forceinline__ float wave_sum_dpp(float v) {
    v += wdpp<0x111, 0xf>(v); v += wdpp<0x112, 0xf>(v); v += wdpp<0x114, 0xf>(v); v += wdpp<0x118, 0xf>(v); v += wdpp<0x142, 0xa>(v); v += wdpp<0x143, 0xc>(v);
    return __int_as_float(__builtin_amdgcn_readlane(__float_as_int(v), 63));
}
__device__ __forceinline__ const GAS float* modv(const Frame& F, int l, int v, int i) { return (const GAS float*)(F.ws + CTL_MODV) + ((size_t)(l * 3 + v) * 6 + i) * D; }
__device__ __forceinline__ int row_v(int row) { return row < TL ? (row >> 14) : 2; }

__device__ __forceinline__ void p0_modv(const Frame& F0) { const Frame F = launder(F0);
    const GAS float* c = F.in[I_C]; const GAS float* cc = F.in[I_CCTX]; const GAS float* wm = F.in[I_WMOD]; const GAS float* bm = F.in[I_BMOD];
    GAS float* mv = (GAS float*)(F.ws + CTL_MODV); LAS float* part = (LAS float*)F.lds;
    constexpr int NBLK = 6 * D / 64, NITEM = DEPTH * NBLK;
    for (int it = blockIdx.x; it < NITEM; it += F.G) {
        const int l = it / NBLK, nb = it % NBLK, n = nb * 64 + F.lane, k0 = F.wave * 128;
        const float s0a = siluf(c[k0 + F.lane]), s1a = siluf(c[D + k0 + F.lane]), s2a = siluf(cc[k0 + F.lane]);
        const float s0b = siluf(c[k0 + 64 + F.lane]), s1b = siluf(c[D + k0 + 64 + F.lane]), s2b = siluf(cc[k0 + 64 + F.lane]);
        float a0 = 0.f, a1 = 0.f, a2 = 0.f;
        const GAS float* w = wm + ((size_t)l * D + k0) * (6 * D) + n;
#pragma unroll 16
        for (int kk = 0; kk < 64; ++kk) { const float wv = w[(size_t)kk * (6 * D)]; a0 += __shfl(s0a, kk) * wv; a1 += __shfl(s1a, kk) * wv; a2 += __shfl(s2a, kk) * wv; }
#pragma unroll 16
        for (int kk = 0; kk < 64; ++kk) { const float wv = w[(size_t)(64 + kk) * (6 * D)]; a0 += __shfl(s0b, kk) * wv; a1 += __shfl(s1b, kk) * wv; a2 += __shfl(s2b, kk) * wv; }
        part[(F.wave * 3 + 0) * 64 + F.lane] = a0; part[(F.wave * 3 + 1) * 64 + F.lane] = a1; part[(F.wave * 3 + 2) * 64 + F.lane] = a2;
        __syncthreads();
        if (F.tid < 192) { const int v = F.tid >> 6, ln = F.tid & 63; float acc = bm[l * 6 * D + nb * 64 + ln];
#pragma unroll
            for (int wv = 0; wv < 8; ++wv) acc += part[(wv * 3 + v) * 64 + ln];
            mv[(size_t)(l * 3 + v) * 6 * D + nb * 64 + ln] = acc; }
        __syncthreads();
    }
}
template <class RowMap>
__device__ __forceinline__ void transpose_item(const GAS float* W, int N, GAS bf16* WT, int ldk, LAS float* scr, int item, int lane, const RowMap& rm, const GAS float* ks) {
    const int nblk = N / 32, kb = item / nblk, nb = item % nblk, k0 = 64 * kb, n0 = 32 * nb;
#pragma unroll 8
    for (int i = 0; i < 32; ++i) { const int kk = 2 * i + (lane >> 5); float v = W[(size_t)(k0 + kk) * N + n0 + (lane & 31)]; if (ks) v *= ks[k0 + kk]; scr[kk * 33 + (lane & 31)] = v; }
    LDS_WAIT(); asm volatile("" ::: "memory");
    const int c = lane & 7;
#pragma unroll
    for (int j = 0; j < 4; ++j) { const int n = (lane >> 3) + 8 * j; const LAS float* s = scr + (8 * c) * 33 + n;
        v4u o; o.x = pk2(s[0 * 33], s[1 * 33]); o.y = pk2(s[2 * 33], s[3 * 33]); o.z = pk2(s[4 * 33], s[5 * 33]); o.w = pk2(s[6 * 33], s[7 * 33]);
        *(GAS v4u*)(WT + (size_t)rm(n0 + n) * ldk + k0 + 8 * c) = o; }
    LDS_WAIT(); asm volatile("" ::: "memory");
}
__device__ __forceinline__ float clamp448(float x) { return fminf(fmaxf(x, -448.f), 448.f); }
__device__ __forceinline__ unsigned pk4_fp8(float a, float b, float c, float d) { unsigned w = 0; w = __builtin_amdgcn_cvt_pk_fp8_f32(clamp448(a), clamp448(b), w, false); w = __builtin_amdgcn_cvt_pk_fp8_f32(clamp448(c), clamp448(d), w, true); return w; }
template <class RowMap>
__device__ __forceinline__ void transpose_item_f8(const GAS float* W, int N, GAS unsigned char* WT, int ldk, LAS float* scr, int item, int lane, const RowMap& rm, float scale) {
    const int nblk = N / 32, kb = item / nblk, nb = item % nblk, k0 = 64 * kb, n0 = 32 * nb;
#pragma unroll 8
    for (int i = 0; i < 32; ++i) { const int kk = 2 * i + (lane >> 5); scr[kk * 33 + (lane & 31)] = W[(size_t)(k0 + kk) * N + n0 + (lane & 31)] * scale; }
    LDS_WAIT(); asm volatile("" ::: "memory");
    const int c = lane & 7;
#pragma unroll
    for (int j = 0; j < 4; ++j) { const int n = (lane >> 3) + 8 * j; const LAS float* s = scr + (8 * c) * 33 + n;
        v2u o; o.x = pk4_fp8(s[0 * 33], s[1 * 33], s[2 * 33], s[3 * 33]); o.y = pk4_fp8(s[4 * 33], s[5 * 33], s[6 * 33], s[7 * 33]);
        *(GAS v2u*)(WT + (size_t)rm(n0 + n) * ldk + k0 + 8 * c) = o; }
    LDS_WAIT(); asm volatile("" ::: "memory");
}
struct RmIdent { int off; __device__ int operator()(int n) const { return n + off; } };
struct RmWin { __device__ int operator()(int c) const {
    if (c < 768) return c; if (c < 800) return PH_ALR + (c - 768); if (c < 1568) return PH_HY + (c - 800); if (c < 1824) return PH_CQ + (c - 1568); if (c < 1952) return PH_CKV + (c - 1824); return PH_KR + (c - 1952); } };
struct RmGlu { int half; __device__ int operator()(int j) const { return (j >> 2) * 8 + half * 4 + (j & 3); } };

__device__ __forceinline__ void p0_weights(const Frame& F0) { const Frame F = launder(F0);
    LAS float* scr = (LAS float*)(F.lds + F.wave * 16384);
    GAS bf16* WIN = (GAS bf16*)(F.ws + WS_WIN); GAS bf16* WOUT = (GAS bf16*)(F.ws + WS_WOUT); GAS bf16* W13 = (GAS bf16*)(F.ws + WS_W13); GAS bf16* W2 = (GAS bf16*)(F.ws + WS_W2);
    GAS bf16* WUQ = (GAS bf16*)(F.ws + WS_WUQ); GAS bf16* WUKV = (GAS bf16*)(F.ws + WS_WUKV);
    constexpr int I_IN = (D / 64) * (1984 / 32), I_OUT = (D / 64) * (D / 32), I_F1 = (D / 64) * (DFF / 32), I_F2 = (DFF / 64) * (D / 32), I_UQ = (256 / 64) * (768 / 32), I_UKV = (128 / 64) * (1024 / 32);
    constexpr int NITEM = DEPTH * I_IN + DEPTH * I_OUT + 2 * I_F1 + I_F2 + DEPTH * I_UQ + DEPTH * I_UKV;
    for (int it = F.gw; it < NITEM; it += F.ngw) {
        int r = it;
        if (r < DEPTH * I_IN) { const int l = r / I_IN; transpose_item(F.in[I_WIN] + (size_t)l * D * 1984, 1984, WIN + (size_t)l * NPH * D, D, scr, r % I_IN, F.lane, RmWin{}, nullptr); continue; } r -= DEPTH * I_IN;
        if (r < DEPTH * I_OUT) { const int l = r / I_OUT; transpose_item(F.in[I_WOUT] + (size_t)l * D * D, D, WOUT + (size_t)l * D * D, D, scr, r % I_OUT, F.lane, RmIdent{0}, nullptr); continue; } r -= DEPTH * I_OUT;
        if (r < I_F1) { transpose_item(F.in[I_FW1], DFF, W13, D, scr, r, F.lane, RmGlu{0}, nullptr); continue; } r -= I_F1;
        if (r < I_F1) { transpose_item(F.in[I_FW3], DFF, W13, D, scr, r, F.lane, RmGlu{1}, nullptr); continue; } r -= I_F1;
        if (r < I_F2) { transpose_item(F.in[I_FW2], D, W2, DFF, scr, r, F.lane, RmIdent{0}, nullptr); continue; } r -= I_F2;
        if (r < DEPTH * I_UQ) { const int l = r / I_UQ; transpose_item(F.in[I_WUQ] + (size_t)l * 256 * 768, 768, WUQ + (size_t)l * 768 * 256, 256, scr, r % I_UQ, F.lane, RmIdent{0}, F.in[I_QNG] + l * 256); continue; } r -= DEPTH * I_UQ;
        { const int l = r / I_UKV; transpose_item(F.in[I_WUKV] + (size_t)l * 128 * 1024, 1024, WUKV + (size_t)l * 1024 * 256, 256, scr, r % I_UKV, F.lane, RmIdent{0}, F.in[I_KVNG] + l * 128); }
    }
    const int gt = blockIdx.x * NTHR + F.tid, ngt = F.G * NTHR;
    for (int i = gt; i < DEPTH * 64 * D / 8; i += ngt) { const int l = i / (64 * D / 8), r = i % (64 * D / 8); *(GAS v4u*)(WIN + ((size_t)l * NPH + 1984) * D + (size_t)r * 8) = (v4u){0u, 0u, 0u, 0u}; }
    for (int i = gt; i < DEPTH * 1024 * 128 / 8; i += ngt) { const int row = i / 16, c = i % 16; *(GAS v4u*)(WUKV + (size_t)row * 256 + 128 + c * 8) = (v4u){0u, 0u, 0u, 0u}; }
}

__device__ __forceinline__ void mod_store_bf16(const f32x4 (&v)[4], const GAS float* sh, const GAS float* sc, GAS bf16* orow, int lane) {
    GAS unsigned long long* o8 = (GAS unsigned long long*)orow + lane;
#pragma unroll
    for (int j = 0; j < 4; ++j) { const f32x4 a = ((const GAS f32x4*)sc)[lane + 64 * j], b = ((const GAS f32x4*)sh)[lane + 64 * j];
        const f32x4 y = v[j] * (a + 1.f) + b;
        o8[64 * j] = (unsigned long long)pk2(y.x, y.y) | ((unsigned long long)pk2(y.z, y.w) << 32); }
}
__device__ __forceinline__ void p_xn0(const Frame& F0) { const Frame F = launder(F0);
    GAS bf16* XN = (GAS bf16*)(F.ws + WS_XN);
    f32x4 nx[4];
#define XN0_LOAD(mm) do { const GAS float* src_ = (mm) < TL ? F.in[I_X] + (size_t)(mm) * D : F.in[I_CTX] + (size_t)((mm) - TL) * D; _Pragma("unroll") for (int j = 0; j < 4; ++j) nx[j] = ((const GAS f32x4*)src_)[F.lane + 64 * j]; } while (0)
    int m = F.gw; if (m < MR) XN0_LOAD(m);
    for (; m < MR; m += F.ngw) {
        f32x4 v[4];
#pragma unroll
        for (int j = 0; j < 4; ++j) v[j] = nx[j];
        if (m + F.ngw < MR) XN0_LOAD(m + F.ngw);
        const int vv = row_v(m);
        mod_store_bf16(v, modv(F, 0, vv, 0), modv(F, 0, vv, 1), XN + (size_t)m * D, F.lane);
    }
#undef XN0_LOAD
}
__device__ __forceinline__ GAS float* xres(const Frame& F, int row) { return row < TL ? F.out + (size_t)row * D : (GAS float*)(F.ws + WS_XC) + (size_t)(row - TL) * D; }
__device__ __forceinline__ void p_ln(const Frame& F0, int nrows, const GAS float* g, const GAS float* b, bool want_xn, int ml, int si) { const Frame F = launder(F0);
    GAS bf16* XN = (GAS bf16*)(F.ws + WS_XN);
    f32x4 nx[4];
    int m = F.gw; if (m < nrows) { const GAS float* r_ = xres(F, m);
#pragma unroll
        for (int j = 0; j < 4; ++j) nx[j] = ((const GAS f32x4*)r_)[F.lane + 64 * j]; }
    for (; m < nrows; m += F.ngw) {
        GAS float* row = xres(F, m);
        f32x4 v[4]; float s = 0.f;
#pragma unroll
        for (int j = 0; j < 4; ++j) { v[j] = nx[j]; s += (v[j].x + v[j].y) + (v[j].z + v[j].w); }
        if (m + F.ngw < nrows) { const GAS float* r_ = xres(F, m + F.ngw);
#pragma unroll
            for (int j = 0; j < 4; ++j) nx[j] = ((const GAS f32x4*)r_)[F.lane + 64 * j]; }
        const float mean = wave_sum(s) * (1.f / D); float s2 = 0.f;
#pragma unroll
        for (int j = 0; j < 4; ++j) { v[j] = v[j] - mean; s2 += (v[j].x * v[j].x + v[j].y * v[j].y) + (v[j].z * v[j].z + v[j].w * v[j].w); }
        const float rstd = 1.f / sqrtf(wave_sum(s2) * (1.f / D) + LN_EPS);
#pragma unroll
        for (int j = 0; j < 4; ++j) { const f32x4 gg = ((const GAS f32x4*)g)[F.lane + 64 * j], bb = ((const GAS f32x4*)b)[F.lane + 64 * j]; v[j] = v[j] * rstd * gg + bb; ((GAS f32x4*)row)[F.lane + 64 * j] = v[j]; }
        if (want_xn) { const int vv = row_v(m); mod_store_bf16(v, modv(F, ml, vv, si), modv(F, ml, vv, si + 1), XN + (size_t)m * D, F.lane); }
    }
}

using pg8::f32x4; using pg8::Unit;
struct EpiStoreBf16 {
    static constexpr bool PERM = true, AFTER_DRAIN = false;
    GAS bf16* O; int ldc; float sc;
    __device__ __forceinline__ void operator()(const pg8::f32x4 (&acc)[2][2][4][2], const Unit& u, int wr, int wc, int fr, int fq) const {
        const int row0 = u.pm * 256 + wr * 64 + fr, col0 = u.pn * 256 + wc * 32 + 8 * fq;
#pragma unroll
        for (int ai = 0; ai < 2; ++ai)
#pragma unroll
            for (int m = 0; m < 4; ++m) { GAS bf16* rowp = O + (size_t)(row0 + ai * 128 + m * 16) * ldc + col0;
#pragma unroll
                for (int bj = 0; bj < 2; ++bj) { const pg8::f32x4 v0 = acc[ai][bj][m][0] * sc, v1 = acc[ai][bj][m][1] * sc;
                    v4u w; w.x = pk2(v0[0], v0[1]); w.y = pk2(v0[2], v0[3]); w.z = pk2(v1[0], v1[1]); w.w = pk2(v1[2], v1[3]);
                    *(GAS v4u*)(rowp + bj * 128) = w; } }
    }
};
struct EpiSwiglu {
    static constexpr bool PERM = true, AFTER_DRAIN = false;
    GAS bf16* G; int ldg; float sc;
    __device__ __forceinline__ void operator()(const pg8::f32x4 (&acc)[2][2][4][2], const Unit& u, int wr, int wc, int fr, int fq) const {
        const int row0 = u.pm * 256 + wr * 64 + fr, col0 = (u.pn * 256 + wc * 32 + 8 * fq) >> 1;
#pragma unroll
        for (int ai = 0; ai < 2; ++ai)
#pragma unroll
            for (int m = 0; m < 4; ++m) { GAS bf16* rowp = G + (size_t)(row0 + ai * 128 + m * 16) * ldg + col0;
#pragma unroll
                for (int bj = 0; bj < 2; ++bj) { const pg8::f32x4 a = acc[ai][bj][m][0] * sc, b = acc[ai][bj][m][1] * sc;
                    v2u w; w.x = pk2(siluf(a[0]) * b[0], siluf(a[1]) * b[1]); w.y = pk2(siluf(a[2]) * b[2], siluf(a[3]) * b[3]);
                    *(GAS v2u*)(rowp + bj * 64) = w; } }
    }
};
struct EpiSwiglu8 {
    static constexpr bool PERM = true, AFTER_DRAIN = false;
    GAS unsigned char* G; int ldg; float sc, osc;
    __device__ __forceinline__ void operator()(const pg8::f32x4 (&acc)[2][2][4][2], const Unit& u, int wr, int wc, int fr, int fq) const {
        const int row0 = u.pm * 256 + wr * 64 + fr, col0 = (u.pn * 256 + wc * 32 + 8 * fq) >> 1;
#pragma unroll
        for (int ai = 0; ai < 2; ++ai)
#pragma unroll
            for (int m = 0; m < 4; ++m) { GAS unsigned char* rowp = G + (size_t)(row0 + ai * 128 + m * 16) * ldg + col0;
#pragma unroll
                for (int bj = 0; bj < 2; ++bj) { const pg8::f32x4 a = acc[ai][bj][m][0] * sc, b = acc[ai][bj][m][1] * sc;
                    *(GAS unsigned*)(rowp + bj * 64) = pk4_fp8(siluf(a[0]) * b[0] * osc, siluf(a[1]) * b[1] * osc, siluf(a[2]) * b[2] * osc, siluf(a[3]) * b[3] * osc); } }
    }
};
struct EpiRes {
    static constexpr bool PERM = false, AFTER_DRAIN = false;
    const GAS float* xin_lat; const GAS float* xin_ctx; GAS float* out_lat; GAS float* out_ctx; const GAS float* gate0;
    __device__ __forceinline__ void operator()(const pg8::f32x4 (&acc)[2][2][4][2], const Unit& u, int wr, int wc, int fr, int fq) const {
        const bool lat = u.pm < TL / 256; const int v = lat ? (u.pm >> 6) : 2;
        const GAS float* xin = lat ? xin_lat : xin_ctx - (size_t)TL * D; GAS float* out = lat ? out_lat : out_ctx - (size_t)TL * D;
        const GAS float* gate = gate0 + (size_t)v * 6 * D;
        const int row0 = u.pm * 256 + wr * 64 + fr, col0 = u.pn * 256 + wc * 32 + 4 * fq;
        pg8::f32x4 gv[2][2];
#pragma unroll
        for (int bj = 0; bj < 2; ++bj)
#pragma unroll
            for (int n = 0; n < 2; ++n) gv[bj][n] = *(const GAS pg8::f32x4*)(gate + col0 + bj * 128 + n * 16);
#pragma unroll
        for (int ai = 0; ai < 2; ++ai)
#pragma unroll
            for (int m = 0; m < 4; ++m) { const size_t off = (size_t)(row0 + ai * 128 + m * 16) * D + col0;
#pragma unroll
                for (int bj = 0; bj < 2; ++bj)
#pragma unroll
                    for (int n = 0; n < 2; ++n) { const pg8::f32x4 xv = *(const GAS pg8::f32x4*)(xin + off + bj * 128 + n * 16);
                        *(GAS pg8::f32x4*)(out + off + bj * 128 + n * 16) = xv * ALPHA + gv[bj][n] * acc[ai][bj][m][n]; } }
    }
};


constexpr int CW_MOECNT = 2048;
constexpr size_t WS_TI = WS_SMALL + 64 * 1024;
constexpr int MOE_CHUNK_TILES = 64, MOE_NCHUNK = 5, MOE_MAXROWS = MOE_NCHUNK * MOE_CHUNK_TILES * 256;
constexpr size_t WS_HS = AB + 65 * MiB, WS_WM13 = AB + 197 * MiB, WS_WM2 = AB + 309 * MiB, WS_GC = AB + 365 * MiB;
constexpr size_t WS_H8 = WS_XN, WS_HS8 = WS_HS + 66 * MiB;
constexpr float MOE_WSCALE = 64.f, MOE_GSCALE = 16.f, MOE_W2SCALE = 256.f;
static_assert(WS_HS + (size_t)(2 * TL + NEXP * 256) * D * 2 <= WS_WM13 && WS_WM13 + (size_t)NEXP * 2 * EFF * D * 2 <= WS_WM2 && WS_WM2 + (size_t)NEXP * D * EFF * 2 <= WS_GC && WS_GC + (size_t)MOE_CHUNK_TILES * 256 * EFF * 2 <= WS_XC, "MoE map");

__device__ __forceinline__ void p_ln_route(const Frame& F0, const GAS float* g, const GAS float* b, int l) { const Frame F = launder(F0);
    GAS bf16* XN = (GAS bf16*)(F.ws + WS_XN);
    GAS int* TI_E = (GAS int*)(F.ws + WS_TI); GAS int* TI_P0 = TI_E + TL; GAS int* TI_P1 = TI_P0 + TL; GAS float* TI_W0 = (GAS float*)(TI_P1 + TL); GAS float* TI_W1 = TI_W0 + TL;
    const GAS float* wr = F.in[I_ROUTER];
    f32x4 rw[4][4][2];
#pragma unroll
    for (int j = 0; j < 4; ++j) { const GAS f32x4* w4 = (const GAS f32x4*)(wr + (size_t)(4 * F.lane + 256 * j) * NEXP);
#pragma unroll
        for (int i = 0; i < 4; ++i) { rw[j][i][0] = w4[2 * i]; rw[j][i][1] = w4[2 * i + 1]; } }
    f32x4 nx[4];
    int e0r = 0, e1r = 0, it = 0;
    int m = F.gw; if (m < TL) {
#pragma unroll
        for (int j = 0; j < 4; ++j) nx[j] = ((const GAS f32x4*)(F.out + (size_t)m * D))[F.lane + 64 * j]; }
    for (; m < TL; m += F.ngw) {
        GAS float* row = F.out + (size_t)m * D;
        f32x4 v[4]; float s = 0.f;
#pragma unroll
        for (int j = 0; j < 4; ++j) { v[j] = nx[j]; s += (v[j].x + v[j].y) + (v[j].z + v[j].w); }
        if (m + F.ngw < TL) {
#pragma unroll
            for (int j = 0; j < 4; ++j) nx[j] = ((const GAS f32x4*)(F.out + (size_t)(m + F.ngw) * D))[F.lane + 64 * j]; }
        const float mean = wave_sum_dpp(s) * (1.f / D); float s2 = 0.f;
#pragma unroll
        for (int j = 0; j < 4; ++j) { v[j] = v[j] - mean; s2 += (v[j].x * v[j].x + v[j].y * v[j].y) + (v[j].z * v[j].z + v[j].w * v[j].w); }
        const float rstd = 1.f / sqrtf(wave_sum_dpp(s2) * (1.f / D) + LN_EPS);
        const int vv = row_v(m); const GAS float* sh = modv(F, l, vv, 3); const GAS float* sc = modv(F, l, vv, 4);
        GAS unsigned* h8 = (GAS unsigned*)(F.ws + WS_H8 + (size_t)m * D) + F.lane;
        float lg[NEXP];
#pragma unroll
        for (int e = 0; e < NEXP; ++e) lg[e] = 0.f;
#pragma unroll
        for (int j = 0; j < 4; ++j) { const f32x4 gg = ((const GAS f32x4*)g)[F.lane + 64 * j], bb = ((const GAS f32x4*)b)[F.lane + 64 * j]; v[j] = v[j] * rstd * gg + bb; ((GAS f32x4*)row)[F.lane + 64 * j] = v[j];
            const f32x4 a = ((const GAS f32x4*)sc)[F.lane + 64 * j], c = ((const GAS f32x4*)sh)[F.lane + 64 * j];
            const f32x4 y = v[j] * (a + 1.f) + c;
            h8[64 * j] = pk4_fp8(y.x, y.y, y.z, y.w);
#pragma unroll
            for (int i = 0; i < 4; ++i) { const f32x4 wa = rw[j][i][0], wb = rw[j][i][1]; const float yi = y[i];
                lg[0] += yi * wa.x; lg[1] += yi * wa.y; lg[2] += yi * wa.z; lg[3] += yi * wa.w; lg[4] += yi * wb.x; lg[5] += yi * wb.y; lg[6] += yi * wb.z; lg[7] += yi * wb.w; } }
#pragma unroll
        for (int e = 0; e < NEXP; ++e) lg[e] = wave_sum_dpp(lg[e]);
        int i0 = 0; float v0 = lg[0];
#pragma unroll
        for (int e = 1; e < NEXP; ++e) if (lg[e] > v0) { v0 = lg[e]; i0 = e; }
        int i1 = -1; float v1 = -3.0e38f;
#pragma unroll
        for (int e = 0; e < NEXP; ++e) if (e != i0 && lg[e] > v1) { v1 = lg[e]; i1 = e; }
        if (F.lane == 0) { const float w0 = 1.f / (1.f + __expf(v1 - v0)); TI_E[m] = i0 | (i1 << 8); TI_W0[m] = w0; TI_W1[m] = 1.f - w0; }
        if (F.lane == it) { e0r = i0; e1r = i1; }
        ++it;
    }
    {
        const bool act = F.lane < it; int rk0 = 0, rk1 = 0, mycnt = 0;
#pragma unroll
        for (int e = 0; e < NEXP; ++e) { const unsigned long long m0 = __ballot(act && e0r == e), m1 = __ballot(act && e1r == e);
            const int n0 = __popcll(m0), n1 = __popcll(m1);
            const int b0 = (int)__builtin_amdgcn_mbcnt_hi((unsigned)(m0 >> 32), __builtin_amdgcn_mbcnt_lo((unsigned)m0, 0u)), b1 = (int)__builtin_amdgcn_mbcnt_hi((unsigned)(m1 >> 32), __builtin_amdgcn_mbcnt_lo((unsigned)m1, 0u));
            if (e0r == e) rk0 = b0; if (e1r == e) rk1 = n0 + b1; if (F.lane == e) mycnt = n0 + n1; }
        int mybase = 0;
        if (F.lane < NEXP && mycnt > 0) mybase = (int)__hip_atomic_fetch_add((GAS unsigned*)F.ctl + CW_MOECNT + 64 * F.lane, (unsigned)mycnt, RLX_AGENT);
        const int p0 = __shfl(mybase, e0r) + rk0, p1 = __shfl(mybase, e1r) + rk1;
        if (act) { const int mr = F.gw + F.lane * F.ngw; TI_P0[mr] = p0; TI_P1[mr] = p1; }
    }
}
struct MoeBase { int bt[NEXP + 1]; };
__device__ __forceinline__ MoeBase moe_base(const Frame& F) {
    MoeBase B; int acc = 0;
#pragma unroll
    for (int e = 0; e < NEXP; ++e) { B.bt[e] = acc; const unsigned c = __hip_atomic_load((GAS unsigned*)F.ctl + CW_MOECNT + 64 * e, RLX_AGENT); acc += (int)((c + 255u) >> 8); }
    B.bt[NEXP] = acc; return B;
}
__device__ __forceinline__ void p_moe_weights(const Frame& F0) { const Frame F = launder(F0);
    LAS float* scr = (LAS float*)(F.lds + F.wave * 16384);
    GAS unsigned char* WM13 = F.ws + WS_WM13; GAS unsigned char* WM2 = F.ws + WS_WM2;
    constexpr int I1 = (D / 64) * (EFF / 32), I2 = (EFF / 64) * (D / 32), NITEM = NEXP * (2 * I1 + I2);
    for (int it = F.gw; it < NITEM; it += F.ngw) {
        const int e = it / (2 * I1 + I2); int r = it % (2 * I1 + I2);
        if (r < I1) { transpose_item_f8(F.in[I_MW1] + (size_t)e * D * EFF, EFF, WM13 + (size_t)e * 2 * EFF * D, D, scr, r, F.lane, RmGlu{0}, MOE_WSCALE); continue; } r -= I1;
        if (r < I1) { transpose_item_f8(F.in[I_MW3] + (size_t)e * D * EFF, EFF, WM13 + (size_t)e * 2 * EFF * D, D, scr, r, F.lane, RmGlu{1}, MOE_WSCALE); continue; } r -= I1;
        transpose_item_f8(F.in[I_MW2] + (size_t)e * EFF * D, D, WM2 + (size_t)e * D * EFF, EFF, scr, r, F.lane, RmIdent{0}, MOE_W2SCALE);
    }
}
__device__ __forceinline__ void p_moe_scatter(const Frame& F0) { const Frame F = launder(F0);
    const MoeBase B = moe_base(F);
    const GAS unsigned char* H8 = F.ws + WS_H8; GAS unsigned char* HS8 = F.ws + WS_HS8;
    GAS int* TI_E = (GAS int*)(F.ws + WS_TI); GAS int* TI_P0 = TI_E + TL; GAS int* TI_P1 = TI_P0 + TL;
    for (int m = F.gw; m < TL; m += F.ngw) {
        const int ee = TI_E[m], e0 = ee & 255, e1 = ee >> 8;
        int b0 = 0, b1 = 0;
#pragma unroll
        for (int e = 0; e < NEXP; ++e) { if (e == e0) b0 = B.bt[e]; if (e == e1) b1 = B.bt[e]; }
        const int s0 = b0 * 256 + TI_P0[m], s1 = b1 * 256 + TI_P1[m];
        const v4u a = *((const GAS v4u*)(H8 + (size_t)m * D) + F.lane);
        *((GAS v4u*)(HS8 + (size_t)s0 * D) + F.lane) = a; *((GAS v4u*)(HS8 + (size_t)s1 * D) + F.lane) = a;
        if (F.lane == 0) { TI_P0[m] = s0; TI_P1[m] = s1; }
    }
}
constexpr int LDS_MOEBT = LDS_MISC + 64;
__device__ __forceinline__ void moe_base_to_lds(const Frame& F) {
    if (F.tid == 0) { volatile LAS int* bt = (volatile LAS int*)(F.lds + LDS_MOEBT); int acc = 0;
        for (int e = 0; e < NEXP; ++e) { bt[e] = acc; const unsigned c = __hip_atomic_load((GAS unsigned*)F.ctl + CW_MOECNT + 64 * e, RLX_AGENT); acc += (int)((c + 255u) >> 8); }
        bt[NEXP] = acc; }
    __syncthreads();
}
struct MoeOrder {
    int nM, nN, nwg, G, c, tile0; const LAS int* bt;
    __device__ void init(const LAS int* bt_, int chunk, int nN_, int G_, int c_) {
        bt = bt_; tile0 = chunk * MOE_CHUNK_TILES; int v = bt[NEXP] - tile0; nM = v < 0 ? 0 : (v > MOE_CHUNK_TILES ? MOE_CHUNK_TILES : v); nN = nN_; nwg = nM * nN; G = G_; c = c_; }
    __device__ bool next(int i, pg8::Unit& u) const {
        const long L = (long)i * G + c; if (L >= nwg) return false;
        int wgid = (int)L; { const int q = nwg / pg8::NXCD, r = nwg % pg8::NXCD, xcd = wgid % pg8::NXCD, off = wgid / pg8::NXCD; wgid = (xcd < r ? xcd * (q + 1) : r * (q + 1) + (xcd - r) * q) + off; }
        const int nig = pg8::WGM * nN, gid = wgid / nig, fm = gid * pg8::WGM, gsz = (nM - fm) < pg8::WGM ? (nM - fm) : pg8::WGM;
        u.pm = fm + ((wgid % nig) % gsz); u.pn = (wgid % nig) / gsz;
        const int gt = tile0 + u.pm; int e = 0;
#pragma unroll
        for (int k = 1; k < NEXP; ++k) e += (gt >= bt[k]) ? 1 : 0;
        u.be = __builtin_amdgcn_readfirstlane(e); return true;
    }
    __device__ __forceinline__ void a_ready(const pg8::Unit&) const {}
    __device__ __forceinline__ void done(const pg8::Unit&) const {}
};
__device__ __forceinline__ void p_ln_combine(const Frame& F0, const GAS float* g, const GAS float* b, int l) { const Frame F = launder(F0);
    const GAS bf16* YS = (const GAS bf16*)(F.ws + WS_HS);
    GAS int* TI_E = (GAS int*)(F.ws + WS_TI); GAS int* TI_P0 = TI_E + TL; GAS int* TI_P1 = TI_P0 + TL; GAS float* TI_W0 = (GAS float*)(TI_P1 + TL); GAS float* TI_W1 = TI_W0 + TL;
    typedef unsigned long long u64_;
    int s0n = 0, s1n = 0; float w0n = 0.f, w1n = 0.f;
    f32x4 nx[4]; u64_ na[4], nc[4]; float w0c = 0.f, w1c = 0.f;
#define CMB_IDX(mm) do { s0n = TI_P0[mm]; s1n = TI_P1[mm]; w0n = TI_W0[mm]; w1n = TI_W1[mm]; } while (0)
#define CMB_DATA(mm) do { const GAS float* r_ = F.out + (size_t)(mm) * D; const GAS u64_* y0_ = (const GAS u64_*)(YS + (size_t)s0n * D) + F.lane; const GAS u64_* y1_ = (const GAS u64_*)(YS + (size_t)s1n * D) + F.lane; \
        _Pragma("unroll") for (int j = 0; j < 4; ++j) { nx[j] = ((const GAS f32x4*)r_)[F.lane + 64 * j]; na[j] = y0_[64 * j]; nc[j] = y1_[64 * j]; } w0c = w0n; w1c = w1n; } while (0)
    int m = F.gw;
    if (m < TL) { CMB_IDX(m); CMB_DATA(m); if (m + F.ngw < TL) CMB_IDX(m + F.ngw); }
    for (; m < TL; m += F.ngw) {
        GAS float* row = F.out + (size_t)m * D;
        const float w0 = w0c, w1 = w1c;
        const GAS float* gate = modv(F, l, row_v(m), 5);
        f32x4 xv[4]; u64_ av[4], cv[4];
#pragma unroll
        for (int j = 0; j < 4; ++j) { xv[j] = nx[j]; av[j] = na[j]; cv[j] = nc[j]; }
        if (m + F.ngw < TL) { CMB_DATA(m + F.ngw); if (m + 2 * F.ngw < TL) CMB_IDX(m + 2 * F.ngw); }
        f32x4 v[4]; float s = 0.f;
#pragma unroll
        for (int j = 0; j < 4; ++j) { const f32x4 x = xv[j], gt = ((const GAS f32x4*)gate)[F.lane + 64 * j];
            const u64_ a = av[j], c = cv[j];
            f32x4 f;
            f.x = w0 * bf2f((unsigned short)a) + w1 * bf2f((unsigned short)c); f.y = w0 * bf2f((unsigned short)(a >> 16)) + w1 * bf2f((unsigned short)(c >> 16));
            f.z = w0 * bf2f((unsigned short)(a >> 32)) + w1 * bf2f((unsigned short)(c >> 32)); f.w = w0 * bf2f((unsigned short)(a >> 48)) + w1 * bf2f((unsigned short)(c >> 48));
            v[j] = x * ALPHA + gt * f; s += (v[j].x + v[j].y) + (v[j].z + v[j].w); }
        const float mean = wave_sum(s) * (1.f / D); float s2 = 0.f;
#pragma unroll
        for (int j = 0; j < 4; ++j) { v[j] = v[j] - mean; s2 += (v[j].x * v[j].x + v[j].y * v[j].y) + (v[j].z * v[j].z + v[j].w * v[j].w); }
        const float rstd = 1.f / sqrtf(wave_sum(s2) * (1.f / D) + LN_EPS);
#pragma unroll
        for (int j = 0; j < 4; ++j) { const f32x4 gg = ((const GAS f32x4*)g)[F.lane + 64 * j], bb = ((const GAS f32x4*)b)[F.lane + 64 * j]; ((GAS f32x4*)row)[F.lane + 64 * j] = v[j] * rstd * gg + bb; }
    }
#undef CMB_IDX
#undef CMB_DATA
}

namespace att {
using bf16x8 = __attribute__((ext_vector_type(8))) short;
using s16x4  = __attribute__((ext_vector_type(4))) short;
using f32x16 = __attribute__((ext_vector_type(16))) float;
using u32x4  = __attribute__((ext_vector_type(4))) unsigned;
constexpr int DQ = 96, DV = 64, NW = 8, QBLK = 32, KVBLK = 64, NKEY = 16640;
constexpr float THR2 = 8.0f;
constexpr int SHM_K = KVBLK * 144, SHM_V = DV * 80;
typedef int i32x8 __attribute__((ext_vector_type(8)));
constexpr int NSLOT = 8;
constexpr int LDS_V = 0, LDS_K = NSLOT * SHM_V, LDS_WS = LDS_K + NSLOT * SHM_K, LDS_Q = LDS_WS + NW * 64 * 4, ATT_LDS = LDS_Q + NW * 4096;
#define KSWZ(row, colB) ((row) * 256 + ((colB) ^ (((row) & 7) << 4)))
#define SBAR() __builtin_amdgcn_sched_barrier(0)
__device__ __forceinline__ int crow(int r, int hi) { return (r & 3) + 8 * (r >> 2) + 4 * hi; }
__device__ __forceinline__ unsigned cvtpk(float lo, float hi) { unsigned r; asm volatile("v_cvt_pk_bf16_f32 %0, %1, %2" : "=v"(r) : "v"(lo), "v"(hi)); return r; }
template <bool FIRST>
__device__ __forceinline__ bool partialSM(f32x16& p0, f32x16& p1, f32x16& negm, float& alpha) {
  float a = fmaxf(fmaxf(p0[0], p0[1]), p1[0]), b = fmaxf(fmaxf(p0[2], p0[3]), p1[1]); a = fmaxf(fmaxf(a, p1[2]), p1[3]);
#pragma unroll
  for (int r = 4; r < 16; r += 4) { a = fmaxf(fmaxf(a, p0[r]), p0[r + 1]); b = fmaxf(fmaxf(b, p0[r + 2]), p0[r + 3]); a = fmaxf(fmaxf(a, p1[r]), p1[r + 1]); b = fmaxf(fmaxf(b, p1[r + 2]), p1[r + 3]); }
  float pmax = fmaxf(a, b);
  { auto rr = __builtin_amdgcn_permlane32_swap(__float_as_uint(pmax), __float_as_uint(pmax), false, false);
    pmax = fmaxf(__uint_as_float(rr[0]), __uint_as_float(rr[1])); }
  bool resc = false;
  if (FIRST || __builtin_expect(__any(pmax > THR2), 0)) {
    const float dl = FIRST ? pmax : fmaxf(pmax, 0.f);
#pragma unroll
    for (int r = 0; r < 16; ++r) { p0[r] -= dl; p1[r] -= dl; negm[r] -= dl; }
    alpha = __builtin_amdgcn_exp2f(-dl); resc = !FIRST;
  }
  return resc;
}
__device__ __forceinline__ void finishSM(f32x16& p0, f32x16& p1, i32x8& pb) {
#pragma unroll
  for (int r = 0; r < 16; ++r) p0[r] = __builtin_amdgcn_exp2f(p0[r]);
#pragma unroll
  for (int r = 0; r < 16; ++r) p1[r] = __builtin_amdgcn_exp2f(p1[r]);
#pragma unroll
  for (int w = 0; w < 4; ++w) {
    int x = __builtin_amdgcn_cvt_pk_fp8_f32(p0[4 * w], p0[4 * w + 1], __float_as_int(p0[4 * w]), false); x = __builtin_amdgcn_cvt_pk_fp8_f32(p0[4 * w + 2], p0[4 * w + 3], x, true); pb[w] = x;
    int y = __builtin_amdgcn_cvt_pk_fp8_f32(p1[4 * w], p1[4 * w + 1], __float_as_int(p1[4 * w]), false); y = __builtin_amdgcn_cvt_pk_fp8_f32(p1[4 * w + 2], p1[4 * w + 3], y, true); pb[4 + w] = y; }
}
__device__ __forceinline__ i32x8 ld32(const LAS char* p) { const u32x4 a = *reinterpret_cast<const LAS u32x4*>(p), b = *reinterpret_cast<const LAS u32x4*>(p + 16);
  return (i32x8){(int)a[0], (int)a[1], (int)a[2], (int)a[3], (int)b[0], (int)b[1], (int)b[2], (int)b[3]}; }
struct KFrag { i32x8 k00, k01, k10, k11; };
__device__ __forceinline__ void qkt_load(KFrag& k, const LAS char* Ks, int r32, int hi) {
  const LAS char* kp = Ks + r32 * 144 + hi * 32;
  k.k00 = ld32(kp); k.k01 = ld32(kp + 64); k.k10 = ld32(kp + 32 * 144); k.k11 = ld32(kp + 32 * 144 + 64);
}
__device__ __forceinline__ void qkt_mma(f32x16& p0, f32x16& p1, const KFrag& k, const i32x8& q0, const i32x8& q1, const f32x16& negm) {
  asm volatile("s_nop 1\n\tv_mfma_f32_32x32x64_f8f6f4 %0, %1, %2, %3" : "=&v"(p0) : "v"(k.k00), "v"(q0), "v"(negm));
  asm volatile("v_mfma_f32_32x32x64_f8f6f4 %0, %1, %2, %3" : "=&v"(p1) : "v"(k.k10), "v"(q0), "v"(negm));
  asm volatile("v_mfma_f32_32x32x64_f8f6f4 %0, %1, %2, %0" : "+v"(p0) : "v"(k.k01), "v"(q1));
  asm volatile("v_mfma_f32_32x32x64_f8f6f4 %0, %1, %2, %0" : "+v"(p1) : "v"(k.k11), "v"(q1));
}
__device__ __forceinline__ void qkt(f32x16& p0, f32x16& p1, const LAS char* Ks, const i32x8& q0, const i32x8& q1, const f32x16& negm, int r32, int hi) {
  KFrag k; qkt_load(k, Ks, r32, hi); qkt_mma(p0, p1, k, q0, q1, negm);
}
#define QK_DRAIN(P0, P1) asm volatile("s_nop 15\n\ts_nop 7" : "+v"(P0), "+v"(P1))
__device__ __forceinline__ void pv_d0(f32x16* o, const LAS char* Vs, const i32x8& pb, int r32, int hi) {
  const LAS char* vp = Vs + r32 * 80 + hi * 32;
  const u32x4 a0 = *reinterpret_cast<const LAS u32x4*>(vp), a1 = *reinterpret_cast<const LAS u32x4*>(vp + 16);
  const u32x4 b0 = *reinterpret_cast<const LAS u32x4*>(vp + 32 * 80), b1 = *reinterpret_cast<const LAS u32x4*>(vp + 32 * 80 + 16);
  const i32x8 va = {(int)a0[0], (int)a0[1], (int)a0[2], (int)a0[3], (int)a1[0], (int)a1[1], (int)a1[2], (int)a1[3]};
  const i32x8 vb = {(int)b0[0], (int)b0[1], (int)b0[2], (int)b0[3], (int)b1[0], (int)b1[1], (int)b1[2], (int)b1[3]};
  const i32x8 ones = {0x38383838, 0x38383838, 0x38383838, 0x38383838, 0x38383838, 0x38383838, 0x38383838, 0x38383838};
  asm volatile("s_nop 1\n\tv_mfma_f32_32x32x64_f8f6f4 %0, %1, %2, %0" : "+v"(o[0]) : "v"(va), "v"(pb));
  asm volatile("v_mfma_f32_32x32x64_f8f6f4 %0, %1, %2, %0" : "+v"(o[1]) : "v"(vb), "v"(pb));
  asm volatile("v_mfma_f32_32x32x64_f8f6f4 %0, %1, %2, %0" : "+v"(o[2]) : "v"(ones), "v"(pb));
}
#define PV_DRAIN() asm volatile("s_nop 15\n\ts_nop 7" : "+v"(o[0]), "+v"(o[1]), "+v"(o[2]))
#define QK_A(P, KA, QA) asm volatile("s_nop 1\n\tv_mfma_f32_32x32x64_f8f6f4 %0, %1, %2, %3" : "=&v"(P) : "v"(KA), "v"(QA), "v"(negm))
#define QK_B(P, KA, QA) asm volatile("v_mfma_f32_32x32x64_f8f6f4 %0, %1, %2, %3" : "=&v"(P) : "v"(KA), "v"(QA), "v"(negm))
#define QK_C(P, KA, QA) asm volatile("v_mfma_f32_32x32x64_f8f6f4 %0, %1, %2, %0" : "+v"(P) : "v"(KA), "v"(QA))
#define PV_A(O, VA) asm volatile("s_nop 1\n\tv_mfma_f32_32x32x64_f8f6f4 %0, %1, %2, %0" : "+v"(O) : "v"(VA), "v"(pb))
#define PV_B(O, VA) asm volatile("v_mfma_f32_32x32x64_f8f6f4 %0, %1, %2, %0" : "+v"(O) : "v"(VA), "v"(pb))
#define EXPS(P, lo, hi_) do { _Pragma("unroll") for (int r_ = (lo); r_ < (hi_); ++r_) P[r_] = __builtin_amdgcn_exp2f(P[r_]); } while (0)
#define CVT4(P, w_, dst) do { int x_ = __builtin_amdgcn_cvt_pk_fp8_f32(P[4 * (w_)], P[4 * (w_) + 1], __float_as_int(P[4 * (w_)]), false); dst = __builtin_amdgcn_cvt_pk_fp8_f32(P[4 * (w_) + 2], P[4 * (w_) + 3], x_, true); } while (0)
__device__ __forceinline__ float mx3(float a, float b, float c) { float r; asm("v_max3_f32 %0, %1, %2, %3" : "=v"(r) : "v"(a), "v"(b), "v"(c)); return r; }
__device__ __forceinline__ float max16(const f32x16& p, float prev) {
  float a, b;
  asm("v_max3_f32 %0, %2, %3, %4\n\tv_max3_f32 %1, %5, %6, %7\n\tv_max3_f32 %0, %0, %8, %9\n\tv_max3_f32 %1, %1, %10, %11\n\t"
      "v_max3_f32 %0, %0, %12, %13\n\tv_max3_f32 %1, %1, %14, %15\n\tv_max3_f32 %0, %0, %16, %17\n\tv_max3_f32 %0, %0, %1, %18"
      : "=&v"(a), "=&v"(b)
      : "v"(p[0]), "v"(p[1]), "v"(p[2]), "v"(p[3]), "v"(p[4]), "v"(p[5]), "v"(p[6]), "v"(p[7]), "v"(p[8]), "v"(p[9]), "v"(p[10]), "v"(p[11]), "v"(p[12]), "v"(p[13]), "v"(p[14]), "v"(p[15]), "v"(prev));
  return a;
}
__device__ __forceinline__ void attn_unit(const GAS unsigned char* __restrict__ Qb, const GAS unsigned char* __restrict__ Kh, const GAS unsigned char* __restrict__ Vh,
                                          GAS unsigned short* __restrict__ Ob, int ldo, int seq, LAS char* lds, int tid) {
  const int wid = tid >> 6, lane = tid & 63, r32 = lane & 31, hi = lane >> 5;
  LAS char* V_lds = lds + LDS_V; LAS char* K_lds = lds + LDS_K;
  f32x16 o[3] = {}; f32x16 negm = {};
  const GAS unsigned char* Qw = Qb + (long)(wid * QBLK + r32) * 128 + hi * 32;
  i32x8 q0, q1;
  { const u32x4 a = *reinterpret_cast<const GAS u32x4*>(Qw), b = *reinterpret_cast<const GAS u32x4*>(Qw + 16), c = *reinterpret_cast<const GAS u32x4*>(Qw + 64), d = *reinterpret_cast<const GAS u32x4*>(Qw + 80);
    q0 = (i32x8){(int)a[0], (int)a[1], (int)a[2], (int)a[3], (int)b[0], (int)b[1], (int)b[2], (int)b[3]}; q1 = (i32x8){(int)c[0], (int)c[1], (int)c[2], (int)c[3], (int)d[0], (int)d[1], (int)d[2], (int)d[3]}; }
  const int vst = (tid >> 3) * 80 + (tid & 7) * 8;
  const int kst0 = (tid >> 3) * 144 + (tid & 7) * 16;
  const GAS unsigned char* Ku = (const GAS unsigned char*)(((unsigned long long)(unsigned)__builtin_amdgcn_readfirstlane((unsigned)((unsigned long long)Kh >> 32)) << 32) | (unsigned long long)(unsigned)__builtin_amdgcn_readfirstlane((unsigned)(unsigned long long)Kh));
  const GAS unsigned char* Vu = (const GAS unsigned char*)(((unsigned long long)(unsigned)__builtin_amdgcn_readfirstlane((unsigned)((unsigned long long)Vh >> 32)) << 32) | (unsigned long long)(unsigned)__builtin_amdgcn_readfirstlane((unsigned)(unsigned long long)Vh));
  const unsigned ko = (unsigned)tid * 16u, vo = (unsigned)tid * 8u;
  bf16x8 sk; v2u sv;
#define SLOAD(t) do { sk = *reinterpret_cast<const GAS bf16x8*>(Ku + (size_t)(t) * (KVBLK * 128) + ko); sv = *reinterpret_cast<const GAS v2u*>(Vu + (size_t)(t) * 4096 + vo); } while (0)
#define SWRITE(t) do { *(LAS bf16x8*)(K_lds + ((t) & 7) * SHM_K + kst0) = sk; *(LAS v2u*)(V_lds + ((t) & 7) * SHM_V + vst) = sv; } while (0)
#define KS(t) (K_lds + ((t) & 7) * SHM_K)
#define VS(t) (V_lds + ((t) & 7) * SHM_V)
#define RESC(flag, a) do { if (flag) { PV_DRAIN(); _Pragma("unroll") for (int d = 0; d < 3; ++d) _Pragma("unroll") for (int r = 0; r < 16; ++r) o[d][r] *= (a); } } while (0)
#define PSM_TAIL(N0, N1, pm) do { \
    if (__builtin_expect(__any((pm) > THR2), 0)) { float pmax = (pm);     \
      { auto rr = __builtin_amdgcn_permlane32_swap(__float_as_uint(pmax), __float_as_uint(pmax), false, false); pmax = fmaxf(__uint_as_float(rr[0]), __uint_as_float(rr[1])); } \
      const float dl = fmaxf(pmax, 0.f); \
      _Pragma("unroll") for (int r = 0; r < 16; ++r) { N0[r] -= dl; N1[r] -= dl; negm[r] -= dl; } \
      const float al = __builtin_amdgcn_exp2f(-dl); RESC(true, al); } } while (0)
#define HI(j, C0, C1, N0, N1, DO_BAR, DO_QK, DO_KR, DO_SW, DO_SL) do { \
    if (DO_BAR) __syncthreads(); \
    if (DO_SW) SWRITE((j) + 4); \
    if (DO_SL) SLOAD((j) + 5); \
    SBAR(); \
    if (DO_QK) { QK_A(N0, kf.k00, q0); SBAR(); } \
    EXPS(C0, 0, 7); SBAR(); \
    if (DO_QK) { QK_B(N1, kf.k10, q0); SBAR(); } \
    EXPS(C0, 7, 14); SBAR(); \
    if (DO_QK) { QK_C(N0, kf.k01, q1); SBAR(); } \
    EXPS(C0, 14, 16); CVT4(C0, 0, pb[0]); CVT4(C0, 1, pb[1]); CVT4(C0, 2, pb[2]); EXPS(C1, 0, 2); SBAR(); \
    if (DO_QK) { QK_C(N1, kf.k11, q1); SBAR(); } \
    { const LAS char* vp = VS(j) + r32 * 80 + hi * 32; va = ld32(vp); vb = ld32(vp + 32 * 80); } \
    EXPS(C1, 2, 9); SBAR(); \
    EXPS(C1, 9, 16); CVT4(C0, 3, pb[3]); CVT4(C1, 0, pb[4]); CVT4(C1, 1, pb[5]); CVT4(C1, 2, pb[6]); CVT4(C1, 3, pb[7]); SBAR(); \
    PV_A(o[0], va); SBAR(); \
    float pm_ = 0.f; if (DO_QK) { pm_ = max16(N0, N0[15]); SBAR(); } \
    PV_B(o[1], vb); SBAR(); \
    if (DO_KR) { qkt_load(kf, KS((j) + 2), r32, hi); SBAR(); } \
    if (DO_QK) { pm_ = max16(N1, pm_); SBAR(); } \
    PV_B(o[2], ones); SBAR(); \
    if (DO_QK) PSM_TAIL(N0, N1, pm_); \
  } while (0)
  i32x8 ones = {0x38383838, 0x38383838, 0x38383838, 0x38383838, 0x38383838, 0x38383838, 0x38383838, 0x38383838};
  asm volatile("" : "+v"(ones));
  f32x16 pA0, pA1, pB0, pB1; i32x8 pb, va, vb; KFrag kf; const int NT = seq / KVBLK;
  SLOAD(0); SWRITE(0); SLOAD(1); SWRITE(1); SLOAD(2); SWRITE(2); SLOAD(3); SWRITE(3); if (NT > 4) SLOAD(4);
  __syncthreads();
  { float al0; qkt(pA0, pA1, KS(0), q0, q1, negm, r32, hi); QK_DRAIN(pA0, pA1); (void)partialSM<true>(pA0, pA1, negm, al0); }
  qkt_load(kf, KS(1), r32, hi);
  int j = 0;
  for (; j + 6 < NT; j += 2) {
    HI(j, pA0, pA1, pB0, pB1, true, true, true, true, true);
    HI(j + 1, pB0, pB1, pA0, pA1, false, true, true, true, true);
  }
  for (; j < NT; j += 2) {
    HI(j, pA0, pA1, pB0, pB1, true, true, (j + 2 < NT), (j + 4 < NT), (j + 5 < NT));
    HI(j + 1, pB0, pB1, pA0, pA1, false, (j + 2 < NT), (j + 3 < NT), (j + 5 < NT), (j + 6 < NT));
  }
#undef KS
#undef VS
  PV_DRAIN();
  const float rl = __builtin_amdgcn_rcpf(o[2][0]);
  GAS unsigned short* Ow = Ob + (long)(wid * QBLK + r32) * ldo + 4 * hi;
#pragma unroll
  for (int d0 = 0; d0 < 2; ++d0)
#pragma unroll
    for (int g = 0; g < 4; ++g) { unsigned long long w = (unsigned long long)cvtpk(o[d0][4 * g] * rl, o[d0][4 * g + 1] * rl) | ((unsigned long long)cvtpk(o[d0][4 * g + 2] * rl, o[d0][4 * g + 3] * rl) << 32);
      *(GAS unsigned long long*)(Ow + d0 * 32 + g * 8) = w; }
  __syncthreads();
#undef SLOAD
#undef SWRITE
#undef RESC
#undef HI
#undef PSM_TAIL
}
#undef KSWZ
}

constexpr size_t WS_ROPE = WS_SMALL;
constexpr size_t WS_RSQ = WS_SMALL + 704 * 1024, WS_RSKV = WS_RSQ + (size_t)MR * 4;
static_assert(WS_RSKV + (size_t)MR * 4 <= WS_WIN, "small map");
constexpr size_t WS_QC = WS_Q + (size_t)NBATCH * 8 * SEQ * 128;
constexpr float MLA_QS = 4.f, MLA_KS = 0.25f;
static_assert(WS_QC + (size_t)NBATCH * 8 * CTXL * 128 <= WS_K && WS_K + (size_t)NBATCH * 8 * 16640 * 128 <= WS_V, "q8/k8 map");
constexpr float MLA_C2 = 0.10206207261596575f * 1.4426950408889634f;

__device__ __forceinline__ void p0_rope_table(const Frame& F0) { const Frame F = launder(F0);
    GAS float* T = (GAS float*)(F.ws + WS_ROPE);
    for (int i = blockIdx.x * NTHR + F.tid; i < 256 * 8; i += F.G * NTHR) {
        const int pos = i >> 3, e = i & 7;
        double inv = 1.0; for (int k = 0; k < (e >> 1); ++k) inv *= 0.1; if (e & 1) inv *= 0.31622776601683794;
        double rev = (double)pos * inv * 0.15915494309189535; rev -= (double)(long long)rev;
        T[2 * i] = __builtin_amdgcn_cosf((float)rev); T[2 * i + 1] = __builtin_amdgcn_sinf((float)rev);
    }
}
__device__ __forceinline__ void p_prep_mla_rows(const Frame& F0) { const Frame F = launder(F0);
    const GAS bf16* PH = (const GAS bf16*)(F.ws + WS_PH);
    GAS float* RSQ = (GAS float*)(F.ws + WS_RSQ); GAS float* RSKV = (GAS float*)(F.ws + WS_RSKV); const GAS float* T = (const GAS float*)(F.ws + WS_ROPE);
    constexpr int RB = 4;
    for (int m0 = F.gw; m0 < MR; m0 += RB * F.ngw) {
        unsigned long long q4[RB], k4[RB]; float xr[RB];
#pragma unroll
        for (int j = 0; j < RB; ++j) { const int m = m0 + j * F.ngw; q4[j] = 0; k4[j] = 0; xr[j] = 0.f;
            if (m < MR) { const GAS bf16* row = PH + (size_t)m * NPH; q4[j] = *((const GAS unsigned long long*)(row + PH_CQ) + F.lane);
                if (F.lane < 32) { k4[j] = *((const GAS unsigned long long*)(row + PH_CKV) + F.lane); xr[j] = bf2f(row[PH_KR + F.lane]); } } }
#pragma unroll
        for (int j = 0; j < RB; ++j) { const int m = m0 + j * F.ngw; if (m >= MR) break;
        float a0 = bf2f((unsigned short)q4[j]), a1 = bf2f((unsigned short)(q4[j] >> 16)), a2 = bf2f((unsigned short)(q4[j] >> 32)), a3 = bf2f((unsigned short)(q4[j] >> 48));
        const float sq = wave_sum(a0 * a0 + a1 * a1 + a2 * a2 + a3 * a3);
        float skv = 0.f; const float x = xr[j];
        if (F.lane < 32) { a0 = bf2f((unsigned short)k4[j]); a1 = bf2f((unsigned short)(k4[j] >> 16)); a2 = bf2f((unsigned short)(k4[j] >> 32)); a3 = bf2f((unsigned short)(k4[j] >> 48));
            skv = a0 * a0 + a1 * a1 + a2 * a2 + a3 * a3; }
        skv = wave_sum(skv);
        if (F.lane == 0) { RSQ[m] = 1.f / sqrtf(sq * (1.f / 256.f) + RMS_EPS); RSKV[m] = 1.f / sqrtf(skv * (1.f / 128.f) + RMS_EPS); }
        const float xp = __shfl_xor(x, 8);
        int b, pos; float y = x;
        if (m < TL) { b = m >> 14; const int t = m & (SEQ - 1); pos = CTXL + t;
            const int i = F.lane & 31, half = i >> 4, w = i & 15, p = half ? (t & 63) : (t >> 6); const float c = T[(p * 8 + (w & 7)) * 2], s = T[(p * 8 + (w & 7)) * 2 + 1];
            y = (w < 8) ? (x * c - xp * s) : (xp * s + x * c); }
        else { b = (m - TL) >> 8; pos = (m - TL) & 255; }
        {
          const unsigned yb = pk4_fp8(F.lane < 32 ? y * MLA_KS : 0.f, 0.f, 0.f, 0.f) & 0xffu;
          const int q0 = (F.lane & 7) * 4;
          const unsigned dw = (unsigned)__shfl((int)yb, q0) | ((unsigned)__shfl((int)yb, q0 + 1) << 8) | ((unsigned)__shfl((int)yb, q0 + 2) << 16) | ((unsigned)__shfl((int)yb, q0 + 3) << 24);
          const unsigned kv = (F.lane & 8) ? 0u : dw;
          GAS unsigned char* K8 = F.ws + WS_K; GAS unsigned char* Q8 = m < TL ? F.ws + WS_Q : F.ws + WS_QC; const int qrows = m < TL ? SEQ : CTXL, qt = m < TL ? (m & (SEQ - 1)) : pos;
#pragma unroll
          for (int hh = 0; hh < 2; ++hh) { const int h = hh * 4 + (F.lane >> 4); *(GAS unsigned*)(K8 + ((size_t)(b * 8 + h) * att::NKEY + pos) * 128 + 64 + (F.lane & 15) * 4) = kv; }
          { const int h = F.lane >> 3; *(GAS unsigned*)(Q8 + ((size_t)(b * 8 + h) * qrows + qt) * 128 + 96 + (F.lane & 7) * 4) = 0u; } }
        }
    }
}
struct EpiMlaQ {
    static constexpr bool PERM = true, AFTER_DRAIN = false;
    GAS unsigned char* Q; GAS unsigned char* QC; const GAS float* rsq; const GAS float* rope;
    __device__ __forceinline__ void operator()(const pg8::f32x4 (&acc)[2][2][4][2], const Unit& u, int wr, int wc, int fr, int fq) const {
        const bool lat = u.pm < TL / 256;
        const int b = lat ? (u.pm >> 6) : (u.pm - TL / 256), t0 = lat ? (u.pm & 63) * 256 : 0, rows = lat ? SEQ : CTXL;
        GAS unsigned char* base = lat ? Q : QC;
        const unsigned lane_off = (unsigned)((wr * 64 + fr) * 128 + 8 * fq);
        const GAS float* rsp = rsq + u.pm * 256 + wr * 64 + fr;
#pragma unroll
        for (int ai = 0; ai < 2; ++ai)
#pragma unroll
            for (int m = 0; m < 4; ++m) { const float rs = rsp[ai * 128 + m * 16] * (MLA_C2 * MLA_QS);
                const int trow = t0 + ai * 128 + m * 16;
#pragma unroll
                for (int bj = 0; bj < 2; ++bj) { const int g32 = 8 * u.pn + 4 * bj + wc, head = g32 / 3, part = g32 - 3 * head;
                    float x[8];
#pragma unroll
                    for (int i = 0; i < 4; ++i) { x[i] = acc[ai][bj][m][0][i] * rs; x[4 + i] = acc[ai][bj][m][1][i] * rs; }
                    if (part == 2 && lat) {
                        const int p = (fq < 2) ? ((trow >> 6) + wr) : (m * 16 + fr); const GAS f32x4* cs = (const GAS f32x4*)(rope + p * 16);
#pragma unroll
                        for (int i2 = 0; i2 < 4; ++i2) { const f32x4 c4 = cs[i2];
                            const float xa = __shfl_xor(x[2 * i2], 16), xb = __shfl_xor(x[2 * i2 + 1], 16);
                            x[2 * i2] = (fq & 1) ? (xa * c4.y + x[2 * i2] * c4.x) : (x[2 * i2] * c4.x - xa * c4.y);
                            x[2 * i2 + 1] = (fq & 1) ? (xb * c4.w + x[2 * i2 + 1] * c4.z) : (x[2 * i2 + 1] * c4.z - xb * c4.w); }
                    }
                    v2u w; w.x = pk4_fp8(x[0], x[1], x[2], x[3]); w.y = pk4_fp8(x[4], x[5], x[6], x[7]);
                    const size_t soff = (((size_t)(b * 8 + head) * rows + trow) * 128 + part * 32);
                    *(GAS v2u*)(base + soff + lane_off) = w; }
                asm volatile("" ::: "memory"); }
    }
};
struct EpiMlaKV {
    static constexpr bool PERM = true, AFTER_DRAIN = false;
    GAS unsigned char* K; GAS bf16* V; const GAS float* rskv;
    __device__ __forceinline__ void operator()(const pg8::f32x4 (&acc)[2][2][4][2], const Unit& u, int wr, int wc, int fr, int fq) const {
        const bool lat = u.pm < TL / 256;
        const int b = lat ? (u.pm >> 6) : (u.pm - TL / 256), pos0 = lat ? CTXL + (u.pm & 63) * 256 : 0;
        const bool isk = wc < 2;
        const unsigned lane_off = isk ? (unsigned)((wr * 64 + fr) * 128 + 32 * (wc & 1) + 8 * fq) : (unsigned)(((wr * 64 + fr) * 64 + 32 * (wc & 1) + 8 * fq) * 2);
        const GAS float* rsp = rskv + u.pm * 256 + wr * 64 + fr;
#pragma unroll
        for (int ai = 0; ai < 2; ++ai)
#pragma unroll
            for (int m = 0; m < 4; ++m) { const float rs = rsp[ai * 128 + m * 16];
#pragma unroll
                for (int bj = 0; bj < 2; ++bj) { const int head = 2 * u.pn + bj;
                    const size_t rk = (size_t)(b * 8 + head) * att::NKEY + pos0 + ai * 128 + m * 16;
                    if (isk) { const pg8::f32x4 v0 = acc[ai][bj][m][0] * (rs * MLA_KS), v1 = acc[ai][bj][m][1] * (rs * MLA_KS);
                        v2u w; w.x = pk4_fp8(v0[0], v0[1], v0[2], v0[3]); w.y = pk4_fp8(v1[0], v1[1], v1[2], v1[3]);
                        *(GAS v2u*)(K + rk * 128 + lane_off) = w; }
                    else { const pg8::f32x4 v0 = acc[ai][bj][m][0] * rs, v1 = acc[ai][bj][m][1] * rs;
                        v4u w; w.x = pk2(v0[0], v0[1]); w.y = pk2(v0[2], v0[3]); w.z = pk2(v1[0], v1[1]); w.w = pk2(v1[2], v1[3]);
                        *(GAS v4u*)((GAS char*)V + rk * 128 + lane_off) = w; } }
                asm volatile("" ::: "memory"); }
    }
};
constexpr size_t WS_V8T = WS_QC + (size_t)NBATCH * 8 * CTXL * 128;
static_assert(WS_V8T + (size_t)NBATCH * 8 * (att::NKEY / 64) * 4096 <= WS_K, "v8t map");
__device__ __forceinline__ void p_attn_vt_pack(const Frame& F0) { const Frame F = launder(F0);
    LAS unsigned short* VL = (LAS unsigned short*)F.lds; const int tid = F.tid;
    const GAS bf16* V = (const GAS bf16*)(F.ws + WS_V); GAS unsigned char* V8T = F.ws + WS_V8T;
    const int ntile = att::NKEY / 64;
    for (int u = blockIdx.x; u < NBATCH * 8 * ntile; u += F.G) {
        const int bh = u / ntile, t = u % ntile;
        { const int key = tid >> 3, c8 = (tid & 7) * 8; const v4u w = *(const GAS v4u*)(V + ((size_t)bh * att::NKEY + t * 64 + key) * 64 + c8);
          LAS unsigned short* d = VL + key * 66 + c8; d[0] = (unsigned short)w.x; d[1] = (unsigned short)(w.x >> 16); d[2] = (unsigned short)w.y; d[3] = (unsigned short)(w.y >> 16);
          d[4] = (unsigned short)w.z; d[5] = (unsigned short)(w.z >> 16); d[6] = (unsigned short)w.w; d[7] = (unsigned short)(w.w >> 16); }
        __syncthreads();
        { const int v = tid >> 3, s8 = (tid & 7) * 8; float x[8];
#pragma unroll
          for (int e = 0; e < 8; ++e) { const int slot = s8 + e, hi = slot >> 5, j = slot & 31, jj = j & 15, key = (j >> 4) * 32 + (jj & 3) + 8 * (jj >> 2) + 4 * hi; x[e] = bf2f(VL[key * 66 + v]); }
          v2u o; o.x = pk4_fp8(x[0], x[1], x[2], x[3]); o.y = pk4_fp8(x[4], x[5], x[6], x[7]);
          *(GAS v2u*)(V8T + (size_t)u * 4096 + v * 64 + s8) = o; }
        __syncthreads();
    }
}
__device__ __forceinline__ void p_attention(const Frame& F0, bool with_ctx) { const Frame F = launder(F0);
    const GAS unsigned char* Q = F.ws + WS_Q; const GAS unsigned char* QC = F.ws + WS_QC; const GAS unsigned char* K = F.ws + WS_K; const GAS unsigned char* V8T = F.ws + WS_V8T;
    GAS bf16* Y = (GAS bf16*)(F.ws + WS_Y);
    LAS char* lds = (LAS char*)F.lds;
    const int nlat = NBATCH * 8 * (SEQ / 256);
    for (int i = 0;; ++i) {
        const int L = i * F.G + (int)blockIdx.x; if (L >= nlat) break;
        int bh, qb;
        if (F.G == 256) { const int xcd = blockIdx.x & 7, slot = blockIdx.x >> 3; bh = xcd + 8 * (i >> 1); qb = (i & 1) * 32 + slot; }
        else { bh = L / (SEQ / 256); qb = L % (SEQ / 256); }
        const int b = bh >> 3, h = bh & 7;
        att::attn_unit(Q + ((size_t)bh * SEQ + qb * 256) * 128, K + (size_t)bh * att::NKEY * 128, V8T + (size_t)bh * (att::NKEY / 64) * 4096,
                       Y + ((size_t)b * SEQ + qb * 256) * D + 512 + h * 64, D, att::NKEY, lds, F.tid);
    }
    if (with_ctx && (int)blockIdx.x < NBATCH * 8) { const int bh = blockIdx.x, b = bh >> 3, h = bh & 7;
        att::attn_unit(QC + (size_t)bh * CTXL * 128, K + (size_t)bh * att::NKEY * 128, V8T + (size_t)bh * (att::NKEY / 64) * 4096,
                       Y + ((size_t)TL + b * CTXL) * D + 512 + h * 64, D, CTXL, lds, F.tid);
    }
}
__device__ __forceinline__ void p_ynorm_c(const Frame& F0, int nrows, const GAS float* mg) { const Frame F = launder(F0);
    GAS bf16* Y = (GAS bf16*)(F.ws + WS_Y);
    const f32x4 g0 = ((const GAS f32x4*)mg)[2 * F.lane], g1 = ((const GAS f32x4*)mg)[2 * F.lane + 1];
    constexpr int RB = 4;
    for (int m0 = F.gw; m0 < nrows; m0 += RB * F.ngw) {
        v4u w[RB];
#pragma unroll
        for (int j = 0; j < RB; ++j) { const int m = m0 + j * F.ngw; w[j] = (v4u){0u, 0u, 0u, 0u}; if (m < nrows) w[j] = *((const GAS v4u*)(Y + (size_t)m * D + 512) + F.lane); }
#pragma unroll
        for (int j = 0; j < RB; ++j) { const int m = m0 + j * F.ngw; if (m >= nrows) break;
            float x[8]; x[0] = bf2f((unsigned short)w[j].x); x[1] = bf2f((unsigned short)(w[j].x >> 16)); x[2] = bf2f((unsigned short)w[j].y); x[3] = bf2f((unsigned short)(w[j].y >> 16));
            x[4] = bf2f((unsigned short)w[j].z); x[5] = bf2f((unsigned short)(w[j].z >> 16)); x[6] = bf2f((unsigned short)w[j].w); x[7] = bf2f((unsigned short)(w[j].w >> 16));
            float s = 0.f;
#pragma unroll
            for (int i = 0; i < 8; ++i) s += x[i] * x[i];
            const float rs = 1.f / sqrtf(wave_sum(s) * (1.f / 512.f) + RMS_EPS);
            v4u o; o.x = pk2(x[0] * rs * g0.x, x[1] * rs * g0.y); o.y = pk2(x[2] * rs * g0.z, x[3] * rs * g0.w); o.z = pk2(x[4] * rs * g1.x, x[5] * rs * g1.y); o.w = pk2(x[6] * rs * g1.z, x[7] * rs * g1.w);
            *((GAS v4u*)(Y + (size_t)m * D + 512) + F.lane) = o; }
    }
}

constexpr int GLA_NCH = 4 + SEQ / 64;
constexpr size_t WS_SLOC = WS_XN, WS_GDEC = AB + 521 * MiB;
static_assert(WS_SLOC + (size_t)NBATCH * 4 * 2 * GLA_NCH * 2048 * 4 <= WS_XN + 33 * MiB && (size_t)NBATCH * 4 * 2 * GLA_NCH * 32 * 4 <= 5 * MiB && GLA_NCH % 20 == 0, "gla map");
constexpr int GB_LA = 0, GB_K = GB_LA + 16384, GB_Q = GB_K + 8192, GB_ALR = GB_Q + 8192, GB_WG = GB_ALR + 8192, GB_BG = GB_WG + 4096, GB_O = GB_BG + 256,
              GB_QF = GB_O + 64 * 65 * 4, GB_QB = GB_QF + 5120, GB_KF = GB_QB + 5120, GB_KB = GB_KF + 5120, GB_KTF = GB_KB + 5120, GB_KTB = GB_KTF + 4608, GB_VT = GB_KTB + 4608,
              GB_ATT = GB_VT + 9216, GB_STF = GB_ATT + 9216, GB_STB = GB_STF + 5120, GB_END = GB_STB + 5120;
static_assert(GB_END <= 131072 && GB_QF % 16 == 0, "gla lds");
typedef short gbf16x8 __attribute__((ext_vector_type(8)));
typedef float gf32x16 __attribute__((ext_vector_type(16)));
__device__ __forceinline__ float logsigmoidf(float z) { return fminf(z, 0.f) - __logf(1.f + __expf(-fabsf(z))); }
__device__ __forceinline__ unsigned short bf1(float x) { return (unsigned short)(pk2(x, x) & 0xffffu); }
__device__ __forceinline__ void ld8bf(const GAS bf16* p, LAS float* d) { const v4u w = *(const GAS v4u*)p;
    d[0] = bf2f((unsigned short)w.x); d[1] = bf2f((unsigned short)(w.x >> 16)); d[2] = bf2f((unsigned short)w.y); d[3] = bf2f((unsigned short)(w.y >> 16));
    d[4] = bf2f((unsigned short)w.z); d[5] = bf2f((unsigned short)(w.z >> 16)); d[6] = bf2f((unsigned short)w.w); d[7] = bf2f((unsigned short)(w.w >> 16)); }
__device__ __forceinline__ int gcrow(int r, int hi) { return (r & 3) + 8 * (r >> 2) + 4 * hi; }
template <int KD>
__device__ __forceinline__ void gmm(gf32x16& acc, const LAS unsigned char* A, int sa, int m0, const LAS unsigned char* BT, int sb, int n0, int r32, int hi) {
#pragma unroll
    for (int kt = 0; kt < KD / 16; ++kt) { const gbf16x8 a = *(const LAS gbf16x8*)(A + (m0 + r32) * sa + (kt * 16 + hi * 8) * 2), b = *(const LAS gbf16x8*)(BT + (n0 + r32) * sb + (kt * 16 + hi * 8) * 2);
        acc = __builtin_amdgcn_mfma_f32_32x32x16_bf16(a, b, acc, 0, 0, 0); }
}
template <int CTRL, int RM> __device__ __forceinline__ float gdpp(float v) { return __int_as_float(__builtin_amdgcn_update_dpp(0, __float_as_int(v), CTRL, RM, 0xf, false)); }
struct GlaRegs { v4u kq, al, vv; float w0, w1, bg; };
__device__ __forceinline__ int gla_row0(int b, int jj) { return jj < 4 ? TL + b * CTXL + jj * 64 : b * SEQ + (jj - 4) * 64; }
__device__ __forceinline__ void st8bf(const v4u w, LAS float* d) {
    d[0] = bf2f((unsigned short)w.x); d[1] = bf2f((unsigned short)(w.x >> 16)); d[2] = bf2f((unsigned short)w.y); d[3] = bf2f((unsigned short)(w.y >> 16));
    d[4] = bf2f((unsigned short)w.z); d[5] = bf2f((unsigned short)(w.z >> 16)); d[6] = bf2f((unsigned short)w.w); d[7] = bf2f((unsigned short)(w.w >> 16)); }
__device__ __forceinline__ void gla_issue(const Frame& F, int l, int b, int h, int jj, bool want_q, GlaRegs& R) {
    const int tid = F.tid;
    const GAS bf16* PH = (const GAS bf16*)(F.ws + WS_PH) + (size_t)gla_row0(b, jj) * NPH;
    { const int t = (tid & 255) >> 2, c = (tid & 3) * 8;
      if (tid < 256) { R.kq = *(const GAS v4u*)(PH + (size_t)t * NPH + PH_KA + h * 32 + c); R.al = *(const GAS v4u*)(PH + (size_t)t * NPH + PH_ALR + c); }
      else if (want_q) R.kq = *(const GAS v4u*)(PH + (size_t)t * NPH + PH_QA + h * 32 + c); }
    { const int t = tid >> 3, c = (tid & 7) * 8; R.vv = *(const GAS v4u*)(PH + (size_t)t * NPH + PH_VA + h * 64 + c); }
    { const GAS float* wg = F.in[I_GWG] + (size_t)l * 2 * 16 * 128;
      { const int i = tid, d = i >> 9, r = (i >> 5) & 15, k = i & 31; R.w0 = wg[(d * 16 + r) * 128 + h * 32 + k]; }
      { const int i = tid + 512, d = i >> 9, r = (i >> 5) & 15, k = i & 31; R.w1 = wg[(d * 16 + r) * 128 + h * 32 + k]; }
      if (tid < 64) R.bg = F.in[I_GBG][l * 256 + (tid >> 5) * 128 + h * 32 + (tid & 31)]; }
}
__device__ __forceinline__ void gla_head(const Frame& F, bool want_q, const GlaRegs& R) {
    LAS unsigned char* LB = F.lds; LAS float* LA = (LAS float*)(LB + GB_LA); LAS float* KK = (LAS float*)(LB + GB_K); LAS float* QQ = (LAS float*)(LB + GB_Q);
    LAS float* BG = (LAS float*)(LB + GB_BG); LAS unsigned short* VT = (LAS unsigned short*)(LB + GB_VT);
    LAS unsigned char* ALRB = LB + GB_ALR; LAS unsigned char* WGB = LB + GB_WG; LAS unsigned char* WGL = LB + GB_Q;
    const int tid = F.tid;
    { const int t = (tid & 255) >> 2, c = (tid & 3) * 8;
      if (tid < 256) { st8bf(R.kq, KK + t * 32 + c); *(LAS v4u*)(ALRB + ((c >> 4) * 64 + t) * 48 + (c & 15) * 2) = R.al; } }
    { const int t = tid >> 3, c = (tid & 7) * 8; const v4u w = R.vv;
      VT[(c + 0) * 72 + t] = (unsigned short)w.x; VT[(c + 1) * 72 + t] = (unsigned short)(w.x >> 16); VT[(c + 2) * 72 + t] = (unsigned short)w.y; VT[(c + 3) * 72 + t] = (unsigned short)(w.y >> 16);
      VT[(c + 4) * 72 + t] = (unsigned short)w.z; VT[(c + 5) * 72 + t] = (unsigned short)(w.z >> 16); VT[(c + 6) * 72 + t] = (unsigned short)w.w; VT[(c + 7) * 72 + t] = (unsigned short)(w.w >> 16); }
    { const int r = (tid >> 5) & 15, k = tid & 31;
      const unsigned short h0 = bf1(R.w0), h1 = bf1(R.w1);
      *(LAS unsigned short*)(WGB + (0 * 32 + k) * 48 + r * 2) = h0; *(LAS unsigned short*)(WGL + (0 * 32 + k) * 48 + r * 2) = bf1(R.w0 - bf2f(h0));
      *(LAS unsigned short*)(WGB + (1 * 32 + k) * 48 + r * 2) = h1; *(LAS unsigned short*)(WGL + (1 * 32 + k) * 48 + r * 2) = bf1(R.w1 - bf2f(h1));
      if (tid < 64) BG[tid] = R.bg; }
    (void)want_q; (void)QQ;
    __syncthreads();
    { const int wv = tid >> 6, lane = tid & 63, r32 = lane & 31, hi = lane >> 5;
      if (wv < 4) { const int d = wv >> 1, mt = wv & 1; gf32x16 acc = {};
          gmm<16>(acc, ALRB + d * 64 * 48, 48, mt * 32, WGB + d * 32 * 48, 48, 0, r32, hi);
          gmm<16>(acc, ALRB + d * 64 * 48, 48, mt * 32, WGL + d * 32 * 48, 48, 0, r32, hi);
          const float bgv = BG[d * 32 + r32];
#pragma unroll
          for (int r = 0; r < 16; ++r) LA[(d * 64 + mt * 32 + gcrow(r, hi)) * 32 + r32] = logsigmoidf(acc[r] + bgv) * (1.f / 16.f); } }
    __syncthreads();
    { const int w = tid >> 6, lane = tid & 63;
#pragma unroll
      for (int c = 0; c < 8; ++c) { const int col = w * 8 + c, d = col >> 5, k = col & 31; float v = LA[(d * 64 + lane) * 32 + k];
          const float x0 = v;
          v += gdpp<0x111, 0xf>(v); v += gdpp<0x112, 0xf>(v); v += gdpp<0x114, 0xf>(v); v += gdpp<0x118, 0xf>(v); v += gdpp<0x142, 0xa>(v); v += gdpp<0x143, 0xc>(v);
          if (d != 0) v = __shfl(v, 63) - v + x0;
          LA[(d * 64 + lane) * 32 + k] = v; } }
    __syncthreads();
}
__device__ __forceinline__ void gla_issue_kqv(const Frame& F, int b, int h, int jj, GlaRegs& R) {
    const int tid = F.tid;
    const GAS bf16* PH = (const GAS bf16*)(F.ws + WS_PH) + (size_t)gla_row0(b, jj) * NPH;
    { const int t = (tid & 255) >> 2, c = (tid & 3) * 8;
      R.kq = *(const GAS v4u*)(PH + (size_t)t * NPH + (tid < 256 ? PH_KA : PH_QA) + h * 32 + c); }
    { const int t = tid >> 3, c = (tid & 7) * 8; R.vv = *(const GAS v4u*)(PH + (size_t)t * NPH + PH_VA + h * 64 + c); }
}
__device__ __forceinline__ void gla_head_kqv(const Frame& F, const GlaRegs& R) {
    LAS unsigned char* LB = F.lds; LAS float* KK = (LAS float*)(LB + GB_K); LAS float* QQ = (LAS float*)(LB + GB_Q); LAS unsigned short* VT = (LAS unsigned short*)(LB + GB_VT);
    const int tid = F.tid;
    { const int t = (tid & 255) >> 2, c = (tid & 3) * 8; st8bf(R.kq, (tid < 256 ? KK : QQ) + t * 32 + c); }
    { const int t = tid >> 3, c = (tid & 7) * 8; const v4u w = R.vv;
      VT[(c + 0) * 72 + t] = (unsigned short)w.x; VT[(c + 1) * 72 + t] = (unsigned short)(w.x >> 16); VT[(c + 2) * 72 + t] = (unsigned short)w.y; VT[(c + 3) * 72 + t] = (unsigned short)(w.y >> 16);
      VT[(c + 4) * 72 + t] = (unsigned short)w.z; VT[(c + 5) * 72 + t] = (unsigned short)(w.z >> 16); VT[(c + 6) * 72 + t] = (unsigned short)w.w; VT[(c + 7) * 72 + t] = (unsigned short)(w.w >> 16); }
}
__device__ __forceinline__ void p_gla_local(const Frame& F0, int l) { const Frame F = launder(F0);
    LAS unsigned char* LB = F.lds; LAS float* LA = (LAS float*)(LB + GB_LA); LAS float* KK = (LAS float*)(LB + GB_K); const int tid = F.tid;
    LAS unsigned short* KTF = (LAS unsigned short*)(LB + GB_KTF); LAS unsigned short* KTB = (LAS unsigned short*)(LB + GB_KTB);
    GAS float* SLOC = (GAS float*)(F.ws + WS_SLOC); GAS float* GDEC = (GAS float*)(F.ws + WS_GDEC);
    const int wv = tid >> 6, lane = tid & 63, r32 = lane & 31, hi = lane >> 5;
    GlaRegs Rn;
    if ((int)blockIdx.x < NBATCH * 4 * GLA_NCH) { const int u = blockIdx.x; gla_issue(F, l, u / (4 * GLA_NCH), (u / GLA_NCH) & 3, u % GLA_NCH, false, Rn); }
    for (int u = blockIdx.x; u < NBATCH * 4 * GLA_NCH; u += F.G) {
        const int b = u / (4 * GLA_NCH), h = (u / GLA_NCH) & 3, jj = u % GLA_NCH;
        const GlaRegs R = Rn;
        { const int un = u + F.G; if (un < NBATCH * 4 * GLA_NCH) gla_issue(F, l, un / (4 * GLA_NCH), (un / GLA_NCH) & 3, un % GLA_NCH, false, Rn); }
        gla_head(F, false, R);
        { const int t = tid >> 3, d = (tid >> 2) & 1, kg = tid & 3;
          GAS f32x4* dst = (GAS f32x4*)((GAS unsigned char*)(F.ws + WS_Y) + (size_t)(gla_row0(b, jj) + t) * (D * 2) + 512 + h * 256 + d * 128 + kg * 32);
          const LAS f32x4* src = (const LAS f32x4*)(LA + (d * 64 + t) * 32 + kg * 8); dst[0] = src[0]; dst[1] = src[1]; }
        for (int i = tid; i < 2048; i += NTHR) { const int t = i >> 5, k = i & 31; const float kv = KK[i];
            KTF[k * 72 + t] = bf1(kv * __expf(LA[63 * 32 + k] - LA[t * 32 + k]));
            KTB[k * 72 + t] = bf1(kv * __expf(LA[64 * 32 + k] - LA[(64 + t) * 32 + k])); }
        __syncthreads();
        if (wv < 4) { const int dir = wv >> 1, nt = wv & 1; gf32x16 acc = {};
            gmm<64>(acc, LB + (dir ? GB_KTB : GB_KTF), 144, 0, LB + GB_VT, 144, nt * 32, r32, hi);
            GAS float* dst = SLOC + ((size_t)((b * 4 + h) * 2 + dir) * GLA_NCH + jj) * 2048 + nt * 32 + r32;
#pragma unroll
            for (int r = 0; r < 16; ++r) dst[gcrow(r, hi) * 64] = acc[r]; }
        if (tid < 64) { const int d = tid >> 5, kk = tid & 31; GDEC[((size_t)((b * 4 + h) * 2 + d) * GLA_NCH + jj) * 32 + kk] = __expf(d ? LA[64 * 32 + kk] : LA[63 * 32 + kk]); }
        __syncthreads();
    }
}
__device__ __forceinline__ void p_gla_scan(const Frame& F0) { const Frame F = launder(F0);
    GAS float* SLOC = (GAS float*)(F.ws + WS_SLOC); const GAS float* GDEC = (const GAS float*)(F.ws + WS_GDEC);
    if (F.tid < 128) for (int it = blockIdx.x; it < 256; it += F.G) {
        const int chain = it >> 4, e = (it & 15) * 128 + F.tid, k = e >> 6, dir = chain & 1;
        GAS float* sl = SLOC + (size_t)chain * GLA_NCH * 2048 + e; const GAS float* dc = GDEC + (size_t)chain * GLA_NCH * 32 + k;
        float S = 0.f;
        for (int j0 = 0; j0 < GLA_NCH; j0 += 20) { float lv[20], dv[20];
#pragma unroll
            for (int q = 0; q < 20; ++q) { const int j = j0 + q, jx = dir == 0 ? j : (j < 4 ? 3 - j : GLA_NCH + 3 - j); lv[q] = sl[(size_t)jx * 2048]; dv[q] = dc[jx * 32]; }
#pragma unroll
            for (int q = 0; q < 20; ++q) { const int j = j0 + q, jx = dir == 0 ? j : (j < 4 ? 3 - j : GLA_NCH + 3 - j); sl[(size_t)jx * 2048] = S; S = dv[q] * S + lv[q]; } }
    }
}
__device__ __forceinline__ void p_gla_out(const Frame& F0, int l, bool with_ctx) { const Frame F = launder(F0);
    LAS unsigned char* LB = F.lds; LAS float* LA = (LAS float*)(LB + GB_LA); LAS float* KK = (LAS float*)(LB + GB_K); LAS float* QQ = (LAS float*)(LB + GB_Q); LAS float* OO = (LAS float*)(LB + GB_O);
    LAS unsigned short* QF = (LAS unsigned short*)(LB + GB_QF); LAS unsigned short* QB = (LAS unsigned short*)(LB + GB_QB); LAS unsigned short* KF = (LAS unsigned short*)(LB + GB_KF); LAS unsigned short* KB = (LAS unsigned short*)(LB + GB_KB);
    LAS unsigned short* ATT = (LAS unsigned short*)(LB + GB_ATT); LAS unsigned short* STF = (LAS unsigned short*)(LB + GB_STF); LAS unsigned short* STB = (LAS unsigned short*)(LB + GB_STB);
    const int tid = F.tid, wv = tid >> 6, lane = tid & 63, r32 = lane & 31, hi = lane >> 5;
    const GAS float* SLOC = (const GAS float*)(F.ws + WS_SLOC); GAS bf16* Y = (GAS bf16*)(F.ws + WS_Y); const GAS bf16* PHB = (const GAS bf16*)(F.ws + WS_PH);
    const GAS float* gng = F.in[I_GNG] + l * 64;
    constexpr int NU = NBATCH * 4 * GLA_NCH;
    GlaRegs Rn; f32x4 san = {}, scn = {}, la0n = {}, la1n = {}; v4u gwn = {};
#define GLA_PF(u_) do { const int b_ = (u_) / (4 * GLA_NCH), h_ = ((u_) / GLA_NCH) & 3, j_ = (u_) % GLA_NCH; gla_issue_kqv(F, b_, h_, j_, Rn); \
        const GAS float* s0_ = SLOC + ((size_t)((b_ * 4 + h_) * 2 + 0) * GLA_NCH + j_) * 2048; const GAS float* s1_ = SLOC + ((size_t)((b_ * 4 + h_) * 2 + 1) * GLA_NCH + j_) * 2048; \
        san = *(const GAS f32x4*)(s0_ + (tid >> 4) * 64 + (tid & 15) * 4); scn = *(const GAS f32x4*)(s1_ + (tid >> 4) * 64 + (tid & 15) * 4); \
        gwn = *(const GAS v4u*)(PHB + (size_t)(gla_row0(b_, j_) + (tid >> 3)) * NPH + PH_GA + h_ * 64 + (tid & 7) * 8); \
        { const GAS f32x4* la_ = (const GAS f32x4*)((const GAS unsigned char*)(F.ws + WS_Y) + (size_t)(gla_row0(b_, j_) + (tid >> 3)) * (D * 2) + 512 + h_ * 256 + ((tid >> 2) & 1) * 128 + (tid & 3) * 32); la0n = la_[0]; la1n = la_[1]; } } while (0)
#define GLA_SKIP(u_) (((u_) % GLA_NCH) < 4 && !with_ctx)
    int u = blockIdx.x; while (u < NU && GLA_SKIP(u)) u += F.G;
    if (u < NU) GLA_PF(u);
    while (u < NU) {
        const int b = u / (4 * GLA_NCH), h = (u / GLA_NCH) & 3, jj = u % GLA_NCH;
        const GlaRegs R = Rn; const f32x4 a = san, c = scn, la0 = la0n, la1 = la1n; const v4u gw = gwn;
        int un = u + F.G; while (un < NU && GLA_SKIP(un)) un += F.G;
        if (un < NU) GLA_PF(un);
        gla_head_kqv(F, R);
        { LAS f32x4* dl = (LAS f32x4*)(LA + (((tid >> 2) & 1) * 64 + (tid >> 3)) * 32 + (tid & 3) * 8); dl[0] = la0; dl[1] = la1; }
        __syncthreads();
        for (int i = tid; i < 2048; i += NTHR) { const int t = i >> 5, k = i & 31; const float qv = QQ[i] * 0.17677669529663687f, kv = KK[i];
            const float bf_ = LA[t * 32 + k], bb_ = LA[(64 + t) * 32 + k];
            QF[t * 40 + k] = bf1(qv * __expf(bf_)); KF[t * 40 + k] = bf1(kv * __expf(-bf_)); QB[t * 40 + k] = bf1(qv * __expf(bb_)); KB[t * 40 + k] = bf1(kv * __expf(-bb_)); }
        { const int k = tid >> 4, v4 = (tid & 15) * 4;
          STF[(v4 + 0) * 40 + k] = bf1(a.x); STF[(v4 + 1) * 40 + k] = bf1(a.y); STF[(v4 + 2) * 40 + k] = bf1(a.z); STF[(v4 + 3) * 40 + k] = bf1(a.w);
          STB[(v4 + 0) * 40 + k] = bf1(c.x); STB[(v4 + 1) * 40 + k] = bf1(c.y); STB[(v4 + 2) * 40 + k] = bf1(c.z); STB[(v4 + 3) * 40 + k] = bf1(c.w); }
        __syncthreads();
        gf32x16 acc = {};
        const int mt = wv & 1, nt = (wv >> 1) & 1;
        if (wv < 4) {
            gf32x16 af = {}, ab = {};
            gmm<32>(af, LB + GB_QF, 80, mt * 32, LB + GB_KF, 80, nt * 32, r32, hi); gmm<32>(ab, LB + GB_QB, 80, mt * 32, LB + GB_KB, 80, nt * 32, r32, hi);
            const int s = nt * 32 + r32;
#pragma unroll
            for (int r = 0; r < 16; ++r) { const int t = mt * 32 + gcrow(r, hi); const float a = (s <= t ? af[r] : 0.f) + (s >= t ? ab[r] : 0.f); ATT[t * 72 + s] = bf1(a); }
        } else {
            gmm<32>(acc, LB + GB_QF, 80, mt * 32, LB + GB_STF, 80, nt * 32, r32, hi); gmm<32>(acc, LB + GB_QB, 80, mt * 32, LB + GB_STB, 80, nt * 32, r32, hi);
        }
        __syncthreads();
        if (wv >= 4) { gmm<64>(acc, LB + GB_ATT, 144, mt * 32, LB + GB_VT, 144, nt * 32, r32, hi);
#pragma unroll
            for (int r = 0; r < 16; ++r) OO[(mt * 32 + gcrow(r, hi)) * 65 + nt * 32 + r32] = acc[r]; }
        __syncthreads();
        { const int t = tid >> 3, vg = tid & 7; float o8[8], ss = 0.f;
#pragma unroll
          for (int i = 0; i < 8; ++i) { o8[i] = OO[t * 65 + vg * 8 + i]; ss += o8[i] * o8[i]; }
          ss += __shfl_xor(ss, 1); ss += __shfl_xor(ss, 2); ss += __shfl_xor(ss, 4);
          const float rs = 1.f / sqrtf(ss * (1.f / 64.f) + RMS_EPS);
          const int row = gla_row0(b, jj) + t;
          float ga[8]; ga[0] = bf2f((unsigned short)gw.x); ga[1] = bf2f((unsigned short)(gw.x >> 16)); ga[2] = bf2f((unsigned short)gw.y); ga[3] = bf2f((unsigned short)(gw.y >> 16));
          ga[4] = bf2f((unsigned short)gw.z); ga[5] = bf2f((unsigned short)(gw.z >> 16)); ga[6] = bf2f((unsigned short)gw.w); ga[7] = bf2f((unsigned short)(gw.w >> 16));
          float y[8];
#pragma unroll
          for (int i = 0; i < 8; ++i) y[i] = o8[i] * rs * gng[vg * 8 + i] * siluf(ga[i]);
          v4u o; o.x = pk2(y[0], y[1]); o.y = pk2(y[2], y[3]); o.z = pk2(y[4], y[5]); o.w = pk2(y[6], y[7]);
          *(GAS v4u*)(Y + (size_t)row * D + h * 64 + vg * 8) = o; }
        __syncthreads();
        u = un;
    }
#undef GLA_PF
#undef GLA_SKIP
}

constexpr int FN = 32768, FN1 = 128, FN2 = 256;
constexpr size_t WS_FA = WS_XN + 33 * MiB;
constexpr size_t WS_HT = WS_PH;
constexpr size_t WS_FA0 = WS_K, WS_FA1 = WS_VT;
constexpr size_t WS_HID = AB + 521 * MiB, WS_HTC = AB + 526 * MiB, WS_CU = AB + 527 * MiB, WS_OTC = AB + 529 * MiB, WS_NPART = AB + 530 * MiB, WS_END2 = AB + 532 * MiB;
static_assert(WS_FA0 + 64 * MiB <= WS_VT && WS_FA1 + 64 * MiB <= WS_HF && WS_END2 <= 573 * MiB, "hyena map");
constexpr size_t CTL_NRM = 256 * 1024;
constexpr int FFT_TW_OFF = 40960;
typedef float f32x2 __attribute__((ext_vector_type(2)));
__device__ __forceinline__ f32x2 cmul(f32x2 a, f32x2 b) { return (f32x2){a.x * b.x - a.y * b.y, a.x * b.y + a.y * b.x}; }
__device__ __forceinline__ unsigned pkc(f32x2 v) { return pk2(v.x, v.y); }
__device__ __forceinline__ f32x2 upc(unsigned w) { return (f32x2){__uint_as_float(w << 16), __uint_as_float(w & 0xffff0000u)}; }
__device__ __forceinline__ f32x2 twid(float rev) { return (f32x2){__builtin_amdgcn_cosf(rev), __builtin_amdgcn_sinf(rev)}; }
__device__ __forceinline__ float nrm_lat(const Frame& F, int order, int c) {
    LAS float* red = (LAS float*)(F.lds + FFT_TW_OFF + 1024); const GAS float* NP = (const GAS float*)(F.ws + WS_NPART);
    const float v = wave_sum(NP[(size_t)(F.tid & 255) * 1024 + order * 512 + (F.tid >> 8) * 256 + c]);
    __syncthreads(); if (F.lane == 0) red[F.wave] = v; __syncthreads();
    float s = 0.f;
#pragma unroll
    for (int w = 0; w < 8; ++w) s += red[w];
    return 1.f / sqrtf(s + 1e-6f);
}
__device__ __forceinline__ float nrm_ctx(const Frame& F, int order, int c) { const GAS float* NP = (const GAS float*)(F.ws + WS_NPART); float s = 0.f;
#pragma unroll
    for (int pb = 256; pb < 260; ++pb) s += NP[(size_t)pb * 1024 + order * 512 + c] + NP[(size_t)pb * 1024 + order * 512 + 256 + c];
    return 1.f / sqrtf(s + 1e-6f); }

__device__ __forceinline__ void p_filt_hidden(const Frame& F0, int l) { const Frame F = launder(F0);
    LAS float* L = (LAS float*)F.lds; LAS float* W1 = L, * W2 = L + 33 * 64, * H1 = W2 + 64 * 64, * PB = H1 + 128 * 65;
    GAS float* HID = (GAS float*)(F.ws + WS_HID); const int tid = F.tid;
    for (int i = tid; i < 33 * 64; i += NTHR) W1[i] = F.in[I_HW1][l * 33 * 64 + i];
    for (int i = tid; i < 64 * 64; i += NTHR) W2[i] = F.in[I_HW2][l * 64 * 64 + i];
    if (tid < 64) { PB[tid] = F.in[I_HB1][l * 64 + tid]; PB[64 + tid] = F.in[I_HF1][l * 64 + tid]; PB[128 + tid] = F.in[I_HB2][l * 64 + tid]; PB[192 + tid] = F.in[I_HF2][l * 64 + tid]; }
    __syncthreads();
    const int p = tid & 127, jq = tid >> 7;
    for (int blk = blockIdx.x; blk < (SEQ + CTXL) / 128; blk += F.G) {
        const int prow = blk * 128 + p; const bool lat = prow < SEQ; const int pos = lat ? prow : prow - SEQ; const float Lf = lat ? (float)SEQ : (float)CTXL;
        float z[33]; z[0] = (float)pos / (Lf - 1.f);
#pragma unroll
        for (int i = 0; i < 16; ++i) { const float fr = 1e-4f + (float)i * ((15.f - 1e-4f) / 15.f); float rev = (float)pos * fr / Lf; rev -= floorf(rev);
            z[1 + i] = __builtin_amdgcn_cosf(rev); z[17 + i] = -__builtin_amdgcn_sinf(rev); }
        for (int j = jq * 16; j < jq * 16 + 16; ++j) { float a = PB[j];
#pragma unroll
            for (int i = 0; i < 33; ++i) a += z[i] * W1[i * 64 + j];
            H1[p * 65 + j] = __sinf(PB[64 + j] * a); }
        __syncthreads();
        for (int j = jq * 16; j < jq * 16 + 16; ++j) { float a = PB[128 + j];
            for (int i = 0; i < 64; ++i) a += H1[p * 65 + i] * W2[i * 64 + j];
            HID[(size_t)prow * 64 + j] = __sinf(PB[192 + j] * a); }
        __syncthreads();
    }
}
__device__ __forceinline__ void p_filt_raw(const Frame& F0, int l) { const Frame F = launder(F0);
    LAS unsigned char* LB = F.lds; LAS unsigned char* HSH = LB, * HSL = LB + 9216, * W3H = LB + 18432, * W3L = LB + 18432 + 36864; const int tid = F.tid;
    const GAS float* HID = (const GAS float*)(F.ws + WS_HID); GAS float* HT = (GAS float*)(F.ws + WS_HT); GAS float* HTC = (GAS float*)(F.ws + WS_HTC);
    const GAS float* w3 = F.in[I_HW3] + (size_t)l * 64 * 1024; const GAS float* b3 = F.in[I_HB3] + l * 1024;
    const int wv = tid >> 6, lane = tid & 63, r32 = lane & 31, hi = lane >> 5;
    int cbl = -1;
    __syncthreads();
    for (int u = blockIdx.x; u < ((SEQ + CTXL) / 64) * 4; u += F.G) {
        const int pb = u >> 2, cb = u & 3, prow0 = pb * 64; const bool lat = prow0 < SEQ; const int pos0 = lat ? prow0 : prow0 - SEQ; const float Lf = lat ? (float)SEQ : (float)CTXL;
        if (cb != cbl) { cbl = cb;
            for (int i = tid; i < 32 * 256; i += NTHR) { const int ip = i >> 8, col = i & 255;
                const float wa = w3[(size_t)(2 * ip) * 1024 + cb * 256 + col], wb = w3[(size_t)(2 * ip + 1) * 1024 + cb * 256 + col];
                const unsigned short ha = bf1(wa), hb = bf1(wb);
                *(LAS unsigned*)(W3H + col * 144 + ip * 4) = (unsigned)ha | ((unsigned)hb << 16);
                *(LAS unsigned*)(W3L + col * 144 + ip * 4) = pk2(wa - bf2f(ha), wb - bf2f(hb)); } }
        { const int p = tid >> 3, c8 = (tid & 7) * 8; const GAS f32x4* src = (const GAS f32x4*)(HID + (size_t)(prow0 + p) * 64 + c8); const f32x4 x0 = src[0], x1 = src[1];
          const unsigned short h0 = bf1(x0.x), h1 = bf1(x0.y), h2 = bf1(x0.z), h3 = bf1(x0.w), h4 = bf1(x1.x), h5 = bf1(x1.y), h6 = bf1(x1.z), h7 = bf1(x1.w);
          v4u vh, vl; vh.x = (unsigned)h0 | ((unsigned)h1 << 16); vh.y = (unsigned)h2 | ((unsigned)h3 << 16); vh.z = (unsigned)h4 | ((unsigned)h5 << 16); vh.w = (unsigned)h6 | ((unsigned)h7 << 16);
          vl.x = pk2(x0.x - bf2f(h0), x0.y - bf2f(h1)); vl.y = pk2(x0.z - bf2f(h2), x0.w - bf2f(h3)); vl.z = pk2(x1.x - bf2f(h4), x1.y - bf2f(h5)); vl.w = pk2(x1.z - bf2f(h6), x1.w - bf2f(h7));
          *(LAS v4u*)(HSH + p * 144 + c8 * 2) = vh; *(LAS v4u*)(HSL + p * 144 + c8 * 2) = vl; }
        __syncthreads();
        const int col = cb * 256 + wv * 32 + r32, ch = col & 255; const float delta = 3.0701134573253944f + (float)ch * (12.280453829301578f / 255.f), bias = b3[col];
        GAS float* dcol = lat ? HT + (size_t)col * SEQ + pos0 : HTC + (size_t)col * CTXL + pos0;
        float ss = 0.f;
#pragma unroll
        for (int mt = 0; mt < 2; ++mt) { gf32x16 acc = {};
            gmm<64>(acc, HSH, 144, mt * 32, W3H, 144, wv * 32, r32, hi); gmm<64>(acc, HSL, 144, mt * 32, W3H, 144, wv * 32, r32, hi); gmm<64>(acc, HSH, 144, mt * 32, W3L, 144, wv * 32, r32, hi);
#pragma unroll
            for (int g = 0; g < 4; ++g) { float o[4];
#pragma unroll
                for (int a = 0; a < 4; ++a) { const int pp = mt * 32 + 8 * g + 4 * hi + a; const float t = (float)(pos0 + pp) / (Lf - 1.f); o[a] = (acc[4 * g + a] + bias) * __expf(-t * delta); ss += o[a] * o[a]; }
                *(GAS f32x4*)(dcol + mt * 32 + 8 * g + 4 * hi) = (f32x4){o[0], o[1], o[2], o[3]}; } }
        ss += __shfl_xor(ss, 32);
        if (hi == 0) ((GAS float*)(F.ws + WS_NPART))[(size_t)pb * 1024 + col] = ss;
        __syncthreads();
    }
}
__device__ __forceinline__ void fft_tw_init(LAS unsigned char* lds, int tid) { if (tid < 128) ((LAS f32x2*)(lds + FFT_TW_OFF))[tid] = twid(-(float)tid * (1.f / 256.f)); __syncthreads(); }
__device__ __forceinline__ f32x2 cconj(f32x2 a) { return (f32x2){a.x, -a.y}; }
__device__ __forceinline__ f32x2 mul_mi(f32x2 a) { return (f32x2){a.y, -a.x}; }
__device__ __forceinline__ f32x2 mul_pi(f32x2 a) { return (f32x2){-a.y, a.x}; }
template <int ST>
__device__ __forceinline__ void dif4(LAS f32x2* X, const LAS f32x2* TW, int base, int g, int s) {
    const int h = 1 << s, p = g & ((h >> 1) - 1), i = (((g >> (s - 1)) << (s + 1)) | p);
    LAS f32x2* P0 = X + base + i * ST; LAS f32x2* P1 = P0 + (h >> 1) * ST; LAS f32x2* P2 = P0 + h * ST; LAS f32x2* P3 = P1 + h * ST;
    const f32x2 x0 = *P0, x1 = *P1, x2 = *P2, x3 = *P3, wa = TW[p << (7 - s)], wc = TW[p << (8 - s)];
    const f32x2 y0 = x0 + x2, y2 = cmul(x0 - x2, wa), y1 = x1 + x3, y3 = mul_mi(cmul(x1 - x3, wa));
    *P0 = y0 + y1; *P1 = cmul(y0 - y1, wc); *P2 = y2 + y3; *P3 = cmul(y2 - y3, wc);
}
template <int ST>
__device__ __forceinline__ void dit4(LAS f32x2* X, const LAS f32x2* TW, int base, int g, int s) {
    const int h = 1 << s, p = g & (h - 1), i = (((g >> s) << (s + 2)) | p);
    LAS f32x2* P0 = X + base + i * ST; LAS f32x2* P1 = P0 + h * ST; LAS f32x2* P2 = P1 + h * ST; LAS f32x2* P3 = P2 + h * ST;
    const f32x2 w1 = cconj(TW[p << (7 - s)]), w2 = cconj(TW[p << (6 - s)]);
    const f32x2 x0 = *P0, x1 = cmul(*P1, w1), x2 = *P2, x3 = cmul(*P3, w1);
    const f32x2 y0 = x0 + x1, y1 = x0 - x1, y2 = cmul(x2 + x3, w2), y3 = mul_pi(cmul(x2 - x3, w2));
    *P0 = y0 + y2; *P2 = y0 - y2; *P1 = y1 + y3; *P3 = y1 - y3;
}
__device__ __forceinline__ void fft128_cols_fwd(LAS f32x2* X, int tid) {
    const int j = tid & 31, q0 = tid >> 5; const LAS f32x2* TW = (const LAS f32x2*)((const LAS unsigned char*)X + FFT_TW_OFF);
#pragma unroll 1
    for (int s = 6; s >= 2; s -= 2) { dif4<32>(X, TW, j, q0, s); dif4<32>(X, TW, j, q0 + 16, s); __syncthreads(); }
#pragma unroll
    for (int i = 0; i < 4; ++i) { const int q = q0 + 16 * i; const f32x2 a = X[(2 * q) * 32 + j], b = X[(2 * q + 1) * 32 + j]; X[(2 * q) * 32 + j] = a + b; X[(2 * q + 1) * 32 + j] = a - b; }
    __syncthreads();
}
__device__ __forceinline__ void fft128_cols_inv(LAS f32x2* X, int tid) {
    const int j = tid & 31, q0 = tid >> 5; const LAS f32x2* TW = (const LAS f32x2*)((const LAS unsigned char*)X + FFT_TW_OFF);
#pragma unroll
    for (int i = 0; i < 4; ++i) { const int q = q0 + 16 * i; const f32x2 a = X[(2 * q) * 32 + j], b = X[(2 * q + 1) * 32 + j]; X[(2 * q) * 32 + j] = a + b; X[(2 * q + 1) * 32 + j] = a - b; }
    __syncthreads();
#pragma unroll 1
    for (int s = 1; s <= 5; s += 2) { dit4<32>(X, TW, j, q0, s); dit4<32>(X, TW, j, q0 + 16, s); __syncthreads(); }
}
__device__ __forceinline__ void fft256_rows_fwd(LAS f32x2* X, int tid) {
    const int g = tid & 63, r0 = tid >> 6; const LAS f32x2* TW = (const LAS f32x2*)((const LAS unsigned char*)X + FFT_TW_OFF);
#pragma unroll 1
    for (int s = 7; s >= 1; s -= 2) { dif4<1>(X, TW, r0 * 256, g, s); dif4<1>(X, TW, (r0 + 8) * 256, g, s); __syncthreads(); }
}
__device__ __forceinline__ void fft256_rows_inv(LAS f32x2* X, int tid) {
    const int g = tid & 63, r0 = tid >> 6; const LAS f32x2* TW = (const LAS f32x2*)((const LAS unsigned char*)X + FFT_TW_OFF);
#pragma unroll 1
    for (int s = 0; s <= 6; s += 2) { dit4<1>(X, TW, r0 * 256, g, s); dit4<1>(X, TW, (r0 + 8) * 256, g, s); __syncthreads(); }
}
__device__ __forceinline__ int bitrev7(int r) { return (int)(__brev((unsigned)r) >> 25); }
template <int KIND>
__device__ __forceinline__ void p_fft_pass1(const Frame& F0, int order, size_t ws_a) { const Frame F = launder(F0);
    fft_tw_init(F.lds, F.tid);
    LAS f32x2* X = (LAS f32x2*)F.lds; const int tid = F.tid, j = tid & 31, q0 = tid >> 5;
    const GAS float* VT = (const GAS float*)(F.ws + WS_VT); const GAS float* HT = (const GAS float*)(F.ws + WS_HT); GAS unsigned* A = (GAS unsigned*)(F.ws + ws_a);
    f32x2 pre[8];
#define P1_LOAD(uu) do { const int sg_ = (uu) >> 3, nb_ = (uu) & 7; _Pragma("unroll") for (int i = 0; i < 8; ++i) { const int n1 = q0 + 16 * i, n = 256 * n1 + 32 * nb_ + j; f32x2 v = {0.f, 0.f}; \
        if (KIND == 0) { if (n1 < 64) { v.x = VT[(size_t)(sg_ * 2 + 0) * SEQ + n]; v.y = VT[(size_t)(sg_ * 2 + 1) * SEQ + n]; } } \
        else if (KIND == 1) { const GAS float* hf = HT + (size_t)(order * 512 + sg_) * SEQ; const GAS float* hb = HT + (size_t)(order * 512 + 256 + sg_) * SEQ; \
               if (n < SEQ) v.x = hf[n]; else if (n > SEQ) v.x = hb[2 * SEQ - n]; } \
        else { const GAS float* hf = HT + (size_t)sg_ * SEQ; const GAS float* hb = HT + (size_t)(256 + sg_) * SEQ;     \
               if (n < SEQ) { v.x = hf[n]; v.y = hf[(size_t)512 * SEQ + n]; } else if (n > SEQ) { v.x = hb[2 * SEQ - n]; v.y = hb[(size_t)512 * SEQ + 2 * SEQ - n]; } } \
        pre[i] = v; } } while (0)
    int u = blockIdx.x; if (u < 256 * 8) P1_LOAD(u);
    for (; u < 256 * 8; u += F.G) {
        const int sg = u >> 3, nb = u & 7;
#pragma unroll
        for (int i = 0; i < 8; ++i) X[(q0 + 16 * i) * 32 + j] = pre[i];
        __syncthreads();
        if (u + F.G < 256 * 8) P1_LOAD(u + F.G);
        fft128_cols_fwd(X, tid);
#pragma unroll
        for (int i = 0; i < 8; ++i) { const int r = q0 + 16 * i, k1 = bitrev7(r), n2 = 32 * nb + j;
            A[((size_t)sg * FN1 + r) * FN2 + n2] = pkc(cmul(X[r * 32 + j], twid(-(float)(n2 * k1) * (1.f / (float)FN)))); }
        __syncthreads();
    }
#undef P1_LOAD
}
template <int KIND>
__device__ __forceinline__ void p_fft_pass2(const Frame& F0, int l, int order, size_t ws_a) { const Frame F = launder(F0);
    fft_tw_init(F.lds, F.tid);
    LAS f32x2* X = (LAS f32x2*)F.lds; const int tid = F.tid;
    GAS unsigned* A = (GAS unsigned*)(F.ws + ws_a); GAS unsigned* HF = (GAS unsigned*)(F.ws + WS_HF);
    unsigned pa[8], ph[8];
#define P2_LOAD(uu) do { const int sg_ = (uu) >> 3, g_ = (uu) & 7; const GAS unsigned* Ab_ = A + ((size_t)sg_ * FN1 + g_ * 16) * FN2; const GAS unsigned* Hb_ = HF + ((size_t)(order * 256 + sg_) * FN1 + g_ * 16) * FN2; \
        _Pragma("unroll") for (int i = 0; i < 8; ++i) { pa[i] = Ab_[tid + NTHR * i]; if (KIND == 0) ph[i] = Hb_[tid + NTHR * i]; } } while (0)
    int u = blockIdx.x; if (u < 256 * 8) P2_LOAD(u);
    for (; u < 256 * 8; u += F.G) {
        const int sg = u >> 3, g = u & 7;
        GAS unsigned* Ab = A + ((size_t)sg * FN1 + g * 16) * FN2; GAS unsigned* Hb = HF + ((size_t)(order * 256 + sg) * FN1 + g * 16) * FN2;
        unsigned hcur[8];
#pragma unroll
        for (int i = 0; i < 8; ++i) { X[tid + NTHR * i] = upc(pa[i]); if (KIND == 0) hcur[i] = ph[i]; }
        __syncthreads();
        if (u + F.G < 256 * 8) P2_LOAD(u + F.G);
        fft256_rows_fwd(X, tid);
        if (KIND == 1) { const float nr = nrm_lat(F, order, sg);
#pragma unroll
            for (int i = 0; i < 8; ++i) { const int e = tid + NTHR * i; const f32x2 v = X[e] * nr; const _Float16 hr = (_Float16)v.x, hi = (_Float16)v.y;
                Hb[e] = (unsigned)__builtin_bit_cast(unsigned short, hr) | ((unsigned)__builtin_bit_cast(unsigned short, hi) << 16); }
            __syncthreads();
        } else {
#pragma unroll
            for (int i = 0; i < 8; ++i) { const int e = tid + NTHR * i; const unsigned hw = hcur[i];
                const f32x2 h = {(float)__builtin_bit_cast(_Float16, (unsigned short)(hw & 0xffffu)), (float)__builtin_bit_cast(_Float16, (unsigned short)(hw >> 16))};
                X[e] = cmul(X[e], h); }
            __syncthreads();
            fft256_rows_inv(X, tid);
#pragma unroll
            for (int i = 0; i < 8; ++i) { const int e = tid + NTHR * i, r = g * 16 + (e >> 8), n2 = e & 255, k1 = bitrev7(r);
                Ab[e] = pkc(cmul(X[e], twid((float)(n2 * k1) * (1.f / (float)FN))) * (1.f / (float)FN)); }
            __syncthreads();
        }
    }
#undef P2_LOAD
}
__device__ __forceinline__ int bitrev8(int r) { return (int)(__brev((unsigned)r) >> 24); }
__device__ __forceinline__ void p_fft_pass2_filtpk(const Frame& F0, size_t ws_a) { const Frame F = launder(F0);
    fft_tw_init(F.lds, F.tid); fft_tw_init(F.lds + 65536, F.tid);
    LAS f32x2* XA = (LAS f32x2*)F.lds; LAS f32x2* XB = (LAS f32x2*)(F.lds + 65536); const int tid = F.tid;
    const GAS unsigned* A = (const GAS unsigned*)(F.ws + ws_a); GAS unsigned* HF = (GAS unsigned*)(F.ws + WS_HF);
    unsigned pa[8], pb[8];
#define PK_GA(it_) ((it_) == 0 ? 0 : (it_) == 1 ? 1 : (it_) == 2 ? 4 : (it_) == 3 ? 2 : 6)
#define PK_GB(it_) ((it_) == 0 ? 0 : (it_) == 1 ? 1 : (it_) == 2 ? 7 : (it_) == 3 ? 3 : 5)
#define PK_LOAD(uu) do { const int sg_ = (uu) / 5, it_ = (uu) % 5; const GAS unsigned* Aa_ = A + ((size_t)sg_ * FN1 + PK_GA(it_) * 16) * FN2; const GAS unsigned* Ab_ = A + ((size_t)sg_ * FN1 + PK_GB(it_) * 16) * FN2; \
        _Pragma("unroll") for (int i = 0; i < 8; ++i) { pa[i] = Aa_[tid + NTHR * i]; pb[i] = Ab_[tid + NTHR * i]; } } while (0)
    int u = blockIdx.x; if (u < 256 * 5) PK_LOAD(u);
    for (; u < 256 * 5; u += F.G) {
        const int sg = u / 5, it = u % 5, gA = PK_GA(it), gB = PK_GB(it);
#pragma unroll
        for (int i = 0; i < 8; ++i) { XA[tid + NTHR * i] = upc(pa[i]); XB[tid + NTHR * i] = upc(pb[i]); }
        __syncthreads();
        if (u + F.G < 256 * 5) PK_LOAD(u + F.G);
        fft256_rows_fwd(XA, tid); fft256_rows_fwd(XB, tid);
        const float nr0 = nrm_lat(F, 0, sg) * 0.5f, nr1 = nrm_lat(F, 1, sg) * 0.5f;
#pragma unroll
        for (int side = 0; side < 2; ++side) { if (side == 1 && gB == gA) break;
            const LAS f32x2* XS = side == 0 ? XA : XB; const LAS f32x2* XP = side == 0 ? XB : XA; const int gS = side == 0 ? gA : gB;
            GAS unsigned* H0 = HF + ((size_t)(0 * 256 + sg) * FN1 + gS * 16) * FN2; GAS unsigned* H1 = HF + ((size_t)(1 * 256 + sg) * FN1 + gS * 16) * FN2;
#pragma unroll
            for (int i = 0; i < 8; ++i) { const int e = tid + NTHR * i, r = gS * 16 + (e >> 8), j = e & 255, k1 = bitrev7(r), k2 = bitrev8(j);
                const int k1p = (128 - k1) & 127, k2p = (256 - k2 - (k1 != 0 ? 1 : 0)) & 255, rp = bitrev7(k1p), jp = bitrev8(k2p);
                const f32x2 z = XS[e], zp = cconj(XP[(rp & 15) * 256 + jp]);
                const f32x2 h0 = (z + zp) * nr0, h1 = mul_mi(z - zp) * nr1;
                const _Float16 a0 = (_Float16)h0.x, b0 = (_Float16)h0.y, a1 = (_Float16)h1.x, b1 = (_Float16)h1.y;
                H0[e] = (unsigned)__builtin_bit_cast(unsigned short, a0) | ((unsigned)__builtin_bit_cast(unsigned short, b0) << 16);
                H1[e] = (unsigned)__builtin_bit_cast(unsigned short, a1) | ((unsigned)__builtin_bit_cast(unsigned short, b1) << 16); } }
        __syncthreads();
    }
#undef PK_LOAD
#undef PK_GA
#undef PK_GB
}
__device__ __forceinline__ void p_fft_pass3(const Frame& F0, int l, int order) { const Frame F = launder(F0);
    fft_tw_init(F.lds, F.tid);
    LAS f32x2* X = (LAS f32x2*)F.lds; const int tid = F.tid, j = tid & 31, q0 = tid >> 5;
    GAS float* VT = (GAS float*)(F.ws + WS_VT); const GAS bf16* GT = (const GAS bf16*)(F.ws + (order == 0 ? WS_X1T : WS_X2T)); const GAS unsigned* A = (const GAS unsigned*)(F.ws + WS_FA);
    const GAS float* skip = F.in[I_HSKIP] + (size_t)(l * 2 + order) * 256;
    unsigned pa[8]; float pv[4][2]; unsigned short pg[4][2];
#define P3_LOAD(uu) do { const int sg_ = (uu) >> 3, nb_ = (uu) & 7; _Pragma("unroll") for (int i = 0; i < 8; ++i) pa[i] = A[((size_t)sg_ * FN1 + q0 + 16 * i) * FN2 + 32 * nb_ + j]; \
        _Pragma("unroll") for (int i = 0; i < 4; ++i) { const int n = 256 * (q0 + 16 * i) + 32 * nb_ + j; const size_t i0 = (size_t)(sg_ * 2 + 0) * SEQ + n, i1 = (size_t)(sg_ * 2 + 1) * SEQ + n; \
            pv[i][0] = VT[i0]; pv[i][1] = VT[i1]; pg[i][0] = GT[i0]; pg[i][1] = GT[i1]; } } while (0)
    int u = blockIdx.x; if (u < 256 * 8) P3_LOAD(u);
    for (; u < 256 * 8; u += F.G) {
        const int sg = u >> 3, nb = u & 7;
        float cv[4][2], cg[4][2];
#pragma unroll
        for (int i = 0; i < 8; ++i) X[(q0 + 16 * i) * 32 + j] = upc(pa[i]);
#pragma unroll
        for (int i = 0; i < 4; ++i) { cv[i][0] = pv[i][0]; cv[i][1] = pv[i][1]; cg[i][0] = bf2f(pg[i][0]); cg[i][1] = bf2f(pg[i][1]); }
        __syncthreads();
        if (u + F.G < 256 * 8) P3_LOAD(u + F.G);
        fft128_cols_inv(X, tid);
        const float sk = skip[sg];
#pragma unroll
        for (int i = 0; i < 4; ++i) { const int n1 = q0 + 16 * i, n = 256 * n1 + 32 * nb + j; const f32x2 y = X[n1 * 32 + j];
            const size_t i0 = (size_t)(sg * 2 + 0) * SEQ + n, i1 = (size_t)(sg * 2 + 1) * SEQ + n;
            VT[i0] = cg[i][0] * (y.x + sk * cv[i][0]); VT[i1] = cg[i][1] * (y.y + sk * cv[i][1]); }
        __syncthreads();
    }
#undef P3_LOAD
}
__device__ __forceinline__ void p_fft_pass31(const Frame& F0, int l) { const Frame F = launder(F0);
    fft_tw_init(F.lds, F.tid);
    LAS f32x2* X = (LAS f32x2*)F.lds; const int tid = F.tid, j = tid & 31, q0 = tid >> 5;
    GAS float* VT = (GAS float*)(F.ws + WS_VT); const GAS bf16* GT = (const GAS bf16*)(F.ws + WS_X1T); GAS unsigned* A = (GAS unsigned*)(F.ws + WS_FA);
    const GAS float* skip = F.in[I_HSKIP] + (size_t)(l * 2 + 0) * 256;
    unsigned pa[8]; float pv[4][2]; unsigned short pg[4][2];
#define P3_LOAD(uu) do { const int sg_ = (uu) >> 3, nb_ = (uu) & 7; _Pragma("unroll") for (int i = 0; i < 8; ++i) pa[i] = A[((size_t)sg_ * FN1 + q0 + 16 * i) * FN2 + 32 * nb_ + j]; \
        _Pragma("unroll") for (int i = 0; i < 4; ++i) { const int n = 256 * (q0 + 16 * i) + 32 * nb_ + j; const size_t i0 = (size_t)(sg_ * 2 + 0) * SEQ + n, i1 = (size_t)(sg_ * 2 + 1) * SEQ + n; \
            pv[i][0] = VT[i0]; pv[i][1] = VT[i1]; pg[i][0] = GT[i0]; pg[i][1] = GT[i1]; } } while (0)
    int u = blockIdx.x; if (u < 256 * 8) P3_LOAD(u);
    for (; u < 256 * 8; u += F.G) {
        const int sg = u >> 3, nb = u & 7;
        float cv[4][2], cg[4][2];
#pragma unroll
        for (int i = 0; i < 8; ++i) X[(q0 + 16 * i) * 32 + j] = upc(pa[i]);
#pragma unroll
        for (int i = 0; i < 4; ++i) { cv[i][0] = pv[i][0]; cv[i][1] = pv[i][1]; cg[i][0] = bf2f(pg[i][0]); cg[i][1] = bf2f(pg[i][1]); }
        __syncthreads();
        if (u + F.G < 256 * 8) P3_LOAD(u + F.G);
        fft128_cols_inv(X, tid);
        const float sk = skip[sg];
#pragma unroll
        for (int i = 0; i < 4; ++i) { const int n1 = q0 + 16 * i, n = 256 * n1 + 32 * nb + j; const f32x2 y = X[n1 * 32 + j];
            const size_t i0 = (size_t)(sg * 2 + 0) * SEQ + n, i1 = (size_t)(sg * 2 + 1) * SEQ + n;
            const f32x2 z = {cg[i][0] * (y.x + sk * cv[i][0]), cg[i][1] * (y.y + sk * cv[i][1])};
            VT[i0] = z.x; VT[i1] = z.y; X[n1 * 32 + j] = z; X[(n1 + 64) * 32 + j] = (f32x2){0.f, 0.f}; }
        __syncthreads();
        fft128_cols_fwd(X, tid);
#pragma unroll
        for (int i = 0; i < 8; ++i) { const int r = q0 + 16 * i, k1 = bitrev7(r), n2 = 32 * nb + j;
            A[((size_t)sg * FN1 + r) * FN2 + n2] = pkc(cmul(X[r * 32 + j], twid(-(float)(n2 * k1) * (1.f / (float)FN)))); }
        __syncthreads();
    }
#undef P3_LOAD
}
__device__ __forceinline__ void p_hy_shortconv(const Frame& F0, int l) { const Frame F = launder(F0);
    LAS bf16* IN = (LAS bf16*)F.lds; LAS float* OT = (LAS float*)(F.lds + 66 * 256 * 2 + 64); const int tid = F.tid;
    const GAS bf16* PH = (const GAS bf16*)(F.ws + WS_PH); GAS float* VT = (GAS float*)(F.ws + WS_VT); GAS bf16* X1T = (GAS bf16*)(F.ws + WS_X1T); GAS bf16* X2T = (GAS bf16*)(F.ws + WS_X2T); GAS float* CU = (GAS float*)(F.ws + WS_CU);
    const GAS float* cw = F.in[I_HCW] + (size_t)l * 3 * 768; const GAS float* cb = F.in[I_HCB] + (size_t)l * 768;
    const int nlat = NBATCH * (SEQ / 64) * 3, nctx = NBATCH * (CTXL / 64) * 3;
    v4u pw[5];
#define SC_LOAD(u_) do { const bool lat_ = (u_) < nlat; const int uu_ = lat_ ? (u_) : (u_) - nlat; const int grp_ = uu_ % 3, tile_ = (uu_ / 3) % (lat_ ? SEQ / 64 : CTXL / 64), b_ = (uu_ / 3) / (lat_ ? SEQ / 64 : CTXL / 64); \
        const int Ls_ = lat_ ? SEQ : CTXL, t0_ = tile_ * 64; const size_t rowb_ = lat_ ? (size_t)b_ * SEQ : (size_t)TL + b_ * CTXL; \
        _Pragma("unroll") for (int k_ = 0; k_ < 5; ++k_) { const int i_ = tid + NTHR * k_; const int rr_ = i_ >> 5, c8_ = (i_ & 31) * 8, t_ = t0_ + rr_ - 1; pw[k_] = (v4u){0u, 0u, 0u, 0u}; \
            if (i_ < 66 * 32 && t_ >= 0 && t_ < Ls_) pw[k_] = *(const GAS v4u*)(PH + (rowb_ + t_) * NPH + PH_HY + grp_ * 256 + c8_); } } while (0)
    if ((int)blockIdx.x < nlat + nctx) SC_LOAD((int)blockIdx.x);
    for (int u = blockIdx.x; u < nlat + nctx; u += F.G) {
        const bool lat = u < nlat; const int uu = lat ? u : u - nlat; const int grp = uu % 3, tile = (uu / 3) % (lat ? SEQ / 64 : CTXL / 64), b = (uu / 3) / (lat ? SEQ / 64 : CTXL / 64);
        const int t0 = tile * 64;
#pragma unroll
        for (int k = 0; k < 5; ++k) { const int i = tid + NTHR * k; if (i < 66 * 32) *(LAS v4u*)(IN + (i >> 5) * 256 + (i & 31) * 8) = pw[k]; }
        if (u + F.G < nlat + nctx) SC_LOAD(u + F.G);
        __syncthreads();
        { const int c = tid & 255, th = tid >> 8, ch = grp * 256 + c; const float w0 = cw[ch], w1 = cw[768 + ch], w2 = cw[1536 + ch], bb = cb[ch];
          float a = bf2f(IN[(th * 32) * 256 + c]), m = bf2f(IN[(th * 32 + 1) * 256 + c]);
          for (int i = 0; i < 32; ++i) { const float n = bf2f(IN[(th * 32 + i + 2) * 256 + c]); const float y = bb + a * w0 + m * w1 + n * w2; a = m; m = n;
              if (lat) OT[c * 65 + th * 32 + i] = y; else CU[((size_t)b * CTXL + t0 + th * 32 + i) * 768 + ch] = y; } }
        __syncthreads();
        if (lat) { const int t4 = (tid & 15) * 4;
#pragma unroll
            for (int i = 0; i < 8; ++i) { const int c = (tid >> 4) + 32 * i; const LAS float* s = OT + c * 65 + t4; const size_t o = (size_t)(c * 2 + b) * SEQ + t0 + t4;
                if (grp == 0) *(GAS f32x4*)(VT + o) = (f32x4){s[0], s[1], s[2], s[3]};
                else { v2u w; w.x = pk2(s[0], s[1]); w.y = pk2(s[2], s[3]); *(GAS v2u*)((grp == 1 ? X1T : X2T) + o) = w; } } }
        __syncthreads();
    }
}
#undef SC_LOAD
__device__ __forceinline__ void p_hy_ctx(const Frame& F0, int l) { const Frame F = launder(F0);
    LAS float* L = (LAS float*)F.lds; const int tid = F.tid, t = tid & 255, cs = tid >> 8;
    LAS float* SV = L + cs * 1280, * HFW = SV + 256, * HBW = SV + 512, * HF2 = SV + 768, * HB2 = SV + 1024;
    const GAS float* CU = (const GAS float*)(F.ws + WS_CU); const GAS float* HTC = (const GAS float*)(F.ws + WS_HTC); GAS float* OTC = (GAS float*)(F.ws + WS_OTC);
    for (int u = blockIdx.x; u < NBATCH * 128; u += F.G) {
        const int b = u >> 7, c = (u & 127) * 2 + cs;
        const float n0 = nrm_ctx(F, 0, c), n1 = nrm_ctx(F, 1, c);
        const GAS float* cu = CU + ((size_t)b * CTXL + t) * 768;
        const float v = cu[c], x1 = cu[256 + c], x2 = cu[512 + c];
        SV[t] = v; HFW[t] = HTC[(size_t)(0 + c) * CTXL + t] * n0; HBW[t] = HTC[(size_t)(256 + c) * CTXL + t] * n0; HF2[t] = HTC[(size_t)(512 + c) * CTXL + t] * n1; HB2[t] = HTC[(size_t)(768 + c) * CTXL + t] * n1;
        __syncthreads();
        float y = F.in[I_HSKIP][(l * 2 + 0) * 256 + c] * v;
        for (int s = 0; s <= t; ++s) y += HFW[t - s] * SV[s];
        for (int s = t + 1; s < CTXL; ++s) y += HBW[s - t] * SV[s];
        const float z = x1 * y;
        __syncthreads();
        SV[t] = z;
        __syncthreads();
        float y2 = F.in[I_HSKIP][(l * 2 + 1) * 256 + c] * z;
        for (int s = 0; s <= t; ++s) y2 += HF2[t - s] * SV[s];
        for (int s = t + 1; s < CTXL; ++s) y2 += HB2[s - t] * SV[s];
        OTC[((size_t)b * CTXL + t) * 256 + c] = x2 * y2;
        __syncthreads();
    }
}
__device__ __forceinline__ void p_ynorm_b(const Frame& F0, int l, bool with_ctx) { const Frame F = launder(F0);
    LAS float* T = (LAS float*)F.lds; LAS float* RS = T + 256 * 65; LAS float* PS = RS + 64; const int tid = F.tid;
    const GAS float* VT = (const GAS float*)(F.ws + WS_VT); const GAS float* OTC = (const GAS float*)(F.ws + WS_OTC); GAS bf16* Y = (GAS bf16*)(F.ws + WS_Y); const GAS float* hg = F.in[I_HNG] + l * 256;
    const int nlat = NBATCH * (SEQ / 64), nctx = with_ctx ? NBATCH * (CTXL / 64) : 0;
    for (int u = blockIdx.x; u < nlat + nctx; u += F.G) {
        const bool lat = u < nlat; const int uu = lat ? u : u - nlat, b = lat ? uu / (SEQ / 64) : uu / (CTXL / 64), t0 = (lat ? uu % (SEQ / 64) : uu % (CTXL / 64)) * 64;
        const size_t rowb = lat ? (size_t)b * SEQ + t0 : (size_t)TL + b * CTXL + t0;
        if (lat) { const int t4 = (tid & 15) * 4;
#pragma unroll
            for (int i = 0; i < 8; ++i) { const int c = (tid >> 4) + 32 * i; const f32x4 v = *(const GAS f32x4*)(VT + (size_t)(c * 2 + b) * SEQ + t0 + t4); LAS float* d = T + c * 65 + t4; d[0] = v.x; d[1] = v.y; d[2] = v.z; d[3] = v.w; } }
        else { for (int i = tid; i < 64 * 256; i += NTHR) { const int t = i >> 8, c = i & 255; T[c * 65 + t] = OTC[((size_t)b * CTXL + t0 + t) * 256 + c]; } }
        __syncthreads();
        { const int t = tid & 63, part = tid >> 6; float s = 0.f;
          for (int c = part * 32; c < part * 32 + 32; ++c) { const float v = T[c * 65 + t]; s += v * v; }
          PS[part * 64 + t] = s; }
        __syncthreads();
        if (tid < 64) { float s = 0.f;
#pragma unroll
            for (int p = 0; p < 8; ++p) s += PS[p * 64 + tid];
            RS[tid] = 1.f / sqrtf(s * (1.f / 256.f) + RMS_EPS); }
        __syncthreads();
        { const int t = tid >> 3, c0 = (tid & 7) * 8; const float rs = RS[t];
#pragma unroll
          for (int i = 0; i < 4; ++i) { const int c = c0 + 64 * i; float y[8];
#pragma unroll
              for (int e = 0; e < 8; ++e) y[e] = T[(c + e) * 65 + t] * rs * hg[c + e];
              v4u o; o.x = pk2(y[0], y[1]); o.y = pk2(y[2], y[3]); o.z = pk2(y[4], y[5]); o.w = pk2(y[6], y[7]);
              *(GAS v4u*)(Y + (rowb + t) * D + 256 + c) = o; } }
        __syncthreads();
    }
}

enum LP { LP_IN = 0, LP_PREP, LP_GLA2, LP_GLA3, LP_HY0, LP_HY1, LP_HY2, LP_HY3, LP_HY4, LP_HY5, LP_HY6, LP_HY7, LP_ATT, LP_YN, LP_OUT, LP_LN1, LP_F1, LP_F2, LP_M0  , LP_LN2 = LP_M0 + 9, PPL };
constexpr int NPRO = 4;
constexpr int NPHASE = NPRO + DEPTH * PPL;
template <int l>
__device__ __forceinline__ void layer_phases(const Frame& F, const XcdBarrier& bar, const int lo, const int hi) {
#define IN(k) (lo <= (k) && (k) < hi)
#define SEAM(k) do { if ((k) + 1 < hi) xcd_barrier(bar); } while (0)
    LAS unsigned char* ring = F.lds;
    constexpr int pb = NPRO + l * PPL;
#define lng (F.in[I_LNG] + (size_t)l * 2 * D)
#define lnb (F.in[I_LNB] + (size_t)l * 2 * D)
        if (IN(pb + LP_IN)) { const Frame P = launder(F);
            pg8::Gemm g{(const GAS bf16*)(P.ws + WS_XN), (const GAS bf16*)(P.ws + WS_WIN) + (size_t)l * NPH * D, MR, NPH, D, D, 0};
            pg8::StaticOrder S; S.init(MR, NPH, F.G, (int)blockIdx.x);
            EpiStoreBf16 E{(GAS bf16*)(P.ws + WS_PH), NPH, 1.f};
            pg8::gemm_phase<EpiStoreBf16, pg8::StaticOrder, true, true>(ring, g, S, E);
            SEAM(pb + LP_IN);
        }
        if (IN(pb + LP_PREP)) { const Frame P = launder(F); p_prep_mla_rows(F); p_gla_local(F, l);
            p_hy_shortconv(F, l); SEAM(pb + LP_PREP); }
        if (IN(pb + LP_GLA2)) { const Frame P = launder(F);
            { pg8::Gemm g{(const GAS bf16*)(P.ws + WS_PH) + PH_CQ, (const GAS bf16*)(P.ws + WS_WUQ) + (size_t)l * 768 * 256, MR, 768, 256, NPH, 0};
              pg8::StaticOrder S; S.init(MR, 768, F.G, (int)blockIdx.x);
              EpiMlaQ E{P.ws + WS_Q, P.ws + WS_QC, (const GAS float*)(P.ws + WS_RSQ), (const GAS float*)(P.ws + WS_ROPE)};
              pg8::gemm_phase<EpiMlaQ, pg8::StaticOrder, true, true>(ring, g, S, E); }
            { pg8::Gemm g{(const GAS bf16*)(P.ws + WS_PH) + PH_CKV, (const GAS bf16*)(P.ws + WS_WUKV) + (size_t)l * 1024 * 256, MR, 1024, 256, NPH, 0};
              pg8::StaticOrder S; S.init(MR, 1024, F.G, (int)blockIdx.x);
              EpiMlaKV E{P.ws + WS_K, (GAS bf16*)(P.ws + WS_V), (const GAS float*)(P.ws + WS_RSKV)};
              pg8::gemm_phase<EpiMlaKV, pg8::StaticOrder, true, true>(ring, g, S, E); }
            p_gla_scan(F); p_fft_pass1<0>(F, 0, WS_FA);
            SEAM(pb + LP_GLA2);
        }
        if (IN(pb + LP_GLA3)) { const Frame P = launder(F); p_gla_out(F, l, l == 0); p_attn_vt_pack(F); p_fft_pass2<0>(F, l, 0, WS_FA); if constexpr (l == 0) p_hy_ctx(F, l);
            SEAM(pb + LP_GLA3); }
        if (IN(pb + LP_HY0)) { p_fft_pass31(F, l); SEAM(pb + LP_HY0); }
        if (IN(pb + LP_HY1)) { p_fft_pass2<0>(F, l, 1, WS_FA); SEAM(pb + LP_HY1); }
        if (IN(pb + LP_HY2)) { p_fft_pass3(F, l, 1); SEAM(pb + LP_HY2); }
        if (IN(pb + LP_ATT)) { const Frame P = launder(F); p_attention(F, l == 0);
            SEAM(pb + LP_ATT); }
        if (IN(pb + LP_YN)) { const Frame P = launder(F); p_ynorm_c(F, l == 0 ? MR : TL, F.in[I_MNG] + (size_t)l * 512); p_ynorm_b(F, l, l == 0); if constexpr (l == 0) p_filt_hidden(F, 1); SEAM(pb + LP_YN); }
        if (IN(pb + LP_OUT)) { const Frame P = launder(F);
            const int M = (l == 0) ? MR : TL;
            pg8::Gemm g{(const GAS bf16*)(P.ws + WS_Y), (const GAS bf16*)(P.ws + WS_WOUT) + (size_t)l * D * D, M, D, D, D, 0};
            pg8::StaticOrder S; S.init(M, D, F.G, (int)blockIdx.x);
            EpiRes E{l == 0 ? F.in[I_X] : F.out, l == 0 ? F.in[I_CTX] : (const GAS float*)(P.ws + WS_XC), F.out, (GAS float*)(P.ws + WS_XC), modv(F, l, 0, 2)};
            pg8::gemm_phase<EpiRes, pg8::StaticOrder, true, true>(ring, g, S, E);
            if constexpr (l == 0) p_filt_raw(F, 1);
            SEAM(pb + LP_OUT);
        }
        if (IN(pb + LP_LN1)) { const Frame P = launder(F);
            if constexpr (l == 0) { p_ln(F, MR, lng, lnb, true, l, 3); p_fft_pass1<2>(F, 0, WS_FA0); }
            else { p_ln_route(F, lng, lnb, l); p_moe_weights(F); }
            SEAM(pb + LP_LN1);
        }
        if constexpr (l == 0) {
            if (IN(pb + LP_F1)) { const Frame P = launder(F);
                pg8::Gemm g{(const GAS bf16*)(P.ws + WS_XN), (const GAS bf16*)(P.ws + WS_W13), MR, 2 * DFF, D, D, 0};
                pg8::StaticOrder S; S.init(MR, 2 * DFF, F.G, (int)blockIdx.x);
                EpiSwiglu E{(GAS bf16*)(P.ws + WS_G), DFF, 1.f};
                pg8::gemm_phase<EpiSwiglu, pg8::StaticOrder, true, true>(ring, g, S, E);
                p_fft_pass2_filtpk(F, WS_FA0);
                SEAM(pb + LP_F1);
            }
            if (IN(pb + LP_F2)) { const Frame P = launder(F);
                pg8::Gemm g{(const GAS bf16*)(P.ws + WS_G), (const GAS bf16*)(P.ws + WS_W2), MR, D, DFF, DFF, 0};
                pg8::StaticOrder S; S.init(MR, D, F.G, (int)blockIdx.x);
                EpiRes E{F.out, (const GAS float*)(P.ws + WS_XC), F.out, (GAS float*)(P.ws + WS_XC), modv(F, l, 0, 5)};
                pg8::gemm_phase<EpiRes, pg8::StaticOrder, true, true>(ring, g, S, E);
                SEAM(pb + LP_F2);
            }
            if (IN(pb + LP_LN2)) { const Frame P = launder(F); p_ln(F, MR, lng + D, lnb + D, true, l + 1, 0); SEAM(pb + LP_LN2); }
        } else {
            if (IN(pb + LP_F1)) { const Frame P = launder(F); p_moe_scatter(F); SEAM(pb + LP_F1); }
            for (int ch = 0; ch < MOE_NCHUNK; ++ch) {
                if (IN(pb + LP_F2 + 2 * ch)) { const Frame P = launder(F);
                    moe_base_to_lds(P);
                    pg8::Gemm g{(const GAS bf16*)(P.ws + WS_HS8 + (size_t)ch * MOE_CHUNK_TILES * 256 * D), (const GAS bf16*)(P.ws + WS_WM13), MOE_CHUNK_TILES * 256, 2 * EFF, D / 2, D / 2, (size_t)2 * EFF * D};
                    MoeOrder S; S.init((const LAS int*)(F.lds + LDS_MOEBT), ch, 2 * EFF / 256, F.G, (int)blockIdx.x);
                    EpiSwiglu8 E{P.ws + WS_GC, EFF, 1.f / MOE_WSCALE, MOE_GSCALE};
                    pg8::gemm_phase<EpiSwiglu8, MoeOrder, true, true, true>(ring, g, S, E);
                    SEAM(pb + LP_F2 + 2 * ch);
                }
                if (IN(pb + LP_F2 + 2 * ch + 1)) { const Frame P = launder(F);
                    moe_base_to_lds(P);
                    pg8::Gemm g{(const GAS bf16*)(P.ws + WS_GC), (const GAS bf16*)(P.ws + WS_WM2), MOE_CHUNK_TILES * 256, D, EFF / 2, EFF / 2, (size_t)D * EFF};
                    MoeOrder S; S.init((const LAS int*)(F.lds + LDS_MOEBT), ch, D / 256, F.G, (int)blockIdx.x);
                    EpiStoreBf16 E{(GAS bf16*)(P.ws + WS_HS) + (size_t)ch * MOE_CHUNK_TILES * 256 * D, D, 1.f / (MOE_GSCALE * MOE_W2SCALE)};
                    pg8::gemm_phase<EpiStoreBf16, MoeOrder, true, true, true>(ring, g, S, E);
                    SEAM(pb + LP_F2 + 2 * ch + 1);
                }
            }
            if (IN(pb + LP_LN2)) { const Frame P = launder(F); p_ln_combine(F, lng + D, lnb + D, l); SEAM(pb + LP_LN2); }
        }

#undef lng
#undef lnb
#undef IN
#undef SEAM
}
__global__ void __launch_bounds__(NTHR, 2) mega(Args args) {
    extern __shared__ __attribute__((aligned(16))) unsigned char lds_raw[];
    Frame F;
    F.lds = (LAS unsigned char*)lds_raw; F.ws = args.ws; F.ctl = (gu32*)(args.ws + WS_CTL); F.in = (const GAS float* const GAS*)(args.ws + WS_PTRTAB); F.out = args.out;
    F.tid = threadIdx.x; F.lane = F.tid & 63; F.wave = __builtin_amdgcn_readfirstlane(F.tid >> 6); F.G = gridDim.x;
    F.gw = blockIdx.x * NWAVES + F.wave; F.ngw = F.G * NWAVES;
    volatile LAS unsigned* MISC = (volatile LAS unsigned*)(F.lds + LDS_MISC);
    if (F.tid < 32) MISC[F.tid] = 0u;
    __syncthreads();
    XcdBarrier bar; bar.bar = (unsigned*)(F.ctl + CW_BAR); bar.x = 0; bar.st = nullptr;
#if !MK_PER_PHASE
    bar = xcd_barrier_post((unsigned*)(F.ctl + CW_BAR), MISC + 8);
#endif
    const int lo = args.ph_lo, hi = args.ph_hi;
#define IN(k) (lo <= (k) && (k) < hi)
#define SEAM(k) do { if ((k) + 1 < hi) xcd_barrier(bar); } while (0)
    LAS unsigned char* ring = F.lds;
#define LTID() ({ int t_ = F.tid; asm volatile("" : "+v"(t_)); t_; })

    if (IN(0)) { Frame FK = F; FK.in = (const GAS float* const GAS*)(const GAS void*)args.in;
        if (blockIdx.x == 0 && F.tid < 37) ((const GAS float* GAS*)(args.ws + WS_PTRTAB))[F.tid] = args.in[F.tid];
        p0_modv(FK); p0_weights(FK); p0_rope_table(FK); __syncthreads();     p_filt_hidden(FK, 0);
        SEAM(0); }
    if (IN(1)) { p_xn0(F); p_filt_raw(F, 0);
        SEAM(1); }
    if (IN(2)) { p_fft_pass1<2>(F, 0, WS_FA0); SEAM(2); }
    if (IN(3)) { p_fft_pass2_filtpk(F, WS_FA0); SEAM(3); }

    layer_phases<0>(F, bar, lo, hi);
    layer_phases<1>(F, bar, lo, hi);
#undef IN
#undef SEAM
}

extern "C" void kernel_launch(void* const* d_in, const int* in_sizes, int n_in, void* d_out, int out_size, void* d_ws, size_t ws_size, hipStream_t stream) {
    static int grid = 0;
    if (grid == 0) {
        if (n_in != 37 || in_sizes[0] != TL * D || out_size != TL * D || ws_size < WS_END2) { fprintf(stderr, "kernel_launch: shape/workspace mismatch (n_in %d in0 %d out %d ws %zu need %zu)\n", n_in, n_in > 0 ? in_sizes[0] : -1, out_size, ws_size, (size_t)WS_END2); grid = -1; return; }
        int dev = 0, cus = 0, per_cu = 0;
        if (hipGetDevice(&dev) != hipSuccess || hipDeviceGetAttribute(&cus, hipDeviceAttributeMultiprocessorCount, dev) != hipSuccess) { grid = -1; return; }
        if (hipFuncSetAttribute((const void*)mega, hipFuncAttributeMaxDynamicSharedMemorySize, LDS_BYTES) != hipSuccess) { fprintf(stderr, "kernel_launch: hipFuncSetAttribute failed\n"); grid = -1; return; }
        if (hipOccupancyMaxActiveBlocksPerMultiprocessor(&per_cu, (const void*)mega, NTHR, LDS_BYTES) != hipSuccess || per_cu < 1) { fprintf(stderr, "kernel_launch: occupancy query says %d\n", per_cu); }
        (void)hipGetLastError();
        grid = cus;
    }
    if (grid < 0) return;
    if (hipMemsetAsync((char*)d_ws + WS_CTL, 0, CTL_ZERO_BYTES, stream) != hipSuccess) return;
    Args a{};
    for (int i = 0; i < 37; ++i) a.in[i] = (const GAS float*)d_in[i];
    a.out = (GAS float*)d_out; a.ws = (GAS unsigned char*)d_ws;
#if MK_PER_PHASE
    for (int p = 0; p < NPHASE; ++p) { a.ph_lo = p; a.ph_hi = p + 1; hipLaunchKernelGGL(mega, dim3(grid), dim3(NTHR), LDS_BYTES, stream, a); }
#else
    a.ph_lo = 0; a.ph_hi = NPHASE;
    hipLaunchKernelGGL(mega, dim3(grid), dim3(NTHR), LDS_BYTES, stream, a);
#endif
    const hipError_t le = hipPeekAtLastError();
    if (le != hipSuccess) fprintf(stderr, "kernel_launch: launch failed: %s\n", hipGetErrorName(le));
}
```
